# Optimizing an MI355X kernel written in HIP

```python
import math
import jax
import jax.numpy as jnp
from jax import lax
import numpy as np

D_MODEL = 1024
BATCH = 4
SEQ = 4096
DEPTH = 4
DEC_BATCH = 32
DEC_SEQ = 64
PAST_LEN = 2048

CHUNK = 64
Q_BLOCK = 128
H_A = 8
DN = 64
DR = 32
DV = 64
Q_RANK = 256
KV_RANK = 128
ROPE_THETA = 10000.0
MLA_SCALE = 1.0 / math.sqrt(DN + DR)
H_B = 8
N_B = 64
D_B = H_B * N_B
W_RANK = 64
A_RANK = 64
G_RANK = 128
D_MIX = H_A * DV + D_B
D_SHIFT = 3 * D_B + W_RANK + A_RANK + G_RANK
D_IN = Q_RANK + KV_RANK + DR + D_SHIFT
N_MEM = 256
MEM_HEADS = 4
MEM_HD = D_MODEL // MEM_HEADS
D_FF = 2816
EPS = 1e-6
GN_EPS = 64e-5
NEG_INF = -1e30

kernel_name = 'hybrid_mla_rwkv7_macaron_stream_step'


def rmsnorm(x, g):
    xf = x.astype(jnp.float32)
    y = xf * lax.rsqrt(jnp.mean(xf * xf, axis=-1, keepdims=True) + EPS)
    return (y * g.astype(jnp.float32)).astype(x.dtype)


def swiglu_half(x, g, w_gate, w_up, w_down):
    h = rmsnorm(x, g)
    return x + 0.5 * ((jax.nn.silu(h @ w_gate) * (h @ w_up)) @ w_down)


def rope(x, pos):
    half = DR // 2
    inv = ROPE_THETA ** (-jnp.arange(half, dtype=jnp.float32) / half)
    ang = pos.astype(jnp.float32)[:, None] * inv[None, :]
    shp = (1, pos.shape[0]) + (1,) * (x.ndim - 3) + (half,)
    cos = jnp.cos(ang).reshape(shp)
    sin = jnp.sin(ang).reshape(shp)
    xf = x.astype(jnp.float32)
    x1, x2 = xf[..., :half], xf[..., half:]
    return jnp.concatenate([x1 * cos - x2 * sin, x1 * sin + x2 * cos], axis=-1).astype(x.dtype)


def mla_block(q_lat, q_rope, q_pos, c_kv, k_rope, k_pos):
    s = (jnp.einsum('bqhc,bkc->bhqk', q_lat, c_kv)
         + jnp.einsum('bqhr,bkr->bhqk', q_rope, k_rope)).astype(jnp.float32) * MLA_SCALE
    limit = (q_pos // CHUNK + 1) * CHUNK
    mask = k_pos[None, :] < limit[:, None]
    s = jnp.where(mask[None, None], s, NEG_INF)
    p = jax.nn.softmax(s, axis=-1).astype(c_kv.dtype)
    return jnp.einsum('bhqk,bkc->bqhc', p, c_kv)


def wkv_scan(r, w, k, v, kk, a, s0):
    def step(S, inp):
        r_t, w_t, k_t, v_t, kk_t, a_t = inp
        sa = jnp.einsum('bhvk,bhk->bhv', S, -kk_t)
        S = (S * w_t[:, :, None, :] + sa[..., None] * (kk_t * a_t)[:, :, None, :]
             + v_t[..., None] * k_t[:, :, None, :])
        return S, jnp.einsum('bhvk,bhk->bhv', S, r_t)
    tm = lambda z: jnp.moveaxis(z, 1, 0)
    S, y = lax.scan(step, s0.astype(jnp.float32), (tm(r), tm(w), tm(k), tm(v), tm(kk), tm(a)))
    return S, jnp.moveaxis(y, 0, 1)


def token_mixer(h, pos, k_pos, ckv_past, krope_past, wkv0, shift0, lp):
    f32 = jnp.float32
    b, t, _ = h.shape
    proj = h @ lp['w_in']
    c_q, c_kv, k_r, p_b = jnp.split(proj, [Q_RANK, Q_RANK + KV_RANK, Q_RANK + KV_RANK + DR], axis=-1)
    q = (rmsnorm(c_q, lp['q_norm']) @ lp['w_uq']).reshape(b, t, H_A, DN + DR)
    q_rope = rope(q[..., DN:], pos)
    q_lat = jnp.einsum('bthd,hcd->bthc', q[..., :DN], lp['w_uk'])
    c_kv = rmsnorm(c_kv, lp['kv_norm'])
    k_r = rope(k_r, pos)
    if ckv_past is None:
        ckv_all, kr_all = c_kv, k_r
    else:
        ckv_all = jnp.concatenate([ckv_past, c_kv], axis=1)
        kr_all = jnp.concatenate([krope_past, k_r], axis=1)
    if t > Q_BLOCK:
        nb = t // Q_BLOCK
        to_blocks = lambda z: jnp.moveaxis(z.reshape((b, nb, Q_BLOCK) + z.shape[2:]), 1, 0)
        o = lax.map(lambda args: mla_block(args[0], args[1], args[2], ckv_all, kr_all, k_pos),
                    (to_blocks(q_lat), to_blocks(q_rope), pos.reshape(nb, Q_BLOCK)))
        o_lat = jnp.moveaxis(o, 0, 1).reshape(b, t, H_A, KV_RANK)
    else:
        o_lat = mla_block(q_lat, q_rope, pos, ckv_all, kr_all, k_pos)
    y_a = jnp.einsum('bthc,hcv->bthv', o_lat, lp['w_uv']).reshape(b, t, H_A * DV)
    prev = jnp.concatenate([shift0, p_b[:, :-1]], axis=1)
    xs = p_b + lp['shift_mu'] * (prev - p_b)
    r, k, v, xw, xa, xg = jnp.split(
        xs, [D_B, 2 * D_B, 3 * D_B, 3 * D_B + W_RANK, 3 * D_B + W_RANK + A_RANK], axis=-1)
    z = (lp['w0'] + jnp.tanh(xw) @ lp['w_up']).astype(f32)
    decay = jnp.exp(-jnp.exp(-jax.nn.softplus(-z) - 0.5))
    a = jax.nn.sigmoid((lp['a0'] + xa @ lp['a_up']).astype(f32))
    g = jax.nn.sigmoid(xg) @ lp['g_up']
    heads = lambda u: u.astype(f32).reshape(b, t, H_B, N_B)
    r_h, k_h, v_h, a_h, w_h = heads(r), heads(k), heads(v), heads(a), heads(decay)
    kk = k_h * lp['k_k'].astype(f32).reshape(H_B, N_B)
    kk = kk * lax.rsqrt(jnp.sum(kk * kk, axis=-1, keepdims=True) + 1e-12)
    k_h = k_h * (1.0 + (a_h - 1.0) * lp['k_a'].astype(f32).reshape(H_B, N_B))
    wkv, y = wkv_scan(r_h, w_h, k_h, v_h, kk, a_h, wkv0)
    mu = jnp.mean(y, axis=-1, keepdims=True)
    var = jnp.mean(jnp.square(y - mu), axis=-1, keepdims=True)
    y = ((y - mu) * lax.rsqrt(var + GN_EPS) * lp['gn_gain'].astype(f32).reshape(H_B, N_B)
         + lp['gn_bias'].astype(f32).reshape(H_B, N_B))
    y = y + jnp.sum(r_h * k_h * lp['r_k'].astype(f32), axis=-1, keepdims=True) * v_h
    y_b = y.reshape(b, t, D_B).astype(h.dtype) * g
    out = jnp.concatenate([y_a, y_b], axis=-1) @ lp['w_out']
    return out, c_kv, k_r, wkv.astype(wkv0.dtype), p_b[:, -1:]


def mem_kv(mem, lp):
    b = mem.shape[0]
    m = rmsnorm(mem, lp['mem_kv_norm'])
    mk = (m @ lp['w_mk']).reshape(b, N_MEM, MEM_HEADS, MEM_HD)
    mv = (m @ lp['w_mv']).reshape(b, N_MEM, MEM_HEADS, MEM_HD)
    return mk, mv


def mem_attend(x, mk, mv, lp):
    b, t, _ = x.shape
    h = rmsnorm(x, lp['xattn_norm'])
    q = (h @ lp['w_mq']).reshape(b, t, MEM_HEADS, MEM_HD)
    s = jnp.einsum('bqhd,bmhd->bhqm', q, mk).astype(jnp.float32) / math.sqrt(MEM_HD)
    p = jax.nn.softmax(s, axis=-1).astype(x.dtype)
    o = jnp.einsum('bhqm,bmhd->bqhd', p, mv).reshape(b, t, D_MODEL)
    return x + o @ lp['w_mo']


def layer(x, pos, k_pos, ckv_past, krope_past, wkv0, shift0, mk, mv, lp):
    x = swiglu_half(x, lp['ffn1_norm'], lp['ffn1_w_gate'], lp['ffn1_w_up'], lp['ffn1_w_down'])
    y, c_kv, k_r, wkv, shift = token_mixer(rmsnorm(x, lp['mix_norm']), pos, k_pos,
                                           ckv_past, krope_past, wkv0, shift0, lp)
    x = x + y
    x = mem_attend(x, mk, mv, lp)
    x = swiglu_half(x, lp['ffn2_norm'], lp['ffn2_w_gate'], lp['ffn2_w_up'], lp['ffn2_w_down'])
    return x, c_kv, k_r, wkv, shift


def setup_inputs(seed: int = 0) -> dict:
    key = jax.random.key(seed)
    keys = jax.random.split(key, 64)
    ctr = [0]

    def nrm(shape, scale):
        kk = keys[ctr[0]]
        ctr[0] += 1
        return scale * jax.random.normal(kk, shape, jnp.float32)

    def gain(shape):
        return 1.0 + nrm(shape, 0.05)

    L, D = DEPTH, D_MODEL
    return {
        'x_prompt': nrm((BATCH, SEQ, D), 1.0),
        'x_sample': nrm((DEC_BATCH, DEC_SEQ, D), 1.0),
        'mem_prompt': nrm((BATCH, N_MEM, D), 1.0),
        'cache_ckv': nrm((L, DEC_BATCH, PAST_LEN, KV_RANK), 1.0),
        'cache_krope': nrm((L, DEC_BATCH, PAST_LEN, DR), 1.0),
        'cache_mem_k': nrm((L, DEC_BATCH, N_MEM, MEM_HEADS, MEM_HD), 1.0),
        'cache_mem_v': nrm((L, DEC_BATCH, N_MEM, MEM_HEADS, MEM_HD), 1.0),
        'state_wkv': nrm((L, DEC_BATCH, H_B, N_B, N_B), 0.5),
        'state_shift': nrm((L, DEC_BATCH, 1, D_SHIFT), 1.0),
        'ffn1_norm': gain((L, D)),
        'ffn1_w_gate': nrm((L, D, D_FF), D ** -0.5),
        'ffn1_w_up': nrm((L, D, D_FF), D ** -0.5),
        'ffn1_w_down': nrm((L, D_FF, D), D_FF ** -0.5),
        'mix_norm': gain((L, D)),
        'w_in': nrm((L, D, D_IN), D ** -0.5),
        'q_norm': gain((L, Q_RANK)),
        'w_uq': nrm((L, Q_RANK, H_A * (DN + DR)), Q_RANK ** -0.5),
        'kv_norm': gain((L, KV_RANK)),
        'w_uk': nrm((L, H_A, KV_RANK, DN), KV_RANK ** -0.5),
        'w_uv': nrm((L, H_A, KV_RANK, DV), KV_RANK ** -0.5),
        'shift_mu': jax.nn.sigmoid(nrm((L, D_SHIFT), 1.0)),
        'w0': -2.0 + nrm((L, D_B), 0.5),
        'w_up': nrm((L, W_RANK, D_B), 0.5 * W_RANK ** -0.5),
        'a0': nrm((L, D_B), 0.5),
        'a_up': nrm((L, A_RANK, D_B), A_RANK ** -0.5),
        'g_up': nrm((L, G_RANK, D_B), G_RANK ** -0.5),
        'k_k': 0.85 + nrm((L, D_B), 0.05),
        'k_a': 1.0 + nrm((L, D_B), 0.05),
        'r_k': nrm((L, H_B, N_B), 0.1),
        'gn_gain': gain((L, D_B)),
        'gn_bias': nrm((L, D_B), 0.02),
        'w_out': nrm((L, D_MIX, D), D_MIX ** -0.5),
        'xattn_norm': gain((L, D)),
        'mem_kv_norm': gain((L, D)),
        'w_mq': nrm((L, D, D), D ** -0.5),
        'w_mk': nrm((L, D, D), D ** -0.5),
        'w_mv': nrm((L, D, D), D ** -0.5),
        'w_mo': nrm((L, D, D), D ** -0.5),
        'ffn2_norm': gain((L, D)),
        'ffn2_w_gate': nrm((L, D, D_FF), D ** -0.5),
        'ffn2_w_up': nrm((L, D, D_FF), D ** -0.5),
        'ffn2_w_down': nrm((L, D_FF, D), D_FF ** -0.5),
        'final_norm': gain((D,)),
    }


def reference(x_prompt, x_sample, mem_prompt, cache_ckv, cache_krope, cache_mem_k, cache_mem_v,
              state_wkv, state_shift, ffn1_norm, ffn1_w_gate, ffn1_w_up, ffn1_w_down, mix_norm, w_in,
              q_norm, w_uq, kv_norm, w_uk, w_uv, shift_mu, w0, w_up, a0, a_up, g_up, k_k, k_a, r_k,
              gn_gain, gn_bias, w_out, xattn_norm, mem_kv_norm, w_mq, w_mk, w_mv, w_mo,
              ffn2_norm, ffn2_w_gate, ffn2_w_up, ffn2_w_down, final_norm):
    b_p = x_prompt.shape[0]
    t_s = x_sample.shape[1]
    pos_p = jnp.arange(x_prompt.shape[1], dtype=jnp.int32)
    pos_s = PAST_LEN + jnp.arange(t_s, dtype=jnp.int32)
    kpos_s = jnp.arange(PAST_LEN + t_s, dtype=jnp.int32)
    wkv_zero = jnp.zeros((b_p, H_B, N_B, N_B), x_prompt.dtype)
    shift_zero = jnp.zeros((b_p, 1, D_SHIFT), x_prompt.dtype)
    xp, xs = x_prompt, x_sample
    ckv_p, kr_p, mk_p, mv_p, wkv_p, sh_p = [], [], [], [], [], []
    ckv_s, kr_s, wkv_s, sh_s = [], [], [], []
    for l in range(DEPTH):
        lp = {
            'ffn1_norm': ffn1_norm[l], 'ffn1_w_gate': ffn1_w_gate[l], 'ffn1_w_up': ffn1_w_up[l],
            'ffn1_w_down': ffn1_w_down[l], 'mix_norm': mix_norm[l], 'w_in': w_in[l],
            'q_norm': q_norm[l], 'w_uq': w_uq[l], 'kv_norm': kv_norm[l], 'w_uk': w_uk[l],
            'w_uv': w_uv[l], 'shift_mu': shift_mu[l], 'w0': w0[l], 'w_up': w_up[l], 'a0': a0[l],
            'a_up': a_up[l], 'g_up': g_up[l], 'k_k': k_k[l], 'k_a': k_a[l], 'r_k': r_k[l],
            'gn_gain': gn_gain[l], 'gn_bias': gn_bias[l], 'w_out': w_out[l],
            'xattn_norm': xattn_norm[l], 'mem_kv_norm': mem_kv_norm[l], 'w_mq': w_mq[l],
            'w_mk': w_mk[l], 'w_mv': w_mv[l], 'w_mo': w_mo[l], 'ffn2_norm': ffn2_norm[l],
            'ffn2_w_gate': ffn2_w_gate[l], 'ffn2_w_up': ffn2_w_up[l], 'ffn2_w_down': ffn2_w_down[l],
        }
        mk, mv = mem_kv(mem_prompt, lp)
        xp, c1, k1, s1, h1 = layer(xp, pos_p, pos_p, None, None, wkv_zero, shift_zero, mk, mv, lp)
        ckv_p.append(c1); kr_p.append(k1); mk_p.append(mk); mv_p.append(mv)
        wkv_p.append(s1); sh_p.append(h1)
        xs, c2, k2, s2, h2 = layer(xs, pos_s, kpos_s, cache_ckv[l], cache_krope[l], state_wkv[l],
                                   state_shift[l], cache_mem_k[l], cache_mem_v[l], lp)
        ckv_s.append(c2); kr_s.append(k2); wkv_s.append(s2); sh_s.append(h2)
    y_prompt = rmsnorm(xp, final_norm)
    y_sample = rmsnorm(xs, final_norm)
    return (y_prompt, y_sample,
            jnp.stack(ckv_p), jnp.stack(kr_p), jnp.stack(mk_p), jnp.stack(mv_p),
            jnp.stack(wkv_p), jnp.stack(sh_p),
            jnp.stack(ckv_s), jnp.stack(kr_s), jnp.stack(wkv_s), jnp.stack(sh_s))
```

```cpp
#include <hip/hip_runtime.h>
#include <hip/hip_cooperative_groups.h>
#include <stdint.h>
#include <stdio.h>
namespace cg = cooperative_groups;

typedef unsigned short u16;
using bf16x8 = __attribute__((ext_vector_type(8))) short;
using f32x4 = __attribute__((ext_vector_type(4))) float;
using f32x16 = __attribute__((ext_vector_type(16))) float;

#ifndef N_LAUNCH_PER_PHASE
#define N_LAUNCH_PER_PHASE 0
#endif

constexpr int TP = 16384, TS = 2048, T = TP + TS, NL = 4;
constexpr int DFF = 2816, DIN = 2208, DINP = 2304, DSH = 1792;
constexpr int NTHR = 512;
constexpr int SMEM_BYTES = 131072 + 1024;
constexpr float QSCALE = 0.10206207261596577f * 1.4426950408889634f;
constexpr float XSCALE = 0.0625f * 1.4426950408889634f;

constexpr size_t OO_Y = 0;
constexpr size_t OO_CKVP = OO_Y + (size_t)T * 1024;
constexpr size_t OO_KRP = OO_CKVP + (size_t)NL * 4 * 4096 * 128;
constexpr size_t OO_MKP = OO_KRP + (size_t)NL * 4 * 4096 * 32;
constexpr size_t OO_MVP = OO_MKP + (size_t)NL * 4 * 256 * 1024;
constexpr size_t OO_WKVP = OO_MVP + (size_t)NL * 4 * 256 * 1024;
constexpr size_t OO_SHP = OO_WKVP + (size_t)NL * 4 * 8 * 4096;
constexpr size_t OO_CKVS = OO_SHP + (size_t)NL * 4 * DSH;
constexpr size_t OO_KRS = OO_CKVS + (size_t)NL * 32 * 64 * 128;
constexpr size_t OO_WKVS = OO_KRS + (size_t)NL * 32 * 64 * 32;
constexpr size_t OO_SHS = OO_WKVS + (size_t)NL * 32 * 8 * 4096;
constexpr size_t OO_END = OO_SHS + (size_t)NL * 32 * DSH;

constexpr size_t al256(size_t x) { return (x + 255) & ~(size_t)255; }
constexpr size_t W_X = 0;
constexpr size_t W_XB = W_X + al256((size_t)T * 1024 * 4);
constexpr size_t W_SSQ = W_XB + al256((size_t)T * 1024 * 2);
constexpr size_t W_ACT = W_SSQ + al256((size_t)T * 4 * 4);
constexpr size_t W_WB = W_ACT;
constexpr size_t W_BB = W_WB + al256((size_t)T * 512 * 4);
constexpr size_t W_GB = W_BB + al256((size_t)T * 512 * 4);
constexpr size_t W_QX = W_ACT;
constexpr size_t W_PROJ = W_ACT + al256((size_t)T * DFF * 2);
constexpr size_t W_AO = W_PROJ;
constexpr size_t W_CQB = W_PROJ + al256((size_t)T * DINP * 2);
constexpr size_t W_A2 = W_CQB + al256((size_t)T * 256 * 2);
constexpr size_t W_QB = W_A2 + al256((size_t)T * 256 * 2);
constexpr size_t W_XO = W_QB;
constexpr size_t W_RB = W_QB + al256((size_t)T * 1280 * 2);
constexpr size_t W_KB = W_RB + al256((size_t)T * 512 * 4);
constexpr size_t W_VB = W_KB + al256((size_t)T * 512 * 4);
constexpr size_t W_KKB = W_VB + al256((size_t)T * 512 * 4);
constexpr size_t W_KP = W_KKB + al256((size_t)T * 512 * 4);
constexpr size_t W_KS = W_KP + al256((size_t)4 * 4096 * 160 * 2);
constexpr size_t W_VTP = W_KS + al256((size_t)32 * 2112 * 160 * 2);
constexpr size_t W_VTS = W_VTP + al256((size_t)4 * 128 * 4096 * 2);
constexpr size_t W_MKP = W_VTS + al256((size_t)32 * 128 * 2112 * 2);
constexpr size_t W_MVTP = W_MKP + al256((size_t)NL * 16 * 65536 * 2);
constexpr size_t W_MKS = W_MVTP + al256((size_t)NL * 16 * 65536 * 2);
constexpr size_t W_MVTS = W_MKS + al256((size_t)128 * 65536 * 2);
constexpr size_t W_MB = W_MVTS + al256((size_t)128 * 65536 * 2);
constexpr size_t W_ROPE = W_MB + al256((size_t)1024 * 1024 * 2);
constexpr size_t W_CNT = W_ROPE + al256((size_t)4096 * 16 * 8);
constexpr size_t W_WT = W_CNT + 256;
constexpr size_t WE_GU1 = 0;
constexpr size_t WE_D1 = WE_GU1 + (size_t)5632 * 1024;
constexpr size_t WE_IN = WE_D1 + (size_t)1024 * DFF;
constexpr size_t WE_Q = WE_IN + (size_t)DINP * 1024;
constexpr size_t WE_RW = WE_Q + (size_t)1280 * 256;
constexpr size_t WE_OUT = WE_RW + (size_t)1536 * 256;
constexpr size_t WE_MQ = WE_OUT + (size_t)1024 * 1536;
constexpr size_t WE_MK = WE_MQ + (size_t)1024 * 1024;
constexpr size_t WE_MV = WE_MK + (size_t)1024 * 1024;
constexpr size_t WE_MO = WE_MV + (size_t)1024 * 1024;
constexpr size_t WE_GU2 = WE_MO + (size_t)1024 * 1024;
constexpr size_t WE_D2 = WE_GU2 + (size_t)5632 * 1024;
constexpr size_t WE_LAYER = WE_D2 + (size_t)1024 * DFF;
constexpr size_t W_END = W_WT + al256(WE_LAYER * NL * 2);

enum { I_XP = 0, I_XS, I_MEMP, I_CCKV, I_CKR, I_CMK, I_CMV, I_SWKV, I_SSH, I_F1N, I_F1G, I_F1U, I_F1D, I_MIXN, I_WIN,
       I_QN, I_WUQ, I_KVN, I_WUK, I_WUV, I_MU, I_W0, I_WUP, I_A0, I_AUP, I_GUP, I_KK, I_KA, I_RK, I_GNG, I_GNB, I_WOUT,
       I_XN, I_MKVN, I_WMQ, I_WMK, I_WMV, I_WMO, I_F2N, I_F2G, I_F2U, I_F2D, I_FN, N_IN };

struct Params {
  const float* in[N_IN];
  float* out;
  char* ws;
  int ph_lo, ph_hi;
};

__device__ __forceinline__ u16 f2bf(float f) {
  unsigned u = __float_as_uint(f);
  u += 0x7fffu + ((u >> 16) & 1u);
  return (u16)(u >> 16);
}
__device__ __forceinline__ float bf2f(u16 h) { return __uint_as_float(((unsigned)h) << 16); }
__device__ __forceinline__ unsigned pack2(float a, float b) { return (unsigned)f2bf(a) | ((unsigned)f2bf(b) << 16); }
__device__ __forceinline__ float wave_sum(float x) {
#pragma unroll
  for (int o = 32; o; o >>= 1) x += __shfl_xor(x, o);
  return x;
}
__device__ __forceinline__ float dpp_sum8(float x) {
  x += __int_as_float(__builtin_amdgcn_update_dpp(0, __float_as_int(x), 0xB1, 0xF, 0xF, false));
  x += __int_as_float(__builtin_amdgcn_update_dpp(0, __float_as_int(x), 0x4E, 0xF, 0xF, false));
  x += __int_as_float(__builtin_amdgcn_update_dpp(0, __float_as_int(x), 0x141, 0xF, 0xF, false));
  return x;
}
__device__ __forceinline__ int tidx() { int t = threadIdx.x; asm volatile("" : "+v"(t)); return t; }
__device__ __forceinline__ float sigmoidf_(float x) { return 1.f / (1.f + __expf(-x)); }

constexpr int BM = 256, BK = 64, HALF = 128, HT = HALF * BK;

__device__ __forceinline__ int lds_byte(int r, int c) {
  int st = (r >> 4) * 2 + (c >> 5), rr = r & 15, cc = c & 31, ob = rr * 64 + cc * 2;
  return st * 1024 + (ob ^ (((ob >> 9) & 1) << 5));
}
__device__ __forceinline__ void stage_rc(int b, int& R, int& C) {
  int st = b / 1024, sb = b % 1024, swz = sb ^ (((sb >> 9) & 1) << 5);
  R = (st >> 1) * 16 + swz / 64; C = (st & 1) * 32 + (swz % 64) / 2;
}

template <class Epi>
__device__ __forceinline__ void gemm_phase(const u16* __restrict__ A, const u16* __restrict__ Bt, const int K,
                                           const int nM, const int nN, const int rot, Epi epi) {
  extern __shared__ __attribute__((aligned(16))) char smem[];
  u16* shm = (u16*)smem;
#define SA(b, h) (shm + ((b) * 2 + (h)) * HT)
#define SB(b, h) (shm + (4 + (b) * 2 + (h)) * HT)
#define STAGE(P, BASE, br, kt) do { const u16* _gb = BASE + ((long)(br) * K + (long)(kt) * BK); \
    __builtin_amdgcn_global_load_lds((const unsigned*)((const char*)_gb + so0), \
        (__attribute__((address_space(3))) unsigned*)((char*)(P) + wu16), 16, 0, 0); \
    __builtin_amdgcn_global_load_lds((const unsigned*)((const char*)_gb + so1), \
        (__attribute__((address_space(3))) unsigned*)((char*)(P) + wu16 + 8192), 16, 0, 0); } while (0)
#define LDA(dst, b, h) for (int m = 0; m < 4; ++m) for (int k = 0; k < 2; ++k) \
    dst[m][k] = *reinterpret_cast<const bf16x8*>((char*)SA(b, h) + lds_byte(wr * 64 + m * 16 + fr, k * 32 + fq * 8))
#define LDB(dst, b, h) for (int n = 0; n < 2; ++n) for (int k = 0; k < 2; ++k) \
    dst[n][k] = *reinterpret_cast<const bf16x8*>((char*)SB(b, h) + lds_byte(wc * 32 + n * 16 + fr, k * 32 + fq * 8))
#define MMA(ai, bj, At_, Bt_) do { __builtin_amdgcn_s_setprio(1); \
    for (int m = 0; m < 4; ++m) for (int n = 0; n < 2; ++n) for (int k = 0; k < 2; ++k) \
      acc[ai][bj][m][n] = __builtin_amdgcn_mfma_f32_16x16x32_bf16(At_[m][k], Bt_[n][k], acc[ai][bj][m][n], 0, 0, 0); \
    __builtin_amdgcn_s_setprio(0); } while (0)
#define WAIT_V(n) asm volatile("s_waitcnt vmcnt(" #n ")" ::: "memory")
#define WAIT_L(n) asm volatile("s_waitcnt lgkmcnt(" #n ")" ::: "memory")
#define BAR __builtin_amdgcn_s_barrier()
#define SCHED __builtin_amdgcn_sched_barrier(0)
  const int G = gridDim.x;
  const int ntiles = nM * nN;
  const int tid_ = tidx();
  const int wid = tid_ >> 6, lane = tid_ & 63, wr = wid >> 2, wc = wid & 3, fr = lane & 15, fq = lane >> 4;
  const int nt = K / BK;
  unsigned so0, so1;
  const int wu16 = __builtin_amdgcn_readfirstlane(tid_ >> 6) * 1024;
  { int _r, _c; stage_rc(tid_ * 16, _r, _c); so0 = (unsigned)(_r * K + _c) * 2u;
    stage_rc(tid_ * 16 + 8192, _r, _c); so1 = (unsigned)(_r * K + _c) * 2u; }
  for (int tile = (int)((blockIdx.x + G - (rot % G)) % G); tile < ntiles; tile += G) {
    int wgid = tile;
    { int q = ntiles / 8, r = ntiles % 8, xcd = wgid % 8, off = wgid / 8;
      wgid = (xcd < r ? xcd * (q + 1) : r * (q + 1) + (xcd - r) * q) + off; }
    int nig = 8 * nN, gid = wgid / nig, fm = gid * 8, gsz = min(nM - fm, 8);
    int pm = fm + ((wgid % nig) % gsz), pn = (wgid % nig) / gsz, brow = pm * BM, bcol = pn * BM;
    f32x4 acc[2][2][4][2] = {};
    bf16x8 At[4][2], B0[2][2], B1[2][2];
    STAGE(SB(0, 0), Bt, bcol, 0); STAGE(SA(0, 0), A, brow, 0);
    STAGE(SB(0, 1), Bt, bcol + HALF, 0); STAGE(SA(0, 1), A, brow + HALF, 0);
    if (wr == 1) BAR;
    WAIT_V(4); BAR;
    STAGE(SB(1, 0), Bt, bcol, 1); STAGE(SA(1, 0), A, brow, 1); STAGE(SB(1, 1), Bt, bcol + HALF, 1);
    WAIT_V(6); BAR;
    for (int t = 0; t < nt - 2; t += 2) {
      LDB(B0, 0, 0); SCHED; LDA(At, 0, 0); STAGE(SA(1, 1), A, brow + HALF, t + 1);
      WAIT_L(8); BAR; WAIT_L(0); MMA(0, 0, At, B0); BAR; SCHED;
      LDB(B1, 0, 1); STAGE(SB(0, 0), Bt, bcol, t + 2);
      BAR; WAIT_L(0); MMA(0, 1, At, B1); BAR;
      LDA(At, 0, 1); STAGE(SA(0, 0), A, brow, t + 2);
      BAR; WAIT_L(0); MMA(1, 0, At, B0); BAR; SCHED;
      STAGE(SB(0, 1), Bt, bcol + HALF, t + 2);
      WAIT_V(6); BAR; MMA(1, 1, At, B1); BAR;
      LDB(B0, 1, 0); SCHED; LDA(At, 1, 0); STAGE(SA(0, 1), A, brow + HALF, t + 2);
      WAIT_L(8); BAR; WAIT_L(0); MMA(0, 0, At, B0); BAR; SCHED;
      LDB(B1, 1, 1); STAGE(SB(1, 0), Bt, bcol, t + 3);
      BAR; WAIT_L(0); MMA(0, 1, At, B1); BAR;
      LDA(At, 1, 1); STAGE(SA(1, 0), A, brow, t + 3);
      BAR; WAIT_L(0); MMA(1, 0, At, B0); BAR; SCHED;
      STAGE(SB(1, 1), Bt, bcol + HALF, t + 3);
      WAIT_V(6); BAR; MMA(1, 1, At, B1); BAR;
    }
    { LDB(B0, 0, 0); LDA(At, 0, 0); STAGE(SA(1, 1), A, brow + HALF, nt - 1);
      BAR; WAIT_L(0); MMA(0, 0, At, B0); BAR;
      LDB(B1, 0, 1); BAR; WAIT_L(0); MMA(0, 1, At, B1); BAR;
      LDA(At, 0, 1); WAIT_V(4); BAR; WAIT_L(0); MMA(1, 0, At, B0); MMA(1, 1, At, B1); BAR; }
    { LDB(B0, 1, 0); LDA(At, 1, 0); WAIT_V(2); BAR; WAIT_L(0); MMA(0, 0, At, B0); BAR;
      LDB(B1, 1, 1); WAIT_V(0); BAR; WAIT_L(0); MMA(0, 1, At, B1); BAR;
      LDA(At, 1, 1); BAR; WAIT_L(0); MMA(1, 0, At, B0); MMA(1, 1, At, B1); BAR; }
    if (wr == 0) BAR;
    float* stg = (float*)smem;
    int tx = tid_;
    asm volatile("" : "+v"(tx));
    const int ewr = tx >> 8, ewc = (tx >> 6) & 3, efr = tx & 15, efq = (tx >> 4) & 3;
#define EPI_HALF(ai) do { \
    __syncthreads(); \
    _Pragma("unroll") for (int bj = 0; bj < 2; ++bj) _Pragma("unroll") for (int m = 0; m < 4; ++m) \
    _Pragma("unroll") for (int n = 0; n < 2; ++n) _Pragma("unroll") for (int j = 0; j < 4; ++j) \
      stg[(ewr * 64 + m * 16 + efq * 4 + j) * 260 + bj * HALF + ewc * 32 + n * 16 + efr] = acc[ai][bj][m][n][j]; \
    __syncthreads(); \
    for (int i = 0; i < 8; ++i) { \
      int item = i * NTHR + tx; int rl = item >> 5, qp = item & 31; \
      int cl = (qp >> 2) * 32 + (qp & 3) * 4; \
      float4 v0 = *(const float4*)(stg + rl * 260 + cl), v1 = *(const float4*)(stg + rl * 260 + cl + 16); \
      int row = brow + ai * HALF + rl; \
      float ss = epi.apply4(row, bcol + cl, v0, v1); \
      if (Epi::kSsq) { \
        ss += __shfl_xor(ss, 1); ss += __shfl_xor(ss, 2); ss += __shfl_xor(ss, 4); ss += __shfl_xor(ss, 8); ss += __shfl_xor(ss, 16); \
        if (qp == 0) epi.ssq_out(row, pn, ss); \
      } \
    } } while (0)
    EPI_HALF(0);
    EPI_HALF(1);
#undef EPI_HALF
    __syncthreads();
  }
#undef SA
#undef SB
#undef STAGE
#undef LDA
#undef LDB
#undef MMA
}

__device__ __forceinline__ float rstd_from_ssq(const float* ssq, int row) {
  float4 s = *(const float4*)(ssq + (size_t)row * 4);
  return rsqrtf((s.x + s.y + s.z + s.w) * (1.f / 1024.f) + 1e-6f);
}
__device__ __forceinline__ uint2 pack4(float4 v) { uint2 w; w.x = pack2(v.x, v.y); w.y = pack2(v.z, v.w); return w; }
__device__ __forceinline__ float silu_mul(float g, float u) { return g / (1.f + __expf(-g)) * u; }
struct EpiGU {
  static constexpr bool kSsq = false;
  const float* ssq; u16* act;
  __device__ __forceinline__ float apply4(int row, int c0, float4 g, float4 u) const {
    float rs = rstd_from_ssq(ssq, row);
    float4 o = make_float4(silu_mul(g.x * rs, u.x * rs), silu_mul(g.y * rs, u.y * rs), silu_mul(g.z * rs, u.z * rs), silu_mul(g.w * rs, u.w * rs));
    *(uint2*)(act + (size_t)row * DFF + ((c0 & ~31) >> 1) + (c0 & 15)) = pack4(o);
    return 0.f;
  }
  __device__ __forceinline__ void ssq_out(int, int, float) const {}
};
struct EpiRes {
  static constexpr bool kSsq = true;
  float* x; u16* xb; float* ssq; float coef;
  __device__ __forceinline__ float apply4(int row, int c0, float4 v0, float4 v1) const {
    size_t i = (size_t)row * 1024 + c0;
    float4 a = *(const float4*)(x + i), b = *(const float4*)(x + i + 16);
    a.x += coef * v0.x; a.y += coef * v0.y; a.z += coef * v0.z; a.w += coef * v0.w;
    b.x += coef * v1.x; b.y += coef * v1.y; b.z += coef * v1.z; b.w += coef * v1.w;
    *(float4*)(x + i) = a; *(float4*)(x + i + 16) = b;
    *(uint2*)(xb + i) = pack4(a); *(uint2*)(xb + i + 16) = pack4(b);
    return a.x * a.x + a.y * a.y + a.z * a.z + a.w * a.w + b.x * b.x + b.y * b.y + b.z * b.z + b.w * b.w;
  }
  __device__ __forceinline__ void ssq_out(int row, int pn, float v) const { ssq[(size_t)row * 4 + pn] = v; }
};
struct EpiScaleBf {
  static constexpr bool kSsq = false;
  const float* ssq; u16* o; int ld;
  __device__ __forceinline__ float apply4(int row, int c0, float4 v0, float4 v1) const {
    float rs = rstd_from_ssq(ssq, row);
    size_t i = (size_t)row * ld + c0;
    *(uint2*)(o + i) = pack4(make_float4(v0.x * rs, v0.y * rs, v0.z * rs, v0.w * rs));
    *(uint2*)(o + i + 16) = pack4(make_float4(v1.x * rs, v1.y * rs, v1.z * rs, v1.w * rs));
    return 0.f;
  }
  __device__ __forceinline__ void ssq_out(int, int, float) const {}
};
struct EpiQ {
  static constexpr bool kSsq = false;
  u16* qb; const float2* rope;
  __device__ __forceinline__ float apply4(int row, int c0, float4 v0, float4 v1) const {
    if (c0 < 1024) {
      size_t i = (size_t)row * 1280 + (c0 >> 7) * 160 + (c0 & 127);
      *(uint2*)(qb + i) = pack4(v0); *(uint2*)(qb + i + 16) = pack4(v1);
    } else {
      int h = (c0 - 1024) >> 5, f0 = c0 & 15;
      int pos = row < TP ? (row & 4095) : (2048 + ((row - TP) & 63));
      const float2* cs = rope + pos * 16 + f0;
      float2 c_0 = cs[0], c_1 = cs[1], c_2 = cs[2], c_3 = cs[3];
      size_t i = (size_t)row * 1280 + h * 160 + 128 + f0;
      *(uint2*)(qb + i) = pack4(make_float4(v0.x * c_0.x - v1.x * c_0.y, v0.y * c_1.x - v1.y * c_1.y, v0.z * c_2.x - v1.z * c_2.y, v0.w * c_3.x - v1.w * c_3.y));
      *(uint2*)(qb + i + 16) = pack4(make_float4(v0.x * c_0.y + v1.x * c_0.x, v0.y * c_1.y + v1.y * c_1.x, v0.z * c_2.y + v1.z * c_2.x, v0.w * c_3.y + v1.w * c_3.x));
    }
    return 0.f;
  }
  __device__ __forceinline__ void ssq_out(int, int, float) const {}
};
__device__ __forceinline__ float decay_f(float z) {
  float nz = -z;
  float sp = fmaxf(nz, 0.f) + __logf(1.f + __expf(-fabsf(nz)));
  return __expf(-__expf(-sp - 0.5f));
}
struct EpiRW {
  static constexpr bool kSsq = false;
  const float* w0; const float* a0; const float* ka; float* wb; float* bb; float* kb; const float* kkb; u16* gb;
  __device__ __forceinline__ void acol(size_t i, int c, float4 v) const {
    float4 a_0 = *(const float4*)(a0 + c), k_a = *(const float4*)(ka + c), kk = *(const float4*)(kkb + i), k = *(const float4*)(kb + i);
    float4 a = make_float4(sigmoidf_(a_0.x + v.x), sigmoidf_(a_0.y + v.y), sigmoidf_(a_0.z + v.z), sigmoidf_(a_0.w + v.w));
    *(float4*)(bb + i) = make_float4(kk.x * a.x, kk.y * a.y, kk.z * a.z, kk.w * a.w);
    *(float4*)(kb + i) = make_float4(k.x * (1.f + (a.x - 1.f) * k_a.x), k.y * (1.f + (a.y - 1.f) * k_a.y), k.z * (1.f + (a.z - 1.f) * k_a.z), k.w * (1.f + (a.w - 1.f) * k_a.w));
  }
  __device__ __forceinline__ float apply4(int row, int c0, float4 v0, float4 v1) const {
    if (c0 < 512) {
      float4 z0 = *(const float4*)(w0 + c0), z1 = *(const float4*)(w0 + c0 + 16);
      size_t i = (size_t)row * 512 + c0;
      *(float4*)(wb + i) = make_float4(decay_f(z0.x + v0.x), decay_f(z0.y + v0.y), decay_f(z0.z + v0.z), decay_f(z0.w + v0.w));
      *(float4*)(wb + i + 16) = make_float4(decay_f(z1.x + v1.x), decay_f(z1.y + v1.y), decay_f(z1.z + v1.z), decay_f(z1.w + v1.w));
    } else if (c0 < 1024) {
      int c = c0 - 512; size_t i = (size_t)row * 512 + c;
      acol(i, c, v0); acol(i + 16, c + 16, v1);
    } else {
      size_t i = (size_t)row * 512 + (c0 - 1024);
      *(uint2*)(gb + i) = pack4(v0); *(uint2*)(gb + i + 16) = pack4(v1);
    }
    return 0.f;
  }
  __device__ __forceinline__ void ssq_out(int, int, float) const {}
};
template <bool ISV>
struct EpiMem {
  static constexpr bool kSsq = false;
  float* of; u16* ob;
  __device__ __forceinline__ void quad(int row, int col, float4 v) const {
    *(float4*)(of + (size_t)row * 1024 + col) = v;
    int b = row >> 8, m = row & 255, h = col >> 8, d = col & 255;
    if (ISV) {
      u16* o = ob + (size_t)((b * 4 + h) * 256 + d) * 256 + m;
      o[0] = f2bf(v.x); o[256] = f2bf(v.y); o[512] = f2bf(v.z); o[768] = f2bf(v.w);
    } else {
      *(uint2*)(ob + (size_t)((b * 4 + h) * 256 + m) * 256 + d) = pack4(v);
    }
  }
  __device__ __forceinline__ float apply4(int row, int c0, float4 v0, float4 v1) const {
    quad(row, c0, v0); quad(row, c0 + 16, v1);
    return 0.f;
  }
  __device__ __forceinline__ void ssq_out(int, int, float) const {}
};

template <class F>
__device__ __forceinline__ void tconv(u16* dst, int ldd, int N, int K, int rot, F f) {
  extern __shared__ __attribute__((aligned(16))) char smem[];
  float* t = (float*)smem;
  const int nk = K / 64, nt = (N / 64) * nk, G = gridDim.x;
  const int tid = tidx(), a = tid >> 6, c = tid & 63;
  for (int tile = (int)((blockIdx.x + G - (rot % G)) % G); tile < nt; tile += G) {
    int n0 = (tile / nk) * 64, k0 = (tile % nk) * 64;
    __syncthreads();
#pragma unroll
    for (int i = 0; i < 8; ++i) { int kk = a + 8 * i; t[kk * 65 + c] = f(k0 + kk, n0 + c); }
    __syncthreads();
#pragma unroll
    for (int i = 0; i < 8; ++i) { int nn = a + 8 * i; dst[(size_t)(n0 + nn) * ldd + k0 + c] = f2bf(t[c * 65 + nn]); }
  }
}

template <int DK, int DV, int RPG>
__device__ __forceinline__ void attn_item(const u16* __restrict__ Qb, int ldq, int nrows, const u16* __restrict__ Kb, int ldk,
                                          const u16* __restrict__ Vtb, int ldvt, int nkeys, u16* __restrict__ Ob, int ldo) {
  extern __shared__ __attribute__((aligned(16))) char smem[];
  constexpr int KS = DK + 8, VS = 68;
  u16* sK = (u16*)smem;
  u16* sV = sK + 64 * KS;
  const int tid = tidx(), wid = tid >> 6, lane = tid & 63, q = lane & 31, hh = lane >> 5;
  const int row = wid * 32 + q;
  const bool active = (wid * 32) < nrows;
  bf16x8 qf[DK / 16];
  if (active) {
#pragma unroll
    for (int ks = 0; ks < DK / 16; ++ks) qf[ks] = *(const bf16x8*)(Qb + (size_t)row * ldq + ks * 16 + hh * 8);
  }
  f32x16 o[DV / 32];
#pragma unroll
  for (int dt = 0; dt < DV / 32; ++dt)
#pragma unroll
    for (int i = 0; i < 16; ++i) o[dt][i] = 0.f;
  float mrun = -1e30f, lrun = 0.f;
  const int nkt = nkeys >> 6;
  for (int kt = 0; kt < nkt; ++kt) {
    __syncthreads();
    for (int c = tid; c < 64 * (DK / 8); c += NTHR) {
      int r = c / (DK / 8), cc = c % (DK / 8);
      uint4 v = *(const uint4*)(Kb + (size_t)(kt * 64 + r) * ldk + cc * 8);
      *(uint4*)(sK + r * KS + cc * 8) = v;
    }
    for (int c = tid; c < DV * 8; c += NTHR) {
      int r = c >> 3, cc = c & 7;
      uint4 v = *(const uint4*)(Vtb + (size_t)r * ldvt + kt * 64 + cc * 8);
      uint2* d = (uint2*)(sV + r * VS + cc * 8);
      d[0] = make_uint2(v.x, v.y); d[1] = make_uint2(v.z, v.w);
    }
    __syncthreads();
    if (active) {
      f32x16 s0, s1;
#pragma unroll
      for (int i = 0; i < 16; ++i) { s0[i] = 0.f; s1[i] = 0.f; }
#pragma unroll
      for (int ks = 0; ks < DK / 16; ++ks) {
        bf16x8 a0 = *(const bf16x8*)(sK + q * KS + ks * 16 + hh * 8);
        bf16x8 a1 = *(const bf16x8*)(sK + (32 + q) * KS + ks * 16 + hh * 8);
        s0 = __builtin_amdgcn_mfma_f32_32x32x16_bf16(a0, qf[ks], s0, 0, 0, 0);
        s1 = __builtin_amdgcn_mfma_f32_32x32x16_bf16(a1, qf[ks], s1, 0, 0, 0);
      }
      float mx = s0[0];
#pragma unroll
      for (int i = 1; i < 16; ++i) mx = fmaxf(mx, s0[i]);
#pragma unroll
      for (int i = 0; i < 16; ++i) mx = fmaxf(mx, s1[i]);
      mx = fmaxf(mx, __shfl_xor(mx, 32));
      float mn = fmaxf(mrun, mx);
      float alpha = __builtin_amdgcn_exp2f(mrun - mn);
      mrun = mn;
      float ps = 0.f;
#pragma unroll
      for (int i = 0; i < 16; ++i) { s0[i] = __builtin_amdgcn_exp2f(s0[i] - mn); ps += s0[i]; }
#pragma unroll
      for (int i = 0; i < 16; ++i) { s1[i] = __builtin_amdgcn_exp2f(s1[i] - mn); ps += s1[i]; }
      lrun = lrun * alpha + ps;
#pragma unroll
      for (int dt = 0; dt < DV / 32; ++dt)
#pragma unroll
        for (int i = 0; i < 16; ++i) o[dt][i] *= alpha;
#pragma unroll
      for (int kb = 0; kb < 2; ++kb)
#pragma unroll
        for (int s = 0; s < 2; ++s) {
          union { bf16x8 v; unsigned u[4]; } pf;
#pragma unroll
          for (int jj = 0; jj < 4; ++jj) {
            float e0 = kb ? s1[8 * s + 2 * jj] : s0[8 * s + 2 * jj];
            float e1 = kb ? s1[8 * s + 2 * jj + 1] : s0[8 * s + 2 * jj + 1];
            pf.u[jj] = pack2(e0, e1);
          }
          const int kbase = kb * 32 + s * 16 + 4 * hh;
#pragma unroll
          for (int dt = 0; dt < DV / 32; ++dt) {
            const u16* vp = sV + (dt * 32 + q) * VS + kbase;
            union { bf16x8 v; uint2 u[2]; } vf;
            vf.u[0] = *(const uint2*)vp; vf.u[1] = *(const uint2*)(vp + 8);
            o[dt] = __builtin_amdgcn_mfma_f32_32x32x16_bf16(vf.v, pf.v, o[dt], 0, 0, 0);
          }
        }
    }
  }
  if (active) {
    lrun += __shfl_xor(lrun, 32);
    float inv = 1.f / lrun;
    u16* op = Ob + (size_t)(row / RPG) * ldo + (size_t)(row % RPG) * DV;
#pragma unroll
    for (int dt = 0; dt < DV / 32; ++dt)
#pragma unroll
      for (int g = 0; g < 4; ++g) {
        uint2 w;
        w.x = pack2(o[dt][4 * g] * inv, o[dt][4 * g + 1] * inv);
        w.y = pack2(o[dt][4 * g + 2] * inv, o[dt][4 * g + 3] * inv);
        *(uint2*)(op + dt * 32 + 8 * g + 4 * hh) = w;
      }
  }
}

__device__ __forceinline__ void scan_item(const Params& p, int l, int g0, int h, int nsteps, const float* S0, float* Sout) {
  extern __shared__ __attribute__((aligned(16))) char smem[];
  float* sR = (float*)smem;
  float* sW = sR + 4096;
  float* sK = sW + 4096;
  float* sKK = sK + 4096;
  float* sB = sKK + 4096;
  float* sV = sB + 4096;
  float* sY = sV + 4096;
  const float* RB = (const float*)(p.ws + W_RB) + h * 64;
  const float* WB = (const float*)(p.ws + W_WB) + h * 64;
  const float* KB = (const float*)(p.ws + W_KB) + h * 64;
  const float* KKB = (const float*)(p.ws + W_KKB) + h * 64;
  const float* BB = (const float*)(p.ws + W_BB) + h * 64;
  const float* VB = (const float*)(p.ws + W_VB) + h * 64;
  const u16* GB = (const u16*)(p.ws + W_GB) + h * 64;
  u16* AO = (u16*)(p.ws + W_AO) + 1024 + h * 64;
  const float* rk = p.in[I_RK] + (l * 8 + h) * 64;
  const float* gng = p.in[I_GNG] + l * 512 + h * 64;
  const float* gnb = p.in[I_GNB] + l * 512 + h * 64;
  const int tid = tidx(), wid = tid >> 6, lane = tid & 63;
  const int i = tid >> 3, sub = tid & 7, j0 = sub * 8;
  float s[8];
#pragma unroll
  for (int j = 0; j < 8; ++j) s[j] = S0 ? S0[i * 64 + j0 + j] : 0.f;
  for (int c0 = 0; c0 < nsteps; c0 += 64) {
    __syncthreads();
    for (int e = tid; e < 1024; e += NTHR) {
      int st = e >> 4, c4 = (e & 15) * 4;
      size_t gi = (size_t)(g0 + c0 + st) * 512 + c4;
      *(float4*)(sR + st * 64 + c4) = *(const float4*)(RB + gi);
      *(float4*)(sW + st * 64 + c4) = *(const float4*)(WB + gi);
      *(float4*)(sK + st * 64 + c4) = *(const float4*)(KB + gi);
      *(float4*)(sKK + st * 64 + c4) = *(const float4*)(KKB + gi);
      *(float4*)(sB + st * 64 + c4) = *(const float4*)(BB + gi);
      *(float4*)(sV + st * 64 + c4) = *(const float4*)(VB + gi);
    }
    __syncthreads();
#pragma unroll 2
    for (int st = 0; st < 64; ++st) {
      float4 k0 = *(const float4*)(sKK + st * 64 + j0), k1 = *(const float4*)(sKK + st * 64 + j0 + 4);
      float4 w0 = *(const float4*)(sW + st * 64 + j0), w1 = *(const float4*)(sW + st * 64 + j0 + 4);
      float4 b0 = *(const float4*)(sB + st * 64 + j0), b1 = *(const float4*)(sB + st * 64 + j0 + 4);
      float4 x0 = *(const float4*)(sK + st * 64 + j0), x1 = *(const float4*)(sK + st * 64 + j0 + 4);
      float4 r0 = *(const float4*)(sR + st * 64 + j0), r1 = *(const float4*)(sR + st * 64 + j0 + 4);
      float vi = sV[st * 64 + i];
      float kk[8] = {k0.x, k0.y, k0.z, k0.w, k1.x, k1.y, k1.z, k1.w};
      float ww[8] = {w0.x, w0.y, w0.z, w0.w, w1.x, w1.y, w1.z, w1.w};
      float bv[8] = {b0.x, b0.y, b0.z, b0.w, b1.x, b1.y, b1.z, b1.w};
      float kx[8] = {x0.x, x0.y, x0.z, x0.w, x1.x, x1.y, x1.z, x1.w};
      float rr[8] = {r0.x, r0.y, r0.z, r0.w, r1.x, r1.y, r1.z, r1.w};
      float d0 = 0.f, d1 = 0.f;
#pragma unroll
      for (int j = 0; j < 8; j += 2) { d0 += s[j] * kk[j]; d1 += s[j + 1] * kk[j + 1]; }
      float sa = -dpp_sum8(d0 + d1);
      float y0 = 0.f, y1 = 0.f;
#pragma unroll
      for (int j = 0; j < 8; j += 2) {
        s[j] = s[j] * ww[j] + sa * bv[j] + vi * kx[j];
        s[j + 1] = s[j + 1] * ww[j + 1] + sa * bv[j + 1] + vi * kx[j + 1];
        y0 += s[j] * rr[j]; y1 += s[j + 1] * rr[j + 1];
      }
      float y = dpp_sum8(y0 + y1);
      if (sub == 0) sY[st * 64 + i] = y;
    }
    __syncthreads();
    for (int st = wid * 8; st < wid * 8 + 8; ++st) {
      float y = sY[st * 64 + lane];
      float mu = wave_sum(y) * (1.f / 64.f);
      float dlt = y - mu;
      float var = wave_sum(dlt * dlt) * (1.f / 64.f);
      float bon = wave_sum(sR[st * 64 + lane] * sK[st * 64 + lane] * rk[lane]);
      float v = dlt * rsqrtf(var + 64e-5f) * gng[lane] + gnb[lane] + bon * sV[st * 64 + lane];
      size_t tok = (size_t)(g0 + c0 + st);
      float g = bf2f(GB[tok * 512 + lane]);
      AO[tok * 1536 + lane] = f2bf(v * g);
    }
  }
  __syncthreads();
#pragma unroll
  for (int j = 0; j < 8; ++j) Sout[i * 64 + j0 + j] = s[j];
}

__device__ __forceinline__ void phase_init(const Params& p) {
  const int G = gridDim.x, tid = tidx(), wid = tid >> 6, lane = tid & 63;
  const int gw = blockIdx.x * 8 + wid, nw = G * 8;
  if (blockIdx.x == 0 && tid < 64) ((int*)(p.ws + W_CNT))[tid] = 0;
  {
    float* X = (float*)(p.ws + W_X); u16* XB = (u16*)(p.ws + W_XB); float* SSQ = (float*)(p.ws + W_SSQ);
    for (int g = gw; g < T; g += nw) {
      const float* src = g < TP ? p.in[I_XP] + (size_t)g * 1024 : p.in[I_XS] + (size_t)(g - TP) * 1024;
      float ss = 0.f;
#pragma unroll
      for (int i = 0; i < 4; ++i) {
        float4 v = *(const float4*)(src + i * 256 + lane * 4);
        *(float4*)(X + (size_t)g * 1024 + i * 256 + lane * 4) = v;
        uint2 w; w.x = pack2(v.x, v.y); w.y = pack2(v.z, v.w);
        *(uint2*)(XB + (size_t)g * 1024 + i * 256 + lane * 4) = w;
        ss += v.x * v.x + v.y * v.y + v.z * v.z + v.w * v.w;
      }
      ss = wave_sum(ss);
      if (lane == 0) *(float4*)(SSQ + (size_t)g * 4) = make_float4(ss, 0.f, 0.f, 0.f);
    }
  }
  {
    u16* MB = (u16*)(p.ws + W_MB);
    for (int g = gw; g < 1024; g += nw) {
      const float* src = p.in[I_MEMP] + (size_t)g * 1024;
      float4 v[4]; float ss = 0.f;
#pragma unroll
      for (int i = 0; i < 4; ++i) { v[i] = *(const float4*)(src + i * 256 + lane * 4); ss += v[i].x * v[i].x + v[i].y * v[i].y + v[i].z * v[i].z + v[i].w * v[i].w; }
      ss = wave_sum(ss);
      float rs = rsqrtf(ss * (1.f / 1024.f) + 1e-6f);
#pragma unroll
      for (int i = 0; i < 4; ++i) {
        uint2 w; w.x = pack2(v[i].x * rs, v[i].y * rs); w.y = pack2(v[i].z * rs, v[i].w * rs);
        *(uint2*)(MB + (size_t)g * 1024 + i * 256 + lane * 4) = w;
      }
    }
  }
  {
    float2* RT = (float2*)(p.ws + W_ROPE);
    for (int e = blockIdx.x * NTHR + tid; e < 4096 * 16; e += G * NTHR) {
      int pos = e >> 4, i = e & 15;
      float inv = powf(10000.f, -(float)i / 16.f);
      float ang = (float)pos * inv;
      float sn, cs; sincosf(ang, &sn, &cs);
      RT[e] = make_float2(cs, sn);
    }
  }
  int rot = 0;
  for (int l = 0; l < NL; ++l) {
    u16* WT = (u16*)(p.ws + W_WT) + (size_t)l * WE_LAYER;
    for (int f = 0; f < 2; ++f) {
      const float* nrm = p.in[f ? I_F2N : I_F1N] + l * 1024;
      const float* wg = p.in[f ? I_F2G : I_F1G] + (size_t)l * 1024 * DFF;
      const float* wu = p.in[f ? I_F2U : I_F1U] + (size_t)l * 1024 * DFF;
      const float* wd = p.in[f ? I_F2D : I_F1D] + (size_t)l * 1024 * DFF;
      tconv(WT + (f ? WE_GU2 : WE_GU1), 1024, 5632, 1024, rot, [=](int k, int n) {
        int j = (n >> 5) * 16 + (n & 15);
        const float* s = ((n >> 4) & 1) ? wu : wg;
        return nrm[k] * s[(size_t)k * DFF + j];
      });
      rot += 88 * 16;
      tconv(WT + (f ? WE_D2 : WE_D1), DFF, 1024, DFF, rot, [=](int k, int n) { return wd[(size_t)k * 1024 + n]; });
      rot += 16 * 44;
    }
    {
      const float* nrm = p.in[I_MIXN] + l * 1024; const float* w = p.in[I_WIN] + (size_t)l * 1024 * DIN;
      tconv(WT + WE_IN, 1024, DINP, 1024, rot, [=](int k, int n) { return n < DIN ? nrm[k] * w[(size_t)k * DIN + n] : 0.f; });
      rot += 36 * 16;
    }
    {
      const float* nrm = p.in[I_QN] + l * 256; const float* wuq = p.in[I_WUQ] + (size_t)l * 256 * 768;
      const float* wuk = p.in[I_WUK] + (size_t)l * 8 * 128 * 64;
      tconv(WT + WE_Q, 256, 1280, 256, rot, [=](int k, int n) {
        float r;
        if (n < 1024) {
          int h = n >> 7, c = n & 127;
          const float* a = wuq + (size_t)k * 768 + h * 96; const float* b = wuk + (size_t)(h * 128 + c) * 64;
          r = 0.f;
          for (int d = 0; d < 64; ++d) r += a[d] * b[d];
        } else {
          int hr = n - 1024;
          r = wuq[(size_t)k * 768 + (hr >> 5) * 96 + 64 + (hr & 31)];
        }
        return r * nrm[k] * QSCALE;
      });
      rot += 20 * 4;
    }
    {
      const float* wup = p.in[I_WUP] + (size_t)l * 64 * 512; const float* aup = p.in[I_AUP] + (size_t)l * 64 * 512;
      const float* gup = p.in[I_GUP] + (size_t)l * 128 * 512;
      tconv(WT + WE_RW, 256, 1536, 256, rot, [=](int k, int n) {
        if (n < 512) return k < 64 ? wup[k * 512 + n] : 0.f;
        if (n < 1024) return (k >= 64 && k < 128) ? aup[(k - 64) * 512 + n - 512] : 0.f;
        return k >= 128 ? gup[(k - 128) * 512 + n - 1024] : 0.f;
      });
      rot += 24 * 4;
    }
    {
      const float* wuv = p.in[I_WUV] + (size_t)l * 8 * 128 * 64; const float* wo = p.in[I_WOUT] + (size_t)l * 1024 * 1024;
      tconv(WT + WE_OUT, 1536, 1024, 1536, rot, [=](int k, int n) {
        if (k < 1024) {
          int h = k >> 7, c = k & 127;
          const float* a = wuv + (size_t)(h * 128 + c) * 64; const float* b = wo + (size_t)(h * 64) * 1024 + n;
          float r = 0.f;
          for (int v = 0; v < 64; ++v) r += a[v] * b[(size_t)v * 1024];
          return r;
        }
        return wo[(size_t)(512 + k - 1024) * 1024 + n];
      });
      rot += 16 * 24;
    }
    {
      const float* nx = p.in[I_XN] + l * 1024; const float* nm = p.in[I_MKVN] + l * 1024;
      const float* wq = p.in[I_WMQ] + (size_t)l * 1048576; const float* wk = p.in[I_WMK] + (size_t)l * 1048576;
      const float* wv = p.in[I_WMV] + (size_t)l * 1048576; const float* wo = p.in[I_WMO] + (size_t)l * 1048576;
      tconv(WT + WE_MQ, 1024, 1024, 1024, rot, [=](int k, int n) { return nx[k] * wq[(size_t)k * 1024 + n] * XSCALE; });
      tconv(WT + WE_MK, 1024, 1024, 1024, rot, [=](int k, int n) { return nm[k] * wk[(size_t)k * 1024 + n]; });
      tconv(WT + WE_MV, 1024, 1024, 1024, rot, [=](int k, int n) { return nm[k] * wv[(size_t)k * 1024 + n]; });
      tconv(WT + WE_MO, 1024, 1024, 1024, rot, [=](int k, int n) { return wo[(size_t)k * 1024 + n]; });
    }
  }
}

__device__ __forceinline__ void phase_prep(const Params& p, int l) {
  const int G = gridDim.x, tid = tidx(), wid = tid >> 6, lane = tid & 63;
  const int gw = blockIdx.x * 8 + wid, nw = G * 8;
  const u16* PROJ = (const u16*)(p.ws + W_PROJ);
  u16* CQB = (u16*)(p.ws + W_CQB); u16* A2 = (u16*)(p.ws + W_A2);
  float* RB = (float*)(p.ws + W_RB); float* KB = (float*)(p.ws + W_KB); float* VB = (float*)(p.ws + W_VB); float* KKB = (float*)(p.ws + W_KKB);
  u16* KP = (u16*)(p.ws + W_KP); u16* KS = (u16*)(p.ws + W_KS); u16* VTP = (u16*)(p.ws + W_VTP); u16* VTS = (u16*)(p.ws + W_VTS);
  const float2* RT = (const float2*)(p.ws + W_ROPE);
  const float* kvn = p.in[I_KVN] + l * 128; const float* mu = p.in[I_MU] + l * DSH; const float* kkw = p.in[I_KK] + l * 512;
  for (int g = gw; g < T; g += nw) {
    const u16* pr = PROJ + (size_t)g * DINP;
    const bool isP = g < TP;
    int b, t, pos, tlen;
    if (isP) { b = g >> 12; t = g & 4095; pos = t; tlen = 4096; } else { int gg = g - TP; b = gg >> 6; t = gg & 63; pos = 2048 + t; tlen = 64; }
    {
      uint2 w = *(const uint2*)(pr + lane * 4);
      float v0 = bf2f(w.x & 0xffff), v1 = bf2f(w.x >> 16), v2 = bf2f(w.y & 0xffff), v3 = bf2f(w.y >> 16);
      float ss = wave_sum(v0 * v0 + v1 * v1 + v2 * v2 + v3 * v3);
      float rs = rsqrtf(ss * (1.f / 256.f) + 1e-6f);
      uint2 o; o.x = pack2(v0 * rs, v1 * rs); o.y = pack2(v2 * rs, v3 * rs);
      *(uint2*)(CQB + (size_t)g * 256 + lane * 4) = o;
    }
    {
      unsigned w = *(const unsigned*)(pr + 256 + lane * 2);
      float v0 = bf2f(w & 0xffff), v1 = bf2f(w >> 16);
      float ss = wave_sum(v0 * v0 + v1 * v1);
      float rs = rsqrtf(ss * (1.f / 128.f) + 1e-6f);
      int c = lane * 2;
      v0 = v0 * rs * kvn[c]; v1 = v1 * rs * kvn[c + 1];
      float* of = isP ? p.out + OO_CKVP + ((size_t)(l * 4 + b) * 4096 + t) * 128 : p.out + OO_CKVS + ((size_t)(l * 32 + b) * 64 + t) * 128;
      *(float2*)(of + c) = make_float2(v0, v1);
      u16* kr = isP ? KP + ((size_t)b * 4096 + t) * 160 : KS + ((size_t)b * 2112 + 2048 + t) * 160;
      *(unsigned*)(kr + c) = pack2(v0, v1);
      if (isP) { VTP[((size_t)b * 128 + c) * 4096 + t] = f2bf(v0); VTP[((size_t)b * 128 + c + 1) * 4096 + t] = f2bf(v1); }
      else { VTS[((size_t)b * 128 + c) * 2112 + 2048 + t] = f2bf(v0); VTS[((size_t)b * 128 + c + 1) * 2112 + 2048 + t] = f2bf(v1); }
      if (lane < 16) {
        float x1 = bf2f(pr[384 + lane]), x2 = bf2f(pr[400 + lane]);
        float2 cs = RT[pos * 16 + lane];
        float o1 = x1 * cs.x - x2 * cs.y, o2 = x1 * cs.y + x2 * cs.x;
        float* okr = isP ? p.out + OO_KRP + ((size_t)(l * 4 + b) * 4096 + t) * 32 : p.out + OO_KRS + ((size_t)(l * 32 + b) * 64 + t) * 32;
        okr[lane] = o1; okr[lane + 16] = o2;
        kr[128 + lane] = f2bf(o1); kr[144 + lane] = f2bf(o2);
      }
    }
    {
      const u16* pb = pr + 416;
      const u16* pp = pr - DINP + 416;
      const float* sh0 = p.in[I_SSH] + (size_t)(l * 32 + b) * DSH;
      const bool last = (t == tlen - 1);
      float* osh = isP ? p.out + OO_SHP + (size_t)(l * 4 + b) * DSH : p.out + OO_SHS + (size_t)(l * 32 + b) * DSH;
#pragma unroll 4
      for (int it = 0; it < 28; ++it) {
        int e = it * 64 + lane;
        float pv = bf2f(pb[e]);
        float prev = t > 0 ? bf2f(pp[e]) : (isP ? 0.f : sh0[e]);
        float xs = pv + mu[e] * (prev - pv);
        if (last) osh[e] = pv;
        if (it < 8) RB[(size_t)g * 512 + e] = xs;
        else if (it < 16) {
          int c = e - 512;
          KB[(size_t)g * 512 + c] = xs;
          float kk = xs * kkw[c];
          float ss = wave_sum(kk * kk);
          KKB[(size_t)g * 512 + c] = kk * rsqrtf(ss + 1e-12f);
        } else if (it < 24) VB[(size_t)g * 512 + e - 1024] = xs;
        else if (it == 24) A2[(size_t)g * 256 + lane] = f2bf(tanhf(xs));
        else if (it == 25) A2[(size_t)g * 256 + 64 + lane] = f2bf(xs);
        else A2[(size_t)g * 256 + 128 + (e - 1664)] = f2bf(sigmoidf_(xs));
      }
    }
  }
  {
    const float* cckv = p.in[I_CCKV] + (size_t)l * 32 * 2048 * 128;
    const float* ckr = p.in[I_CKR] + (size_t)l * 32 * 2048 * 32;
    for (int idx = blockIdx.x * NTHR + tid; idx < 32 * 2048 * 20; idx += G * NTHR) {
      int rowi = idx / 20, ch = idx % 20;
      int b = rowi >> 11, t = rowi & 2047;
      const float* s = ch < 16 ? cckv + (size_t)rowi * 128 + ch * 8 : ckr + (size_t)rowi * 32 + (ch - 16) * 8;
      float4 a = *(const float4*)s, c = *(const float4*)(s + 4);
      uint4 o; o.x = pack2(a.x, a.y); o.y = pack2(a.z, a.w); o.z = pack2(c.x, c.y); o.w = pack2(c.z, c.w);
      *(uint4*)(KS + ((size_t)b * 2112 + t) * 160 + ch * 8) = o;
    }
    tconv(VTS, 2112, 4096, 2048, 0, [=](int k, int n) { return cckv[((size_t)(n >> 7) * 2048 + k) * 128 + (n & 127)]; });
    const float* cmk = p.in[I_CMK] + (size_t)l * 32 * 256 * 1024;
    const float* cmv = p.in[I_CMV] + (size_t)l * 32 * 256 * 1024;
    u16* MKS = (u16*)(p.ws + W_MKS); u16* MVTS = (u16*)(p.ws + W_MVTS);
    for (int idx = blockIdx.x * NTHR + tid; idx < 32 * 4 * 256 * 32; idx += G * NTHR) {
      int d8 = idx & 31, m = (idx >> 5) & 255, h = (idx >> 13) & 3, b = idx >> 15;
      const float* s = cmk + ((size_t)(b * 256 + m) * 4 + h) * 256 + d8 * 8;
      float4 a = *(const float4*)s, c = *(const float4*)(s + 4);
      uint4 o; o.x = pack2(a.x, a.y); o.y = pack2(a.z, a.w); o.z = pack2(c.x, c.y); o.w = pack2(c.z, c.w);
      *(uint4*)(MKS + (size_t)idx * 8) = o;
    }
    tconv(MVTS, 256, 32768, 256, 0, [=](int k, int n) { return cmv[((size_t)((n >> 10) * 256 + k) * 4 + ((n >> 8) & 3)) * 256 + (n & 255)]; });
  }
}

__device__ __forceinline__ void mla_sub(const Params& p, int b, int c, int half) {
  const u16* QB = (const u16*)(p.ws + W_QB); u16* AO = (u16*)(p.ws + W_AO);
  size_t tok = (size_t)b * 4096 + c * 64 + half * 32;
  attn_item<160, 128, 8>(QB + tok * 1280, 160, 256, (const u16*)(p.ws + W_KP) + (size_t)b * 4096 * 160, 160,
                         (const u16*)(p.ws + W_VTP) + (size_t)b * 128 * 4096, 4096, (c + 1) * 64, AO + tok * 1536, 1536);
}
__device__ __forceinline__ void phase_mix(const Params& p, int l) {
  extern __shared__ __attribute__((aligned(16))) char smem[];
  int* sItem = (int*)(smem + 131072);
  int* cnt = (int*)(p.ws + W_CNT) + l;
  for (;;) {
    __syncthreads();
    if (threadIdx.x == 0) *sItem = atomicAdd(cnt, 1);
    __syncthreads();
    int it = *sItem;
    if (it >= 608) break;
    if (it < 32) {
      int b = it >> 3, h = it & 7;
      scan_item(p, l, b * 4096, h, 4096, nullptr, p.out + OO_WKVP + ((size_t)(l * 4 + b) * 8 + h) * 4096);
    } else if (it < 288) {
      int k = it - 32; int b = k >> 6, pr = (k >> 1) & 31, half = k & 1;
      mla_sub(p, b, 63 - pr, half);
      mla_sub(p, b, pr, half);
    } else if (it < 352) {
      int k = it - 288; int b = k >> 1, half = k & 1;
      const u16* QB = (const u16*)(p.ws + W_QB); u16* AO = (u16*)(p.ws + W_AO);
      size_t tok = (size_t)TP + b * 64 + half * 32;
      attn_item<160, 128, 8>(QB + tok * 1280, 160, 256, (const u16*)(p.ws + W_KS) + (size_t)b * 2112 * 160, 160,
                             (const u16*)(p.ws + W_VTS) + (size_t)b * 128 * 2112, 2112, 2112, AO + tok * 1536, 1536);
    } else {
      int k = it - 352; int b = k >> 3, h = k & 7;
      scan_item(p, l, TP + b * 64, h, 64, p.in[I_SWKV] + ((size_t)(l * 32 + b) * 8 + h) * 4096,
                p.out + OO_WKVS + ((size_t)(l * 32 + b) * 8 + h) * 4096);
    }
  }
}

__device__ __forceinline__ void phase_xattn(const Params& p, int l) {
  const u16* QX = (const u16*)(p.ws + W_QX); u16* XO = (u16*)(p.ws + W_XO);
  for (int it = blockIdx.x; it < 384; it += gridDim.x) {
    if (it < 256) {
      int b = it >> 6, h = (it >> 4) & 3, qt = it & 15;
      size_t tok = (size_t)b * 4096 + qt * 256;
      for (int hv = 0; hv < 2; ++hv)
        attn_item<256, 128, 1>(QX + tok * 1024 + h * 256, 1024, 256, (const u16*)(p.ws + W_MKP) + (size_t)((l * 4 + b) * 4 + h) * 65536, 256,
                               (const u16*)(p.ws + W_MVTP) + (size_t)((l * 4 + b) * 4 + h) * 65536 + hv * 128 * 256, 256, 256, XO + tok * 1024 + h * 256 + hv * 128, 1024);
    } else {
      int k = it - 256; int b = k >> 2, h = k & 3;
      size_t tok = (size_t)TP + b * 64;
      for (int hv = 0; hv < 2; ++hv)
        attn_item<256, 128, 1>(QX + tok * 1024 + h * 256, 1024, 64, (const u16*)(p.ws + W_MKS) + (size_t)(b * 4 + h) * 65536, 256,
                               (const u16*)(p.ws + W_MVTS) + (size_t)(b * 4 + h) * 65536 + hv * 128 * 256, 256, 256, XO + tok * 1024 + h * 256 + hv * 128, 1024);
    }
  }
}

__device__ __forceinline__ void phase_final(const Params& p) {
  const int tid = tidx(), wid = tid >> 6, lane = tid & 63;
  const float* X = (const float*)(p.ws + W_X); const float* fn = p.in[I_FN];
  for (int g = blockIdx.x * 8 + wid; g < T; g += gridDim.x * 8) {
    float4 v[4]; float ss = 0.f;
#pragma unroll
    for (int i = 0; i < 4; ++i) { v[i] = *(const float4*)(X + (size_t)g * 1024 + i * 256 + lane * 4); ss += v[i].x * v[i].x + v[i].y * v[i].y + v[i].z * v[i].z + v[i].w * v[i].w; }
    ss = wave_sum(ss);
    float rs = rsqrtf(ss * (1.f / 1024.f) + 1e-6f);
#pragma unroll
    for (int i = 0; i < 4; ++i) {
      float4 gn = *(const float4*)(fn + i * 256 + lane * 4);
      *(float4*)(p.out + OO_Y + (size_t)g * 1024 + i * 256 + lane * 4) = make_float4(v[i].x * rs * gn.x, v[i].y * rs * gn.y, v[i].z * rs * gn.z, v[i].w * rs * gn.w);
    }
  }
}

constexpr int N_PHASES = 2 + 12 * NL + 1;

__device__ __forceinline__ void run_phase(const Params& p, int ph) {
  float* X = (float*)(p.ws + W_X); u16* XB = (u16*)(p.ws + W_XB); float* SSQ = (float*)(p.ws + W_SSQ);
  u16* ACT = (u16*)(p.ws + W_ACT);
#ifdef ONLY_S
  if (ONLY_S == 100) { if (ph == 0) phase_init(p); return; }
  if (ONLY_S == 102) { if (ph == N_PHASES - 1) phase_final(p); return; }
  if (ONLY_S != 101 && ph < 2) return;
  if (ONLY_S == 101 && ph != 1) return;
  if (ONLY_S < 100 && (ph < 2 || ph == N_PHASES - 1 || (ph - 2) % 12 != ONLY_S)) return;
#endif
  if (ph == 0) { phase_init(p); return; }
  if (ph == 1) {
    for (int l = 0; l < NL; ++l) {
      const u16* WT = (const u16*)(p.ws + W_WT) + (size_t)l * WE_LAYER;
      gemm_phase((const u16*)(p.ws + W_MB), WT + WE_MK, 1024, 4, 4, (2 * l) * 16,
                 EpiMem<false>{p.out + OO_MKP + (size_t)l * 1048576, (u16*)(p.ws + W_MKP) + (size_t)l * 16 * 65536});
      gemm_phase((const u16*)(p.ws + W_MB), WT + WE_MV, 1024, 4, 4, (2 * l + 1) * 16,
                 EpiMem<true>{p.out + OO_MVP + (size_t)l * 1048576, (u16*)(p.ws + W_MVTP) + (size_t)l * 16 * 65536});
    }
    return;
  }
  if (ph == N_PHASES - 1) { phase_final(p); return; }
  const int l = (ph - 2) / 12, s = (ph - 2) % 12;
  const u16* WT = (const u16*)(p.ws + W_WT) + (size_t)l * WE_LAYER;
  switch (s) {
    case 0: gemm_phase(XB, WT + WE_GU1, 1024, 72, 22, 0, EpiGU{SSQ, ACT}); break;
    case 1: gemm_phase(ACT, WT + WE_D1, DFF, 72, 4, 0, EpiRes{X, XB, SSQ, 0.5f}); break;
    case 2: gemm_phase(XB, WT + WE_IN, 1024, 72, 9, 0, EpiScaleBf{SSQ, (u16*)(p.ws + W_PROJ), DINP}); break;
    case 3: phase_prep(p, l); break;
    case 4:
      gemm_phase((const u16*)(p.ws + W_CQB), WT + WE_Q, 256, 72, 5, 0, EpiQ{(u16*)(p.ws + W_QB), (const float2*)(p.ws + W_ROPE)});
      gemm_phase((const u16*)(p.ws + W_A2), WT + WE_RW, 256, 72, 6, 360,
                 EpiRW{p.in[I_W0] + l * 512, p.in[I_A0] + l * 512, p.in[I_KA] + l * 512, (float*)(p.ws + W_WB), (float*)(p.ws + W_BB),
                       (float*)(p.ws + W_KB), (const float*)(p.ws + W_KKB), (u16*)(p.ws + W_GB)});
      break;
    case 5: phase_mix(p, l); break;
    case 6: gemm_phase((const u16*)(p.ws + W_AO), WT + WE_OUT, 1536, 72, 4, 0, EpiRes{X, XB, SSQ, 1.0f}); break;
    case 7: gemm_phase(XB, WT + WE_MQ, 1024, 72, 4, 0, EpiScaleBf{SSQ, (u16*)(p.ws + W_QX), 1024}); break;
    case 8: phase_xattn(p, l); break;
    case 9: gemm_phase((const u16*)(p.ws + W_XO), WT + WE_MO, 1024, 72, 4, 0, EpiRes{X, XB, SSQ, 1.0f}); break;
    case 10: gemm_phase(XB, WT + WE_GU2, 1024, 72, 22, 0, EpiGU{SSQ, ACT}); break;
    case 11: gemm_phase(ACT, WT + WE_D2, DFF, 72, 4, 0, EpiRes{X, XB, SSQ, 0.5f}); break;
  }
}

__global__ void __launch_bounds__(NTHR) mega(Params p) {
  cg::grid_group grid = cg::this_grid();
  for (int ph = p.ph_lo; ph < p.ph_hi; ++ph) {
    run_phase(p, ph);
    if (ph + 1 < p.ph_hi) grid.sync();
  }
}

extern "C" void kernel_launch(void* const* d_in, const int* in_sizes, int n_in, void* d_out, int out_size, void* d_ws,
                              size_t ws_size, hipStream_t stream) {
  static int grid = 0;
  if (grid == 0) {
    if (n_in != N_IN || (size_t)out_size != OO_END || ws_size < W_END) {
      fprintf(stderr, "kernel_launch: unexpected shapes n_in=%d out=%d ws=%zu (need %zu)\n", n_in, out_size, ws_size, (size_t)W_END);
      grid = -1; return;
    }
    int dev = 0, cus = 0, per_cu = 0;
    hipGetDevice(&dev);
    hipDeviceGetAttribute(&cus, hipDeviceAttributeMultiprocessorCount, dev);
    hipFuncSetAttribute((const void*)mega, hipFuncAttributeMaxDynamicSharedMemorySize, SMEM_BYTES);
    hipOccupancyMaxActiveBlocksPerMultiprocessor(&per_cu, (const void*)mega, NTHR, SMEM_BYTES);
    if (per_cu < 1) { fprintf(stderr, "kernel_launch: occupancy query says %d blocks/CU\n", per_cu); per_cu = 1; }
    (void)hipGetLastError();
    grid = cus;
  }
  if (grid < 0) return;
  Params p{};
  for (int i = 0; i < N_IN; ++i) p.in[i] = (const float*)d_in[i];
  p.out = (float*)d_out; p.ws = (char*)d_ws;
#if N_LAUNCH_PER_PHASE
  for (int ph = 0; ph < N_PHASES; ++ph) {
    p.ph_lo = ph; p.ph_hi = ph + 1;
    void* args[] = {&p};
    hipError_t e = hipLaunchCooperativeKernel((const void*)mega, dim3(grid), dim3(NTHR), args, SMEM_BYTES, stream);
    if (e != hipSuccess) { fprintf(stderr, "launch failed: %s\n", hipGetErrorString(e)); break; }
  }
#else
  p.ph_lo = 0; p.ph_hi = N_PHASES;
  void* args[] = {&p};
  hipError_t e = hipLaunchCooperativeKernel((const void*)mega, dim3(grid), dim3(NTHR), args, SMEM_BYTES, stream);
  if (e != hipSuccess) fprintf(stderr, "cooperative launch failed: %s (grid %d)\n", hipGetErrorString(e), grid);
#endif
}
```

```cpp
#include <hip/hip_runtime.h>
#include <hip/hip_cooperative_groups.h>
#include <stdint.h>
#include <stdio.h>
namespace cg = cooperative_groups;

typedef unsigned short u16;
using bf16x8 = __attribute__((ext_vector_type(8))) short;
using f32x4 = __attribute__((ext_vector_type(4))) float;
using f32x16 = __attribute__((ext_vector_type(16))) float;

#ifndef REP_WHICH
#define REP_WHICH 0
#endif
#ifndef N_LAUNCH_PER_PHASE
#define N_LAUNCH_PER_PHASE 0
#endif

constexpr int TP = 16384, TS = 2048, T = TP + TS, NL = 4;
constexpr int DFF = 2816, DIN = 2208, DINP = 2304, DSH = 1792;
constexpr int NTHR = 512;
constexpr int SMEM_BYTES = 131072 + 1024;
constexpr float QSCALE = 0.10206207261596577f * 1.4426950408889634f;
constexpr float XSCALE = 0.0625f * 1.4426950408889634f;

constexpr size_t OO_Y = 0;
constexpr size_t OO_CKVP = OO_Y + (size_t)T * 1024;
constexpr size_t OO_KRP = OO_CKVP + (size_t)NL * 4 * 4096 * 128;
constexpr size_t OO_MKP = OO_KRP + (size_t)NL * 4 * 4096 * 32;
constexpr size_t OO_MVP = OO_MKP + (size_t)NL * 4 * 256 * 1024;
constexpr size_t OO_WKVP = OO_MVP + (size_t)NL * 4 * 256 * 1024;
constexpr size_t OO_SHP = OO_WKVP + (size_t)NL * 4 * 8 * 4096;
constexpr size_t OO_CKVS = OO_SHP + (size_t)NL * 4 * DSH;
constexpr size_t OO_KRS = OO_CKVS + (size_t)NL * 32 * 64 * 128;
constexpr size_t OO_WKVS = OO_KRS + (size_t)NL * 32 * 64 * 32;
constexpr size_t OO_SHS = OO_WKVS + (size_t)NL * 32 * 8 * 4096;
constexpr size_t OO_END = OO_SHS + (size_t)NL * 32 * DSH;

constexpr size_t al256(size_t x) { return (x + 255) & ~(size_t)255; }
constexpr size_t W_X = 0;
constexpr size_t W_XB = W_X + al256((size_t)T * 1024 * 4);
constexpr size_t W_SSQ = W_XB + al256((size_t)T * 1024 * 2);
constexpr size_t W_ACT = W_SSQ + al256((size_t)T * 4 * 4);
constexpr size_t W_WB = W_ACT;
constexpr size_t W_BB = W_WB + al256((size_t)T * 512 * 4);
constexpr size_t W_GB = W_BB + al256((size_t)T * 512 * 4);
constexpr size_t W_QX = W_ACT;
constexpr size_t W_PROJ = W_ACT + al256((size_t)T * DFF * 2);
constexpr size_t W_AO = W_PROJ;
constexpr size_t W_CQB = W_PROJ + al256((size_t)T * DINP * 2);
constexpr size_t W_A2 = W_CQB + al256((size_t)T * 256 * 2);
constexpr size_t W_QB = W_A2 + al256((size_t)T * 256 * 2);
constexpr size_t W_XO = W_QB;
constexpr size_t W_RB = W_QB + al256((size_t)T * 1280 * 2);
constexpr size_t W_KB = W_RB + al256((size_t)T * 512 * 4);
constexpr size_t W_VB = W_KB + al256((size_t)T * 512 * 4);
constexpr size_t W_KKB = W_VB + al256((size_t)T * 512 * 4);
constexpr size_t W_KP = W_KKB + al256((size_t)T * 512 * 4);
constexpr size_t W_KS = W_KP + al256((size_t)4 * 4096 * 160 * 2);
constexpr size_t W_VTP = W_KS + al256((size_t)32 * 2112 * 160 * 2);
constexpr size_t W_VTS = W_VTP + al256((size_t)4 * 128 * 4096 * 2);
constexpr size_t W_MKP = W_VTS + al256((size_t)32 * 128 * 2112 * 2);
constexpr size_t W_MVTP = W_MKP + al256((size_t)NL * 16 * 65536 * 2);
constexpr size_t W_MKS = W_MVTP + al256((size_t)NL * 16 * 65536 * 2);
constexpr size_t W_MVTS = W_MKS + al256((size_t)128 * 65536 * 2);
constexpr size_t W_MB = W_MVTS + al256((size_t)128 * 65536 * 2);
constexpr size_t W_ROPE = W_MB + al256((size_t)1024 * 1024 * 2);
constexpr size_t W_CNT = W_ROPE + al256((size_t)4096 * 16 * 8);
constexpr size_t W_YB = W_CNT + 256;
constexpr size_t W_WT = W_YB + al256((size_t)T * 512 * 4);
constexpr size_t WE_GU1 = 0;
constexpr size_t WE_D1 = WE_GU1 + (size_t)5632 * 1024;
constexpr size_t WE_IN = WE_D1 + (size_t)1024 * DFF;
constexpr size_t WE_Q = WE_IN + (size_t)DINP * 1024;
constexpr size_t WE_RW = WE_Q + (size_t)1280 * 256;
constexpr size_t WE_OUT = WE_RW + (size_t)1536 * 256;
constexpr size_t WE_MQ = WE_OUT + (size_t)1024 * 1536;
constexpr size_t WE_MK = WE_MQ + (size_t)1024 * 1024;
constexpr size_t WE_MV = WE_MK + (size_t)1024 * 1024;
constexpr size_t WE_MO = WE_MV + (size_t)1024 * 1024;
constexpr size_t WE_GU2 = WE_MO + (size_t)1024 * 1024;
constexpr size_t WE_D2 = WE_GU2 + (size_t)5632 * 1024;
constexpr size_t WE_LAYER = WE_D2 + (size_t)1024 * DFF;
constexpr size_t W_END = W_WT + al256(WE_LAYER * NL * 2);

enum { I_XP = 0, I_XS, I_MEMP, I_CCKV, I_CKR, I_CMK, I_CMV, I_SWKV, I_SSH, I_F1N, I_F1G, I_F1U, I_F1D, I_MIXN, I_WIN,
       I_QN, I_WUQ, I_KVN, I_WUK, I_WUV, I_MU, I_W0, I_WUP, I_A0, I_AUP, I_GUP, I_KK, I_KA, I_RK, I_GNG, I_GNB, I_WOUT,
       I_XN, I_MKVN, I_WMQ, I_WMK, I_WMV, I_WMO, I_F2N, I_F2G, I_F2U, I_F2D, I_FN, N_IN };

struct Params {
  const float* in[N_IN];
  float* out;
  char* ws;
  int ph_lo, ph_hi;
};

typedef const __attribute__((address_space(4))) Params& KPR;

__device__ __forceinline__ u16 f2bf(float f) {
  unsigned u = __float_as_uint(f);
  u += 0x7fffu + ((u >> 16) & 1u);
  return (u16)(u >> 16);
}
__device__ __forceinline__ float bf2f(u16 h) { return __uint_as_float(((unsigned)h) << 16); }
__device__ __forceinline__ unsigned pack2(float a, float b) { return (unsigned)f2bf(a) | ((unsigned)f2bf(b) << 16); }
__device__ __forceinline__ float wave_sum(float x) {
#pragma unroll
  for (int o = 32; o; o >>= 1) x += __shfl_xor(x, o);
  return x;
}
__device__ __forceinline__ float dpp_sum8(float x) {
  x += __int_as_float(__builtin_amdgcn_update_dpp(0, __float_as_int(x), 0xB1, 0xF, 0xF, false));
  x += __int_as_float(__builtin_amdgcn_update_dpp(0, __float_as_int(x), 0x4E, 0xF, 0xF, false));
  x += __int_as_float(__builtin_amdgcn_update_dpp(0, __float_as_int(x), 0x141, 0xF, 0xF, false));
  return x;
}
__device__ __forceinline__ int tidx() { int t = threadIdx.x; asm volatile("" : "+v"(t)); return t; }
__device__ __forceinline__ float fma_s(float a, float b, float c) { float d; asm("v_fma_f32 %0, %1, %2, %3" : "=v"(d) : "v"(a), "v"(b), "v"(c)); return d; }
__device__ __forceinline__ float mul_s(float a, float b) { float d; asm("v_mul_f32 %0, %1, %2" : "=v"(d) : "v"(a), "v"(b)); return d; }
__device__ __forceinline__ float sigmoidf_(float x) { return 1.f / (1.f + __expf(-x)); }

constexpr int BM = 256, BK = 64, HALF = 128, HT = HALF * BK;

__device__ __forceinline__ int lds_byte(int r, int c) {
  int st = (r >> 4) * 2 + (c >> 5), rr = r & 15, cc = c & 31, ob = rr * 64 + cc * 2;
  return st * 1024 + (ob ^ (((ob >> 9) & 1) << 5));
}
__device__ __forceinline__ void stage_rc(int b, int& R, int& C) {
  int st = b / 1024, sb = b % 1024, swz = sb ^ (((sb >> 9) & 1) << 5);
  R = (st >> 1) * 16 + swz / 64; C = (st & 1) * 32 + (swz % 64) / 2;
}

template <class Epi>
__device__ __forceinline__ void gemm_phase(const u16* __restrict__ A, const u16* __restrict__ Bt, const int K,
                                           const int nM, const int nN, const int rot, Epi epi) {
  extern __shared__ __attribute__((aligned(16))) char smem[];
  u16* shm = (u16*)smem;
#define SA(b, h) (shm + ((b) * 2 + (h)) * HT)
#define SB(b, h) (shm + (4 + (b) * 2 + (h)) * HT)
#define STAGE(P, BASE, br, kt) do { const u16* _gb = BASE + ((long)(br) * K + (long)(kt) * BK); \
    __builtin_amdgcn_global_load_lds((const unsigned*)((const char*)_gb + so0), \
        (__attribute__((address_space(3))) unsigned*)((char*)(P) + wu16), 16, 0, 0); \
    __builtin_amdgcn_global_load_lds((const unsigned*)((const char*)_gb + so1), \
        (__attribute__((address_space(3))) unsigned*)((char*)(P) + wu16 + 8192), 16, 0, 0); } while (0)
#define LDA(dst, b, h) for (int m = 0; m < 4; ++m) for (int k = 0; k < 2; ++k) \
    dst[m][k] = *reinterpret_cast<const bf16x8*>((char*)SA(b, h) + lds_byte(wr * 64 + m * 16 + fr, k * 32 + fq * 8))
#define LDB(dst, b, h) for (int n = 0; n < 2; ++n) for (int k = 0; k < 2; ++k) \
    dst[n][k] = *reinterpret_cast<const bf16x8*>((char*)SB(b, h) + lds_byte(wc * 32 + n * 16 + fr, k * 32 + fq * 8))
#define MMA(ai, bj, At_, Bt_) do { __builtin_amdgcn_s_setprio(1); \
    for (int m = 0; m < 4; ++m) for (int n = 0; n < 2; ++n) for (int k = 0; k < 2; ++k) \
      acc[ai][bj][m][n] = __builtin_amdgcn_mfma_f32_16x16x32_bf16(At_[m][k], Bt_[n][k], acc[ai][bj][m][n], 0, 0, 0); \
    __builtin_amdgcn_s_setprio(0); } while (0)
#define WAIT_V(n) asm volatile("s_waitcnt vmcnt(" #n ")" ::: "memory")
#define WAIT_L(n) asm volatile("s_waitcnt lgkmcnt(" #n ")" ::: "memory")
#define BAR __builtin_amdgcn_s_barrier()
#define SCHED __builtin_amdgcn_sched_barrier(0)
  const int G = gridDim.x;
  const int ntiles = nM * nN;
  const int tid_ = tidx();
  const int wid = tid_ >> 6, lane = tid_ & 63, wr = wid >> 2, wc = wid & 3, fr = lane & 15, fq = lane >> 4;
  const int nt = K / BK;
  unsigned so0, so1;
  const int wu16 = __builtin_amdgcn_readfirstlane(tid_ >> 6) * 1024;
  { int _r, _c; stage_rc(tid_ * 16, _r, _c); so0 = (unsigned)(_r * K + _c) * 2u;
    stage_rc(tid_ * 16 + 8192, _r, _c); so1 = (unsigned)(_r * K + _c) * 2u; }
  for (int tile = (int)((blockIdx.x + G - (rot % G)) % G); tile < ntiles; tile += G) {
    int wgid = tile;
    { int q = ntiles / 8, r = ntiles % 8, xcd = wgid % 8, off = wgid / 8;
      wgid = (xcd < r ? xcd * (q + 1) : r * (q + 1) + (xcd - r) * q) + off; }
    int nig = 8 * nN, gid = wgid / nig, fm = gid * 8, gsz = min(nM - fm, 8);
    int pm = fm + ((wgid % nig) % gsz), pn = (wgid % nig) / gsz, brow = pm * BM, bcol = pn * BM;
    f32x4 acc[2][2][4][2] = {};
    bf16x8 At[4][2], B0[2][2], B1[2][2];
    STAGE(SB(0, 0), Bt, bcol, 0); STAGE(SA(0, 0), A, brow, 0);
    STAGE(SB(0, 1), Bt, bcol + HALF, 0); STAGE(SA(0, 1), A, brow + HALF, 0);
    if (wr == 1) BAR;
    WAIT_V(4); BAR;
    STAGE(SB(1, 0), Bt, bcol, 1); STAGE(SA(1, 0), A, brow, 1); STAGE(SB(1, 1), Bt, bcol + HALF, 1);
    WAIT_V(6); BAR;
    for (int t = 0; t < nt - 2; t += 2) {
      LDB(B0, 0, 0); SCHED; LDA(At, 0, 0); STAGE(SA(1, 1), A, brow + HALF, t + 1);
      WAIT_L(8); BAR; WAIT_L(0); MMA(0, 0, At, B0); BAR; SCHED;
      LDB(B1, 0, 1); STAGE(SB(0, 0), Bt, bcol, t + 2);
      BAR; WAIT_L(0); MMA(0, 1, At, B1); BAR;
      LDA(At, 0, 1); STAGE(SA(0, 0), A, brow, t + 2);
      BAR; WAIT_L(0); MMA(1, 0, At, B0); BAR; SCHED;
      STAGE(SB(0, 1), Bt, bcol + HALF, t + 2);
      WAIT_V(6); BAR; MMA(1, 1, At, B1); BAR;
      LDB(B0, 1, 0); SCHED; LDA(At, 1, 0); STAGE(SA(0, 1), A, brow + HALF, t + 2);
      WAIT_L(8); BAR; WAIT_L(0); MMA(0, 0, At, B0); BAR; SCHED;
      LDB(B1, 1, 1); STAGE(SB(1, 0), Bt, bcol, t + 3);
      BAR; WAIT_L(0); MMA(0, 1, At, B1); BAR;
      LDA(At, 1, 1); STAGE(SA(1, 0), A, brow, t + 3);
      BAR; WAIT_L(0); MMA(1, 0, At, B0); BAR; SCHED;
      STAGE(SB(1, 1), Bt, bcol + HALF, t + 3);
      WAIT_V(6); BAR; MMA(1, 1, At, B1); BAR;
    }
    { LDB(B0, 0, 0); LDA(At, 0, 0); STAGE(SA(1, 1), A, brow + HALF, nt - 1);
      BAR; WAIT_L(0); MMA(0, 0, At, B0); BAR;
      LDB(B1, 0, 1); BAR; WAIT_L(0); MMA(0, 1, At, B1); BAR;
      LDA(At, 0, 1); WAIT_V(4); BAR; WAIT_L(0); MMA(1, 0, At, B0); MMA(1, 1, At, B1); BAR; }
    { LDB(B0, 1, 0); LDA(At, 1, 0); WAIT_V(2); BAR; WAIT_L(0); MMA(0, 0, At, B0); BAR;
      LDB(B1, 1, 1); WAIT_V(0); BAR; WAIT_L(0); MMA(0, 1, At, B1); BAR;
      LDA(At, 1, 1); BAR; WAIT_L(0); MMA(1, 0, At, B0); MMA(1, 1, At, B1); BAR; }
    if (wr == 0) BAR;
    float* stg = (float*)smem;
    int tx = tid_;
    asm volatile("" : "+v"(tx));
    const int ewr = tx >> 8, ewc = (tx >> 6) & 3, efr = tx & 15, efq = (tx >> 4) & 3;
#define EPI_HALF(ai) do { \
    __syncthreads(); \
    _Pragma("unroll") for (int bj = 0; bj < 2; ++bj) _Pragma("unroll") for (int m = 0; m < 4; ++m) \
    _Pragma("unroll") for (int n = 0; n < 2; ++n) _Pragma("unroll") for (int j = 0; j < 4; ++j) \
      stg[(ewr * 64 + m * 16 + efq * 4 + j) * 260 + bj * HALF + ewc * 32 + n * 16 + efr] = acc[ai][bj][m][n][j]; \
    __syncthreads(); \
    for (int i = 0; i < 8; ++i) { \
      int item = i * NTHR + tx; int rl = item >> 5, qp = item & 31; \
      int cl = (qp >> 2) * 32 + (qp & 3) * 4; \
      float4 v0 = *(const float4*)(stg + rl * 260 + cl), v1 = *(const float4*)(stg + rl * 260 + cl + 16); \
      int row = brow + ai * HALF + rl; \
      float ss = epi.apply4(row, bcol + cl, v0, v1); \
      if (Epi::kSsq) { \
        ss += __shfl_xor(ss, 1); ss += __shfl_xor(ss, 2); ss += __shfl_xor(ss, 4); ss += __shfl_xor(ss, 8); ss += __shfl_xor(ss, 16); \
        if (qp == 0) epi.ssq_out(row, pn, ss); \
      } \
    } } while (0)
    EPI_HALF(0);
    EPI_HALF(1);
#undef EPI_HALF
    __syncthreads();
  }
#undef SA
#undef SB
#undef STAGE
#undef LDA
#undef LDB
#undef MMA
}

__device__ __forceinline__ float rstd_from_ssq(const float* ssq, int row) {
  float4 s = *(const float4*)(ssq + (size_t)row * 4);
  return rsqrtf((s.x + s.y + s.z + s.w) * (1.f / 1024.f) + 1e-6f);
}
__device__ __forceinline__ uint2 pack4(float4 v) { uint2 w; w.x = pack2(v.x, v.y); w.y = pack2(v.z, v.w); return w; }
__device__ __forceinline__ float silu_mul(float g, float u) { return g / (1.f + __expf(-g)) * u; }
struct EpiGU {
  static constexpr bool kSsq = false;
  const float* ssq; u16* act;
  __device__ __forceinline__ float apply4(int row, int c0, float4 g, float4 u) const {
    float rs = rstd_from_ssq(ssq, row);
    float4 o = make_float4(silu_mul(g.x * rs, u.x * rs), silu_mul(g.y * rs, u.y * rs), silu_mul(g.z * rs, u.z * rs), silu_mul(g.w * rs, u.w * rs));
    *(uint2*)(act + (size_t)row * DFF + ((c0 & ~31) >> 1) + (c0 & 15)) = pack4(o);
    return 0.f;
  }
  __device__ __forceinline__ void ssq_out(int, int, float) const {}
};
struct EpiRes {
  static constexpr bool kSsq = true;
  float* x; u16* xb; float* ssq; float coef;
  __device__ __forceinline__ float apply4(int row, int c0, float4 v0, float4 v1) const {
    size_t i = (size_t)row * 1024 + c0;
    float4 a = *(const float4*)(x + i), b = *(const float4*)(x + i + 16);
    a.x += coef * v0.x; a.y += coef * v0.y; a.z += coef * v0.z; a.w += coef * v0.w;
    b.x += coef * v1.x; b.y += coef * v1.y; b.z += coef * v1.z; b.w += coef * v1.w;
    *(float4*)(x + i) = a; *(float4*)(x + i + 16) = b;
    *(uint2*)(xb + i) = pack4(a); *(uint2*)(xb + i + 16) = pack4(b);
    return a.x * a.x + a.y * a.y + a.z * a.z + a.w * a.w + b.x * b.x + b.y * b.y + b.z * b.z + b.w * b.w;
  }
  __device__ __forceinline__ void ssq_out(int row, int pn, float v) const { ssq[(size_t)row * 4 + pn] = v; }
};
struct EpiScaleBf {
  static constexpr bool kSsq = false;
  const float* ssq; u16* o; int ld;
  __device__ __forceinline__ float apply4(int row, int c0, float4 v0, float4 v1) const {
    float rs = rstd_from_ssq(ssq, row);
    size_t i = (size_t)row * ld + c0;
    *(uint2*)(o + i) = pack4(make_float4(v0.x * rs, v0.y * rs, v0.z * rs, v0.w * rs));
    *(uint2*)(o + i + 16) = pack4(make_float4(v1.x * rs, v1.y * rs, v1.z * rs, v1.w * rs));
    return 0.f;
  }
  __device__ __forceinline__ void ssq_out(int, int, float) const {}
};
struct EpiQ {
  static constexpr bool kSsq = false;
  u16* qb; const float2* rope;
  __device__ __forceinline__ float apply4(int row, int c0, float4 v0, float4 v1) const {
    if (c0 < 1024) {
      size_t i = (size_t)row * 1280 + (c0 >> 7) * 160 + (c0 & 127);
      *(uint2*)(qb + i) = pack4(v0); *(uint2*)(qb + i + 16) = pack4(v1);
    } else {
      int h = (c0 - 1024) >> 5, f0 = c0 & 15;
      int pos = row < TP ? (row & 4095) : (2048 + ((row - TP) & 63));
      const float2* cs = rope + pos * 16 + f0;
      float2 c_0 = cs[0], c_1 = cs[1], c_2 = cs[2], c_3 = cs[3];
      size_t i = (size_t)row * 1280 + h * 160 + 128 + f0;
      *(uint2*)(qb + i) = pack4(make_float4(v0.x * c_0.x - v1.x * c_0.y, v0.y * c_1.x - v1.y * c_1.y, v0.z * c_2.x - v1.z * c_2.y, v0.w * c_3.x - v1.w * c_3.y));
      *(uint2*)(qb + i + 16) = pack4(make_float4(v0.x * c_0.y + v1.x * c_0.x, v0.y * c_1.y + v1.y * c_1.x, v0.z * c_2.y + v1.z * c_2.x, v0.w * c_3.y + v1.w * c_3.x));
    }
    return 0.f;
  }
  __device__ __forceinline__ void ssq_out(int, int, float) const {}
};
__device__ __forceinline__ float decay_f(float z) {
  float nz = -z;
  float sp = fmaxf(nz, 0.f) + __logf(1.f + __expf(-fabsf(nz)));
  return __expf(-__expf(-sp - 0.5f));
}
struct EpiRW {
  static constexpr bool kSsq = false;
  const float* w0; const float* a0; const float* ka; float* wb; float* bb; float* kb; const float* kkb; u16* gb;
  __device__ __forceinline__ void acol(size_t i, int c, float4 v) const {
    float4 a_0 = *(const float4*)(a0 + c), k_a = *(const float4*)(ka + c), kk = *(const float4*)(kkb + i), k = *(const float4*)(kb + i);
    float4 a = make_float4(sigmoidf_(a_0.x + v.x), sigmoidf_(a_0.y + v.y), sigmoidf_(a_0.z + v.z), sigmoidf_(a_0.w + v.w));
    *(float4*)(bb + i) = make_float4(kk.x * a.x, kk.y * a.y, kk.z * a.z, kk.w * a.w);
    *(float4*)(kb + i) = make_float4(k.x * (1.f + (a.x - 1.f) * k_a.x), k.y * (1.f + (a.y - 1.f) * k_a.y), k.z * (1.f + (a.z - 1.f) * k_a.z), k.w * (1.f + (a.w - 1.f) * k_a.w));
  }
  __device__ __forceinline__ float apply4(int row, int c0, float4 v0, float4 v1) const {
    if (c0 < 512) {
      float4 z0 = *(const float4*)(w0 + c0), z1 = *(const float4*)(w0 + c0 + 16);
      size_t i = (size_t)row * 512 + c0;
      *(float4*)(wb + i) = make_float4(decay_f(z0.x + v0.x), decay_f(z0.y + v0.y), decay_f(z0.z + v0.z), decay_f(z0.w + v0.w));
      *(float4*)(wb + i + 16) = make_float4(decay_f(z1.x + v1.x), decay_f(z1.y + v1.y), decay_f(z1.z + v1.z), decay_f(z1.w + v1.w));
    } else if (c0 < 1024) {
      int c = c0 - 512; size_t i = (size_t)row * 512 + c;
      acol(i, c, v0); acol(i + 16, c + 16, v1);
    } else {
      size_t i = (size_t)row * 512 + (c0 - 1024);
      *(uint2*)(gb + i) = pack4(v0); *(uint2*)(gb + i + 16) = pack4(v1);
    }
    return 0.f;
  }
  __device__ __forceinline__ void ssq_out(int, int, float) const {}
};
template <bool ISV>
struct EpiMem {
  static constexpr bool kSsq = false;
  float* of; u16* ob;
  __device__ __forceinline__ void quad(int row, int col, float4 v) const {
    *(float4*)(of + (size_t)row * 1024 + col) = v;
    int b = row >> 8, m = row & 255, h = col >> 8, d = col & 255;
    if (ISV) {
      u16* o = ob + (size_t)((b * 4 + h) * 256 + d) * 256 + m;
      o[0] = f2bf(v.x); o[256] = f2bf(v.y); o[512] = f2bf(v.z); o[768] = f2bf(v.w);
    } else {
      *(uint2*)(ob + (size_t)((b * 4 + h) * 256 + m) * 256 + d) = pack4(v);
    }
  }
  __device__ __forceinline__ float apply4(int row, int c0, float4 v0, float4 v1) const {
    quad(row, c0, v0); quad(row, c0 + 16, v1);
    return 0.f;
  }
  __device__ __forceinline__ void ssq_out(int, int, float) const {}
};

template <class F>
__device__ __forceinline__ void tconv(u16* dst, int ldd, int N, int K, int rot, F f) {
  extern __shared__ __attribute__((aligned(16))) char smem[];
  float* t = (float*)smem;
  const int nk = K / 64, nt = (N / 64) * nk, G = gridDim.x;
  const int tid = tidx(), a = tid >> 6, c = tid & 63;
  for (int tile = (int)((blockIdx.x + G - (rot % G)) % G); tile < nt; tile += G) {
    int n0 = (tile / nk) * 64, k0 = (tile % nk) * 64;
    __syncthreads();
#pragma unroll
    for (int i = 0; i < 8; ++i) { int kk = a + 8 * i; t[kk * 65 + c] = f(k0 + kk, n0 + c); }
    __syncthreads();
#pragma unroll
    for (int i = 0; i < 8; ++i) { int nn = a + 8 * i; dst[(size_t)(n0 + nn) * ldd + k0 + c] = f2bf(t[c * 65 + nn]); }
  }
}

template <class F>
__device__ __forceinline__ void tconv_v(u16* dst, int ldd, int N, int K, int vb, int nvb, F f) {
  extern __shared__ __attribute__((aligned(16))) char smem[];
  float* t = (float*)smem;
  const int nk = K / 64, nt = (N / 64) * nk;
  const int tid = tidx(), a = tid >> 6, c = tid & 63;
  for (int tile = vb; tile < nt; tile += nvb) {
    int n0 = (tile / nk) * 64, k0 = (tile % nk) * 64;
    __syncthreads();
#pragma unroll
    for (int i = 0; i < 8; ++i) { int kk = a + 8 * i; t[kk * 65 + c] = f(k0 + kk, n0 + c); }
    __syncthreads();
#pragma unroll
    for (int i = 0; i < 8; ++i) { int nn = a + 8 * i; dst[(size_t)(n0 + nn) * ldd + k0 + c] = f2bf(t[c * 65 + nn]); }
  }
  __syncthreads();
}

template <int DK, int DV, int RPG>
__device__ __forceinline__ void attn_item(const u16* __restrict__ Qb, int ldq, int nrows, const u16* __restrict__ Kb, int ldk,
                                          const u16* __restrict__ Vtb, int ldvt, int nkeys, u16* __restrict__ Ob, int ldo) {
  extern __shared__ __attribute__((aligned(16))) char smem[];
  constexpr int KS = DK + 8, VS = 68;
  u16* sK = (u16*)smem;
  u16* sV = sK + 64 * KS;
  const int tid = tidx(), wid = tid >> 6, lane = tid & 63, q = lane & 31, hh = lane >> 5;
  const int row = wid * 32 + q;
  const bool active = (wid * 32) < nrows;
  bf16x8 qf[DK / 16];
  if (active) {
#pragma unroll
    for (int ks = 0; ks < DK / 16; ++ks) qf[ks] = *(const bf16x8*)(Qb + (size_t)row * ldq + ks * 16 + hh * 8);
  }
  f32x16 o[DV / 32];
#pragma unroll
  for (int dt = 0; dt < DV / 32; ++dt)
#pragma unroll
    for (int i = 0; i < 16; ++i) o[dt][i] = 0.f;
  float mrun = -1e30f, lrun = 0.f;
  const int nkt = nkeys >> 6;
  for (int kt = 0; kt < nkt; ++kt) {
    __syncthreads();
    for (int c = tid; c < 64 * (DK / 8); c += NTHR) {
      int r = c / (DK / 8), cc = c % (DK / 8);
      uint4 v = *(const uint4*)(Kb + (size_t)(kt * 64 + r) * ldk + cc * 8);
      *(uint4*)(sK + r * KS + cc * 8) = v;
    }
    for (int c = tid; c < DV * 8; c += NTHR) {
      int r = c >> 3, cc = c & 7;
      uint4 v = *(const uint4*)(Vtb + (size_t)r * ldvt + kt * 64 + cc * 8);
      uint2* d = (uint2*)(sV + r * VS + cc * 8);
      d[0] = make_uint2(v.x, v.y); d[1] = make_uint2(v.z, v.w);
    }
    __syncthreads();
    if (active) {
      f32x16 s0, s1;
#pragma unroll
      for (int i = 0; i < 16; ++i) { s0[i] = 0.f; s1[i] = 0.f; }
#pragma unroll
      for (int ks = 0; ks < DK / 16; ++ks) {
        bf16x8 a0 = *(const bf16x8*)(sK + q * KS + ks * 16 + hh * 8);
        bf16x8 a1 = *(const bf16x8*)(sK + (32 + q) * KS + ks * 16 + hh * 8);
        s0 = __builtin_amdgcn_mfma_f32_32x32x16_bf16(a0, qf[ks], s0, 0, 0, 0);
        s1 = __builtin_amdgcn_mfma_f32_32x32x16_bf16(a1, qf[ks], s1, 0, 0, 0);
      }
      float mx = s0[0];
#pragma unroll
      for (int i = 1; i < 16; ++i) mx = fmaxf(mx, s0[i]);
#pragma unroll
      for (int i = 0; i < 16; ++i) mx = fmaxf(mx, s1[i]);
      mx = fmaxf(mx, __shfl_xor(mx, 32));
      float mn = fmaxf(mrun, mx);
      float alpha = __builtin_amdgcn_exp2f(mrun - mn);
      mrun = mn;
      float ps = 0.f;
#pragma unroll
      for (int i = 0; i < 16; ++i) { s0[i] = __builtin_amdgcn_exp2f(s0[i] - mn); ps += s0[i]; }
#pragma unroll
      for (int i = 0; i < 16; ++i) { s1[i] = __builtin_amdgcn_exp2f(s1[i] - mn); ps += s1[i]; }
      lrun = lrun * alpha + ps;
#pragma unroll
      for (int dt = 0; dt < DV / 32; ++dt)
#pragma unroll
        for (int i = 0; i < 16; ++i) o[dt][i] *= alpha;
#pragma unroll
      for (int kb = 0; kb < 2; ++kb)
#pragma unroll
        for (int s = 0; s < 2; ++s) {
          union { bf16x8 v; unsigned u[4]; } pf;
#pragma unroll
          for (int jj = 0; jj < 4; ++jj) {
            float e0 = kb ? s1[8 * s + 2 * jj] : s0[8 * s + 2 * jj];
            float e1 = kb ? s1[8 * s + 2 * jj + 1] : s0[8 * s + 2 * jj + 1];
            pf.u[jj] = pack2(e0, e1);
          }
          const int kbase = kb * 32 + s * 16 + 4 * hh;
#pragma unroll
          for (int dt = 0; dt < DV / 32; ++dt) {
            const u16* vp = sV + (dt * 32 + q) * VS + kbase;
            union { bf16x8 v; uint2 u[2]; } vf;
            vf.u[0] = *(const uint2*)vp; vf.u[1] = *(const uint2*)(vp + 8);
            o[dt] = __builtin_amdgcn_mfma_f32_32x32x16_bf16(vf.v, pf.v, o[dt], 0, 0, 0);
          }
        }
    }
  }
  if (active) {
    lrun += __shfl_xor(lrun, 32);
    float inv = 1.f / lrun;
    u16* op = Ob + (size_t)(row / RPG) * ldo + (size_t)(row % RPG) * DV;
#pragma unroll
    for (int dt = 0; dt < DV / 32; ++dt)
#pragma unroll
      for (int g = 0; g < 4; ++g) {
        uint2 w;
        w.x = pack2(o[dt][4 * g] * inv, o[dt][4 * g + 1] * inv);
        w.y = pack2(o[dt][4 * g + 2] * inv, o[dt][4 * g + 3] * inv);
        *(uint2*)(op + dt * 32 + 8 * g + 4 * hh) = w;
      }
  }
}

__device__ __forceinline__ float dpp_sum16(float x) {
  x += __int_as_float(__builtin_amdgcn_update_dpp(0, __float_as_int(x), 0xB1, 0xF, 0xF, false));
  x += __int_as_float(__builtin_amdgcn_update_dpp(0, __float_as_int(x), 0x4E, 0xF, 0xF, false));
  x += __int_as_float(__builtin_amdgcn_update_dpp(0, __float_as_int(x), 0x141, 0xF, 0xF, false));
  x += __int_as_float(__builtin_amdgcn_update_dpp(0, __float_as_int(x), 0x140, 0xF, 0xF, false));
  return x;
}
__device__ __forceinline__ void scan_item(KPR p, int l, int g0, int h, int half, int nsteps, const float* S0, float* Sout) {
  extern __shared__ __attribute__((aligned(16))) char smem[];
  float* sT = (float*)smem;
  float* sV = sT + 5 * 4096;
  const float* src0 = (const float*)(p.ws + W_RB) + h * 64; const float* src1 = (const float*)(p.ws + W_WB) + h * 64;
  const float* src2 = (const float*)(p.ws + W_KB) + h * 64; const float* src3 = (const float*)(p.ws + W_KKB) + h * 64;
  const float* src4 = (const float*)(p.ws + W_BB) + h * 64;
  const float* VB = (const float*)(p.ws + W_VB) + h * 64 + half * 32;
  float* YB = (float*)(p.ws + W_YB) + h * 64 + half * 32;
  const int tid = tidx();
  const int il = tid >> 4, sub = tid & 15, j0 = sub * 4, i = half * 32 + il;
  float s[4];
#pragma unroll
  for (int j = 0; j < 4; ++j) s[j] = S0 ? S0[i * 64 + j0 + j] : 0.f;
  float4 pa0, pa1, pa2, pa3, pa4, pb0, pb1, pb2, pb3, pb4, pfv;
  const int e0 = tid, e1 = tid + NTHR;
  const int st0 = e0 >> 4, c40 = (e0 & 15) * 4, st1 = e1 >> 4, c41 = (e1 & 15) * 4;
  const int stv = tid >> 3, c4v = (tid & 7) * 4;
#define SC_GL1(x, c0_) pa##x = *(const float4*)(src##x + (size_t)(g0 + (c0_) + st0) * 512 + c40); \
                       pb##x = *(const float4*)(src##x + (size_t)(g0 + (c0_) + st1) * 512 + c41);
#define SC_GLOAD(c0_) do { SC_GL1(0, c0_) SC_GL1(1, c0_) SC_GL1(2, c0_) SC_GL1(3, c0_) SC_GL1(4, c0_) \
    pfv = *(const float4*)(VB + (size_t)(g0 + (c0_) + stv) * 512 + c4v); } while (0)
#define SC_ST1(x) *(float4*)(sT + x * 4096 + st0 * 64 + c40) = pa##x; *(float4*)(sT + x * 4096 + st1 * 64 + c41) = pb##x;
  SC_GLOAD(0);
  for (int c0 = 0; c0 < nsteps; c0 += 64) {
    __syncthreads();
    SC_ST1(0) SC_ST1(1) SC_ST1(2) SC_ST1(3) SC_ST1(4)
    *(float4*)(sV + stv * 32 + c4v) = pfv;
    __syncthreads();
    if (c0 + 64 < nsteps) SC_GLOAD(c0 + 64);
#define SC_LD(S, st_) do { const int _s = (st_) < 64 ? (st_) : 63; \
      S##r = *(const float4*)(sT + _s * 64 + j0); S##w = *(const float4*)(sT + 4096 + _s * 64 + j0); \
      S##k = *(const float4*)(sT + 8192 + _s * 64 + j0); S##q = *(const float4*)(sT + 12288 + _s * 64 + j0); \
      S##b = *(const float4*)(sT + 16384 + _s * 64 + j0); S##v = sV[_s * 32 + il]; } while (0)
#define SC_STEP(S, st_) do { \
      float sa = -dpp_sum16(fma_s(s[1], S##q.y, mul_s(s[0], S##q.x)) + fma_s(s[3], S##q.w, mul_s(s[2], S##q.z))); \
      s[0] = fma_s(sa, S##b.x, fma_s(s[0], S##w.x, mul_s(S##v, S##k.x))); \
      s[1] = fma_s(sa, S##b.y, fma_s(s[1], S##w.y, mul_s(S##v, S##k.y))); \
      s[2] = fma_s(sa, S##b.z, fma_s(s[2], S##w.z, mul_s(S##v, S##k.z))); \
      s[3] = fma_s(sa, S##b.w, fma_s(s[3], S##w.w, mul_s(S##v, S##k.w))); \
      float y = dpp_sum16(fma_s(s[1], S##r.y, mul_s(s[0], S##r.x)) + fma_s(s[3], S##r.w, mul_s(s[2], S##r.z))); \
      ykeep = (sub == ((st_) & 15)) ? y : ykeep; } while (0)
    float4 Ar, Aw, Ak, Aq, Ab, Br, Bw, Bk, Bq, Bb, Cr, Cw, Ck, Cq, Cb, Dr, Dw, Dk, Dq, Db;
    float Av, Bv, Cv, Dv, ykeep = 0.f;
    SC_LD(A, 0); SC_LD(B, 1); SC_LD(C, 2);
    for (int st = 0; st < 64; st += 4) {
      SC_LD(D, st + 3); SC_STEP(A, st);
      SC_LD(A, st + 4); SC_STEP(B, st + 1);
      SC_LD(B, st + 5); SC_STEP(C, st + 2);
      SC_LD(C, st + 6); SC_STEP(D, st + 3);
      if ((st & 15) == 12) YB[(size_t)(g0 + c0 + (st - 12) + sub) * 512 + il] = ykeep;
    }
  }
#undef SC_LD
#undef SC_STEP
#undef SC_GLOAD
#undef SC_GL1
#undef SC_ST1
  *(float4*)(Sout + i * 64 + j0) = make_float4(s[0], s[1], s[2], s[3]);
}

__device__ __forceinline__ void phase_yfin(KPR p, int l) {
  const int tid = tidx(), wid = tid >> 6, lane = tid & 63;
  const float* YB = (const float*)(p.ws + W_YB); const float* RB = (const float*)(p.ws + W_RB); const float* KB = (const float*)(p.ws + W_KB);
  const float* VB = (const float*)(p.ws + W_VB); const u16* GB = (const u16*)(p.ws + W_GB); u16* AO = (u16*)(p.ws + W_AO);
  const float* rk = p.in[I_RK] + l * 512; const float* gng = p.in[I_GNG] + l * 512; const float* gnb = p.in[I_GNB] + l * 512;
  for (int g = blockIdx.x * 8 + wid; g < T; g += gridDim.x * 8) {
#pragma unroll 2
    for (int h = 0; h < 8; ++h) {
      size_t i = (size_t)g * 512 + h * 64 + lane;
      float y = YB[i];
      float mu = wave_sum(y) * (1.f / 64.f);
      float dlt = y - mu;
      float var = wave_sum(dlt * dlt) * (1.f / 64.f);
      float bon = wave_sum(RB[i] * KB[i] * rk[h * 64 + lane]);
      float v = dlt * rsqrtf(var + 64e-5f) * gng[h * 64 + lane] + gnb[h * 64 + lane] + bon * VB[i];
      AO[(size_t)g * 1536 + 1024 + h * 64 + lane] = f2bf(v * bf2f(GB[i]));
    }
  }
}

__device__ __forceinline__ void phase_init(KPR p) {
  const int G = gridDim.x, tid = tidx(), wid = tid >> 6, lane = tid & 63;
  const int gw = blockIdx.x * 8 + wid, nw = G * 8;
  if (blockIdx.x == 0 && tid < 64) ((int*)(p.ws + W_CNT))[tid] = 0;
  {
    float* X = (float*)(p.ws + W_X); u16* XB = (u16*)(p.ws + W_XB); float* SSQ = (float*)(p.ws + W_SSQ);
    for (int g = gw; g < T; g += nw) {
      const float* src = g < TP ? p.in[I_XP] + (size_t)g * 1024 : p.in[I_XS] + (size_t)(g - TP) * 1024;
      float ss = 0.f;
#pragma unroll
      for (int i = 0; i < 4; ++i) {
        float4 v = *(const float4*)(src + i * 256 + lane * 4);
        *(float4*)(X + (size_t)g * 1024 + i * 256 + lane * 4) = v;
        uint2 w; w.x = pack2(v.x, v.y); w.y = pack2(v.z, v.w);
        *(uint2*)(XB + (size_t)g * 1024 + i * 256 + lane * 4) = w;
        ss += v.x * v.x + v.y * v.y + v.z * v.z + v.w * v.w;
      }
      ss = wave_sum(ss);
      if (lane == 0) *(float4*)(SSQ + (size_t)g * 4) = make_float4(ss, 0.f, 0.f, 0.f);
    }
  }
  {
    u16* MB = (u16*)(p.ws + W_MB);
    for (int g = gw; g < 1024; g += nw) {
      const float* src = p.in[I_MEMP] + (size_t)g * 1024;
      float4 v[4]; float ss = 0.f;
#pragma unroll
      for (int i = 0; i < 4; ++i) { v[i] = *(const float4*)(src + i * 256 + lane * 4); ss += v[i].x * v[i].x + v[i].y * v[i].y + v[i].z * v[i].z + v[i].w * v[i].w; }
      ss = wave_sum(ss);
      float rs = rsqrtf(ss * (1.f / 1024.f) + 1e-6f);
#pragma unroll
      for (int i = 0; i < 4; ++i) {
        uint2 w; w.x = pack2(v[i].x * rs, v[i].y * rs); w.y = pack2(v[i].z * rs, v[i].w * rs);
        *(uint2*)(MB + (size_t)g * 1024 + i * 256 + lane * 4) = w;
      }
    }
  }
  {
    float2* RT = (float2*)(p.ws + W_ROPE);
    for (int e = blockIdx.x * NTHR + tid; e < 4096 * 16; e += G * NTHR) {
      int pos = e >> 4, i = e & 15;
      float inv = powf(10000.f, -(float)i / 16.f);
      float ang = (float)pos * inv;
      float sn, cs; sincosf(ang, &sn, &cs);
      RT[e] = make_float2(cs, sn);
    }
  }
  int rot = 0;
  for (int l = 0; l < NL; ++l) {
    u16* WT = (u16*)(p.ws + W_WT) + (size_t)l * WE_LAYER;
    for (int f = 0; f < 2; ++f) {
      const float* nrm = p.in[f ? I_F2N : I_F1N] + l * 1024;
      const float* wg = p.in[f ? I_F2G : I_F1G] + (size_t)l * 1024 * DFF;
      const float* wu = p.in[f ? I_F2U : I_F1U] + (size_t)l * 1024 * DFF;
      const float* wd = p.in[f ? I_F2D : I_F1D] + (size_t)l * 1024 * DFF;
      tconv(WT + (f ? WE_GU2 : WE_GU1), 1024, 5632, 1024, rot, [=](int k, int n) {
        int j = (n >> 5) * 16 + (n & 15);
        const float* s = ((n >> 4) & 1) ? wu : wg;
        return nrm[k] * s[(size_t)k * DFF + j];
      });
      rot += 88 * 16;
      tconv(WT + (f ? WE_D2 : WE_D1), DFF, 1024, DFF, rot, [=](int k, int n) { return wd[(size_t)k * 1024 + n]; });
      rot += 16 * 44;
    }
    {
      const float* nrm = p.in[I_MIXN] + l * 1024; const float* w = p.in[I_WIN] + (size_t)l * 1024 * DIN;
      tconv(WT + WE_IN, 1024, DINP, 1024, rot, [=](int k, int n) { return n < DIN ? nrm[k] * w[(size_t)k * DIN + n] : 0.f; });
      rot += 36 * 16;
    }
    {
      const float* nrm = p.in[I_QN] + l * 256; const float* wuq = p.in[I_WUQ] + (size_t)l * 256 * 768;
      const float* wuk = p.in[I_WUK] + (size_t)l * 8 * 128 * 64;
      tconv(WT + WE_Q, 256, 1280, 256, rot, [=](int k, int n) {
        float r;
        if (n < 1024) {
          int h = n >> 7, c = n & 127;
          const float* a = wuq + (size_t)k * 768 + h * 96; const float* b = wuk + (size_t)(h * 128 + c) * 64;
          r = 0.f;
          for (int d = 0; d < 64; ++d) r += a[d] * b[d];
        } else {
          int hr = n - 1024;
          r = wuq[(size_t)k * 768 + (hr >> 5) * 96 + 64 + (hr & 31)];
        }
        return r * nrm[k] * QSCALE;
      });
      rot += 20 * 4;
    }
    {
      const float* wup = p.in[I_WUP] + (size_t)l * 64 * 512; const float* aup = p.in[I_AUP] + (size_t)l * 64 * 512;
      const float* gup = p.in[I_GUP] + (size_t)l * 128 * 512;
      tconv(WT + WE_RW, 256, 1536, 256, rot, [=](int k, int n) {
        if (n < 512) return k < 64 ? wup[k * 512 + n] : 0.f;
        if (n < 1024) return (k >= 64 && k < 128) ? aup[(k - 64) * 512 + n - 512] : 0.f;
        return k >= 128 ? gup[(k - 128) * 512 + n - 1024] : 0.f;
      });
      rot += 24 * 4;
    }
    {
      const float* wuv = p.in[I_WUV] + (size_t)l * 8 * 128 * 64; const float* wo = p.in[I_WOUT] + (size_t)l * 1024 * 1024;
      tconv(WT + WE_OUT, 1536, 1024, 1536, rot, [=](int k, int n) {
        if (k < 1024) {
          int h = k >> 7, c = k & 127;
          const float* a = wuv + (size_t)(h * 128 + c) * 64; const float* b = wo + (size_t)(h * 64) * 1024 + n;
          float r = 0.f;
          for (int v = 0; v < 64; ++v) r += a[v] * b[(size_t)v * 1024];
          return r;
        }
        return wo[(size_t)(512 + k - 1024) * 1024 + n];
      });
      rot += 16 * 24;
    }
    {
      const float* nx = p.in[I_XN] + l * 1024; const float* nm = p.in[I_MKVN] + l * 1024;
      const float* wq = p.in[I_WMQ] + (size_t)l * 1048576; const float* wk = p.in[I_WMK] + (size_t)l * 1048576;
      const float* wv = p.in[I_WMV] + (size_t)l * 1048576; const float* wo = p.in[I_WMO] + (size_t)l * 1048576;
      tconv(WT + WE_MQ, 1024, 1024, 1024, rot, [=](int k, int n) { return nx[k] * wq[(size_t)k * 1024 + n] * XSCALE; });
      tconv(WT + WE_MK, 1024, 1024, 1024, rot, [=](int k, int n) { return nm[k] * wk[(size_t)k * 1024 + n]; });
      tconv(WT + WE_MV, 1024, 1024, 1024, rot, [=](int k, int n) { return nm[k] * wv[(size_t)k * 1024 + n]; });
      tconv(WT + WE_MO, 1024, 1024, 1024, rot, [=](int k, int n) { return wo[(size_t)k * 1024 + n]; });
    }
  }
}

__device__ __forceinline__ void phase_prep(KPR p, int l) {
  const int G = gridDim.x, tid = tidx(), wid = tid >> 6, lane = tid & 63;
  const int gw = blockIdx.x * 8 + wid, nw = G * 8;
  const u16* PROJ = (const u16*)(p.ws + W_PROJ);
  u16* CQB = (u16*)(p.ws + W_CQB); u16* A2 = (u16*)(p.ws + W_A2);
  float* RB = (float*)(p.ws + W_RB); float* KB = (float*)(p.ws + W_KB); float* VB = (float*)(p.ws + W_VB); float* KKB = (float*)(p.ws + W_KKB);
  u16* KP = (u16*)(p.ws + W_KP); u16* KS = (u16*)(p.ws + W_KS); u16* VTP = (u16*)(p.ws + W_VTP); u16* VTS = (u16*)(p.ws + W_VTS);
  const float2* RT = (const float2*)(p.ws + W_ROPE);
  const float* kvn = p.in[I_KVN] + l * 128; const float* mu = p.in[I_MU] + l * DSH; const float* kkw = p.in[I_KK] + l * 512;
  for (int g = gw; g < T; g += nw) {
    const u16* pr = PROJ + (size_t)g * DINP;
    const bool isP = g < TP;
    int b, t, pos, tlen;
    if (isP) { b = g >> 12; t = g & 4095; pos = t; tlen = 4096; } else { int gg = g - TP; b = gg >> 6; t = gg & 63; pos = 2048 + t; tlen = 64; }
    {
      uint2 w = *(const uint2*)(pr + lane * 4);
      float v0 = bf2f(w.x & 0xffff), v1 = bf2f(w.x >> 16), v2 = bf2f(w.y & 0xffff), v3 = bf2f(w.y >> 16);
      float ss = wave_sum(v0 * v0 + v1 * v1 + v2 * v2 + v3 * v3);
      float rs = rsqrtf(ss * (1.f / 256.f) + 1e-6f);
      uint2 o; o.x = pack2(v0 * rs, v1 * rs); o.y = pack2(v2 * rs, v3 * rs);
      *(uint2*)(CQB + (size_t)g * 256 + lane * 4) = o;
    }
    {
      unsigned w = *(const unsigned*)(pr + 256 + lane * 2);
      float v0 = bf2f(w & 0xffff), v1 = bf2f(w >> 16);
      float ss = wave_sum(v0 * v0 + v1 * v1);
      float rs = rsqrtf(ss * (1.f / 128.f) + 1e-6f);
      int c = lane * 2;
      v0 = v0 * rs * kvn[c]; v1 = v1 * rs * kvn[c + 1];
      float* of = isP ? p.out + OO_CKVP + ((size_t)(l * 4 + b) * 4096 + t) * 128 : p.out + OO_CKVS + ((size_t)(l * 32 + b) * 64 + t) * 128;
      *(float2*)(of + c) = make_float2(v0, v1);
      u16* kr = isP ? KP + ((size_t)b * 4096 + t) * 160 : KS + ((size_t)b * 2112 + 2048 + t) * 160;
      *(unsigned*)(kr + c) = pack2(v0, v1);
      if (isP) { VTP[((size_t)b * 128 + c) * 4096 + t] = f2bf(v0); VTP[((size_t)b * 128 + c + 1) * 4096 + t] = f2bf(v1); }
      else { VTS[((size_t)b * 128 + c) * 2112 + 2048 + t] = f2bf(v0); VTS[((size_t)b * 128 + c + 1) * 2112 + 2048 + t] = f2bf(v1); }
      if (lane < 16) {
        float x1 = bf2f(pr[384 + lane]), x2 = bf2f(pr[400 + lane]);
        float2 cs = RT[pos * 16 + lane];
        float o1 = x1 * cs.x - x2 * cs.y, o2 = x1 * cs.y + x2 * cs.x;
        float* okr = isP ? p.out + OO_KRP + ((size_t)(l * 4 + b) * 4096 + t) * 32 : p.out + OO_KRS + ((size_t)(l * 32 + b) * 64 + t) * 32;
        okr[lane] = o1; okr[lane + 16] = o2;
        kr[128 + lane] = f2bf(o1); kr[144 + lane] = f2bf(o2);
      }
    }
    {
      const u16* pb = pr + 416;
      const u16* pp = pr - DINP + 416;
      const float* sh0 = p.in[I_SSH] + (size_t)(l * 32 + b) * DSH;
      const bool last = (t == tlen - 1);
      float* osh = isP ? p.out + OO_SHP + (size_t)(l * 4 + b) * DSH : p.out + OO_SHS + (size_t)(l * 32 + b) * DSH;
#pragma unroll
      for (int it = 0; it < 4; ++it) {
        const int c = it * 64 + lane;
        if (c < 224) {
          const int e = c * 8;
          uint4 w = *(const uint4*)(pb + e);
          float pv[8] = {bf2f(w.x & 0xffff), bf2f(w.x >> 16), bf2f(w.y & 0xffff), bf2f(w.y >> 16), bf2f(w.z & 0xffff), bf2f(w.z >> 16), bf2f(w.w & 0xffff), bf2f(w.w >> 16)};
          float pq[8];
          if (t > 0) {
            uint4 q = *(const uint4*)(pp + e);
            pq[0] = bf2f(q.x & 0xffff); pq[1] = bf2f(q.x >> 16); pq[2] = bf2f(q.y & 0xffff); pq[3] = bf2f(q.y >> 16);
            pq[4] = bf2f(q.z & 0xffff); pq[5] = bf2f(q.z >> 16); pq[6] = bf2f(q.w & 0xffff); pq[7] = bf2f(q.w >> 16);
          } else if (!isP) {
            float4 q0 = *(const float4*)(sh0 + e), q1 = *(const float4*)(sh0 + e + 4);
            pq[0] = q0.x; pq[1] = q0.y; pq[2] = q0.z; pq[3] = q0.w; pq[4] = q1.x; pq[5] = q1.y; pq[6] = q1.z; pq[7] = q1.w;
          } else {
#pragma unroll
            for (int j = 0; j < 8; ++j) pq[j] = 0.f;
          }
          float4 m0 = *(const float4*)(mu + e), m1 = *(const float4*)(mu + e + 4);
          float mm[8] = {m0.x, m0.y, m0.z, m0.w, m1.x, m1.y, m1.z, m1.w};
          float xs[8];
#pragma unroll
          for (int j = 0; j < 8; ++j) xs[j] = pv[j] + mm[j] * (pq[j] - pv[j]);
          if (last) { *(float4*)(osh + e) = make_float4(pv[0], pv[1], pv[2], pv[3]); *(float4*)(osh + e + 4) = make_float4(pv[4], pv[5], pv[6], pv[7]); }
          if (it == 0) {
            float* o = RB + (size_t)g * 512 + e;
            *(float4*)o = make_float4(xs[0], xs[1], xs[2], xs[3]); *(float4*)(o + 4) = make_float4(xs[4], xs[5], xs[6], xs[7]);
          } else if (it == 1) {
            const int cc = e - 512;
            float* o = KB + (size_t)g * 512 + cc;
            *(float4*)o = make_float4(xs[0], xs[1], xs[2], xs[3]); *(float4*)(o + 4) = make_float4(xs[4], xs[5], xs[6], xs[7]);
            float4 k0 = *(const float4*)(kkw + cc), k1 = *(const float4*)(kkw + cc + 4);
            float kk[8] = {xs[0] * k0.x, xs[1] * k0.y, xs[2] * k0.z, xs[3] * k0.w, xs[4] * k1.x, xs[5] * k1.y, xs[6] * k1.z, xs[7] * k1.w};
            float ss = 0.f;
#pragma unroll
            for (int j = 0; j < 8; ++j) ss += kk[j] * kk[j];
            ss = dpp_sum8(ss);
            float rn = rsqrtf(ss + 1e-12f);
            float* o2 = KKB + (size_t)g * 512 + cc;
            *(float4*)o2 = make_float4(kk[0] * rn, kk[1] * rn, kk[2] * rn, kk[3] * rn); *(float4*)(o2 + 4) = make_float4(kk[4] * rn, kk[5] * rn, kk[6] * rn, kk[7] * rn);
          } else if (it == 2) {
            float* o = VB + (size_t)g * 512 + (e - 1024);
            *(float4*)o = make_float4(xs[0], xs[1], xs[2], xs[3]); *(float4*)(o + 4) = make_float4(xs[4], xs[5], xs[6], xs[7]);
          } else {
            const int cc = e - 1536;
            float y[8];
#pragma unroll
            for (int j = 0; j < 8; ++j) y[j] = cc < 64 ? tanhf(xs[j]) : (cc < 128 ? xs[j] : sigmoidf_(xs[j]));
            uint4 o; o.x = pack2(y[0], y[1]); o.y = pack2(y[2], y[3]); o.z = pack2(y[4], y[5]); o.w = pack2(y[6], y[7]);
            *(uint4*)(A2 + (size_t)g * 256 + cc) = o;
          }
        }
      }
    }
  }
}

__device__ __forceinline__ void conv_caches(KPR p, int l, int vb, int nvb) {
  const int tid = tidx();
  u16* KS = (u16*)(p.ws + W_KS); u16* VTS = (u16*)(p.ws + W_VTS);
  {
    const float* cckv = p.in[I_CCKV] + (size_t)l * 32 * 2048 * 128;
    const float* ckr = p.in[I_CKR] + (size_t)l * 32 * 2048 * 32;
    for (int idx = vb * NTHR + tid; idx < 32 * 2048 * 20; idx += nvb * NTHR) {
      int rowi = idx / 20, ch = idx % 20;
      int b = rowi >> 11, t = rowi & 2047;
      const float* s = ch < 16 ? cckv + (size_t)rowi * 128 + ch * 8 : ckr + (size_t)rowi * 32 + (ch - 16) * 8;
      float4 a = *(const float4*)s, c = *(const float4*)(s + 4);
      uint4 o; o.x = pack2(a.x, a.y); o.y = pack2(a.z, a.w); o.z = pack2(c.x, c.y); o.w = pack2(c.z, c.w);
      *(uint4*)(KS + ((size_t)b * 2112 + t) * 160 + ch * 8) = o;
    }
    tconv_v(VTS, 2112, 4096, 2048, vb, nvb, [=](int k, int n) { return cckv[((size_t)(n >> 7) * 2048 + k) * 128 + (n & 127)]; });
    const float* cmk = p.in[I_CMK] + (size_t)l * 32 * 256 * 1024;
    const float* cmv = p.in[I_CMV] + (size_t)l * 32 * 256 * 1024;
    u16* MKS = (u16*)(p.ws + W_MKS); u16* MVTS = (u16*)(p.ws + W_MVTS);
    for (int idx = vb * NTHR + tid; idx < 32 * 4 * 256 * 32; idx += nvb * NTHR) {
      int d8 = idx & 31, m = (idx >> 5) & 255, h = (idx >> 13) & 3, b = idx >> 15;
      const float* s = cmk + ((size_t)(b * 256 + m) * 4 + h) * 256 + d8 * 8;
      float4 a = *(const float4*)s, c = *(const float4*)(s + 4);
      uint4 o; o.x = pack2(a.x, a.y); o.y = pack2(a.z, a.w); o.z = pack2(c.x, c.y); o.w = pack2(c.z, c.w);
      *(uint4*)(MKS + (size_t)idx * 8) = o;
    }
    tconv_v(MVTS, 256, 32768, 256, vb, nvb, [=](int k, int n) { return cmv[((size_t)((n >> 10) * 256 + k) * 4 + ((n >> 8) & 3)) * 256 + (n & 255)]; });
  }
}

__device__ __forceinline__ void mla_sub(KPR p, int b, int c, int half) {
  const u16* QB = (const u16*)(p.ws + W_QB); u16* AO = (u16*)(p.ws + W_AO);
  size_t tok = (size_t)b * 4096 + c * 64 + half * 32;
  attn_item<160, 128, 8>(QB + tok * 1280, 160, 256, (const u16*)(p.ws + W_KP) + (size_t)b * 4096 * 160, 160,
                         (const u16*)(p.ws + W_VTP) + (size_t)b * 128 * 4096, 4096, (c + 1) * 64, AO + tok * 1536, 1536);
}
__device__ __forceinline__ void phase_mix(KPR p, int l, int mode = 0) {
  extern __shared__ __attribute__((aligned(16))) char smem[];
  int* sItem = (int*)(smem + 131072);
  int* cnt = (int*)(p.ws + W_CNT) + l + mode * 8;
  for (;;) {
    __syncthreads();
    if (threadIdx.x == 0) *sItem = atomicAdd(cnt, 1);
    __syncthreads();
    int it = *sItem;
    if (it >= 896) break;
    if (mode == 1 && it >= 64 && it < 384) continue;
    if (mode == 2 && (it < 64 || it >= 384)) continue;
    if (it < 64) {
      int b = it >> 4, h = (it >> 1) & 7, half = it & 1;
      scan_item(p, l, b * 4096, h, half, 4096, nullptr, p.out + OO_WKVP + ((size_t)(l * 4 + b) * 8 + h) * 4096);
    } else if (it < 320) {
      int k = it - 64; int b = k >> 6, pr = (k >> 1) & 31, half = k & 1;
      mla_sub(p, b, 63 - pr, half);
      mla_sub(p, b, pr, half);
    } else if (it < 384) {
      int k = it - 320; int b = k >> 1, half = k & 1;
      const u16* QB = (const u16*)(p.ws + W_QB); u16* AO = (u16*)(p.ws + W_AO);
      size_t tok = (size_t)TP + b * 64 + half * 32;
      attn_item<160, 128, 8>(QB + tok * 1280, 160, 256, (const u16*)(p.ws + W_KS) + (size_t)b * 2112 * 160, 160,
                             (const u16*)(p.ws + W_VTS) + (size_t)b * 128 * 2112, 2112, 2112, AO + tok * 1536, 1536);
    } else {
      int k = it - 384; int b = k >> 4, h = (k >> 1) & 7, half = k & 1;
      scan_item(p, l, TP + b * 64, h, half, 64, p.in[I_SWKV] + ((size_t)(l * 32 + b) * 8 + h) * 4096,
                p.out + OO_WKVS + ((size_t)(l * 32 + b) * 8 + h) * 4096);
    }
  }
}

__device__ __forceinline__ void phase_xattn(KPR p, int l) {
  const u16* QX = (const u16*)(p.ws + W_QX); u16* XO = (u16*)(p.ws + W_XO);
  for (int it = blockIdx.x; it < 384; it += gridDim.x) {
    if (it < 256) {
      int b = it >> 6, h = (it >> 4) & 3, qt = it & 15;
      size_t tok = (size_t)b * 4096 + qt * 256;
      for (int hv = 0; hv < 2; ++hv)
        attn_item<256, 128, 1>(QX + tok * 1024 + h * 256, 1024, 256, (const u16*)(p.ws + W_MKP) + (size_t)((l * 4 + b) * 4 + h) * 65536, 256,
                               (const u16*)(p.ws + W_MVTP) + (size_t)((l * 4 + b) * 4 + h) * 65536 + hv * 128 * 256, 256, 256, XO + tok * 1024 + h * 256 + hv * 128, 1024);
    } else {
      int k = it - 256; int b = k >> 2, h = k & 3;
      size_t tok = (size_t)TP + b * 64;
      for (int hv = 0; hv < 2; ++hv)
        attn_item<256, 128, 1>(QX + tok * 1024 + h * 256, 1024, 64, (const u16*)(p.ws + W_MKS) + (size_t)(b * 4 + h) * 65536, 256,
                               (const u16*)(p.ws + W_MVTS) + (size_t)(b * 4 + h) * 65536 + hv * 128 * 256, 256, 256, XO + tok * 1024 + h * 256 + hv * 128, 1024);
    }
  }
}

__device__ __forceinline__ void phase_final(KPR p) {
  const int tid = tidx(), wid = tid >> 6, lane = tid & 63;
  const float* X = (const float*)(p.ws + W_X); const float* fn = p.in[I_FN];
  for (int g = blockIdx.x * 8 + wid; g < T; g += gridDim.x * 8) {
    float4 v[4]; float ss = 0.f;
#pragma unroll
    for (int i = 0; i < 4; ++i) { v[i] = *(const float4*)(X + (size_t)g * 1024 + i * 256 + lane * 4); ss += v[i].x * v[i].x + v[i].y * v[i].y + v[i].z * v[i].z + v[i].w * v[i].w; }
    ss = wave_sum(ss);
    float rs = rsqrtf(ss * (1.f / 1024.f) + 1e-6f);
#pragma unroll
    for (int i = 0; i < 4; ++i) {
      float4 gn = *(const float4*)(fn + i * 256 + lane * 4);
      *(float4*)(p.out + OO_Y + (size_t)g * 1024 + i * 256 + lane * 4) = make_float4(v[i].x * rs * gn.x, v[i].y * rs * gn.y, v[i].z * rs * gn.z, v[i].w * rs * gn.w);
    }
  }
}

constexpr int NPL = 13;
constexpr int N_PHASES = 2 + NPL * NL + 1;

__device__ __forceinline__ void run_phase(KPR p, int ph, int rep) {
  float* X = (float*)(p.ws + W_X); u16* XB = (u16*)(p.ws + W_XB); float* SSQ = (float*)(p.ws + W_SSQ);
  u16* ACT = (u16*)(p.ws + W_ACT);
#ifdef ONLY_S
  if (ONLY_S == 100) { if (ph == 0) phase_init(p); return; }
  if (ONLY_S == 102) { if (ph == N_PHASES - 1) phase_final(p); return; }
  if (ONLY_S != 101 && ph < 2) return;
  if (ONLY_S == 101 && ph != 1) return;
  if (ONLY_S < 100 && (ph < 2 || ph == N_PHASES - 1 || (ph - 2) % NPL != ONLY_S)) return;
#endif
  if (ph == 0) { phase_init(p); return; }
  if (ph == 1) {
    for (int l = 0; l < NL; ++l) {
      const u16* WT = (const u16*)(p.ws + W_WT) + (size_t)l * WE_LAYER;
      gemm_phase((const u16*)(p.ws + W_MB), WT + WE_MK, 1024, 4, 4, (2 * l) * 16,
                 EpiMem<false>{p.out + OO_MKP + (size_t)l * 1048576, (u16*)(p.ws + W_MKP) + (size_t)l * 16 * 65536});
      gemm_phase((const u16*)(p.ws + W_MB), WT + WE_MV, 1024, 4, 4, (2 * l + 1) * 16,
                 EpiMem<true>{p.out + OO_MVP + (size_t)l * 1048576, (u16*)(p.ws + W_MVTP) + (size_t)l * 16 * 65536});
    }
    return;
  }
  if (ph == N_PHASES - 1) { phase_final(p); return; }
  const int l = (ph - 2) / NPL, s = (ph - 2) % NPL;
  const u16* WT = (const u16*)(p.ws + W_WT) + (size_t)l * WE_LAYER;
  {
    const float rc = rep ? 0.f : 1.f;
    switch (s) {
      case 0: gemm_phase(XB, WT + WE_GU1, 1024, 72, 22, 0, EpiGU{SSQ, ACT}); break;
      case 1:
        gemm_phase(ACT, WT + WE_D1, DFF, 72, 4, 0, EpiRes{X, XB, SSQ, 0.5f * rc});
        if (blockIdx.x >= 32 && rep == 0) conv_caches(p, l, blockIdx.x - 32, gridDim.x - 32);
        break;
      case 2: gemm_phase(XB, WT + WE_IN, 1024, 72, 9, 0, EpiScaleBf{SSQ, (u16*)(p.ws + W_PROJ), DINP}); break;
      case 3: phase_prep(p, l); break;
      case 4:
        gemm_phase((const u16*)(p.ws + W_CQB), WT + WE_Q, 256, 72, 5, 0, EpiQ{(u16*)(p.ws + W_QB), (const float2*)(p.ws + W_ROPE)});
        gemm_phase((const u16*)(p.ws + W_A2), WT + WE_RW, 256, 72, 6, 360,
                   EpiRW{p.in[I_W0] + l * 512, p.in[I_A0] + l * 512, p.in[I_KA] + l * 512, (float*)(p.ws + W_WB), (float*)(p.ws + W_BB),
                         (float*)(p.ws + W_KB), (const float*)(p.ws + W_KKB), (u16*)(p.ws + W_GB)});
        break;
      case 5:
        phase_mix(p, l, 0);
        if (REP_WHICH == 3) { cg::this_grid().sync(); phase_mix(p, l, 1); }
        if (REP_WHICH == 4) { cg::this_grid().sync(); phase_mix(p, l, 2); }
        break;
      case 6: phase_yfin(p, l); break;
      case 7: gemm_phase((const u16*)(p.ws + W_AO), WT + WE_OUT, 1536, 72, 4, 0, EpiRes{X, XB, SSQ, rc}); break;
      case 8: gemm_phase(XB, WT + WE_MQ, 1024, 72, 4, 0, EpiScaleBf{SSQ, (u16*)(p.ws + W_QX), 1024}); break;
      case 9: phase_xattn(p, l); break;
      case 10: gemm_phase((const u16*)(p.ws + W_XO), WT + WE_MO, 1024, 72, 4, 0, EpiRes{X, XB, SSQ, rc}); break;
      case 11: gemm_phase(XB, WT + WE_GU2, 1024, 72, 22, 0, EpiGU{SSQ, ACT}); break;
      case 12: gemm_phase(ACT, WT + WE_D2, DFF, 72, 4, 0, EpiRes{X, XB, SSQ, 0.5f * rc}); break;
    }
  }
}

__global__ void __launch_bounds__(NTHR) mega(Params p) {
  cg::grid_group grid = cg::this_grid();
  for (int ph = p.ph_lo; ph < p.ph_hi; ++ph) {
    int nrep = 1;
    if (REP_WHICH && ph >= 2 && ph < N_PHASES - 1) {
      const int s = (ph - 2) % NPL;
      if ((REP_WHICH == 1 && (s == 0 || s == 11)) || (REP_WHICH == 2 && (s == 1 || s == 12)) || (REP_WHICH == 5 && s == 2) ||
          (REP_WHICH == 6 && s == 3) || (REP_WHICH == 7 && s == 9) || (REP_WHICH == 9 && (s == 7 || s == 8 || s == 10))) nrep = 2;
    }
    if (REP_WHICH == 8 && ph == 0) nrep = 2;
    for (int rep = 0; rep < nrep; ++rep) {
      const __attribute__((address_space(4))) Params* q = (const __attribute__((address_space(4))) Params*)__builtin_amdgcn_kernarg_segment_ptr();
      asm volatile("" : "+s"(q));
      run_phase(*q, ph, rep);
      if (ph + 1 < p.ph_hi || rep + 1 < nrep) grid.sync();
    }
  }
}

extern "C" void kernel_launch(void* const* d_in, const int* in_sizes, int n_in, void* d_out, int out_size, void* d_ws,
                              size_t ws_size, hipStream_t stream) {
  static int grid = 0;
  if (grid == 0) {
    if (n_in != N_IN || (size_t)out_size != OO_END || ws_size < W_END) {
      fprintf(stderr, "kernel_launch: unexpected shapes n_in=%d out=%d ws=%zu (need %zu)\n", n_in, out_size, ws_size, (size_t)W_END);
      grid = -1; return;
    }
    int dev = 0, cus = 0, per_cu = 0;
    hipGetDevice(&dev);
    hipDeviceGetAttribute(&cus, hipDeviceAttributeMultiprocessorCount, dev);
    hipFuncSetAttribute((const void*)mega, hipFuncAttributeMaxDynamicSharedMemorySize, SMEM_BYTES);
    hipOccupancyMaxActiveBlocksPerMultiprocessor(&per_cu, (const void*)mega, NTHR, SMEM_BYTES);
    if (per_cu < 1) { fprintf(stderr, "kernel_launch: occupancy query says %d blocks/CU\n", per_cu); per_cu = 1; }
    (void)hipGetLastError();
    grid = cus;
  }
  if (grid < 0) return;
  Params p{};
  for (int i = 0; i < N_IN; ++i) p.in[i] = (const float*)d_in[i];
  p.out = (float*)d_out; p.ws = (char*)d_ws;
#if N_LAUNCH_PER_PHASE
  for (int ph = 0; ph < N_PHASES; ++ph) {
    p.ph_lo = ph; p.ph_hi = ph + 1;
    void* args[] = {&p};
    hipError_t e = hipLaunchCooperativeKernel((const void*)mega, dim3(grid), dim3(NTHR), args, SMEM_BYTES, stream);
    if (e != hipSuccess) { fprintf(stderr, "launch failed: %s\n", hipGetErrorString(e)); break; }
  }
#else
  p.ph_lo = 0; p.ph_hi = N_PHASES;
  void* args[] = {&p};
  hipError_t e = hipLaunchCooperativeKernel((const void*)mega, dim3(grid), dim3(NTHR), args, SMEM_BYTES, stream);
  if (e != hipSuccess) fprintf(stderr, "cooperative launch failed: %s (grid %d)\n", hipGetErrorString(e), grid);
#endif
}
```

```cpp
#include <hip/hip_runtime.h>
#include <hip/hip_cooperative_groups.h>
#include <stdint.h>
#include <stdio.h>
namespace cg = cooperative_groups;

typedef unsigned short u16;
using bf16x8 = __attribute__((ext_vector_type(8))) short;
using f32x4 = __attribute__((ext_vector_type(4))) float;
using f32x16 = __attribute__((ext_vector_type(16))) float;

#ifndef REP_WHICH
#define REP_WHICH 0
#endif
#ifndef N_LAUNCH_PER_PHASE
#define N_LAUNCH_PER_PHASE 0
#endif

constexpr int TP = 16384, TS = 2048, T = TP + TS, NL = 4;
constexpr int DFF = 2816, DIN = 2208, DINP = 2304, DSH = 1792;
constexpr int NTHR = 512;
constexpr int SMEM_BYTES = 139264 + 2048;
constexpr int SMEM_ITEM = 139264 + 1024;
constexpr float QSCALE = 0.10206207261596577f * 1.4426950408889634f;
constexpr float XSCALE = 0.0625f * 1.4426950408889634f;

constexpr size_t OO_Y = 0;
constexpr size_t OO_CKVP = OO_Y + (size_t)T * 1024;
constexpr size_t OO_KRP = OO_CKVP + (size_t)NL * 4 * 4096 * 128;
constexpr size_t OO_MKP = OO_KRP + (size_t)NL * 4 * 4096 * 32;
constexpr size_t OO_MVP = OO_MKP + (size_t)NL * 4 * 256 * 1024;
constexpr size_t OO_WKVP = OO_MVP + (size_t)NL * 4 * 256 * 1024;
constexpr size_t OO_SHP = OO_WKVP + (size_t)NL * 4 * 8 * 4096;
constexpr size_t OO_CKVS = OO_SHP + (size_t)NL * 4 * DSH;
constexpr size_t OO_KRS = OO_CKVS + (size_t)NL * 32 * 64 * 128;
constexpr size_t OO_WKVS = OO_KRS + (size_t)NL * 32 * 64 * 32;
constexpr size_t OO_SHS = OO_WKVS + (size_t)NL * 32 * 8 * 4096;
constexpr size_t OO_END = OO_SHS + (size_t)NL * 32 * DSH;

constexpr size_t al256(size_t x) { return (x + 255) & ~(size_t)255; }
constexpr size_t W_X = 0;
constexpr size_t W_XB = W_X + al256((size_t)T * 1024 * 4);
constexpr size_t W_SSQ = W_XB + al256((size_t)T * 1024 * 2);
constexpr size_t W_ACT = W_SSQ + al256((size_t)T * 4 * 4);
constexpr size_t W_WB = W_ACT;
constexpr size_t W_BB = W_WB + al256((size_t)T * 512 * 4);
constexpr size_t W_GB = W_BB + al256((size_t)T * 512 * 4);
constexpr size_t W_QX = W_ACT;
constexpr size_t W_PROJ = W_ACT + al256((size_t)T * DFF * 2);
constexpr size_t W_AO = W_PROJ;
constexpr size_t W_CQB = W_PROJ + al256((size_t)T * DINP * 2);
constexpr size_t W_A2 = W_CQB + al256((size_t)T * 256 * 2);
constexpr size_t W_QB = W_A2 + al256((size_t)T * 256 * 2);
constexpr size_t W_XO = W_QB;
constexpr size_t W_RB = W_QB + al256((size_t)T * 1280 * 2);
constexpr size_t W_KB = W_RB + al256((size_t)T * 512 * 4);
constexpr size_t W_VB = W_KB + al256((size_t)T * 512 * 4);
constexpr size_t W_KKB = W_VB + al256((size_t)T * 512 * 4);
constexpr size_t W_KP = W_KKB + al256((size_t)T * 512 * 4);
constexpr size_t W_KS = W_KP + al256((size_t)4 * 4096 * 160 * 2);
constexpr size_t W_VTP = W_KS + al256((size_t)32 * 2112 * 160 * 2);
constexpr size_t W_VTS = W_VTP + al256((size_t)4 * 128 * 4096 * 2);
constexpr size_t W_MKP = W_VTS + al256((size_t)32 * 128 * 2112 * 2);
constexpr size_t W_MVTP = W_MKP + al256((size_t)NL * 16 * 65536 * 2);
constexpr size_t W_MKS = W_MVTP + al256((size_t)NL * 16 * 65536 * 2);
constexpr size_t W_MVTS = W_MKS + al256((size_t)128 * 65536 * 2);
constexpr size_t W_MB = W_MVTS + al256((size_t)128 * 65536 * 2);
constexpr size_t W_ROPE = W_MB + al256((size_t)1024 * 1024 * 2);
constexpr size_t W_CNT = W_ROPE + al256((size_t)4096 * 16 * 8);
constexpr size_t W_YB = W_CNT + 256;
constexpr size_t W_CQ = W_YB + al256((size_t)T * 512 * 4);
constexpr size_t W_WT = W_CQ + al256((size_t)2304 * 4096 * 4);
constexpr size_t W_CRR = W_PROJ + al256((size_t)T * 1536 * 2);
constexpr size_t W_CPT = W_CQB;
static_assert(W_CRR + (size_t)2304 * 4096 * 2 <= W_CQB, "RRt must fit behind AO");
static_assert((size_t)2304 * 4096 * 2 <= 2 * al256((size_t)T * 256 * 2), "Pt must fit in CQB+A2");
constexpr size_t WE_GU1 = 0;
constexpr size_t WE_D1 = WE_GU1 + (size_t)5632 * 1024;
constexpr size_t WE_IN = WE_D1 + (size_t)1024 * DFF;
constexpr size_t WE_Q = WE_IN + (size_t)DINP * 1024;
constexpr size_t WE_RW = WE_Q + (size_t)1280 * 256;
constexpr size_t WE_OUT = WE_RW + (size_t)1536 * 256;
constexpr size_t WE_MQ = WE_OUT + (size_t)1024 * 1536;
constexpr size_t WE_MK = WE_MQ + (size_t)1024 * 1024;
constexpr size_t WE_MV = WE_MK + (size_t)1024 * 1024;
constexpr size_t WE_MO = WE_MV + (size_t)1024 * 1024;
constexpr size_t WE_GU2 = WE_MO + (size_t)1024 * 1024;
constexpr size_t WE_D2 = WE_GU2 + (size_t)5632 * 1024;
constexpr size_t WE_LAYER = WE_D2 + (size_t)1024 * DFF;
constexpr size_t W_END = W_WT + al256(WE_LAYER * NL * 2);

enum { I_XP = 0, I_XS, I_MEMP, I_CCKV, I_CKR, I_CMK, I_CMV, I_SWKV, I_SSH, I_F1N, I_F1G, I_F1U, I_F1D, I_MIXN, I_WIN,
       I_QN, I_WUQ, I_KVN, I_WUK, I_WUV, I_MU, I_W0, I_WUP, I_A0, I_AUP, I_GUP, I_KK, I_KA, I_RK, I_GNG, I_GNB, I_WOUT,
       I_XN, I_MKVN, I_WMQ, I_WMK, I_WMV, I_WMO, I_F2N, I_F2G, I_F2U, I_F2D, I_FN, N_IN };

struct Params {
  const float* in[N_IN];
  float* out;
  char* ws;
  int ph_lo, ph_hi;
};

typedef const __attribute__((address_space(4))) Params& KPR;

typedef __bf16 bf2_t __attribute__((ext_vector_type(2)));
typedef float f2_t __attribute__((ext_vector_type(2)));
__device__ __forceinline__ u16 f2bf(float f) { __bf16 b = (__bf16)f; return __builtin_bit_cast(u16, b); }
__device__ __forceinline__ float bf2f(u16 h) { return __uint_as_float(((unsigned)h) << 16); }
__device__ __forceinline__ unsigned pack2(float a, float b) { f2_t v = {a, b}; bf2_t r = __builtin_convertvector(v, bf2_t); return __builtin_bit_cast(unsigned, r); }
__device__ __forceinline__ float wave_sum(float x) {
#pragma unroll
  for (int o = 32; o; o >>= 1) x += __shfl_xor(x, o);
  return x;
}
__device__ __forceinline__ float dpp_sum8(float x) {
  x += __int_as_float(__builtin_amdgcn_update_dpp(0, __float_as_int(x), 0xB1, 0xF, 0xF, false));
  x += __int_as_float(__builtin_amdgcn_update_dpp(0, __float_as_int(x), 0x4E, 0xF, 0xF, false));
  x += __int_as_float(__builtin_amdgcn_update_dpp(0, __float_as_int(x), 0x141, 0xF, 0xF, false));
  return x;
}
__device__ __forceinline__ int tidx() { int t = threadIdx.x; asm volatile("" : "+v"(t)); return t; }
__device__ __forceinline__ float fma_s(float a, float b, float c) { float d; asm("v_fma_f32 %0, %1, %2, %3" : "=v"(d) : "v"(a), "v"(b), "v"(c)); return d; }
__device__ __forceinline__ float sub_s(float a, float b) { float d; asm("v_sub_f32 %0, %1, %2" : "=v"(d) : "v"(a), "v"(b)); return d; }
__device__ __forceinline__ float add_s(float a, float b) { float d; asm("v_add_f32 %0, %1, %2" : "=v"(d) : "v"(a), "v"(b)); return d; }
__device__ __forceinline__ float mul_s(float a, float b) { float d; asm("v_mul_f32 %0, %1, %2" : "=v"(d) : "v"(a), "v"(b)); return d; }
__device__ __forceinline__ float sigmoidf_(float x) { return 1.f / (1.f + __expf(-x)); }

constexpr int BM = 256, BK = 64, HALF = 128, HT = HALF * BK;

__device__ __forceinline__ int lds_byte(int r, int c) {
  int st = (r >> 4) * 2 + (c >> 5), rr = r & 15, cc = c & 31, ob = rr * 64 + cc * 2;
  return st * 1024 + (ob ^ (((ob >> 9) & 1) << 5));
}
__device__ __forceinline__ void stage_rc(int b, int& R, int& C) {
  int st = b / 1024, sb = b % 1024, swz = sb ^ (((sb >> 9) & 1) << 5);
  R = (st >> 1) * 16 + swz / 64; C = (st & 1) * 32 + (swz % 64) / 2;
}

template <class Epi>
__device__ __forceinline__ void gemm_phase(const u16* __restrict__ A, const u16* __restrict__ Bt, const int K,
                                           const int nM, const int nN, const int rot, Epi epi) {
  extern __shared__ __attribute__((aligned(16))) char smem[];
  u16* shm = (u16*)smem;
#define SA(b, h) (shm + ((b) * 2 + (h)) * HT)
#define SB(b, h) (shm + (4 + (b) * 2 + (h)) * HT)
#define STAGE(P, BASE, br, kt) do { const u16* _gb = BASE + ((long)(br) * K + (long)(kt) * BK); \
    __builtin_amdgcn_global_load_lds((const unsigned*)((const char*)_gb + so0), \
        (__attribute__((address_space(3))) unsigned*)((char*)(P) + wu16), 16, 0, 0); \
    __builtin_amdgcn_global_load_lds((const unsigned*)((const char*)_gb + so1), \
        (__attribute__((address_space(3))) unsigned*)((char*)(P) + wu16 + 8192), 16, 0, 0); } while (0)
#define LDA(dst, b, h) for (int m = 0; m < 4; ++m) for (int k = 0; k < 2; ++k) \
    dst[m][k] = *reinterpret_cast<const bf16x8*>((char*)SA(b, h) + lds_byte(wr * 64 + m * 16 + fr, k * 32 + fq * 8))
#define LDB(dst, b, h) for (int n = 0; n < 2; ++n) for (int k = 0; k < 2; ++k) \
    dst[n][k] = *reinterpret_cast<const bf16x8*>((char*)SB(b, h) + lds_byte(wc * 32 + n * 16 + fr, k * 32 + fq * 8))
#define MMA(ai, bj, At_, Bt_) do { __builtin_amdgcn_s_setprio(1); \
    for (int m = 0; m < 4; ++m) for (int n = 0; n < 2; ++n) for (int k = 0; k < 2; ++k) \
      acc[ai][bj][m][n] = __builtin_amdgcn_mfma_f32_16x16x32_bf16(At_[m][k], Bt_[n][k], acc[ai][bj][m][n], 0, 0, 0); \
    __builtin_amdgcn_s_setprio(0); } while (0)
#define WAIT_V(n) asm volatile("s_waitcnt vmcnt(" #n ")" ::: "memory")
#define WAIT_L(n) asm volatile("s_waitcnt lgkmcnt(" #n ")" ::: "memory")
#define BAR __builtin_amdgcn_s_barrier()
#define SCHED __builtin_amdgcn_sched_barrier(0)
  const int G = gridDim.x;
  const int ntiles = nM * nN;
  const int tid_ = tidx();
  const int wid = tid_ >> 6, lane = tid_ & 63, wr = wid >> 2, wc = wid & 3, fr = lane & 15, fq = lane >> 4;
  const int nt = K / BK;
  const int wu16 = __builtin_amdgcn_readfirstlane(tid_ >> 6) * 1024;
  for (int tile = (int)((blockIdx.x + G - (rot % G)) % G); tile < ntiles; tile += G) {
    int wgid = tile;
    unsigned so0, so1;
    { int t2 = tid_; asm volatile("" : "+v"(t2)); int _r, _c; stage_rc(t2 * 16, _r, _c); so0 = (unsigned)(_r * K + _c) * 2u;
      stage_rc(t2 * 16 + 8192, _r, _c); so1 = (unsigned)(_r * K + _c) * 2u; }
    { int q = ntiles / 8, r = ntiles % 8, xcd = wgid % 8, off = wgid / 8;
      wgid = (xcd < r ? xcd * (q + 1) : r * (q + 1) + (xcd - r) * q) + off; }
    int nig = 8 * nN, gid = wgid / nig, fm = gid * 8, gsz = min(nM - fm, 8);
    int pm = fm + ((wgid % nig) % gsz), pn = (wgid % nig) / gsz, brow = pm * BM, bcol = pn * BM;
    f32x4 acc[2][2][4][2] = {};
    bf16x8 At[4][2], B0[2][2], B1[2][2];
    STAGE(SB(0, 0), Bt, bcol, 0); STAGE(SA(0, 0), A, brow, 0);
    STAGE(SB(0, 1), Bt, bcol + HALF, 0); STAGE(SA(0, 1), A, brow + HALF, 0);
    if (wr == 1) BAR;
    WAIT_V(4); BAR;
    STAGE(SB(1, 0), Bt, bcol, 1); STAGE(SA(1, 0), A, brow, 1); STAGE(SB(1, 1), Bt, bcol + HALF, 1);
    WAIT_V(6); BAR;
    for (int t = 0; t < nt - 2; t += 2) {
      LDB(B0, 0, 0); SCHED; LDA(At, 0, 0); STAGE(SA(1, 1), A, brow + HALF, t + 1);
      WAIT_L(8); BAR; WAIT_L(0); MMA(0, 0, At, B0); BAR; SCHED;
      LDB(B1, 0, 1); STAGE(SB(0, 0), Bt, bcol, t + 2);
      BAR; WAIT_L(0); MMA(0, 1, At, B1); BAR;
      LDA(At, 0, 1); STAGE(SA(0, 0), A, brow, t + 2);
      BAR; WAIT_L(0); MMA(1, 0, At, B0); BAR; SCHED;
      STAGE(SB(0, 1), Bt, bcol + HALF, t + 2);
      WAIT_V(6); BAR; MMA(1, 1, At, B1); BAR;
      LDB(B0, 1, 0); SCHED; LDA(At, 1, 0); STAGE(SA(0, 1), A, brow + HALF, t + 2);
      WAIT_L(8); BAR; WAIT_L(0); MMA(0, 0, At, B0); BAR; SCHED;
      LDB(B1, 1, 1); STAGE(SB(1, 0), Bt, bcol, t + 3);
      BAR; WAIT_L(0); MMA(0, 1, At, B1); BAR;
      LDA(At, 1, 1); STAGE(SA(1, 0), A, brow, t + 3);
      BAR; WAIT_L(0); MMA(1, 0, At, B0); BAR; SCHED;
      STAGE(SB(1, 1), Bt, bcol + HALF, t + 3);
      WAIT_V(6); BAR; MMA(1, 1, At, B1); BAR;
    }
    { LDB(B0, 0, 0); LDA(At, 0, 0); STAGE(SA(1, 1), A, brow + HALF, nt - 1);
      BAR; WAIT_L(0); MMA(0, 0, At, B0); BAR;
      LDB(B1, 0, 1); BAR; WAIT_L(0); MMA(0, 1, At, B1); BAR;
      LDA(At, 0, 1); WAIT_V(4); BAR; WAIT_L(0); MMA(1, 0, At, B0); MMA(1, 1, At, B1); BAR; }
    { LDB(B0, 1, 0); LDA(At, 1, 0); WAIT_V(2); BAR; WAIT_L(0); MMA(0, 0, At, B0); BAR;
      LDB(B1, 1, 1); WAIT_V(0); BAR; WAIT_L(0); MMA(0, 1, At, B1); BAR;
      LDA(At, 1, 1); BAR; WAIT_L(0); MMA(1, 0, At, B0); MMA(1, 1, At, B1); BAR; }
    if (wr == 0) BAR;
    float* stg = (float*)smem;
    int tx = tid_;
    asm volatile("" : "+v"(tx));
    const int ewr = tx >> 8, ewc = (tx >> 6) & 3, efr = tx & 15, efq = (tx >> 4) & 3;
#define EPI_HALF(ai) do { \
    __syncthreads(); \
    _Pragma("unroll") for (int bj = 0; bj < 2; ++bj) _Pragma("unroll") for (int m = 0; m < 4; ++m) \
    _Pragma("unroll") for (int n = 0; n < 2; ++n) _Pragma("unroll") for (int j = 0; j < 4; ++j) \
      stg[(ewr * 64 + m * 16 + efq * 4 + j) * 260 + bj * HALF + ewc * 32 + n * 16 + efr] = acc[ai][bj][m][n][j]; \
    __syncthreads(); \
    for (int i = 0; i < 8; ++i) { \
      int item = i * NTHR + tx; int rl = item >> 5, qp = item & 31; \
      int cl = (qp >> 2) * 32 + (qp & 3) * 4; \
      float4 v0 = *(const float4*)(stg + rl * 260 + cl), v1 = *(const float4*)(stg + rl * 260 + cl + 16); \
      int row = brow + ai * HALF + rl; \
      float ss = epi.apply4(row, bcol + cl, v0, v1); \
      if (Epi::kSsq) { \
        ss += __shfl_xor(ss, 1); ss += __shfl_xor(ss, 2); ss += __shfl_xor(ss, 4); ss += __shfl_xor(ss, 8); ss += __shfl_xor(ss, 16); \
        if (qp == 0) epi.ssq_out(row, pn, ss); \
      } \
    } } while (0)
    EPI_HALF(0);
    EPI_HALF(1);
#undef EPI_HALF
    __syncthreads();
  }
#undef SA
#undef SB
#undef STAGE
#undef LDA
#undef LDB
#undef MMA
}

__device__ __forceinline__ float rstd_from_ssq(const float* ssq, int row) {
  float4 s = *(const float4*)(ssq + (size_t)row * 4);
  return rsqrtf((s.x + s.y + s.z + s.w) * (1.f / 1024.f) + 1e-6f);
}
__device__ __forceinline__ uint2 pack4(float4 v) { uint2 w; w.x = pack2(v.x, v.y); w.y = pack2(v.z, v.w); return w; }
__device__ __forceinline__ float silu_mul(float g, float u) { return g / (1.f + __expf(-g)) * u; }
struct EpiGU {
  static constexpr bool kSsq = false;
  const float* ssq; u16* act;
  __device__ __forceinline__ float apply4(int row, int c0, float4 g, float4 u) const {
    float rs = rstd_from_ssq(ssq, row);
    float4 o = make_float4(silu_mul(g.x * rs, u.x * rs), silu_mul(g.y * rs, u.y * rs), silu_mul(g.z * rs, u.z * rs), silu_mul(g.w * rs, u.w * rs));
    *(uint2*)(act + (size_t)row * DFF + ((c0 & ~31) >> 1) + (c0 & 15)) = pack4(o);
    return 0.f;
  }
  __device__ __forceinline__ void ssq_out(int, int, float) const {}
};
struct EpiRes {
  static constexpr bool kSsq = true;
  float* x; u16* xb; float* ssq; float coef;
  __device__ __forceinline__ float apply4(int row, int c0, float4 v0, float4 v1) const {
    size_t i = (size_t)row * 1024 + c0;
    float4 a = *(const float4*)(x + i), b = *(const float4*)(x + i + 16);
    a.x += coef * v0.x; a.y += coef * v0.y; a.z += coef * v0.z; a.w += coef * v0.w;
    b.x += coef * v1.x; b.y += coef * v1.y; b.z += coef * v1.z; b.w += coef * v1.w;
    *(float4*)(x + i) = a; *(float4*)(x + i + 16) = b;
    *(uint2*)(xb + i) = pack4(a); *(uint2*)(xb + i + 16) = pack4(b);
    return a.x * a.x + a.y * a.y + a.z * a.z + a.w * a.w + b.x * b.x + b.y * b.y + b.z * b.z + b.w * b.w;
  }
  __device__ __forceinline__ void ssq_out(int row, int pn, float v) const { ssq[(size_t)row * 4 + pn] = v; }
};
struct EpiScaleBf {
  static constexpr bool kSsq = false;
  const float* ssq; u16* o; int ld;
  __device__ __forceinline__ float apply4(int row, int c0, float4 v0, float4 v1) const {
    float rs = rstd_from_ssq(ssq, row);
    size_t i = (size_t)row * ld + c0;
    *(uint2*)(o + i) = pack4(make_float4(v0.x * rs, v0.y * rs, v0.z * rs, v0.w * rs));
    *(uint2*)(o + i + 16) = pack4(make_float4(v1.x * rs, v1.y * rs, v1.z * rs, v1.w * rs));
    return 0.f;
  }
  __device__ __forceinline__ void ssq_out(int, int, float) const {}
};
struct EpiQ {
  static constexpr bool kSsq = false;
  u16* qb; const float2* rope;
  __device__ __forceinline__ float apply4(int row, int c0, float4 v0, float4 v1) const {
    if (c0 < 1024) {
      size_t i = (size_t)row * 1280 + (c0 >> 7) * 160 + (c0 & 127);
      *(uint2*)(qb + i) = pack4(v0); *(uint2*)(qb + i + 16) = pack4(v1);
    } else {
      int h = (c0 - 1024) >> 5, f0 = c0 & 15;
      int pos = row < TP ? (row & 4095) : (2048 + ((row - TP) & 63));
      const float2* cs = rope + pos * 16 + f0;
      float2 c_0 = cs[0], c_1 = cs[1], c_2 = cs[2], c_3 = cs[3];
      size_t i = (size_t)row * 1280 + h * 160 + 128 + f0;
      *(uint2*)(qb + i) = pack4(make_float4(v0.x * c_0.x - v1.x * c_0.y, v0.y * c_1.x - v1.y * c_1.y, v0.z * c_2.x - v1.z * c_2.y, v0.w * c_3.x - v1.w * c_3.y));
      *(uint2*)(qb + i + 16) = pack4(make_float4(v0.x * c_0.y + v1.x * c_0.x, v0.y * c_1.y + v1.y * c_1.x, v0.z * c_2.y + v1.z * c_2.x, v0.w * c_3.y + v1.w * c_3.x));
    }
    return 0.f;
  }
  __device__ __forceinline__ void ssq_out(int, int, float) const {}
};
__device__ __forceinline__ float decay_f(float z) {
  float nz = -z;
  float sp = fmaxf(nz, 0.f) + __logf(1.f + __expf(-fabsf(nz)));
  return __expf(-__expf(-sp - 0.5f));
}
struct EpiRW {
  static constexpr bool kSsq = false;
  const float* w0; const float* a0; const float* ka; char* ws;
  __device__ __forceinline__ void acol(size_t i, int c, float4 v) const {
    float* bb = (float*)(ws + W_BB); float* kb = (float*)(ws + W_KB); const float* kkb = (const float*)(ws + W_KKB);
    float4 a_0 = *(const float4*)(a0 + c), k_a = *(const float4*)(ka + c), kk = *(const float4*)(kkb + i), k = *(const float4*)(kb + i);
    float4 a = make_float4(sigmoidf_(a_0.x + v.x), sigmoidf_(a_0.y + v.y), sigmoidf_(a_0.z + v.z), sigmoidf_(a_0.w + v.w));
    *(float4*)(bb + i) = make_float4(kk.x * a.x, kk.y * a.y, kk.z * a.z, kk.w * a.w);
    *(float4*)(kb + i) = make_float4(k.x * (1.f + (a.x - 1.f) * k_a.x), k.y * (1.f + (a.y - 1.f) * k_a.y), k.z * (1.f + (a.z - 1.f) * k_a.z), k.w * (1.f + (a.w - 1.f) * k_a.w));
  }
  __device__ __forceinline__ float apply4(int row, int c0, float4 v0, float4 v1) const {
    if (c0 < 512) {
      float* wb = (float*)(ws + W_WB);
      float4 z0 = *(const float4*)(w0 + c0), z1 = *(const float4*)(w0 + c0 + 16);
      size_t i = (size_t)row * 512 + c0;
      *(float4*)(wb + i) = make_float4(decay_f(z0.x + v0.x), decay_f(z0.y + v0.y), decay_f(z0.z + v0.z), decay_f(z0.w + v0.w));
      *(float4*)(wb + i + 16) = make_float4(decay_f(z1.x + v1.x), decay_f(z1.y + v1.y), decay_f(z1.z + v1.z), decay_f(z1.w + v1.w));
    } else if (c0 < 1024) {
      int c = c0 - 512; size_t i = (size_t)row * 512 + c;
      acol(i, c, v0); acol(i + 16, c + 16, v1);
    } else {
      u16* gb = (u16*)(ws + W_GB);
      size_t i = (size_t)row * 512 + (c0 - 1024);
      *(uint2*)(gb + i) = pack4(v0); *(uint2*)(gb + i + 16) = pack4(v1);
    }
    return 0.f;
  }
  __device__ __forceinline__ void ssq_out(int, int, float) const {}
};
template <bool ISV>
struct EpiMem {
  static constexpr bool kSsq = false;
  float* of; u16* ob;
  __device__ __forceinline__ void quad(int row, int col, float4 v) const {
    *(float4*)(of + (size_t)row * 1024 + col) = v;
    int b = row >> 8, m = row & 255, h = col >> 8, d = col & 255;
    if (ISV) {
      u16* o = ob + (size_t)((b * 4 + h) * 256 + d) * 256 + m;
      o[0] = f2bf(v.x); o[256] = f2bf(v.y); o[512] = f2bf(v.z); o[768] = f2bf(v.w);
    } else {
      *(uint2*)(ob + (size_t)((b * 4 + h) * 256 + m) * 256 + d) = pack4(v);
    }
  }
  __device__ __forceinline__ float apply4(int row, int c0, float4 v0, float4 v1) const {
    quad(row, c0, v0); quad(row, c0 + 16, v1);
    return 0.f;
  }
  __device__ __forceinline__ void ssq_out(int, int, float) const {}
};

template <class F>
__device__ __forceinline__ void tconv(u16* dst, int ldd, int N, int K, int rot, F f) {
  extern __shared__ __attribute__((aligned(16))) char smem[];
  float* t = (float*)smem;
  const int nk = K / 64, nt = (N / 64) * nk, G = gridDim.x;
  const int tid = tidx(), a = tid >> 6, c = tid & 63;
  for (int tile = (int)((blockIdx.x + G - (rot % G)) % G); tile < nt; tile += G) {
    int n0 = (tile / nk) * 64, k0 = (tile % nk) * 64;
    __syncthreads();
#pragma unroll
    for (int i = 0; i < 8; ++i) { int kk = a + 8 * i; t[kk * 65 + c] = f(k0 + kk, n0 + c); }
    __syncthreads();
#pragma unroll
    for (int i = 0; i < 8; ++i) { int nn = a + 8 * i; dst[(size_t)(n0 + nn) * ldd + k0 + c] = f2bf(t[c * 65 + nn]); }
  }
}

template <class F>
__device__ __forceinline__ void tconv_v(u16* dst, int ldd, int N, int K, int vb, int nvb, F f) {
  extern __shared__ __attribute__((aligned(16))) char smem[];
  float* t = (float*)smem;
  const int nk = K / 64, nt = (N / 64) * nk;
  const int tid = tidx(), a = tid >> 6, c = tid & 63;
  for (int tile = vb; tile < nt; tile += nvb) {
    int n0 = (tile / nk) * 64, k0 = (tile % nk) * 64;
    __syncthreads();
#pragma unroll
    for (int i = 0; i < 8; ++i) { int kk = a + 8 * i; t[kk * 65 + c] = f(k0 + kk, n0 + c); }
    __syncthreads();
#pragma unroll
    for (int i = 0; i < 8; ++i) { int nn = a + 8 * i; dst[(size_t)(n0 + nn) * ldd + k0 + c] = f2bf(t[c * 65 + nn]); }
  }
  __syncthreads();
}

template <int DK, int DV, int RPG>
__device__ __forceinline__ void attn_item(const u16* __restrict__ Qb, int ldq, int nrows, const u16* __restrict__ Kb, int ldk,
                                          const u16* __restrict__ Vtb, int ldvt, int nkeys, u16* __restrict__ Ob, int ldo) {
  extern __shared__ __attribute__((aligned(16))) char smem[];
  constexpr int KS = DK + 8, VS = 68;
  u16* sK = (u16*)smem;
  u16* sV = sK + 64 * KS;
  const int tid = tidx(), wid = tid >> 6, lane = tid & 63, q = lane & 31, hh = lane >> 5;
  const int row = wid * 32 + q;
  const bool active = (wid * 32) < nrows;
  bf16x8 qf[DK / 16];
  if (active) {
#pragma unroll
    for (int ks = 0; ks < DK / 16; ++ks) qf[ks] = *(const bf16x8*)(Qb + (size_t)row * ldq + ks * 16 + hh * 8);
  }
  f32x16 o[DV / 32];
#pragma unroll
  for (int dt = 0; dt < DV / 32; ++dt)
#pragma unroll
    for (int i = 0; i < 16; ++i) o[dt][i] = 0.f;
  float mrun = -1e30f, lrun = 0.f;
  const int nkt = nkeys >> 6;
  constexpr int KCH = (64 * (DK / 8) + NTHR - 1) / NTHR;
  static_assert(DV == 128 && KCH <= 4, "staging registers are written out by hand");
  uint4 kr0, kr1, kr2, kr3, vr0, vr1;
#define AT_KL(N_, kt_) { const int c = tid + N_ * NTHR; if (N_ < KCH && c < 64 * (DK / 8)) { const int r = c / (DK / 8), cc = c % (DK / 8); \
      kr##N_ = *(const uint4*)(Kb + (size_t)((kt_) * 64 + r) * ldk + cc * 8); } }
#define AT_VL(N_, kt_) { const int c = tid + N_ * NTHR; const int r = c >> 3, cc = c & 7; vr##N_ = *(const uint4*)(Vtb + (size_t)r * ldvt + (kt_) * 64 + cc * 8); }
#define AT_GLOAD(kt_) do { AT_KL(0, kt_) AT_KL(1, kt_) AT_KL(2, kt_) AT_KL(3, kt_) AT_VL(0, kt_) AT_VL(1, kt_) } while (0)
#define AT_KS(N_) { const int c = tid + N_ * NTHR; if (N_ < KCH && c < 64 * (DK / 8)) { const int r = c / (DK / 8), cc = c % (DK / 8); *(uint4*)(sK + r * KS + cc * 8) = kr##N_; } }
#define AT_VS(N_) { const int c = tid + N_ * NTHR; const int r = c >> 3, cc = c & 7; uint2* d = (uint2*)(sV + r * VS + cc * 8); \
      const uint4 t_ = vr##N_; d[0] = make_uint2(t_.x, t_.y); d[1] = make_uint2(t_.z, t_.w); }
  AT_GLOAD(0);
  for (int kt = 0; kt < nkt; ++kt) {
    __syncthreads();
    AT_KS(0) AT_KS(1) AT_KS(2) AT_KS(3) AT_VS(0) AT_VS(1)
    __syncthreads();
    if (kt + 1 < nkt) AT_GLOAD(kt + 1);
    if (active) {
      f32x16 s0, s1;
#pragma unroll
      for (int i = 0; i < 16; ++i) { s0[i] = 0.f; s1[i] = 0.f; }
#pragma unroll
      for (int ks = 0; ks < DK / 16; ++ks) {
        bf16x8 a0 = *(const bf16x8*)(sK + q * KS + ks * 16 + hh * 8);
        bf16x8 a1 = *(const bf16x8*)(sK + (32 + q) * KS + ks * 16 + hh * 8);
        s0 = __builtin_amdgcn_mfma_f32_32x32x16_bf16(a0, qf[ks], s0, 0, 0, 0);
        s1 = __builtin_amdgcn_mfma_f32_32x32x16_bf16(a1, qf[ks], s1, 0, 0, 0);
      }
      float mx = s0[0];
#pragma unroll
      for (int i = 1; i < 16; ++i) mx = fmaxf(mx, s0[i]);
#pragma unroll
      for (int i = 0; i < 16; ++i) mx = fmaxf(mx, s1[i]);
      mx = fmaxf(mx, __shfl_xor(mx, 32));
      float mn = fmaxf(mrun, mx);
      float alpha = __builtin_amdgcn_exp2f(mrun - mn);
      mrun = mn;
      float ps = 0.f;
#pragma unroll
      for (int i = 0; i < 16; ++i) { s0[i] = __builtin_amdgcn_exp2f(sub_s(s0[i], mn)); ps = add_s(ps, s0[i]); }
#pragma unroll
      for (int i = 0; i < 16; ++i) { s1[i] = __builtin_amdgcn_exp2f(sub_s(s1[i], mn)); ps = add_s(ps, s1[i]); }
      lrun = lrun * alpha + ps;
#pragma unroll
      for (int dt = 0; dt < DV / 32; ++dt)
#pragma unroll
        for (int i = 0; i < 16; ++i) o[dt][i] = mul_s(o[dt][i], alpha);
#pragma unroll
      for (int kb = 0; kb < 2; ++kb)
#pragma unroll
        for (int s = 0; s < 2; ++s) {
          union { bf16x8 v; unsigned u[4]; } pf;
#pragma unroll
          for (int jj = 0; jj < 4; ++jj) {
            float e0 = kb ? s1[8 * s + 2 * jj] : s0[8 * s + 2 * jj];
            float e1 = kb ? s1[8 * s + 2 * jj + 1] : s0[8 * s + 2 * jj + 1];
            pf.u[jj] = pack2(e0, e1);
          }
          const int kbase = kb * 32 + s * 16 + 4 * hh;
#pragma unroll
          for (int dt = 0; dt < DV / 32; ++dt) {
            const u16* vp = sV + (dt * 32 + q) * VS + kbase;
            union { bf16x8 v; uint2 u[2]; } vf;
            vf.u[0] = *(const uint2*)vp; vf.u[1] = *(const uint2*)(vp + 8);
            o[dt] = __builtin_amdgcn_mfma_f32_32x32x16_bf16(vf.v, pf.v, o[dt], 0, 0, 0);
          }
        }
    }
  }
  if (active) {
    lrun += __shfl_xor(lrun, 32);
    float inv = 1.f / lrun;
    u16* op = Ob + (size_t)(row / RPG) * ldo + (size_t)(row % RPG) * DV;
#pragma unroll
    for (int dt = 0; dt < DV / 32; ++dt)
#pragma unroll
      for (int g = 0; g < 4; ++g) {
        uint2 w;
        w.x = pack2(o[dt][4 * g] * inv, o[dt][4 * g + 1] * inv);
        w.y = pack2(o[dt][4 * g + 2] * inv, o[dt][4 * g + 3] * inv);
        *(uint2*)(op + dt * 32 + 8 * g + 4 * hh) = w;
      }
  }
}

#undef AT_GLOAD
#undef AT_KL
#undef AT_VL
#undef AT_KS
#undef AT_VS
__device__ __forceinline__ float dpp_sum16(float x) {
  x += __int_as_float(__builtin_amdgcn_update_dpp(0, __float_as_int(x), 0xB1, 0xF, 0xF, false));
  x += __int_as_float(__builtin_amdgcn_update_dpp(0, __float_as_int(x), 0x4E, 0xF, 0xF, false));
  x += __int_as_float(__builtin_amdgcn_update_dpp(0, __float_as_int(x), 0x141, 0xF, 0xF, false));
  x += __int_as_float(__builtin_amdgcn_update_dpp(0, __float_as_int(x), 0x140, 0xF, 0xF, false));
  return x;
}
__device__ __forceinline__ void scan_item(KPR p, int l, int g0, int h, int half, int nsteps, const float* S0, float* Sout) {
  extern __shared__ __attribute__((aligned(16))) char smem[];
  float* sT = (float*)smem;
  float* sV = sT + 5 * 4096;
  const float* src0 = (const float*)(p.ws + W_RB) + h * 64; const float* src1 = (const float*)(p.ws + W_WB) + h * 64;
  const float* src2 = (const float*)(p.ws + W_KB) + h * 64; const float* src3 = (const float*)(p.ws + W_KKB) + h * 64;
  const float* src4 = (const float*)(p.ws + W_BB) + h * 64;
  const float* VB = (const float*)(p.ws + W_VB) + h * 64 + half * 32;
  float* YB = (float*)(p.ws + W_YB) + h * 64 + half * 32;
  const int tid = tidx();
  const int il = tid >> 4, sub = tid & 15, j0 = sub * 4, i = half * 32 + il;
  float s[4];
#pragma unroll
  for (int j = 0; j < 4; ++j) s[j] = S0 ? S0[i * 64 + j0 + j] : 0.f;
  float4 pa0, pa1, pa2, pa3, pa4, pb0, pb1, pb2, pb3, pb4, pfv;
  const int e0 = tid, e1 = tid + NTHR;
  const int st0 = e0 >> 4, c40 = (e0 & 15) * 4, st1 = e1 >> 4, c41 = (e1 & 15) * 4;
  const int stv = tid >> 3, c4v = (tid & 7) * 4;
#define SC_GL1(x, c0_) pa##x = *(const float4*)(src##x + (size_t)(g0 + (c0_) + st0) * 512 + c40); \
                       pb##x = *(const float4*)(src##x + (size_t)(g0 + (c0_) + st1) * 512 + c41);
#define SC_GLOAD(c0_) do { SC_GL1(0, c0_) SC_GL1(1, c0_) SC_GL1(2, c0_) SC_GL1(3, c0_) SC_GL1(4, c0_) \
    pfv = *(const float4*)(VB + (size_t)(g0 + (c0_) + stv) * 512 + c4v); } while (0)
#define SC_ST1(x) *(float4*)(sT + x * 4096 + st0 * 64 + c40) = pa##x; *(float4*)(sT + x * 4096 + st1 * 64 + c41) = pb##x;
  SC_GLOAD(0);
  for (int c0 = 0; c0 < nsteps; c0 += 64) {
    __syncthreads();
    SC_ST1(0) SC_ST1(1) SC_ST1(2) SC_ST1(3) SC_ST1(4)
    *(float4*)(sV + stv * 32 + c4v) = pfv;
    __syncthreads();
    if (c0 + 64 < nsteps) SC_GLOAD(c0 + 64);
#define SC_LD(S, st_) do { const int _s = (st_) < 64 ? (st_) : 63; \
      S##r = *(const float4*)(sT + _s * 64 + j0); S##w = *(const float4*)(sT + 4096 + _s * 64 + j0); \
      S##k = *(const float4*)(sT + 8192 + _s * 64 + j0); S##q = *(const float4*)(sT + 12288 + _s * 64 + j0); \
      S##b = *(const float4*)(sT + 16384 + _s * 64 + j0); S##v = sV[_s * 32 + il]; } while (0)
#define SC_STEP(S, st_) do { \
      float sa = -dpp_sum16(fma_s(s[1], S##q.y, mul_s(s[0], S##q.x)) + fma_s(s[3], S##q.w, mul_s(s[2], S##q.z))); \
      s[0] = fma_s(sa, S##b.x, fma_s(s[0], S##w.x, mul_s(S##v, S##k.x))); \
      s[1] = fma_s(sa, S##b.y, fma_s(s[1], S##w.y, mul_s(S##v, S##k.y))); \
      s[2] = fma_s(sa, S##b.z, fma_s(s[2], S##w.z, mul_s(S##v, S##k.z))); \
      s[3] = fma_s(sa, S##b.w, fma_s(s[3], S##w.w, mul_s(S##v, S##k.w))); \
      float y = dpp_sum16(fma_s(s[1], S##r.y, mul_s(s[0], S##r.x)) + fma_s(s[3], S##r.w, mul_s(s[2], S##r.z))); \
      ykeep = (sub == ((st_) & 15)) ? y : ykeep; } while (0)
    float4 Ar, Aw, Ak, Aq, Ab, Br, Bw, Bk, Bq, Bb, Cr, Cw, Ck, Cq, Cb, Dr, Dw, Dk, Dq, Db;
    float Av, Bv, Cv, Dv, ykeep = 0.f;
    SC_LD(A, 0); SC_LD(B, 1); SC_LD(C, 2);
    for (int st = 0; st < 64; st += 4) {
      SC_LD(D, st + 3); SC_STEP(A, st);
      SC_LD(A, st + 4); SC_STEP(B, st + 1);
      SC_LD(B, st + 5); SC_STEP(C, st + 2);
      SC_LD(C, st + 6); SC_STEP(D, st + 3);
      if ((st & 15) == 12) YB[(size_t)(g0 + c0 + (st - 12) + sub) * 512 + il] = ykeep;
    }
  }
#undef SC_LD
#undef SC_STEP
#undef SC_GLOAD
#undef SC_GL1
#undef SC_ST1
  *(float4*)(Sout + i * 64 + j0) = make_float4(s[0], s[1], s[2], s[3]);
}

constexpr int LS = 68;
constexpr int LBUF = 64 * LS;
constexpr int LH = 72;

__device__ __forceinline__ void split8(const float* x, bf16x8& hi, bf16x8& lo) {
  union { bf16x8 v; unsigned u[4]; } H, Lo;
#pragma unroll
  for (int j = 0; j < 4; ++j) {
    const unsigned h = pack2(x[2 * j], x[2 * j + 1]);
    H.u[j] = h;
    Lo.u[j] = pack2(x[2 * j] - __uint_as_float(h << 16), x[2 * j + 1] - __uint_as_float(h & 0xffff0000u));
  }
  hi = H.v; lo = Lo.v;
}
template <int AM, int AK, int BKS, int BN>
__device__ __forceinline__ void mm64(const float* A, const float* B, f32x4 (&acc)[2], int m0, int n0, int lane) {
  const int lr = lane & 15, lq = lane >> 4;
#pragma unroll
  for (int ks = 0; ks < 2; ++ks) {
    const int k0 = ks * 32 + lq * 8;
    float a[8];
    if (AK == 1) {
      float4 x0 = *(const float4*)(A + (m0 + lr) * AM + k0), x1 = *(const float4*)(A + (m0 + lr) * AM + k0 + 4);
      a[0] = x0.x; a[1] = x0.y; a[2] = x0.z; a[3] = x0.w; a[4] = x1.x; a[5] = x1.y; a[6] = x1.z; a[7] = x1.w;
    } else {
#pragma unroll
      for (int j = 0; j < 8; ++j) a[j] = A[(m0 + lr) * AM + (k0 + j) * AK];
    }
    bf16x8 ah, al; split8(a, ah, al);
#pragma unroll
    for (int nt = 0; nt < 2; ++nt) {
      const int n = n0 + nt * 16 + lr;
      float b[8];
      if (BKS == 1) {
        float4 x0 = *(const float4*)(B + n * BN + k0), x1 = *(const float4*)(B + n * BN + k0 + 4);
        b[0] = x0.x; b[1] = x0.y; b[2] = x0.z; b[3] = x0.w; b[4] = x1.x; b[5] = x1.y; b[6] = x1.z; b[7] = x1.w;
      } else {
#pragma unroll
        for (int j = 0; j < 8; ++j) b[j] = B[(k0 + j) * BKS + n * BN];
      }
      bf16x8 bh, bl; split8(b, bh, bl);
      acc[nt] = __builtin_amdgcn_mfma_f32_16x16x32_bf16(ah, bh, acc[nt], 0, 0, 0);
      acc[nt] = __builtin_amdgcn_mfma_f32_16x16x32_bf16(ah, bl, acc[nt], 0, 0, 0);
      acc[nt] = __builtin_amdgcn_mfma_f32_16x16x32_bf16(al, bh, acc[nt], 0, 0, 0);
    }
  }
}
#define MM_ZERO(acc) do { acc[0] = f32x4{0.f, 0.f, 0.f, 0.f}; acc[1] = f32x4{0.f, 0.f, 0.f, 0.f}; } while (0)
#define MM_FOREACH(acc, BODY) do { _Pragma("unroll") for (int nt_ = 0; nt_ < 2; ++nt_) _Pragma("unroll") for (int rg_ = 0; rg_ < 4; ++rg_) { \
    const int m = m0 + lq * 4 + rg_, n = n0 + nt_ * 16 + lr; const float val = acc[nt_][rg_]; BODY } } while (0)

__device__ __forceinline__ void cprep_item(KPR p, int grow0, int h, int cid) {
  extern __shared__ __attribute__((aligned(16))) char smem[];
  float* B0 = (float*)smem; float* B1 = B0 + LBUF; float* B2 = B1 + LBUF; float* B3 = B2 + LBUF;
  float* B4 = B3 + LBUF; float* B5 = B4 + LBUF; float* B6 = B5 + LBUF; float* B7 = B6 + LBUF;
  float* wC = (float*)(smem + 139264);
  const int tid = tidx(), wid = tid >> 6, lane = tid & 63, lr = lane & 15, lq = lane >> 4;
  const int m0 = (wid >> 1) * 16, n0 = (wid & 1) * 32;
  const float* WB = (const float*)(p.ws + W_WB) + h * 64; const float* KKB = (const float*)(p.ws + W_KKB) + h * 64;
  const float* BB = (const float*)(p.ws + W_BB) + h * 64; const float* KB = (const float*)(p.ws + W_KB) + h * 64;
  const float* RB = (const float*)(p.ws + W_RB) + h * 64; const float* VB = (const float*)(p.ws + W_VB) + h * 64;
  f32x4 acc[2];
  __syncthreads();
#pragma unroll
  for (int q = 0; q < 2; ++q) {
    const int e = tid + q * NTHR, t = e >> 4, c4 = (e & 15) * 4;
    const size_t gi = (size_t)(grow0 + t) * 512 + c4;
    *(float4*)(B0 + t * LS + c4) = *(const float4*)(WB + gi);
    float4 kk = *(const float4*)(KKB + gi);
    *(float4*)(B1 + t * LS + c4) = make_float4(-kk.x, -kk.y, -kk.z, -kk.w);
    *(float4*)(B2 + t * LS + c4) = *(const float4*)(BB + gi);
    *(float4*)(B3 + t * LS + c4) = *(const float4*)(KB + gi);
    *(float4*)(B4 + t * LS + c4) = *(const float4*)(RB + gi);
  }
  __syncthreads();
  {
    const int j = tid & 63, sg = tid >> 6;
    float wv[8];
#pragma unroll
    for (int u = 0; u < 8; ++u) wv[u] = B0[(sg * 8 + u) * LS + j];
#pragma unroll
    for (int u = 1; u < 8; ++u) wv[u] *= wv[u - 1];
    float* segp = B5;
    segp[sg * 64 + j] = wv[7];
    __syncthreads();
    float pre = 1.f;
    for (int u = 0; u < sg; ++u) pre *= segp[u * 64 + j];
#pragma unroll
    for (int u = 0; u < 8; ++u) B0[(sg * 8 + u) * LS + j] = wv[u] * pre;
    if (sg == 7) wC[j] = wv[7] * pre;
  }
  __syncthreads();
  for (int e = tid; e < 4096; e += NTHR) {
    const int t = e >> 6, j = e & 63, o = t * LS + j;
    const float wt = B0[o], wp = t ? B0[o - LS] : 1.f, iw = 1.f / wt;
    B1[o] *= wp; B2[o] *= iw; B3[o] *= iw; B4[o] *= wt;
  }
  __syncthreads();
  MM_ZERO(acc); mm64<LS, 1, 1, LS>(B2, B1, acc, m0, n0, lane);
  MM_FOREACH(acc, { const float v = m < n ? val : 0.f; B5[m * LS + n] = v; B6[m * LS + n] = v + (m == n ? 1.f : 0.f); });
  __syncthreads();
  MM_ZERO(acc); mm64<LS, 1, LS, 1>(B5, B5, acc, m0, n0, lane);
  MM_FOREACH(acc, { B7[m * LS + n] = val; });
  __syncthreads();
  for (int it = 0; it < 5; ++it) {
    MM_ZERO(acc); mm64<LS, 1, LS, 1>(B6, B7, acc, m0, n0, lane);
    f32x4 acc2[2]; MM_ZERO(acc2);
    if (it < 4) mm64<LS, 1, LS, 1>(B7, B7, acc2, m0, n0, lane);
    __syncthreads();
    MM_FOREACH(acc, { B6[m * LS + n] += val; });
    if (it < 4) MM_FOREACH(acc2, { B7[m * LS + n] = val; });
    __syncthreads();
  }
  MM_ZERO(acc); mm64<1, LS, LS, 1>(B1, B6, acc, m0, n0, lane);
  MM_FOREACH(acc, { B5[m * LS + n] = val; });
  MM_ZERO(acc); mm64<LS, 1, 1, LS>(B3, B1, acc, m0, n0, lane);
  MM_FOREACH(acc, { B0[m * LS + n] = m < n ? val : 0.f; });
  __syncthreads();
  MM_ZERO(acc); mm64<LS, 1, LS, 1>(B0, B6, acc, m0, n0, lane);
  MM_FOREACH(acc, { B7[m * LS + n] = val; });
  __syncthreads();
  MM_ZERO(acc); mm64<LS, 1, 1, LS>(B2, B4, acc, m0, n0, lane);
  {
    f32x4 acc2[2]; MM_ZERO(acc2); mm64<LS, 1, 1, LS>(B3, B4, acc2, m0, n0, lane);
    __syncthreads();
    MM_FOREACH(acc, { B0[m * LS + n] = m <= n ? val : 0.f; });
    MM_FOREACH(acc2, { B1[m * LS + n] = m <= n ? val : 0.f; });
  }
  __syncthreads();
  {
    u16* RRT = (u16*)(p.ws + W_CRR) + (size_t)cid * 4096;
    MM_ZERO(acc); mm64<1, LS, 1, LS>(B0, B5, acc, m0, n0, lane);
    MM_FOREACH(acc, { RRT[m * 64 + n] = f2bf(val + B4[m * LS + n]); });
    MM_ZERO(acc); mm64<LS, 1, LS, 1>(B7, B0, acc, m0, n0, lane);
    MM_FOREACH(acc, { B6[m * LS + n] = val + B1[m * LS + n]; });
  }
  __syncthreads();
  for (int e = tid; e < 4096; e += NTHR) {
    const int t = e >> 6, j = e & 63, o = t * LS + j;
    const float wc = wC[j];
    B2[o] *= wc; B3[o] *= wc;
  }
#pragma unroll
  for (int q = 0; q < 2; ++q) {
    const int e = tid + q * NTHR, t = e >> 4, c4 = (e & 15) * 4;
    *(float4*)(B4 + t * LS + c4) = *(const float4*)(VB + (size_t)(grow0 + t) * 512 + c4);
  }
  __syncthreads();
  {
    float* YB = (float*)(p.ws + W_YB) + h * 64;
    MM_ZERO(acc); mm64<1, LS, LS, 1>(B6, B4, acc, m0, n0, lane);
    MM_FOREACH(acc, { YB[(size_t)(grow0 + m) * 512 + n] = val; });
    u16* PT = (u16*)(p.ws + W_CPT) + (size_t)cid * 4096;
    MM_ZERO(acc); mm64<1, LS, 1, LS>(B2, B5, acc, m0, n0, lane);
    MM_FOREACH(acc, { PT[m * 64 + n] = f2bf(val + (m == n ? wC[m] : 0.f)); });
    MM_ZERO(acc); mm64<LS, 1, LS, 1>(B7, B2, acc, m0, n0, lane);
    MM_FOREACH(acc, { B0[m * LS + n] = val + B3[m * LS + n]; });
  }
  __syncthreads();
  {
    float* CQ = (float*)(p.ws + W_CQ) + (size_t)cid * 4096;
    MM_ZERO(acc); mm64<1, LS, LS, 1>(B4, B0, acc, m0, n0, lane);
    MM_FOREACH(acc, { CQ[m * 64 + n] = val; });
  }
}

__device__ __forceinline__ void phase_cprep(KPR p) {
  for (int rr = 0; rr < (REP_WHICH == 10 ? 2 : 1); ++rr)
  for (int id = blockIdx.x; id < 2304; id += gridDim.x) {
    if (id < 2048) { int b = id >> 9, h = (id >> 6) & 7, c = id & 63; cprep_item(p, b * 4096 + c * 64, h, id); }
    else { int k = id - 2048; cprep_item(p, TP + (k >> 3) * 64, k & 7, id); }
  }
}

__device__ __forceinline__ void cseq_item(KPR p, int g0, int h, int nch, int cid0, const float* S0, float* Sout) {
  extern __shared__ __attribute__((aligned(16))) char smem[];
  float* Sf = (float*)smem;
  float* Qf = Sf + LBUF;
  float* Yf = Qf + LBUF;
  u16* Rb = (u16*)(Yf + LBUF);
  u16* Pb = Rb + 64 * LH;
  const int tid = tidx(), wid = tid >> 6, lane = tid & 63, lr = lane & 15, lq = lane >> 4;
  const int m0 = (wid >> 1) * 16, n0 = (wid & 1) * 32;
  float* YB = (float*)(p.ws + W_YB) + h * 64;
  const u16* RRT = (const u16*)(p.ws + W_CRR) + (size_t)cid0 * 4096;
  const u16* PT = (const u16*)(p.ws + W_CPT) + (size_t)cid0 * 4096;
  const float* CQ = (const float*)(p.ws + W_CQ) + (size_t)cid0 * 4096;
  __syncthreads();
  for (int e = tid; e < 4096; e += NTHR) { const int i = e >> 6, j = e & 63; Sf[i * LS + j] = S0 ? S0[e] : 0.f; }
  const int hr = tid >> 3, hc = (tid & 7) * 8;
  const int f0t = tid >> 4, f0c = (tid & 15) * 4;
  uint4 pr, pp; float4 q0, q1, y0, y1;
#define CS_LOAD(c_) do { \
    pr = *(const uint4*)(RRT + (size_t)(c_) * 4096 + hr * 64 + hc); pp = *(const uint4*)(PT + (size_t)(c_) * 4096 + hr * 64 + hc); \
    q0 = *(const float4*)(CQ + (size_t)(c_) * 4096 + f0t * 64 + f0c); q1 = *(const float4*)(CQ + (size_t)(c_) * 4096 + (f0t + 32) * 64 + f0c); \
    y0 = *(const float4*)(YB + (size_t)(g0 + (c_) * 64 + f0t) * 512 + f0c); y1 = *(const float4*)(YB + (size_t)(g0 + (c_) * 64 + f0t + 32) * 512 + f0c); } while (0)
  CS_LOAD(0);
  for (int c = 0; c < nch; ++c) {
    __syncthreads();
    *(uint4*)(Rb + hr * LH + hc) = pr; *(uint4*)(Pb + hr * LH + hc) = pp;
    *(float4*)(Qf + f0t * LS + f0c) = q0; *(float4*)(Qf + (f0t + 32) * LS + f0c) = q1;
    *(float4*)(Yf + f0t * LS + f0c) = y0; *(float4*)(Yf + (f0t + 32) * LS + f0c) = y1;
    __syncthreads();
    if (c + 1 < nch) CS_LOAD(c + 1);
    f32x4 ay[2], as[2]; MM_ZERO(ay); MM_ZERO(as);
#pragma unroll
    for (int ks = 0; ks < 2; ++ks) {
      const int k0 = ks * 32 + lq * 8;
      const bf16x8 ra = *(const bf16x8*)(Rb + (m0 + lr) * LH + k0);
      float sa[8];
      { float4 x0 = *(const float4*)(Sf + (m0 + lr) * LS + k0), x1 = *(const float4*)(Sf + (m0 + lr) * LS + k0 + 4);
        sa[0] = x0.x; sa[1] = x0.y; sa[2] = x0.z; sa[3] = x0.w; sa[4] = x1.x; sa[5] = x1.y; sa[6] = x1.z; sa[7] = x1.w; }
      bf16x8 sah, sal; split8(sa, sah, sal);
#pragma unroll
      for (int nt = 0; nt < 2; ++nt) {
        const int n = n0 + nt * 16 + lr;
        float sb[8];
        { float4 x0 = *(const float4*)(Sf + n * LS + k0), x1 = *(const float4*)(Sf + n * LS + k0 + 4);
          sb[0] = x0.x; sb[1] = x0.y; sb[2] = x0.z; sb[3] = x0.w; sb[4] = x1.x; sb[5] = x1.y; sb[6] = x1.z; sb[7] = x1.w; }
        bf16x8 sbh, sbl; split8(sb, sbh, sbl);
        ay[nt] = __builtin_amdgcn_mfma_f32_16x16x32_bf16(ra, sbh, ay[nt], 0, 0, 0);
        ay[nt] = __builtin_amdgcn_mfma_f32_16x16x32_bf16(ra, sbl, ay[nt], 0, 0, 0);
        const bf16x8 pb = *(const bf16x8*)(Pb + n * LH + k0);
        as[nt] = __builtin_amdgcn_mfma_f32_16x16x32_bf16(sah, pb, as[nt], 0, 0, 0);
        as[nt] = __builtin_amdgcn_mfma_f32_16x16x32_bf16(sal, pb, as[nt], 0, 0, 0);
      }
    }
    MM_FOREACH(ay, { YB[(size_t)(g0 + c * 64 + m) * 512 + n] = val + Yf[m * LS + n]; });
    __syncthreads();
    MM_FOREACH(as, { Sf[m * LS + n] = val + Qf[m * LS + n]; });
  }
#undef CS_LOAD
  __syncthreads();
  for (int e = tid; e < 4096; e += NTHR) { const int i = e >> 6, j = e & 63; Sout[e] = Sf[i * LS + j]; }
}

__device__ __forceinline__ void phase_yfin(KPR p, int l) {
  const int tid = tidx(), wid = tid >> 6, lane = tid & 63;
  const float* YB = (const float*)(p.ws + W_YB); const float* RB = (const float*)(p.ws + W_RB); const float* KB = (const float*)(p.ws + W_KB);
  const float* VB = (const float*)(p.ws + W_VB); const u16* GB = (const u16*)(p.ws + W_GB); u16* AO = (u16*)(p.ws + W_AO);
  const float* rk = p.in[I_RK] + l * 512; const float* gng = p.in[I_GNG] + l * 512; const float* gnb = p.in[I_GNB] + l * 512;
  for (int g = blockIdx.x * 8 + wid; g < T; g += gridDim.x * 8) {
#pragma unroll 2
    for (int h = 0; h < 8; ++h) {
      size_t i = (size_t)g * 512 + h * 64 + lane;
      float y = YB[i];
      float mu = wave_sum(y) * (1.f / 64.f);
      float dlt = y - mu;
      float var = wave_sum(dlt * dlt) * (1.f / 64.f);
      float bon = wave_sum(RB[i] * KB[i] * rk[h * 64 + lane]);
      float v = dlt * rsqrtf(var + 64e-5f) * gng[h * 64 + lane] + gnb[h * 64 + lane] + bon * VB[i];
      AO[(size_t)g * 1536 + 1024 + h * 64 + lane] = f2bf(v * bf2f(GB[i]));
    }
  }
}

__device__ __forceinline__ void phase_init(KPR p) {
  const int G = gridDim.x, tid = tidx(), wid = tid >> 6, lane = tid & 63;
  const int gw = blockIdx.x * 8 + wid, nw = G * 8;
  if (blockIdx.x == 0 && tid < 64) ((int*)(p.ws + W_CNT))[tid] = 0;
  {
    float* X = (float*)(p.ws + W_X); u16* XB = (u16*)(p.ws + W_XB); float* SSQ = (float*)(p.ws + W_SSQ);
    for (int g = gw; g < T; g += nw) {
      const float* src = g < TP ? p.in[I_XP] + (size_t)g * 1024 : p.in[I_XS] + (size_t)(g - TP) * 1024;
      float ss = 0.f;
#pragma unroll
      for (int i = 0; i < 4; ++i) {
        float4 v = *(const float4*)(src + i * 256 + lane * 4);
        *(float4*)(X + (size_t)g * 1024 + i * 256 + lane * 4) = v;
        uint2 w; w.x = pack2(v.x, v.y); w.y = pack2(v.z, v.w);
        *(uint2*)(XB + (size_t)g * 1024 + i * 256 + lane * 4) = w;
        ss += v.x * v.x + v.y * v.y + v.z * v.z + v.w * v.w;
      }
      ss = wave_sum(ss);
      if (lane == 0) *(float4*)(SSQ + (size_t)g * 4) = make_float4(ss, 0.f, 0.f, 0.f);
    }
  }
  {
    u16* MB = (u16*)(p.ws + W_MB);
    for (int g = gw; g < 1024; g += nw) {
      const float* src = p.in[I_MEMP] + (size_t)g * 1024;
      float4 v[4]; float ss = 0.f;
#pragma unroll
      for (int i = 0; i < 4; ++i) { v[i] = *(const float4*)(src + i * 256 + lane * 4); ss += v[i].x * v[i].x + v[i].y * v[i].y + v[i].z * v[i].z + v[i].w * v[i].w; }
      ss = wave_sum(ss);
      float rs = rsqrtf(ss * (1.f / 1024.f) + 1e-6f);
#pragma unroll
      for (int i = 0; i < 4; ++i) {
        uint2 w; w.x = pack2(v[i].x * rs, v[i].y * rs); w.y = pack2(v[i].z * rs, v[i].w * rs);
        *(uint2*)(MB + (size_t)g * 1024 + i * 256 + lane * 4) = w;
      }
    }
  }
  {
    float2* RT = (float2*)(p.ws + W_ROPE);
    for (int e = blockIdx.x * NTHR + tid; e < 4096 * 16; e += G * NTHR) {
      int pos = e >> 4, i = e & 15;
      float inv = powf(10000.f, -(float)i / 16.f);
      float ang = (float)pos * inv;
      float sn, cs; sincosf(ang, &sn, &cs);
      RT[e] = make_float2(cs, sn);
    }
  }
  int rot = 0;
  for (int l = 0; l < NL; ++l) {
    u16* WT = (u16*)(p.ws + W_WT) + (size_t)l * WE_LAYER;
    for (int f = 0; f < 2; ++f) {
      const float* nrm = p.in[f ? I_F2N : I_F1N] + l * 1024;
      const float* wg = p.in[f ? I_F2G : I_F1G] + (size_t)l * 1024 * DFF;
      const float* wu = p.in[f ? I_F2U : I_F1U] + (size_t)l * 1024 * DFF;
      const float* wd = p.in[f ? I_F2D : I_F1D] + (size_t)l * 1024 * DFF;
      tconv(WT + (f ? WE_GU2 : WE_GU1), 1024, 5632, 1024, rot, [=](int k, int n) {
        int j = (n >> 5) * 16 + (n & 15);
        const float* s = ((n >> 4) & 1) ? wu : wg;
        return nrm[k] * s[(size_t)k * DFF + j];
      });
      rot += 88 * 16;
      tconv(WT + (f ? WE_D2 : WE_D1), DFF, 1024, DFF, rot, [=](int k, int n) { return wd[(size_t)k * 1024 + n]; });
      rot += 16 * 44;
    }
    {
      const float* nrm = p.in[I_MIXN] + l * 1024; const float* w = p.in[I_WIN] + (size_t)l * 1024 * DIN;
      tconv(WT + WE_IN, 1024, DINP, 1024, rot, [=](int k, int n) { return n < DIN ? nrm[k] * w[(size_t)k * DIN + n] : 0.f; });
      rot += 36 * 16;
    }
    {
      const float* nrm = p.in[I_QN] + l * 256; const float* wuq = p.in[I_WUQ] + (size_t)l * 256 * 768;
      const float* wuk = p.in[I_WUK] + (size_t)l * 8 * 128 * 64;
      tconv(WT + WE_Q, 256, 1280, 256, rot, [=](int k, int n) {
        float r;
        if (n < 1024) {
          int h = n >> 7, c = n & 127;
          const float* a = wuq + (size_t)k * 768 + h * 96; const float* b = wuk + (size_t)(h * 128 + c) * 64;
          r = 0.f;
          for (int d = 0; d < 64; ++d) r += a[d] * b[d];
        } else {
          int hr = n - 1024;
          r = wuq[(size_t)k * 768 + (hr >> 5) * 96 + 64 + (hr & 31)];
        }
        return r * nrm[k] * QSCALE;
      });
      rot += 20 * 4;
    }
    {
      const float* wup = p.in[I_WUP] + (size_t)l * 64 * 512; const float* aup = p.in[I_AUP] + (size_t)l * 64 * 512;
      const float* gup = p.in[I_GUP] + (size_t)l * 128 * 512;
      tconv(WT + WE_RW, 256, 1536, 256, rot, [=](int k, int n) {
        if (n < 512) return k < 64 ? wup[k * 512 + n] : 0.f;
        if (n < 1024) return (k >= 64 && k < 128) ? aup[(k - 64) * 512 + n - 512] : 0.f;
        return k >= 128 ? gup[(k - 128) * 512 + n - 1024] : 0.f;
      });
      rot += 24 * 4;
    }
    {
      const float* wuv = p.in[I_WUV] + (size_t)l * 8 * 128 * 64; const float* wo = p.in[I_WOUT] + (size_t)l * 1024 * 1024;
      tconv(WT + WE_OUT, 1536, 1024, 1536, rot, [=](int k, int n) {
        if (k < 1024) {
          int h = k >> 7, c = k & 127;
          const float* a = wuv + (size_t)(h * 128 + c) * 64; const float* b = wo + (size_t)(h * 64) * 1024 + n;
          float r = 0.f;
          for (int v = 0; v < 64; ++v) r += a[v] * b[(size_t)v * 1024];
          return r;
        }
        return wo[(size_t)(512 + k - 1024) * 1024 + n];
      });
      rot += 16 * 24;
    }
    {
      const float* nx = p.in[I_XN] + l * 1024; const float* nm = p.in[I_MKVN] + l * 1024;
      const float* wq = p.in[I_WMQ] + (size_t)l * 1048576; const float* wk = p.in[I_WMK] + (size_t)l * 1048576;
      const float* wv = p.in[I_WMV] + (size_t)l * 1048576; const float* wo = p.in[I_WMO] + (size_t)l * 1048576;
      tconv(WT + WE_MQ, 1024, 1024, 1024, rot, [=](int k, int n) { return nx[k] * wq[(size_t)k * 1024 + n] * XSCALE; });
      tconv(WT + WE_MK, 1024, 1024, 1024, rot, [=](int k, int n) { return nm[k] * wk[(size_t)k * 1024 + n]; });
      tconv(WT + WE_MV, 1024, 1024, 1024, rot, [=](int k, int n) { return nm[k] * wv[(size_t)k * 1024 + n]; });
      tconv(WT + WE_MO, 1024, 1024, 1024, rot, [=](int k, int n) { return wo[(size_t)k * 1024 + n]; });
    }
  }
}

__device__ __forceinline__ void phase_prep(KPR p, int l) {
  const int G = gridDim.x, tid = tidx(), wid = tid >> 6, lane = tid & 63;
  const int gw = blockIdx.x * 8 + wid, nw = G * 8;
  const u16* PROJ = (const u16*)(p.ws + W_PROJ);
  u16* CQB = (u16*)(p.ws + W_CQB); u16* A2 = (u16*)(p.ws + W_A2);
  float* RB = (float*)(p.ws + W_RB); float* KB = (float*)(p.ws + W_KB); float* VB = (float*)(p.ws + W_VB); float* KKB = (float*)(p.ws + W_KKB);
  u16* KP = (u16*)(p.ws + W_KP); u16* KS = (u16*)(p.ws + W_KS); u16* VTP = (u16*)(p.ws + W_VTP); u16* VTS = (u16*)(p.ws + W_VTS);
  const float2* RT = (const float2*)(p.ws + W_ROPE);
  const float* kvn = p.in[I_KVN] + l * 128; const float* mu = p.in[I_MU] + l * DSH; const float* kkw = p.in[I_KK] + l * 512;
  for (int g = gw; g < T; g += nw) {
    const u16* pr = PROJ + (size_t)g * DINP;
    const bool isP = g < TP;
    int b, t, pos, tlen;
    if (isP) { b = g >> 12; t = g & 4095; pos = t; tlen = 4096; } else { int gg = g - TP; b = gg >> 6; t = gg & 63; pos = 2048 + t; tlen = 64; }
    {
      uint2 w = *(const uint2*)(pr + lane * 4);
      float v0 = bf2f(w.x & 0xffff), v1 = bf2f(w.x >> 16), v2 = bf2f(w.y & 0xffff), v3 = bf2f(w.y >> 16);
      float ss = wave_sum(v0 * v0 + v1 * v1 + v2 * v2 + v3 * v3);
      float rs = rsqrtf(ss * (1.f / 256.f) + 1e-6f);
      uint2 o; o.x = pack2(v0 * rs, v1 * rs); o.y = pack2(v2 * rs, v3 * rs);
      *(uint2*)(CQB + (size_t)g * 256 + lane * 4) = o;
    }
    {
      unsigned w = *(const unsigned*)(pr + 256 + lane * 2);
      float v0 = bf2f(w & 0xffff), v1 = bf2f(w >> 16);
      float ss = wave_sum(v0 * v0 + v1 * v1);
      float rs = rsqrtf(ss * (1.f / 128.f) + 1e-6f);
      int c = lane * 2;
      v0 = v0 * rs * kvn[c]; v1 = v1 * rs * kvn[c + 1];
      float* of = isP ? p.out + OO_CKVP + ((size_t)(l * 4 + b) * 4096 + t) * 128 : p.out + OO_CKVS + ((size_t)(l * 32 + b) * 64 + t) * 128;
      *(float2*)(of + c) = make_float2(v0, v1);
      u16* kr = isP ? KP + ((size_t)b * 4096 + t) * 160 : KS + ((size_t)b * 2112 + 2048 + t) * 160;
      *(unsigned*)(kr + c) = pack2(v0, v1);
      if (isP) { VTP[((size_t)b * 128 + c) * 4096 + t] = f2bf(v0); VTP[((size_t)b * 128 + c + 1) * 4096 + t] = f2bf(v1); }
      else { VTS[((size_t)b * 128 + c) * 2112 + 2048 + t] = f2bf(v0); VTS[((size_t)b * 128 + c + 1) * 2112 + 2048 + t] = f2bf(v1); }
      if (lane < 16) {
        float x1 = bf2f(pr[384 + lane]), x2 = bf2f(pr[400 + lane]);
        float2 cs = RT[pos * 16 + lane];
        float o1 = x1 * cs.x - x2 * cs.y, o2 = x1 * cs.y + x2 * cs.x;
        float* okr = isP ? p.out + OO_KRP + ((size_t)(l * 4 + b) * 4096 + t) * 32 : p.out + OO_KRS + ((size_t)(l * 32 + b) * 64 + t) * 32;
        okr[lane] = o1; okr[lane + 16] = o2;
        kr[128 + lane] = f2bf(o1); kr[144 + lane] = f2bf(o2);
      }
    }
    {
      const u16* pb = pr + 416;
      const u16* pp = pr - DINP + 416;
      const float* sh0 = p.in[I_SSH] + (size_t)(l * 32 + b) * DSH;
      const bool last = (t == tlen - 1);
      float* osh = isP ? p.out + OO_SHP + (size_t)(l * 4 + b) * DSH : p.out + OO_SHS + (size_t)(l * 32 + b) * DSH;
#pragma unroll
      for (int it = 0; it < 4; ++it) {
        const int c = it * 64 + lane;
        if (c < 224) {
          const int e = c * 8;
          uint4 w = *(const uint4*)(pb + e);
          float pv[8] = {bf2f(w.x & 0xffff), bf2f(w.x >> 16), bf2f(w.y & 0xffff), bf2f(w.y >> 16), bf2f(w.z & 0xffff), bf2f(w.z >> 16), bf2f(w.w & 0xffff), bf2f(w.w >> 16)};
          float pq[8];
          if (t > 0) {
            uint4 q = *(const uint4*)(pp + e);
            pq[0] = bf2f(q.x & 0xffff); pq[1] = bf2f(q.x >> 16); pq[2] = bf2f(q.y & 0xffff); pq[3] = bf2f(q.y >> 16);
            pq[4] = bf2f(q.z & 0xffff); pq[5] = bf2f(q.z >> 16); pq[6] = bf2f(q.w & 0xffff); pq[7] = bf2f(q.w >> 16);
          } else if (!isP) {
            float4 q0 = *(const float4*)(sh0 + e), q1 = *(const float4*)(sh0 + e + 4);
            pq[0] = q0.x; pq[1] = q0.y; pq[2] = q0.z; pq[3] = q0.w; pq[4] = q1.x; pq[5] = q1.y; pq[6] = q1.z; pq[7] = q1.w;
          } else {
#pragma unroll
            for (int j = 0; j < 8; ++j) pq[j] = 0.f;
          }
          float4 m0 = *(const float4*)(mu + e), m1 = *(const float4*)(mu + e + 4);
          float mm[8] = {m0.x, m0.y, m0.z, m0.w, m1.x, m1.y, m1.z, m1.w};
          float xs[8];
#pragma unroll
          for (int j = 0; j < 8; ++j) xs[j] = pv[j] + mm[j] * (pq[j] - pv[j]);
          if (last) { *(float4*)(osh + e) = make_float4(pv[0], pv[1], pv[2], pv[3]); *(float4*)(osh + e + 4) = make_float4(pv[4], pv[5], pv[6], pv[7]); }
          if (it == 0) {
            float* o = RB + (size_t)g * 512 + e;
            *(float4*)o = make_float4(xs[0], xs[1], xs[2], xs[3]); *(float4*)(o + 4) = make_float4(xs[4], xs[5], xs[6], xs[7]);
          } else if (it == 1) {
            const int cc = e - 512;
            float* o = KB + (size_t)g * 512 + cc;
            *(float4*)o = make_float4(xs[0], xs[1], xs[2], xs[3]); *(float4*)(o + 4) = make_float4(xs[4], xs[5], xs[6], xs[7]);
            float4 k0 = *(const float4*)(kkw + cc), k1 = *(const float4*)(kkw + cc + 4);
            float kk[8] = {xs[0] * k0.x, xs[1] * k0.y, xs[2] * k0.z, xs[3] * k0.w, xs[4] * k1.x, xs[5] * k1.y, xs[6] * k1.z, xs[7] * k1.w};
            float ss = 0.f;
#pragma unroll
            for (int j = 0; j < 8; ++j) ss += kk[j] * kk[j];
            ss = dpp_sum8(ss);
            float rn = rsqrtf(ss + 1e-12f);
            float* o2 = KKB + (size_t)g * 512 + cc;
            *(float4*)o2 = make_float4(kk[0] * rn, kk[1] * rn, kk[2] * rn, kk[3] * rn); *(float4*)(o2 + 4) = make_float4(kk[4] * rn, kk[5] * rn, kk[6] * rn, kk[7] * rn);
          } else if (it == 2) {
            float* o = VB + (size_t)g * 512 + (e - 1024);
            *(float4*)o = make_float4(xs[0], xs[1], xs[2], xs[3]); *(float4*)(o + 4) = make_float4(xs[4], xs[5], xs[6], xs[7]);
          } else {
            const int cc = e - 1536;
            float y[8];
#pragma unroll
            for (int j = 0; j < 8; ++j) y[j] = cc < 64 ? tanhf(xs[j]) : (cc < 128 ? xs[j] : sigmoidf_(xs[j]));
            uint4 o; o.x = pack2(y[0], y[1]); o.y = pack2(y[2], y[3]); o.z = pack2(y[4], y[5]); o.w = pack2(y[6], y[7]);
            *(uint4*)(A2 + (size_t)g * 256 + cc) = o;
          }
        }
      }
    }
  }
}

__device__ __forceinline__ void conv_caches(KPR p, int l, int vb, int nvb) {
  const int tid = tidx();
  u16* KS = (u16*)(p.ws + W_KS); u16* VTS = (u16*)(p.ws + W_VTS);
  {
    const float* cckv = p.in[I_CCKV] + (size_t)l * 32 * 2048 * 128;
    const float* ckr = p.in[I_CKR] + (size_t)l * 32 * 2048 * 32;
    for (int idx = vb * NTHR + tid; idx < 32 * 2048 * 20; idx += nvb * NTHR) {
      int rowi = idx / 20, ch = idx % 20;
      int b = rowi >> 11, t = rowi & 2047;
      const float* s = ch < 16 ? cckv + (size_t)rowi * 128 + ch * 8 : ckr + (size_t)rowi * 32 + (ch - 16) * 8;
      float4 a = *(const float4*)s, c = *(const float4*)(s + 4);
      uint4 o; o.x = pack2(a.x, a.y); o.y = pack2(a.z, a.w); o.z = pack2(c.x, c.y); o.w = pack2(c.z, c.w);
      *(uint4*)(KS + ((size_t)b * 2112 + t) * 160 + ch * 8) = o;
    }
    tconv_v(VTS, 2112, 4096, 2048, vb, nvb, [=](int k, int n) { return cckv[((size_t)(n >> 7) * 2048 + k) * 128 + (n & 127)]; });
    const float* cmk = p.in[I_CMK] + (size_t)l * 32 * 256 * 1024;
    const float* cmv = p.in[I_CMV] + (size_t)l * 32 * 256 * 1024;
    u16* MKS = (u16*)(p.ws + W_MKS); u16* MVTS = (u16*)(p.ws + W_MVTS);
    for (int idx = vb * NTHR + tid; idx < 32 * 4 * 256 * 32; idx += nvb * NTHR) {
      int d8 = idx & 31, m = (idx >> 5) & 255, h = (idx >> 13) & 3, b = idx >> 15;
      const float* s = cmk + ((size_t)(b * 256 + m) * 4 + h) * 256 + d8 * 8;
      float4 a = *(const float4*)s, c = *(const float4*)(s + 4);
      uint4 o; o.x = pack2(a.x, a.y); o.y = pack2(a.z, a.w); o.z = pack2(c.x, c.y); o.w = pack2(c.z, c.w);
      *(uint4*)(MKS + (size_t)idx * 8) = o;
    }
    tconv_v(MVTS, 256, 32768, 256, vb, nvb, [=](int k, int n) { return cmv[((size_t)((n >> 10) * 256 + k) * 4 + ((n >> 8) & 3)) * 256 + (n & 255)]; });
  }
}

__device__ __forceinline__ void mla_sub(KPR p, int b, int c, int half) {
  const u16* QB = (const u16*)(p.ws + W_QB); u16* AO = (u16*)(p.ws + W_AO);
  size_t tok = (size_t)b * 4096 + c * 64 + half * 32;
  attn_item<160, 128, 8>(QB + tok * 1280, 160, 256, (const u16*)(p.ws + W_KP) + (size_t)b * 4096 * 160, 160,
                         (const u16*)(p.ws + W_VTP) + (size_t)b * 128 * 4096, 4096, (c + 1) * 64, AO + tok * 1536, 1536);
}
__device__ __forceinline__ void phase_mix(KPR p, int l, int mode = 0) {
  extern __shared__ __attribute__((aligned(16))) char smem[];
  int* sItem = (int*)(smem + SMEM_ITEM);
  int* cnt = (int*)(p.ws + W_CNT) + l + mode * 8;
  for (;;) {
    __syncthreads();
    if (threadIdx.x == 0) *sItem = atomicAdd(cnt, 1);
    __syncthreads();
    int it = *sItem;
    if (it >= 608) break;
    if (mode == 1 && it >= 32 && it < 352) continue;
    if (mode == 2 && (it < 32 || it >= 352)) continue;
    if (it < 32) {
      int b = it >> 3, h = it & 7;
      cseq_item(p, b * 4096, h, 64, (b * 8 + h) * 64, nullptr, p.out + OO_WKVP + ((size_t)(l * 4 + b) * 8 + h) * 4096);
    } else if (it < 288) {
      int k = it - 32; int b = k >> 6, pr = (k >> 1) & 31, half = k & 1;
      mla_sub(p, b, 63 - pr, half);
      mla_sub(p, b, pr, half);
    } else if (it < 352) {
      int k = it - 288; int b = k >> 1, half = k & 1;
      const u16* QB = (const u16*)(p.ws + W_QB); u16* AO = (u16*)(p.ws + W_AO);
      size_t tok = (size_t)TP + b * 64 + half * 32;
      attn_item<160, 128, 8>(QB + tok * 1280, 160, 256, (const u16*)(p.ws + W_KS) + (size_t)b * 2112 * 160, 160,
                             (const u16*)(p.ws + W_VTS) + (size_t)b * 128 * 2112, 2112, 2112, AO + tok * 1536, 1536);
    } else {
      int k = it - 352; int b = k >> 3, h = k & 7;
      cseq_item(p, TP + b * 64, h, 1, 2048 + k, p.in[I_SWKV] + ((size_t)(l * 32 + b) * 8 + h) * 4096,
                p.out + OO_WKVS + ((size_t)(l * 32 + b) * 8 + h) * 4096);
    }
  }
}

__device__ __forceinline__ void phase_xattn(KPR p, int l) {
  const u16* QX = (const u16*)(p.ws + W_QX); u16* XO = (u16*)(p.ws + W_XO);
  for (int it = blockIdx.x; it < 384; it += gridDim.x) {
    if (it < 256) {
      int b = it >> 6, h = (it >> 4) & 3, qt = it & 15;
      size_t tok = (size_t)b * 4096 + qt * 256;
      for (int hv = 0; hv < 2; ++hv)
        attn_item<256, 128, 1>(QX + tok * 1024 + h * 256, 1024, 256, (const u16*)(p.ws + W_MKP) + (size_t)((l * 4 + b) * 4 + h) * 65536, 256,
                               (const u16*)(p.ws + W_MVTP) + (size_t)((l * 4 + b) * 4 + h) * 65536 + hv * 128 * 256, 256, 256, XO + tok * 1024 + h * 256 + hv * 128, 1024);
    } else {
      int k = it - 256; int b = k >> 2, h = k & 3;
      size_t tok = (size_t)TP + b * 64;
      for (int hv = 0; hv < 2; ++hv)
        attn_item<256, 128, 1>(QX + tok * 1024 + h * 256, 1024, 64, (const u16*)(p.ws + W_MKS) + (size_t)(b * 4 + h) * 65536, 256,
                               (const u16*)(p.ws + W_MVTS) + (size_t)(b * 4 + h) * 65536 + hv * 128 * 256, 256, 256, XO + tok * 1024 + h * 256 + hv * 128, 1024);
    }
  }
}

__device__ __forceinline__ void phase_final(KPR p) {
  const int tid = tidx(), wid = tid >> 6, lane = tid & 63;
  const float* X = (const float*)(p.ws + W_X); const float* fn = p.in[I_FN];
  for (int g = blockIdx.x * 8 + wid; g < T; g += gridDim.x * 8) {
    float4 v[4]; float ss = 0.f;
#pragma unroll
    for (int i = 0; i < 4; ++i) { v[i] = *(const float4*)(X + (size_t)g * 1024 + i * 256 + lane * 4); ss += v[i].x * v[i].x + v[i].y * v[i].y + v[i].z * v[i].z + v[i].w * v[i].w; }
    ss = wave_sum(ss);
    float rs = rsqrtf(ss * (1.f / 1024.f) + 1e-6f);
#pragma unroll
    for (int i = 0; i < 4; ++i) {
      float4 gn = *(const float4*)(fn + i * 256 + lane * 4);
      *(float4*)(p.out + OO_Y + (size_t)g * 1024 + i * 256 + lane * 4) = make_float4(v[i].x * rs * gn.x, v[i].y * rs * gn.y, v[i].z * rs * gn.z, v[i].w * rs * gn.w);
    }
  }
}

constexpr int NPL = 14;
constexpr int N_PHASES = 2 + NPL * NL + 1;

__device__ __forceinline__ void run_phase(KPR p, int ph, int rep) {
  float* X = (float*)(p.ws + W_X); u16* XB = (u16*)(p.ws + W_XB); float* SSQ = (float*)(p.ws + W_SSQ);
  u16* ACT = (u16*)(p.ws + W_ACT);
#ifdef ONLY_S
  if (ONLY_S == 100) { if (ph == 0) phase_init(p); return; }
  if (ONLY_S == 102) { if (ph == N_PHASES - 1) phase_final(p); return; }
  if (ONLY_S != 101 && ph < 2) return;
  if (ONLY_S == 101 && ph != 1) return;
  if (ONLY_S < 100 && (ph < 2 || ph == N_PHASES - 1 || (ph - 2) % NPL != ONLY_S)) return;
#endif
  if (ph == 0) { phase_init(p); return; }
  if (ph == 1) {
    for (int l = 0; l < NL; ++l) {
      const u16* WT = (const u16*)(p.ws + W_WT) + (size_t)l * WE_LAYER;
      gemm_phase((const u16*)(p.ws + W_MB), WT + WE_MK, 1024, 4, 4, (2 * l) * 16,
                 EpiMem<false>{p.out + OO_MKP + (size_t)l * 1048576, (u16*)(p.ws + W_MKP) + (size_t)l * 16 * 65536});
      gemm_phase((const u16*)(p.ws + W_MB), WT + WE_MV, 1024, 4, 4, (2 * l + 1) * 16,
                 EpiMem<true>{p.out + OO_MVP + (size_t)l * 1048576, (u16*)(p.ws + W_MVTP) + (size_t)l * 16 * 65536});
    }
    return;
  }
  if (ph == N_PHASES - 1) { phase_final(p); return; }
  const int l = (ph - 2) / NPL, s = (ph - 2) % NPL;
  const u16* WT = (const u16*)(p.ws + W_WT) + (size_t)l * WE_LAYER;
  {
    const float rc = rep ? 0.f : 1.f;
    switch (s) {
      case 0: gemm_phase(XB, WT + WE_GU1, 1024, 72, 22, 0, EpiGU{SSQ, ACT}); break;
      case 1:
        gemm_phase(ACT, WT + WE_D1, DFF, 72, 4, 0, EpiRes{X, XB, SSQ, 0.5f * rc});
        if (blockIdx.x >= 32 && rep == 0) conv_caches(p, l, blockIdx.x - 32, gridDim.x - 32);
        break;
      case 2: gemm_phase(XB, WT + WE_IN, 1024, 72, 9, 0, EpiScaleBf{SSQ, (u16*)(p.ws + W_PROJ), DINP}); break;
      case 3: phase_prep(p, l); break;
      case 4:
        gemm_phase((const u16*)(p.ws + W_CQB), WT + WE_Q, 256, 72, 5, 0, EpiQ{(u16*)(p.ws + W_QB), (const float2*)(p.ws + W_ROPE)});
        gemm_phase((const u16*)(p.ws + W_A2), WT + WE_RW, 256, 72, 6, 360,
                   EpiRW{p.in[I_W0] + l * 512, p.in[I_A0] + l * 512, p.in[I_KA] + l * 512, p.ws});
        break;
      case 5: phase_cprep(p); break;
      case 6:
        phase_mix(p, l, 0);
        if (REP_WHICH == 3) { cg::this_grid().sync(); phase_mix(p, l, 1); }
        if (REP_WHICH == 4) { cg::this_grid().sync(); phase_mix(p, l, 2); }
        break;
      case 7: phase_yfin(p, l); break;
      case 8: gemm_phase((const u16*)(p.ws + W_AO), WT + WE_OUT, 1536, 72, 4, 0, EpiRes{X, XB, SSQ, rc}); break;
      case 9: gemm_phase(XB, WT + WE_MQ, 1024, 72, 4, 0, EpiScaleBf{SSQ, (u16*)(p.ws + W_QX), 1024}); break;
      case 10: phase_xattn(p, l); break;
      case 11: gemm_phase((const u16*)(p.ws + W_XO), WT + WE_MO, 1024, 72, 4, 0, EpiRes{X, XB, SSQ, rc}); break;
      case 12: gemm_phase(XB, WT + WE_GU2, 1024, 72, 22, 0, EpiGU{SSQ, ACT}); break;
      case 13: gemm_phase(ACT, WT + WE_D2, DFF, 72, 4, 0, EpiRes{X, XB, SSQ, 0.5f * rc}); break;
    }
  }
}

__global__ void __launch_bounds__(NTHR) mega(Params p) {
  cg::grid_group grid = cg::this_grid();
  for (int ph = p.ph_lo; ph < p.ph_hi; ++ph) {
    int nrep = 1;
    if (REP_WHICH && ph >= 2 && ph < N_PHASES - 1) {
      const int s = (ph - 2) % NPL;
      if ((REP_WHICH == 1 && (s == 0 || s == 12)) || (REP_WHICH == 2 && (s == 1 || s == 13)) || (REP_WHICH == 5 && s == 2) ||
          (REP_WHICH == 6 && s == 3) || (REP_WHICH == 7 && s == 10) || (REP_WHICH == 9 && (s == 8 || s == 9 || s == 11))) nrep = 2;
    }
    if (REP_WHICH == 8 && ph == 0) nrep = 2;
    for (int rep = 0; rep < nrep; ++rep) {
      const __attribute__((address_space(4))) Params* q = (const __attribute__((address_space(4))) Params*)__builtin_amdgcn_kernarg_segment_ptr();
      asm volatile("" : "+s"(q));
      run_phase(*q, ph, rep);
      if (ph + 1 < p.ph_hi || rep + 1 < nrep) grid.sync();
    }
  }
}

extern "C" void kernel_launch(void* const* d_in, const int* in_sizes, int n_in, void* d_out, int out_size, void* d_ws,
                              size_t ws_size, hipStream_t stream) {
  static int grid = 0;
  if (grid == 0) {
    if (n_in != N_IN || (size_t)out_size != OO_END || ws_size < W_END) {
      fprintf(stderr, "kernel_launch: unexpected shapes n_in=%d out=%d ws=%zu (need %zu)\n", n_in, out_size, ws_size, (size_t)W_END);
      grid = -1; return;
    }
    int dev = 0, cus = 0, per_cu = 0;
    hipGetDevice(&dev);
    hipDeviceGetAttribute(&cus, hipDeviceAttributeMultiprocessorCount, dev);
    hipFuncSetAttribute((const void*)mega, hipFuncAttributeMaxDynamicSharedMemorySize, SMEM_BYTES);
    hipOccupancyMaxActiveBlocksPerMultiprocessor(&per_cu, (const void*)mega, NTHR, SMEM_BYTES);
    if (per_cu < 1) { fprintf(stderr, "kernel_launch: occupancy query says %d blocks/CU\n", per_cu); per_cu = 1; }
    (void)hipGetLastError();
    grid = cus;
  }
  if (grid < 0) return;
  Params p{};
  for (int i = 0; i < N_IN; ++i) p.in[i] = (const float*)d_in[i];
  p.out = (float*)d_out; p.ws = (char*)d_ws;
#if N_LAUNCH_PER_PHASE
  for (int ph = 0; ph < N_PHASES; ++ph) {
    p.ph_lo = ph; p.ph_hi = ph + 1;
    void* args[] = {&p};
    hipError_t e = hipLaunchCooperativeKernel((const void*)mega, dim3(grid), dim3(NTHR), args, SMEM_BYTES, stream);
    if (e != hipSuccess) { fprintf(stderr, "launch failed: %s\n", hipGetErrorString(e)); break; }
  }
#else
  p.ph_lo = 0; p.ph_hi = N_PHASES;
  void* args[] = {&p};
  hipError_t e = hipLaunchCooperativeKernel((const void*)mega, dim3(grid), dim3(NTHR), args, SMEM_BYTES, stream);
  if (e != hipSuccess) fprintf(stderr, "cooperative launch failed: %s (grid %d)\n", hipGetErrorString(e), grid);
#endif
}
```

```cpp
#include <hip/hip_runtime.h>
#include <hip/hip_cooperative_groups.h>
#include <stdint.h>
#include <stdio.h>
namespace cg = cooperative_groups;

typedef unsigned short u16;
using bf16x8 = __attribute__((ext_vector_type(8))) short;
using f32x4 = __attribute__((ext_vector_type(4))) float;
using f32x16 = __attribute__((ext_vector_type(16))) float;

#ifndef REP_WHICH
#define REP_WHICH 0
#endif
#ifndef N_LAUNCH_PER_PHASE
#define N_LAUNCH_PER_PHASE 0
#endif

constexpr int TP = 16384, TS = 2048, T = TP + TS, NL = 4;
constexpr int DFF = 2816, DIN = 2208, DINP = 2304, DSH = 1792;
constexpr int NTHR = 512;
constexpr int SMEM_BYTES = 139264 + 2048;
constexpr int SMEM_ITEM = 139264 + 1024;
constexpr float QSCALE = 0.10206207261596577f * 1.4426950408889634f;
constexpr float XSCALE = 0.0625f * 1.4426950408889634f;

constexpr size_t OO_Y = 0;
constexpr size_t OO_CKVP = OO_Y + (size_t)T * 1024;
constexpr size_t OO_KRP = OO_CKVP + (size_t)NL * 4 * 4096 * 128;
constexpr size_t OO_MKP = OO_KRP + (size_t)NL * 4 * 4096 * 32;
constexpr size_t OO_MVP = OO_MKP + (size_t)NL * 4 * 256 * 1024;
constexpr size_t OO_WKVP = OO_MVP + (size_t)NL * 4 * 256 * 1024;
constexpr size_t OO_SHP = OO_WKVP + (size_t)NL * 4 * 8 * 4096;
constexpr size_t OO_CKVS = OO_SHP + (size_t)NL * 4 * DSH;
constexpr size_t OO_KRS = OO_CKVS + (size_t)NL * 32 * 64 * 128;
constexpr size_t OO_WKVS = OO_KRS + (size_t)NL * 32 * 64 * 32;
constexpr size_t OO_SHS = OO_WKVS + (size_t)NL * 32 * 8 * 4096;
constexpr size_t OO_END = OO_SHS + (size_t)NL * 32 * DSH;

constexpr size_t al256(size_t x) { return (x + 255) & ~(size_t)255; }
constexpr size_t W_X = 0;
constexpr size_t W_XB = W_X + al256((size_t)T * 1024 * 4);
constexpr size_t W_SSQ = W_XB + al256((size_t)T * 1024 * 2);
constexpr size_t W_ACT = W_SSQ + al256((size_t)T * 4 * 4);
constexpr size_t W_WB = W_ACT;
constexpr size_t W_BB = W_WB + al256((size_t)T * 512 * 4);
constexpr size_t W_GB = W_BB + al256((size_t)T * 512 * 4);
constexpr size_t W_QX = W_ACT;
constexpr size_t W_PROJ = W_ACT + al256((size_t)T * DFF * 2);
constexpr size_t W_AO = W_PROJ;
constexpr size_t W_CQB = W_PROJ + al256((size_t)T * DINP * 2);
constexpr size_t W_A2 = W_CQB + al256((size_t)T * 256 * 2);
constexpr size_t W_QB = W_A2 + al256((size_t)T * 256 * 2);
constexpr size_t W_XO = W_QB;
constexpr size_t W_RB = W_QB + al256((size_t)T * 1280 * 2);
constexpr size_t W_KB = W_RB + al256((size_t)T * 512 * 4);
constexpr size_t W_VB = W_KB + al256((size_t)T * 512 * 4);
constexpr size_t W_KKB = W_VB + al256((size_t)T * 512 * 4);
constexpr size_t W_KP = W_KKB + al256((size_t)T * 512 * 4);
constexpr size_t W_KS = W_KP + al256((size_t)4 * 4096 * 160 * 2);
constexpr size_t W_VTP = W_KS + al256((size_t)32 * 2112 * 160 * 2);
constexpr size_t W_VTS = W_VTP + al256((size_t)4 * 128 * 4096 * 2);
constexpr size_t W_MKP = W_VTS + al256((size_t)32 * 128 * 2112 * 2);
constexpr size_t W_MVTP = W_MKP + al256((size_t)NL * 16 * 65536 * 2);
constexpr size_t W_MKS = W_MVTP + al256((size_t)NL * 16 * 65536 * 2);
constexpr size_t W_MVTS = W_MKS + al256((size_t)128 * 65536 * 2);
constexpr size_t W_MB = W_MVTS + al256((size_t)128 * 65536 * 2);
constexpr size_t W_ROPE = W_MB + al256((size_t)1024 * 1024 * 2);
constexpr size_t W_CNT = W_ROPE + al256((size_t)4096 * 16 * 8);
constexpr size_t W_YB = W_CNT + 32768;
constexpr size_t W_CQ = W_YB + al256((size_t)T * 512 * 4);
constexpr size_t W_WT = W_CQ + al256((size_t)2304 * 4096 * 4);
constexpr size_t W_CRR = W_PROJ + al256((size_t)T * 1536 * 2);
constexpr size_t W_CPT = W_CQB;
static_assert(W_CRR + (size_t)2304 * 4096 * 2 <= W_CQB, "RRt must fit behind AO");
static_assert((size_t)2304 * 4096 * 2 <= 2 * al256((size_t)T * 256 * 2), "Pt must fit in CQB+A2");
constexpr size_t WE_GU1 = 0;
constexpr size_t WE_D1 = WE_GU1 + (size_t)5632 * 1024;
constexpr size_t WE_IN = WE_D1 + (size_t)1024 * DFF;
constexpr size_t WE_Q = WE_IN + (size_t)DINP * 1024;
constexpr size_t WE_RW = WE_Q + (size_t)1280 * 256;
constexpr size_t WE_OUT = WE_RW + (size_t)1536 * 256;
constexpr size_t WE_MQ = WE_OUT + (size_t)1024 * 1536;
constexpr size_t WE_MK = WE_MQ + (size_t)1024 * 1024;
constexpr size_t WE_MV = WE_MK + (size_t)1024 * 1024;
constexpr size_t WE_MO = WE_MV + (size_t)1024 * 1024;
constexpr size_t WE_GU2 = WE_MO + (size_t)1024 * 1024;
constexpr size_t WE_D2 = WE_GU2 + (size_t)5632 * 1024;
constexpr size_t WE_LAYER = WE_D2 + (size_t)1024 * DFF;
constexpr size_t W_END = W_WT + al256(WE_LAYER * NL * 2);

enum { I_XP = 0, I_XS, I_MEMP, I_CCKV, I_CKR, I_CMK, I_CMV, I_SWKV, I_SSH, I_F1N, I_F1G, I_F1U, I_F1D, I_MIXN, I_WIN,
       I_QN, I_WUQ, I_KVN, I_WUK, I_WUV, I_MU, I_W0, I_WUP, I_A0, I_AUP, I_GUP, I_KK, I_KA, I_RK, I_GNG, I_GNB, I_WOUT,
       I_XN, I_MKVN, I_WMQ, I_WMK, I_WMV, I_WMO, I_F2N, I_F2G, I_F2U, I_F2D, I_FN, N_IN };

struct Params {
  const float* in[N_IN];
  float* out;
  char* ws;
  int ph_lo, ph_hi;
};

typedef const __attribute__((address_space(4))) Params& KPR;

typedef __bf16 bf2_t __attribute__((ext_vector_type(2)));
typedef float f2_t __attribute__((ext_vector_type(2)));
__device__ __forceinline__ u16 f2bf(float f) { __bf16 b = (__bf16)f; return __builtin_bit_cast(u16, b); }
__device__ __forceinline__ float bf2f(u16 h) { return __uint_as_float(((unsigned)h) << 16); }
__device__ __forceinline__ unsigned pack2(float a, float b) { f2_t v = {a, b}; bf2_t r = __builtin_convertvector(v, bf2_t); return __builtin_bit_cast(unsigned, r); }
__device__ __forceinline__ float wave_sum(float x) {
#pragma unroll
  for (int o = 32; o; o >>= 1) x += __shfl_xor(x, o);
  return x;
}
__device__ __forceinline__ float dpp_sum8(float x) {
  x += __int_as_float(__builtin_amdgcn_update_dpp(0, __float_as_int(x), 0xB1, 0xF, 0xF, false));
  x += __int_as_float(__builtin_amdgcn_update_dpp(0, __float_as_int(x), 0x4E, 0xF, 0xF, false));
  x += __int_as_float(__builtin_amdgcn_update_dpp(0, __float_as_int(x), 0x141, 0xF, 0xF, false));
  return x;
}
__device__ __forceinline__ int tidx() { int t = threadIdx.x; asm volatile("" : "+v"(t)); return t; }
__device__ __forceinline__ float fma_s(float a, float b, float c) { float d; asm("v_fma_f32 %0, %1, %2, %3" : "=v"(d) : "v"(a), "v"(b), "v"(c)); return d; }
__device__ __forceinline__ float sub_s(float a, float b) { float d; asm("v_sub_f32 %0, %1, %2" : "=v"(d) : "v"(a), "v"(b)); return d; }
__device__ __forceinline__ float add_s(float a, float b) { float d; asm("v_add_f32 %0, %1, %2" : "=v"(d) : "v"(a), "v"(b)); return d; }
__device__ __forceinline__ float mul_s(float a, float b) { float d; asm("v_mul_f32 %0, %1, %2" : "=v"(d) : "v"(a), "v"(b)); return d; }
__device__ __forceinline__ float sigmoidf_(float x) { return 1.f / (1.f + __expf(-x)); }

constexpr int BM = 256, BK = 64, HALF = 128, HT = HALF * BK;

__device__ __forceinline__ int lds_byte(int r, int c) {
  int st = (r >> 4) * 2 + (c >> 5), rr = r & 15, cc = c & 31, ob = rr * 64 + cc * 2;
  return st * 1024 + (ob ^ (((ob >> 9) & 1) << 5));
}
__device__ __forceinline__ void stage_rc(int b, int& R, int& C) {
  int st = b / 1024, sb = b % 1024, swz = sb ^ (((sb >> 9) & 1) << 5);
  R = (st >> 1) * 16 + swz / 64; C = (st & 1) * 32 + (swz % 64) / 2;
}

__device__ __forceinline__ void tile_map(int tile, int nM, int nN, int& pm, int& pn) {
  const int ntiles = nM * nN;
  int wgid = tile;
  { int q = ntiles / 8, r = ntiles % 8, xcd = wgid % 8, off = wgid / 8;
    wgid = (xcd < r ? xcd * (q + 1) : r * (q + 1) + (xcd - r) * q) + off; }
  int nig = 8 * nN, gid = wgid / nig, fm = gid * 8, gsz = min(nM - fm, 8);
  pm = fm + ((wgid % nig) % gsz); pn = (wgid % nig) / gsz;
}

template <class Epi>
__device__ __forceinline__ void gemm_tile(const u16* __restrict__ A, const u16* __restrict__ Bt, const int K,
                                          const int pm, const int pn, Epi epi) {
  extern __shared__ __attribute__((aligned(16))) char smem[];
  u16* shm = (u16*)smem;
#define SA(b, h) (shm + ((b) * 2 + (h)) * HT)
#define SB(b, h) (shm + (4 + (b) * 2 + (h)) * HT)
#define STAGE(P, BASE, br, kt) do { const u16* _gb = BASE + ((long)(br) * K + (long)(kt) * BK); \
    __builtin_amdgcn_global_load_lds((const unsigned*)((const char*)_gb + so0), \
        (__attribute__((address_space(3))) unsigned*)((char*)(P) + wu16), 16, 0, 0); \
    __builtin_amdgcn_global_load_lds((const unsigned*)((const char*)_gb + so1), \
        (__attribute__((address_space(3))) unsigned*)((char*)(P) + wu16 + 8192), 16, 0, 0); } while (0)
#define LDA(dst, b, h) for (int m = 0; m < 4; ++m) for (int k = 0; k < 2; ++k) \
    dst[m][k] = *reinterpret_cast<const bf16x8*>((char*)SA(b, h) + lds_byte(wr * 64 + m * 16 + fr, k * 32 + fq * 8))
#define LDB(dst, b, h) for (int n = 0; n < 2; ++n) for (int k = 0; k < 2; ++k) \
    dst[n][k] = *reinterpret_cast<const bf16x8*>((char*)SB(b, h) + lds_byte(wc * 32 + n * 16 + fr, k * 32 + fq * 8))
#define MMA(ai, bj, At_, Bt_) do { __builtin_amdgcn_s_setprio(1); \
    for (int m = 0; m < 4; ++m) for (int n = 0; n < 2; ++n) for (int k = 0; k < 2; ++k) \
      acc[ai][bj][m][n] = __builtin_amdgcn_mfma_f32_16x16x32_bf16(At_[m][k], Bt_[n][k], acc[ai][bj][m][n], 0, 0, 0); \
    __builtin_amdgcn_s_setprio(0); } while (0)
#define WAIT_V(n) asm volatile("s_waitcnt vmcnt(" #n ")" ::: "memory")
#define WAIT_L(n) asm volatile("s_waitcnt lgkmcnt(" #n ")" ::: "memory")
#define BAR __builtin_amdgcn_s_barrier()
#define SCHED __builtin_amdgcn_sched_barrier(0)
  const int tid_ = tidx();
  const int wid = tid_ >> 6, lane = tid_ & 63, wr = wid >> 2, wc = wid & 3, fr = lane & 15, fq = lane >> 4;
  const int nt = K / BK;
  const int wu16 = __builtin_amdgcn_readfirstlane(tid_ >> 6) * 1024;
  {
    unsigned so0, so1;
    { int _r, _c; stage_rc(tid_ * 16, _r, _c); so0 = (unsigned)(_r * K + _c) * 2u;
      stage_rc(tid_ * 16 + 8192, _r, _c); so1 = (unsigned)(_r * K + _c) * 2u; }
    const int brow = pm * BM, bcol = pn * BM;
    f32x4 acc[2][2][4][2] = {};
    bf16x8 At[4][2], B0[2][2], B1[2][2];
    STAGE(SB(0, 0), Bt, bcol, 0); STAGE(SA(0, 0), A, brow, 0);
    STAGE(SB(0, 1), Bt, bcol + HALF, 0); STAGE(SA(0, 1), A, brow + HALF, 0);
    if (wr == 1) BAR;
    WAIT_V(4); BAR;
    STAGE(SB(1, 0), Bt, bcol, 1); STAGE(SA(1, 0), A, brow, 1); STAGE(SB(1, 1), Bt, bcol + HALF, 1);
    WAIT_V(6); BAR;
    for (int t = 0; t < nt - 2; t += 2) {
      LDB(B0, 0, 0); SCHED; LDA(At, 0, 0); STAGE(SA(1, 1), A, brow + HALF, t + 1);
      WAIT_L(8); BAR; WAIT_L(0); MMA(0, 0, At, B0); BAR; SCHED;
      LDB(B1, 0, 1); STAGE(SB(0, 0), Bt, bcol, t + 2);
      BAR; WAIT_L(0); MMA(0, 1, At, B1); BAR;
      LDA(At, 0, 1); STAGE(SA(0, 0), A, brow, t + 2);
      BAR; WAIT_L(0); MMA(1, 0, At, B0); BAR; SCHED;
      STAGE(SB(0, 1), Bt, bcol + HALF, t + 2);
      WAIT_V(6); BAR; MMA(1, 1, At, B1); BAR;
      LDB(B0, 1, 0); SCHED; LDA(At, 1, 0); STAGE(SA(0, 1), A, brow + HALF, t + 2);
      WAIT_L(8); BAR; WAIT_L(0); MMA(0, 0, At, B0); BAR; SCHED;
      LDB(B1, 1, 1); STAGE(SB(1, 0), Bt, bcol, t + 3);
      BAR; WAIT_L(0); MMA(0, 1, At, B1); BAR;
      LDA(At, 1, 1); STAGE(SA(1, 0), A, brow, t + 3);
      BAR; WAIT_L(0); MMA(1, 0, At, B0); BAR; SCHED;
      STAGE(SB(1, 1), Bt, bcol + HALF, t + 3);
      WAIT_V(6); BAR; MMA(1, 1, At, B1); BAR;
    }
    { LDB(B0, 0, 0); LDA(At, 0, 0); STAGE(SA(1, 1), A, brow + HALF, nt - 1);
      BAR; WAIT_L(0); MMA(0, 0, At, B0); BAR;
      LDB(B1, 0, 1); BAR; WAIT_L(0); MMA(0, 1, At, B1); BAR;
      LDA(At, 0, 1); WAIT_V(4); BAR; WAIT_L(0); MMA(1, 0, At, B0); MMA(1, 1, At, B1); BAR; }
    { LDB(B0, 1, 0); LDA(At, 1, 0); WAIT_V(2); BAR; WAIT_L(0); MMA(0, 0, At, B0); BAR;
      LDB(B1, 1, 1); WAIT_V(0); BAR; WAIT_L(0); MMA(0, 1, At, B1); BAR;
      LDA(At, 1, 1); BAR; WAIT_L(0); MMA(1, 0, At, B0); MMA(1, 1, At, B1); BAR; }
    if (wr == 0) BAR;
    float* stg = (float*)smem;
    int tx = tid_;
    asm volatile("" : "+v"(tx));
    const int ewr = tx >> 8, ewc = (tx >> 6) & 3, efr = tx & 15, efq = (tx >> 4) & 3;
#define EPI_HALF(ai) do { \
    __syncthreads(); \
    _Pragma("unroll") for (int bj = 0; bj < 2; ++bj) _Pragma("unroll") for (int m = 0; m < 4; ++m) \
    _Pragma("unroll") for (int n = 0; n < 2; ++n) _Pragma("unroll") for (int j = 0; j < 4; ++j) \
      stg[(ewr * 64 + m * 16 + efq * 4 + j) * 260 + bj * HALF + ewc * 32 + n * 16 + efr] = acc[ai][bj][m][n][j]; \
    __syncthreads(); \
    for (int i = 0; i < 8; ++i) { \
      int item = i * NTHR + tx; int rl = item >> 5, qp = item & 31; \
      int cl = (qp >> 2) * 32 + (qp & 3) * 4; \
      float4 v0 = *(const float4*)(stg + rl * 260 + cl), v1 = *(const float4*)(stg + rl * 260 + cl + 16); \
      int row = brow + ai * HALF + rl; \
      float ss = epi.apply4(row, bcol + cl, v0, v1); \
      if (Epi::kSsq) { \
        ss += __shfl_xor(ss, 1); ss += __shfl_xor(ss, 2); ss += __shfl_xor(ss, 4); ss += __shfl_xor(ss, 8); ss += __shfl_xor(ss, 16); \
        if (qp == 0) epi.ssq_out(row, pn, ss); \
      } \
    } } while (0)
    EPI_HALF(0);
    EPI_HALF(1);
#undef EPI_HALF
    __syncthreads();
  }
#undef SA
#undef SB
#undef STAGE
#undef LDA
#undef LDB
#undef MMA
}

template <class Epi>
__device__ __forceinline__ void gemm_phase(const u16* __restrict__ A, const u16* __restrict__ Bt, const int K,
                                           const int nM, const int nN, const int rot, Epi epi) {
  const int G = gridDim.x;
  for (int tile = (int)((blockIdx.x + G - (rot % G)) % G); tile < nM * nN; tile += G) {
    int pm, pn; tile_map(tile, nM, nN, pm, pn);
    gemm_tile(A, Bt, K, pm, pn, epi);
  }
}

__device__ __forceinline__ float rstd_from_ssq(const float* ssq, int row) {
  float4 s = *(const float4*)(ssq + (size_t)row * 4);
  return rsqrtf((s.x + s.y + s.z + s.w) * (1.f / 1024.f) + 1e-6f);
}
__device__ __forceinline__ uint2 pack4(float4 v) { uint2 w; w.x = pack2(v.x, v.y); w.y = pack2(v.z, v.w); return w; }
__device__ __forceinline__ float silu_mul(float g, float u) { return g / (1.f + __expf(-g)) * u; }
struct EpiGU {
  static constexpr bool kSsq = false;
  const float* ssq; u16* act;
  __device__ __forceinline__ float apply4(int row, int c0, float4 g, float4 u) const {
    float rs = rstd_from_ssq(ssq, row);
    float4 o = make_float4(silu_mul(g.x * rs, u.x * rs), silu_mul(g.y * rs, u.y * rs), silu_mul(g.z * rs, u.z * rs), silu_mul(g.w * rs, u.w * rs));
    *(uint2*)(act + (size_t)row * DFF + ((c0 & ~31) >> 1) + (c0 & 15)) = pack4(o);
    return 0.f;
  }
  __device__ __forceinline__ void ssq_out(int, int, float) const {}
};
struct EpiRes {
  static constexpr bool kSsq = true;
  float* x; u16* xb; float* ssq; float coef;
  __device__ __forceinline__ float apply4(int row, int c0, float4 v0, float4 v1) const {
    size_t i = (size_t)row * 1024 + c0;
    float4 a = *(const float4*)(x + i), b = *(const float4*)(x + i + 16);
    a.x += coef * v0.x; a.y += coef * v0.y; a.z += coef * v0.z; a.w += coef * v0.w;
    b.x += coef * v1.x; b.y += coef * v1.y; b.z += coef * v1.z; b.w += coef * v1.w;
    *(float4*)(x + i) = a; *(float4*)(x + i + 16) = b;
    *(uint2*)(xb + i) = pack4(a); *(uint2*)(xb + i + 16) = pack4(b);
    return a.x * a.x + a.y * a.y + a.z * a.z + a.w * a.w + b.x * b.x + b.y * b.y + b.z * b.z + b.w * b.w;
  }
  __device__ __forceinline__ void ssq_out(int row, int pn, float v) const { ssq[(size_t)row * 4 + pn] = v; }
};
struct EpiScaleBf {
  static constexpr bool kSsq = false;
  const float* ssq; u16* o; int ld;
  __device__ __forceinline__ float apply4(int row, int c0, float4 v0, float4 v1) const {
    float rs = rstd_from_ssq(ssq, row);
    size_t i = (size_t)row * ld + c0;
    *(uint2*)(o + i) = pack4(make_float4(v0.x * rs, v0.y * rs, v0.z * rs, v0.w * rs));
    *(uint2*)(o + i + 16) = pack4(make_float4(v1.x * rs, v1.y * rs, v1.z * rs, v1.w * rs));
    return 0.f;
  }
  __device__ __forceinline__ void ssq_out(int, int, float) const {}
};
struct EpiQ {
  static constexpr bool kSsq = false;
  u16* qb; const float2* rope;
  __device__ __forceinline__ float apply4(int row, int c0, float4 v0, float4 v1) const {
    if (c0 < 1024) {
      size_t i = (size_t)row * 1280 + (c0 >> 7) * 160 + (c0 & 127);
      *(uint2*)(qb + i) = pack4(v0); *(uint2*)(qb + i + 16) = pack4(v1);
    } else {
      int h = (c0 - 1024) >> 5, f0 = c0 & 15;
      int pos = row < TP ? (row & 4095) : (2048 + ((row - TP) & 63));
      const float2* cs = rope + pos * 16 + f0;
      float2 c_0 = cs[0], c_1 = cs[1], c_2 = cs[2], c_3 = cs[3];
      size_t i = (size_t)row * 1280 + h * 160 + 128 + f0;
      *(uint2*)(qb + i) = pack4(make_float4(v0.x * c_0.x - v1.x * c_0.y, v0.y * c_1.x - v1.y * c_1.y, v0.z * c_2.x - v1.z * c_2.y, v0.w * c_3.x - v1.w * c_3.y));
      *(uint2*)(qb + i + 16) = pack4(make_float4(v0.x * c_0.y + v1.x * c_0.x, v0.y * c_1.y + v1.y * c_1.x, v0.z * c_2.y + v1.z * c_2.x, v0.w * c_3.y + v1.w * c_3.x));
    }
    return 0.f;
  }
  __device__ __forceinline__ void ssq_out(int, int, float) const {}
};
__device__ __forceinline__ float decay_f(float z) {
  float nz = -z;
  float sp = fmaxf(nz, 0.f) + __logf(1.f + __expf(-fabsf(nz)));
  return __expf(-__expf(-sp - 0.5f));
}
struct EpiRW {
  static constexpr bool kSsq = false;
  const float* w0; const float* a0; const float* ka; char* ws;
  __device__ __forceinline__ void acol(size_t i, int c, float4 v) const {
    float* bb = (float*)(ws + W_BB); float* kb = (float*)(ws + W_KB); const float* kkb = (const float*)(ws + W_KKB);
    float4 a_0 = *(const float4*)(a0 + c), k_a = *(const float4*)(ka + c), kk = *(const float4*)(kkb + i), k = *(const float4*)(kb + i);
    float4 a = make_float4(sigmoidf_(a_0.x + v.x), sigmoidf_(a_0.y + v.y), sigmoidf_(a_0.z + v.z), sigmoidf_(a_0.w + v.w));
    *(float4*)(bb + i) = make_float4(kk.x * a.x, kk.y * a.y, kk.z * a.z, kk.w * a.w);
    *(float4*)(kb + i) = make_float4(k.x * (1.f + (a.x - 1.f) * k_a.x), k.y * (1.f + (a.y - 1.f) * k_a.y), k.z * (1.f + (a.z - 1.f) * k_a.z), k.w * (1.f + (a.w - 1.f) * k_a.w));
  }
  __device__ __forceinline__ float apply4(int row, int c0, float4 v0, float4 v1) const {
    if (c0 < 512) {
      float* wb = (float*)(ws + W_WB);
      float4 z0 = *(const float4*)(w0 + c0), z1 = *(const float4*)(w0 + c0 + 16);
      size_t i = (size_t)row * 512 + c0;
      *(float4*)(wb + i) = make_float4(decay_f(z0.x + v0.x), decay_f(z0.y + v0.y), decay_f(z0.z + v0.z), decay_f(z0.w + v0.w));
      *(float4*)(wb + i + 16) = make_float4(decay_f(z1.x + v1.x), decay_f(z1.y + v1.y), decay_f(z1.z + v1.z), decay_f(z1.w + v1.w));
    } else if (c0 < 1024) {
      int c = c0 - 512; size_t i = (size_t)row * 512 + c;
      acol(i, c, v0); acol(i + 16, c + 16, v1);
    } else {
      u16* gb = (u16*)(ws + W_GB);
      size_t i = (size_t)row * 512 + (c0 - 1024);
      *(uint2*)(gb + i) = pack4(v0); *(uint2*)(gb + i + 16) = pack4(v1);
    }
    return 0.f;
  }
  __device__ __forceinline__ void ssq_out(int, int, float) const {}
};
template <bool ISV>
struct EpiMem {
  static constexpr bool kSsq = false;
  float* of; u16* ob;
  __device__ __forceinline__ void quad(int row, int col, float4 v) const {
    *(float4*)(of + (size_t)row * 1024 + col) = v;
    int b = row >> 8, m = row & 255, h = col >> 8, d = col & 255;
    if (ISV) {
      u16* o = ob + (size_t)((b * 4 + h) * 256 + d) * 256 + m;
      o[0] = f2bf(v.x); o[256] = f2bf(v.y); o[512] = f2bf(v.z); o[768] = f2bf(v.w);
    } else {
      *(uint2*)(ob + (size_t)((b * 4 + h) * 256 + m) * 256 + d) = pack4(v);
    }
  }
  __device__ __forceinline__ float apply4(int row, int c0, float4 v0, float4 v1) const {
    quad(row, c0, v0); quad(row, c0 + 16, v1);
    return 0.f;
  }
  __device__ __forceinline__ void ssq_out(int, int, float) const {}
};

template <class F>
__device__ __forceinline__ void tconv(u16* dst, int ldd, int N, int K, int rot, F f) {
  extern __shared__ __attribute__((aligned(16))) char smem[];
  float* t = (float*)smem;
  const int nk = K / 64, nt = (N / 64) * nk, G = gridDim.x;
  const int tid = tidx(), a = tid >> 6, c = tid & 63;
  for (int tile = (int)((blockIdx.x + G - (rot % G)) % G); tile < nt; tile += G) {
    int n0 = (tile / nk) * 64, k0 = (tile % nk) * 64;
    __syncthreads();
#pragma unroll
    for (int i = 0; i < 8; ++i) { int kk = a + 8 * i; t[kk * 65 + c] = f(k0 + kk, n0 + c); }
    __syncthreads();
#pragma unroll
    for (int i = 0; i < 8; ++i) { int nn = a + 8 * i; dst[(size_t)(n0 + nn) * ldd + k0 + c] = f2bf(t[c * 65 + nn]); }
  }
}

template <class F>
__device__ __forceinline__ void tconv_v(u16* dst, int ldd, int N, int K, int vb, int nvb, F f) {
  extern __shared__ __attribute__((aligned(16))) char smem[];
  float* t = (float*)smem;
  const int nk = K / 64, nt = (N / 64) * nk;
  const int tid = tidx(), a = tid >> 6, c = tid & 63;
  for (int tile = vb; tile < nt; tile += nvb) {
    int n0 = (tile / nk) * 64, k0 = (tile % nk) * 64;
    __syncthreads();
#pragma unroll
    for (int i = 0; i < 8; ++i) { int kk = a + 8 * i; t[kk * 65 + c] = f(k0 + kk, n0 + c); }
    __syncthreads();
#pragma unroll
    for (int i = 0; i < 8; ++i) { int nn = a + 8 * i; dst[(size_t)(n0 + nn) * ldd + k0 + c] = f2bf(t[c * 65 + nn]); }
  }
  __syncthreads();
}

template <int DK, int DV, int RPG>
__device__ __forceinline__ void attn_item(const u16* __restrict__ Qb, int ldq, int nrows, const u16* __restrict__ Kb, int ldk,
                                          const u16* __restrict__ Vtb, int ldvt, int nkeys, u16* __restrict__ Ob, int ldo) {
  extern __shared__ __attribute__((aligned(16))) char smem[];
  constexpr int KS = DK + 8, VS = 68;
  u16* sK = (u16*)smem;
  u16* sV = sK + 64 * KS;
  const int tid = tidx(), wid = tid >> 6, lane = tid & 63, q = lane & 31, hh = lane >> 5;
  const int row = wid * 32 + q;
  const bool active = (wid * 32) < nrows;
  bf16x8 qf[DK / 16];
  if (active) {
#pragma unroll
    for (int ks = 0; ks < DK / 16; ++ks) qf[ks] = *(const bf16x8*)(Qb + (size_t)row * ldq + ks * 16 + hh * 8);
  }
  f32x16 o[DV / 32];
#pragma unroll
  for (int dt = 0; dt < DV / 32; ++dt)
#pragma unroll
    for (int i = 0; i < 16; ++i) o[dt][i] = 0.f;
  float mrun = -1e30f, lrun = 0.f;
  const int nkt = nkeys >> 6;
  constexpr int KCH = (64 * (DK / 8) + NTHR - 1) / NTHR;
  static_assert(DV == 128 && KCH <= 4, "staging registers are written out by hand");
  uint4 kr0, kr1, kr2, kr3, vr0, vr1;
#define AT_KL(N_, kt_) { const int c = tid + N_ * NTHR; if (N_ < KCH && c < 64 * (DK / 8)) { const int r = c / (DK / 8), cc = c % (DK / 8); \
      kr##N_ = *(const uint4*)(Kb + (size_t)((kt_) * 64 + r) * ldk + cc * 8); } }
#define AT_VL(N_, kt_) { const int c = tid + N_ * NTHR; const int r = c >> 3, cc = c & 7; vr##N_ = *(const uint4*)(Vtb + (size_t)r * ldvt + (kt_) * 64 + cc * 8); }
#define AT_GLOAD(kt_) do { AT_KL(0, kt_) AT_KL(1, kt_) AT_KL(2, kt_) AT_KL(3, kt_) AT_VL(0, kt_) AT_VL(1, kt_) } while (0)
#define AT_KS(N_) { const int c = tid + N_ * NTHR; if (N_ < KCH && c < 64 * (DK / 8)) { const int r = c / (DK / 8), cc = c % (DK / 8); *(uint4*)(sK + r * KS + cc * 8) = kr##N_; } }
#define AT_VS(N_) { const int c = tid + N_ * NTHR; const int r = c >> 3, cc = c & 7; uint2* d = (uint2*)(sV + r * VS + cc * 8); \
      const uint4 t_ = vr##N_; d[0] = make_uint2(t_.x, t_.y); d[1] = make_uint2(t_.z, t_.w); }
  AT_GLOAD(0);
  for (int kt = 0; kt < nkt; ++kt) {
    __syncthreads();
    AT_KS(0) AT_KS(1) AT_KS(2) AT_KS(3) AT_VS(0) AT_VS(1)
    __syncthreads();
    if (kt + 1 < nkt) AT_GLOAD(kt + 1);
    if (active) {
      f32x16 s0, s1;
#pragma unroll
      for (int i = 0; i < 16; ++i) { s0[i] = 0.f; s1[i] = 0.f; }
#pragma unroll
      for (int ks = 0; ks < DK / 16; ++ks) {
        bf16x8 a0 = *(const bf16x8*)(sK + q * KS + ks * 16 + hh * 8);
        bf16x8 a1 = *(const bf16x8*)(sK + (32 + q) * KS + ks * 16 + hh * 8);
        s0 = __builtin_amdgcn_mfma_f32_32x32x16_bf16(a0, qf[ks], s0, 0, 0, 0);
        s1 = __builtin_amdgcn_mfma_f32_32x32x16_bf16(a1, qf[ks], s1, 0, 0, 0);
      }
      float mx = s0[0];
#pragma unroll
      for (int i = 1; i < 16; ++i) mx = fmaxf(mx, s0[i]);
#pragma unroll
      for (int i = 0; i < 16; ++i) mx = fmaxf(mx, s1[i]);
      mx = fmaxf(mx, __shfl_xor(mx, 32));
      float mn = fmaxf(mrun, mx);
      float alpha = __builtin_amdgcn_exp2f(mrun - mn);
      mrun = mn;
      float ps = 0.f;
#pragma unroll
      for (int i = 0; i < 16; ++i) { s0[i] = __builtin_amdgcn_exp2f(sub_s(s0[i], mn)); ps = add_s(ps, s0[i]); }
#pragma unroll
      for (int i = 0; i < 16; ++i) { s1[i] = __builtin_amdgcn_exp2f(sub_s(s1[i], mn)); ps = add_s(ps, s1[i]); }
      lrun = lrun * alpha + ps;
#pragma unroll
      for (int dt = 0; dt < DV / 32; ++dt)
#pragma unroll
        for (int i = 0; i < 16; ++i) o[dt][i] = mul_s(o[dt][i], alpha);
#pragma unroll
      for (int kb = 0; kb < 2; ++kb)
#pragma unroll
        for (int s = 0; s < 2; ++s) {
          union { bf16x8 v; unsigned u[4]; } pf;
#pragma unroll
          for (int jj = 0; jj < 4; ++jj) {
            float e0 = kb ? s1[8 * s + 2 * jj] : s0[8 * s + 2 * jj];
            float e1 = kb ? s1[8 * s + 2 * jj + 1] : s0[8 * s + 2 * jj + 1];
            pf.u[jj] = pack2(e0, e1);
          }
          const int kbase = kb * 32 + s * 16 + 4 * hh;
#pragma unroll
          for (int dt = 0; dt < DV / 32; ++dt) {
            const u16* vp = sV + (dt * 32 + q) * VS + kbase;
            union { bf16x8 v; uint2 u[2]; } vf;
            vf.u[0] = *(const uint2*)vp; vf.u[1] = *(const uint2*)(vp + 8);
            o[dt] = __builtin_amdgcn_mfma_f32_32x32x16_bf16(vf.v, pf.v, o[dt], 0, 0, 0);
          }
        }
    }
  }
  if (active) {
    lrun += __shfl_xor(lrun, 32);
    float inv = 1.f / lrun;
    u16* op = Ob + (size_t)(row / RPG) * ldo + (size_t)(row % RPG) * DV;
#pragma unroll
    for (int dt = 0; dt < DV / 32; ++dt)
#pragma unroll
      for (int g = 0; g < 4; ++g) {
        uint2 w;
        w.x = pack2(o[dt][4 * g] * inv, o[dt][4 * g + 1] * inv);
        w.y = pack2(o[dt][4 * g + 2] * inv, o[dt][4 * g + 3] * inv);
        *(uint2*)(op + dt * 32 + 8 * g + 4 * hh) = w;
      }
  }
}

#undef AT_GLOAD
#undef AT_KL
#undef AT_VL
#undef AT_KS
#undef AT_VS
__device__ __forceinline__ float dpp_sum16(float x) {
  x += __int_as_float(__builtin_amdgcn_update_dpp(0, __float_as_int(x), 0xB1, 0xF, 0xF, false));
  x += __int_as_float(__builtin_amdgcn_update_dpp(0, __float_as_int(x), 0x4E, 0xF, 0xF, false));
  x += __int_as_float(__builtin_amdgcn_update_dpp(0, __float_as_int(x), 0x141, 0xF, 0xF, false));
  x += __int_as_float(__builtin_amdgcn_update_dpp(0, __float_as_int(x), 0x140, 0xF, 0xF, false));
  return x;
}
__device__ __forceinline__ void scan_item(KPR p, int l, int g0, int h, int half, int nsteps, const float* S0, float* Sout) {
  extern __shared__ __attribute__((aligned(16))) char smem[];
  float* sT = (float*)smem;
  float* sV = sT + 5 * 4096;
  const float* src0 = (const float*)(p.ws + W_RB) + h * 64; const float* src1 = (const float*)(p.ws + W_WB) + h * 64;
  const float* src2 = (const float*)(p.ws + W_KB) + h * 64; const float* src3 = (const float*)(p.ws + W_KKB) + h * 64;
  const float* src4 = (const float*)(p.ws + W_BB) + h * 64;
  const float* VB = (const float*)(p.ws + W_VB) + h * 64 + half * 32;
  float* YB = (float*)(p.ws + W_YB) + h * 64 + half * 32;
  const int tid = tidx();
  const int il = tid >> 4, sub = tid & 15, j0 = sub * 4, i = half * 32 + il;
  float s[4];
#pragma unroll
  for (int j = 0; j < 4; ++j) s[j] = S0 ? S0[i * 64 + j0 + j] : 0.f;
  float4 pa0, pa1, pa2, pa3, pa4, pb0, pb1, pb2, pb3, pb4, pfv;
  const int e0 = tid, e1 = tid + NTHR;
  const int st0 = e0 >> 4, c40 = (e0 & 15) * 4, st1 = e1 >> 4, c41 = (e1 & 15) * 4;
  const int stv = tid >> 3, c4v = (tid & 7) * 4;
#define SC_GL1(x, c0_) pa##x = *(const float4*)(src##x + (size_t)(g0 + (c0_) + st0) * 512 + c40); \
                       pb##x = *(const float4*)(src##x + (size_t)(g0 + (c0_) + st1) * 512 + c41);
#define SC_GLOAD(c0_) do { SC_GL1(0, c0_) SC_GL1(1, c0_) SC_GL1(2, c0_) SC_GL1(3, c0_) SC_GL1(4, c0_) \
    pfv = *(const float4*)(VB + (size_t)(g0 + (c0_) + stv) * 512 + c4v); } while (0)
#define SC_ST1(x) *(float4*)(sT + x * 4096 + st0 * 64 + c40) = pa##x; *(float4*)(sT + x * 4096 + st1 * 64 + c41) = pb##x;
  SC_GLOAD(0);
  for (int c0 = 0; c0 < nsteps; c0 += 64) {
    __syncthreads();
    SC_ST1(0) SC_ST1(1) SC_ST1(2) SC_ST1(3) SC_ST1(4)
    *(float4*)(sV + stv * 32 + c4v) = pfv;
    __syncthreads();
    if (c0 + 64 < nsteps) SC_GLOAD(c0 + 64);
#define SC_LD(S, st_) do { const int _s = (st_) < 64 ? (st_) : 63; \
      S##r = *(const float4*)(sT + _s * 64 + j0); S##w = *(const float4*)(sT + 4096 + _s * 64 + j0); \
      S##k = *(const float4*)(sT + 8192 + _s * 64 + j0); S##q = *(const float4*)(sT + 12288 + _s * 64 + j0); \
      S##b = *(const float4*)(sT + 16384 + _s * 64 + j0); S##v = sV[_s * 32 + il]; } while (0)
#define SC_STEP(S, st_) do { \
      float sa = -dpp_sum16(fma_s(s[1], S##q.y, mul_s(s[0], S##q.x)) + fma_s(s[3], S##q.w, mul_s(s[2], S##q.z))); \
      s[0] = fma_s(sa, S##b.x, fma_s(s[0], S##w.x, mul_s(S##v, S##k.x))); \
      s[1] = fma_s(sa, S##b.y, fma_s(s[1], S##w.y, mul_s(S##v, S##k.y))); \
      s[2] = fma_s(sa, S##b.z, fma_s(s[2], S##w.z, mul_s(S##v, S##k.z))); \
      s[3] = fma_s(sa, S##b.w, fma_s(s[3], S##w.w, mul_s(S##v, S##k.w))); \
      float y = dpp_sum16(fma_s(s[1], S##r.y, mul_s(s[0], S##r.x)) + fma_s(s[3], S##r.w, mul_s(s[2], S##r.z))); \
      ykeep = (sub == ((st_) & 15)) ? y : ykeep; } while (0)
    float4 Ar, Aw, Ak, Aq, Ab, Br, Bw, Bk, Bq, Bb, Cr, Cw, Ck, Cq, Cb, Dr, Dw, Dk, Dq, Db;
    float Av, Bv, Cv, Dv, ykeep = 0.f;
    SC_LD(A, 0); SC_LD(B, 1); SC_LD(C, 2);
    for (int st = 0; st < 64; st += 4) {
      SC_LD(D, st + 3); SC_STEP(A, st);
      SC_LD(A, st + 4); SC_STEP(B, st + 1);
      SC_LD(B, st + 5); SC_STEP(C, st + 2);
      SC_LD(C, st + 6); SC_STEP(D, st + 3);
      if ((st & 15) == 12) YB[(size_t)(g0 + c0 + (st - 12) + sub) * 512 + il] = ykeep;
    }
  }
#undef SC_LD
#undef SC_STEP
#undef SC_GLOAD
#undef SC_GL1
#undef SC_ST1
  *(float4*)(Sout + i * 64 + j0) = make_float4(s[0], s[1], s[2], s[3]);
}

constexpr int LS = 68;
constexpr int LBUF = 64 * LS;
constexpr int LH = 72;

__device__ __forceinline__ void split8(const float* x, bf16x8& hi, bf16x8& lo) {
  union { bf16x8 v; unsigned u[4]; } H, Lo;
#pragma unroll
  for (int j = 0; j < 4; ++j) {
    const unsigned h = pack2(x[2 * j], x[2 * j + 1]);
    H.u[j] = h;
    Lo.u[j] = pack2(x[2 * j] - __uint_as_float(h << 16), x[2 * j + 1] - __uint_as_float(h & 0xffff0000u));
  }
  hi = H.v; lo = Lo.v;
}
template <int AM, int AK, int BKS, int BN>
__device__ __forceinline__ void mm64(const float* A, const float* B, f32x4 (&acc)[2], int m0, int n0, int lane) {
  const int lr = lane & 15, lq = lane >> 4;
#pragma unroll
  for (int ks = 0; ks < 2; ++ks) {
    const int k0 = ks * 32 + lq * 8;
    float a[8];
    if (AK == 1) {
      float4 x0 = *(const float4*)(A + (m0 + lr) * AM + k0), x1 = *(const float4*)(A + (m0 + lr) * AM + k0 + 4);
      a[0] = x0.x; a[1] = x0.y; a[2] = x0.z; a[3] = x0.w; a[4] = x1.x; a[5] = x1.y; a[6] = x1.z; a[7] = x1.w;
    } else {
#pragma unroll
      for (int j = 0; j < 8; ++j) a[j] = A[(m0 + lr) * AM + (k0 + j) * AK];
    }
    bf16x8 ah, al; split8(a, ah, al);
#pragma unroll
    for (int nt = 0; nt < 2; ++nt) {
      const int n = n0 + nt * 16 + lr;
      float b[8];
      if (BKS == 1) {
        float4 x0 = *(const float4*)(B + n * BN + k0), x1 = *(const float4*)(B + n * BN + k0 + 4);
        b[0] = x0.x; b[1] = x0.y; b[2] = x0.z; b[3] = x0.w; b[4] = x1.x; b[5] = x1.y; b[6] = x1.z; b[7] = x1.w;
      } else {
#pragma unroll
        for (int j = 0; j < 8; ++j) b[j] = B[(k0 + j) * BKS + n * BN];
      }
      bf16x8 bh, bl; split8(b, bh, bl);
      acc[nt] = __builtin_amdgcn_mfma_f32_16x16x32_bf16(ah, bh, acc[nt], 0, 0, 0);
      acc[nt] = __builtin_amdgcn_mfma_f32_16x16x32_bf16(ah, bl, acc[nt], 0, 0, 0);
      acc[nt] = __builtin_amdgcn_mfma_f32_16x16x32_bf16(al, bh, acc[nt], 0, 0, 0);
    }
  }
}
#define MM_ZERO(acc) do { acc[0] = f32x4{0.f, 0.f, 0.f, 0.f}; acc[1] = f32x4{0.f, 0.f, 0.f, 0.f}; } while (0)
#define MM_FOREACH(acc, BODY) do { _Pragma("unroll") for (int nt_ = 0; nt_ < 2; ++nt_) _Pragma("unroll") for (int rg_ = 0; rg_ < 4; ++rg_) { \
    const int m = m0 + lq * 4 + rg_, n = n0 + nt_ * 16 + lr; const float val = acc[nt_][rg_]; BODY } } while (0)

__device__ __forceinline__ void cprep_item(KPR p, int grow0, int h, int cid) {
  extern __shared__ __attribute__((aligned(16))) char smem[];
  float* B0 = (float*)smem; float* B1 = B0 + LBUF; float* B2 = B1 + LBUF; float* B3 = B2 + LBUF;
  float* B4 = B3 + LBUF; float* B5 = B4 + LBUF; float* B6 = B5 + LBUF; float* B7 = B6 + LBUF;
  float* wC = (float*)(smem + 139264);
  const int tid = tidx(), wid = tid >> 6, lane = tid & 63, lr = lane & 15, lq = lane >> 4;
  const int m0 = (wid >> 1) * 16, n0 = (wid & 1) * 32;
  const float* WB = (const float*)(p.ws + W_WB) + h * 64; const float* KKB = (const float*)(p.ws + W_KKB) + h * 64;
  const float* BB = (const float*)(p.ws + W_BB) + h * 64; const float* KB = (const float*)(p.ws + W_KB) + h * 64;
  const float* RB = (const float*)(p.ws + W_RB) + h * 64; const float* VB = (const float*)(p.ws + W_VB) + h * 64;
  f32x4 acc[2];
  __syncthreads();
#pragma unroll
  for (int q = 0; q < 2; ++q) {
    const int e = tid + q * NTHR, t = e >> 4, c4 = (e & 15) * 4;
    const size_t gi = (size_t)(grow0 + t) * 512 + c4;
    *(float4*)(B0 + t * LS + c4) = *(const float4*)(WB + gi);
    float4 kk = *(const float4*)(KKB + gi);
    *(float4*)(B1 + t * LS + c4) = make_float4(-kk.x, -kk.y, -kk.z, -kk.w);
    *(float4*)(B2 + t * LS + c4) = *(const float4*)(BB + gi);
    *(float4*)(B3 + t * LS + c4) = *(const float4*)(KB + gi);
    *(float4*)(B4 + t * LS + c4) = *(const float4*)(RB + gi);
  }
  __syncthreads();
  {
    const int j = tid & 63, sg = tid >> 6;
    float wv[8];
#pragma unroll
    for (int u = 0; u < 8; ++u) wv[u] = B0[(sg * 8 + u) * LS + j];
#pragma unroll
    for (int u = 1; u < 8; ++u) wv[u] *= wv[u - 1];
    float* segp = B5;
    segp[sg * 64 + j] = wv[7];
    __syncthreads();
    float pre = 1.f;
    for (int u = 0; u < sg; ++u) pre *= segp[u * 64 + j];
#pragma unroll
    for (int u = 0; u < 8; ++u) B0[(sg * 8 + u) * LS + j] = wv[u] * pre;
    if (sg == 7) wC[j] = wv[7] * pre;
  }
  __syncthreads();
  for (int e = tid; e < 4096; e += NTHR) {
    const int t = e >> 6, j = e & 63, o = t * LS + j;
    const float wt = B0[o], wp = t ? B0[o - LS] : 1.f, iw = 1.f / wt;
    B1[o] *= wp; B2[o] *= iw; B3[o] *= iw; B4[o] *= wt;
  }
  __syncthreads();
  MM_ZERO(acc); mm64<LS, 1, 1, LS>(B2, B1, acc, m0, n0, lane);
  MM_FOREACH(acc, { const float v = m < n ? val : 0.f; B5[m * LS + n] = v; B6[m * LS + n] = v + (m == n ? 1.f : 0.f); });
  __syncthreads();
  MM_ZERO(acc); mm64<LS, 1, LS, 1>(B5, B5, acc, m0, n0, lane);
  MM_FOREACH(acc, { B7[m * LS + n] = val; });
  __syncthreads();
  for (int it = 0; it < 5; ++it) {
    MM_ZERO(acc); mm64<LS, 1, LS, 1>(B6, B7, acc, m0, n0, lane);
    f32x4 acc2[2]; MM_ZERO(acc2);
    if (it < 4) mm64<LS, 1, LS, 1>(B7, B7, acc2, m0, n0, lane);
    __syncthreads();
    MM_FOREACH(acc, { B6[m * LS + n] += val; });
    if (it < 4) MM_FOREACH(acc2, { B7[m * LS + n] = val; });
    __syncthreads();
  }
  MM_ZERO(acc); mm64<1, LS, LS, 1>(B1, B6, acc, m0, n0, lane);
  MM_FOREACH(acc, { B5[m * LS + n] = val; });
  MM_ZERO(acc); mm64<LS, 1, 1, LS>(B3, B1, acc, m0, n0, lane);
  MM_FOREACH(acc, { B0[m * LS + n] = m < n ? val : 0.f; });
  __syncthreads();
  MM_ZERO(acc); mm64<LS, 1, LS, 1>(B0, B6, acc, m0, n0, lane);
  MM_FOREACH(acc, { B7[m * LS + n] = val; });
  __syncthreads();
  MM_ZERO(acc); mm64<LS, 1, 1, LS>(B2, B4, acc, m0, n0, lane);
  {
    f32x4 acc2[2]; MM_ZERO(acc2); mm64<LS, 1, 1, LS>(B3, B4, acc2, m0, n0, lane);
    __syncthreads();
    MM_FOREACH(acc, { B0[m * LS + n] = m <= n ? val : 0.f; });
    MM_FOREACH(acc2, { B1[m * LS + n] = m <= n ? val : 0.f; });
  }
  __syncthreads();
  {
    u16* RRT = (u16*)(p.ws + W_CRR) + (size_t)cid * 4096;
    MM_ZERO(acc); mm64<1, LS, 1, LS>(B0, B5, acc, m0, n0, lane);
    MM_FOREACH(acc, { RRT[m * 64 + n] = f2bf(val + B4[m * LS + n]); });
    MM_ZERO(acc); mm64<LS, 1, LS, 1>(B7, B0, acc, m0, n0, lane);
    MM_FOREACH(acc, { B6[m * LS + n] = val + B1[m * LS + n]; });
  }
  __syncthreads();
  for (int e = tid; e < 4096; e += NTHR) {
    const int t = e >> 6, j = e & 63, o = t * LS + j;
    const float wc = wC[j];
    B2[o] *= wc; B3[o] *= wc;
  }
#pragma unroll
  for (int q = 0; q < 2; ++q) {
    const int e = tid + q * NTHR, t = e >> 4, c4 = (e & 15) * 4;
    *(float4*)(B4 + t * LS + c4) = *(const float4*)(VB + (size_t)(grow0 + t) * 512 + c4);
  }
  __syncthreads();
  {
    float* YB = (float*)(p.ws + W_YB) + h * 64;
    MM_ZERO(acc); mm64<1, LS, LS, 1>(B6, B4, acc, m0, n0, lane);
    MM_FOREACH(acc, { YB[(size_t)(grow0 + m) * 512 + n] = val; });
    u16* PT = (u16*)(p.ws + W_CPT) + (size_t)cid * 4096;
    MM_ZERO(acc); mm64<1, LS, 1, LS>(B2, B5, acc, m0, n0, lane);
    MM_FOREACH(acc, { PT[m * 64 + n] = f2bf(val + (m == n ? wC[m] : 0.f)); });
    MM_ZERO(acc); mm64<LS, 1, LS, 1>(B7, B2, acc, m0, n0, lane);
    MM_FOREACH(acc, { B0[m * LS + n] = val + B3[m * LS + n]; });
  }
  __syncthreads();
  {
    float* CQ = (float*)(p.ws + W_CQ) + (size_t)cid * 4096;
    MM_ZERO(acc); mm64<1, LS, LS, 1>(B4, B0, acc, m0, n0, lane);
    MM_FOREACH(acc, { CQ[m * 64 + n] = val; });
  }
}

__device__ __forceinline__ void phase_cprep(KPR p) {
  for (int id = blockIdx.x; id < 2304; id += gridDim.x) {
    if (id < 2048) { int b = id >> 9, h = (id >> 6) & 7, c = id & 63; cprep_item(p, b * 4096 + c * 64, h, id); }
    else { int k = id - 2048; cprep_item(p, TP + (k >> 3) * 64, k & 7, id); }
  }
}

__device__ __forceinline__ void cseq_item(KPR p, int g0, int h, int nch, int cid0, const float* S0, float* Sout) {
  extern __shared__ __attribute__((aligned(16))) char smem[];
  float* Sf = (float*)smem;
  float* Qf = Sf + LBUF;
  float* Yf = Qf + LBUF;
  u16* Rb = (u16*)(Yf + LBUF);
  u16* Pb = Rb + 64 * LH;
  const int tid = tidx(), wid = tid >> 6, lane = tid & 63, lr = lane & 15, lq = lane >> 4;
  const int m0 = (wid >> 1) * 16, n0 = (wid & 1) * 32;
  float* YB = (float*)(p.ws + W_YB) + h * 64;
  const u16* RRT = (const u16*)(p.ws + W_CRR) + (size_t)cid0 * 4096;
  const u16* PT = (const u16*)(p.ws + W_CPT) + (size_t)cid0 * 4096;
  const float* CQ = (const float*)(p.ws + W_CQ) + (size_t)cid0 * 4096;
  __syncthreads();
  for (int e = tid; e < 4096; e += NTHR) { const int i = e >> 6, j = e & 63; Sf[i * LS + j] = S0 ? S0[e] : 0.f; }
  const int hr = tid >> 3, hc = (tid & 7) * 8;
  const int f0t = tid >> 4, f0c = (tid & 15) * 4;
  uint4 pr, pp; float4 q0, q1, y0, y1;
#define CS_LOAD(c_) do { \
    pr = *(const uint4*)(RRT + (size_t)(c_) * 4096 + hr * 64 + hc); pp = *(const uint4*)(PT + (size_t)(c_) * 4096 + hr * 64 + hc); \
    q0 = *(const float4*)(CQ + (size_t)(c_) * 4096 + f0t * 64 + f0c); q1 = *(const float4*)(CQ + (size_t)(c_) * 4096 + (f0t + 32) * 64 + f0c); \
    y0 = *(const float4*)(YB + (size_t)(g0 + (c_) * 64 + f0t) * 512 + f0c); y1 = *(const float4*)(YB + (size_t)(g0 + (c_) * 64 + f0t + 32) * 512 + f0c); } while (0)
  CS_LOAD(0);
  for (int c = 0; c < nch; ++c) {
    __syncthreads();
    *(uint4*)(Rb + hr * LH + hc) = pr; *(uint4*)(Pb + hr * LH + hc) = pp;
    *(float4*)(Qf + f0t * LS + f0c) = q0; *(float4*)(Qf + (f0t + 32) * LS + f0c) = q1;
    *(float4*)(Yf + f0t * LS + f0c) = y0; *(float4*)(Yf + (f0t + 32) * LS + f0c) = y1;
    __syncthreads();
    if (c + 1 < nch) CS_LOAD(c + 1);
    f32x4 ay[2], as[2]; MM_ZERO(ay); MM_ZERO(as);
#pragma unroll
    for (int ks = 0; ks < 2; ++ks) {
      const int k0 = ks * 32 + lq * 8;
      const bf16x8 ra = *(const bf16x8*)(Rb + (m0 + lr) * LH + k0);
      float sa[8];
      { float4 x0 = *(const float4*)(Sf + (m0 + lr) * LS + k0), x1 = *(const float4*)(Sf + (m0 + lr) * LS + k0 + 4);
        sa[0] = x0.x; sa[1] = x0.y; sa[2] = x0.z; sa[3] = x0.w; sa[4] = x1.x; sa[5] = x1.y; sa[6] = x1.z; sa[7] = x1.w; }
      bf16x8 sah, sal; split8(sa, sah, sal);
#pragma unroll
      for (int nt = 0; nt < 2; ++nt) {
        const int n = n0 + nt * 16 + lr;
        float sb[8];
        { float4 x0 = *(const float4*)(Sf + n * LS + k0), x1 = *(const float4*)(Sf + n * LS + k0 + 4);
          sb[0] = x0.x; sb[1] = x0.y; sb[2] = x0.z; sb[3] = x0.w; sb[4] = x1.x; sb[5] = x1.y; sb[6] = x1.z; sb[7] = x1.w; }
        bf16x8 sbh, sbl; split8(sb, sbh, sbl);
        ay[nt] = __builtin_amdgcn_mfma_f32_16x16x32_bf16(ra, sbh, ay[nt], 0, 0, 0);
        ay[nt] = __builtin_amdgcn_mfma_f32_16x16x32_bf16(ra, sbl, ay[nt], 0, 0, 0);
        const bf16x8 pb = *(const bf16x8*)(Pb + n * LH + k0);
        as[nt] = __builtin_amdgcn_mfma_f32_16x16x32_bf16(sah, pb, as[nt], 0, 0, 0);
        as[nt] = __builtin_amdgcn_mfma_f32_16x16x32_bf16(sal, pb, as[nt], 0, 0, 0);
      }
    }
    MM_FOREACH(ay, { YB[(size_t)(g0 + c * 64 + m) * 512 + n] = val + Yf[m * LS + n]; });
    __syncthreads();
    MM_FOREACH(as, { Sf[m * LS + n] = val + Qf[m * LS + n]; });
  }
#undef CS_LOAD
  __syncthreads();
  for (int e = tid; e < 4096; e += NTHR) { const int i = e >> 6, j = e & 63; Sout[e] = Sf[i * LS + j]; }
}

__device__ __forceinline__ void phase_yfin(KPR p, int l) {
  const int tid = tidx(), wid = tid >> 6, lane = tid & 63;
  const float* YB = (const float*)(p.ws + W_YB); const float* RB = (const float*)(p.ws + W_RB); const float* KB = (const float*)(p.ws + W_KB);
  const float* VB = (const float*)(p.ws + W_VB); const u16* GB = (const u16*)(p.ws + W_GB); u16* AO = (u16*)(p.ws + W_AO);
  const float* rk = p.in[I_RK] + l * 512; const float* gng = p.in[I_GNG] + l * 512; const float* gnb = p.in[I_GNB] + l * 512;
  for (int g = blockIdx.x * 8 + wid; g < T; g += gridDim.x * 8) {
#pragma unroll 2
    for (int h = 0; h < 8; ++h) {
      size_t i = (size_t)g * 512 + h * 64 + lane;
      float y = YB[i];
      float mu = wave_sum(y) * (1.f / 64.f);
      float dlt = y - mu;
      float var = wave_sum(dlt * dlt) * (1.f / 64.f);
      float bon = wave_sum(RB[i] * KB[i] * rk[h * 64 + lane]);
      float v = dlt * rsqrtf(var + 64e-5f) * gng[h * 64 + lane] + gnb[h * 64 + lane] + bon * VB[i];
      AO[(size_t)g * 1536 + 1024 + h * 64 + lane] = f2bf(v * bf2f(GB[i]));
    }
  }
}

__device__ __forceinline__ void phase_init(KPR p) {
  const int G = gridDim.x, tid = tidx(), wid = tid >> 6, lane = tid & 63;
  const int gw = blockIdx.x * 8 + wid, nw = G * 8;
  if (blockIdx.x == 0) for (int i = tid; i < 8192; i += NTHR) ((int*)(p.ws + W_CNT))[i] = 0;
  {
    float* X = (float*)(p.ws + W_X); u16* XB = (u16*)(p.ws + W_XB); float* SSQ = (float*)(p.ws + W_SSQ);
    for (int g = gw; g < T; g += nw) {
      const float* src = g < TP ? p.in[I_XP] + (size_t)g * 1024 : p.in[I_XS] + (size_t)(g - TP) * 1024;
      float ss = 0.f;
#pragma unroll
      for (int i = 0; i < 4; ++i) {
        float4 v = *(const float4*)(src + i * 256 + lane * 4);
        *(float4*)(X + (size_t)g * 1024 + i * 256 + lane * 4) = v;
        uint2 w; w.x = pack2(v.x, v.y); w.y = pack2(v.z, v.w);
        *(uint2*)(XB + (size_t)g * 1024 + i * 256 + lane * 4) = w;
        ss += v.x * v.x + v.y * v.y + v.z * v.z + v.w * v.w;
      }
      ss = wave_sum(ss);
      if (lane == 0) *(float4*)(SSQ + (size_t)g * 4) = make_float4(ss, 0.f, 0.f, 0.f);
    }
  }
  {
    u16* MB = (u16*)(p.ws + W_MB);
    for (int g = gw; g < 1024; g += nw) {
      const float* src = p.in[I_MEMP] + (size_t)g * 1024;
      float4 v[4]; float ss = 0.f;
#pragma unroll
      for (int i = 0; i < 4; ++i) { v[i] = *(const float4*)(src + i * 256 + lane * 4); ss += v[i].x * v[i].x + v[i].y * v[i].y + v[i].z * v[i].z + v[i].w * v[i].w; }
      ss = wave_sum(ss);
      float rs = rsqrtf(ss * (1.f / 1024.f) + 1e-6f);
#pragma unroll
      for (int i = 0; i < 4; ++i) {
        uint2 w; w.x = pack2(v[i].x * rs, v[i].y * rs); w.y = pack2(v[i].z * rs, v[i].w * rs);
        *(uint2*)(MB + (size_t)g * 1024 + i * 256 + lane * 4) = w;
      }
    }
  }
  {
    float2* RT = (float2*)(p.ws + W_ROPE);
    for (int e = blockIdx.x * NTHR + tid; e < 4096 * 16; e += G * NTHR) {
      int pos = e >> 4, i = e & 15;
      float inv = powf(10000.f, -(float)i / 16.f);
      float ang = (float)pos * inv;
      float sn, cs; sincosf(ang, &sn, &cs);
      RT[e] = make_float2(cs, sn);
    }
  }
  int rot = 0;
  for (int l = 0; l < NL; ++l) {
    u16* WT = (u16*)(p.ws + W_WT) + (size_t)l * WE_LAYER;
    for (int f = 0; f < 2; ++f) {
      const float* nrm = p.in[f ? I_F2N : I_F1N] + l * 1024;
      const float* wg = p.in[f ? I_F2G : I_F1G] + (size_t)l * 1024 * DFF;
      const float* wu = p.in[f ? I_F2U : I_F1U] + (size_t)l * 1024 * DFF;
      const float* wd = p.in[f ? I_F2D : I_F1D] + (size_t)l * 1024 * DFF;
      tconv(WT + (f ? WE_GU2 : WE_GU1), 1024, 5632, 1024, rot, [=](int k, int n) {
        int j = (n >> 5) * 16 + (n & 15);
        const float* s = ((n >> 4) & 1) ? wu : wg;
        return nrm[k] * s[(size_t)k * DFF + j];
      });
      rot += 88 * 16;
      tconv(WT + (f ? WE_D2 : WE_D1), DFF, 1024, DFF, rot, [=](int k, int n) { return wd[(size_t)k * 1024 + n]; });
      rot += 16 * 44;
    }
    {
      const float* nrm = p.in[I_MIXN] + l * 1024; const float* w = p.in[I_WIN] + (size_t)l * 1024 * DIN;
      tconv(WT + WE_IN, 1024, DINP, 1024, rot, [=](int k, int n) { return n < DIN ? nrm[k] * w[(size_t)k * DIN + n] : 0.f; });
      rot += 36 * 16;
    }
    {
      const float* nrm = p.in[I_QN] + l * 256; const float* wuq = p.in[I_WUQ] + (size_t)l * 256 * 768;
      const float* wuk = p.in[I_WUK] + (size_t)l * 8 * 128 * 64;
      tconv(WT + WE_Q, 256, 1280, 256, rot, [=](int k, int n) {
        float r;
        if (n < 1024) {
          int h = n >> 7, c = n & 127;
          const float* a = wuq + (size_t)k * 768 + h * 96; const float* b = wuk + (size_t)(h * 128 + c) * 64;
          r = 0.f;
          for (int d = 0; d < 64; ++d) r += a[d] * b[d];
        } else {
          int hr = n - 1024;
          r = wuq[(size_t)k * 768 + (hr >> 5) * 96 + 64 + (hr & 31)];
        }
        return r * nrm[k] * QSCALE;
      });
      rot += 20 * 4;
    }
    {
      const float* wup = p.in[I_WUP] + (size_t)l * 64 * 512; const float* aup = p.in[I_AUP] + (size_t)l * 64 * 512;
      const float* gup = p.in[I_GUP] + (size_t)l * 128 * 512;
      tconv(WT + WE_RW, 256, 1536, 256, rot, [=](int k, int n) {
        if (n < 512) return k < 64 ? wup[k * 512 + n] : 0.f;
        if (n < 1024) return (k >= 64 && k < 128) ? aup[(k - 64) * 512 + n - 512] : 0.f;
        return k >= 128 ? gup[(k - 128) * 512 + n - 1024] : 0.f;
      });
      rot += 24 * 4;
    }
    {
      const float* wuv = p.in[I_WUV] + (size_t)l * 8 * 128 * 64; const float* wo = p.in[I_WOUT] + (size_t)l * 1024 * 1024;
      tconv(WT + WE_OUT, 1536, 1024, 1536, rot, [=](int k, int n) {
        if (k < 1024) {
          int h = k >> 7, c = k & 127;
          const float* a = wuv + (size_t)(h * 128 + c) * 64; const float* b = wo + (size_t)(h * 64) * 1024 + n;
          float r = 0.f;
          for (int v = 0; v < 64; ++v) r += a[v] * b[(size_t)v * 1024];
          return r;
        }
        return wo[(size_t)(512 + k - 1024) * 1024 + n];
      });
      rot += 16 * 24;
    }
    {
      const float* nx = p.in[I_XN] + l * 1024; const float* nm = p.in[I_MKVN] + l * 1024;
      const float* wq = p.in[I_WMQ] + (size_t)l * 1048576; const float* wk = p.in[I_WMK] + (size_t)l * 1048576;
      const float* wv = p.in[I_WMV] + (size_t)l * 1048576; const float* wo = p.in[I_WMO] + (size_t)l * 1048576;
      tconv(WT + WE_MQ, 1024, 1024, 1024, rot, [=](int k, int n) { return nx[k] * wq[(size_t)k * 1024 + n] * XSCALE; });
      tconv(WT + WE_MK, 1024, 1024, 1024, rot, [=](int k, int n) { return nm[k] * wk[(size_t)k * 1024 + n]; });
      tconv(WT + WE_MV, 1024, 1024, 1024, rot, [=](int k, int n) { return nm[k] * wv[(size_t)k * 1024 + n]; });
      tconv(WT + WE_MO, 1024, 1024, 1024, rot, [=](int k, int n) { return wo[(size_t)k * 1024 + n]; });
    }
  }
}

__device__ __forceinline__ void phase_prep(KPR p, int l) {
  const int G = gridDim.x, tid = tidx(), wid = tid >> 6, lane = tid & 63;
  const int gw = blockIdx.x * 8 + wid, nw = G * 8;
  const u16* PROJ = (const u16*)(p.ws + W_PROJ);
  u16* CQB = (u16*)(p.ws + W_CQB); u16* A2 = (u16*)(p.ws + W_A2);
  float* RB = (float*)(p.ws + W_RB); float* KB = (float*)(p.ws + W_KB); float* VB = (float*)(p.ws + W_VB); float* KKB = (float*)(p.ws + W_KKB);
  u16* KP = (u16*)(p.ws + W_KP); u16* KS = (u16*)(p.ws + W_KS); u16* VTP = (u16*)(p.ws + W_VTP); u16* VTS = (u16*)(p.ws + W_VTS);
  const float2* RT = (const float2*)(p.ws + W_ROPE);
  const float* kvn = p.in[I_KVN] + l * 128; const float* mu = p.in[I_MU] + l * DSH; const float* kkw = p.in[I_KK] + l * 512;
  for (int g = gw; g < T; g += nw) {
    const u16* pr = PROJ + (size_t)g * DINP;
    const bool isP = g < TP;
    int b, t, pos, tlen;
    if (isP) { b = g >> 12; t = g & 4095; pos = t; tlen = 4096; } else { int gg = g - TP; b = gg >> 6; t = gg & 63; pos = 2048 + t; tlen = 64; }
    {
      uint2 w = *(const uint2*)(pr + lane * 4);
      float v0 = bf2f(w.x & 0xffff), v1 = bf2f(w.x >> 16), v2 = bf2f(w.y & 0xffff), v3 = bf2f(w.y >> 16);
      float ss = wave_sum(v0 * v0 + v1 * v1 + v2 * v2 + v3 * v3);
      float rs = rsqrtf(ss * (1.f / 256.f) + 1e-6f);
      uint2 o; o.x = pack2(v0 * rs, v1 * rs); o.y = pack2(v2 * rs, v3 * rs);
      *(uint2*)(CQB + (size_t)g * 256 + lane * 4) = o;
    }
    {
      unsigned w = *(const unsigned*)(pr + 256 + lane * 2);
      float v0 = bf2f(w & 0xffff), v1 = bf2f(w >> 16);
      float ss = wave_sum(v0 * v0 + v1 * v1);
      float rs = rsqrtf(ss * (1.f / 128.f) + 1e-6f);
      int c = lane * 2;
      v0 = v0 * rs * kvn[c]; v1 = v1 * rs * kvn[c + 1];
      float* of = isP ? p.out + OO_CKVP + ((size_t)(l * 4 + b) * 4096 + t) * 128 : p.out + OO_CKVS + ((size_t)(l * 32 + b) * 64 + t) * 128;
      *(float2*)(of + c) = make_float2(v0, v1);
      u16* kr = isP ? KP + ((size_t)b * 4096 + t) * 160 : KS + ((size_t)b * 2112 + 2048 + t) * 160;
      *(unsigned*)(kr + c) = pack2(v0, v1);
      if (isP) { VTP[((size_t)b * 128 + c) * 4096 + t] = f2bf(v0); VTP[((size_t)b * 128 + c + 1) * 4096 + t] = f2bf(v1); }
      else { VTS[((size_t)b * 128 + c) * 2112 + 2048 + t] = f2bf(v0); VTS[((size_t)b * 128 + c + 1) * 2112 + 2048 + t] = f2bf(v1); }
      if (lane < 16) {
        float x1 = bf2f(pr[384 + lane]), x2 = bf2f(pr[400 + lane]);
        float2 cs = RT[pos * 16 + lane];
        float o1 = x1 * cs.x - x2 * cs.y, o2 = x1 * cs.y + x2 * cs.x;
        float* okr = isP ? p.out + OO_KRP + ((size_t)(l * 4 + b) * 4096 + t) * 32 : p.out + OO_KRS + ((size_t)(l * 32 + b) * 64 + t) * 32;
        okr[lane] = o1; okr[lane + 16] = o2;
        kr[128 + lane] = f2bf(o1); kr[144 + lane] = f2bf(o2);
      }
    }
    {
      const u16* pb = pr + 416;
      const u16* pp = pr - DINP + 416;
      const float* sh0 = p.in[I_SSH] + (size_t)(l * 32 + b) * DSH;
      const bool last = (t == tlen - 1);
      float* osh = isP ? p.out + OO_SHP + (size_t)(l * 4 + b) * DSH : p.out + OO_SHS + (size_t)(l * 32 + b) * DSH;
#pragma unroll
      for (int it = 0; it < 4; ++it) {
        const int c = it * 64 + lane;
        if (c < 224) {
          const int e = c * 8;
          uint4 w = *(const uint4*)(pb + e);
          float pv[8] = {bf2f(w.x & 0xffff), bf2f(w.x >> 16), bf2f(w.y & 0xffff), bf2f(w.y >> 16), bf2f(w.z & 0xffff), bf2f(w.z >> 16), bf2f(w.w & 0xffff), bf2f(w.w >> 16)};
          float pq[8];
          if (t > 0) {
            uint4 q = *(const uint4*)(pp + e);
            pq[0] = bf2f(q.x & 0xffff); pq[1] = bf2f(q.x >> 16); pq[2] = bf2f(q.y & 0xffff); pq[3] = bf2f(q.y >> 16);
            pq[4] = bf2f(q.z & 0xffff); pq[5] = bf2f(q.z >> 16); pq[6] = bf2f(q.w & 0xffff); pq[7] = bf2f(q.w >> 16);
          } else if (!isP) {
            float4 q0 = *(const float4*)(sh0 + e), q1 = *(const float4*)(sh0 + e + 4);
            pq[0] = q0.x; pq[1] = q0.y; pq[2] = q0.z; pq[3] = q0.w; pq[4] = q1.x; pq[5] = q1.y; pq[6] = q1.z; pq[7] = q1.w;
          } else {
#pragma unroll
            for (int j = 0; j < 8; ++j) pq[j] = 0.f;
          }
          float4 m0 = *(const float4*)(mu + e), m1 = *(const float4*)(mu + e + 4);
          float mm[8] = {m0.x, m0.y, m0.z, m0.w, m1.x, m1.y, m1.z, m1.w};
          float xs[8];
#pragma unroll
          for (int j = 0; j < 8; ++j) xs[j] = pv[j] + mm[j] * (pq[j] - pv[j]);
          if (last) { *(float4*)(osh + e) = make_float4(pv[0], pv[1], pv[2], pv[3]); *(float4*)(osh + e + 4) = make_float4(pv[4], pv[5], pv[6], pv[7]); }
          if (it == 0) {
            float* o = RB + (size_t)g * 512 + e;
            *(float4*)o = make_float4(xs[0], xs[1], xs[2], xs[3]); *(float4*)(o + 4) = make_float4(xs[4], xs[5], xs[6], xs[7]);
          } else if (it == 1) {
            const int cc = e - 512;
            float* o = KB + (size_t)g * 512 + cc;
            *(float4*)o = make_float4(xs[0], xs[1], xs[2], xs[3]); *(float4*)(o + 4) = make_float4(xs[4], xs[5], xs[6], xs[7]);
            float4 k0 = *(const float4*)(kkw + cc), k1 = *(const float4*)(kkw + cc + 4);
            float kk[8] = {xs[0] * k0.x, xs[1] * k0.y, xs[2] * k0.z, xs[3] * k0.w, xs[4] * k1.x, xs[5] * k1.y, xs[6] * k1.z, xs[7] * k1.w};
            float ss = 0.f;
#pragma unroll
            for (int j = 0; j < 8; ++j) ss += kk[j] * kk[j];
            ss = dpp_sum8(ss);
            float rn = rsqrtf(ss + 1e-12f);
            float* o2 = KKB + (size_t)g * 512 + cc;
            *(float4*)o2 = make_float4(kk[0] * rn, kk[1] * rn, kk[2] * rn, kk[3] * rn); *(float4*)(o2 + 4) = make_float4(kk[4] * rn, kk[5] * rn, kk[6] * rn, kk[7] * rn);
          } else if (it == 2) {
            float* o = VB + (size_t)g * 512 + (e - 1024);
            *(float4*)o = make_float4(xs[0], xs[1], xs[2], xs[3]); *(float4*)(o + 4) = make_float4(xs[4], xs[5], xs[6], xs[7]);
          } else {
            const int cc = e - 1536;
            float y[8];
#pragma unroll
            for (int j = 0; j < 8; ++j) y[j] = cc < 64 ? tanhf(xs[j]) : (cc < 128 ? xs[j] : sigmoidf_(xs[j]));
            uint4 o; o.x = pack2(y[0], y[1]); o.y = pack2(y[2], y[3]); o.z = pack2(y[4], y[5]); o.w = pack2(y[6], y[7]);
            *(uint4*)(A2 + (size_t)g * 256 + cc) = o;
          }
        }
      }
    }
  }
}

__device__ __forceinline__ void conv_caches(KPR p, int l, int vb, int nvb) {
  const int tid = tidx();
  u16* KS = (u16*)(p.ws + W_KS); u16* VTS = (u16*)(p.ws + W_VTS);
  {
    const float* cckv = p.in[I_CCKV] + (size_t)l * 32 * 2048 * 128;
    const float* ckr = p.in[I_CKR] + (size_t)l * 32 * 2048 * 32;
    for (int idx = vb * NTHR + tid; idx < 32 * 2048 * 20; idx += nvb * NTHR) {
      int rowi = idx / 20, ch = idx % 20;
      int b = rowi >> 11, t = rowi & 2047;
      const float* s = ch < 16 ? cckv + (size_t)rowi * 128 + ch * 8 : ckr + (size_t)rowi * 32 + (ch - 16) * 8;
      float4 a = *(const float4*)s, c = *(const float4*)(s + 4);
      uint4 o; o.x = pack2(a.x, a.y); o.y = pack2(a.z, a.w); o.z = pack2(c.x, c.y); o.w = pack2(c.z, c.w);
      *(uint4*)(KS + ((size_t)b * 2112 + t) * 160 + ch * 8) = o;
    }
    tconv_v(VTS, 2112, 4096, 2048, vb, nvb, [=](int k, int n) { return cckv[((size_t)(n >> 7) * 2048 + k) * 128 + (n & 127)]; });
    const float* cmk = p.in[I_CMK] + (size_t)l * 32 * 256 * 1024;
    const float* cmv = p.in[I_CMV] + (size_t)l * 32 * 256 * 1024;
    u16* MKS = (u16*)(p.ws + W_MKS); u16* MVTS = (u16*)(p.ws + W_MVTS);
    for (int idx = vb * NTHR + tid; idx < 32 * 4 * 256 * 32; idx += nvb * NTHR) {
      int d8 = idx & 31, m = (idx >> 5) & 255, h = (idx >> 13) & 3, b = idx >> 15;
      const float* s = cmk + ((size_t)(b * 256 + m) * 4 + h) * 256 + d8 * 8;
      float4 a = *(const float4*)s, c = *(const float4*)(s + 4);
      uint4 o; o.x = pack2(a.x, a.y); o.y = pack2(a.z, a.w); o.z = pack2(c.x, c.y); o.w = pack2(c.z, c.w);
      *(uint4*)(MKS + (size_t)idx * 8) = o;
    }
    tconv_v(MVTS, 256, 32768, 256, vb, nvb, [=](int k, int n) { return cmv[((size_t)((n >> 10) * 256 + k) * 4 + ((n >> 8) & 3)) * 256 + (n & 255)]; });
  }
}

__device__ __forceinline__ void mla_sub(KPR p, int b, int c, int half) {
  const u16* QB = (const u16*)(p.ws + W_QB); u16* AO = (u16*)(p.ws + W_AO);
  size_t tok = (size_t)b * 4096 + c * 64 + half * 32;
  attn_item<160, 128, 8>(QB + tok * 1280, 160, 256, (const u16*)(p.ws + W_KP) + (size_t)b * 4096 * 160, 160,
                         (const u16*)(p.ws + W_VTP) + (size_t)b * 128 * 4096, 4096, (c + 1) * 64, AO + tok * 1536, 1536);
}
__device__ __forceinline__ void phase_mix(KPR p, int l, int mode = 0) {
  extern __shared__ __attribute__((aligned(16))) char smem[];
  int* sItem = (int*)(smem + SMEM_ITEM);
  int* cnt = (int*)(p.ws + W_CNT) + l + mode * 8;
  for (;;) {
    __syncthreads();
    if (threadIdx.x == 0) *sItem = atomicAdd(cnt, 1);
    __syncthreads();
    int it = *sItem;
    if (it >= 608) break;
    if (mode == 1 && it >= 32 && it < 352) continue;
    if (mode == 2 && (it < 32 || it >= 352)) continue;
    if (it < 32) {
      int b = it >> 3, h = it & 7;
      cseq_item(p, b * 4096, h, 64, (b * 8 + h) * 64, nullptr, p.out + OO_WKVP + ((size_t)(l * 4 + b) * 8 + h) * 4096);
    } else if (it < 288) {
      int k = it - 32; int b = k >> 6, pr = (k >> 1) & 31, half = k & 1;
      mla_sub(p, b, 63 - pr, half);
      mla_sub(p, b, pr, half);
    } else if (it < 352) {
      int k = it - 288; int b = k >> 1, half = k & 1;
      const u16* QB = (const u16*)(p.ws + W_QB); u16* AO = (u16*)(p.ws + W_AO);
      size_t tok = (size_t)TP + b * 64 + half * 32;
      attn_item<160, 128, 8>(QB + tok * 1280, 160, 256, (const u16*)(p.ws + W_KS) + (size_t)b * 2112 * 160, 160,
                             (const u16*)(p.ws + W_VTS) + (size_t)b * 128 * 2112, 2112, 2112, AO + tok * 1536, 1536);
    } else {
      int k = it - 352; int b = k >> 3, h = k & 7;
      cseq_item(p, TP + b * 64, h, 1, 2048 + k, p.in[I_SWKV] + ((size_t)(l * 32 + b) * 8 + h) * 4096,
                p.out + OO_WKVS + ((size_t)(l * 32 + b) * 8 + h) * 4096);
    }
  }
}

__device__ __forceinline__ void xattn_item(KPR p, int l, int it) {
  const u16* QX = (const u16*)(p.ws + W_QX); u16* XO = (u16*)(p.ws + W_XO);
  if (it < 256) {
    int b = it >> 6, h = (it >> 4) & 3, qt = it & 15;
    size_t tok = (size_t)b * 4096 + qt * 256;
    for (int hv = 0; hv < 2; ++hv)
      attn_item<256, 128, 1>(QX + tok * 1024 + h * 256, 1024, 256, (const u16*)(p.ws + W_MKP) + (size_t)((l * 4 + b) * 4 + h) * 65536, 256,
                             (const u16*)(p.ws + W_MVTP) + (size_t)((l * 4 + b) * 4 + h) * 65536 + hv * 128 * 256, 256, 256, XO + tok * 1024 + h * 256 + hv * 128, 1024);
  } else {
    int k = it - 256; int b = k >> 2, h = k & 3;
    size_t tok = (size_t)TP + b * 64;
    for (int hv = 0; hv < 2; ++hv)
      attn_item<256, 128, 1>(QX + tok * 1024 + h * 256, 1024, 64, (const u16*)(p.ws + W_MKS) + (size_t)(b * 4 + h) * 65536, 256,
                             (const u16*)(p.ws + W_MVTS) + (size_t)(b * 4 + h) * 65536 + hv * 128 * 256, 256, 256, XO + tok * 1024 + h * 256 + hv * 128, 1024);
  }
}

constexpr int CH_NST = 10;
__device__ __forceinline__ void phase_chain(KPR p, int ci) {
  extern __shared__ __attribute__((aligned(16))) char smem[];
  int* sItem = (int*)(smem + SMEM_ITEM);
  int* CT = (int*)(p.ws + W_CNT);
  int* q = CT + 3800 + ci; int* xa = CT + 72 + ci; int* oa = CT + 80 + ci;
  int* cnt = CT + 128 + ci * CH_NST * 72;
  int* stamp = CT + 4096 + ci * CH_NST * 72;
  int* G = CT + 8000 + ci; int* xast = CT + 8010 + ci; int* oast = CT + 8020 + ci;
  int lastG = 0;
  const bool hasTail = ci >= 1, hasHead = ci < NL;
  const int lt = ci - 1, lh = ci;
  const int e0 = hasTail ? 288 : 0, e1 = e0 + (hasTail ? 288 : 0), e2 = e1 + (hasTail ? 384 : 0), e3 = e2 + (hasTail ? 288 : 0),
            e4 = e3 + (hasTail ? 1584 : 0), e5 = e4 + (hasTail ? 288 : 0), e6 = e5 + (hasHead ? 1584 : 0), e7 = e6 + (hasHead ? 288 : 0),
            e8 = e7 + (hasHead ? 224 : 0), e9 = e8 + (hasHead ? 648 : 0);
  float* X = (float*)(p.ws + W_X); u16* XB = (u16*)(p.ws + W_XB); float* SSQ = (float*)(p.ws + W_SSQ); u16* ACT = (u16*)(p.ws + W_ACT);
  for (;;) {
    __syncthreads();
    const int tid = tidx();
    if (tid == 0) {
      const int grp = blockIdx.x & 7;
      const int it = atomicAdd(q + grp * 8, 1) * 8 + grp;
      if (it < e9) {
        int st, idx;
        if (it < e0) { st = 0; idx = it; } else if (it < e1) { st = 1; idx = it - e0; } else if (it < e2) { st = 2; idx = it - e1; }
        else if (it < e3) { st = 3; idx = it - e2; } else if (it < e4) { st = 4; idx = it - e3; } else if (it < e5) { st = 5; idx = it - e4; }
        else if (it < e6) { st = 6; idx = it - e5; } else if (it < e7) { st = 7; idx = it - e6; } else if (it < e8) { st = 8; idx = it - e7; }
        else { st = 9; idx = it - e8; }
        int pm = 0, pn = 0;
        if (st == 2) pm = idx < 256 ? ((idx >> 6) * 16 + (idx & 15)) : (64 + ((idx - 256) >> 4));
        else if (st != 8) tile_map(idx, 72, (st == 4 || st == 6) ? 22 : (st == 9 ? 9 : 4), pm, pn);
        const int* c1 = nullptr; const int* c2 = nullptr;
        switch (st) {
          case 1: c1 = stamp + 0 * 72 + pm; break;
          case 2: c1 = stamp + 1 * 72 + pm; break;
          case 3: c1 = stamp + 2 * 72 + pm; break;
          case 4: c1 = stamp + 3 * 72 + pm; c2 = xast; break;
          case 5: c1 = stamp + 4 * 72 + pm; break;
          case 6: if (hasTail) c1 = stamp + 5 * 72 + pm; break;
          case 7: c1 = stamp + 6 * 72 + pm; break;
          case 8: if (hasTail) c1 = xast; break;
          case 9: c1 = stamp + 7 * 72 + pm; if (hasTail) c2 = oast; break;
          default: break;
        }
        int s1 = 0, s2 = 0;
        if (c1) while ((s1 = __hip_atomic_load(c1, __ATOMIC_RELAXED, __HIP_MEMORY_SCOPE_AGENT)) == 0) __builtin_amdgcn_s_sleep(4);
        if (c2) while ((s2 = __hip_atomic_load(c2, __ATOMIC_RELAXED, __HIP_MEMORY_SCOPE_AGENT)) == 0) __builtin_amdgcn_s_sleep(4);
        if ((s1 > s2 ? s1 : s2) >= lastG) {
          const int g = __hip_atomic_load(G, __ATOMIC_RELAXED, __HIP_MEMORY_SCOPE_AGENT);
          __threadfence();
          lastG = g;
        }
        sItem[1] = st; sItem[2] = idx; sItem[3] = pm; sItem[4] = pn;
      }
      sItem[0] = it;
    }
    __syncthreads();
    if (sItem[0] >= e9) break;
    const int st = sItem[1], idx = sItem[2], pm = sItem[3], pn = sItem[4];
    const u16* WTt = (const u16*)(p.ws + W_WT) + (size_t)(lt < 0 ? 0 : lt) * WE_LAYER;
    const u16* WTh = (const u16*)(p.ws + W_WT) + (size_t)(lh >= NL ? 0 : lh) * WE_LAYER;
    switch (st) {
      case 0: gemm_tile((const u16*)(p.ws + W_AO), WTt + WE_OUT, 1536, pm, pn, EpiRes{X, XB, SSQ, 1.0f}); break;
      case 1: gemm_tile(XB, WTt + WE_MQ, 1024, pm, pn, EpiScaleBf{SSQ, (u16*)(p.ws + W_QX), 1024}); break;
      case 2: xattn_item(p, lt, idx); break;
      case 3: gemm_tile((const u16*)(p.ws + W_XO), WTt + WE_MO, 1024, pm, pn, EpiRes{X, XB, SSQ, 1.0f}); break;
      case 4: gemm_tile(XB, WTt + WE_GU2, 1024, pm, pn, EpiGU{SSQ, ACT}); break;
      case 5: gemm_tile(ACT, WTt + WE_D2, DFF, pm, pn, EpiRes{X, XB, SSQ, 0.5f}); break;
      case 6: gemm_tile(XB, WTh + WE_GU1, 1024, pm, pn, EpiGU{SSQ, ACT}); break;
      case 7: gemm_tile(ACT, WTh + WE_D1, DFF, pm, pn, EpiRes{X, XB, SSQ, 0.5f}); break;
      case 8: conv_caches(p, lh, idx, 224); break;
      default: gemm_tile(XB, WTh + WE_IN, 1024, pm, pn, EpiScaleBf{SSQ, (u16*)(p.ws + W_PROJ), DINP}); break;
    }
    asm volatile("s_waitcnt vmcnt(0)" ::: "memory");
    __syncthreads();
    if (tidx() == 0) {
      __threadfence();
      atomicAdd(G, 1);
      const int full = (st == 4 || st == 6) ? 22 : (st == 9 ? 9 : (st == 2 ? (pm < 64 ? 4 : 16) : 4));
      if (atomicAdd(cnt + st * 72 + pm, 1) + 1 == full)
        __hip_atomic_store(stamp + st * 72 + pm, __hip_atomic_load(G, __ATOMIC_RELAXED, __HIP_MEMORY_SCOPE_AGENT), __ATOMIC_RELAXED, __HIP_MEMORY_SCOPE_AGENT);
      if (st == 2 && atomicAdd(xa, 1) + 1 == 384)
        __hip_atomic_store(xast, __hip_atomic_load(G, __ATOMIC_RELAXED, __HIP_MEMORY_SCOPE_AGENT), __ATOMIC_RELAXED, __HIP_MEMORY_SCOPE_AGENT);
      if (st == 0 && atomicAdd(oa, 1) + 1 == 288)
        __hip_atomic_store(oast, __hip_atomic_load(G, __ATOMIC_RELAXED, __HIP_MEMORY_SCOPE_AGENT), __ATOMIC_RELAXED, __HIP_MEMORY_SCOPE_AGENT);
    }
  }
}

__device__ __forceinline__ void phase_final(KPR p) {
  const int tid = tidx(), wid = tid >> 6, lane = tid & 63;
  const float* X = (const float*)(p.ws + W_X); const float* fn = p.in[I_FN];
  for (int g = blockIdx.x * 8 + wid; g < T; g += gridDim.x * 8) {
    float4 v[4]; float ss = 0.f;
#pragma unroll
    for (int i = 0; i < 4; ++i) { v[i] = *(const float4*)(X + (size_t)g * 1024 + i * 256 + lane * 4); ss += v[i].x * v[i].x + v[i].y * v[i].y + v[i].z * v[i].z + v[i].w * v[i].w; }
    ss = wave_sum(ss);
    float rs = rsqrtf(ss * (1.f / 1024.f) + 1e-6f);
#pragma unroll
    for (int i = 0; i < 4; ++i) {
      float4 gn = *(const float4*)(fn + i * 256 + lane * 4);
      *(float4*)(p.out + OO_Y + (size_t)g * 1024 + i * 256 + lane * 4) = make_float4(v[i].x * rs * gn.x, v[i].y * rs * gn.y, v[i].z * rs * gn.z, v[i].w * rs * gn.w);
    }
  }
}

constexpr int NPL = 6;
constexpr int N_PHASES = 3 + NPL * NL + 1;

__device__ __forceinline__ void run_phase(KPR p, int ph) {
  if (ph == 0) { phase_init(p); return; }
  if (ph == 1) {
    for (int l = 0; l < NL; ++l) {
      const u16* WT = (const u16*)(p.ws + W_WT) + (size_t)l * WE_LAYER;
      gemm_phase((const u16*)(p.ws + W_MB), WT + WE_MK, 1024, 4, 4, (2 * l) * 16,
                 EpiMem<false>{p.out + OO_MKP + (size_t)l * 1048576, (u16*)(p.ws + W_MKP) + (size_t)l * 16 * 65536});
      gemm_phase((const u16*)(p.ws + W_MB), WT + WE_MV, 1024, 4, 4, (2 * l + 1) * 16,
                 EpiMem<true>{p.out + OO_MVP + (size_t)l * 1048576, (u16*)(p.ws + W_MVTP) + (size_t)l * 16 * 65536});
    }
    return;
  }
  if (ph == 2) { phase_chain(p, 0); return; }
  if (ph == N_PHASES - 1) { phase_final(p); return; }
  const int l = (ph - 3) / NPL, s = (ph - 3) % NPL;
  const u16* WT = (const u16*)(p.ws + W_WT) + (size_t)l * WE_LAYER;
  switch (s) {
    case 0: phase_prep(p, l); break;
    case 1:
      gemm_phase((const u16*)(p.ws + W_CQB), WT + WE_Q, 256, 72, 5, 0, EpiQ{(u16*)(p.ws + W_QB), (const float2*)(p.ws + W_ROPE)});
      gemm_phase((const u16*)(p.ws + W_A2), WT + WE_RW, 256, 72, 6, 360,
                 EpiRW{p.in[I_W0] + l * 512, p.in[I_A0] + l * 512, p.in[I_KA] + l * 512, p.ws});
      break;
    case 2: phase_cprep(p); break;
    case 3: phase_mix(p, l, 0); break;
    case 4: phase_yfin(p, l); break;
    default: phase_chain(p, l + 1); break;
  }
}

__global__ void __launch_bounds__(NTHR) mega(Params p) {
  cg::grid_group grid = cg::this_grid();
  for (int ph = p.ph_lo; ph < p.ph_hi; ++ph) {
    const __attribute__((address_space(4))) Params* q = (const __attribute__((address_space(4))) Params*)__builtin_amdgcn_kernarg_segment_ptr();
    asm volatile("" : "+s"(q));
    run_phase(*q, ph);
    if (ph + 1 < p.ph_hi) grid.sync();
  }
}

extern "C" void kernel_launch(void* const* d_in, const int* in_sizes, int n_in, void* d_out, int out_size, void* d_ws,
                              size_t ws_size, hipStream_t stream) {
  static int grid = 0;
  if (grid == 0) {
    if (n_in != N_IN || (size_t)out_size != OO_END || ws_size < W_END) {
      fprintf(stderr, "kernel_launch: unexpected shapes n_in=%d out=%d ws=%zu (need %zu)\n", n_in, out_size, ws_size, (size_t)W_END);
      grid = -1; return;
    }
    int dev = 0, cus = 0, per_cu = 0;
    hipGetDevice(&dev);
    hipDeviceGetAttribute(&cus, hipDeviceAttributeMultiprocessorCount, dev);
    hipFuncSetAttribute((const void*)mega, hipFuncAttributeMaxDynamicSharedMemorySize, SMEM_BYTES);
    hipOccupancyMaxActiveBlocksPerMultiprocessor(&per_cu, (const void*)mega, NTHR, SMEM_BYTES);
    if (per_cu < 1) { fprintf(stderr, "kernel_launch: occupancy query says %d blocks/CU\n", per_cu); per_cu = 1; }
    (void)hipGetLastError();
    grid = cus;
  }
  if (grid < 0) return;
  Params p{};
  for (int i = 0; i < N_IN; ++i) p.in[i] = (const float*)d_in[i];
  p.out = (float*)d_out; p.ws = (char*)d_ws;
#if N_LAUNCH_PER_PHASE
  for (int ph = 0; ph < N_PHASES; ++ph) {
    p.ph_lo = ph; p.ph_hi = ph + 1;
    void* args[] = {&p};
    hipError_t e = hipLaunchCooperativeKernel((const void*)mega, dim3(grid), dim3(NTHR), args, SMEM_BYTES, stream);
    if (e != hipSuccess) { fprintf(stderr, "launch failed: %s\n", hipGetErrorString(e)); break; }
  }
#else
  p.ph_lo = 0; p.ph_hi = N_PHASES;
  void* args[] = {&p};
  hipError_t e = hipLaunchCooperativeKernel((const void*)mega, dim3(grid), dim3(NTHR), args, SMEM_BYTES, stream);
  if (e != hipSuccess) fprintf(stderr, "cooperative launch failed: %s (grid %d)\n", hipGetErrorString(e), grid);
#endif
}
```

```cpp
#include <hip/hip_runtime.h>
#include <hip/hip_cooperative_groups.h>
#include <stdint.h>
#include <stdio.h>
namespace cg = cooperative_groups;

typedef unsigned short u16;
using bf16x8 = __attribute__((ext_vector_type(8))) short;
using f32x4 = __attribute__((ext_vector_type(4))) float;
using f32x16 = __attribute__((ext_vector_type(16))) float;

#ifndef REP_WHICH
#define REP_WHICH 0
#endif
#ifndef PROBE_REP
#define PROBE_REP 0
#endif
#ifndef PROBE_MASK
#define PROBE_MASK 0x3ff
#endif
#ifndef N_LAUNCH_PER_PHASE
#define N_LAUNCH_PER_PHASE 0
#endif

constexpr int TP = 16384, TS = 2048, T = TP + TS, NL = 4;
constexpr int DFF = 2816, DIN = 2208, DINP = 2304, DSH = 1792;
constexpr int NTHR = 512;
constexpr int SMEM_BYTES = 139264 + 2048;
constexpr int SMEM_ITEM = 139264 + 1024;
constexpr float QSCALE = 0.10206207261596577f * 1.4426950408889634f;
constexpr float XSCALE = 0.0625f * 1.4426950408889634f;

constexpr size_t OO_Y = 0;
constexpr size_t OO_CKVP = OO_Y + (size_t)T * 1024;
constexpr size_t OO_KRP = OO_CKVP + (size_t)NL * 4 * 4096 * 128;
constexpr size_t OO_MKP = OO_KRP + (size_t)NL * 4 * 4096 * 32;
constexpr size_t OO_MVP = OO_MKP + (size_t)NL * 4 * 256 * 1024;
constexpr size_t OO_WKVP = OO_MVP + (size_t)NL * 4 * 256 * 1024;
constexpr size_t OO_SHP = OO_WKVP + (size_t)NL * 4 * 8 * 4096;
constexpr size_t OO_CKVS = OO_SHP + (size_t)NL * 4 * DSH;
constexpr size_t OO_KRS = OO_CKVS + (size_t)NL * 32 * 64 * 128;
constexpr size_t OO_WKVS = OO_KRS + (size_t)NL * 32 * 64 * 32;
constexpr size_t OO_SHS = OO_WKVS + (size_t)NL * 32 * 8 * 4096;
constexpr size_t OO_END = OO_SHS + (size_t)NL * 32 * DSH;

constexpr size_t al256(size_t x) { return (x + 255) & ~(size_t)255; }
constexpr size_t W_X = 0;
constexpr size_t W_XB = W_X + al256((size_t)T * 1024 * 4);
constexpr size_t W_SSQ = W_XB + al256((size_t)T * 1024 * 2);
constexpr size_t W_ACT = W_SSQ + al256((size_t)T * 4 * 4);
constexpr size_t W_WB = W_ACT;
constexpr size_t W_BB = W_WB + al256((size_t)T * 512 * 4);
constexpr size_t W_GB = W_BB + al256((size_t)T * 512 * 4);
constexpr size_t W_QX = W_ACT;
constexpr size_t W_PROJ = W_ACT + al256((size_t)T * DFF * 2);
constexpr size_t W_AO = W_PROJ;
constexpr size_t W_CQB = W_PROJ + al256((size_t)T * DINP * 2);
constexpr size_t W_A2 = W_CQB + al256((size_t)T * 256 * 2);
constexpr size_t W_QB = W_A2 + al256((size_t)T * 256 * 2);
constexpr size_t W_XO = W_QB;
constexpr size_t W_RB = W_QB + al256((size_t)T * 1280 * 2);
constexpr size_t W_KB = W_RB + al256((size_t)T * 512 * 4);
constexpr size_t W_VB = W_KB + al256((size_t)T * 512 * 4);
constexpr size_t W_KKB = W_VB + al256((size_t)T * 512 * 4);
constexpr size_t W_KP = W_KKB + al256((size_t)T * 512 * 4);
constexpr size_t W_KS = W_KP + al256((size_t)4 * 4096 * 160 * 2);
constexpr size_t W_VTP = W_KS + al256((size_t)32 * 2112 * 160 * 2);
constexpr size_t W_VTS = W_VTP + al256((size_t)4 * 128 * 4096 * 2);
constexpr size_t W_MKP = W_VTS + al256((size_t)32 * 128 * 2112 * 2);
constexpr size_t W_MVTP = W_MKP + al256((size_t)NL * 16 * 65536 * 2);
constexpr size_t W_MKS = W_MVTP + al256((size_t)NL * 16 * 65536 * 2);
constexpr size_t W_MVTS = W_MKS + al256((size_t)128 * 65536 * 2);
constexpr size_t W_MB = W_MVTS + al256((size_t)128 * 65536 * 2);
constexpr size_t W_ROPE = W_MB + al256((size_t)1024 * 1024 * 2);
constexpr size_t W_CNT = W_ROPE + al256((size_t)4096 * 16 * 8);
constexpr size_t W_YB = W_CNT + 65536;
constexpr size_t W_CQ = W_YB + al256((size_t)T * 512 * 4);
constexpr size_t W_WT = W_CQ + al256((size_t)2304 * 4096 * 4);
constexpr size_t W_CRR = W_PROJ + al256((size_t)T * 1536 * 2);
constexpr size_t W_CPT = W_CQB;
static_assert(W_CRR + (size_t)2304 * 4096 * 2 <= W_CQB, "RRt must fit behind AO");
static_assert((size_t)2304 * 4096 * 2 <= 2 * al256((size_t)T * 256 * 2), "Pt must fit in CQB+A2");
constexpr size_t WE_GU1 = 0;
constexpr size_t WE_D1 = WE_GU1 + (size_t)5632 * 1024;
constexpr size_t WE_IN = WE_D1 + (size_t)1024 * DFF;
constexpr size_t WE_Q = WE_IN + (size_t)DINP * 1024;
constexpr size_t WE_RW = WE_Q + (size_t)1280 * 256;
constexpr size_t WE_OUT = WE_RW + (size_t)1536 * 256;
constexpr size_t WE_MQ = WE_OUT + (size_t)1024 * 1536;
constexpr size_t WE_MK = WE_MQ + (size_t)1024 * 1024;
constexpr size_t WE_MV = WE_MK + (size_t)1024 * 1024;
constexpr size_t WE_MO = WE_MV + (size_t)1024 * 1024;
constexpr size_t WE_GU2 = WE_MO + (size_t)1024 * 1024;
constexpr size_t WE_D2 = WE_GU2 + (size_t)5632 * 1024;
constexpr size_t WE_LAYER = WE_D2 + (size_t)1024 * DFF;
constexpr size_t W_END = W_WT + al256(WE_LAYER * NL * 2);

enum { I_XP = 0, I_XS, I_MEMP, I_CCKV, I_CKR, I_CMK, I_CMV, I_SWKV, I_SSH, I_F1N, I_F1G, I_F1U, I_F1D, I_MIXN, I_WIN,
       I_QN, I_WUQ, I_KVN, I_WUK, I_WUV, I_MU, I_W0, I_WUP, I_A0, I_AUP, I_GUP, I_KK, I_KA, I_RK, I_GNG, I_GNB, I_WOUT,
       I_XN, I_MKVN, I_WMQ, I_WMK, I_WMV, I_WMO, I_F2N, I_F2G, I_F2U, I_F2D, I_FN, N_IN };

struct Params {
  const float* in[N_IN];
  float* out;
  char* ws;
  int ph_lo, ph_hi;
};

typedef const __attribute__((address_space(4))) Params& KPR;

typedef __bf16 bf2_t __attribute__((ext_vector_type(2)));
typedef float f2_t __attribute__((ext_vector_type(2)));
__device__ __forceinline__ u16 f2bf(float f) { __bf16 b = (__bf16)f; return __builtin_bit_cast(u16, b); }
__device__ __forceinline__ float bf2f(u16 h) { return __uint_as_float(((unsigned)h) << 16); }
__device__ __forceinline__ unsigned pack2(float a, float b) { f2_t v = {a, b}; bf2_t r = __builtin_convertvector(v, bf2_t); return __builtin_bit_cast(unsigned, r); }
__device__ __forceinline__ float wave_sum(float x) {
#pragma unroll
  for (int o = 32; o; o >>= 1) x += __shfl_xor(x, o);
  return x;
}
__device__ __forceinline__ float dpp_sum8(float x) {
  x += __int_as_float(__builtin_amdgcn_update_dpp(0, __float_as_int(x), 0xB1, 0xF, 0xF, false));
  x += __int_as_float(__builtin_amdgcn_update_dpp(0, __float_as_int(x), 0x4E, 0xF, 0xF, false));
  x += __int_as_float(__builtin_amdgcn_update_dpp(0, __float_as_int(x), 0x141, 0xF, 0xF, false));
  return x;
}
__device__ __forceinline__ int tidx() { int t = threadIdx.x; asm volatile("" : "+v"(t)); return t; }
__device__ __forceinline__ float fma_s(float a, float b, float c) { float d; asm("v_fma_f32 %0, %1, %2, %3" : "=v"(d) : "v"(a), "v"(b), "v"(c)); return d; }
__device__ __forceinline__ float sub_s(float a, float b) { float d; asm("v_sub_f32 %0, %1, %2" : "=v"(d) : "v"(a), "v"(b)); return d; }
__device__ __forceinline__ float add_s(float a, float b) { float d; asm("v_add_f32 %0, %1, %2" : "=v"(d) : "v"(a), "v"(b)); return d; }
__device__ __forceinline__ float mul_s(float a, float b) { float d; asm("v_mul_f32 %0, %1, %2" : "=v"(d) : "v"(a), "v"(b)); return d; }
__device__ __forceinline__ float sigmoidf_(float x) { return 1.f / (1.f + __expf(-x)); }

constexpr int BM = 256, BK = 64, HALF = 128, HT = HALF * BK;

__device__ __forceinline__ int lds_byte(int r, int c) {
  int st = (r >> 4) * 2 + (c >> 5), rr = r & 15, cc = c & 31, ob = rr * 64 + cc * 2;
  return st * 1024 + (ob ^ (((ob >> 9) & 1) << 5));
}
__device__ __forceinline__ void stage_rc(int b, int& R, int& C) {
  int st = b / 1024, sb = b % 1024, swz = sb ^ (((sb >> 9) & 1) << 5);
  R = (st >> 1) * 16 + swz / 64; C = (st & 1) * 32 + (swz % 64) / 2;
}

__device__ __forceinline__ void tile_map(int tile, int nM, int nN, int& pm, int& pn) {
  const int ntiles = nM * nN;
  int wgid = tile;
  { int q = ntiles / 8, r = ntiles % 8, xcd = wgid % 8, off = wgid / 8;
    wgid = (xcd < r ? xcd * (q + 1) : r * (q + 1) + (xcd - r) * q) + off; }
  int nig = 8 * nN, gid = wgid / nig, fm = gid * 8, gsz = min(nM - fm, 8);
  pm = fm + ((wgid % nig) % gsz); pn = (wgid % nig) / gsz;
}

template <class Epi>
__device__ __forceinline__ void gemm_tile(const u16* __restrict__ A, const u16* __restrict__ Bt, const int K,
                                          const int pm, const int pn, Epi epi) {
  extern __shared__ __attribute__((aligned(16))) char smem[];
  u16* shm = (u16*)smem;
#define SA(b, h) (shm + ((b) * 2 + (h)) * HT)
#define SB(b, h) (shm + (4 + (b) * 2 + (h)) * HT)
#define STAGE(P, BASE, br, kt) do { const u16* _gb = BASE + ((long)(br) * K + (long)(kt) * BK); \
    __builtin_amdgcn_global_load_lds((const unsigned*)((const char*)_gb + so0), \
        (__attribute__((address_space(3))) unsigned*)((char*)(P) + wu16), 16, 0, 0); \
    __builtin_amdgcn_global_load_lds((const unsigned*)((const char*)_gb + so1), \
        (__attribute__((address_space(3))) unsigned*)((char*)(P) + wu16 + 8192), 16, 0, 0); } while (0)
#define LDA(dst, b, h) for (int m = 0; m < 4; ++m) for (int k = 0; k < 2; ++k) \
    dst[m][k] = *reinterpret_cast<const bf16x8*>((char*)SA(b, h) + lds_byte(wr * 64 + m * 16 + fr, k * 32 + fq * 8))
#define LDB(dst, b, h) for (int n = 0; n < 2; ++n) for (int k = 0; k < 2; ++k) \
    dst[n][k] = *reinterpret_cast<const bf16x8*>((char*)SB(b, h) + lds_byte(wc * 32 + n * 16 + fr, k * 32 + fq * 8))
#define MMA(ai, bj, At_, Bt_) do { __builtin_amdgcn_s_setprio(1); \
    for (int m = 0; m < 4; ++m) for (int n = 0; n < 2; ++n) for (int k = 0; k < 2; ++k) \
      acc[ai][bj][m][n] = __builtin_amdgcn_mfma_f32_16x16x32_bf16(At_[m][k], Bt_[n][k], acc[ai][bj][m][n], 0, 0, 0); \
    __builtin_amdgcn_s_setprio(0); } while (0)
#define WAIT_V(n) asm volatile("s_waitcnt vmcnt(" #n ")" ::: "memory")
#define WAIT_L(n) asm volatile("s_waitcnt lgkmcnt(" #n ")" ::: "memory")
#define BAR __builtin_amdgcn_s_barrier()
#define SCHED __builtin_amdgcn_sched_barrier(0)
  const int tid_ = tidx();
  const int wid = tid_ >> 6, lane = tid_ & 63, wr = wid >> 2, wc = wid & 3, fr = lane & 15, fq = lane >> 4;
  const int nt = K / BK;
  const int wu16 = __builtin_amdgcn_readfirstlane(tid_ >> 6) * 1024;
  {
    unsigned so0, so1;
    { int _r, _c; stage_rc(tid_ * 16, _r, _c); so0 = (unsigned)(_r * K + _c) * 2u;
      stage_rc(tid_ * 16 + 8192, _r, _c); so1 = (unsigned)(_r * K + _c) * 2u; }
    const int brow = pm * BM, bcol = pn * BM;
    f32x4 acc[2][2][4][2] = {};
    bf16x8 At[4][2], B0[2][2], B1[2][2];
    STAGE(SB(0, 0), Bt, bcol, 0); STAGE(SA(0, 0), A, brow, 0);
    STAGE(SB(0, 1), Bt, bcol + HALF, 0); STAGE(SA(0, 1), A, brow + HALF, 0);
    if (wr == 1) BAR;
    WAIT_V(4); BAR;
    STAGE(SB(1, 0), Bt, bcol, 1); STAGE(SA(1, 0), A, brow, 1); STAGE(SB(1, 1), Bt, bcol + HALF, 1);
    WAIT_V(6); BAR;
    for (int t = 0; t < nt - 2; t += 2) {
      LDB(B0, 0, 0); SCHED; LDA(At, 0, 0); STAGE(SA(1, 1), A, brow + HALF, t + 1);
      WAIT_L(8); BAR; WAIT_L(0); MMA(0, 0, At, B0); BAR; SCHED;
      LDB(B1, 0, 1); STAGE(SB(0, 0), Bt, bcol, t + 2);
      BAR; WAIT_L(0); MMA(0, 1, At, B1); BAR;
      LDA(At, 0, 1); STAGE(SA(0, 0), A, brow, t + 2);
      BAR; WAIT_L(0); MMA(1, 0, At, B0); BAR; SCHED;
      STAGE(SB(0, 1), Bt, bcol + HALF, t + 2);
      WAIT_V(6); BAR; MMA(1, 1, At, B1); BAR;
      LDB(B0, 1, 0); SCHED; LDA(At, 1, 0); STAGE(SA(0, 1), A, brow + HALF, t + 2);
      WAIT_L(8); BAR; WAIT_L(0); MMA(0, 0, At, B0); BAR; SCHED;
      LDB(B1, 1, 1); STAGE(SB(1, 0), Bt, bcol, t + 3);
      BAR; WAIT_L(0); MMA(0, 1, At, B1); BAR;
      LDA(At, 1, 1); STAGE(SA(1, 0), A, brow, t + 3);
      BAR; WAIT_L(0); MMA(1, 0, At, B0); BAR; SCHED;
      STAGE(SB(1, 1), Bt, bcol + HALF, t + 3);
      WAIT_V(6); BAR; MMA(1, 1, At, B1); BAR;
    }
    { LDB(B0, 0, 0); LDA(At, 0, 0); STAGE(SA(1, 1), A, brow + HALF, nt - 1);
      BAR; WAIT_L(0); MMA(0, 0, At, B0); BAR;
      LDB(B1, 0, 1); BAR; WAIT_L(0); MMA(0, 1, At, B1); BAR;
      LDA(At, 0, 1); WAIT_V(4); BAR; WAIT_L(0); MMA(1, 0, At, B0); MMA(1, 1, At, B1); BAR; }
    { LDB(B0, 1, 0); LDA(At, 1, 0); WAIT_V(2); BAR; WAIT_L(0); MMA(0, 0, At, B0); BAR;
      LDB(B1, 1, 1); WAIT_V(0); BAR; WAIT_L(0); MMA(0, 1, At, B1); BAR;
      LDA(At, 1, 1); BAR; WAIT_L(0); MMA(1, 0, At, B0); MMA(1, 1, At, B1); BAR; }
    if (wr == 0) BAR;
    float* stg = (float*)smem;
    int tx = tid_;
    asm volatile("" : "+v"(tx));
    const int ewr = tx >> 8, ewc = (tx >> 6) & 3, efr = tx & 15, efq = (tx >> 4) & 3;
#define EPI_HALF(ai) do { \
    __syncthreads(); \
    _Pragma("unroll") for (int bj = 0; bj < 2; ++bj) _Pragma("unroll") for (int m = 0; m < 4; ++m) \
    _Pragma("unroll") for (int n = 0; n < 2; ++n) _Pragma("unroll") for (int j = 0; j < 4; ++j) \
      stg[(ewr * 64 + m * 16 + efq * 4 + j) * 260 + bj * HALF + ewc * 32 + n * 16 + efr] = acc[ai][bj][m][n][j]; \
    __syncthreads(); \
    for (int i = 0; i < 8; ++i) { \
      int item = i * NTHR + tx; int rl = item >> 5, qp = item & 31; \
      int cl = (qp >> 2) * 32 + (qp & 3) * 4; \
      float4 v0 = *(const float4*)(stg + rl * 260 + cl), v1 = *(const float4*)(stg + rl * 260 + cl + 16); \
      int row = brow + ai * HALF + rl; \
      float ss = epi.apply4(row, bcol + cl, v0, v1); \
      if (Epi::kSsq) { \
        ss += __shfl_xor(ss, 1); ss += __shfl_xor(ss, 2); ss += __shfl_xor(ss, 4); ss += __shfl_xor(ss, 8); ss += __shfl_xor(ss, 16); \
        if (qp == 0) epi.ssq_out(row, pn, ss); \
      } \
    } } while (0)
    EPI_HALF(0);
    EPI_HALF(1);
#undef EPI_HALF
    __syncthreads();
  }
#undef SA
#undef SB
#undef STAGE
#undef LDA
#undef LDB
#undef MMA
}

template <class Epi>
__device__ __forceinline__ void gemm_phase(const u16* __restrict__ A, const u16* __restrict__ Bt, const int K,
                                           const int nM, const int nN, const int rot, Epi epi) {
  const int G = gridDim.x;
  for (int tile = (int)((blockIdx.x + G - (rot % G)) % G); tile < nM * nN; tile += G) {
    int pm, pn; tile_map(tile, nM, nN, pm, pn);
    gemm_tile(A, Bt, K, pm, pn, epi);
  }
}

__device__ __forceinline__ float rstd_from_ssq(const float* ssq, int row) {
  float4 s = *(const float4*)(ssq + (size_t)row * 4);
  return rsqrtf((s.x + s.y + s.z + s.w) * (1.f / 1024.f) + 1e-6f);
}
__device__ __forceinline__ uint2 pack4(float4 v) { uint2 w; w.x = pack2(v.x, v.y); w.y = pack2(v.z, v.w); return w; }
__device__ __forceinline__ float silu_mul(float g, float u) { return g / (1.f + __expf(-g)) * u; }
struct EpiGU {
  static constexpr bool kSsq = false;
  const float* ssq; u16* act;
  __device__ __forceinline__ float apply4(int row, int c0, float4 g, float4 u) const {
    float rs = rstd_from_ssq(ssq, row);
    float4 o = make_float4(silu_mul(g.x * rs, u.x * rs), silu_mul(g.y * rs, u.y * rs), silu_mul(g.z * rs, u.z * rs), silu_mul(g.w * rs, u.w * rs));
    *(uint2*)(act + (size_t)row * DFF + ((c0 & ~31) >> 1) + (c0 & 15)) = pack4(o);
    return 0.f;
  }
  __device__ __forceinline__ void ssq_out(int, int, float) const {}
};
struct EpiRes {
  static constexpr bool kSsq = true;
  float* x; u16* xb; float* ssq; float coef;
  __device__ __forceinline__ float apply4(int row, int c0, float4 v0, float4 v1) const {
    size_t i = (size_t)row * 1024 + c0;
    float4 a = *(const float4*)(x + i), b = *(const float4*)(x + i + 16);
    a.x += coef * v0.x; a.y += coef * v0.y; a.z += coef * v0.z; a.w += coef * v0.w;
    b.x += coef * v1.x; b.y += coef * v1.y; b.z += coef * v1.z; b.w += coef * v1.w;
    *(float4*)(x + i) = a; *(float4*)(x + i + 16) = b;
    *(uint2*)(xb + i) = pack4(a); *(uint2*)(xb + i + 16) = pack4(b);
    return a.x * a.x + a.y * a.y + a.z * a.z + a.w * a.w + b.x * b.x + b.y * b.y + b.z * b.z + b.w * b.w;
  }
  __device__ __forceinline__ void ssq_out(int row, int pn, float v) const { ssq[(size_t)row * 4 + pn] = v; }
};
struct EpiScaleBf {
  static constexpr bool kSsq = false;
  const float* ssq; u16* o; int ld;
  __device__ __forceinline__ float apply4(int row, int c0, float4 v0, float4 v1) const {
    float rs = rstd_from_ssq(ssq, row);
    size_t i = (size_t)row * ld + c0;
    *(uint2*)(o + i) = pack4(make_float4(v0.x * rs, v0.y * rs, v0.z * rs, v0.w * rs));
    *(uint2*)(o + i + 16) = pack4(make_float4(v1.x * rs, v1.y * rs, v1.z * rs, v1.w * rs));
    return 0.f;
  }
  __device__ __forceinline__ void ssq_out(int, int, float) const {}
};
struct EpiQ {
  static constexpr bool kSsq = false;
  u16* qb; const float2* rope;
  __device__ __forceinline__ float apply4(int row, int c0, float4 v0, float4 v1) const {
    if (c0 < 1024) {
      size_t i = (size_t)row * 1280 + (c0 >> 7) * 160 + (c0 & 127);
      *(uint2*)(qb + i) = pack4(v0); *(uint2*)(qb + i + 16) = pack4(v1);
    } else {
      int h = (c0 - 1024) >> 5, f0 = c0 & 15;
      int pos = row < TP ? (row & 4095) : (2048 + ((row - TP) & 63));
      const float2* cs = rope + pos * 16 + f0;
      float2 c_0 = cs[0], c_1 = cs[1], c_2 = cs[2], c_3 = cs[3];
      size_t i = (size_t)row * 1280 + h * 160 + 128 + f0;
      *(uint2*)(qb + i) = pack4(make_float4(v0.x * c_0.x - v1.x * c_0.y, v0.y * c_1.x - v1.y * c_1.y, v0.z * c_2.x - v1.z * c_2.y, v0.w * c_3.x - v1.w * c_3.y));
      *(uint2*)(qb + i + 16) = pack4(make_float4(v0.x * c_0.y + v1.x * c_0.x, v0.y * c_1.y + v1.y * c_1.x, v0.z * c_2.y + v1.z * c_2.x, v0.w * c_3.y + v1.w * c_3.x));
    }
    return 0.f;
  }
  __device__ __forceinline__ void ssq_out(int, int, float) const {}
};
__device__ __forceinline__ float decay_f(float z) {
  float nz = -z;
  float sp = fmaxf(nz, 0.f) + __logf(1.f + __expf(-fabsf(nz)));
  return __expf(-__expf(-sp - 0.5f));
}
struct EpiRW {
  static constexpr bool kSsq = false;
  const float* w0; const float* a0; const float* ka; char* ws;
  __device__ __forceinline__ void acol(size_t i, int c, float4 v) const {
    float* bb = (float*)(ws + W_BB); float* kb = (float*)(ws + W_KB); const float* kkb = (const float*)(ws + W_KKB);
    float4 a_0 = *(const float4*)(a0 + c), k_a = *(const float4*)(ka + c), kk = *(const float4*)(kkb + i), k = *(const float4*)(kb + i);
    float4 a = make_float4(sigmoidf_(a_0.x + v.x), sigmoidf_(a_0.y + v.y), sigmoidf_(a_0.z + v.z), sigmoidf_(a_0.w + v.w));
    *(float4*)(bb + i) = make_float4(kk.x * a.x, kk.y * a.y, kk.z * a.z, kk.w * a.w);
    *(float4*)(kb + i) = make_float4(k.x * (1.f + (a.x - 1.f) * k_a.x), k.y * (1.f + (a.y - 1.f) * k_a.y), k.z * (1.f + (a.z - 1.f) * k_a.z), k.w * (1.f + (a.w - 1.f) * k_a.w));
  }
  __device__ __forceinline__ float apply4(int row, int c0, float4 v0, float4 v1) const {
    if (c0 < 512) {
      float* wb = (float*)(ws + W_WB);
      float4 z0 = *(const float4*)(w0 + c0), z1 = *(const float4*)(w0 + c0 + 16);
      size_t i = (size_t)row * 512 + c0;
      *(float4*)(wb + i) = make_float4(decay_f(z0.x + v0.x), decay_f(z0.y + v0.y), decay_f(z0.z + v0.z), decay_f(z0.w + v0.w));
      *(float4*)(wb + i + 16) = make_float4(decay_f(z1.x + v1.x), decay_f(z1.y + v1.y), decay_f(z1.z + v1.z), decay_f(z1.w + v1.w));
    } else if (c0 < 1024) {
      int c = c0 - 512; size_t i = (size_t)row * 512 + c;
      acol(i, c, v0); acol(i + 16, c + 16, v1);
    } else {
      u16* gb = (u16*)(ws + W_GB);
      size_t i = (size_t)row * 512 + (c0 - 1024);
      *(uint2*)(gb + i) = pack4(v0); *(uint2*)(gb + i + 16) = pack4(v1);
    }
    return 0.f;
  }
  __device__ __forceinline__ void ssq_out(int, int, float) const {}
};
template <bool ISV>
struct EpiMem {
  static constexpr bool kSsq = false;
  float* of; u16* ob;
  __device__ __forceinline__ void quad(int row, int col, float4 v) const {
    *(float4*)(of + (size_t)row * 1024 + col) = v;
    int b = row >> 8, m = row & 255, h = col >> 8, d = col & 255;
    if (ISV) {
      u16* o = ob + (size_t)((b * 4 + h) * 256 + d) * 256 + m;
      o[0] = f2bf(v.x); o[256] = f2bf(v.y); o[512] = f2bf(v.z); o[768] = f2bf(v.w);
    } else {
      *(uint2*)(ob + (size_t)((b * 4 + h) * 256 + m) * 256 + d) = pack4(v);
    }
  }
  __device__ __forceinline__ float apply4(int row, int c0, float4 v0, float4 v1) const {
    quad(row, c0, v0); quad(row, c0 + 16, v1);
    return 0.f;
  }
  __device__ __forceinline__ void ssq_out(int, int, float) const {}
};

template <class F>
__device__ __forceinline__ void tconv(u16* dst, int ldd, int N, int K, int rot, F f) {
  extern __shared__ __attribute__((aligned(16))) char smem[];
  float* t = (float*)smem;
  const int nk = K / 64, nt = (N / 64) * nk, G = gridDim.x;
  const int tid = tidx(), a = tid >> 6, c = tid & 63;
  for (int tile = (int)((blockIdx.x + G - (rot % G)) % G); tile < nt; tile += G) {
    int n0 = (tile / nk) * 64, k0 = (tile % nk) * 64;
    __syncthreads();
#pragma unroll
    for (int i = 0; i < 8; ++i) { int kk = a + 8 * i; t[kk * 65 + c] = f(k0 + kk, n0 + c); }
    __syncthreads();
#pragma unroll
    for (int i = 0; i < 8; ++i) { int nn = a + 8 * i; dst[(size_t)(n0 + nn) * ldd + k0 + c] = f2bf(t[c * 65 + nn]); }
  }
}

template <class F>
__device__ __forceinline__ void tconv_v(u16* dst, int ldd, int N, int K, int vb, int nvb, F f) {
  extern __shared__ __attribute__((aligned(16))) char smem[];
  float* t = (float*)smem;
  const int nk = K / 64, nt = (N / 64) * nk;
  const int tid = tidx(), a = tid >> 6, c = tid & 63;
  for (int tile = vb; tile < nt; tile += nvb) {
    int n0 = (tile / nk) * 64, k0 = (tile % nk) * 64;
    __syncthreads();
#pragma unroll
    for (int i = 0; i < 8; ++i) { int kk = a + 8 * i; t[kk * 65 + c] = f(k0 + kk, n0 + c); }
    __syncthreads();
#pragma unroll
    for (int i = 0; i < 8; ++i) { int nn = a + 8 * i; dst[(size_t)(n0 + nn) * ldd + k0 + c] = f2bf(t[c * 65 + nn]); }
  }
  __syncthreads();
}

template <int DK, int DV, int RPG>
__device__ __forceinline__ void attn_item(const u16* __restrict__ Qb, int ldq, int nrows, const u16* __restrict__ Kb, int ldk,
                                          const u16* __restrict__ Vtb, int ldvt, int nkeys, u16* __restrict__ Ob, int ldo) {
  extern __shared__ __attribute__((aligned(16))) char smem[];
  constexpr int KS = DK + 8, VS = 68;
  u16* sK = (u16*)smem;
  u16* sV = sK + 64 * KS;
  const int tid = tidx(), wid = tid >> 6, lane = tid & 63, q = lane & 31, hh = lane >> 5;
  const int row = wid * 32 + q;
  const bool active = (wid * 32) < nrows;
  bf16x8 qf[DK / 16];
  if (active) {
#pragma unroll
    for (int ks = 0; ks < DK / 16; ++ks) qf[ks] = *(const bf16x8*)(Qb + (size_t)row * ldq + ks * 16 + hh * 8);
  }
  f32x16 o[DV / 32];
#pragma unroll
  for (int dt = 0; dt < DV / 32; ++dt)
#pragma unroll
    for (int i = 0; i < 16; ++i) o[dt][i] = 0.f;
  float mrun = -1e30f, lrun = 0.f;
  const int nkt = nkeys >> 6;
  constexpr int KCH = (64 * (DK / 8) + NTHR - 1) / NTHR;
  static_assert(DV == 128 && KCH <= 4, "staging registers are written out by hand");
  uint4 kr0, kr1, kr2, kr3, vr0, vr1;
#define AT_KL(N_, kt_) { const int c = tid + N_ * NTHR; if (N_ < KCH && c < 64 * (DK / 8)) { const int r = c / (DK / 8), cc = c % (DK / 8); \
      kr##N_ = *(const uint4*)(Kb + (size_t)((kt_) * 64 + r) * ldk + cc * 8); } }
#define AT_VL(N_, kt_) { const int c = tid + N_ * NTHR; const int r = c >> 3, cc = c & 7; vr##N_ = *(const uint4*)(Vtb + (size_t)r * ldvt + (kt_) * 64 + cc * 8); }
#define AT_GLOAD(kt_) do { AT_KL(0, kt_) AT_KL(1, kt_) AT_KL(2, kt_) AT_KL(3, kt_) AT_VL(0, kt_) AT_VL(1, kt_) } while (0)
#define AT_KS(N_) { const int c = tid + N_ * NTHR; if (N_ < KCH && c < 64 * (DK / 8)) { const int r = c / (DK / 8), cc = c % (DK / 8); *(uint4*)(sK + r * KS + cc * 8) = kr##N_; } }
#define AT_VS(N_) { const int c = tid + N_ * NTHR; const int r = c >> 3, cc = c & 7; uint2* d = (uint2*)(sV + r * VS + cc * 8); \
      const uint4 t_ = vr##N_; d[0] = make_uint2(t_.x, t_.y); d[1] = make_uint2(t_.z, t_.w); }
  AT_GLOAD(0);
  for (int kt = 0; kt < nkt; ++kt) {
    __syncthreads();
    AT_KS(0) AT_KS(1) AT_KS(2) AT_KS(3) AT_VS(0) AT_VS(1)
    __syncthreads();
    if (kt + 1 < nkt) AT_GLOAD(kt + 1);
    if (active) {
      f32x16 s0, s1;
#pragma unroll
      for (int i = 0; i < 16; ++i) { s0[i] = 0.f; s1[i] = 0.f; }
#pragma unroll
      for (int ks = 0; ks < DK / 16; ++ks) {
        bf16x8 a0 = *(const bf16x8*)(sK + q * KS + ks * 16 + hh * 8);
        bf16x8 a1 = *(const bf16x8*)(sK + (32 + q) * KS + ks * 16 + hh * 8);
        s0 = __builtin_amdgcn_mfma_f32_32x32x16_bf16(a0, qf[ks], s0, 0, 0, 0);
        s1 = __builtin_amdgcn_mfma_f32_32x32x16_bf16(a1, qf[ks], s1, 0, 0, 0);
      }
      float mx = s0[0];
#pragma unroll
      for (int i = 1; i < 16; ++i) mx = fmaxf(mx, s0[i]);
#pragma unroll
      for (int i = 0; i < 16; ++i) mx = fmaxf(mx, s1[i]);
      mx = fmaxf(mx, __shfl_xor(mx, 32));
      float mn = fmaxf(mrun, mx);
      float alpha = __builtin_amdgcn_exp2f(mrun - mn);
      mrun = mn;
      float ps = 0.f;
#pragma unroll
      for (int i = 0; i < 16; ++i) { s0[i] = __builtin_amdgcn_exp2f(sub_s(s0[i], mn)); ps = add_s(ps, s0[i]); }
#pragma unroll
      for (int i = 0; i < 16; ++i) { s1[i] = __builtin_amdgcn_exp2f(sub_s(s1[i], mn)); ps = add_s(ps, s1[i]); }
      lrun = lrun * alpha + ps;
#pragma unroll
      for (int dt = 0; dt < DV / 32; ++dt)
#pragma unroll
        for (int i = 0; i < 16; ++i) o[dt][i] = mul_s(o[dt][i], alpha);
#pragma unroll
      for (int kb = 0; kb < 2; ++kb)
#pragma unroll
        for (int s = 0; s < 2; ++s) {
          union { bf16x8 v; unsigned u[4]; } pf;
#pragma unroll
          for (int jj = 0; jj < 4; ++jj) {
            float e0 = kb ? s1[8 * s + 2 * jj] : s0[8 * s + 2 * jj];
            float e1 = kb ? s1[8 * s + 2 * jj + 1] : s0[8 * s + 2 * jj + 1];
            pf.u[jj] = pack2(e0, e1);
          }
          const int kbase = kb * 32 + s * 16 + 4 * hh;
#pragma unroll
          for (int dt = 0; dt < DV / 32; ++dt) {
            const u16* vp = sV + (dt * 32 + q) * VS + kbase;
            union { bf16x8 v; uint2 u[2]; } vf;
            vf.u[0] = *(const uint2*)vp; vf.u[1] = *(const uint2*)(vp + 8);
            o[dt] = __builtin_amdgcn_mfma_f32_32x32x16_bf16(vf.v, pf.v, o[dt], 0, 0, 0);
          }
        }
    }
  }
  if (active) {
    lrun += __shfl_xor(lrun, 32);
    float inv = 1.f / lrun;
    u16* op = Ob + (size_t)(row / RPG) * ldo + (size_t)(row % RPG) * DV;
#pragma unroll
    for (int dt = 0; dt < DV / 32; ++dt)
#pragma unroll
      for (int g = 0; g < 4; ++g) {
        uint2 w;
        w.x = pack2(o[dt][4 * g] * inv, o[dt][4 * g + 1] * inv);
        w.y = pack2(o[dt][4 * g + 2] * inv, o[dt][4 * g + 3] * inv);
        *(uint2*)(op + dt * 32 + 8 * g + 4 * hh) = w;
      }
  }
}

#undef AT_GLOAD
#undef AT_KL
#undef AT_VL
#undef AT_KS
#undef AT_VS
__device__ __forceinline__ float dpp_sum16(float x) {
  x += __int_as_float(__builtin_amdgcn_update_dpp(0, __float_as_int(x), 0xB1, 0xF, 0xF, false));
  x += __int_as_float(__builtin_amdgcn_update_dpp(0, __float_as_int(x), 0x4E, 0xF, 0xF, false));
  x += __int_as_float(__builtin_amdgcn_update_dpp(0, __float_as_int(x), 0x141, 0xF, 0xF, false));
  x += __int_as_float(__builtin_amdgcn_update_dpp(0, __float_as_int(x), 0x140, 0xF, 0xF, false));
  return x;
}
__device__ __forceinline__ void scan_item(KPR p, int l, int g0, int h, int half, int nsteps, const float* S0, float* Sout) {
  extern __shared__ __attribute__((aligned(16))) char smem[];
  float* sT = (float*)smem;
  float* sV = sT + 5 * 4096;
  const float* src0 = (const float*)(p.ws + W_RB) + h * 64; const float* src1 = (const float*)(p.ws + W_WB) + h * 64;
  const float* src2 = (const float*)(p.ws + W_KB) + h * 64; const float* src3 = (const float*)(p.ws + W_KKB) + h * 64;
  const float* src4 = (const float*)(p.ws + W_BB) + h * 64;
  const float* VB = (const float*)(p.ws + W_VB) + h * 64 + half * 32;
  float* YB = (float*)(p.ws + W_YB) + h * 64 + half * 32;
  const int tid = tidx();
  const int il = tid >> 4, sub = tid & 15, j0 = sub * 4, i = half * 32 + il;
  float s[4];
#pragma unroll
  for (int j = 0; j < 4; ++j) s[j] = S0 ? S0[i * 64 + j0 + j] : 0.f;
  float4 pa0, pa1, pa2, pa3, pa4, pb0, pb1, pb2, pb3, pb4, pfv;
  const int e0 = tid, e1 = tid + NTHR;
  const int st0 = e0 >> 4, c40 = (e0 & 15) * 4, st1 = e1 >> 4, c41 = (e1 & 15) * 4;
  const int stv = tid >> 3, c4v = (tid & 7) * 4;
#define SC_GL1(x, c0_) pa##x = *(const float4*)(src##x + (size_t)(g0 + (c0_) + st0) * 512 + c40); \
                       pb##x = *(const float4*)(src##x + (size_t)(g0 + (c0_) + st1) * 512 + c41);
#define SC_GLOAD(c0_) do { SC_GL1(0, c0_) SC_GL1(1, c0_) SC_GL1(2, c0_) SC_GL1(3, c0_) SC_GL1(4, c0_) \
    pfv = *(const float4*)(VB + (size_t)(g0 + (c0_) + stv) * 512 + c4v); } while (0)
#define SC_ST1(x) *(float4*)(sT + x * 4096 + st0 * 64 + c40) = pa##x; *(float4*)(sT + x * 4096 + st1 * 64 + c41) = pb##x;
  SC_GLOAD(0);
  for (int c0 = 0; c0 < nsteps; c0 += 64) {
    __syncthreads();
    SC_ST1(0) SC_ST1(1) SC_ST1(2) SC_ST1(3) SC_ST1(4)
    *(float4*)(sV + stv * 32 + c4v) = pfv;
    __syncthreads();
    if (c0 + 64 < nsteps) SC_GLOAD(c0 + 64);
#define SC_LD(S, st_) do { const int _s = (st_) < 64 ? (st_) : 63; \
      S##r = *(const float4*)(sT + _s * 64 + j0); S##w = *(const float4*)(sT + 4096 + _s * 64 + j0); \
      S##k = *(const float4*)(sT + 8192 + _s * 64 + j0); S##q = *(const float4*)(sT + 12288 + _s * 64 + j0); \
      S##b = *(const float4*)(sT + 16384 + _s * 64 + j0); S##v = sV[_s * 32 + il]; } while (0)
#define SC_STEP(S, st_) do { \
      float sa = -dpp_sum16(fma_s(s[1], S##q.y, mul_s(s[0], S##q.x)) + fma_s(s[3], S##q.w, mul_s(s[2], S##q.z))); \
      s[0] = fma_s(sa, S##b.x, fma_s(s[0], S##w.x, mul_s(S##v, S##k.x))); \
      s[1] = fma_s(sa, S##b.y, fma_s(s[1], S##w.y, mul_s(S##v, S##k.y))); \
      s[2] = fma_s(sa, S##b.z, fma_s(s[2], S##w.z, mul_s(S##v, S##k.z))); \
      s[3] = fma_s(sa, S##b.w, fma_s(s[3], S##w.w, mul_s(S##v, S##k.w))); \
      float y = dpp_sum16(fma_s(s[1], S##r.y, mul_s(s[0], S##r.x)) + fma_s(s[3], S##r.w, mul_s(s[2], S##r.z))); \
      ykeep = (sub == ((st_) & 15)) ? y : ykeep; } while (0)
    float4 Ar, Aw, Ak, Aq, Ab, Br, Bw, Bk, Bq, Bb, Cr, Cw, Ck, Cq, Cb, Dr, Dw, Dk, Dq, Db;
    float Av, Bv, Cv, Dv, ykeep = 0.f;
    SC_LD(A, 0); SC_LD(B, 1); SC_LD(C, 2);
    for (int st = 0; st < 64; st += 4) {
      SC_LD(D, st + 3); SC_STEP(A, st);
      SC_LD(A, st + 4); SC_STEP(B, st + 1);
      SC_LD(B, st + 5); SC_STEP(C, st + 2);
      SC_LD(C, st + 6); SC_STEP(D, st + 3);
      if ((st & 15) == 12) YB[(size_t)(g0 + c0 + (st - 12) + sub) * 512 + il] = ykeep;
    }
  }
#undef SC_LD
#undef SC_STEP
#undef SC_GLOAD
#undef SC_GL1
#undef SC_ST1
  *(float4*)(Sout + i * 64 + j0) = make_float4(s[0], s[1], s[2], s[3]);
}

constexpr int LS = 68;
constexpr int LBUF = 64 * LS;
constexpr int LH = 72;

__device__ __forceinline__ void split8(const float* x, bf16x8& hi, bf16x8& lo) {
  union { bf16x8 v; unsigned u[4]; } H, Lo;
#pragma unroll
  for (int j = 0; j < 4; ++j) {
    const unsigned h = pack2(x[2 * j], x[2 * j + 1]);
    H.u[j] = h;
    Lo.u[j] = pack2(x[2 * j] - __uint_as_float(h << 16), x[2 * j + 1] - __uint_as_float(h & 0xffff0000u));
  }
  hi = H.v; lo = Lo.v;
}
template <int AM, int AK, int BKS, int BN, bool SPLIT = true>
__device__ __forceinline__ void mm64(const float* A, const float* B, f32x4 (&acc)[2], int m0, int n0, int lane) {
  const int lr = lane & 15, lq = lane >> 4;
#pragma unroll
  for (int ks = 0; ks < 2; ++ks) {
    const int k0 = ks * 32 + lq * 8;
    float a[8];
    if (AK == 1) {
      float4 x0 = *(const float4*)(A + (m0 + lr) * AM + k0), x1 = *(const float4*)(A + (m0 + lr) * AM + k0 + 4);
      a[0] = x0.x; a[1] = x0.y; a[2] = x0.z; a[3] = x0.w; a[4] = x1.x; a[5] = x1.y; a[6] = x1.z; a[7] = x1.w;
    } else {
#pragma unroll
      for (int j = 0; j < 8; ++j) a[j] = A[(m0 + lr) * AM + (k0 + j) * AK];
    }
    bf16x8 ah, al;
    if (SPLIT) split8(a, ah, al);
    else { union { bf16x8 v; unsigned u[4]; } H; for (int j = 0; j < 4; ++j) H.u[j] = pack2(a[2 * j], a[2 * j + 1]); ah = H.v; al = H.v; }
#pragma unroll
    for (int nt = 0; nt < 2; ++nt) {
      const int n = n0 + nt * 16 + lr;
      float b[8];
      if (BKS == 1) {
        float4 x0 = *(const float4*)(B + n * BN + k0), x1 = *(const float4*)(B + n * BN + k0 + 4);
        b[0] = x0.x; b[1] = x0.y; b[2] = x0.z; b[3] = x0.w; b[4] = x1.x; b[5] = x1.y; b[6] = x1.z; b[7] = x1.w;
      } else {
#pragma unroll
        for (int j = 0; j < 8; ++j) b[j] = B[(k0 + j) * BKS + n * BN];
      }
      if (SPLIT) {
        bf16x8 bh, bl; split8(b, bh, bl);
        acc[nt] = __builtin_amdgcn_mfma_f32_16x16x32_bf16(ah, bh, acc[nt], 0, 0, 0);
        acc[nt] = __builtin_amdgcn_mfma_f32_16x16x32_bf16(ah, bl, acc[nt], 0, 0, 0);
        acc[nt] = __builtin_amdgcn_mfma_f32_16x16x32_bf16(al, bh, acc[nt], 0, 0, 0);
      } else {
        union { bf16x8 v; unsigned u[4]; } Bh;
#pragma unroll
        for (int j = 0; j < 4; ++j) Bh.u[j] = pack2(b[2 * j], b[2 * j + 1]);
        acc[nt] = __builtin_amdgcn_mfma_f32_16x16x32_bf16(ah, Bh.v, acc[nt], 0, 0, 0);
      }
    }
  }
}
#define MM_ZERO(acc) do { acc[0] = f32x4{0.f, 0.f, 0.f, 0.f}; acc[1] = f32x4{0.f, 0.f, 0.f, 0.f}; } while (0)
#define MM_FOREACH(acc, BODY) do { _Pragma("unroll") for (int nt_ = 0; nt_ < 2; ++nt_) _Pragma("unroll") for (int rg_ = 0; rg_ < 4; ++rg_) { \
    const int m = m0 + lq * 4 + rg_, n = n0 + nt_ * 16 + lr; const float val = acc[nt_][rg_]; BODY } } while (0)

__device__ __forceinline__ void cprep_item(KPR p, int grow0, int h, int cid) {
  extern __shared__ __attribute__((aligned(16))) char smem[];
  float* B0 = (float*)smem; float* B1 = B0 + LBUF; float* B2 = B1 + LBUF; float* B3 = B2 + LBUF;
  float* B4 = B3 + LBUF; float* B5 = B4 + LBUF; float* B6 = B5 + LBUF; float* B7 = B6 + LBUF;
  float* wC = (float*)(smem + 139264);
  const int tid = tidx(), wid = tid >> 6, lane = tid & 63, lr = lane & 15, lq = lane >> 4;
  const int m0 = (wid >> 1) * 16, n0 = (wid & 1) * 32;
  const float* WB = (const float*)(p.ws + W_WB) + h * 64; const float* KKB = (const float*)(p.ws + W_KKB) + h * 64;
  const float* BB = (const float*)(p.ws + W_BB) + h * 64; const float* KB = (const float*)(p.ws + W_KB) + h * 64;
  const float* RB = (const float*)(p.ws + W_RB) + h * 64; const float* VB = (const float*)(p.ws + W_VB) + h * 64;
  f32x4 acc[2];
  __syncthreads();
#pragma unroll
  for (int q = 0; q < 2; ++q) {
    const int e = tid + q * NTHR, t = e >> 4, c4 = (e & 15) * 4;
    const size_t gi = (size_t)(grow0 + t) * 512 + c4;
    *(float4*)(B0 + t * LS + c4) = *(const float4*)(WB + gi);
    float4 kk = *(const float4*)(KKB + gi);
    *(float4*)(B1 + t * LS + c4) = make_float4(-kk.x, -kk.y, -kk.z, -kk.w);
    *(float4*)(B2 + t * LS + c4) = *(const float4*)(BB + gi);
    *(float4*)(B3 + t * LS + c4) = *(const float4*)(KB + gi);
    *(float4*)(B4 + t * LS + c4) = *(const float4*)(RB + gi);
  }
  __syncthreads();
  {
    const int j = tid & 63, sg = tid >> 6;
    float wv[8];
#pragma unroll
    for (int u = 0; u < 8; ++u) wv[u] = B0[(sg * 8 + u) * LS + j];
#pragma unroll
    for (int u = 1; u < 8; ++u) wv[u] *= wv[u - 1];
    float* segp = B5;
    segp[sg * 64 + j] = wv[7];
    __syncthreads();
    float pre = 1.f;
    for (int u = 0; u < sg; ++u) pre *= segp[u * 64 + j];
#pragma unroll
    for (int u = 0; u < 8; ++u) B0[(sg * 8 + u) * LS + j] = wv[u] * pre;
    if (sg == 7) wC[j] = wv[7] * pre;
  }
  __syncthreads();
  for (int e = tid; e < 4096; e += NTHR) {
    const int t = e >> 6, j = e & 63, o = t * LS + j;
    const float wt = B0[o], wp = t ? B0[o - LS] : 1.f, iw = 1.f / wt;
    B1[o] *= wp; B2[o] *= iw; B3[o] *= iw; B4[o] *= wt;
  }
  __syncthreads();
  MM_ZERO(acc); mm64<LS, 1, 1, LS>(B2, B1, acc, m0, n0, lane);
  MM_FOREACH(acc, { const float v = m < n ? val : 0.f; B5[m * LS + n] = v; B6[m * LS + n] = v + (m == n ? 1.f : 0.f); });
  __syncthreads();
  MM_ZERO(acc); mm64<LS, 1, LS, 1>(B5, B5, acc, m0, n0, lane);
  MM_FOREACH(acc, { B7[m * LS + n] = val; });
  __syncthreads();
  for (int it = 0; it < 5; ++it) {
    MM_ZERO(acc); mm64<LS, 1, LS, 1>(B6, B7, acc, m0, n0, lane);
    f32x4 acc2[2]; MM_ZERO(acc2);
    if (it < 4) mm64<LS, 1, LS, 1>(B7, B7, acc2, m0, n0, lane);
    __syncthreads();
    MM_FOREACH(acc, { B6[m * LS + n] += val; });
    if (it < 4) MM_FOREACH(acc2, { B7[m * LS + n] = val; });
    __syncthreads();
  }
  MM_ZERO(acc); mm64<1, LS, LS, 1>(B1, B6, acc, m0, n0, lane);
  MM_FOREACH(acc, { B5[m * LS + n] = val; });
  MM_ZERO(acc); mm64<LS, 1, 1, LS>(B3, B1, acc, m0, n0, lane);
  MM_FOREACH(acc, { B0[m * LS + n] = m < n ? val : 0.f; });
  __syncthreads();
  MM_ZERO(acc); mm64<LS, 1, LS, 1>(B0, B6, acc, m0, n0, lane);
  MM_FOREACH(acc, { B7[m * LS + n] = val; });
  __syncthreads();
  MM_ZERO(acc); mm64<LS, 1, 1, LS, false>(B2, B4, acc, m0, n0, lane);
  {
    f32x4 acc2[2]; MM_ZERO(acc2); mm64<LS, 1, 1, LS, false>(B3, B4, acc2, m0, n0, lane);
    __syncthreads();
    MM_FOREACH(acc, { B0[m * LS + n] = m <= n ? val : 0.f; });
    MM_FOREACH(acc2, { B1[m * LS + n] = m <= n ? val : 0.f; });
  }
  __syncthreads();
  {
    u16* RRT = (u16*)(p.ws + W_CRR) + (size_t)cid * 4096;
    MM_ZERO(acc); mm64<1, LS, 1, LS, false>(B0, B5, acc, m0, n0, lane);
    MM_FOREACH(acc, { RRT[m * 64 + n] = f2bf(val + B4[m * LS + n]); });
    MM_ZERO(acc); mm64<LS, 1, LS, 1, false>(B7, B0, acc, m0, n0, lane);
    MM_FOREACH(acc, { B6[m * LS + n] = val + B1[m * LS + n]; });
  }
  __syncthreads();
  for (int e = tid; e < 4096; e += NTHR) {
    const int t = e >> 6, j = e & 63, o = t * LS + j;
    const float wc = wC[j];
    B2[o] *= wc; B3[o] *= wc;
  }
#pragma unroll
  for (int q = 0; q < 2; ++q) {
    const int e = tid + q * NTHR, t = e >> 4, c4 = (e & 15) * 4;
    *(float4*)(B4 + t * LS + c4) = *(const float4*)(VB + (size_t)(grow0 + t) * 512 + c4);
  }
  __syncthreads();
  {
    float* YB = (float*)(p.ws + W_YB) + h * 64;
    MM_ZERO(acc); mm64<1, LS, LS, 1, false>(B6, B4, acc, m0, n0, lane);
    MM_FOREACH(acc, { YB[(size_t)(grow0 + m) * 512 + n] = val; });
    u16* PT = (u16*)(p.ws + W_CPT) + (size_t)cid * 4096;
    MM_ZERO(acc); mm64<1, LS, 1, LS, false>(B2, B5, acc, m0, n0, lane);
    MM_FOREACH(acc, { PT[m * 64 + n] = f2bf(val + (m == n ? wC[m] : 0.f)); });
    MM_ZERO(acc); mm64<LS, 1, LS, 1, false>(B7, B2, acc, m0, n0, lane);
    MM_FOREACH(acc, { B0[m * LS + n] = val + B3[m * LS + n]; });
  }
  __syncthreads();
  {
    float* CQ = (float*)(p.ws + W_CQ) + (size_t)cid * 4096;
    MM_ZERO(acc); mm64<1, LS, LS, 1, false>(B4, B0, acc, m0, n0, lane);
    MM_FOREACH(acc, { CQ[m * 64 + n] = val; });
  }
}

__device__ __forceinline__ void phase_cprep(KPR p) {
  for (int id = blockIdx.x; id < 2304; id += gridDim.x) {
    if (id < 2048) { int b = id >> 9, h = (id >> 6) & 7, c = id & 63; cprep_item(p, b * 4096 + c * 64, h, id); }
    else { int k = id - 2048; cprep_item(p, TP + (k >> 3) * 64, k & 7, id); }
  }
}

__device__ __forceinline__ void cseq_item(KPR p, int g0, int h, int nch, int cid0, const float* S0, float* Sout) {
  extern __shared__ __attribute__((aligned(16))) char smem[];
  float* Sf = (float*)smem;
  float* Qf = Sf + LBUF;
  float* Yf = Qf + LBUF;
  u16* Rb = (u16*)(Yf + LBUF);
  u16* Pb = Rb + 64 * LH;
  const int tid = tidx(), wid = tid >> 6, lane = tid & 63, lr = lane & 15, lq = lane >> 4;
  const int m0 = (wid >> 1) * 16, n0 = (wid & 1) * 32;
  float* YB = (float*)(p.ws + W_YB) + h * 64;
  const u16* RRT = (const u16*)(p.ws + W_CRR) + (size_t)cid0 * 4096;
  const u16* PT = (const u16*)(p.ws + W_CPT) + (size_t)cid0 * 4096;
  const float* CQ = (const float*)(p.ws + W_CQ) + (size_t)cid0 * 4096;
  __syncthreads();
  for (int e = tid; e < 4096; e += NTHR) { const int i = e >> 6, j = e & 63; Sf[i * LS + j] = S0 ? S0[e] : 0.f; }
  const int hr = tid >> 3, hc = (tid & 7) * 8;
  const int f0t = tid >> 4, f0c = (tid & 15) * 4;
  uint4 pr, pp; float4 q0, q1, y0, y1;
#define CS_LOAD(c_) do { \
    pr = *(const uint4*)(RRT + (size_t)(c_) * 4096 + hr * 64 + hc); pp = *(const uint4*)(PT + (size_t)(c_) * 4096 + hr * 64 + hc); \
    q0 = *(const float4*)(CQ + (size_t)(c_) * 4096 + f0t * 64 + f0c); q1 = *(const float4*)(CQ + (size_t)(c_) * 4096 + (f0t + 32) * 64 + f0c); \
    y0 = *(const float4*)(YB + (size_t)(g0 + (c_) * 64 + f0t) * 512 + f0c); y1 = *(const float4*)(YB + (size_t)(g0 + (c_) * 64 + f0t + 32) * 512 + f0c); } while (0)
  CS_LOAD(0);
  for (int c = 0; c < nch; ++c) {
    __syncthreads();
    *(uint4*)(Rb + hr * LH + hc) = pr; *(uint4*)(Pb + hr * LH + hc) = pp;
    *(float4*)(Qf + f0t * LS + f0c) = q0; *(float4*)(Qf + (f0t + 32) * LS + f0c) = q1;
    *(float4*)(Yf + f0t * LS + f0c) = y0; *(float4*)(Yf + (f0t + 32) * LS + f0c) = y1;
    __syncthreads();
    if (c + 1 < nch) CS_LOAD(c + 1);
    f32x4 ay[2], as[2]; MM_ZERO(ay); MM_ZERO(as);
#pragma unroll
    for (int ks = 0; ks < 2; ++ks) {
      const int k0 = ks * 32 + lq * 8;
      const bf16x8 ra = *(const bf16x8*)(Rb + (m0 + lr) * LH + k0);
      float sa[8];
      { float4 x0 = *(const float4*)(Sf + (m0 + lr) * LS + k0), x1 = *(const float4*)(Sf + (m0 + lr) * LS + k0 + 4);
        sa[0] = x0.x; sa[1] = x0.y; sa[2] = x0.z; sa[3] = x0.w; sa[4] = x1.x; sa[5] = x1.y; sa[6] = x1.z; sa[7] = x1.w; }
      bf16x8 sah, sal; split8(sa, sah, sal);
#pragma unroll
      for (int nt = 0; nt < 2; ++nt) {
        const int n = n0 + nt * 16 + lr;
        float sb[8];
        { float4 x0 = *(const float4*)(Sf + n * LS + k0), x1 = *(const float4*)(Sf + n * LS + k0 + 4);
          sb[0] = x0.x; sb[1] = x0.y; sb[2] = x0.z; sb[3] = x0.w; sb[4] = x1.x; sb[5] = x1.y; sb[6] = x1.z; sb[7] = x1.w; }
        bf16x8 sbh, sbl; split8(sb, sbh, sbl);
        ay[nt] = __builtin_amdgcn_mfma_f32_16x16x32_bf16(ra, sbh, ay[nt], 0, 0, 0);
        ay[nt] = __builtin_amdgcn_mfma_f32_16x16x32_bf16(ra, sbl, ay[nt], 0, 0, 0);
        const bf16x8 pb = *(const bf16x8*)(Pb + n * LH + k0);
        as[nt] = __builtin_amdgcn_mfma_f32_16x16x32_bf16(sah, pb, as[nt], 0, 0, 0);
        as[nt] = __builtin_amdgcn_mfma_f32_16x16x32_bf16(sal, pb, as[nt], 0, 0, 0);
      }
    }
    MM_FOREACH(ay, { YB[(size_t)(g0 + c * 64 + m) * 512 + n] = val + Yf[m * LS + n]; });
    __syncthreads();
    MM_FOREACH(as, { Sf[m * LS + n] = val + Qf[m * LS + n]; });
  }
#undef CS_LOAD
  __syncthreads();
  for (int e = tid; e < 4096; e += NTHR) { const int i = e >> 6, j = e & 63; Sout[e] = Sf[i * LS + j]; }
}

__device__ __forceinline__ void phase_yfin(KPR p, int l) {
  const int tid = tidx(), wid = tid >> 6, lane = tid & 63;
  const float* YB = (const float*)(p.ws + W_YB); const float* RB = (const float*)(p.ws + W_RB); const float* KB = (const float*)(p.ws + W_KB);
  const float* VB = (const float*)(p.ws + W_VB); const u16* GB = (const u16*)(p.ws + W_GB); u16* AO = (u16*)(p.ws + W_AO);
  const float* rk = p.in[I_RK] + l * 512; const float* gng = p.in[I_GNG] + l * 512; const float* gnb = p.in[I_GNB] + l * 512;
  for (int g = blockIdx.x * 8 + wid; g < T; g += gridDim.x * 8) {
#pragma unroll 2
    for (int h = 0; h < 8; ++h) {
      size_t i = (size_t)g * 512 + h * 64 + lane;
      float y = YB[i];
      float mu = wave_sum(y) * (1.f / 64.f);
      float dlt = y - mu;
      float var = wave_sum(dlt * dlt) * (1.f / 64.f);
      float bon = wave_sum(RB[i] * KB[i] * rk[h * 64 + lane]);
      float v = dlt * rsqrtf(var + 64e-5f) * gng[h * 64 + lane] + gnb[h * 64 + lane] + bon * VB[i];
      AO[(size_t)g * 1536 + 1024 + h * 64 + lane] = f2bf(v * bf2f(GB[i]));
    }
  }
}

__device__ __forceinline__ void phase_init(KPR p) {
  const int G = gridDim.x, tid = tidx(), wid = tid >> 6, lane = tid & 63;
  const int gw = blockIdx.x * 8 + wid, nw = G * 8;
  {
    float* X = (float*)(p.ws + W_X); u16* XB = (u16*)(p.ws + W_XB); float* SSQ = (float*)(p.ws + W_SSQ);
    for (int g = gw; g < T; g += nw) {
      const float* src = g < TP ? p.in[I_XP] + (size_t)g * 1024 : p.in[I_XS] + (size_t)(g - TP) * 1024;
      float ss = 0.f;
#pragma unroll
      for (int i = 0; i < 4; ++i) {
        float4 v = *(const float4*)(src + i * 256 + lane * 4);
        *(float4*)(X + (size_t)g * 1024 + i * 256 + lane * 4) = v;
        uint2 w; w.x = pack2(v.x, v.y); w.y = pack2(v.z, v.w);
        *(uint2*)(XB + (size_t)g * 1024 + i * 256 + lane * 4) = w;
        ss += v.x * v.x + v.y * v.y + v.z * v.z + v.w * v.w;
      }
      ss = wave_sum(ss);
      if (lane == 0) *(float4*)(SSQ + (size_t)g * 4) = make_float4(ss, 0.f, 0.f, 0.f);
    }
  }
  {
    u16* MB = (u16*)(p.ws + W_MB);
    for (int g = gw; g < 1024; g += nw) {
      const float* src = p.in[I_MEMP] + (size_t)g * 1024;
      float4 v[4]; float ss = 0.f;
#pragma unroll
      for (int i = 0; i < 4; ++i) { v[i] = *(const float4*)(src + i * 256 + lane * 4); ss += v[i].x * v[i].x + v[i].y * v[i].y + v[i].z * v[i].z + v[i].w * v[i].w; }
      ss = wave_sum(ss);
      float rs = rsqrtf(ss * (1.f / 1024.f) + 1e-6f);
#pragma unroll
      for (int i = 0; i < 4; ++i) {
        uint2 w; w.x = pack2(v[i].x * rs, v[i].y * rs); w.y = pack2(v[i].z * rs, v[i].w * rs);
        *(uint2*)(MB + (size_t)g * 1024 + i * 256 + lane * 4) = w;
      }
    }
  }
  {
    float2* RT = (float2*)(p.ws + W_ROPE);
    for (int e = blockIdx.x * NTHR + tid; e < 4096 * 16; e += G * NTHR) {
      int pos = e >> 4, i = e & 15;
      float inv = powf(10000.f, -(float)i / 16.f);
      float ang = (float)pos * inv;
      float sn, cs; sincosf(ang, &sn, &cs);
      RT[e] = make_float2(cs, sn);
    }
  }
  int rot = 0;
  for (int l = 0; l < NL; ++l) {
    u16* WT = (u16*)(p.ws + W_WT) + (size_t)l * WE_LAYER;
    for (int f = 0; f < 2; ++f) {
      const float* nrm = p.in[f ? I_F2N : I_F1N] + l * 1024;
      const float* wg = p.in[f ? I_F2G : I_F1G] + (size_t)l * 1024 * DFF;
      const float* wu = p.in[f ? I_F2U : I_F1U] + (size_t)l * 1024 * DFF;
      const float* wd = p.in[f ? I_F2D : I_F1D] + (size_t)l * 1024 * DFF;
      tconv(WT + (f ? WE_GU2 : WE_GU1), 1024, 5632, 1024, rot, [=](int k, int n) {
        int j = (n >> 5) * 16 + (n & 15);
        const float* s = ((n >> 4) & 1) ? wu : wg;
        return nrm[k] * s[(size_t)k * DFF + j];
      });
      rot += 88 * 16;
      tconv(WT + (f ? WE_D2 : WE_D1), DFF, 1024, DFF, rot, [=](int k, int n) { return wd[(size_t)k * 1024 + n]; });
      rot += 16 * 44;
    }
    {
      const float* nrm = p.in[I_MIXN] + l * 1024; const float* w = p.in[I_WIN] + (size_t)l * 1024 * DIN;
      tconv(WT + WE_IN, 1024, DINP, 1024, rot, [=](int k, int n) { return n < DIN ? nrm[k] * w[(size_t)k * DIN + n] : 0.f; });
      rot += 36 * 16;
    }
    {
      const float* nrm = p.in[I_QN] + l * 256; const float* wuq = p.in[I_WUQ] + (size_t)l * 256 * 768;
      const float* wuk = p.in[I_WUK] + (size_t)l * 8 * 128 * 64;
      tconv(WT + WE_Q, 256, 1280, 256, rot, [=](int k, int n) {
        float r;
        if (n < 1024) {
          int h = n >> 7, c = n & 127;
          const float* a = wuq + (size_t)k * 768 + h * 96; const float* b = wuk + (size_t)(h * 128 + c) * 64;
          r = 0.f;
          for (int d = 0; d < 64; ++d) r += a[d] * b[d];
        } else {
          int hr = n - 1024;
          r = wuq[(size_t)k * 768 + (hr >> 5) * 96 + 64 + (hr & 31)];
        }
        return r * nrm[k] * QSCALE;
      });
      rot += 20 * 4;
    }
    {
      const float* wup = p.in[I_WUP] + (size_t)l * 64 * 512; const float* aup = p.in[I_AUP] + (size_t)l * 64 * 512;
      const float* gup = p.in[I_GUP] + (size_t)l * 128 * 512;
      tconv(WT + WE_RW, 256, 1536, 256, rot, [=](int k, int n) {
        if (n < 512) return k < 64 ? wup[k * 512 + n] : 0.f;
        if (n < 1024) return (k >= 64 && k < 128) ? aup[(k - 64) * 512 + n - 512] : 0.f;
        return k >= 128 ? gup[(k - 128) * 512 + n - 1024] : 0.f;
      });
      rot += 24 * 4;
    }
    {
      const float* wuv = p.in[I_WUV] + (size_t)l * 8 * 128 * 64; const float* wo = p.in[I_WOUT] + (size_t)l * 1024 * 1024;
      tconv(WT + WE_OUT, 1536, 1024, 1536, rot, [=](int k, int n) {
        if (k < 1024) {
          int h = k >> 7, c = k & 127;
          const float* a = wuv + (size_t)(h * 128 + c) * 64; const float* b = wo + (size_t)(h * 64) * 1024 + n;
          float r = 0.f;
          for (int v = 0; v < 64; ++v) r += a[v] * b[(size_t)v * 1024];
          return r;
        }
        return wo[(size_t)(512 + k - 1024) * 1024 + n];
      });
      rot += 16 * 24;
    }
    {
      const float* nx = p.in[I_XN] + l * 1024; const float* nm = p.in[I_MKVN] + l * 1024;
      const float* wq = p.in[I_WMQ] + (size_t)l * 1048576; const float* wk = p.in[I_WMK] + (size_t)l * 1048576;
      const float* wv = p.in[I_WMV] + (size_t)l * 1048576; const float* wo = p.in[I_WMO] + (size_t)l * 1048576;
      tconv(WT + WE_MQ, 1024, 1024, 1024, rot, [=](int k, int n) { return nx[k] * wq[(size_t)k * 1024 + n] * XSCALE; });
      tconv(WT + WE_MK, 1024, 1024, 1024, rot, [=](int k, int n) { return nm[k] * wk[(size_t)k * 1024 + n]; });
      tconv(WT + WE_MV, 1024, 1024, 1024, rot, [=](int k, int n) { return nm[k] * wv[(size_t)k * 1024 + n]; });
      tconv(WT + WE_MO, 1024, 1024, 1024, rot, [=](int k, int n) { return wo[(size_t)k * 1024 + n]; });
    }
  }
}

__device__ __forceinline__ void phase_prep(KPR p, int l) {
  extern __shared__ __attribute__((aligned(16))) char smem[];
  u16* sv = (u16*)smem;
  const int tid = tidx(), wid = tid >> 6, lane = tid & 63;
  const u16* PROJ = (const u16*)(p.ws + W_PROJ);
  u16* CQB = (u16*)(p.ws + W_CQB); u16* A2 = (u16*)(p.ws + W_A2);
  float* RB = (float*)(p.ws + W_RB); float* KB = (float*)(p.ws + W_KB); float* VB = (float*)(p.ws + W_VB); float* KKB = (float*)(p.ws + W_KKB);
  u16* KP = (u16*)(p.ws + W_KP); u16* KS = (u16*)(p.ws + W_KS); u16* VTP = (u16*)(p.ws + W_VTP); u16* VTS = (u16*)(p.ws + W_VTS);
  const float2* RT = (const float2*)(p.ws + W_ROPE);
  const float* kvn = p.in[I_KVN] + l * 128; const float* mu = p.in[I_MU] + l * DSH; const float* kkw = p.in[I_KK] + l * 512;
  for (int chunk = blockIdx.x; chunk < T / 72; chunk += gridDim.x) {
  __syncthreads();
  for (int ri = 0; ri < 9; ++ri) {
    const int rl = wid * 9 + ri, g = chunk * 72 + rl;
    const u16* pr = PROJ + (size_t)g * DINP;
    const bool isP = g < TP;
    int b, t, pos, tlen;
    if (isP) { b = g >> 12; t = g & 4095; pos = t; tlen = 4096; } else { int gg = g - TP; b = gg >> 6; t = gg & 63; pos = 2048 + t; tlen = 64; }
    {
      uint2 w = *(const uint2*)(pr + lane * 4);
      float v0 = bf2f(w.x & 0xffff), v1 = bf2f(w.x >> 16), v2 = bf2f(w.y & 0xffff), v3 = bf2f(w.y >> 16);
      float ss = wave_sum(v0 * v0 + v1 * v1 + v2 * v2 + v3 * v3);
      float rs = rsqrtf(ss * (1.f / 256.f) + 1e-6f);
      uint2 o; o.x = pack2(v0 * rs, v1 * rs); o.y = pack2(v2 * rs, v3 * rs);
      *(uint2*)(CQB + (size_t)g * 256 + lane * 4) = o;
    }
    {
      unsigned w = *(const unsigned*)(pr + 256 + lane * 2);
      float v0 = bf2f(w & 0xffff), v1 = bf2f(w >> 16);
      float ss = wave_sum(v0 * v0 + v1 * v1);
      float rs = rsqrtf(ss * (1.f / 128.f) + 1e-6f);
      int c = lane * 2;
      v0 = v0 * rs * kvn[c]; v1 = v1 * rs * kvn[c + 1];
      float* of = isP ? p.out + OO_CKVP + ((size_t)(l * 4 + b) * 4096 + t) * 128 : p.out + OO_CKVS + ((size_t)(l * 32 + b) * 64 + t) * 128;
      *(float2*)(of + c) = make_float2(v0, v1);
      u16* kr = isP ? KP + ((size_t)b * 4096 + t) * 160 : KS + ((size_t)b * 2112 + 2048 + t) * 160;
      *(unsigned*)(kr + c) = pack2(v0, v1);
      *(unsigned*)(sv + rl * 128 + c) = pack2(v0, v1);
      if (lane < 16) {
        float x1 = bf2f(pr[384 + lane]), x2 = bf2f(pr[400 + lane]);
        float2 cs = RT[pos * 16 + lane];
        float o1 = x1 * cs.x - x2 * cs.y, o2 = x1 * cs.y + x2 * cs.x;
        float* okr = isP ? p.out + OO_KRP + ((size_t)(l * 4 + b) * 4096 + t) * 32 : p.out + OO_KRS + ((size_t)(l * 32 + b) * 64 + t) * 32;
        okr[lane] = o1; okr[lane + 16] = o2;
        kr[128 + lane] = f2bf(o1); kr[144 + lane] = f2bf(o2);
      }
    }
    {
      const u16* pb = pr + 416;
      const u16* pp = pr - DINP + 416;
      const float* sh0 = p.in[I_SSH] + (size_t)(l * 32 + b) * DSH;
      const bool last = (t == tlen - 1);
      float* osh = isP ? p.out + OO_SHP + (size_t)(l * 4 + b) * DSH : p.out + OO_SHS + (size_t)(l * 32 + b) * DSH;
#pragma unroll
      for (int it = 0; it < 4; ++it) {
        const int c = it * 64 + lane;
        if (c < 224) {
          const int e = c * 8;
          uint4 w = *(const uint4*)(pb + e);
          float pv[8] = {bf2f(w.x & 0xffff), bf2f(w.x >> 16), bf2f(w.y & 0xffff), bf2f(w.y >> 16), bf2f(w.z & 0xffff), bf2f(w.z >> 16), bf2f(w.w & 0xffff), bf2f(w.w >> 16)};
          float pq[8];
          if (t > 0) {
            uint4 q = *(const uint4*)(pp + e);
            pq[0] = bf2f(q.x & 0xffff); pq[1] = bf2f(q.x >> 16); pq[2] = bf2f(q.y & 0xffff); pq[3] = bf2f(q.y >> 16);
            pq[4] = bf2f(q.z & 0xffff); pq[5] = bf2f(q.z >> 16); pq[6] = bf2f(q.w & 0xffff); pq[7] = bf2f(q.w >> 16);
          } else if (!isP) {
            float4 q0 = *(const float4*)(sh0 + e), q1 = *(const float4*)(sh0 + e + 4);
            pq[0] = q0.x; pq[1] = q0.y; pq[2] = q0.z; pq[3] = q0.w; pq[4] = q1.x; pq[5] = q1.y; pq[6] = q1.z; pq[7] = q1.w;
          } else {
#pragma unroll
            for (int j = 0; j < 8; ++j) pq[j] = 0.f;
          }
          float4 m0 = *(const float4*)(mu + e), m1 = *(const float4*)(mu + e + 4);
          float mm[8] = {m0.x, m0.y, m0.z, m0.w, m1.x, m1.y, m1.z, m1.w};
          float xs[8];
#pragma unroll
          for (int j = 0; j < 8; ++j) xs[j] = pv[j] + mm[j] * (pq[j] - pv[j]);
          if (last) { *(float4*)(osh + e) = make_float4(pv[0], pv[1], pv[2], pv[3]); *(float4*)(osh + e + 4) = make_float4(pv[4], pv[5], pv[6], pv[7]); }
          if (it == 0) {
            float* o = RB + (size_t)g * 512 + e;
            *(float4*)o = make_float4(xs[0], xs[1], xs[2], xs[3]); *(float4*)(o + 4) = make_float4(xs[4], xs[5], xs[6], xs[7]);
          } else if (it == 1) {
            const int cc = e - 512;
            float* o = KB + (size_t)g * 512 + cc;
            *(float4*)o = make_float4(xs[0], xs[1], xs[2], xs[3]); *(float4*)(o + 4) = make_float4(xs[4], xs[5], xs[6], xs[7]);
            float4 k0 = *(const float4*)(kkw + cc), k1 = *(const float4*)(kkw + cc + 4);
            float kk[8] = {xs[0] * k0.x, xs[1] * k0.y, xs[2] * k0.z, xs[3] * k0.w, xs[4] * k1.x, xs[5] * k1.y, xs[6] * k1.z, xs[7] * k1.w};
            float ss = 0.f;
#pragma unroll
            for (int j = 0; j < 8; ++j) ss += kk[j] * kk[j];
            ss = dpp_sum8(ss);
            float rn = rsqrtf(ss + 1e-12f);
            float* o2 = KKB + (size_t)g * 512 + cc;
            *(float4*)o2 = make_float4(kk[0] * rn, kk[1] * rn, kk[2] * rn, kk[3] * rn); *(float4*)(o2 + 4) = make_float4(kk[4] * rn, kk[5] * rn, kk[6] * rn, kk[7] * rn);
          } else if (it == 2) {
            float* o = VB + (size_t)g * 512 + (e - 1024);
            *(float4*)o = make_float4(xs[0], xs[1], xs[2], xs[3]); *(float4*)(o + 4) = make_float4(xs[4], xs[5], xs[6], xs[7]);
          } else {
            const int cc = e - 1536;
            float y[8];
#pragma unroll
            for (int j = 0; j < 8; ++j) y[j] = cc < 64 ? (1.f - 2.f / (1.f + __expf(2.f * xs[j]))) : (cc < 128 ? xs[j] : sigmoidf_(xs[j]));
            uint4 o; o.x = pack2(y[0], y[1]); o.y = pack2(y[2], y[3]); o.z = pack2(y[4], y[5]); o.w = pack2(y[6], y[7]);
            *(uint4*)(A2 + (size_t)g * 256 + cc) = o;
          }
        }
      }
    }
  }
  __syncthreads();
  for (int idx = tid; idx < 128 * 9; idx += NTHR) {
    const int d = idx & 127, rl0 = (idx >> 7) * 8, g = chunk * 72 + rl0;
    unsigned w[4];
#pragma unroll
    for (int j = 0; j < 4; ++j) w[j] = (unsigned)sv[(rl0 + 2 * j) * 128 + d] | ((unsigned)sv[(rl0 + 2 * j + 1) * 128 + d] << 16);
    u16* dst;
    if (g < TP) dst = VTP + ((size_t)(g >> 12) * 128 + d) * 4096 + (g & 4095);
    else { const int gg = g - TP; dst = VTS + ((size_t)(gg >> 6) * 128 + d) * 2112 + 2048 + (gg & 63); }
    *(uint4*)dst = make_uint4(w[0], w[1], w[2], w[3]);
  }
  }
}

__device__ __forceinline__ void conv_caches(KPR p, int l, int vb, int nvb) {
  const int tid = tidx();
  u16* KS = (u16*)(p.ws + W_KS); u16* VTS = (u16*)(p.ws + W_VTS);
  {
    const float* cckv = p.in[I_CCKV] + (size_t)l * 32 * 2048 * 128;
    const float* ckr = p.in[I_CKR] + (size_t)l * 32 * 2048 * 32;
    for (int idx = vb * NTHR + tid; idx < 32 * 2048 * 20; idx += nvb * NTHR) {
      int rowi = idx / 20, ch = idx % 20;
      int b = rowi >> 11, t = rowi & 2047;
      const float* s = ch < 16 ? cckv + (size_t)rowi * 128 + ch * 8 : ckr + (size_t)rowi * 32 + (ch - 16) * 8;
      float4 a = *(const float4*)s, c = *(const float4*)(s + 4);
      uint4 o; o.x = pack2(a.x, a.y); o.y = pack2(a.z, a.w); o.z = pack2(c.x, c.y); o.w = pack2(c.z, c.w);
      *(uint4*)(KS + ((size_t)b * 2112 + t) * 160 + ch * 8) = o;
    }
    tconv_v(VTS, 2112, 4096, 2048, vb, nvb, [=](int k, int n) { return cckv[((size_t)(n >> 7) * 2048 + k) * 128 + (n & 127)]; });
    const float* cmk = p.in[I_CMK] + (size_t)l * 32 * 256 * 1024;
    const float* cmv = p.in[I_CMV] + (size_t)l * 32 * 256 * 1024;
    u16* MKS = (u16*)(p.ws + W_MKS); u16* MVTS = (u16*)(p.ws + W_MVTS);
    for (int idx = vb * NTHR + tid; idx < 32 * 4 * 256 * 32; idx += nvb * NTHR) {
      int d8 = idx & 31, m = (idx >> 5) & 255, h = (idx >> 13) & 3, b = idx >> 15;
      const float* s = cmk + ((size_t)(b * 256 + m) * 4 + h) * 256 + d8 * 8;
      float4 a = *(const float4*)s, c = *(const float4*)(s + 4);
      uint4 o; o.x = pack2(a.x, a.y); o.y = pack2(a.z, a.w); o.z = pack2(c.x, c.y); o.w = pack2(c.z, c.w);
      *(uint4*)(MKS + (size_t)idx * 8) = o;
    }
    tconv_v(MVTS, 256, 32768, 256, vb, nvb, [=](int k, int n) { return cmv[((size_t)((n >> 10) * 256 + k) * 4 + ((n >> 8) & 3)) * 256 + (n & 255)]; });
  }
}

__device__ __forceinline__ void mla_sub(KPR p, int b, int c, int half) {
  const u16* QB = (const u16*)(p.ws + W_QB); u16* AO = (u16*)(p.ws + W_AO);
  size_t tok = (size_t)b * 4096 + c * 64 + half * 32;
  attn_item<160, 128, 8>(QB + tok * 1280, 160, 256, (const u16*)(p.ws + W_KP) + (size_t)b * 4096 * 160, 160,
                         (const u16*)(p.ws + W_VTP) + (size_t)b * 128 * 4096, 4096, (c + 1) * 64, AO + tok * 1536, 1536);
}
__device__ __forceinline__ void phase_mix(KPR p, int l, int mode = 0) {
  extern __shared__ __attribute__((aligned(16))) char smem[];
  int* sItem = (int*)(smem + SMEM_ITEM);
  int* cnt = (int*)(p.ws + W_CNT) + l + mode * 8;
  for (;;) {
    __syncthreads();
    if (threadIdx.x == 0) *sItem = atomicAdd(cnt, 1);
    __syncthreads();
    int it = *sItem;
    if (it >= 864) break;
    if (mode == 2 && (it < 32 || it >= 608)) continue;
    if (it < 32) {
      int b = it >> 3, h = it & 7;
      cseq_item(p, b * 4096, h, 64, (b * 8 + h) * 64, nullptr, p.out + OO_WKVP + ((size_t)(l * 4 + b) * 8 + h) * 4096);
    } else if (it < 608) {
      int k = it - 32;
      if (k >= 248 && k < 312) {
        int j = k - 248; int b = j >> 1, half = j & 1;
        const u16* QB = (const u16*)(p.ws + W_QB); u16* AO = (u16*)(p.ws + W_AO);
        size_t tok = (size_t)TP + b * 64 + half * 32;
        attn_item<160, 128, 8>(QB + tok * 1280, 160, 256, (const u16*)(p.ws + W_KS) + (size_t)b * 2112 * 160, 160,
                               (const u16*)(p.ws + W_VTS) + (size_t)b * 128 * 2112, 2112, 2112, AO + tok * 1536, 1536);
      } else {
        if (k >= 312) k -= 64;
        int c = 63 - (k >> 3), b = (k >> 1) & 3, half = k & 1;
        mla_sub(p, b, c, half);
      }
    } else {
      int k = it - 608; int b = k >> 3, h = k & 7;
      cseq_item(p, TP + b * 64, h, 1, 2048 + k, p.in[I_SWKV] + ((size_t)(l * 32 + b) * 8 + h) * 4096,
                p.out + OO_WKVS + ((size_t)(l * 32 + b) * 8 + h) * 4096);
    }
  }
}

__device__ __forceinline__ void xattn_item(KPR p, int l, int it) {
  const u16* QX = (const u16*)(p.ws + W_QX); u16* XO = (u16*)(p.ws + W_XO);
  if (it < 256) {
    int b = it >> 6, h = (it >> 4) & 3, qt = it & 15;
    size_t tok = (size_t)b * 4096 + qt * 256;
    for (int hv = 0; hv < 2; ++hv)
      attn_item<256, 128, 1>(QX + tok * 1024 + h * 256, 1024, 256, (const u16*)(p.ws + W_MKP) + (size_t)((l * 4 + b) * 4 + h) * 65536, 256,
                             (const u16*)(p.ws + W_MVTP) + (size_t)((l * 4 + b) * 4 + h) * 65536 + hv * 128 * 256, 256, 256, XO + tok * 1024 + h * 256 + hv * 128, 1024);
  } else {
    int k = it - 256; int b = k >> 2, h = k & 3;
    size_t tok = (size_t)TP + b * 64;
    for (int hv = 0; hv < 2; ++hv)
      attn_item<256, 128, 1>(QX + tok * 1024 + h * 256, 1024, 64, (const u16*)(p.ws + W_MKS) + (size_t)(b * 4 + h) * 65536, 256,
                             (const u16*)(p.ws + W_MVTS) + (size_t)(b * 4 + h) * 65536 + hv * 128 * 256, 256, 256, XO + tok * 1024 + h * 256 + hv * 128, 1024);
  }
}

constexpr int CH_NST = 10;
__device__ __forceinline__ void phase_chain(KPR p, int ci, int dup = 0) {
  extern __shared__ __attribute__((aligned(16))) char smem[];
  int* sItem = (int*)(smem + SMEM_ITEM);
  int* CT = (int*)(p.ws + W_CNT) + dup * 8192;
  const float rc = dup ? 0.f : 1.f;
  int* q = CT + 3800 + ci; int* xa = CT + 72 + ci; int* oa = CT + 80 + ci;
  int* cnt = CT + 128 + ci * CH_NST * 72;
  int* stamp = CT + 4096 + ci * CH_NST * 72;
  int* G = CT + 8000 + ci; int* xast = CT + 8010 + ci; int* oast = CT + 8020 + ci;
  int lastG = 0;
  const bool hasTail = ci >= 1, hasHead = ci < NL;
  const int lt = ci - 1, lh = ci;
  const int e0 = hasTail ? 288 : 0, e1 = e0 + (hasTail ? 288 : 0), e2 = e1 + (hasTail ? 384 : 0), e3 = e2 + (hasTail ? 288 : 0),
            e4 = e3 + (hasTail ? 1584 : 0), e5 = e4 + (hasTail ? 288 : 0), e6 = e5 + (hasHead ? 1584 : 0), e7 = e6 + (hasHead ? 288 : 0),
            e8 = e7 + (hasHead ? 224 : 0), e9 = e8 + (hasHead ? 648 : 0);
  float* X = (float*)(p.ws + W_X); u16* XB = (u16*)(p.ws + W_XB); float* SSQ = (float*)(p.ws + W_SSQ); u16* ACT = (u16*)(p.ws + W_ACT);
  const int grp = blockIdx.x & 7;
  int nxt = 0;
  if (tidx() == 0) nxt = atomicAdd(q + grp * 8, 1) * 8 + grp;
  for (;;) {
    const int tid = tidx();
    if (tid == 0) {
      const int it = nxt;
      if (it < e9) {
        int st, idx;
        if (it < e0) { st = 0; idx = it; } else if (it < e1) { st = 1; idx = it - e0; } else if (it < e2) { st = 2; idx = it - e1; }
        else if (it < e3) { st = 3; idx = it - e2; } else if (it < e4) { st = 4; idx = it - e3; } else if (it < e5) { st = 5; idx = it - e4; }
        else if (it < e6) { st = 6; idx = it - e5; } else if (it < e7) { st = 7; idx = it - e6; } else if (it < e8) { st = 8; idx = it - e7; }
        else { st = 9; idx = it - e8; }
        int pm = 0, pn = 0;
        if (st == 2) pm = idx < 256 ? ((idx >> 6) * 16 + (idx & 15)) : (64 + ((idx - 256) >> 4));
        else if (st != 8) tile_map(idx, 72, (st == 4 || st == 6) ? 22 : (st == 9 ? 9 : 4), pm, pn);
        const int* c1 = nullptr; const int* c2 = nullptr;
        switch (st) {
          case 1: c1 = stamp + 0 * 72 + pm; break;
          case 2: c1 = stamp + 1 * 72 + pm; break;
          case 3: c1 = stamp + 2 * 72 + pm; break;
          case 4: c1 = stamp + 3 * 72 + pm; c2 = xast; break;
          case 5: c1 = stamp + 4 * 72 + pm; break;
          case 6: if (hasTail) c1 = stamp + 5 * 72 + pm; break;
          case 7: c1 = stamp + 6 * 72 + pm; break;
          case 8: if (hasTail) c1 = xast; break;
          case 9: c1 = stamp + 7 * 72 + pm; if (hasTail) c2 = oast; break;
          default: break;
        }
        if (dup) { c1 = nullptr; c2 = nullptr; }
        int s1 = 0, s2 = 0;
        if (c1) while ((s1 = __hip_atomic_load(c1, __ATOMIC_RELAXED, __HIP_MEMORY_SCOPE_AGENT)) == 0) __builtin_amdgcn_s_sleep(4);
        if (c2) while ((s2 = __hip_atomic_load(c2, __ATOMIC_RELAXED, __HIP_MEMORY_SCOPE_AGENT)) == 0) __builtin_amdgcn_s_sleep(4);
        if ((s1 > s2 ? s1 : s2) >= lastG) {
          const int g = __hip_atomic_load(G, __ATOMIC_RELAXED, __HIP_MEMORY_SCOPE_AGENT);
          __builtin_amdgcn_fence(__ATOMIC_ACQUIRE, "agent");
          asm volatile("s_waitcnt vmcnt(0)" ::: "memory");
          lastG = g;
        }
        sItem[1] = st; sItem[2] = idx; sItem[3] = pm; sItem[4] = pn;
      }
      sItem[0] = it;
    }
    __syncthreads();
    if (sItem[0] >= e9) break;
    const int st = sItem[1], idx = sItem[2], pm = sItem[3], pn = sItem[4];
    if (tid == 0) nxt = atomicAdd(q + grp * 8, 1) * 8 + grp;
    if (dup && !((PROBE_MASK >> st) & 1)) { __syncthreads(); continue; }
    const u16* WTt = (const u16*)(p.ws + W_WT) + (size_t)(lt < 0 ? 0 : lt) * WE_LAYER;
    const u16* WTh = (const u16*)(p.ws + W_WT) + (size_t)(lh >= NL ? 0 : lh) * WE_LAYER;
    switch (st) {
      case 0: gemm_tile((const u16*)(p.ws + W_AO), WTt + WE_OUT, 1536, pm, pn, EpiRes{X, XB, SSQ, rc}); break;
      case 1: gemm_tile(XB, WTt + WE_MQ, 1024, pm, pn, EpiScaleBf{SSQ, (u16*)(p.ws + W_QX), 1024}); break;
      case 2: xattn_item(p, lt, idx); break;
      case 3: gemm_tile((const u16*)(p.ws + W_XO), WTt + WE_MO, 1024, pm, pn, EpiRes{X, XB, SSQ, rc}); break;
      case 4: gemm_tile(XB, WTt + WE_GU2, 1024, pm, pn, EpiGU{SSQ, ACT}); break;
      case 5: gemm_tile(ACT, WTt + WE_D2, DFF, pm, pn, EpiRes{X, XB, SSQ, 0.5f * rc}); break;
      case 6: gemm_tile(XB, WTh + WE_GU1, 1024, pm, pn, EpiGU{SSQ, ACT}); break;
      case 7: gemm_tile(ACT, WTh + WE_D1, DFF, pm, pn, EpiRes{X, XB, SSQ, 0.5f * rc}); break;
      case 8: conv_caches(p, lh, idx, 224); break;
      default: gemm_tile(XB, WTh + WE_IN, 1024, pm, pn, EpiScaleBf{SSQ, (u16*)(p.ws + W_PROJ), DINP}); break;
    }
    asm volatile("s_waitcnt vmcnt(0)" ::: "memory");
    __syncthreads();
    if (tidx() == 64) {
      __builtin_amdgcn_fence(__ATOMIC_RELEASE, "agent");
      asm volatile("s_waitcnt vmcnt(0)" ::: "memory");
      atomicAdd(G, 1);
      const int full = (st == 4 || st == 6) ? 22 : (st == 9 ? 9 : (st == 2 ? (pm < 64 ? 4 : 16) : 4));
      if (atomicAdd(cnt + st * 72 + pm, 1) + 1 == full)
        __hip_atomic_store(stamp + st * 72 + pm, __hip_atomic_load(G, __ATOMIC_RELAXED, __HIP_MEMORY_SCOPE_AGENT), __ATOMIC_RELAXED, __HIP_MEMORY_SCOPE_AGENT);
      if (st == 2 && atomicAdd(xa, 1) + 1 == 384)
        __hip_atomic_store(xast, __hip_atomic_load(G, __ATOMIC_RELAXED, __HIP_MEMORY_SCOPE_AGENT), __ATOMIC_RELAXED, __HIP_MEMORY_SCOPE_AGENT);
      if (st == 0 && atomicAdd(oa, 1) + 1 == 288)
        __hip_atomic_store(oast, __hip_atomic_load(G, __ATOMIC_RELAXED, __HIP_MEMORY_SCOPE_AGENT), __ATOMIC_RELAXED, __HIP_MEMORY_SCOPE_AGENT);
    }
  }
}

__device__ __forceinline__ void phase_final(KPR p) {
  const int tid = tidx(), wid = tid >> 6, lane = tid & 63;
  const float* X = (const float*)(p.ws + W_X); const float* fn = p.in[I_FN];
  for (int g = blockIdx.x * 8 + wid; g < T; g += gridDim.x * 8) {
    float4 v[4]; float ss = 0.f;
#pragma unroll
    for (int i = 0; i < 4; ++i) { v[i] = *(const float4*)(X + (size_t)g * 1024 + i * 256 + lane * 4); ss += v[i].x * v[i].x + v[i].y * v[i].y + v[i].z * v[i].z + v[i].w * v[i].w; }
    ss = wave_sum(ss);
    float rs = rsqrtf(ss * (1.f / 1024.f) + 1e-6f);
#pragma unroll
    for (int i = 0; i < 4; ++i) {
      float4 gn = *(const float4*)(fn + i * 256 + lane * 4);
      *(float4*)(p.out + OO_Y + (size_t)g * 1024 + i * 256 + lane * 4) = make_float4(v[i].x * rs * gn.x, v[i].y * rs * gn.y, v[i].z * rs * gn.z, v[i].w * rs * gn.w);
    }
  }
}

constexpr int NPL = 6;
constexpr int N_PHASES = 3 + NPL * NL + 1;

__device__ __forceinline__ void run_phase(KPR p, int ph) {
  if (ph == 0) { phase_init(p); return; }
  if (ph == 1) {
    for (int l = 0; l < NL; ++l) {
      const u16* WT = (const u16*)(p.ws + W_WT) + (size_t)l * WE_LAYER;
      gemm_phase((const u16*)(p.ws + W_MB), WT + WE_MK, 1024, 4, 4, (2 * l) * 16,
                 EpiMem<false>{p.out + OO_MKP + (size_t)l * 1048576, (u16*)(p.ws + W_MKP) + (size_t)l * 16 * 65536});
      gemm_phase((const u16*)(p.ws + W_MB), WT + WE_MV, 1024, 4, 4, (2 * l + 1) * 16,
                 EpiMem<true>{p.out + OO_MVP + (size_t)l * 1048576, (u16*)(p.ws + W_MVTP) + (size_t)l * 16 * 65536});
    }
    return;
  }
  if (ph == 2) { phase_chain(p, 0); if (PROBE_REP & 1) { cg::this_grid().sync(); phase_chain(p, 0, 1); } return; }
  if (ph == N_PHASES - 1) { if (PROBE_REP & 64) for (int i = 0; i < 40; ++i) cg::this_grid().sync(); phase_final(p); return; }
  const int l = (ph - 3) / NPL, s = (ph - 3) % NPL;
  const u16* WT = (const u16*)(p.ws + W_WT) + (size_t)l * WE_LAYER;
  switch (s) {
    case 0: phase_prep(p, l); if (PROBE_REP & 2) { cg::this_grid().sync(); phase_prep(p, l); } break;
    case 1:
      gemm_phase((const u16*)(p.ws + W_CQB), WT + WE_Q, 256, 72, 5, 0, EpiQ{(u16*)(p.ws + W_QB), (const float2*)(p.ws + W_ROPE)});
      gemm_phase((const u16*)(p.ws + W_A2), WT + WE_RW, 256, 72, 6, 360,
                 EpiRW{p.in[I_W0] + l * 512, p.in[I_A0] + l * 512, p.in[I_KA] + l * 512, p.ws});
      break;
    case 2: phase_cprep(p); if (PROBE_REP & 8) { cg::this_grid().sync(); phase_cprep(p); } break;
    case 3: phase_mix(p, l, 0); if (PROBE_REP & 16) { cg::this_grid().sync(); phase_mix(p, l, 2); } break;
    case 4: phase_yfin(p, l); if (PROBE_REP & 32) { cg::this_grid().sync(); phase_yfin(p, l); } break;
    default: phase_chain(p, l + 1); if (PROBE_REP & 1) { cg::this_grid().sync(); phase_chain(p, l + 1, 1); } break;
  }
}

__device__ __forceinline__ void grid_barrier(int* CT, int gen) {
  asm volatile("s_waitcnt vmcnt(0)" ::: "memory");
  __syncthreads();
  if (tidx() == 0) {
    __builtin_amdgcn_fence(__ATOMIC_RELEASE, "agent");
    asm volatile("s_waitcnt vmcnt(0)" ::: "memory");
    int* grpc = CT + 15000 + (blockIdx.x & 7) * 32;
    int* glob = CT + 15000 + 8 * 32;
    const int per = gridDim.x >> 3;
    if (atomicAdd(grpc, 1) + 1 == per * (gen + 1)) atomicAdd(glob, 1);
    while (__hip_atomic_load(glob, __ATOMIC_RELAXED, __HIP_MEMORY_SCOPE_AGENT) < 8 * (gen + 1)) __builtin_amdgcn_s_sleep(1);
    __builtin_amdgcn_fence(__ATOMIC_ACQUIRE, "agent");
    asm volatile("s_waitcnt vmcnt(0)" ::: "memory");
  }
  __syncthreads();
}

__global__ void __launch_bounds__(NTHR) mega(Params p) {
  cg::grid_group grid = cg::this_grid();
  for (int ph = p.ph_lo; ph < p.ph_hi; ++ph) {
    const __attribute__((address_space(4))) Params* q = (const __attribute__((address_space(4))) Params*)__builtin_amdgcn_kernarg_segment_ptr();
    asm volatile("" : "+s"(q));
    run_phase(*q, ph);
    if (ph + 1 < p.ph_hi) {
      if (ph == p.ph_lo) grid.sync();
      else grid_barrier((int*)(q->ws + W_CNT), ph - p.ph_lo - 1);
    }
  }
}

extern "C" void kernel_launch(void* const* d_in, const int* in_sizes, int n_in, void* d_out, int out_size, void* d_ws,
                              size_t ws_size, hipStream_t stream) {
  static int grid = 0;
  if (grid == 0) {
    if (n_in != N_IN || (size_t)out_size != OO_END || ws_size < W_END) {
      fprintf(stderr, "kernel_launch: unexpected shapes n_in=%d out=%d ws=%zu (need %zu)\n", n_in, out_size, ws_size, (size_t)W_END);
      grid = -1; return;
    }
    int dev = 0, cus = 0, per_cu = 0;
    hipGetDevice(&dev);
    hipDeviceGetAttribute(&cus, hipDeviceAttributeMultiprocessorCount, dev);
    hipFuncSetAttribute((const void*)mega, hipFuncAttributeMaxDynamicSharedMemorySize, SMEM_BYTES);
    hipOccupancyMaxActiveBlocksPerMultiprocessor(&per_cu, (const void*)mega, NTHR, SMEM_BYTES);
    if (per_cu < 1) { fprintf(stderr, "kernel_launch: occupancy query says %d blocks/CU\n", per_cu); per_cu = 1; }
    (void)hipGetLastError();
    grid = cus;
  }
  if (grid < 0) return;
  if (hipMemsetAsync((char*)d_ws + W_CNT, 0, 65536, stream) != hipSuccess) { fprintf(stderr, "kernel_launch: memset of control words failed\n"); return; }
  Params p{};
  for (int i = 0; i < N_IN; ++i) p.in[i] = (const float*)d_in[i];
  p.out = (float*)d_out; p.ws = (char*)d_ws;
#if N_LAUNCH_PER_PHASE
  for (int ph = 0; ph < N_PHASES; ++ph) {
    p.ph_lo = ph; p.ph_hi = ph + 1;
    void* args[] = {&p};
    hipError_t e = hipLaunchCooperativeKernel((const void*)mega, dim3(grid), dim3(NTHR), args, SMEM_BYTES, stream);
    if (e != hipSuccess) { fprintf(stderr, "launch failed: %s\n", hipGetErrorString(e)); break; }
  }
#else
  p.ph_lo = 0; p.ph_hi = N_PHASES;
  void* args[] = {&p};
  hipError_t e = hipLaunchCooperativeKernel((const void*)mega, dim3(grid), dim3(NTHR), args, SMEM_BYTES, stream);
  if (e != hipSuccess) fprintf(stderr, "cooperative launch failed: %s (grid %d)\n", hipGetErrorString(e), grid);
#endif
}
```

```cpp
#include <hip/hip_runtime.h>
#include <hip/hip_cooperative_groups.h>
#include <stdint.h>
#include <stdio.h>
namespace cg = cooperative_groups;

typedef unsigned short u16;
using bf16x8 = __attribute__((ext_vector_type(8))) short;
using f32x4 = __attribute__((ext_vector_type(4))) float;
using f32x16 = __attribute__((ext_vector_type(16))) float;

#ifndef REP_WHICH
#define REP_WHICH 0
#endif
#ifndef PROBE_REP
#define PROBE_REP 0
#endif
#ifndef PROBE_MASK
#define PROBE_MASK 0x3ff
#endif
#ifndef N_LAUNCH_PER_PHASE
#define N_LAUNCH_PER_PHASE 0
#endif

constexpr int TP = 16384, TS = 2048, T = TP + TS, NL = 4;
constexpr int DFF = 2816, DIN = 2208, DINP = 2304, DSH = 1792;
constexpr int NTHR = 512;
constexpr int SMEM_BYTES = 139264 + 2048;
constexpr int SMEM_ITEM = 139264 + 1024;
constexpr float QSCALE = 0.10206207261596577f * 1.4426950408889634f;
constexpr float XSCALE = 0.0625f * 1.4426950408889634f;

constexpr size_t OO_Y = 0;
constexpr size_t OO_CKVP = OO_Y + (size_t)T * 1024;
constexpr size_t OO_KRP = OO_CKVP + (size_t)NL * 4 * 4096 * 128;
constexpr size_t OO_MKP = OO_KRP + (size_t)NL * 4 * 4096 * 32;
constexpr size_t OO_MVP = OO_MKP + (size_t)NL * 4 * 256 * 1024;
constexpr size_t OO_WKVP = OO_MVP + (size_t)NL * 4 * 256 * 1024;
constexpr size_t OO_SHP = OO_WKVP + (size_t)NL * 4 * 8 * 4096;
constexpr size_t OO_CKVS = OO_SHP + (size_t)NL * 4 * DSH;
constexpr size_t OO_KRS = OO_CKVS + (size_t)NL * 32 * 64 * 128;
constexpr size_t OO_WKVS = OO_KRS + (size_t)NL * 32 * 64 * 32;
constexpr size_t OO_SHS = OO_WKVS + (size_t)NL * 32 * 8 * 4096;
constexpr size_t OO_END = OO_SHS + (size_t)NL * 32 * DSH;

constexpr size_t al256(size_t x) { return (x + 255) & ~(size_t)255; }
constexpr size_t W_X = 0;
constexpr size_t W_XB = W_X + al256((size_t)T * 1024 * 4);
constexpr size_t W_SSQ = W_XB + al256((size_t)T * 1024 * 2);
constexpr size_t W_ACT = W_SSQ + al256((size_t)T * 4 * 4);
constexpr size_t W_WB = W_ACT;
constexpr size_t W_BB = W_WB + al256((size_t)T * 512 * 4);
constexpr size_t W_GB = W_BB + al256((size_t)T * 512 * 4);
constexpr size_t W_QX = W_ACT;
constexpr size_t W_PROJ = W_ACT + al256((size_t)T * DFF * 2);
constexpr size_t W_AO = W_PROJ;
constexpr size_t W_CQB = W_PROJ + al256((size_t)T * DINP * 2);
constexpr size_t W_A2 = W_CQB + al256((size_t)T * 256 * 2);
constexpr size_t W_QB = W_A2 + al256((size_t)T * 256 * 2);
constexpr size_t W_XO = W_QB;
constexpr size_t W_RB = W_QB + al256((size_t)T * 1280 * 2);
constexpr size_t W_KB = W_RB + al256((size_t)T * 512 * 4);
constexpr size_t W_VB = W_KB + al256((size_t)T * 512 * 4);
constexpr size_t W_KKB = W_VB + al256((size_t)T * 512 * 4);
constexpr size_t W_KP = W_KKB + al256((size_t)T * 512 * 4);
constexpr size_t W_KS = W_KP + al256((size_t)4 * 4096 * 160 * 2);
constexpr size_t W_VTP = W_KS + al256((size_t)32 * 2112 * 160 * 2);
constexpr size_t W_VTS = W_VTP + al256((size_t)4 * 128 * 4096 * 2);
constexpr size_t W_MKP = W_VTS + al256((size_t)32 * 128 * 2112 * 2);
constexpr size_t W_MVTP = W_MKP + al256((size_t)NL * 16 * 65536 * 2);
constexpr size_t W_MKS = W_MVTP + al256((size_t)NL * 16 * 65536 * 2);
constexpr size_t W_MVTS = W_MKS + al256((size_t)128 * 65536 * 2);
constexpr size_t W_MB = W_MVTS + al256((size_t)128 * 65536 * 2);
constexpr size_t W_ROPE = W_MB + al256((size_t)1024 * 1024 * 2);
constexpr size_t W_CNT = W_ROPE + al256((size_t)4096 * 16 * 8);
constexpr size_t W_YB = W_CNT + 65536;
constexpr size_t W_CQ = W_YB + al256((size_t)T * 512 * 4);
constexpr size_t W_WT = W_CQ + al256((size_t)2304 * 4096 * 4);
constexpr size_t W_CRR = W_PROJ + al256((size_t)T * 1536 * 2);
constexpr size_t W_CPT = W_CQB;
static_assert(W_CRR + (size_t)2304 * 4096 * 2 <= W_CQB, "RRt must fit behind AO");
static_assert((size_t)2304 * 4096 * 2 <= 2 * al256((size_t)T * 256 * 2), "Pt must fit in CQB+A2");
constexpr size_t WE_GU1 = 0;
constexpr size_t WE_D1 = WE_GU1 + (size_t)5632 * 1024;
constexpr size_t WE_IN = WE_D1 + (size_t)1024 * DFF;
constexpr size_t WE_Q = WE_IN + (size_t)DINP * 1024;
constexpr size_t WE_RW = WE_Q + (size_t)1280 * 256;
constexpr size_t WE_OUT = WE_RW + (size_t)1536 * 256;
constexpr size_t WE_MQ = WE_OUT + (size_t)1024 * 1536;
constexpr size_t WE_MK = WE_MQ + (size_t)1024 * 1024;
constexpr size_t WE_MV = WE_MK + (size_t)1024 * 1024;
constexpr size_t WE_MO = WE_MV + (size_t)1024 * 1024;
constexpr size_t WE_GU2 = WE_MO + (size_t)1024 * 1024;
constexpr size_t WE_D2 = WE_GU2 + (size_t)5632 * 1024;
constexpr size_t WE_LAYER = WE_D2 + (size_t)1024 * DFF;
constexpr size_t W_END = W_WT + al256(WE_LAYER * NL * 2);

enum { I_XP = 0, I_XS, I_MEMP, I_CCKV, I_CKR, I_CMK, I_CMV, I_SWKV, I_SSH, I_F1N, I_F1G, I_F1U, I_F1D, I_MIXN, I_WIN,
       I_QN, I_WUQ, I_KVN, I_WUK, I_WUV, I_MU, I_W0, I_WUP, I_A0, I_AUP, I_GUP, I_KK, I_KA, I_RK, I_GNG, I_GNB, I_WOUT,
       I_XN, I_MKVN, I_WMQ, I_WMK, I_WMV, I_WMO, I_F2N, I_F2G, I_F2U, I_F2D, I_FN, N_IN };

struct Params {
  const float* in[N_IN];
  float* out;
  char* ws;
  int ph_lo, ph_hi;
};

typedef const __attribute__((address_space(4))) Params& KPR;

typedef __bf16 bf2_t __attribute__((ext_vector_type(2)));
typedef float f2_t __attribute__((ext_vector_type(2)));
__device__ __forceinline__ u16 f2bf(float f) { __bf16 b = (__bf16)f; return __builtin_bit_cast(u16, b); }
__device__ __forceinline__ float bf2f(u16 h) { return __uint_as_float(((unsigned)h) << 16); }
__device__ __forceinline__ unsigned pack2(float a, float b) { f2_t v = {a, b}; bf2_t r = __builtin_convertvector(v, bf2_t); return __builtin_bit_cast(unsigned, r); }
__device__ __forceinline__ float wave_sum(float x) {
#pragma unroll
  for (int o = 32; o; o >>= 1) x += __shfl_xor(x, o);
  return x;
}
__device__ __forceinline__ float dpp_sum8(float x) {
  x += __int_as_float(__builtin_amdgcn_update_dpp(0, __float_as_int(x), 0xB1, 0xF, 0xF, false));
  x += __int_as_float(__builtin_amdgcn_update_dpp(0, __float_as_int(x), 0x4E, 0xF, 0xF, false));
  x += __int_as_float(__builtin_amdgcn_update_dpp(0, __float_as_int(x), 0x141, 0xF, 0xF, false));
  return x;
}
__device__ __forceinline__ int tidx() { int t = threadIdx.x; asm volatile("" : "+v"(t)); return t; }
__device__ __forceinline__ float fma_s(float a, float b, float c) { float d; asm("v_fma_f32 %0, %1, %2, %3" : "=v"(d) : "v"(a), "v"(b), "v"(c)); return d; }
__device__ __forceinline__ float sub_s(float a, float b) { float d; asm("v_sub_f32 %0, %1, %2" : "=v"(d) : "v"(a), "v"(b)); return d; }
__device__ __forceinline__ float add_s(float a, float b) { float d; asm("v_add_f32 %0, %1, %2" : "=v"(d) : "v"(a), "v"(b)); return d; }
__device__ __forceinline__ float mul_s(float a, float b) { float d; asm("v_mul_f32 %0, %1, %2" : "=v"(d) : "v"(a), "v"(b)); return d; }
__device__ __forceinline__ float sigmoidf_(float x) { return 1.f / (1.f + __expf(-x)); }

constexpr int BM = 256, BK = 64, HALF = 128, HT = HALF * BK;

__device__ __forceinline__ int lds_byte(int r, int c) {
  int st = (r >> 4) * 2 + (c >> 5), rr = r & 15, cc = c & 31, ob = rr * 64 + cc * 2;
  return st * 1024 + (ob ^ (((ob >> 9) & 1) << 5));
}
__device__ __forceinline__ void stage_rc(int b, int& R, int& C) {
  int st = b / 1024, sb = b % 1024, swz = sb ^ (((sb >> 9) & 1) << 5);
  R = (st >> 1) * 16 + swz / 64; C = (st & 1) * 32 + (swz % 64) / 2;
}

__device__ __forceinline__ void tile_map(int tile, int nM, int nN, int& pm, int& pn) {
  const int ntiles = nM * nN;
  int wgid = tile;
  { int q = ntiles / 8, r = ntiles % 8, xcd = wgid % 8, off = wgid / 8;
    wgid = (xcd < r ? xcd * (q + 1) : r * (q + 1) + (xcd - r) * q) + off; }
  int nig = 8 * nN, gid = wgid / nig, fm = gid * 8, gsz = min(nM - fm, 8);
  pm = fm + ((wgid % nig) % gsz); pn = (wgid % nig) / gsz;
}

template <class Epi>
__device__ __forceinline__ void gemm_tile(const u16* __restrict__ A, const u16* __restrict__ Bt, const int K,
                                          const int pm, const int pn, Epi epi) {
  extern __shared__ __attribute__((aligned(16))) char smem[];
  u16* shm = (u16*)smem;
#define SA(b, h) (shm + ((b) * 2 + (h)) * HT)
#define SB(b, h) (shm + (4 + (b) * 2 + (h)) * HT)
#define STAGE(P, BASE, br, kt) do { const u16* _gb = BASE + ((long)(br) * K + (long)(kt) * BK); \
    __builtin_amdgcn_global_load_lds((const unsigned*)((const char*)_gb + so0), \
        (__attribute__((address_space(3))) unsigned*)((char*)(P) + wu16), 16, 0, 0); \
    __builtin_amdgcn_global_load_lds((const unsigned*)((const char*)_gb + so1), \
        (__attribute__((address_space(3))) unsigned*)((char*)(P) + wu16 + 8192), 16, 0, 0); } while (0)
#define LDA(dst, b, h) for (int m = 0; m < 4; ++m) for (int k = 0; k < 2; ++k) \
    dst[m][k] = *reinterpret_cast<const bf16x8*>((char*)SA(b, h) + lds_byte(wr * 64 + m * 16 + fr, k * 32 + fq * 8))
#define LDB(dst, b, h) for (int n = 0; n < 2; ++n) for (int k = 0; k < 2; ++k) \
    dst[n][k] = *reinterpret_cast<const bf16x8*>((char*)SB(b, h) + lds_byte(wc * 32 + n * 16 + fr, k * 32 + fq * 8))
#define MMA(ai, bj, At_, Bt_) do { __builtin_amdgcn_s_setprio(1); \
    for (int m = 0; m < 4; ++m) for (int n = 0; n < 2; ++n) for (int k = 0; k < 2; ++k) \
      acc[ai][bj][m][n] = __builtin_amdgcn_mfma_f32_16x16x32_bf16(At_[m][k], Bt_[n][k], acc[ai][bj][m][n], 0, 0, 0); \
    __builtin_amdgcn_s_setprio(0); } while (0)
#define WAIT_V(n) asm volatile("s_waitcnt vmcnt(" #n ")" ::: "memory")
#define WAIT_L(n) asm volatile("s_waitcnt lgkmcnt(" #n ")" ::: "memory")
#define BAR __builtin_amdgcn_s_barrier()
#define SCHED __builtin_amdgcn_sched_barrier(0)
  const int tid_ = tidx();
  const int wid = tid_ >> 6, lane = tid_ & 63, wr = wid >> 2, wc = wid & 3, fr = lane & 15, fq = lane >> 4;
  const int nt = K / BK;
  const int wu16 = __builtin_amdgcn_readfirstlane(tid_ >> 6) * 1024;
  {
    unsigned so0, so1;
    { int _r, _c; stage_rc(tid_ * 16, _r, _c); so0 = (unsigned)(_r * K + _c) * 2u;
      stage_rc(tid_ * 16 + 8192, _r, _c); so1 = (unsigned)(_r * K + _c) * 2u; }
    const int brow = pm * BM, bcol = pn * BM;
    f32x4 acc[2][2][4][2] = {};
    bf16x8 At[4][2], B0[2][2], B1[2][2];
    STAGE(SB(0, 0), Bt, bcol, 0); STAGE(SA(0, 0), A, brow, 0);
    STAGE(SB(0, 1), Bt, bcol + HALF, 0); STAGE(SA(0, 1), A, brow + HALF, 0);
    if (wr == 1) BAR;
    WAIT_V(4); BAR;
    STAGE(SB(1, 0), Bt, bcol, 1); STAGE(SA(1, 0), A, brow, 1); STAGE(SB(1, 1), Bt, bcol + HALF, 1);
    WAIT_V(6); BAR;
    for (int t = 0; t < nt - 2; t += 2) {
      LDB(B0, 0, 0); SCHED; LDA(At, 0, 0); STAGE(SA(1, 1), A, brow + HALF, t + 1);
      WAIT_L(8); BAR; WAIT_L(0); MMA(0, 0, At, B0); BAR; SCHED;
      LDB(B1, 0, 1); STAGE(SB(0, 0), Bt, bcol, t + 2);
      BAR; WAIT_L(0); MMA(0, 1, At, B1); BAR;
      LDA(At, 0, 1); STAGE(SA(0, 0), A, brow, t + 2);
      BAR; WAIT_L(0); MMA(1, 0, At, B0); BAR; SCHED;
      STAGE(SB(0, 1), Bt, bcol + HALF, t + 2);
      WAIT_V(6); BAR; MMA(1, 1, At, B1); BAR;
      LDB(B0, 1, 0); SCHED; LDA(At, 1, 0); STAGE(SA(0, 1), A, brow + HALF, t + 2);
      WAIT_L(8); BAR; WAIT_L(0); MMA(0, 0, At, B0); BAR; SCHED;
      LDB(B1, 1, 1); STAGE(SB(1, 0), Bt, bcol, t + 3);
      BAR; WAIT_L(0); MMA(0, 1, At, B1); BAR;
      LDA(At, 1, 1); STAGE(SA(1, 0), A, brow, t + 3);
      BAR; WAIT_L(0); MMA(1, 0, At, B0); BAR; SCHED;
      STAGE(SB(1, 1), Bt, bcol + HALF, t + 3);
      WAIT_V(6); BAR; MMA(1, 1, At, B1); BAR;
    }
    { LDB(B0, 0, 0); LDA(At, 0, 0); STAGE(SA(1, 1), A, brow + HALF, nt - 1);
      BAR; WAIT_L(0); MMA(0, 0, At, B0); BAR;
      LDB(B1, 0, 1); BAR; WAIT_L(0); MMA(0, 1, At, B1); BAR;
      LDA(At, 0, 1); WAIT_V(4); BAR; WAIT_L(0); MMA(1, 0, At, B0); MMA(1, 1, At, B1); BAR; }
    { LDB(B0, 1, 0); LDA(At, 1, 0); WAIT_V(2); BAR; WAIT_L(0); MMA(0, 0, At, B0); BAR;
      LDB(B1, 1, 1); WAIT_V(0); BAR; WAIT_L(0); MMA(0, 1, At, B1); BAR;
      LDA(At, 1, 1); BAR; WAIT_L(0); MMA(1, 0, At, B0); MMA(1, 1, At, B1); BAR; }
    if (wr == 0) BAR;
    float* stg = (float*)smem;
    int tx = tid_;
    asm volatile("" : "+v"(tx));
    const int ewr = tx >> 8, ewc = (tx >> 6) & 3, efr = tx & 15, efq = (tx >> 4) & 3;
#define EPI_HALF(ai) do { \
    __syncthreads(); \
    _Pragma("unroll") for (int bj = 0; bj < 2; ++bj) _Pragma("unroll") for (int m = 0; m < 4; ++m) \
    _Pragma("unroll") for (int n = 0; n < 2; ++n) _Pragma("unroll") for (int j = 0; j < 4; ++j) \
      stg[(ewr * 64 + m * 16 + efq * 4 + j) * 260 + bj * HALF + ewc * 32 + n * 16 + efr] = acc[ai][bj][m][n][j]; \
    __syncthreads(); \
    for (int i = 0; i < 8; ++i) { \
      int item = i * NTHR + tx; int rl = item >> 5, qp = item & 31; \
      int cl = (qp >> 2) * 32 + (qp & 3) * 4; \
      float4 v0 = *(const float4*)(stg + rl * 260 + cl), v1 = *(const float4*)(stg + rl * 260 + cl + 16); \
      int row = brow + ai * HALF + rl; \
      float ss = epi.apply4(row, bcol + cl, v0, v1); \
      if (Epi::kSsq) { \
        ss += __shfl_xor(ss, 1); ss += __shfl_xor(ss, 2); ss += __shfl_xor(ss, 4); ss += __shfl_xor(ss, 8); ss += __shfl_xor(ss, 16); \
        if (qp == 0) epi.ssq_out(row, pn, ss); \
      } \
    } } while (0)
    EPI_HALF(0);
    EPI_HALF(1);
#undef EPI_HALF
    __syncthreads();
  }
#undef SA
#undef SB
#undef STAGE
#undef LDA
#undef LDB
#undef MMA
}

template <class Epi>
__device__ __forceinline__ void gemm_phase(const u16* __restrict__ A, const u16* __restrict__ Bt, const int K,
                                           const int nM, const int nN, const int rot, Epi epi) {
  const int G = gridDim.x;
  for (int tile = (int)((blockIdx.x + G - (rot % G)) % G); tile < nM * nN; tile += G) {
    int pm, pn; tile_map(tile, nM, nN, pm, pn);
    gemm_tile(A, Bt, K, pm, pn, epi);
  }
}

__device__ __forceinline__ float rstd_from_ssq(const float* ssq, int row) {
  float4 s = *(const float4*)(ssq + (size_t)row * 4);
  return rsqrtf((s.x + s.y + s.z + s.w) * (1.f / 1024.f) + 1e-6f);
}
__device__ __forceinline__ uint2 pack4(float4 v) { uint2 w; w.x = pack2(v.x, v.y); w.y = pack2(v.z, v.w); return w; }
__device__ __forceinline__ float silu_mul(float g, float u) { return g / (1.f + __expf(-g)) * u; }
struct EpiGU {
  static constexpr bool kSsq = false;
  const float* ssq; u16* act;
  __device__ __forceinline__ float apply4(int row, int c0, float4 g, float4 u) const {
    float rs = rstd_from_ssq(ssq, row);
    float4 o = make_float4(silu_mul(g.x * rs, u.x * rs), silu_mul(g.y * rs, u.y * rs), silu_mul(g.z * rs, u.z * rs), silu_mul(g.w * rs, u.w * rs));
    *(uint2*)(act + (size_t)row * DFF + ((c0 & ~31) >> 1) + (c0 & 15)) = pack4(o);
    return 0.f;
  }
  __device__ __forceinline__ void ssq_out(int, int, float) const {}
};
struct EpiRes {
  static constexpr bool kSsq = true;
  float* x; u16* xb; float* ssq; float coef;
  __device__ __forceinline__ float apply4(int row, int c0, float4 v0, float4 v1) const {
    size_t i = (size_t)row * 1024 + c0;
    float4 a = *(const float4*)(x + i), b = *(const float4*)(x + i + 16);
    a.x += coef * v0.x; a.y += coef * v0.y; a.z += coef * v0.z; a.w += coef * v0.w;
    b.x += coef * v1.x; b.y += coef * v1.y; b.z += coef * v1.z; b.w += coef * v1.w;
    *(float4*)(x + i) = a; *(float4*)(x + i + 16) = b;
    *(uint2*)(xb + i) = pack4(a); *(uint2*)(xb + i + 16) = pack4(b);
    return a.x * a.x + a.y * a.y + a.z * a.z + a.w * a.w + b.x * b.x + b.y * b.y + b.z * b.z + b.w * b.w;
  }
  __device__ __forceinline__ void ssq_out(int row, int pn, float v) const { ssq[(size_t)row * 4 + pn] = v; }
};
struct EpiScaleBf {
  static constexpr bool kSsq = false;
  const float* ssq; u16* o; int ld;
  __device__ __forceinline__ float apply4(int row, int c0, float4 v0, float4 v1) const {
    float rs = rstd_from_ssq(ssq, row);
    size_t i = (size_t)row * ld + c0;
    *(uint2*)(o + i) = pack4(make_float4(v0.x * rs, v0.y * rs, v0.z * rs, v0.w * rs));
    *(uint2*)(o + i + 16) = pack4(make_float4(v1.x * rs, v1.y * rs, v1.z * rs, v1.w * rs));
    return 0.f;
  }
  __device__ __forceinline__ void ssq_out(int, int, float) const {}
};
struct EpiQ {
  static constexpr bool kSsq = false;
  u16* qb; const float2* rope;
  __device__ __forceinline__ float apply4(int row, int c0, float4 v0, float4 v1) const {
    if (c0 < 1024) {
      size_t i = (size_t)row * 1280 + (c0 >> 7) * 160 + (c0 & 127);
      *(uint2*)(qb + i) = pack4(v0); *(uint2*)(qb + i + 16) = pack4(v1);
    } else {
      int h = (c0 - 1024) >> 5, f0 = c0 & 15;
      int pos = row < TP ? (row & 4095) : (2048 + ((row - TP) & 63));
      const float2* cs = rope + pos * 16 + f0;
      float2 c_0 = cs[0], c_1 = cs[1], c_2 = cs[2], c_3 = cs[3];
      size_t i = (size_t)row * 1280 + h * 160 + 128 + f0;
      *(uint2*)(qb + i) = pack4(make_float4(v0.x * c_0.x - v1.x * c_0.y, v0.y * c_1.x - v1.y * c_1.y, v0.z * c_2.x - v1.z * c_2.y, v0.w * c_3.x - v1.w * c_3.y));
      *(uint2*)(qb + i + 16) = pack4(make_float4(v0.x * c_0.y + v1.x * c_0.x, v0.y * c_1.y + v1.y * c_1.x, v0.z * c_2.y + v1.z * c_2.x, v0.w * c_3.y + v1.w * c_3.x));
    }
    return 0.f;
  }
  __device__ __forceinline__ void ssq_out(int, int, float) const {}
};
__device__ __forceinline__ float decay_f(float z) {
  float nz = -z;
  float sp = fmaxf(nz, 0.f) + __logf(1.f + __expf(-fabsf(nz)));
  return __expf(-__expf(-sp - 0.5f));
}
struct EpiRW {
  static constexpr bool kSsq = false;
  const float* w0; const float* a0; const float* ka; char* ws;
  __device__ __forceinline__ void acol(size_t i, int c, float4 v) const {
    float* bb = (float*)(ws + W_BB); float* kb = (float*)(ws + W_KB); const float* kkb = (const float*)(ws + W_KKB);
    float4 a_0 = *(const float4*)(a0 + c), k_a = *(const float4*)(ka + c), kk = *(const float4*)(kkb + i), k = *(const float4*)(kb + i);
    float4 a = make_float4(sigmoidf_(a_0.x + v.x), sigmoidf_(a_0.y + v.y), sigmoidf_(a_0.z + v.z), sigmoidf_(a_0.w + v.w));
    *(float4*)(bb + i) = make_float4(kk.x * a.x, kk.y * a.y, kk.z * a.z, kk.w * a.w);
    *(float4*)(kb + i) = make_float4(k.x * (1.f + (a.x - 1.f) * k_a.x), k.y * (1.f + (a.y - 1.f) * k_a.y), k.z * (1.f + (a.z - 1.f) * k_a.z), k.w * (1.f + (a.w - 1.f) * k_a.w));
  }
  __device__ __forceinline__ float apply4(int row, int c0, float4 v0, float4 v1) const {
    if (c0 < 512) {
      float* wb = (float*)(ws + W_WB);
      float4 z0 = *(const float4*)(w0 + c0), z1 = *(const float4*)(w0 + c0 + 16);
      size_t i = (size_t)row * 512 + c0;
      *(float4*)(wb + i) = make_float4(decay_f(z0.x + v0.x), decay_f(z0.y + v0.y), decay_f(z0.z + v0.z), decay_f(z0.w + v0.w));
      *(float4*)(wb + i + 16) = make_float4(decay_f(z1.x + v1.x), decay_f(z1.y + v1.y), decay_f(z1.z + v1.z), decay_f(z1.w + v1.w));
    } else if (c0 < 1024) {
      int c = c0 - 512; size_t i = (size_t)row * 512 + c;
      acol(i, c, v0); acol(i + 16, c + 16, v1);
    } else {
      u16* gb = (u16*)(ws + W_GB);
      size_t i = (size_t)row * 512 + (c0 - 1024);
      *(uint2*)(gb + i) = pack4(v0); *(uint2*)(gb + i + 16) = pack4(v1);
    }
    return 0.f;
  }
  __device__ __forceinline__ void ssq_out(int, int, float) const {}
};
template <bool ISV>
struct EpiMem {
  static constexpr bool kSsq = false;
  float* of; u16* ob;
  __device__ __forceinline__ void quad(int row, int col, float4 v) const {
    *(float4*)(of + (size_t)row * 1024 + col) = v;
    int b = row >> 8, m = row & 255, h = col >> 8, d = col & 255;
    if (ISV) {
      u16* o = ob + (size_t)((b * 4 + h) * 256 + d) * 256 + m;
      o[0] = f2bf(v.x); o[256] = f2bf(v.y); o[512] = f2bf(v.z); o[768] = f2bf(v.w);
    } else {
      *(uint2*)(ob + (size_t)((b * 4 + h) * 256 + m) * 256 + d) = pack4(v);
    }
  }
  __device__ __forceinline__ float apply4(int row, int c0, float4 v0, float4 v1) const {
    quad(row, c0, v0); quad(row, c0 + 16, v1);
    return 0.f;
  }
  __device__ __forceinline__ void ssq_out(int, int, float) const {}
};

template <class F>
__device__ __forceinline__ void tconv(u16* dst, int ldd, int N, int K, int rot, F f) {
  extern __shared__ __attribute__((aligned(16))) char smem[];
  float* t = (float*)smem;
  const int nk = K / 64, nt = (N / 64) * nk, G = gridDim.x;
  const int tid = tidx(), a = tid >> 6, c = tid & 63;
  for (int tile = (int)((blockIdx.x + G - (rot % G)) % G); tile < nt; tile += G) {
    int n0 = (tile / nk) * 64, k0 = (tile % nk) * 64;
    __syncthreads();
#pragma unroll
    for (int i = 0; i < 8; ++i) { int kk = a + 8 * i; t[kk * 65 + c] = f(k0 + kk, n0 + c); }
    __syncthreads();
#pragma unroll
    for (int i = 0; i < 8; ++i) { int nn = a + 8 * i; dst[(size_t)(n0 + nn) * ldd + k0 + c] = f2bf(t[c * 65 + nn]); }
  }
}

template <class F>
__device__ __forceinline__ void tconv_v(u16* dst, int ldd, int N, int K, int vb, int nvb, F f) {
  extern __shared__ __attribute__((aligned(16))) char smem[];
  float* t = (float*)smem;
  const int nk = K / 64, nt = (N / 64) * nk;
  const int tid = tidx(), a = tid >> 6, c = tid & 63;
  for (int tile = vb; tile < nt; tile += nvb) {
    int n0 = (tile / nk) * 64, k0 = (tile % nk) * 64;
    __syncthreads();
#pragma unroll
    for (int i = 0; i < 8; ++i) { int kk = a + 8 * i; t[kk * 65 + c] = f(k0 + kk, n0 + c); }
    __syncthreads();
#pragma unroll
    for (int i = 0; i < 8; ++i) { int nn = a + 8 * i; dst[(size_t)(n0 + nn) * ldd + k0 + c] = f2bf(t[c * 65 + nn]); }
  }
  __syncthreads();
}

template <int DK, int DV, int RPG>
__device__ __forceinline__ void attn_item(const u16* __restrict__ Qb, int ldq, int nrows, const u16* __restrict__ Kb, int ldk,
                                          const u16* __restrict__ Vtb, int ldvt, int nkeys, u16* __restrict__ Ob, int ldo) {
  extern __shared__ __attribute__((aligned(16))) char smem[];
  constexpr int KS = DK + 8, VS = 68;
  u16* sK = (u16*)smem;
  u16* sV = sK + 64 * KS;
  const int tid = tidx(), wid = tid >> 6, lane = tid & 63, q = lane & 31, hh = lane >> 5;
  const int row = wid * 32 + q;
  const bool active = (wid * 32) < nrows;
  bf16x8 qf[DK / 16];
  if (active) {
#pragma unroll
    for (int ks = 0; ks < DK / 16; ++ks) qf[ks] = *(const bf16x8*)(Qb + (size_t)row * ldq + ks * 16 + hh * 8);
  }
  f32x16 o[DV / 32];
#pragma unroll
  for (int dt = 0; dt < DV / 32; ++dt)
#pragma unroll
    for (int i = 0; i < 16; ++i) o[dt][i] = 0.f;
  float mrun = -1e30f, lrun = 0.f;
  const int nkt = nkeys >> 6;
  constexpr int KCH = (64 * (DK / 8) + NTHR - 1) / NTHR;
  static_assert(DV == 128 && KCH <= 4, "staging registers are written out by hand");
  uint4 kr0, kr1, kr2, kr3, vr0, vr1;
#define AT_KL(N_, kt_) { const int c = tid + N_ * NTHR; if (N_ < KCH && c < 64 * (DK / 8)) { const int r = c / (DK / 8), cc = c % (DK / 8); \
      kr##N_ = *(const uint4*)(Kb + (size_t)((kt_) * 64 + r) * ldk + cc * 8); } }
#define AT_VL(N_, kt_) { const int c = tid + N_ * NTHR; const int r = c >> 3, cc = c & 7; vr##N_ = *(const uint4*)(Vtb + (size_t)r * ldvt + (kt_) * 64 + cc * 8); }
#define AT_GLOAD(kt_) do { AT_KL(0, kt_) AT_KL(1, kt_) AT_KL(2, kt_) AT_KL(3, kt_) AT_VL(0, kt_) AT_VL(1, kt_) } while (0)
#define AT_KS(N_) { const int c = tid + N_ * NTHR; if (N_ < KCH && c < 64 * (DK / 8)) { const int r = c / (DK / 8), cc = c % (DK / 8); *(uint4*)(sK + r * KS + cc * 8) = kr##N_; } }
#define AT_VS(N_) { const int c = tid + N_ * NTHR; const int r = c >> 3, cc = c & 7; uint2* d = (uint2*)(sV + r * VS + cc * 8); \
      const uint4 t_ = vr##N_; d[0] = make_uint2(t_.x, t_.y); d[1] = make_uint2(t_.z, t_.w); }
  AT_GLOAD(0);
  for (int kt = 0; kt < nkt; ++kt) {
    __syncthreads();
    AT_KS(0) AT_KS(1) AT_KS(2) AT_KS(3) AT_VS(0) AT_VS(1)
    __syncthreads();
    if (kt + 1 < nkt) AT_GLOAD(kt + 1);
    if (active) {
      f32x16 s0, s1;
#pragma unroll
      for (int i = 0; i < 16; ++i) { s0[i] = 0.f; s1[i] = 0.f; }
#pragma unroll
      for (int ks = 0; ks < DK / 16; ++ks) {
        bf16x8 a0 = *(const bf16x8*)(sK + q * KS + ks * 16 + hh * 8);
        bf16x8 a1 = *(const bf16x8*)(sK + (32 + q) * KS + ks * 16 + hh * 8);
        s0 = __builtin_amdgcn_mfma_f32_32x32x16_bf16(a0, qf[ks], s0, 0, 0, 0);
        s1 = __builtin_amdgcn_mfma_f32_32x32x16_bf16(a1, qf[ks], s1, 0, 0, 0);
      }
      float mx = s0[0];
#pragma unroll
      for (int i = 1; i < 16; ++i) mx = fmaxf(mx, s0[i]);
#pragma unroll
      for (int i = 0; i < 16; ++i) mx = fmaxf(mx, s1[i]);
      mx = fmaxf(mx, __shfl_xor(mx, 32));
      float mn = fmaxf(mrun, mx);
      float alpha = __builtin_amdgcn_exp2f(mrun - mn);
      mrun = mn;
      float ps = 0.f;
#pragma unroll
      for (int i = 0; i < 16; ++i) { s0[i] = __builtin_amdgcn_exp2f(sub_s(s0[i], mn)); ps = add_s(ps, s0[i]); }
#pragma unroll
      for (int i = 0; i < 16; ++i) { s1[i] = __builtin_amdgcn_exp2f(sub_s(s1[i], mn)); ps = add_s(ps, s1[i]); }
      lrun = lrun * alpha + ps;
#pragma unroll
      for (int dt = 0; dt < DV / 32; ++dt)
#pragma unroll
        for (int i = 0; i < 16; ++i) o[dt][i] = mul_s(o[dt][i], alpha);
#pragma unroll
      for (int kb = 0; kb < 2; ++kb)
#pragma unroll
        for (int s = 0; s < 2; ++s) {
          union { bf16x8 v; unsigned u[4]; } pf;
#pragma unroll
          for (int jj = 0; jj < 4; ++jj) {
            float e0 = kb ? s1[8 * s + 2 * jj] : s0[8 * s + 2 * jj];
            float e1 = kb ? s1[8 * s + 2 * jj + 1] : s0[8 * s + 2 * jj + 1];
            pf.u[jj] = pack2(e0, e1);
          }
          const int kbase = kb * 32 + s * 16 + 4 * hh;
#pragma unroll
          for (int dt = 0; dt < DV / 32; ++dt) {
            const u16* vp = sV + (dt * 32 + q) * VS + kbase;
            union { bf16x8 v; uint2 u[2]; } vf;
            vf.u[0] = *(const uint2*)vp; vf.u[1] = *(const uint2*)(vp + 8);
            o[dt] = __builtin_amdgcn_mfma_f32_32x32x16_bf16(vf.v, pf.v, o[dt], 0, 0, 0);
          }
        }
    }
  }
  if (active) {
    lrun += __shfl_xor(lrun, 32);
    float inv = 1.f / lrun;
    u16* op = Ob + (size_t)(row / RPG) * ldo + (size_t)(row % RPG) * DV;
#pragma unroll
    for (int dt = 0; dt < DV / 32; ++dt)
#pragma unroll
      for (int g = 0; g < 4; ++g) {
        uint2 w;
        w.x = pack2(o[dt][4 * g] * inv, o[dt][4 * g + 1] * inv);
        w.y = pack2(o[dt][4 * g + 2] * inv, o[dt][4 * g + 3] * inv);
        *(uint2*)(op + dt * 32 + 8 * g + 4 * hh) = w;
      }
  }
}

#undef AT_GLOAD
#undef AT_KL
#undef AT_VL
#undef AT_KS
#undef AT_VS
__device__ __forceinline__ float dpp_sum16(float x) {
  x += __int_as_float(__builtin_amdgcn_update_dpp(0, __float_as_int(x), 0xB1, 0xF, 0xF, false));
  x += __int_as_float(__builtin_amdgcn_update_dpp(0, __float_as_int(x), 0x4E, 0xF, 0xF, false));
  x += __int_as_float(__builtin_amdgcn_update_dpp(0, __float_as_int(x), 0x141, 0xF, 0xF, false));
  x += __int_as_float(__builtin_amdgcn_update_dpp(0, __float_as_int(x), 0x140, 0xF, 0xF, false));
  return x;
}
__device__ __forceinline__ void scan_item(KPR p, int l, int g0, int h, int half, int nsteps, const float* S0, float* Sout) {
  extern __shared__ __attribute__((aligned(16))) char smem[];
  float* sT = (float*)smem;
  float* sV = sT + 5 * 4096;
  const float* src0 = (const float*)(p.ws + W_RB) + h * 64; const float* src1 = (const float*)(p.ws + W_WB) + h * 64;
  const float* src2 = (const float*)(p.ws + W_KB) + h * 64; const float* src3 = (const float*)(p.ws + W_KKB) + h * 64;
  const float* src4 = (const float*)(p.ws + W_BB) + h * 64;
  const float* VB = (const float*)(p.ws + W_VB) + h * 64 + half * 32;
  float* YB = (float*)(p.ws + W_YB) + h * 64 + half * 32;
  const int tid = tidx();
  const int il = tid >> 4, sub = tid & 15, j0 = sub * 4, i = half * 32 + il;
  float s[4];
#pragma unroll
  for (int j = 0; j < 4; ++j) s[j] = S0 ? S0[i * 64 + j0 + j] : 0.f;
  float4 pa0, pa1, pa2, pa3, pa4, pb0, pb1, pb2, pb3, pb4, pfv;
  const int e0 = tid, e1 = tid + NTHR;
  const int st0 = e0 >> 4, c40 = (e0 & 15) * 4, st1 = e1 >> 4, c41 = (e1 & 15) * 4;
  const int stv = tid >> 3, c4v = (tid & 7) * 4;
#define SC_GL1(x, c0_) pa##x = *(const float4*)(src##x + (size_t)(g0 + (c0_) + st0) * 512 + c40); \
                       pb##x = *(const float4*)(src##x + (size_t)(g0 + (c0_) + st1) * 512 + c41);
#define SC_GLOAD(c0_) do { SC_GL1(0, c0_) SC_GL1(1, c0_) SC_GL1(2, c0_) SC_GL1(3, c0_) SC_GL1(4, c0_) \
    pfv = *(const float4*)(VB + (size_t)(g0 + (c0_) + stv) * 512 + c4v); } while (0)
#define SC_ST1(x) *(float4*)(sT + x * 4096 + st0 * 64 + c40) = pa##x; *(float4*)(sT + x * 4096 + st1 * 64 + c41) = pb##x;
  SC_GLOAD(0);
  for (int c0 = 0; c0 < nsteps; c0 += 64) {
    __syncthreads();
    SC_ST1(0) SC_ST1(1) SC_ST1(2) SC_ST1(3) SC_ST1(4)
    *(float4*)(sV + stv * 32 + c4v) = pfv;
    __syncthreads();
    if (c0 + 64 < nsteps) SC_GLOAD(c0 + 64);
#define SC_LD(S, st_) do { const int _s = (st_) < 64 ? (st_) : 63; \
      S##r = *(const float4*)(sT + _s * 64 + j0); S##w = *(const float4*)(sT + 4096 + _s * 64 + j0); \
      S##k = *(const float4*)(sT + 8192 + _s * 64 + j0); S##q = *(const float4*)(sT + 12288 + _s * 64 + j0); \
      S##b = *(const float4*)(sT + 16384 + _s * 64 + j0); S##v = sV[_s * 32 + il]; } while (0)
#define SC_STEP(S, st_) do { \
      float sa = -dpp_sum16(fma_s(s[1], S##q.y, mul_s(s[0], S##q.x)) + fma_s(s[3], S##q.w, mul_s(s[2], S##q.z))); \
      s[0] = fma_s(sa, S##b.x, fma_s(s[0], S##w.x, mul_s(S##v, S##k.x))); \
      s[1] = fma_s(sa, S##b.y, fma_s(s[1], S##w.y, mul_s(S##v, S##k.y))); \
      s[2] = fma_s(sa, S##b.z, fma_s(s[2], S##w.z, mul_s(S##v, S##k.z))); \
      s[3] = fma_s(sa, S##b.w, fma_s(s[3], S##w.w, mul_s(S##v, S##k.w))); \
      float y = dpp_sum16(fma_s(s[1], S##r.y, mul_s(s[0], S##r.x)) + fma_s(s[3], S##r.w, mul_s(s[2], S##r.z))); \
      ykeep = (sub == ((st_) & 15)) ? y : ykeep; } while (0)
    float4 Ar, Aw, Ak, Aq, Ab, Br, Bw, Bk, Bq, Bb, Cr, Cw, Ck, Cq, Cb, Dr, Dw, Dk, Dq, Db;
    float Av, Bv, Cv, Dv, ykeep = 0.f;
    SC_LD(A, 0); SC_LD(B, 1); SC_LD(C, 2);
    for (int st = 0; st < 64; st += 4) {
      SC_LD(D, st + 3); SC_STEP(A, st);
      SC_LD(A, st + 4); SC_STEP(B, st + 1);
      SC_LD(B, st + 5); SC_STEP(C, st + 2);
      SC_LD(C, st + 6); SC_STEP(D, st + 3);
      if ((st & 15) == 12) YB[(size_t)(g0 + c0 + (st - 12) + sub) * 512 + il] = ykeep;
    }
  }
#undef SC_LD
#undef SC_STEP
#undef SC_GLOAD
#undef SC_GL1
#undef SC_ST1
  *(float4*)(Sout + i * 64 + j0) = make_float4(s[0], s[1], s[2], s[3]);
}

constexpr int LS = 68;
constexpr int LBUF = 64 * LS;
constexpr int LH = 72;

__device__ __forceinline__ void split8(const float* x, bf16x8& hi, bf16x8& lo) {
  union { bf16x8 v; unsigned u[4]; } H, Lo;
#pragma unroll
  for (int j = 0; j < 4; ++j) {
    const unsigned h = pack2(x[2 * j], x[2 * j + 1]);
    H.u[j] = h;
    Lo.u[j] = pack2(x[2 * j] - __uint_as_float(h << 16), x[2 * j + 1] - __uint_as_float(h & 0xffff0000u));
  }
  hi = H.v; lo = Lo.v;
}
template <int AM, int AK, int BKS, int BN, bool SPLIT = true>
__device__ __forceinline__ void mm64(const float* A, const float* B, f32x4 (&acc)[2], int m0, int n0, int lane) {
  const int lr = lane & 15, lq = lane >> 4;
#pragma unroll
  for (int ks = 0; ks < 2; ++ks) {
    const int k0 = ks * 32 + lq * 8;
    float a[8];
    if (AK == 1) {
      float4 x0 = *(const float4*)(A + (m0 + lr) * AM + k0), x1 = *(const float4*)(A + (m0 + lr) * AM + k0 + 4);
      a[0] = x0.x; a[1] = x0.y; a[2] = x0.z; a[3] = x0.w; a[4] = x1.x; a[5] = x1.y; a[6] = x1.z; a[7] = x1.w;
    } else {
#pragma unroll
      for (int j = 0; j < 8; ++j) a[j] = A[(m0 + lr) * AM + (k0 + j) * AK];
    }
    bf16x8 ah, al;
    if (SPLIT) split8(a, ah, al);
    else { union { bf16x8 v; unsigned u[4]; } H; for (int j = 0; j < 4; ++j) H.u[j] = pack2(a[2 * j], a[2 * j + 1]); ah = H.v; al = H.v; }
#pragma unroll
    for (int nt = 0; nt < 2; ++nt) {
      const int n = n0 + nt * 16 + lr;
      float b[8];
      if (BKS == 1) {
        float4 x0 = *(const float4*)(B + n * BN + k0), x1 = *(const float4*)(B + n * BN + k0 + 4);
        b[0] = x0.x; b[1] = x0.y; b[2] = x0.z; b[3] = x0.w; b[4] = x1.x; b[5] = x1.y; b[6] = x1.z; b[7] = x1.w;
      } else {
#pragma unroll
        for (int j = 0; j < 8; ++j) b[j] = B[(k0 + j) * BKS + n * BN];
      }
      if (SPLIT) {
        bf16x8 bh, bl; split8(b, bh, bl);
        acc[nt] = __builtin_amdgcn_mfma_f32_16x16x32_bf16(ah, bh, acc[nt], 0, 0, 0);
        acc[nt] = __builtin_amdgcn_mfma_f32_16x16x32_bf16(ah, bl, acc[nt], 0, 0, 0);
        acc[nt] = __builtin_amdgcn_mfma_f32_16x16x32_bf16(al, bh, acc[nt], 0, 0, 0);
      } else {
        union { bf16x8 v; unsigned u[4]; } Bh;
#pragma unroll
        for (int j = 0; j < 4; ++j) Bh.u[j] = pack2(b[2 * j], b[2 * j + 1]);
        acc[nt] = __builtin_amdgcn_mfma_f32_16x16x32_bf16(ah, Bh.v, acc[nt], 0, 0, 0);
      }
    }
  }
}
#define MM_ZERO(acc) do { acc[0] = f32x4{0.f, 0.f, 0.f, 0.f}; acc[1] = f32x4{0.f, 0.f, 0.f, 0.f}; } while (0)
#define MM_FOREACH(acc, BODY) do { _Pragma("unroll") for (int nt_ = 0; nt_ < 2; ++nt_) _Pragma("unroll") for (int rg_ = 0; rg_ < 4; ++rg_) { \
    const int m = m0 + lq * 4 + rg_, n = n0 + nt_ * 16 + lr; const float val = acc[nt_][rg_]; BODY } } while (0)

#define CPRE_PARAMS float4& c_w0, float4& c_w1, float4& c_q0, float4& c_q1, float4& c_b0, float4& c_b1, float4& c_k0, float4& c_k1, float4& c_r0, float4& c_r1, float4& c_v0, float4& c_v1
#define CPRE_ARGS(P) P##w0, P##w1, P##q0, P##q1, P##b0, P##b1, P##k0, P##k1, P##r0, P##r1, P##v0, P##v1
__device__ __forceinline__ void cprep_load(KPR p, int grow0, int h, int tid, CPRE_PARAMS) {
  const int t0 = tid >> 4, c4 = (tid & 15) * 4;
  const size_t g0 = (size_t)(grow0 + t0) * 512 + h * 64 + c4, g1 = g0 + (size_t)32 * 512;
  const float* WB = (const float*)(p.ws + W_WB); const float* KKB = (const float*)(p.ws + W_KKB); const float* BB = (const float*)(p.ws + W_BB);
  const float* KB = (const float*)(p.ws + W_KB); const float* RB = (const float*)(p.ws + W_RB); const float* VB = (const float*)(p.ws + W_VB);
  c_w0 = *(const float4*)(WB + g0); c_w1 = *(const float4*)(WB + g1); c_q0 = *(const float4*)(KKB + g0); c_q1 = *(const float4*)(KKB + g1);
  c_b0 = *(const float4*)(BB + g0); c_b1 = *(const float4*)(BB + g1); c_k0 = *(const float4*)(KB + g0); c_k1 = *(const float4*)(KB + g1);
  c_r0 = *(const float4*)(RB + g0); c_r1 = *(const float4*)(RB + g1); c_v0 = *(const float4*)(VB + g0); c_v1 = *(const float4*)(VB + g1);
}
__device__ __forceinline__ void cprep_item(KPR p, int grow0, int h, int cid, int ngrow0, int nh, CPRE_PARAMS) {
  extern __shared__ __attribute__((aligned(16))) char smem[];
  float* B0 = (float*)smem; float* B1 = B0 + LBUF; float* B2 = B1 + LBUF; float* B3 = B2 + LBUF;
  float* B4 = B3 + LBUF; float* B5 = B4 + LBUF; float* B6 = B5 + LBUF; float* B7 = B6 + LBUF;
  float* wC = (float*)(smem + 139264);
  const int tid = tidx(), wid = tid >> 6, lane = tid & 63, lr = lane & 15, lq = lane >> 4;
  const int m0 = (wid >> 1) * 16, n0 = (wid & 1) * 32;
  const float* WB = (const float*)(p.ws + W_WB) + h * 64; const float* KKB = (const float*)(p.ws + W_KKB) + h * 64;
  const float* BB = (const float*)(p.ws + W_BB) + h * 64; const float* KB = (const float*)(p.ws + W_KB) + h * 64;
  const float* RB = (const float*)(p.ws + W_RB) + h * 64; const float* VB = (const float*)(p.ws + W_VB) + h * 64;
  f32x4 acc[2];
  __syncthreads();
  {
    const int t0 = tid >> 4, c4 = (tid & 15) * 4, o0 = t0 * LS + c4, o1 = (t0 + 32) * LS + c4;
    *(float4*)(B0 + o0) = c_w0; *(float4*)(B0 + o1) = c_w1;
    *(float4*)(B1 + o0) = make_float4(-c_q0.x, -c_q0.y, -c_q0.z, -c_q0.w); *(float4*)(B1 + o1) = make_float4(-c_q1.x, -c_q1.y, -c_q1.z, -c_q1.w);
    *(float4*)(B2 + o0) = c_b0; *(float4*)(B2 + o1) = c_b1;
    *(float4*)(B3 + o0) = c_k0; *(float4*)(B3 + o1) = c_k1;
    *(float4*)(B4 + o0) = c_r0; *(float4*)(B4 + o1) = c_r1;
  }
  const float4 vk0 = c_v0, vk1 = c_v1;
  __syncthreads();
  cprep_load(p, ngrow0, nh, tid, CPRE_ARGS(c_));
  {
    const int j = tid & 63, sg = tid >> 6;
    float wv[8];
#pragma unroll
    for (int u = 0; u < 8; ++u) wv[u] = B0[(sg * 8 + u) * LS + j];
#pragma unroll
    for (int u = 1; u < 8; ++u) wv[u] *= wv[u - 1];
    float* segp = B5;
    segp[sg * 64 + j] = wv[7];
    __syncthreads();
    float pre = 1.f;
    for (int u = 0; u < sg; ++u) pre *= segp[u * 64 + j];
#pragma unroll
    for (int u = 0; u < 8; ++u) B0[(sg * 8 + u) * LS + j] = wv[u] * pre;
    if (sg == 7) wC[j] = wv[7] * pre;
  }
  __syncthreads();
  for (int e = tid; e < 4096; e += NTHR) {
    const int t = e >> 6, j = e & 63, o = t * LS + j;
    const float wt = B0[o], wp = t ? B0[o - LS] : 1.f, iw = 1.f / wt;
    B1[o] *= wp; B2[o] *= iw; B3[o] *= iw; B4[o] *= wt;
  }
  __syncthreads();
  MM_ZERO(acc); mm64<LS, 1, 1, LS>(B2, B1, acc, m0, n0, lane);
  MM_FOREACH(acc, { const float v = m < n ? val : 0.f; B5[m * LS + n] = v; B6[m * LS + n] = v + (m == n ? 1.f : 0.f); });
  __syncthreads();
  MM_ZERO(acc); mm64<LS, 1, LS, 1>(B5, B5, acc, m0, n0, lane);
  MM_FOREACH(acc, { B7[m * LS + n] = val; });
  __syncthreads();
  for (int it = 0; it < 5; ++it) {
    MM_ZERO(acc); mm64<LS, 1, LS, 1>(B6, B7, acc, m0, n0, lane);
    f32x4 acc2[2]; MM_ZERO(acc2);
    if (it < 4) mm64<LS, 1, LS, 1>(B7, B7, acc2, m0, n0, lane);
    __syncthreads();
    MM_FOREACH(acc, { B6[m * LS + n] += val; });
    if (it < 4) MM_FOREACH(acc2, { B7[m * LS + n] = val; });
    __syncthreads();
  }
  MM_ZERO(acc); mm64<1, LS, LS, 1>(B1, B6, acc, m0, n0, lane);
  MM_FOREACH(acc, { B5[m * LS + n] = val; });
  MM_ZERO(acc); mm64<LS, 1, 1, LS>(B3, B1, acc, m0, n0, lane);
  MM_FOREACH(acc, { B0[m * LS + n] = m < n ? val : 0.f; });
  __syncthreads();
  MM_ZERO(acc); mm64<LS, 1, LS, 1>(B0, B6, acc, m0, n0, lane);
  MM_FOREACH(acc, { B7[m * LS + n] = val; });
  __syncthreads();
  MM_ZERO(acc); mm64<LS, 1, 1, LS, false>(B2, B4, acc, m0, n0, lane);
  {
    f32x4 acc2[2]; MM_ZERO(acc2); mm64<LS, 1, 1, LS, false>(B3, B4, acc2, m0, n0, lane);
    __syncthreads();
    MM_FOREACH(acc, { B0[m * LS + n] = m <= n ? val : 0.f; });
    MM_FOREACH(acc2, { B1[m * LS + n] = m <= n ? val : 0.f; });
  }
  __syncthreads();
  {
    u16* RRT = (u16*)(p.ws + W_CRR) + (size_t)cid * 4096;
    MM_ZERO(acc); mm64<1, LS, 1, LS, false>(B0, B5, acc, m0, n0, lane);
    MM_FOREACH(acc, { RRT[m * 64 + n] = f2bf(val + B4[m * LS + n]); });
    MM_ZERO(acc); mm64<LS, 1, LS, 1, false>(B7, B0, acc, m0, n0, lane);
    MM_FOREACH(acc, { B6[m * LS + n] = val + B1[m * LS + n]; });
  }
  __syncthreads();
  for (int e = tid; e < 4096; e += NTHR) {
    const int t = e >> 6, j = e & 63, o = t * LS + j;
    const float wc = wC[j];
    B2[o] *= wc; B3[o] *= wc;
  }
  { const int t0 = tid >> 4, c4 = (tid & 15) * 4; *(float4*)(B4 + t0 * LS + c4) = vk0; *(float4*)(B4 + (t0 + 32) * LS + c4) = vk1; }
  __syncthreads();
  {
    float* YB = (float*)(p.ws + W_YB) + h * 64;
    MM_ZERO(acc); mm64<1, LS, LS, 1, false>(B6, B4, acc, m0, n0, lane);
    MM_FOREACH(acc, { YB[(size_t)(grow0 + m) * 512 + n] = val; });
    u16* PT = (u16*)(p.ws + W_CPT) + (size_t)cid * 4096;
    MM_ZERO(acc); mm64<1, LS, 1, LS, false>(B2, B5, acc, m0, n0, lane);
    MM_FOREACH(acc, { PT[m * 64 + n] = f2bf(val + (m == n ? wC[m] : 0.f)); });
    MM_ZERO(acc); mm64<LS, 1, LS, 1, false>(B7, B2, acc, m0, n0, lane);
    MM_FOREACH(acc, { B0[m * LS + n] = val + B3[m * LS + n]; });
  }
  __syncthreads();
  {
    float* CQ = (float*)(p.ws + W_CQ) + (size_t)cid * 4096;
    MM_ZERO(acc); mm64<1, LS, LS, 1, false>(B4, B0, acc, m0, n0, lane);
    MM_FOREACH(acc, { CQ[m * 64 + n] = val; });
  }
}

__device__ __forceinline__ void cprep_decode(int id, int& grow0, int& h) {
  if (id < 2048) { grow0 = (id >> 9) * 4096 + (id & 63) * 64; h = (id >> 6) & 7; }
  else { const int k = id - 2048; grow0 = TP + (k >> 3) * 64; h = k & 7; }
}
__device__ __forceinline__ void phase_cprep(KPR p) {
  float4 u_w0, u_w1, u_q0, u_q1, u_b0, u_b1, u_k0, u_k1, u_r0, u_r1, u_v0, u_v1;
  int id = blockIdx.x, grow0 = 0, h = 0;
  cprep_decode(id < 2304 ? id : 0, grow0, h); cprep_load(p, grow0, h, tidx(), CPRE_ARGS(u_));
  for (; id < 2304; id += gridDim.x) {
    const int nid = id + gridDim.x;
    int ng = 0, nh = 0;
    cprep_decode(nid < 2304 ? nid : id, ng, nh);
    cprep_item(p, grow0, h, id, ng, nh, CPRE_ARGS(u_));
    grow0 = ng; h = nh;
  }
}

__device__ __forceinline__ void cseq_item(KPR p, int g0, int h, int nch, int cid0, const float* S0, float* Sout) {
  extern __shared__ __attribute__((aligned(16))) char smem[];
  float* Sf = (float*)smem;
  float* Qf = Sf + LBUF;
  float* Yf = Qf + LBUF;
  u16* Rb = (u16*)(Yf + LBUF);
  u16* Pb = Rb + 64 * LH;
  const int tid = tidx(), wid = tid >> 6, lane = tid & 63, lr = lane & 15, lq = lane >> 4;
  const int m0 = (wid >> 1) * 16, n0 = (wid & 1) * 32;
  float* YB = (float*)(p.ws + W_YB) + h * 64;
  const u16* RRT = (const u16*)(p.ws + W_CRR) + (size_t)cid0 * 4096;
  const u16* PT = (const u16*)(p.ws + W_CPT) + (size_t)cid0 * 4096;
  const float* CQ = (const float*)(p.ws + W_CQ) + (size_t)cid0 * 4096;
  __syncthreads();
  for (int e = tid; e < 4096; e += NTHR) { const int i = e >> 6, j = e & 63; Sf[i * LS + j] = S0 ? S0[e] : 0.f; }
  const int hr = tid >> 3, hc = (tid & 7) * 8;
  const int f0t = tid >> 4, f0c = (tid & 15) * 4;
  uint4 pr, pp; float4 q0, q1, y0, y1;
#define CS_LOAD(c_) do { \
    pr = *(const uint4*)(RRT + (size_t)(c_) * 4096 + hr * 64 + hc); pp = *(const uint4*)(PT + (size_t)(c_) * 4096 + hr * 64 + hc); \
    q0 = *(const float4*)(CQ + (size_t)(c_) * 4096 + f0t * 64 + f0c); q1 = *(const float4*)(CQ + (size_t)(c_) * 4096 + (f0t + 32) * 64 + f0c); \
    y0 = *(const float4*)(YB + (size_t)(g0 + (c_) * 64 + f0t) * 512 + f0c); y1 = *(const float4*)(YB + (size_t)(g0 + (c_) * 64 + f0t + 32) * 512 + f0c); } while (0)
  CS_LOAD(0);
  for (int c = 0; c < nch; ++c) {
    __syncthreads();
    *(uint4*)(Rb + hr * LH + hc) = pr; *(uint4*)(Pb + hr * LH + hc) = pp;
    *(float4*)(Qf + f0t * LS + f0c) = q0; *(float4*)(Qf + (f0t + 32) * LS + f0c) = q1;
    *(float4*)(Yf + f0t * LS + f0c) = y0; *(float4*)(Yf + (f0t + 32) * LS + f0c) = y1;
    __syncthreads();
    if (c + 1 < nch) CS_LOAD(c + 1);
    f32x4 ay[2], as[2]; MM_ZERO(ay); MM_ZERO(as);
#pragma unroll
    for (int ks = 0; ks < 2; ++ks) {
      const int k0 = ks * 32 + lq * 8;
      const bf16x8 ra = *(const bf16x8*)(Rb + (m0 + lr) * LH + k0);
      float sa[8];
      { float4 x0 = *(const float4*)(Sf + (m0 + lr) * LS + k0), x1 = *(const float4*)(Sf + (m0 + lr) * LS + k0 + 4);
        sa[0] = x0.x; sa[1] = x0.y; sa[2] = x0.z; sa[3] = x0.w; sa[4] = x1.x; sa[5] = x1.y; sa[6] = x1.z; sa[7] = x1.w; }
      bf16x8 sah, sal; split8(sa, sah, sal);
#pragma unroll
      for (int nt = 0; nt < 2; ++nt) {
        const int n = n0 + nt * 16 + lr;
        float sb[8];
        { float4 x0 = *(const float4*)(Sf + n * LS + k0), x1 = *(const float4*)(Sf + n * LS + k0 + 4);
          sb[0] = x0.x; sb[1] = x0.y; sb[2] = x0.z; sb[3] = x0.w; sb[4] = x1.x; sb[5] = x1.y; sb[6] = x1.z; sb[7] = x1.w; }
        bf16x8 sbh, sbl; split8(sb, sbh, sbl);
        ay[nt] = __builtin_amdgcn_mfma_f32_16x16x32_bf16(ra, sbh, ay[nt], 0, 0, 0);
        ay[nt] = __builtin_amdgcn_mfma_f32_16x16x32_bf16(ra, sbl, ay[nt], 0, 0, 0);
        const bf16x8 pb = *(const bf16x8*)(Pb + n * LH + k0);
        as[nt] = __builtin_amdgcn_mfma_f32_16x16x32_bf16(sah, pb, as[nt], 0, 0, 0);
        as[nt] = __builtin_amdgcn_mfma_f32_16x16x32_bf16(sal, pb, as[nt], 0, 0, 0);
      }
    }
    MM_FOREACH(ay, { YB[(size_t)(g0 + c * 64 + m) * 512 + n] = val + Yf[m * LS + n]; });
    __syncthreads();
    MM_FOREACH(as, { Sf[m * LS + n] = val + Qf[m * LS + n]; });
  }
#undef CS_LOAD
  __syncthreads();
  for (int e = tid; e < 4096; e += NTHR) { const int i = e >> 6, j = e & 63; Sout[e] = Sf[i * LS + j]; }
}

__device__ __forceinline__ void phase_yfin(KPR p, int l) {
  const int tid = tidx(), wid = tid >> 6, lane = tid & 63;
  const float* YB = (const float*)(p.ws + W_YB); const float* RB = (const float*)(p.ws + W_RB); const float* KB = (const float*)(p.ws + W_KB);
  const float* VB = (const float*)(p.ws + W_VB); const u16* GB = (const u16*)(p.ws + W_GB); u16* AO = (u16*)(p.ws + W_AO);
  const float* rk = p.in[I_RK] + l * 512; const float* gng = p.in[I_GNG] + l * 512; const float* gnb = p.in[I_GNB] + l * 512;
  for (int g = blockIdx.x * 8 + wid; g < T; g += gridDim.x * 8) {
#pragma unroll 2
    for (int h = 0; h < 8; ++h) {
      size_t i = (size_t)g * 512 + h * 64 + lane;
      float y = YB[i];
      float mu = wave_sum(y) * (1.f / 64.f);
      float dlt = y - mu;
      float var = wave_sum(dlt * dlt) * (1.f / 64.f);
      float bon = wave_sum(RB[i] * KB[i] * rk[h * 64 + lane]);
      float v = dlt * rsqrtf(var + 64e-5f) * gng[h * 64 + lane] + gnb[h * 64 + lane] + bon * VB[i];
      AO[(size_t)g * 1536 + 1024 + h * 64 + lane] = f2bf(v * bf2f(GB[i]));
    }
  }
}

__device__ __forceinline__ void phase_init(KPR p) {
  const int G = gridDim.x, tid = tidx(), wid = tid >> 6, lane = tid & 63;
  const int gw = blockIdx.x * 8 + wid, nw = G * 8;
  {
    float* X = (float*)(p.ws + W_X); u16* XB = (u16*)(p.ws + W_XB); float* SSQ = (float*)(p.ws + W_SSQ);
    for (int g = gw; g < T; g += nw) {
      const float* src = g < TP ? p.in[I_XP] + (size_t)g * 1024 : p.in[I_XS] + (size_t)(g - TP) * 1024;
      float ss = 0.f;
#pragma unroll
      for (int i = 0; i < 4; ++i) {
        float4 v = *(const float4*)(src + i * 256 + lane * 4);
        *(float4*)(X + (size_t)g * 1024 + i * 256 + lane * 4) = v;
        uint2 w; w.x = pack2(v.x, v.y); w.y = pack2(v.z, v.w);
        *(uint2*)(XB + (size_t)g * 1024 + i * 256 + lane * 4) = w;
        ss += v.x * v.x + v.y * v.y + v.z * v.z + v.w * v.w;
      }
      ss = wave_sum(ss);
      if (lane == 0) *(float4*)(SSQ + (size_t)g * 4) = make_float4(ss, 0.f, 0.f, 0.f);
    }
  }
  {
    u16* MB = (u16*)(p.ws + W_MB);
    for (int g = gw; g < 1024; g += nw) {
      const float* src = p.in[I_MEMP] + (size_t)g * 1024;
      float4 v[4]; float ss = 0.f;
#pragma unroll
      for (int i = 0; i < 4; ++i) { v[i] = *(const float4*)(src + i * 256 + lane * 4); ss += v[i].x * v[i].x + v[i].y * v[i].y + v[i].z * v[i].z + v[i].w * v[i].w; }
      ss = wave_sum(ss);
      float rs = rsqrtf(ss * (1.f / 1024.f) + 1e-6f);
#pragma unroll
      for (int i = 0; i < 4; ++i) {
        uint2 w; w.x = pack2(v[i].x * rs, v[i].y * rs); w.y = pack2(v[i].z * rs, v[i].w * rs);
        *(uint2*)(MB + (size_t)g * 1024 + i * 256 + lane * 4) = w;
      }
    }
  }
  {
    float2* RT = (float2*)(p.ws + W_ROPE);
    for (int e = blockIdx.x * NTHR + tid; e < 4096 * 16; e += G * NTHR) {
      int pos = e >> 4, i = e & 15;
      float inv = powf(10000.f, -(float)i / 16.f);
      float ang = (float)pos * inv;
      float sn, cs; sincosf(ang, &sn, &cs);
      RT[e] = make_float2(cs, sn);
    }
  }
  int rot = 0;
  for (int l = 0; l < NL; ++l) {
    u16* WT = (u16*)(p.ws + W_WT) + (size_t)l * WE_LAYER;
    for (int f = 0; f < 2; ++f) {
      const float* nrm = p.in[f ? I_F2N : I_F1N] + l * 1024;
      const float* wg = p.in[f ? I_F2G : I_F1G] + (size_t)l * 1024 * DFF;
      const float* wu = p.in[f ? I_F2U : I_F1U] + (size_t)l * 1024 * DFF;
      const float* wd = p.in[f ? I_F2D : I_F1D] + (size_t)l * 1024 * DFF;
      tconv(WT + (f ? WE_GU2 : WE_GU1), 1024, 5632, 1024, rot, [=](int k, int n) {
        int j = (n >> 5) * 16 + (n & 15);
        const float* s = ((n >> 4) & 1) ? wu : wg;
        return nrm[k] * s[(size_t)k * DFF + j];
      });
      rot += 88 * 16;
      tconv(WT + (f ? WE_D2 : WE_D1), DFF, 1024, DFF, rot, [=](int k, int n) { return wd[(size_t)k * 1024 + n]; });
      rot += 16 * 44;
    }
    {
      const float* nrm = p.in[I_MIXN] + l * 1024; const float* w = p.in[I_WIN] + (size_t)l * 1024 * DIN;
      tconv(WT + WE_IN, 1024, DINP, 1024, rot, [=](int k, int n) { return n < DIN ? nrm[k] * w[(size_t)k * DIN + n] : 0.f; });
      rot += 36 * 16;
    }
    {
      const float* nrm = p.in[I_QN] + l * 256; const float* wuq = p.in[I_WUQ] + (size_t)l * 256 * 768;
      const float* wuk = p.in[I_WUK] + (size_t)l * 8 * 128 * 64;
      tconv(WT + WE_Q, 256, 1280, 256, rot, [=](int k, int n) {
        float r;
        if (n < 1024) {
          int h = n >> 7, c = n & 127;
          const float* a = wuq + (size_t)k * 768 + h * 96; const float* b = wuk + (size_t)(h * 128 + c) * 64;
          r = 0.f;
          for (int d = 0; d < 64; ++d) r += a[d] * b[d];
        } else {
          int hr = n - 1024;
          r = wuq[(size_t)k * 768 + (hr >> 5) * 96 + 64 + (hr & 31)];
        }
        return r * nrm[k] * QSCALE;
      });
      rot += 20 * 4;
    }
    {
      const float* wup = p.in[I_WUP] + (size_t)l * 64 * 512; const float* aup = p.in[I_AUP] + (size_t)l * 64 * 512;
      const float* gup = p.in[I_GUP] + (size_t)l * 128 * 512;
      tconv(WT + WE_RW, 256, 1536, 256, rot, [=](int k, int n) {
        if (n < 512) return k < 64 ? wup[k * 512 + n] : 0.f;
        if (n < 1024) return (k >= 64 && k < 128) ? aup[(k - 64) * 512 + n - 512] : 0.f;
        return k >= 128 ? gup[(k - 128) * 512 + n - 1024] : 0.f;
      });
      rot += 24 * 4;
    }
    {
      const float* wuv = p.in[I_WUV] + (size_t)l * 8 * 128 * 64; const float* wo = p.in[I_WOUT] + (size_t)l * 1024 * 1024;
      tconv(WT + WE_OUT, 1536, 1024, 1536, rot, [=](int k, int n) {
        if (k < 1024) {
          int h = k >> 7, c = k & 127;
          const float* a = wuv + (size_t)(h * 128 + c) * 64; const float* b = wo + (size_t)(h * 64) * 1024 + n;
          float r = 0.f;
          for (int v = 0; v < 64; ++v) r += a[v] * b[(size_t)v * 1024];
          return r;
        }
        return wo[(size_t)(512 + k - 1024) * 1024 + n];
      });
      rot += 16 * 24;
    }
    {
      const float* nx = p.in[I_XN] + l * 1024; const float* nm = p.in[I_MKVN] + l * 1024;
      const float* wq = p.in[I_WMQ] + (size_t)l * 1048576; const float* wk = p.in[I_WMK] + (size_t)l * 1048576;
      const float* wv = p.in[I_WMV] + (size_t)l * 1048576; const float* wo = p.in[I_WMO] + (size_t)l * 1048576;
      tconv(WT + WE_MQ, 1024, 1024, 1024, rot, [=](int k, int n) { return nx[k] * wq[(size_t)k * 1024 + n] * XSCALE; });
      tconv(WT + WE_MK, 1024, 1024, 1024, rot, [=](int k, int n) { return nm[k] * wk[(size_t)k * 1024 + n]; });
      tconv(WT + WE_MV, 1024, 1024, 1024, rot, [=](int k, int n) { return nm[k] * wv[(size_t)k * 1024 + n]; });
      tconv(WT + WE_MO, 1024, 1024, 1024, rot, [=](int k, int n) { return wo[(size_t)k * 1024 + n]; });
    }
  }
}

__device__ __forceinline__ void phase_prep(KPR p, int l) {
  extern __shared__ __attribute__((aligned(16))) char smem[];
  u16* sv = (u16*)smem;
  const int tid = tidx(), wid = tid >> 6, lane = tid & 63;
  const u16* PROJ = (const u16*)(p.ws + W_PROJ);
  u16* CQB = (u16*)(p.ws + W_CQB); u16* A2 = (u16*)(p.ws + W_A2);
  float* RB = (float*)(p.ws + W_RB); float* KB = (float*)(p.ws + W_KB); float* VB = (float*)(p.ws + W_VB); float* KKB = (float*)(p.ws + W_KKB);
  u16* KP = (u16*)(p.ws + W_KP); u16* KS = (u16*)(p.ws + W_KS); u16* VTP = (u16*)(p.ws + W_VTP); u16* VTS = (u16*)(p.ws + W_VTS);
  const float2* RT = (const float2*)(p.ws + W_ROPE);
  const float* kvn = p.in[I_KVN] + l * 128; const float* mu = p.in[I_MU] + l * DSH; const float* kkw = p.in[I_KK] + l * 512;
  for (int chunk = blockIdx.x; chunk < T / 72; chunk += gridDim.x) {
  __syncthreads();
  for (int ri = 0; ri < 9; ++ri) {
    const int rl = wid * 9 + ri, g = chunk * 72 + rl;
    const u16* pr = PROJ + (size_t)g * DINP;
    const bool isP = g < TP;
    int b, t, pos, tlen;
    if (isP) { b = g >> 12; t = g & 4095; pos = t; tlen = 4096; } else { int gg = g - TP; b = gg >> 6; t = gg & 63; pos = 2048 + t; tlen = 64; }
    {
      uint2 w = *(const uint2*)(pr + lane * 4);
      float v0 = bf2f(w.x & 0xffff), v1 = bf2f(w.x >> 16), v2 = bf2f(w.y & 0xffff), v3 = bf2f(w.y >> 16);
      float ss = wave_sum(v0 * v0 + v1 * v1 + v2 * v2 + v3 * v3);
      float rs = rsqrtf(ss * (1.f / 256.f) + 1e-6f);
      uint2 o; o.x = pack2(v0 * rs, v1 * rs); o.y = pack2(v2 * rs, v3 * rs);
      *(uint2*)(CQB + (size_t)g * 256 + lane * 4) = o;
    }
    {
      unsigned w = *(const unsigned*)(pr + 256 + lane * 2);
      float v0 = bf2f(w & 0xffff), v1 = bf2f(w >> 16);
      float ss = wave_sum(v0 * v0 + v1 * v1);
      float rs = rsqrtf(ss * (1.f / 128.f) + 1e-6f);
      int c = lane * 2;
      v0 = v0 * rs * kvn[c]; v1 = v1 * rs * kvn[c + 1];
      float* of = isP ? p.out + OO_CKVP + ((size_t)(l * 4 + b) * 4096 + t) * 128 : p.out + OO_CKVS + ((size_t)(l * 32 + b) * 64 + t) * 128;
      *(float2*)(of + c) = make_float2(v0, v1);
      u16* kr = isP ? KP + ((size_t)b * 4096 + t) * 160 : KS + ((size_t)b * 2112 + 2048 + t) * 160;
      *(unsigned*)(kr + c) = pack2(v0, v1);
      *(unsigned*)(sv + rl * 128 + c) = pack2(v0, v1);
      if (lane < 16) {
        float x1 = bf2f(pr[384 + lane]), x2 = bf2f(pr[400 + lane]);
        float2 cs = RT[pos * 16 + lane];
        float o1 = x1 * cs.x - x2 * cs.y, o2 = x1 * cs.y + x2 * cs.x;
        float* okr = isP ? p.out + OO_KRP + ((size_t)(l * 4 + b) * 4096 + t) * 32 : p.out + OO_KRS + ((size_t)(l * 32 + b) * 64 + t) * 32;
        okr[lane] = o1; okr[lane + 16] = o2;
        kr[128 + lane] = f2bf(o1); kr[144 + lane] = f2bf(o2);
      }
    }
    {
      const u16* pb = pr + 416;
      const u16* pp = pr - DINP + 416;
      const float* sh0 = p.in[I_SSH] + (size_t)(l * 32 + b) * DSH;
      const bool last = (t == tlen - 1);
      float* osh = isP ? p.out + OO_SHP + (size_t)(l * 4 + b) * DSH : p.out + OO_SHS + (size_t)(l * 32 + b) * DSH;
#pragma unroll
      for (int it = 0; it < 4; ++it) {
        const int c = it * 64 + lane;
        if (c < 224) {
          const int e = c * 8;
          uint4 w = *(const uint4*)(pb + e);
          float pv[8] = {bf2f(w.x & 0xffff), bf2f(w.x >> 16), bf2f(w.y & 0xffff), bf2f(w.y >> 16), bf2f(w.z & 0xffff), bf2f(w.z >> 16), bf2f(w.w & 0xffff), bf2f(w.w >> 16)};
          float pq[8];
          if (t > 0) {
            uint4 q = *(const uint4*)(pp + e);
            pq[0] = bf2f(q.x & 0xffff); pq[1] = bf2f(q.x >> 16); pq[2] = bf2f(q.y & 0xffff); pq[3] = bf2f(q.y >> 16);
            pq[4] = bf2f(q.z & 0xffff); pq[5] = bf2f(q.z >> 16); pq[6] = bf2f(q.w & 0xffff); pq[7] = bf2f(q.w >> 16);
          } else if (!isP) {
            float4 q0 = *(const float4*)(sh0 + e), q1 = *(const float4*)(sh0 + e + 4);
            pq[0] = q0.x; pq[1] = q0.y; pq[2] = q0.z; pq[3] = q0.w; pq[4] = q1.x; pq[5] = q1.y; pq[6] = q1.z; pq[7] = q1.w;
          } else {
#pragma unroll
            for (int j = 0; j < 8; ++j) pq[j] = 0.f;
          }
          float4 m0 = *(const float4*)(mu + e), m1 = *(const float4*)(mu + e + 4);
          float mm[8] = {m0.x, m0.y, m0.z, m0.w, m1.x, m1.y, m1.z, m1.w};
          float xs[8];
#pragma unroll
          for (int j = 0; j < 8; ++j) xs[j] = pv[j] + mm[j] * (pq[j] - pv[j]);
          if (last) { *(float4*)(osh + e) = make_float4(pv[0], pv[1], pv[2], pv[3]); *(float4*)(osh + e + 4) = make_float4(pv[4], pv[5], pv[6], pv[7]); }
          if (it == 0) {
            float* o = RB + (size_t)g * 512 + e;
            *(float4*)o = make_float4(xs[0], xs[1], xs[2], xs[3]); *(float4*)(o + 4) = make_float4(xs[4], xs[5], xs[6], xs[7]);
          } else if (it == 1) {
            const int cc = e - 512;
            float* o = KB + (size_t)g * 512 + cc;
            *(float4*)o = make_float4(xs[0], xs[1], xs[2], xs[3]); *(float4*)(o + 4) = make_float4(xs[4], xs[5], xs[6], xs[7]);
            float4 k0 = *(const float4*)(kkw + cc), k1 = *(const float4*)(kkw + cc + 4);
            float kk[8] = {xs[0] * k0.x, xs[1] * k0.y, xs[2] * k0.z, xs[3] * k0.w, xs[4] * k1.x, xs[5] * k1.y, xs[6] * k1.z, xs[7] * k1.w};
            float ss = 0.f;
#pragma unroll
            for (int j = 0; j < 8; ++j) ss += kk[j] * kk[j];
            ss = dpp_sum8(ss);
            float rn = rsqrtf(ss + 1e-12f);
            float* o2 = KKB + (size_t)g * 512 + cc;
            *(float4*)o2 = make_float4(kk[0] * rn, kk[1] * rn, kk[2] * rn, kk[3] * rn); *(float4*)(o2 + 4) = make_float4(kk[4] * rn, kk[5] * rn, kk[6] * rn, kk[7] * rn);
          } else if (it == 2) {
            float* o = VB + (size_t)g * 512 + (e - 1024);
            *(float4*)o = make_float4(xs[0], xs[1], xs[2], xs[3]); *(float4*)(o + 4) = make_float4(xs[4], xs[5], xs[6], xs[7]);
          } else {
            const int cc = e - 1536;
            float y[8];
#pragma unroll
            for (int j = 0; j < 8; ++j) y[j] = cc < 64 ? (1.f - 2.f / (1.f + __expf(2.f * xs[j]))) : (cc < 128 ? xs[j] : sigmoidf_(xs[j]));
            uint4 o; o.x = pack2(y[0], y[1]); o.y = pack2(y[2], y[3]); o.z = pack2(y[4], y[5]); o.w = pack2(y[6], y[7]);
            *(uint4*)(A2 + (size_t)g * 256 + cc) = o;
          }
        }
      }
    }
  }
  __syncthreads();
  for (int idx = tid; idx < 128 * 9; idx += NTHR) {
    const int d = idx & 127, rl0 = (idx >> 7) * 8, g = chunk * 72 + rl0;
    unsigned w[4];
#pragma unroll
    for (int j = 0; j < 4; ++j) w[j] = (unsigned)sv[(rl0 + 2 * j) * 128 + d] | ((unsigned)sv[(rl0 + 2 * j + 1) * 128 + d] << 16);
    u16* dst;
    if (g < TP) dst = VTP + ((size_t)(g >> 12) * 128 + d) * 4096 + (g & 4095);
    else { const int gg = g - TP; dst = VTS + ((size_t)(gg >> 6) * 128 + d) * 2112 + 2048 + (gg & 63); }
    *(uint4*)dst = make_uint4(w[0], w[1], w[2], w[3]);
  }
  }
}

__device__ __forceinline__ void conv_caches(KPR p, int l, int vb, int nvb) {
  const int tid = tidx();
  u16* KS = (u16*)(p.ws + W_KS); u16* VTS = (u16*)(p.ws + W_VTS);
  {
    const float* cckv = p.in[I_CCKV] + (size_t)l * 32 * 2048 * 128;
    const float* ckr = p.in[I_CKR] + (size_t)l * 32 * 2048 * 32;
    for (int idx = vb * NTHR + tid; idx < 32 * 2048 * 20; idx += nvb * NTHR) {
      int rowi = idx / 20, ch = idx % 20;
      int b = rowi >> 11, t = rowi & 2047;
      const float* s = ch < 16 ? cckv + (size_t)rowi * 128 + ch * 8 : ckr + (size_t)rowi * 32 + (ch - 16) * 8;
      float4 a = *(const float4*)s, c = *(const float4*)(s + 4);
      uint4 o; o.x = pack2(a.x, a.y); o.y = pack2(a.z, a.w); o.z = pack2(c.x, c.y); o.w = pack2(c.z, c.w);
      *(uint4*)(KS + ((size_t)b * 2112 + t) * 160 + ch * 8) = o;
    }
    tconv_v(VTS, 2112, 4096, 2048, vb, nvb, [=](int k, int n) { return cckv[((size_t)(n >> 7) * 2048 + k) * 128 + (n & 127)]; });
    const float* cmk = p.in[I_CMK] + (size_t)l * 32 * 256 * 1024;
    const float* cmv = p.in[I_CMV] + (size_t)l * 32 * 256 * 1024;
    u16* MKS = (u16*)(p.ws + W_MKS); u16* MVTS = (u16*)(p.ws + W_MVTS);
    for (int idx = vb * NTHR + tid; idx < 32 * 4 * 256 * 32; idx += nvb * NTHR) {
      int d8 = idx & 31, m = (idx >> 5) & 255, h = (idx >> 13) & 3, b = idx >> 15;
      const float* s = cmk + ((size_t)(b * 256 + m) * 4 + h) * 256 + d8 * 8;
      float4 a = *(const float4*)s, c = *(const float4*)(s + 4);
      uint4 o; o.x = pack2(a.x, a.y); o.y = pack2(a.z, a.w); o.z = pack2(c.x, c.y); o.w = pack2(c.z, c.w);
      *(uint4*)(MKS + (size_t)idx * 8) = o;
    }
    tconv_v(MVTS, 256, 32768, 256, vb, nvb, [=](int k, int n) { return cmv[((size_t)((n >> 10) * 256 + k) * 4 + ((n >> 8) & 3)) * 256 + (n & 255)]; });
  }
}

__device__ __forceinline__ void mla_sub(KPR p, int b, int c, int half) {
  const u16* QB = (const u16*)(p.ws + W_QB); u16* AO = (u16*)(p.ws + W_AO);
  size_t tok = (size_t)b * 4096 + c * 64 + half * 32;
  attn_item<160, 128, 8>(QB + tok * 1280, 160, 256, (const u16*)(p.ws + W_KP) + (size_t)b * 4096 * 160, 160,
                         (const u16*)(p.ws + W_VTP) + (size_t)b * 128 * 4096, 4096, (c + 1) * 64, AO + tok * 1536, 1536);
}
__device__ __forceinline__ void phase_mix(KPR p, int l, int mode = 0) {
  extern __shared__ __attribute__((aligned(16))) char smem[];
  int* sItem = (int*)(smem + SMEM_ITEM);
  int* cnt = (int*)(p.ws + W_CNT) + l + mode * 8;
  for (;;) {
    __syncthreads();
    if (threadIdx.x == 0) *sItem = atomicAdd(cnt, 1);
    __syncthreads();
    int it = *sItem;
    if (it >= 864) break;
    if (mode == 2 && (it < 32 || it >= 608)) continue;
    if (it < 32) {
      int b = it >> 3, h = it & 7;
      cseq_item(p, b * 4096, h, 64, (b * 8 + h) * 64, nullptr, p.out + OO_WKVP + ((size_t)(l * 4 + b) * 8 + h) * 4096);
    } else if (it < 608) {
      int k = it - 32;
      if (k >= 248 && k < 312) {
        int j = k - 248; int b = j >> 1, half = j & 1;
        const u16* QB = (const u16*)(p.ws + W_QB); u16* AO = (u16*)(p.ws + W_AO);
        size_t tok = (size_t)TP + b * 64 + half * 32;
        attn_item<160, 128, 8>(QB + tok * 1280, 160, 256, (const u16*)(p.ws + W_KS) + (size_t)b * 2112 * 160, 160,
                               (const u16*)(p.ws + W_VTS) + (size_t)b * 128 * 2112, 2112, 2112, AO + tok * 1536, 1536);
      } else {
        if (k >= 312) k -= 64;
        int c = 63 - (k >> 3), b = (k >> 1) & 3, half = k & 1;
        mla_sub(p, b, c, half);
      }
    } else {
      int k = it - 608; int b = k >> 3, h = k & 7;
      cseq_item(p, TP + b * 64, h, 1, 2048 + k, p.in[I_SWKV] + ((size_t)(l * 32 + b) * 8 + h) * 4096,
                p.out + OO_WKVS + ((size_t)(l * 32 + b) * 8 + h) * 4096);
    }
  }
}

__device__ __forceinline__ void xattn_item(KPR p, int l, int it) {
  const u16* QX = (const u16*)(p.ws + W_QX); u16* XO = (u16*)(p.ws + W_XO);
  if (it < 256) {
    int b = it >> 6, h = (it >> 4) & 3, qt = it & 15;
    size_t tok = (size_t)b * 4096 + qt * 256;
    for (int hv = 0; hv < 2; ++hv)
      attn_item<256, 128, 1>(QX + tok * 1024 + h * 256, 1024, 256, (const u16*)(p.ws + W_MKP) + (size_t)((l * 4 + b) * 4 + h) * 65536, 256,
                             (const u16*)(p.ws + W_MVTP) + (size_t)((l * 4 + b) * 4 + h) * 65536 + hv * 128 * 256, 256, 256, XO + tok * 1024 + h * 256 + hv * 128, 1024);
  } else {
    int k = it - 256; int b = k >> 2, h = k & 3;
    size_t tok = (size_t)TP + b * 64;
    for (int hv = 0; hv < 2; ++hv)
      attn_item<256, 128, 1>(QX + tok * 1024 + h * 256, 1024, 64, (const u16*)(p.ws + W_MKS) + (size_t)(b * 4 + h) * 65536, 256,
                             (const u16*)(p.ws + W_MVTS) + (size_t)(b * 4 + h) * 65536 + hv * 128 * 256, 256, 256, XO + tok * 1024 + h * 256 + hv * 128, 1024);
  }
}

constexpr int CH_NST = 10;
__device__ __forceinline__ void phase_chain(KPR p, int ci, int dup = 0) {
  extern __shared__ __attribute__((aligned(16))) char smem[];
  int* sItem = (int*)(smem + SMEM_ITEM);
  int* CT = (int*)(p.ws + W_CNT) + dup * 8192;
  const float rc = dup ? 0.f : 1.f;
  int* q = CT + 3800 + ci; int* xa = CT + 72 + ci; int* oa = CT + 80 + ci;
  int* cnt = CT + 128 + ci * CH_NST * 72;
  int* stamp = CT + 4096 + ci * CH_NST * 72;
  int* G = CT + 8000 + ci; int* xast = CT + 8010 + ci; int* oast = CT + 8020 + ci;
  int lastG = 0;
  const bool hasTail = ci >= 1, hasHead = ci < NL;
  const int lt = ci - 1, lh = ci;
  const int e0 = hasTail ? 288 : 0, e1 = e0 + (hasTail ? 288 : 0), e2 = e1 + (hasTail ? 384 : 0), e3 = e2 + (hasTail ? 288 : 0),
            e4 = e3 + (hasTail ? 792 : 0), e5 = e4 + (hasTail ? 288 : 0), e6 = e5 + (hasHead ? 792 : 0), e7 = e6 + (hasHead ? 288 : 0),
            e8 = e7 + (hasHead ? 224 : 0), e9 = e8 + (hasHead ? 648 : 0);
  float* X = (float*)(p.ws + W_X); u16* XB = (u16*)(p.ws + W_XB); float* SSQ = (float*)(p.ws + W_SSQ); u16* ACT = (u16*)(p.ws + W_ACT);
  const int grp = blockIdx.x & 7;
  int nxt = 0;
  if (tidx() == 0) nxt = atomicAdd(q + grp * 8, 1) * 8 + grp;
  for (;;) {
    const int tid = tidx();
    if (tid == 0) {
      const int it = nxt;
      if (it < e9) {
        int st, idx;
        if (it < e0) { st = 0; idx = it; } else if (it < e1) { st = 1; idx = it - e0; } else if (it < e2) { st = 2; idx = it - e1; }
        else if (it < e3) { st = 3; idx = it - e2; } else if (it < e4) { st = 4; idx = it - e3; } else if (it < e5) { st = 5; idx = it - e4; }
        else if (it < e6) { st = 6; idx = it - e5; } else if (it < e7) { st = 7; idx = it - e6; } else if (it < e8) { st = 8; idx = it - e7; }
        else { st = 9; idx = it - e8; }
        int pm = 0, pn = 0;
        if (st == 2) pm = idx < 256 ? ((idx >> 6) * 16 + (idx & 15)) : (64 + ((idx - 256) >> 4));
        else if (st != 8) tile_map(idx, 72, (st == 4 || st == 6) ? 11 : (st == 9 ? 9 : 4), pm, pn);
        const int* c1 = nullptr; const int* c2 = nullptr;
        switch (st) {
          case 1: c1 = stamp + 0 * 72 + pm; break;
          case 2: c1 = stamp + 1 * 72 + pm; break;
          case 3: c1 = stamp + 2 * 72 + pm; break;
          case 4: c1 = stamp + 3 * 72 + pm; c2 = xast; break;
          case 5: c1 = stamp + 4 * 72 + pm; break;
          case 6: if (hasTail) c1 = stamp + 5 * 72 + pm; break;
          case 7: c1 = stamp + 6 * 72 + pm; break;
          case 8: if (hasTail) c1 = xast; break;
          case 9: c1 = stamp + 7 * 72 + pm; if (hasTail) c2 = oast; break;
          default: break;
        }
        if (dup) { c1 = nullptr; c2 = nullptr; }
        int s1 = 0, s2 = 0;
        if (c1) while ((s1 = __hip_atomic_load(c1, __ATOMIC_RELAXED, __HIP_MEMORY_SCOPE_AGENT)) == 0) __builtin_amdgcn_s_sleep(4);
        if (c2) while ((s2 = __hip_atomic_load(c2, __ATOMIC_RELAXED, __HIP_MEMORY_SCOPE_AGENT)) == 0) __builtin_amdgcn_s_sleep(4);
        if ((s1 > s2 ? s1 : s2) >= lastG) {
          const int g = __hip_atomic_load(G, __ATOMIC_RELAXED, __HIP_MEMORY_SCOPE_AGENT);
          __builtin_amdgcn_fence(__ATOMIC_ACQUIRE, "agent");
          asm volatile("s_waitcnt vmcnt(0)" ::: "memory");
          lastG = g;
        }
        sItem[1] = st; sItem[2] = idx; sItem[3] = pm; sItem[4] = pn;
      }
      sItem[0] = it;
    }
    __syncthreads();
    if (sItem[0] >= e9) break;
    const int st = sItem[1], idx = sItem[2], pm = sItem[3], pn = sItem[4];
    if (tid == 0) nxt = atomicAdd(q + grp * 8, 1) * 8 + grp;
    if (dup && !((PROBE_MASK >> st) & 1)) { __syncthreads(); continue; }
    const u16* WTt = (const u16*)(p.ws + W_WT) + (size_t)(lt < 0 ? 0 : lt) * WE_LAYER;
    const u16* WTh = (const u16*)(p.ws + W_WT) + (size_t)(lh >= NL ? 0 : lh) * WE_LAYER;
    switch (st) {
      case 0: gemm_tile((const u16*)(p.ws + W_AO), WTt + WE_OUT, 1536, pm, pn, EpiRes{X, XB, SSQ, rc}); break;
      case 1: gemm_tile(XB, WTt + WE_MQ, 1024, pm, pn, EpiScaleBf{SSQ, (u16*)(p.ws + W_QX), 1024}); break;
      case 2: xattn_item(p, lt, idx); break;
      case 3: gemm_tile((const u16*)(p.ws + W_XO), WTt + WE_MO, 1024, pm, pn, EpiRes{X, XB, SSQ, rc}); break;
      case 4: gemm_tile(XB, WTt + WE_GU2, 1024, pm, 2 * pn, EpiGU{SSQ, ACT}); gemm_tile(XB, WTt + WE_GU2, 1024, pm, 2 * pn + 1, EpiGU{SSQ, ACT}); break;
      case 5: gemm_tile(ACT, WTt + WE_D2, DFF, pm, pn, EpiRes{X, XB, SSQ, 0.5f * rc}); break;
      case 6: gemm_tile(XB, WTh + WE_GU1, 1024, pm, 2 * pn, EpiGU{SSQ, ACT}); gemm_tile(XB, WTh + WE_GU1, 1024, pm, 2 * pn + 1, EpiGU{SSQ, ACT}); break;
      case 7: gemm_tile(ACT, WTh + WE_D1, DFF, pm, pn, EpiRes{X, XB, SSQ, 0.5f * rc}); break;
      case 8: conv_caches(p, lh, idx, 224); break;
      default: gemm_tile(XB, WTh + WE_IN, 1024, pm, pn, EpiScaleBf{SSQ, (u16*)(p.ws + W_PROJ), DINP}); break;
    }
    asm volatile("s_waitcnt vmcnt(0)" ::: "memory");
    __syncthreads();
    if (tidx() == 64) {
      __builtin_amdgcn_fence(__ATOMIC_RELEASE, "agent");
      asm volatile("s_waitcnt vmcnt(0)" ::: "memory");
      atomicAdd(G, 1);
      const int full = (st == 4 || st == 6) ? 11 : (st == 9 ? 9 : (st == 2 ? (pm < 64 ? 4 : 16) : 4));
      if (atomicAdd(cnt + st * 72 + pm, 1) + 1 == full)
        __hip_atomic_store(stamp + st * 72 + pm, __hip_atomic_load(G, __ATOMIC_RELAXED, __HIP_MEMORY_SCOPE_AGENT), __ATOMIC_RELAXED, __HIP_MEMORY_SCOPE_AGENT);
      if (st == 2 && atomicAdd(xa, 1) + 1 == 384)
        __hip_atomic_store(xast, __hip_atomic_load(G, __ATOMIC_RELAXED, __HIP_MEMORY_SCOPE_AGENT), __ATOMIC_RELAXED, __HIP_MEMORY_SCOPE_AGENT);
      if (st == 0 && atomicAdd(oa, 1) + 1 == 288)
        __hip_atomic_store(oast, __hip_atomic_load(G, __ATOMIC_RELAXED, __HIP_MEMORY_SCOPE_AGENT), __ATOMIC_RELAXED, __HIP_MEMORY_SCOPE_AGENT);
    }
  }
}

__device__ __forceinline__ void phase_final(KPR p) {
  const int tid = tidx(), wid = tid >> 6, lane = tid & 63;
  const float* X = (const float*)(p.ws + W_X); const float* fn = p.in[I_FN];
  for (int g = blockIdx.x * 8 + wid; g < T; g += gridDim.x * 8) {
    float4 v[4]; float ss = 0.f;
#pragma unroll
    for (int i = 0; i < 4; ++i) { v[i] = *(const float4*)(X + (size_t)g * 1024 + i * 256 + lane * 4); ss += v[i].x * v[i].x + v[i].y * v[i].y + v[i].z * v[i].z + v[i].w * v[i].w; }
    ss = wave_sum(ss);
    float rs = rsqrtf(ss * (1.f / 1024.f) + 1e-6f);
#pragma unroll
    for (int i = 0; i < 4; ++i) {
      float4 gn = *(const float4*)(fn + i * 256 + lane * 4);
      *(float4*)(p.out + OO_Y + (size_t)g * 1024 + i * 256 + lane * 4) = make_float4(v[i].x * rs * gn.x, v[i].y * rs * gn.y, v[i].z * rs * gn.z, v[i].w * rs * gn.w);
    }
  }
}

constexpr int NPL = 6;
constexpr int N_PHASES = 3 + NPL * NL + 1;

__device__ __forceinline__ void run_phase(KPR p, int ph) {
  if (ph == 0) { phase_init(p); return; }
  if (ph == 1) {
    for (int l = 0; l < NL; ++l) {
      const u16* WT = (const u16*)(p.ws + W_WT) + (size_t)l * WE_LAYER;
      gemm_phase((const u16*)(p.ws + W_MB), WT + WE_MK, 1024, 4, 4, (2 * l) * 16,
                 EpiMem<false>{p.out + OO_MKP + (size_t)l * 1048576, (u16*)(p.ws + W_MKP) + (size_t)l * 16 * 65536});
      gemm_phase((const u16*)(p.ws + W_MB), WT + WE_MV, 1024, 4, 4, (2 * l + 1) * 16,
                 EpiMem<true>{p.out + OO_MVP + (size_t)l * 1048576, (u16*)(p.ws + W_MVTP) + (size_t)l * 16 * 65536});
    }
    return;
  }
  if (ph == 2) { phase_chain(p, 0); if (PROBE_REP & 1) { cg::this_grid().sync(); phase_chain(p, 0, 1); } return; }
  if (ph == N_PHASES - 1) { if (PROBE_REP & 64) for (int i = 0; i < 40; ++i) cg::this_grid().sync(); phase_final(p); return; }
  const int l = (ph - 3) / NPL, s = (ph - 3) % NPL;
  const u16* WT = (const u16*)(p.ws + W_WT) + (size_t)l * WE_LAYER;
  switch (s) {
    case 0: phase_prep(p, l); if (PROBE_REP & 2) { cg::this_grid().sync(); phase_prep(p, l); } break;
    case 1:
      gemm_phase((const u16*)(p.ws + W_CQB), WT + WE_Q, 256, 72, 5, 0, EpiQ{(u16*)(p.ws + W_QB), (const float2*)(p.ws + W_ROPE)});
      gemm_phase((const u16*)(p.ws + W_A2), WT + WE_RW, 256, 72, 6, 360,
                 EpiRW{p.in[I_W0] + l * 512, p.in[I_A0] + l * 512, p.in[I_KA] + l * 512, p.ws});
      break;
    case 2: phase_cprep(p); if (PROBE_REP & 8) { cg::this_grid().sync(); phase_cprep(p); } break;
    case 3: phase_mix(p, l, 0); if (PROBE_REP & 16) { cg::this_grid().sync(); phase_mix(p, l, 2); } break;
    case 4: phase_yfin(p, l); if (PROBE_REP & 32) { cg::this_grid().sync(); phase_yfin(p, l); } break;
    default: phase_chain(p, l + 1); if (PROBE_REP & 1) { cg::this_grid().sync(); phase_chain(p, l + 1, 1); } break;
  }
}

__device__ __forceinline__ void grid_barrier(int* CT, int gen) {
  asm volatile("s_waitcnt vmcnt(0)" ::: "memory");
  __syncthreads();
  if (tidx() == 0) {
    __builtin_amdgcn_fence(__ATOMIC_RELEASE, "agent");
    asm volatile("s_waitcnt vmcnt(0)" ::: "memory");
    int* grpc = CT + 15000 + (blockIdx.x & 7) * 32;
    int* glob = CT + 15000 + 8 * 32;
    const int per = gridDim.x >> 3;
    if (atomicAdd(grpc, 1) + 1 == per * (gen + 1)) atomicAdd(glob, 1);
    while (__hip_atomic_load(glob, __ATOMIC_RELAXED, __HIP_MEMORY_SCOPE_AGENT) < 8 * (gen + 1)) __builtin_amdgcn_s_sleep(1);
    __builtin_amdgcn_fence(__ATOMIC_ACQUIRE, "agent");
    asm volatile("s_waitcnt vmcnt(0)" ::: "memory");
  }
  __syncthreads();
}

__global__ void __launch_bounds__(NTHR) mega(Params p) {
  cg::grid_group grid = cg::this_grid();
  for (int ph = p.ph_lo; ph < p.ph_hi; ++ph) {
    const __attribute__((address_space(4))) Params* q = (const __attribute__((address_space(4))) Params*)__builtin_amdgcn_kernarg_segment_ptr();
    asm volatile("" : "+s"(q));
    run_phase(*q, ph);
    if (ph + 1 < p.ph_hi) {
      if (ph == p.ph_lo) grid.sync();
      else grid_barrier((int*)(q->ws + W_CNT), ph - p.ph_lo - 1);
    }
  }
}

extern "C" void kernel_launch(void* const* d_in, const int* in_sizes, int n_in, void* d_out, int out_size, void* d_ws,
                              size_t ws_size, hipStream_t stream) {
  static int grid = 0;
  if (grid == 0) {
    if (n_in != N_IN || (size_t)out_size != OO_END || ws_size < W_END) {
      fprintf(stderr, "kernel_launch: unexpected shapes n_in=%d out=%d ws=%zu (need %zu)\n", n_in, out_size, ws_size, (size_t)W_END);
      grid = -1; return;
    }
    int dev = 0, cus = 0, per_cu = 0;
    hipGetDevice(&dev);
    hipDeviceGetAttribute(&cus, hipDeviceAttributeMultiprocessorCount, dev);
    hipFuncSetAttribute((const void*)mega, hipFuncAttributeMaxDynamicSharedMemorySize, SMEM_BYTES);
    hipOccupancyMaxActiveBlocksPerMultiprocessor(&per_cu, (const void*)mega, NTHR, SMEM_BYTES);
    if (per_cu < 1) { fprintf(stderr, "kernel_launch: occupancy query says %d blocks/CU\n", per_cu); per_cu = 1; }
    (void)hipGetLastError();
    grid = cus;
  }
  if (grid < 0) return;
  if (hipMemsetAsync((char*)d_ws + W_CNT, 0, 65536, stream) != hipSuccess) { fprintf(stderr, "kernel_launch: memset of control words failed\n"); return; }
  Params p{};
  for (int i = 0; i < N_IN; ++i) p.in[i] = (const float*)d_in[i];
  p.out = (float*)d_out; p.ws = (char*)d_ws;
#if N_LAUNCH_PER_PHASE
  for (int ph = 0; ph < N_PHASES; ++ph) {
    p.ph_lo = ph; p.ph_hi = ph + 1;
    void* args[] = {&p};
    hipError_t e = hipLaunchCooperativeKernel((const void*)mega, dim3(grid), dim3(NTHR), args, SMEM_BYTES, stream);
    if (e != hipSuccess) { fprintf(stderr, "launch failed: %s\n", hipGetErrorString(e)); break; }
  }
#else
  p.ph_lo = 0; p.ph_hi = N_PHASES;
  void* args[] = {&p};
  hipError_t e = hipLaunchCooperativeKernel((const void*)mega, dim3(grid), dim3(NTHR), args, SMEM_BYTES, stream);
  if (e != hipSuccess) fprintf(stderr, "cooperative launch failed: %s (grid %d)\n", hipGetErrorString(e), grid);
#endif
}
```

```cpp
#include <hip/hip_runtime.h>
#include <hip/hip_cooperative_groups.h>
#include <stdint.h>
#include <stdio.h>
namespace cg = cooperative_groups;

typedef unsigned short u16;
using bf16x8 = __attribute__((ext_vector_type(8))) short;
using f32x4 = __attribute__((ext_vector_type(4))) float;
using f32x16 = __attribute__((ext_vector_type(16))) float;

#ifndef REP_WHICH
#define REP_WHICH 0
#endif
#ifndef PROBE_REP
#define PROBE_REP 0
#endif
#ifndef PROBE_MASK
#define PROBE_MASK 0x3ff
#endif
#ifndef N_LAUNCH_PER_PHASE
#define N_LAUNCH_PER_PHASE 0
#endif

constexpr int TP = 16384, TS = 2048, T = TP + TS, NL = 4;
constexpr int DFF = 2816, DIN = 2208, DINP = 2304, DSH = 1792;
constexpr int NTHR = 512;
constexpr int SMEM_BYTES = 139264 + 2048;
constexpr int SMEM_ITEM = 139264 + 1024;
constexpr float QSCALE = 0.10206207261596577f * 1.4426950408889634f;
constexpr float XSCALE = 0.0625f * 1.4426950408889634f;

constexpr size_t OO_Y = 0;
constexpr size_t OO_CKVP = OO_Y + (size_t)T * 1024;
constexpr size_t OO_KRP = OO_CKVP + (size_t)NL * 4 * 4096 * 128;
constexpr size_t OO_MKP = OO_KRP + (size_t)NL * 4 * 4096 * 32;
constexpr size_t OO_MVP = OO_MKP + (size_t)NL * 4 * 256 * 1024;
constexpr size_t OO_WKVP = OO_MVP + (size_t)NL * 4 * 256 * 1024;
constexpr size_t OO_SHP = OO_WKVP + (size_t)NL * 4 * 8 * 4096;
constexpr size_t OO_CKVS = OO_SHP + (size_t)NL * 4 * DSH;
constexpr size_t OO_KRS = OO_CKVS + (size_t)NL * 32 * 64 * 128;
constexpr size_t OO_WKVS = OO_KRS + (size_t)NL * 32 * 64 * 32;
constexpr size_t OO_SHS = OO_WKVS + (size_t)NL * 32 * 8 * 4096;
constexpr size_t OO_END = OO_SHS + (size_t)NL * 32 * DSH;

constexpr size_t al256(size_t x) { return (x + 255) & ~(size_t)255; }
constexpr size_t W_X = 0;
constexpr size_t W_XB = W_X + al256((size_t)T * 1024 * 4);
constexpr size_t W_SSQ = W_XB + al256((size_t)T * 1024 * 2);
constexpr size_t W_ACT = W_SSQ + al256((size_t)T * 4 * 4);
constexpr size_t W_WB = W_ACT;
constexpr size_t W_BB = W_WB + al256((size_t)T * 512 * 4);
constexpr size_t W_GB = W_BB + al256((size_t)T * 512 * 4);
constexpr size_t W_QX = W_ACT;
constexpr size_t W_PROJ = W_ACT + al256((size_t)T * DFF * 2);
constexpr size_t W_AO = W_PROJ;
constexpr size_t W_CQB = W_PROJ + al256((size_t)T * DINP * 2);
constexpr size_t W_A2 = W_CQB + al256((size_t)T * 256 * 2);
constexpr size_t W_QB = W_A2 + al256((size_t)T * 256 * 2);
constexpr size_t W_XO = W_QB;
constexpr size_t W_RB = W_QB + al256((size_t)T * 1280 * 2);
constexpr size_t W_KB = W_RB + al256((size_t)T * 512 * 4);
constexpr size_t W_VB = W_KB + al256((size_t)T * 512 * 4);
constexpr size_t W_KKB = W_VB + al256((size_t)T * 512 * 4);
constexpr size_t W_KP = W_KKB + al256((size_t)T * 512 * 4);
constexpr size_t W_KS = W_KP + al256((size_t)4 * 4096 * 160 * 2);
constexpr size_t W_VTP = W_KS + al256((size_t)32 * 2112 * 160 * 2);
constexpr size_t W_VTS = W_VTP + al256((size_t)4 * 128 * 4096 * 2);
constexpr size_t W_MKP = W_VTS + al256((size_t)32 * 128 * 2112 * 2);
constexpr size_t W_MVTP = W_MKP + al256((size_t)NL * 16 * 65536 * 2);
constexpr size_t W_MKS = W_MVTP + al256((size_t)NL * 16 * 65536 * 2);
constexpr size_t W_MVTS = W_MKS + al256((size_t)128 * 65536 * 2);
constexpr size_t W_MB = W_MVTS + al256((size_t)128 * 65536 * 2);
constexpr size_t W_ROPE = W_MB + al256((size_t)1024 * 1024 * 2);
constexpr size_t W_CNT = W_ROPE + al256((size_t)4096 * 16 * 8);
constexpr size_t W_YB = W_CNT + 65536;
constexpr size_t W_CQ = W_YB + al256((size_t)T * 512 * 4);
constexpr size_t W_WT = W_CQ + al256((size_t)2304 * 4096 * 4);
constexpr size_t W_CRR = W_PROJ + al256((size_t)T * 1536 * 2);
constexpr size_t W_CPT = W_CQB;
static_assert(W_CRR + (size_t)2304 * 4096 * 2 <= W_CQB, "RRt must fit behind AO");
static_assert((size_t)2304 * 4096 * 2 <= 2 * al256((size_t)T * 256 * 2), "Pt must fit in CQB+A2");
constexpr size_t WE_GU1 = 0;
constexpr size_t WE_D1 = WE_GU1 + (size_t)5632 * 1024;
constexpr size_t WE_IN = WE_D1 + (size_t)1024 * DFF;
constexpr size_t WE_Q = WE_IN + (size_t)DINP * 1024;
constexpr size_t WE_RW = WE_Q + (size_t)1280 * 256;
constexpr size_t WE_OUT = WE_RW + (size_t)1536 * 256;
constexpr size_t WE_MQ = WE_OUT + (size_t)1024 * 1536;
constexpr size_t WE_MK = WE_MQ + (size_t)1024 * 1024;
constexpr size_t WE_MV = WE_MK + (size_t)1024 * 1024;
constexpr size_t WE_MO = WE_MV + (size_t)1024 * 1024;
constexpr size_t WE_GU2 = WE_MO + (size_t)1024 * 1024;
constexpr size_t WE_D2 = WE_GU2 + (size_t)5632 * 1024;
constexpr size_t WE_LAYER = WE_D2 + (size_t)1024 * DFF;
constexpr size_t W_END = W_WT + al256(WE_LAYER * NL * 2);

enum { I_XP = 0, I_XS, I_MEMP, I_CCKV, I_CKR, I_CMK, I_CMV, I_SWKV, I_SSH, I_F1N, I_F1G, I_F1U, I_F1D, I_MIXN, I_WIN,
       I_QN, I_WUQ, I_KVN, I_WUK, I_WUV, I_MU, I_W0, I_WUP, I_A0, I_AUP, I_GUP, I_KK, I_KA, I_RK, I_GNG, I_GNB, I_WOUT,
       I_XN, I_MKVN, I_WMQ, I_WMK, I_WMV, I_WMO, I_F2N, I_F2G, I_F2U, I_F2D, I_FN, N_IN };

struct Params {
  const float* in[N_IN];
  float* out;
  char* ws;
  int ph_lo, ph_hi;
};

typedef const __attribute__((address_space(4))) Params& KPR;

typedef __bf16 bf2_t __attribute__((ext_vector_type(2)));
typedef float f2_t __attribute__((ext_vector_type(2)));
__device__ __forceinline__ u16 f2bf(float f) { __bf16 b = (__bf16)f; return __builtin_bit_cast(u16, b); }
__device__ __forceinline__ float bf2f(u16 h) { return __uint_as_float(((unsigned)h) << 16); }
__device__ __forceinline__ unsigned pack2(float a, float b) { f2_t v = {a, b}; bf2_t r = __builtin_convertvector(v, bf2_t); return __builtin_bit_cast(unsigned, r); }
__device__ __forceinline__ float wave_sum(float x) {
#pragma unroll
  for (int o = 32; o; o >>= 1) x += __shfl_xor(x, o);
  return x;
}
__device__ __forceinline__ float dpp_sum8(float x) {
  x += __int_as_float(__builtin_amdgcn_update_dpp(0, __float_as_int(x), 0xB1, 0xF, 0xF, false));
  x += __int_as_float(__builtin_amdgcn_update_dpp(0, __float_as_int(x), 0x4E, 0xF, 0xF, false));
  x += __int_as_float(__builtin_amdgcn_update_dpp(0, __float_as_int(x), 0x141, 0xF, 0xF, false));
  return x;
}
__device__ __forceinline__ int tidx() { int t = threadIdx.x; asm volatile("" : "+v"(t)); return t; }
__device__ __forceinline__ float fma_s(float a, float b, float c) { float d; asm("v_fma_f32 %0, %1, %2, %3" : "=v"(d) : "v"(a), "v"(b), "v"(c)); return d; }
__device__ __forceinline__ float sub_s(float a, float b) { float d; asm("v_sub_f32 %0, %1, %2" : "=v"(d) : "v"(a), "v"(b)); return d; }
__device__ __forceinline__ float add_s(float a, float b) { float d; asm("v_add_f32 %0, %1, %2" : "=v"(d) : "v"(a), "v"(b)); return d; }
__device__ __forceinline__ float mul_s(float a, float b) { float d; asm("v_mul_f32 %0, %1, %2" : "=v"(d) : "v"(a), "v"(b)); return d; }
__device__ __forceinline__ float sigmoidf_(float x) { return 1.f / (1.f + __expf(-x)); }

constexpr int BM = 256, BK = 64, HALF = 128, HT = HALF * BK;

__device__ __forceinline__ int lds_byte(int r, int c) {
  int st = (r >> 4) * 2 + (c >> 5), rr = r & 15, cc = c & 31, ob = rr * 64 + cc * 2;
  return st * 1024 + (ob ^ (((ob >> 9) & 1) << 5));
}
__device__ __forceinline__ void stage_rc(int b, int& R, int& C) {
  int st = b / 1024, sb = b % 1024, swz = sb ^ (((sb >> 9) & 1) << 5);
  R = (st >> 1) * 16 + swz / 64; C = (st & 1) * 32 + (swz % 64) / 2;
}

__device__ __forceinline__ void tile_map(int tile, int nM, int nN, int& pm, int& pn) {
  const int ntiles = nM * nN;
  int wgid = tile;
  { int q = ntiles / 8, r = ntiles % 8, xcd = wgid % 8, off = wgid / 8;
    wgid = (xcd < r ? xcd * (q + 1) : r * (q + 1) + (xcd - r) * q) + off; }
  int nig = 8 * nN, gid = wgid / nig, fm = gid * 8, gsz = min(nM - fm, 8);
  pm = fm + ((wgid % nig) % gsz); pn = (wgid % nig) / gsz;
}

template <class Epi>
__device__ __forceinline__ void gemm_tile(const u16* __restrict__ A, const u16* __restrict__ Bt, const int K,
                                          const int pm, const int pn, Epi epi) {
  extern __shared__ __attribute__((aligned(16))) char smem[];
  u16* shm = (u16*)smem;
#define SA(b, h) (shm + ((b) * 2 + (h)) * HT)
#define SB(b, h) (shm + (4 + (b) * 2 + (h)) * HT)
#define STAGE(P, BASE, br, kt) do { const u16* _gb = BASE + ((long)(br) * K + (long)(kt) * BK); \
    __builtin_amdgcn_global_load_lds((const unsigned*)((const char*)_gb + so0), \
        (__attribute__((address_space(3))) unsigned*)((char*)(P) + wu16), 16, 0, 0); \
    __builtin_amdgcn_global_load_lds((const unsigned*)((const char*)_gb + so1), \
        (__attribute__((address_space(3))) unsigned*)((char*)(P) + wu16 + 8192), 16, 0, 0); } while (0)
#define LDA(dst, b, h) for (int m = 0; m < 4; ++m) for (int k = 0; k < 2; ++k) \
    dst[m][k] = *reinterpret_cast<const bf16x8*>((char*)SA(b, h) + lds_byte(wr * 64 + m * 16 + fr, k * 32 + fq * 8))
#define LDB(dst, b, h) for (int n = 0; n < 2; ++n) for (int k = 0; k < 2; ++k) \
    dst[n][k] = *reinterpret_cast<const bf16x8*>((char*)SB(b, h) + lds_byte(wc * 32 + n * 16 + fr, k * 32 + fq * 8))
#define MMA(ai, bj, At_, Bt_) do { __builtin_amdgcn_s_setprio(1); \
    for (int m = 0; m < 4; ++m) for (int n = 0; n < 2; ++n) for (int k = 0; k < 2; ++k) \
      acc[ai][bj][m][n] = __builtin_amdgcn_mfma_f32_16x16x32_bf16(At_[m][k], Bt_[n][k], acc[ai][bj][m][n], 0, 0, 0); \
    __builtin_amdgcn_s_setprio(0); } while (0)
#define WAIT_V(n) asm volatile("s_waitcnt vmcnt(" #n ")" ::: "memory")
#define WAIT_L(n) asm volatile("s_waitcnt lgkmcnt(" #n ")" ::: "memory")
#define BAR __builtin_amdgcn_s_barrier()
#define SCHED __builtin_amdgcn_sched_barrier(0)
  const int tid_ = tidx();
  const int wid = tid_ >> 6, lane = tid_ & 63, wr = wid >> 2, wc = wid & 3, fr = lane & 15, fq = lane >> 4;
  const int nt = K / BK;
  const int wu16 = __builtin_amdgcn_readfirstlane(tid_ >> 6) * 1024;
  {
    unsigned so0, so1;
    { int _r, _c; stage_rc(tid_ * 16, _r, _c); so0 = (unsigned)(_r * K + _c) * 2u;
      stage_rc(tid_ * 16 + 8192, _r, _c); so1 = (unsigned)(_r * K + _c) * 2u; }
    const int brow = pm * BM, bcol = pn * BM;
    f32x4 acc[2][2][4][2] = {};
    bf16x8 At[4][2], B0[2][2], B1[2][2];
    STAGE(SB(0, 0), Bt, bcol, 0); STAGE(SA(0, 0), A, brow, 0);
    STAGE(SB(0, 1), Bt, bcol + HALF, 0); STAGE(SA(0, 1), A, brow + HALF, 0);
    if (wr == 1) BAR;
    WAIT_V(4); BAR;
    STAGE(SB(1, 0), Bt, bcol, 1); STAGE(SA(1, 0), A, brow, 1); STAGE(SB(1, 1), Bt, bcol + HALF, 1);
    WAIT_V(6); BAR;
    for (int t = 0; t < nt - 2; t += 2) {
      LDB(B0, 0, 0); SCHED; LDA(At, 0, 0); STAGE(SA(1, 1), A, brow + HALF, t + 1);
      WAIT_L(8); BAR; WAIT_L(0); MMA(0, 0, At, B0); BAR; SCHED;
      LDB(B1, 0, 1); STAGE(SB(0, 0), Bt, bcol, t + 2);
      BAR; WAIT_L(0); MMA(0, 1, At, B1); BAR;
      LDA(At, 0, 1); STAGE(SA(0, 0), A, brow, t + 2);
      BAR; WAIT_L(0); MMA(1, 0, At, B0); BAR; SCHED;
      STAGE(SB(0, 1), Bt, bcol + HALF, t + 2);
      WAIT_V(6); BAR; MMA(1, 1, At, B1); BAR;
      LDB(B0, 1, 0); SCHED; LDA(At, 1, 0); STAGE(SA(0, 1), A, brow + HALF, t + 2);
      WAIT_L(8); BAR; WAIT_L(0); MMA(0, 0, At, B0); BAR; SCHED;
      LDB(B1, 1, 1); STAGE(SB(1, 0), Bt, bcol, t + 3);
      BAR; WAIT_L(0); MMA(0, 1, At, B1); BAR;
      LDA(At, 1, 1); STAGE(SA(1, 0), A, brow, t + 3);
      BAR; WAIT_L(0); MMA(1, 0, At, B0); BAR; SCHED;
      STAGE(SB(1, 1), Bt, bcol + HALF, t + 3);
      WAIT_V(6); BAR; MMA(1, 1, At, B1); BAR;
    }
    { LDB(B0, 0, 0); LDA(At, 0, 0); STAGE(SA(1, 1), A, brow + HALF, nt - 1);
      BAR; WAIT_L(0); MMA(0, 0, At, B0); BAR;
      LDB(B1, 0, 1); BAR; WAIT_L(0); MMA(0, 1, At, B1); BAR;
      LDA(At, 0, 1); WAIT_V(4); BAR; WAIT_L(0); MMA(1, 0, At, B0); MMA(1, 1, At, B1); BAR; }
    { LDB(B0, 1, 0); LDA(At, 1, 0); WAIT_V(2); BAR; WAIT_L(0); MMA(0, 0, At, B0); BAR;
      LDB(B1, 1, 1); WAIT_V(0); BAR; WAIT_L(0); MMA(0, 1, At, B1); BAR;
      LDA(At, 1, 1); BAR; WAIT_L(0); MMA(1, 0, At, B0); MMA(1, 1, At, B1); BAR; }
    if (wr == 0) BAR;
    float* stg = (float*)smem;
    int tx = tid_;
    asm volatile("" : "+v"(tx));
    const int ewr = tx >> 8, ewc = (tx >> 6) & 3, efr = tx & 15, efq = (tx >> 4) & 3;
#define EPI_HALF(ai) do { \
    __syncthreads(); \
    _Pragma("unroll") for (int bj = 0; bj < 2; ++bj) _Pragma("unroll") for (int m = 0; m < 4; ++m) \
    _Pragma("unroll") for (int n = 0; n < 2; ++n) _Pragma("unroll") for (int j = 0; j < 4; ++j) \
      stg[(ewr * 64 + m * 16 + efq * 4 + j) * 260 + bj * HALF + ewc * 32 + n * 16 + efr] = acc[ai][bj][m][n][j]; \
    __syncthreads(); \
    for (int i = 0; i < 8; ++i) { \
      int item = i * NTHR + tx; int rl = item >> 5, qp = item & 31; \
      int cl = (qp >> 2) * 32 + (qp & 3) * 4; \
      float4 v0 = *(const float4*)(stg + rl * 260 + cl), v1 = *(const float4*)(stg + rl * 260 + cl + 16); \
      int row = brow + ai * HALF + rl; \
      float ss = epi.apply4(row, bcol + cl, v0, v1); \
      if (Epi::kSsq) { \
        ss += __shfl_xor(ss, 1); ss += __shfl_xor(ss, 2); ss += __shfl_xor(ss, 4); ss += __shfl_xor(ss, 8); ss += __shfl_xor(ss, 16); \
        if (qp == 0) epi.ssq_out(row, pn, ss); \
      } \
    } } while (0)
    EPI_HALF(0);
    EPI_HALF(1);
#undef EPI_HALF
    __syncthreads();
  }
#undef SA
#undef SB
#undef STAGE
#undef LDA
#undef LDB
#undef MMA
}

template <class Epi>
__device__ __forceinline__ void gemm_phase(const u16* __restrict__ A, const u16* __restrict__ Bt, const int K,
                                           const int nM, const int nN, const int rot, Epi epi) {
  const int G = gridDim.x;
  for (int tile = (int)((blockIdx.x + G - (rot % G)) % G); tile < nM * nN; tile += G) {
    int pm, pn; tile_map(tile, nM, nN, pm, pn);
    gemm_tile(A, Bt, K, pm, pn, epi);
  }
}

__device__ __forceinline__ float rstd_from_ssq(const float* ssq, int row) {
  float4 s = *(const float4*)(ssq + (size_t)row * 4);
  return rsqrtf((s.x + s.y + s.z + s.w) * (1.f / 1024.f) + 1e-6f);
}
__device__ __forceinline__ uint2 pack4(float4 v) { uint2 w; w.x = pack2(v.x, v.y); w.y = pack2(v.z, v.w); return w; }
__device__ __forceinline__ float silu_mul(float g, float u) { return g / (1.f + __expf(-g)) * u; }
struct EpiGU {
  static constexpr bool kSsq = false;
  const float* ssq; u16* act;
  __device__ __forceinline__ float apply4(int row, int c0, float4 g, float4 u) const {
    float rs = rstd_from_ssq(ssq, row);
    float4 o = make_float4(silu_mul(g.x * rs, u.x * rs), silu_mul(g.y * rs, u.y * rs), silu_mul(g.z * rs, u.z * rs), silu_mul(g.w * rs, u.w * rs));
    *(uint2*)(act + (size_t)row * DFF + ((c0 & ~31) >> 1) + (c0 & 15)) = pack4(o);
    return 0.f;
  }
  __device__ __forceinline__ void ssq_out(int, int, float) const {}
};
struct EpiRes {
  static constexpr bool kSsq = true;
  float* x; u16* xb; float* ssq; float coef;
  __device__ __forceinline__ float apply4(int row, int c0, float4 v0, float4 v1) const {
    size_t i = (size_t)row * 1024 + c0;
    float4 a = *(const float4*)(x + i), b = *(const float4*)(x + i + 16);
    a.x += coef * v0.x; a.y += coef * v0.y; a.z += coef * v0.z; a.w += coef * v0.w;
    b.x += coef * v1.x; b.y += coef * v1.y; b.z += coef * v1.z; b.w += coef * v1.w;
    *(float4*)(x + i) = a; *(float4*)(x + i + 16) = b;
    *(uint2*)(xb + i) = pack4(a); *(uint2*)(xb + i + 16) = pack4(b);
    return a.x * a.x + a.y * a.y + a.z * a.z + a.w * a.w + b.x * b.x + b.y * b.y + b.z * b.z + b.w * b.w;
  }
  __device__ __forceinline__ void ssq_out(int row, int pn, float v) const { ssq[(size_t)row * 4 + pn] = v; }
};
struct EpiScaleBf {
  static constexpr bool kSsq = false;
  const float* ssq; u16* o; int ld;
  __device__ __forceinline__ float apply4(int row, int c0, float4 v0, float4 v1) const {
    float rs = rstd_from_ssq(ssq, row);
    size_t i = (size_t)row * ld + c0;
    *(uint2*)(o + i) = pack4(make_float4(v0.x * rs, v0.y * rs, v0.z * rs, v0.w * rs));
    *(uint2*)(o + i + 16) = pack4(make_float4(v1.x * rs, v1.y * rs, v1.z * rs, v1.w * rs));
    return 0.f;
  }
  __device__ __forceinline__ void ssq_out(int, int, float) const {}
};
struct EpiQ {
  static constexpr bool kSsq = false;
  u16* qb; const float2* rope;
  __device__ __forceinline__ float apply4(int row, int c0, float4 v0, float4 v1) const {
    if (c0 < 1024) {
      size_t i = (size_t)row * 1280 + (c0 >> 7) * 160 + (c0 & 127);
      *(uint2*)(qb + i) = pack4(v0); *(uint2*)(qb + i + 16) = pack4(v1);
    } else {
      int h = (c0 - 1024) >> 5, f0 = c0 & 15;
      int pos = row < TP ? (row & 4095) : (2048 + ((row - TP) & 63));
      const float2* cs = rope + pos * 16 + f0;
      float2 c_0 = cs[0], c_1 = cs[1], c_2 = cs[2], c_3 = cs[3];
      size_t i = (size_t)row * 1280 + h * 160 + 128 + f0;
      *(uint2*)(qb + i) = pack4(make_float4(v0.x * c_0.x - v1.x * c_0.y, v0.y * c_1.x - v1.y * c_1.y, v0.z * c_2.x - v1.z * c_2.y, v0.w * c_3.x - v1.w * c_3.y));
      *(uint2*)(qb + i + 16) = pack4(make_float4(v0.x * c_0.y + v1.x * c_0.x, v0.y * c_1.y + v1.y * c_1.x, v0.z * c_2.y + v1.z * c_2.x, v0.w * c_3.y + v1.w * c_3.x));
    }
    return 0.f;
  }
  __device__ __forceinline__ void ssq_out(int, int, float) const {}
};
__device__ __forceinline__ float decay_f(float z) {
  float nz = -z;
  float sp = fmaxf(nz, 0.f) + __logf(1.f + __expf(-fabsf(nz)));
  return __expf(-__expf(-sp - 0.5f));
}
struct EpiRW {
  static constexpr bool kSsq = false;
  const float* w0; const float* a0; const float* ka; char* ws;
  __device__ __forceinline__ void acol(size_t i, int c, float4 v) const {
    float* bb = (float*)(ws + W_BB); float* kb = (float*)(ws + W_KB); const float* kkb = (const float*)(ws + W_KKB);
    float4 a_0 = *(const float4*)(a0 + c), k_a = *(const float4*)(ka + c), kk = *(const float4*)(kkb + i), k = *(const float4*)(kb + i);
    float4 a = make_float4(sigmoidf_(a_0.x + v.x), sigmoidf_(a_0.y + v.y), sigmoidf_(a_0.z + v.z), sigmoidf_(a_0.w + v.w));
    *(float4*)(bb + i) = make_float4(kk.x * a.x, kk.y * a.y, kk.z * a.z, kk.w * a.w);
    *(float4*)(kb + i) = make_float4(k.x * (1.f + (a.x - 1.f) * k_a.x), k.y * (1.f + (a.y - 1.f) * k_a.y), k.z * (1.f + (a.z - 1.f) * k_a.z), k.w * (1.f + (a.w - 1.f) * k_a.w));
  }
  __device__ __forceinline__ float apply4(int row, int c0, float4 v0, float4 v1) const {
    if (c0 < 512) {
      float* wb = (float*)(ws + W_WB);
      float4 z0 = *(const float4*)(w0 + c0), z1 = *(const float4*)(w0 + c0 + 16);
      size_t i = (size_t)row * 512 + c0;
      *(float4*)(wb + i) = make_float4(decay_f(z0.x + v0.x), decay_f(z0.y + v0.y), decay_f(z0.z + v0.z), decay_f(z0.w + v0.w));
      *(float4*)(wb + i + 16) = make_float4(decay_f(z1.x + v1.x), decay_f(z1.y + v1.y), decay_f(z1.z + v1.z), decay_f(z1.w + v1.w));
    } else if (c0 < 1024) {
      int c = c0 - 512; size_t i = (size_t)row * 512 + c;
      acol(i, c, v0); acol(i + 16, c + 16, v1);
    } else {
      u16* gb = (u16*)(ws + W_GB);
      size_t i = (size_t)row * 512 + (c0 - 1024);
      *(uint2*)(gb + i) = pack4(v0); *(uint2*)(gb + i + 16) = pack4(v1);
    }
    return 0.f;
  }
  __device__ __forceinline__ void ssq_out(int, int, float) const {}
};
template <bool ISV>
struct EpiMem {
  static constexpr bool kSsq = false;
  float* of; u16* ob;
  __device__ __forceinline__ void quad(int row, int col, float4 v) const {
    *(float4*)(of + (size_t)row * 1024 + col) = v;
    int b = row >> 8, m = row & 255, h = col >> 8, d = col & 255;
    if (ISV) {
      u16* o = ob + (size_t)((b * 4 + h) * 256 + d) * 256 + m;
      o[0] = f2bf(v.x); o[256] = f2bf(v.y); o[512] = f2bf(v.z); o[768] = f2bf(v.w);
    } else {
      *(uint2*)(ob + (size_t)((b * 4 + h) * 256 + m) * 256 + d) = pack4(v);
    }
  }
  __device__ __forceinline__ float apply4(int row, int c0, float4 v0, float4 v1) const {
    quad(row, c0, v0); quad(row, c0 + 16, v1);
    return 0.f;
  }
  __device__ __forceinline__ void ssq_out(int, int, float) const {}
};

template <class F>
__device__ __forceinline__ void tconv(u16* dst, int ldd, int N, int K, int rot, F f) {
  extern __shared__ __attribute__((aligned(16))) char smem[];
  float* t = (float*)smem;
  const int nk = K / 64, nt = (N / 64) * nk, G = gridDim.x;
  const int tid = tidx(), a = tid >> 6, c = tid & 63;
  for (int tile = (int)((blockIdx.x + G - (rot % G)) % G); tile < nt; tile += G) {
    int n0 = (tile / nk) * 64, k0 = (tile % nk) * 64;
    __syncthreads();
#pragma unroll
    for (int i = 0; i < 8; ++i) { int kk = a + 8 * i; t[kk * 65 + c] = f(k0 + kk, n0 + c); }
    __syncthreads();
#pragma unroll
    for (int i = 0; i < 2; ++i) {
      const int nn = (tid >> 4) + 32 * i, kq = (tid & 15) * 4;
      uint2 w; w.x = pack2(t[kq * 65 + nn], t[(kq + 1) * 65 + nn]); w.y = pack2(t[(kq + 2) * 65 + nn], t[(kq + 3) * 65 + nn]);
      *(uint2*)(dst + (size_t)(n0 + nn) * ldd + k0 + kq) = w;
    }
  }
}

template <class F>
__device__ __forceinline__ void tconv_v(u16* dst, int ldd, int N, int K, int vb, int nvb, F f) {
  extern __shared__ __attribute__((aligned(16))) char smem[];
  float* t = (float*)smem;
  const int nk = K / 64, nt = (N / 64) * nk;
  const int tid = tidx(), a = tid >> 6, c = tid & 63;
  for (int tile = vb; tile < nt; tile += nvb) {
    int n0 = (tile / nk) * 64, k0 = (tile % nk) * 64;
    __syncthreads();
#pragma unroll
    for (int i = 0; i < 8; ++i) { int kk = a + 8 * i; t[kk * 65 + c] = f(k0 + kk, n0 + c); }
    __syncthreads();
#pragma unroll
    for (int i = 0; i < 2; ++i) {
      const int nn = (tid >> 4) + 32 * i, kq = (tid & 15) * 4;
      uint2 w; w.x = pack2(t[kq * 65 + nn], t[(kq + 1) * 65 + nn]); w.y = pack2(t[(kq + 2) * 65 + nn], t[(kq + 3) * 65 + nn]);
      *(uint2*)(dst + (size_t)(n0 + nn) * ldd + k0 + kq) = w;
    }
  }
  __syncthreads();
}

template <int DK, int DV, int RPG>
__device__ __forceinline__ void attn_item(const u16* __restrict__ Qb, int ldq, int nrows, const u16* __restrict__ Kb, int ldk,
                                          const u16* __restrict__ Vtb, int ldvt, int nkeys, u16* __restrict__ Ob, int ldo) {
  extern __shared__ __attribute__((aligned(16))) char smem[];
  constexpr int KS = DK + 8, VS = 68;
  u16* sK = (u16*)smem;
  u16* sV = sK + 64 * KS;
  const int tid = tidx(), wid = tid >> 6, lane = tid & 63, q = lane & 31, hh = lane >> 5;
  const int row = wid * 32 + q;
  const bool active = (wid * 32) < nrows;
  bf16x8 qf[DK / 16];
  if (active) {
#pragma unroll
    for (int ks = 0; ks < DK / 16; ++ks) qf[ks] = *(const bf16x8*)(Qb + (size_t)row * ldq + ks * 16 + hh * 8);
  }
  f32x16 o[DV / 32];
#pragma unroll
  for (int dt = 0; dt < DV / 32; ++dt)
#pragma unroll
    for (int i = 0; i < 16; ++i) o[dt][i] = 0.f;
  float mrun = -1e30f, lrun = 0.f;
  const int nkt = nkeys >> 6;
  constexpr int KCH = (64 * (DK / 8) + NTHR - 1) / NTHR;
  static_assert(DV == 128 && KCH <= 4, "staging registers are written out by hand");
  uint4 kr0, kr1, kr2, kr3, vr0, vr1;
#define AT_KL(N_, kt_) { const int c = tid + N_ * NTHR; if (N_ < KCH && c < 64 * (DK / 8)) { const int r = c / (DK / 8), cc = c % (DK / 8); \
      kr##N_ = *(const uint4*)(Kb + (size_t)((kt_) * 64 + r) * ldk + cc * 8); } }
#define AT_VL(N_, kt_) { const int c = tid + N_ * NTHR; const int r = c >> 3, cc = c & 7; vr##N_ = *(const uint4*)(Vtb + (size_t)r * ldvt + (kt_) * 64 + cc * 8); }
#define AT_GLOAD(kt_) do { AT_KL(0, kt_) AT_KL(1, kt_) AT_KL(2, kt_) AT_KL(3, kt_) AT_VL(0, kt_) AT_VL(1, kt_) } while (0)
#define AT_KS(N_) { const int c = tid + N_ * NTHR; if (N_ < KCH && c < 64 * (DK / 8)) { const int r = c / (DK / 8), cc = c % (DK / 8); *(uint4*)(sK + r * KS + cc * 8) = kr##N_; } }
#define AT_VS(N_) { const int c = tid + N_ * NTHR; const int r = c >> 3, cc = c & 7; uint2* d = (uint2*)(sV + r * VS + cc * 8); \
      const uint4 t_ = vr##N_; d[0] = make_uint2(t_.x, t_.y); d[1] = make_uint2(t_.z, t_.w); }
  AT_GLOAD(0);
  for (int kt = 0; kt < nkt; ++kt) {
    __syncthreads();
    AT_KS(0) AT_KS(1) AT_KS(2) AT_KS(3) AT_VS(0) AT_VS(1)
    __syncthreads();
    if (kt + 1 < nkt) AT_GLOAD(kt + 1);
    if (active) {
      f32x16 s0, s1;
#pragma unroll
      for (int i = 0; i < 16; ++i) { s0[i] = 0.f; s1[i] = 0.f; }
#pragma unroll
      for (int ks = 0; ks < DK / 16; ++ks) {
        bf16x8 a0 = *(const bf16x8*)(sK + q * KS + ks * 16 + hh * 8);
        bf16x8 a1 = *(const bf16x8*)(sK + (32 + q) * KS + ks * 16 + hh * 8);
        s0 = __builtin_amdgcn_mfma_f32_32x32x16_bf16(a0, qf[ks], s0, 0, 0, 0);
        s1 = __builtin_amdgcn_mfma_f32_32x32x16_bf16(a1, qf[ks], s1, 0, 0, 0);
      }
      float mx = s0[0];
#pragma unroll
      for (int i = 1; i < 16; ++i) mx = fmaxf(mx, s0[i]);
#pragma unroll
      for (int i = 0; i < 16; ++i) mx = fmaxf(mx, s1[i]);
      mx = fmaxf(mx, __shfl_xor(mx, 32));
      float mn = fmaxf(mrun, mx);
      float alpha = __builtin_amdgcn_exp2f(mrun - mn);
      mrun = mn;
      float ps = 0.f;
#pragma unroll
      for (int i = 0; i < 16; ++i) { s0[i] = __builtin_amdgcn_exp2f(sub_s(s0[i], mn)); ps = add_s(ps, s0[i]); }
#pragma unroll
      for (int i = 0; i < 16; ++i) { s1[i] = __builtin_amdgcn_exp2f(sub_s(s1[i], mn)); ps = add_s(ps, s1[i]); }
      lrun = lrun * alpha + ps;
#pragma unroll
      for (int dt = 0; dt < DV / 32; ++dt)
#pragma unroll
        for (int i = 0; i < 16; ++i) o[dt][i] = mul_s(o[dt][i], alpha);
#pragma unroll
      for (int kb = 0; kb < 2; ++kb)
#pragma unroll
        for (int s = 0; s < 2; ++s) {
          union { bf16x8 v; unsigned u[4]; } pf;
#pragma unroll
          for (int jj = 0; jj < 4; ++jj) {
            float e0 = kb ? s1[8 * s + 2 * jj] : s0[8 * s + 2 * jj];
            float e1 = kb ? s1[8 * s + 2 * jj + 1] : s0[8 * s + 2 * jj + 1];
            pf.u[jj] = pack2(e0, e1);
          }
          const int kbase = kb * 32 + s * 16 + 4 * hh;
#pragma unroll
          for (int dt = 0; dt < DV / 32; ++dt) {
            const u16* vp = sV + (dt * 32 + q) * VS + kbase;
            union { bf16x8 v; uint2 u[2]; } vf;
            vf.u[0] = *(const uint2*)vp; vf.u[1] = *(const uint2*)(vp + 8);
            o[dt] = __builtin_amdgcn_mfma_f32_32x32x16_bf16(vf.v, pf.v, o[dt], 0, 0, 0);
          }
        }
    }
  }
  if (active) {
    lrun += __shfl_xor(lrun, 32);
    float inv = 1.f / lrun;
    u16* op = Ob + (size_t)(row / RPG) * ldo + (size_t)(row % RPG) * DV;
#pragma unroll
    for (int dt = 0; dt < DV / 32; ++dt)
#pragma unroll
      for (int g = 0; g < 4; ++g) {
        uint2 w;
        w.x = pack2(o[dt][4 * g] * inv, o[dt][4 * g + 1] * inv);
        w.y = pack2(o[dt][4 * g + 2] * inv, o[dt][4 * g + 3] * inv);
        *(uint2*)(op + dt * 32 + 8 * g + 4 * hh) = w;
      }
  }
}

#undef AT_GLOAD
#undef AT_KL
#undef AT_VL
#undef AT_KS
#undef AT_VS
__device__ __forceinline__ float dpp_sum16(float x) {
  x += __int_as_float(__builtin_amdgcn_update_dpp(0, __float_as_int(x), 0xB1, 0xF, 0xF, false));
  x += __int_as_float(__builtin_amdgcn_update_dpp(0, __float_as_int(x), 0x4E, 0xF, 0xF, false));
  x += __int_as_float(__builtin_amdgcn_update_dpp(0, __float_as_int(x), 0x141, 0xF, 0xF, false));
  x += __int_as_float(__builtin_amdgcn_update_dpp(0, __float_as_int(x), 0x140, 0xF, 0xF, false));
  return x;
}
__device__ __forceinline__ void scan_item(KPR p, int l, int g0, int h, int half, int nsteps, const float* S0, float* Sout) {
  extern __shared__ __attribute__((aligned(16))) char smem[];
  float* sT = (float*)smem;
  float* sV = sT + 5 * 4096;
  const float* src0 = (const float*)(p.ws + W_RB) + h * 64; const float* src1 = (const float*)(p.ws + W_WB) + h * 64;
  const float* src2 = (const float*)(p.ws + W_KB) + h * 64; const float* src3 = (const float*)(p.ws + W_KKB) + h * 64;
  const float* src4 = (const float*)(p.ws + W_BB) + h * 64;
  const float* VB = (const float*)(p.ws + W_VB) + h * 64 + half * 32;
  float* YB = (float*)(p.ws + W_YB) + h * 64 + half * 32;
  const int tid = tidx();
  const int il = tid >> 4, sub = tid & 15, j0 = sub * 4, i = half * 32 + il;
  float s[4];
#pragma unroll
  for (int j = 0; j < 4; ++j) s[j] = S0 ? S0[i * 64 + j0 + j] : 0.f;
  float4 pa0, pa1, pa2, pa3, pa4, pb0, pb1, pb2, pb3, pb4, pfv;
  const int e0 = tid, e1 = tid + NTHR;
  const int st0 = e0 >> 4, c40 = (e0 & 15) * 4, st1 = e1 >> 4, c41 = (e1 & 15) * 4;
  const int stv = tid >> 3, c4v = (tid & 7) * 4;
#define SC_GL1(x, c0_) pa##x = *(const float4*)(src##x + (size_t)(g0 + (c0_) + st0) * 512 + c40); \
                       pb##x = *(const float4*)(src##x + (size_t)(g0 + (c0_) + st1) * 512 + c41);
#define SC_GLOAD(c0_) do { SC_GL1(0, c0_) SC_GL1(1, c0_) SC_GL1(2, c0_) SC_GL1(3, c0_) SC_GL1(4, c0_) \
    pfv = *(const float4*)(VB + (size_t)(g0 + (c0_) + stv) * 512 + c4v); } while (0)
#define SC_ST1(x) *(float4*)(sT + x * 4096 + st0 * 64 + c40) = pa##x; *(float4*)(sT + x * 4096 + st1 * 64 + c41) = pb##x;
  SC_GLOAD(0);
  for (int c0 = 0; c0 < nsteps; c0 += 64) {
    __syncthreads();
    SC_ST1(0) SC_ST1(1) SC_ST1(2) SC_ST1(3) SC_ST1(4)
    *(float4*)(sV + stv * 32 + c4v) = pfv;
    __syncthreads();
    if (c0 + 64 < nsteps) SC_GLOAD(c0 + 64);
#define SC_LD(S, st_) do { const int _s = (st_) < 64 ? (st_) : 63; \
      S##r = *(const float4*)(sT + _s * 64 + j0); S##w = *(const float4*)(sT + 4096 + _s * 64 + j0); \
      S##k = *(const float4*)(sT + 8192 + _s * 64 + j0); S##q = *(const float4*)(sT + 12288 + _s * 64 + j0); \
      S##b = *(const float4*)(sT + 16384 + _s * 64 + j0); S##v = sV[_s * 32 + il]; } while (0)
#define SC_STEP(S, st_) do { \
      float sa = -dpp_sum16(fma_s(s[1], S##q.y, mul_s(s[0], S##q.x)) + fma_s(s[3], S##q.w, mul_s(s[2], S##q.z))); \
      s[0] = fma_s(sa, S##b.x, fma_s(s[0], S##w.x, mul_s(S##v, S##k.x))); \
      s[1] = fma_s(sa, S##b.y, fma_s(s[1], S##w.y, mul_s(S##v, S##k.y))); \
      s[2] = fma_s(sa, S##b.z, fma_s(s[2], S##w.z, mul_s(S##v, S##k.z))); \
      s[3] = fma_s(sa, S##b.w, fma_s(s[3], S##w.w, mul_s(S##v, S##k.w))); \
      float y = dpp_sum16(fma_s(s[1], S##r.y, mul_s(s[0], S##r.x)) + fma_s(s[3], S##r.w, mul_s(s[2], S##r.z))); \
      ykeep = (sub == ((st_) & 15)) ? y : ykeep; } while (0)
    float4 Ar, Aw, Ak, Aq, Ab, Br, Bw, Bk, Bq, Bb, Cr, Cw, Ck, Cq, Cb, Dr, Dw, Dk, Dq, Db;
    float Av, Bv, Cv, Dv, ykeep = 0.f;
    SC_LD(A, 0); SC_LD(B, 1); SC_LD(C, 2);
    for (int st = 0; st < 64; st += 4) {
      SC_LD(D, st + 3); SC_STEP(A, st);
      SC_LD(A, st + 4); SC_STEP(B, st + 1);
      SC_LD(B, st + 5); SC_STEP(C, st + 2);
      SC_LD(C, st + 6); SC_STEP(D, st + 3);
      if ((st & 15) == 12) YB[(size_t)(g0 + c0 + (st - 12) + sub) * 512 + il] = ykeep;
    }
  }
#undef SC_LD
#undef SC_STEP
#undef SC_GLOAD
#undef SC_GL1
#undef SC_ST1
  *(float4*)(Sout + i * 64 + j0) = make_float4(s[0], s[1], s[2], s[3]);
}

constexpr int LS = 68;
constexpr int LBUF = 64 * LS;
constexpr int LH = 72;

__device__ __forceinline__ void split8(const float* x, bf16x8& hi, bf16x8& lo) {
  union { bf16x8 v; unsigned u[4]; } H, Lo;
#pragma unroll
  for (int j = 0; j < 4; ++j) {
    const unsigned h = pack2(x[2 * j], x[2 * j + 1]);
    H.u[j] = h;
    Lo.u[j] = pack2(x[2 * j] - __uint_as_float(h << 16), x[2 * j + 1] - __uint_as_float(h & 0xffff0000u));
  }
  hi = H.v; lo = Lo.v;
}
template <int AM, int AK, int BKS, int BN, bool SPLIT = true>
__device__ __forceinline__ void mm64(const float* A, const float* B, f32x4 (&acc)[2], int m0, int n0, int lane) {
  const int lr = lane & 15, lq = lane >> 4;
#pragma unroll
  for (int ks = 0; ks < 2; ++ks) {
    const int k0 = ks * 32 + lq * 8;
    float a[8];
    if (AK == 1) {
      float4 x0 = *(const float4*)(A + (m0 + lr) * AM + k0), x1 = *(const float4*)(A + (m0 + lr) * AM + k0 + 4);
      a[0] = x0.x; a[1] = x0.y; a[2] = x0.z; a[3] = x0.w; a[4] = x1.x; a[5] = x1.y; a[6] = x1.z; a[7] = x1.w;
    } else {
#pragma unroll
      for (int j = 0; j < 8; ++j) a[j] = A[(m0 + lr) * AM + (k0 + j) * AK];
    }
    bf16x8 ah, al;
    if (SPLIT) split8(a, ah, al);
    else { union { bf16x8 v; unsigned u[4]; } H; for (int j = 0; j < 4; ++j) H.u[j] = pack2(a[2 * j], a[2 * j + 1]); ah = H.v; al = H.v; }
#pragma unroll
    for (int nt = 0; nt < 2; ++nt) {
      const int n = n0 + nt * 16 + lr;
      float b[8];
      if (BKS == 1) {
        float4 x0 = *(const float4*)(B + n * BN + k0), x1 = *(const float4*)(B + n * BN + k0 + 4);
        b[0] = x0.x; b[1] = x0.y; b[2] = x0.z; b[3] = x0.w; b[4] = x1.x; b[5] = x1.y; b[6] = x1.z; b[7] = x1.w;
      } else {
#pragma unroll
        for (int j = 0; j < 8; ++j) b[j] = B[(k0 + j) * BKS + n * BN];
      }
      if (SPLIT) {
        bf16x8 bh, bl; split8(b, bh, bl);
        acc[nt] = __builtin_amdgcn_mfma_f32_16x16x32_bf16(ah, bh, acc[nt], 0, 0, 0);
        acc[nt] = __builtin_amdgcn_mfma_f32_16x16x32_bf16(ah, bl, acc[nt], 0, 0, 0);
        acc[nt] = __builtin_amdgcn_mfma_f32_16x16x32_bf16(al, bh, acc[nt], 0, 0, 0);
      } else {
        union { bf16x8 v; unsigned u[4]; } Bh;
#pragma unroll
        for (int j = 0; j < 4; ++j) Bh.u[j] = pack2(b[2 * j], b[2 * j + 1]);
        acc[nt] = __builtin_amdgcn_mfma_f32_16x16x32_bf16(ah, Bh.v, acc[nt], 0, 0, 0);
      }
    }
  }
}
#define MM_ZERO(acc) do { acc[0] = f32x4{0.f, 0.f, 0.f, 0.f}; acc[1] = f32x4{0.f, 0.f, 0.f, 0.f}; } while (0)
#define MM_FOREACH(acc, BODY) do { _Pragma("unroll") for (int nt_ = 0; nt_ < 2; ++nt_) _Pragma("unroll") for (int rg_ = 0; rg_ < 4; ++rg_) { \
    const int m = m0 + lq * 4 + rg_, n = n0 + nt_ * 16 + lr; const float val = acc[nt_][rg_]; BODY } } while (0)

#define CPRE_PARAMS float4& c_w0, float4& c_w1, float4& c_q0, float4& c_q1, float4& c_b0, float4& c_b1, float4& c_k0, float4& c_k1, float4& c_r0, float4& c_r1, float4& c_v0, float4& c_v1
#define CPRE_ARGS(P) P##w0, P##w1, P##q0, P##q1, P##b0, P##b1, P##k0, P##k1, P##r0, P##r1, P##v0, P##v1
__device__ __forceinline__ void cprep_load(KPR p, int grow0, int h, int tid, CPRE_PARAMS) {
  const int t0 = tid >> 4, c4 = (tid & 15) * 4;
  const size_t g0 = (size_t)(grow0 + t0) * 512 + h * 64 + c4, g1 = g0 + (size_t)32 * 512;
  const float* WB = (const float*)(p.ws + W_WB); const float* KKB = (const float*)(p.ws + W_KKB); const float* BB = (const float*)(p.ws + W_BB);
  const float* KB = (const float*)(p.ws + W_KB); const float* RB = (const float*)(p.ws + W_RB); const float* VB = (const float*)(p.ws + W_VB);
  c_w0 = *(const float4*)(WB + g0); c_w1 = *(const float4*)(WB + g1); c_q0 = *(const float4*)(KKB + g0); c_q1 = *(const float4*)(KKB + g1);
  c_b0 = *(const float4*)(BB + g0); c_b1 = *(const float4*)(BB + g1); c_k0 = *(const float4*)(KB + g0); c_k1 = *(const float4*)(KB + g1);
  c_r0 = *(const float4*)(RB + g0); c_r1 = *(const float4*)(RB + g1); c_v0 = *(const float4*)(VB + g0); c_v1 = *(const float4*)(VB + g1);
}
__device__ __forceinline__ void cprep_item(KPR p, int grow0, int h, int cid, int ngrow0, int nh, CPRE_PARAMS) {
  extern __shared__ __attribute__((aligned(16))) char smem[];
  float* B0 = (float*)smem; float* B1 = B0 + LBUF; float* B2 = B1 + LBUF; float* B3 = B2 + LBUF;
  float* B4 = B3 + LBUF; float* B5 = B4 + LBUF; float* B6 = B5 + LBUF; float* B7 = B6 + LBUF;
  float* wC = (float*)(smem + 139264);
  const int tid = tidx(), wid = tid >> 6, lane = tid & 63, lr = lane & 15, lq = lane >> 4;
  const int m0 = (wid >> 1) * 16, n0 = (wid & 1) * 32;
  const float* WB = (const float*)(p.ws + W_WB) + h * 64; const float* KKB = (const float*)(p.ws + W_KKB) + h * 64;
  const float* BB = (const float*)(p.ws + W_BB) + h * 64; const float* KB = (const float*)(p.ws + W_KB) + h * 64;
  const float* RB = (const float*)(p.ws + W_RB) + h * 64; const float* VB = (const float*)(p.ws + W_VB) + h * 64;
  f32x4 acc[2];
  __syncthreads();
  {
    const int t0 = tid >> 4, c4 = (tid & 15) * 4, o0 = t0 * LS + c4, o1 = (t0 + 32) * LS + c4;
    *(float4*)(B0 + o0) = c_w0; *(float4*)(B0 + o1) = c_w1;
    *(float4*)(B1 + o0) = make_float4(-c_q0.x, -c_q0.y, -c_q0.z, -c_q0.w); *(float4*)(B1 + o1) = make_float4(-c_q1.x, -c_q1.y, -c_q1.z, -c_q1.w);
    *(float4*)(B2 + o0) = c_b0; *(float4*)(B2 + o1) = c_b1;
    *(float4*)(B3 + o0) = c_k0; *(float4*)(B3 + o1) = c_k1;
    *(float4*)(B4 + o0) = c_r0; *(float4*)(B4 + o1) = c_r1;
  }
  const float4 vk0 = c_v0, vk1 = c_v1;
  __syncthreads();
  cprep_load(p, ngrow0, nh, tid, CPRE_ARGS(c_));
  {
    const int j = tid & 63, sg = tid >> 6;
    float wv[8];
#pragma unroll
    for (int u = 0; u < 8; ++u) wv[u] = B0[(sg * 8 + u) * LS + j];
#pragma unroll
    for (int u = 1; u < 8; ++u) wv[u] *= wv[u - 1];
    float* segp = B5;
    segp[sg * 64 + j] = wv[7];
    __syncthreads();
    float pre = 1.f;
    for (int u = 0; u < sg; ++u) pre *= segp[u * 64 + j];
#pragma unroll
    for (int u = 0; u < 8; ++u) B0[(sg * 8 + u) * LS + j] = wv[u] * pre;
    if (sg == 7) wC[j] = wv[7] * pre;
  }
  __syncthreads();
  for (int e = tid; e < 4096; e += NTHR) {
    const int t = e >> 6, j = e & 63, o = t * LS + j;
    const float wt = B0[o], wp = t ? B0[o - LS] : 1.f, iw = 1.f / wt;
    B1[o] *= wp; B2[o] *= iw; B3[o] *= iw; B4[o] *= wt;
  }
  __syncthreads();
  MM_ZERO(acc); mm64<LS, 1, 1, LS>(B2, B1, acc, m0, n0, lane);
  MM_FOREACH(acc, { const float v = m < n ? val : 0.f; B5[m * LS + n] = v; B6[m * LS + n] = v + (m == n ? 1.f : 0.f); });
  __syncthreads();
  MM_ZERO(acc); mm64<LS, 1, LS, 1>(B5, B5, acc, m0, n0, lane);
  MM_FOREACH(acc, { B7[m * LS + n] = val; });
  __syncthreads();
  for (int it = 0; it < 5; ++it) {
    MM_ZERO(acc); mm64<LS, 1, LS, 1>(B6, B7, acc, m0, n0, lane);
    f32x4 acc2[2]; MM_ZERO(acc2);
    if (it < 4) mm64<LS, 1, LS, 1>(B7, B7, acc2, m0, n0, lane);
    __syncthreads();
    MM_FOREACH(acc, { B6[m * LS + n] += val; });
    if (it < 4) MM_FOREACH(acc2, { B7[m * LS + n] = val; });
    __syncthreads();
  }
  MM_ZERO(acc); mm64<1, LS, LS, 1>(B1, B6, acc, m0, n0, lane);
  MM_FOREACH(acc, { B5[m * LS + n] = val; });
  MM_ZERO(acc); mm64<LS, 1, 1, LS>(B3, B1, acc, m0, n0, lane);
  MM_FOREACH(acc, { B0[m * LS + n] = m < n ? val : 0.f; });
  __syncthreads();
  MM_ZERO(acc); mm64<LS, 1, LS, 1>(B0, B6, acc, m0, n0, lane);
  MM_FOREACH(acc, { B7[m * LS + n] = val; });
  __syncthreads();
  MM_ZERO(acc); mm64<LS, 1, 1, LS, false>(B2, B4, acc, m0, n0, lane);
  {
    f32x4 acc2[2]; MM_ZERO(acc2); mm64<LS, 1, 1, LS, false>(B3, B4, acc2, m0, n0, lane);
    __syncthreads();
    MM_FOREACH(acc, { B0[m * LS + n] = m <= n ? val : 0.f; });
    MM_FOREACH(acc2, { B1[m * LS + n] = m <= n ? val : 0.f; });
  }
  __syncthreads();
  {
    u16* RRT = (u16*)(p.ws + W_CRR) + (size_t)cid * 4096;
    MM_ZERO(acc); mm64<1, LS, 1, LS, false>(B0, B5, acc, m0, n0, lane);
    MM_FOREACH(acc, { RRT[m * 64 + n] = f2bf(val + B4[m * LS + n]); });
    MM_ZERO(acc); mm64<LS, 1, LS, 1, false>(B7, B0, acc, m0, n0, lane);
    MM_FOREACH(acc, { B6[m * LS + n] = val + B1[m * LS + n]; });
  }
  __syncthreads();
  for (int e = tid; e < 4096; e += NTHR) {
    const int t = e >> 6, j = e & 63, o = t * LS + j;
    const float wc = wC[j];
    B2[o] *= wc; B3[o] *= wc;
  }
  { const int t0 = tid >> 4, c4 = (tid & 15) * 4; *(float4*)(B4 + t0 * LS + c4) = vk0; *(float4*)(B4 + (t0 + 32) * LS + c4) = vk1; }
  __syncthreads();
  {
    float* YB = (float*)(p.ws + W_YB) + h * 64;
    MM_ZERO(acc); mm64<1, LS, LS, 1, false>(B6, B4, acc, m0, n0, lane);
    MM_FOREACH(acc, { YB[(size_t)(grow0 + m) * 512 + n] = val; });
    u16* PT = (u16*)(p.ws + W_CPT) + (size_t)cid * 4096;
    MM_ZERO(acc); mm64<1, LS, 1, LS, false>(B2, B5, acc, m0, n0, lane);
    MM_FOREACH(acc, { PT[m * 64 + n] = f2bf(val + (m == n ? wC[m] : 0.f)); });
    MM_ZERO(acc); mm64<LS, 1, LS, 1, false>(B7, B2, acc, m0, n0, lane);
    MM_FOREACH(acc, { B0[m * LS + n] = val + B3[m * LS + n]; });
  }
  __syncthreads();
  {
    float* CQ = (float*)(p.ws + W_CQ) + (size_t)cid * 4096;
    MM_ZERO(acc); mm64<1, LS, LS, 1, false>(B4, B0, acc, m0, n0, lane);
    MM_FOREACH(acc, { CQ[m * 64 + n] = val; });
  }
}

__device__ __forceinline__ void cprep_decode(int id, int& grow0, int& h) {
  if (id < 2048) { grow0 = (id >> 9) * 4096 + (id & 63) * 64; h = (id >> 6) & 7; }
  else { const int k = id - 2048; grow0 = TP + (k >> 3) * 64; h = k & 7; }
}
__device__ __forceinline__ void phase_cprep(KPR p) {
  float4 u_w0, u_w1, u_q0, u_q1, u_b0, u_b1, u_k0, u_k1, u_r0, u_r1, u_v0, u_v1;
  int id = blockIdx.x, grow0 = 0, h = 0;
  cprep_decode(id < 2304 ? id : 0, grow0, h); cprep_load(p, grow0, h, tidx(), CPRE_ARGS(u_));
  for (; id < 2304; id += gridDim.x) {
    const int nid = id + gridDim.x;
    int ng = 0, nh = 0;
    cprep_decode(nid < 2304 ? nid : id, ng, nh);
    cprep_item(p, grow0, h, id, ng, nh, CPRE_ARGS(u_));
    grow0 = ng; h = nh;
  }
}

__device__ __forceinline__ void cseq_item(KPR p, int g0, int h, int nch, int cid0, const float* S0, float* Sout) {
  extern __shared__ __attribute__((aligned(16))) char smem[];
  float* Sf = (float*)smem;
  float* Qf = Sf + LBUF;
  float* Yf = Qf + LBUF;
  u16* Rb = (u16*)(Yf + LBUF);
  u16* Pb = Rb + 64 * LH;
  const int tid = tidx(), wid = tid >> 6, lane = tid & 63, lr = lane & 15, lq = lane >> 4;
  const int m0 = (wid >> 1) * 16, n0 = (wid & 1) * 32;
  float* YB = (float*)(p.ws + W_YB) + h * 64;
  const u16* RRT = (const u16*)(p.ws + W_CRR) + (size_t)cid0 * 4096;
  const u16* PT = (const u16*)(p.ws + W_CPT) + (size_t)cid0 * 4096;
  const float* CQ = (const float*)(p.ws + W_CQ) + (size_t)cid0 * 4096;
  __syncthreads();
  for (int e = tid; e < 4096; e += NTHR) { const int i = e >> 6, j = e & 63; Sf[i * LS + j] = S0 ? S0[e] : 0.f; }
  const int hr = tid >> 3, hc = (tid & 7) * 8;
  const int f0t = tid >> 4, f0c = (tid & 15) * 4;
  uint4 pr, pp; float4 q0, q1, y0, y1;
#define CS_LOAD(c_) do { \
    pr = *(const uint4*)(RRT + (size_t)(c_) * 4096 + hr * 64 + hc); pp = *(const uint4*)(PT + (size_t)(c_) * 4096 + hr * 64 + hc); \
    q0 = *(const float4*)(CQ + (size_t)(c_) * 4096 + f0t * 64 + f0c); q1 = *(const float4*)(CQ + (size_t)(c_) * 4096 + (f0t + 32) * 64 + f0c); \
    y0 = *(const float4*)(YB + (size_t)(g0 + (c_) * 64 + f0t) * 512 + f0c); y1 = *(const float4*)(YB + (size_t)(g0 + (c_) * 64 + f0t + 32) * 512 + f0c); } while (0)
  CS_LOAD(0);
  for (int c = 0; c < nch; ++c) {
    __syncthreads();
    *(uint4*)(Rb + hr * LH + hc) = pr; *(uint4*)(Pb + hr * LH + hc) = pp;
    *(float4*)(Qf + f0t * LS + f0c) = q0; *(float4*)(Qf + (f0t + 32) * LS + f0c) = q1;
    *(float4*)(Yf + f0t * LS + f0c) = y0; *(float4*)(Yf + (f0t + 32) * LS + f0c) = y1;
    __syncthreads();
    if (c + 1 < nch) CS_LOAD(c + 1);
    f32x4 ay[2], as[2]; MM_ZERO(ay); MM_ZERO(as);
#pragma unroll
    for (int ks = 0; ks < 2; ++ks) {
      const int k0 = ks * 32 + lq * 8;
      const bf16x8 ra = *(const bf16x8*)(Rb + (m0 + lr) * LH + k0);
      float sa[8];
      { float4 x0 = *(const float4*)(Sf + (m0 + lr) * LS + k0), x1 = *(const float4*)(Sf + (m0 + lr) * LS + k0 + 4);
        sa[0] = x0.x; sa[1] = x0.y; sa[2] = x0.z; sa[3] = x0.w; sa[4] = x1.x; sa[5] = x1.y; sa[6] = x1.z; sa[7] = x1.w; }
      bf16x8 sah, sal; split8(sa, sah, sal);
#pragma unroll
      for (int nt = 0; nt < 2; ++nt) {
        const int n = n0 + nt * 16 + lr;
        float sb[8];
        { float4 x0 = *(const float4*)(Sf + n * LS + k0), x1 = *(const float4*)(Sf + n * LS + k0 + 4);
          sb[0] = x0.x; sb[1] = x0.y; sb[2] = x0.z; sb[3] = x0.w; sb[4] = x1.x; sb[5] = x1.y; sb[6] = x1.z; sb[7] = x1.w; }
        bf16x8 sbh, sbl; split8(sb, sbh, sbl);
        ay[nt] = __builtin_amdgcn_mfma_f32_16x16x32_bf16(ra, sbh, ay[nt], 0, 0, 0);
        ay[nt] = __builtin_amdgcn_mfma_f32_16x16x32_bf16(ra, sbl, ay[nt], 0, 0, 0);
        const bf16x8 pb = *(const bf16x8*)(Pb + n * LH + k0);
        as[nt] = __builtin_amdgcn_mfma_f32_16x16x32_bf16(sah, pb, as[nt], 0, 0, 0);
        as[nt] = __builtin_amdgcn_mfma_f32_16x16x32_bf16(sal, pb, as[nt], 0, 0, 0);
      }
    }
    MM_FOREACH(ay, { YB[(size_t)(g0 + c * 64 + m) * 512 + n] = val + Yf[m * LS + n]; });
    __syncthreads();
    MM_FOREACH(as, { Sf[m * LS + n] = val + Qf[m * LS + n]; });
  }
#undef CS_LOAD
  __syncthreads();
  for (int e = tid; e < 4096; e += NTHR) { const int i = e >> 6, j = e & 63; Sout[e] = Sf[i * LS + j]; }
}

__device__ __forceinline__ void phase_yfin(KPR p, int l) {
  const int tid = tidx(), wid = tid >> 6, lane = tid & 63;
  const float* YB = (const float*)(p.ws + W_YB); const float* RB = (const float*)(p.ws + W_RB); const float* KB = (const float*)(p.ws + W_KB);
  const float* VB = (const float*)(p.ws + W_VB); const u16* GB = (const u16*)(p.ws + W_GB); u16* AO = (u16*)(p.ws + W_AO);
  const float* rk = p.in[I_RK] + l * 512; const float* gng = p.in[I_GNG] + l * 512; const float* gnb = p.in[I_GNB] + l * 512;
  for (int g = blockIdx.x * 8 + wid; g < T; g += gridDim.x * 8) {
#pragma unroll 2
    for (int h = 0; h < 8; ++h) {
      size_t i = (size_t)g * 512 + h * 64 + lane;
      float y = YB[i];
      float mu = wave_sum(y) * (1.f / 64.f);
      float dlt = y - mu;
      float var = wave_sum(dlt * dlt) * (1.f / 64.f);
      float bon = wave_sum(RB[i] * KB[i] * rk[h * 64 + lane]);
      float v = dlt * rsqrtf(var + 64e-5f) * gng[h * 64 + lane] + gnb[h * 64 + lane] + bon * VB[i];
      AO[(size_t)g * 1536 + 1024 + h * 64 + lane] = f2bf(v * bf2f(GB[i]));
    }
  }
}

__device__ __forceinline__ void phase_init(KPR p) {
  const int G = gridDim.x, tid = tidx(), wid = tid >> 6, lane = tid & 63;
  const int gw = blockIdx.x * 8 + wid, nw = G * 8;
  {
    float* X = (float*)(p.ws + W_X); u16* XB = (u16*)(p.ws + W_XB); float* SSQ = (float*)(p.ws + W_SSQ);
    for (int g = gw; g < T; g += nw) {
      const float* src = g < TP ? p.in[I_XP] + (size_t)g * 1024 : p.in[I_XS] + (size_t)(g - TP) * 1024;
      float ss = 0.f;
#pragma unroll
      for (int i = 0; i < 4; ++i) {
        float4 v = *(const float4*)(src + i * 256 + lane * 4);
        *(float4*)(X + (size_t)g * 1024 + i * 256 + lane * 4) = v;
        uint2 w; w.x = pack2(v.x, v.y); w.y = pack2(v.z, v.w);
        *(uint2*)(XB + (size_t)g * 1024 + i * 256 + lane * 4) = w;
        ss += v.x * v.x + v.y * v.y + v.z * v.z + v.w * v.w;
      }
      ss = wave_sum(ss);
      if (lane == 0) *(float4*)(SSQ + (size_t)g * 4) = make_float4(ss, 0.f, 0.f, 0.f);
    }
  }
  {
    u16* MB = (u16*)(p.ws + W_MB);
    for (int g = gw; g < 1024; g += nw) {
      const float* src = p.in[I_MEMP] + (size_t)g * 1024;
      float4 v[4]; float ss = 0.f;
#pragma unroll
      for (int i = 0; i < 4; ++i) { v[i] = *(const float4*)(src + i * 256 + lane * 4); ss += v[i].x * v[i].x + v[i].y * v[i].y + v[i].z * v[i].z + v[i].w * v[i].w; }
      ss = wave_sum(ss);
      float rs = rsqrtf(ss * (1.f / 1024.f) + 1e-6f);
#pragma unroll
      for (int i = 0; i < 4; ++i) {
        uint2 w; w.x = pack2(v[i].x * rs, v[i].y * rs); w.y = pack2(v[i].z * rs, v[i].w * rs);
        *(uint2*)(MB + (size_t)g * 1024 + i * 256 + lane * 4) = w;
      }
    }
  }
  {
    float2* RT = (float2*)(p.ws + W_ROPE);
    for (int e = blockIdx.x * NTHR + tid; e < 4096 * 16; e += G * NTHR) {
      int pos = e >> 4, i = e & 15;
      float inv = powf(10000.f, -(float)i / 16.f);
      float ang = (float)pos * inv;
      float sn, cs; sincosf(ang, &sn, &cs);
      RT[e] = make_float2(cs, sn);
    }
  }
  int rot = 0;
  for (int l = 0; l < NL; ++l) {
    u16* WT = (u16*)(p.ws + W_WT) + (size_t)l * WE_LAYER;
    for (int f = 0; f < 2; ++f) {
      const float* nrm = p.in[f ? I_F2N : I_F1N] + l * 1024;
      const float* wg = p.in[f ? I_F2G : I_F1G] + (size_t)l * 1024 * DFF;
      const float* wu = p.in[f ? I_F2U : I_F1U] + (size_t)l * 1024 * DFF;
      const float* wd = p.in[f ? I_F2D : I_F1D] + (size_t)l * 1024 * DFF;
      tconv(WT + (f ? WE_GU2 : WE_GU1), 1024, 5632, 1024, rot, [=](int k, int n) {
        int j = (n >> 5) * 16 + (n & 15);
        const float* s = ((n >> 4) & 1) ? wu : wg;
        return nrm[k] * s[(size_t)k * DFF + j];
      });
      rot += 88 * 16;
      tconv(WT + (f ? WE_D2 : WE_D1), DFF, 1024, DFF, rot, [=](int k, int n) { return wd[(size_t)k * 1024 + n]; });
      rot += 16 * 44;
    }
    {
      const float* nrm = p.in[I_MIXN] + l * 1024; const float* w = p.in[I_WIN] + (size_t)l * 1024 * DIN;
      tconv(WT + WE_IN, 1024, DINP, 1024, rot, [=](int k, int n) { return n < DIN ? nrm[k] * w[(size_t)k * DIN + n] : 0.f; });
      rot += 36 * 16;
    }
    {
      const float* nrm = p.in[I_QN] + l * 256; const float* wuq = p.in[I_WUQ] + (size_t)l * 256 * 768;
      const float* wuk = p.in[I_WUK] + (size_t)l * 8 * 128 * 64;
      tconv(WT + WE_Q, 256, 1280, 256, rot, [=](int k, int n) {
        float r;
        if (n < 1024) {
          int h = n >> 7, c = n & 127;
          const float* a = wuq + (size_t)k * 768 + h * 96; const float* b = wuk + (size_t)(h * 128 + c) * 64;
          r = 0.f;
          for (int d = 0; d < 64; ++d) r += a[d] * b[d];
        } else {
          int hr = n - 1024;
          r = wuq[(size_t)k * 768 + (hr >> 5) * 96 + 64 + (hr & 31)];
        }
        return r * nrm[k] * QSCALE;
      });
      rot += 20 * 4;
    }
    {
      const float* wup = p.in[I_WUP] + (size_t)l * 64 * 512; const float* aup = p.in[I_AUP] + (size_t)l * 64 * 512;
      const float* gup = p.in[I_GUP] + (size_t)l * 128 * 512;
      tconv(WT + WE_RW, 256, 1536, 256, rot, [=](int k, int n) {
        if (n < 512) return k < 64 ? wup[k * 512 + n] : 0.f;
        if (n < 1024) return (k >= 64 && k < 128) ? aup[(k - 64) * 512 + n - 512] : 0.f;
        return k >= 128 ? gup[(k - 128) * 512 + n - 1024] : 0.f;
      });
      rot += 24 * 4;
    }
    {
      const float* wuv = p.in[I_WUV] + (size_t)l * 8 * 128 * 64; const float* wo = p.in[I_WOUT] + (size_t)l * 1024 * 1024;
      tconv(WT + WE_OUT, 1536, 1024, 1536, rot, [=](int k, int n) {
        if (k < 1024) {
          int h = k >> 7, c = k & 127;
          const float* a = wuv + (size_t)(h * 128 + c) * 64; const float* b = wo + (size_t)(h * 64) * 1024 + n;
          float r = 0.f;
          for (int v = 0; v < 64; ++v) r += a[v] * b[(size_t)v * 1024];
          return r;
        }
        return wo[(size_t)(512 + k - 1024) * 1024 + n];
      });
      rot += 16 * 24;
    }
    {
      const float* nx = p.in[I_XN] + l * 1024; const float* nm = p.in[I_MKVN] + l * 1024;
      const float* wq = p.in[I_WMQ] + (size_t)l * 1048576; const float* wk = p.in[I_WMK] + (size_t)l * 1048576;
      const float* wv = p.in[I_WMV] + (size_t)l * 1048576; const float* wo = p.in[I_WMO] + (size_t)l * 1048576;
      tconv(WT + WE_MQ, 1024, 1024, 1024, rot, [=](int k, int n) { return nx[k] * wq[(size_t)k * 1024 + n] * XSCALE; });
      tconv(WT + WE_MK, 1024, 1024, 1024, rot, [=](int k, int n) { return nm[k] * wk[(size_t)k * 1024 + n]; });
      tconv(WT + WE_MV, 1024, 1024, 1024, rot, [=](int k, int n) { return nm[k] * wv[(size_t)k * 1024 + n]; });
      tconv(WT + WE_MO, 1024, 1024, 1024, rot, [=](int k, int n) { return wo[(size_t)k * 1024 + n]; });
    }
  }
}

__device__ __forceinline__ void phase_prep(KPR p, int l) {
  extern __shared__ __attribute__((aligned(16))) char smem[];
  u16* sv = (u16*)smem;
  const int tid = tidx(), wid = tid >> 6, lane = tid & 63;
  const u16* PROJ = (const u16*)(p.ws + W_PROJ);
  u16* CQB = (u16*)(p.ws + W_CQB); u16* A2 = (u16*)(p.ws + W_A2);
  float* RB = (float*)(p.ws + W_RB); float* KB = (float*)(p.ws + W_KB); float* VB = (float*)(p.ws + W_VB); float* KKB = (float*)(p.ws + W_KKB);
  u16* KP = (u16*)(p.ws + W_KP); u16* KS = (u16*)(p.ws + W_KS); u16* VTP = (u16*)(p.ws + W_VTP); u16* VTS = (u16*)(p.ws + W_VTS);
  const float2* RT = (const float2*)(p.ws + W_ROPE);
  const float* kvn = p.in[I_KVN] + l * 128; const float* mu = p.in[I_MU] + l * DSH; const float* kkw = p.in[I_KK] + l * 512;
  for (int chunk = blockIdx.x; chunk < T / 72; chunk += gridDim.x) {
  __syncthreads();
  uint2 n_cq; unsigned n_ckv; u16 n_k1 = 0, n_k2 = 0; uint4 n_pb0, n_pb1, n_pb2, n_pb3 = make_uint4(0, 0, 0, 0);
  uint4 q_pb0, q_pb1, q_pb2, q_pb3 = make_uint4(0, 0, 0, 0);
#define PREP_LOAD(ROW) do { const u16* pr_ = PROJ + (size_t)(ROW) * DINP; \
    n_cq = *(const uint2*)(pr_ + lane * 4); n_ckv = *(const unsigned*)(pr_ + 256 + lane * 2); \
    if (lane < 16) { n_k1 = pr_[384 + lane]; n_k2 = pr_[400 + lane]; } \
    n_pb0 = *(const uint4*)(pr_ + 416 + lane * 8); n_pb1 = *(const uint4*)(pr_ + 416 + 512 + lane * 8); \
    n_pb2 = *(const uint4*)(pr_ + 416 + 1024 + lane * 8); if (lane < 32) n_pb3 = *(const uint4*)(pr_ + 416 + 1536 + lane * 8); } while (0)
  {
    const int gfirst = chunk * 72 + wid * 9;
    if (gfirst > 0) { PREP_LOAD(gfirst - 1); q_pb0 = n_pb0; q_pb1 = n_pb1; q_pb2 = n_pb2; q_pb3 = n_pb3; }
    else { q_pb0 = q_pb1 = q_pb2 = make_uint4(0, 0, 0, 0); }
    PREP_LOAD(gfirst);
  }
  for (int ri = 0; ri < 9; ++ri) {
    const int rl = wid * 9 + ri, g = chunk * 72 + rl;
    const u16* pr = PROJ + (size_t)g * DINP;
    const uint2 c_cq = n_cq; const unsigned c_ckv = n_ckv; const u16 c_k1 = n_k1, c_k2 = n_k2;
    const uint4 c_pb0 = n_pb0, c_pb1 = n_pb1, c_pb2 = n_pb2, c_pb3 = n_pb3;
    { const int gn = g + 1 < T ? g + 1 : g; PREP_LOAD(gn); }
    const bool isP = g < TP;
    int b, t, pos, tlen;
    if (isP) { b = g >> 12; t = g & 4095; pos = t; tlen = 4096; } else { int gg = g - TP; b = gg >> 6; t = gg & 63; pos = 2048 + t; tlen = 64; }
    {
      uint2 w = c_cq;
      float v0 = bf2f(w.x & 0xffff), v1 = bf2f(w.x >> 16), v2 = bf2f(w.y & 0xffff), v3 = bf2f(w.y >> 16);
      float ss = wave_sum(v0 * v0 + v1 * v1 + v2 * v2 + v3 * v3);
      float rs = rsqrtf(ss * (1.f / 256.f) + 1e-6f);
      uint2 o; o.x = pack2(v0 * rs, v1 * rs); o.y = pack2(v2 * rs, v3 * rs);
      *(uint2*)(CQB + (size_t)g * 256 + lane * 4) = o;
    }
    {
      unsigned w = c_ckv;
      float v0 = bf2f(w & 0xffff), v1 = bf2f(w >> 16);
      float ss = wave_sum(v0 * v0 + v1 * v1);
      float rs = rsqrtf(ss * (1.f / 128.f) + 1e-6f);
      int c = lane * 2;
      v0 = v0 * rs * kvn[c]; v1 = v1 * rs * kvn[c + 1];
      float* of = isP ? p.out + OO_CKVP + ((size_t)(l * 4 + b) * 4096 + t) * 128 : p.out + OO_CKVS + ((size_t)(l * 32 + b) * 64 + t) * 128;
      *(float2*)(of + c) = make_float2(v0, v1);
      u16* kr = isP ? KP + ((size_t)b * 4096 + t) * 160 : KS + ((size_t)b * 2112 + 2048 + t) * 160;
      *(unsigned*)(kr + c) = pack2(v0, v1);
      *(unsigned*)(sv + rl * 128 + c) = pack2(v0, v1);
      if (lane < 16) {
        float x1 = bf2f(c_k1), x2 = bf2f(c_k2);
        float2 cs = RT[pos * 16 + lane];
        float o1 = x1 * cs.x - x2 * cs.y, o2 = x1 * cs.y + x2 * cs.x;
        float* okr = isP ? p.out + OO_KRP + ((size_t)(l * 4 + b) * 4096 + t) * 32 : p.out + OO_KRS + ((size_t)(l * 32 + b) * 64 + t) * 32;
        okr[lane] = o1; okr[lane + 16] = o2;
        kr[128 + lane] = f2bf(o1); kr[144 + lane] = f2bf(o2);
      }
    }
    {
      const u16* pb = pr + 416;
      const u16* pp = pr - DINP + 416;
      const float* sh0 = p.in[I_SSH] + (size_t)(l * 32 + b) * DSH;
      const bool last = (t == tlen - 1);
      float* osh = isP ? p.out + OO_SHP + (size_t)(l * 4 + b) * DSH : p.out + OO_SHS + (size_t)(l * 32 + b) * DSH;
#pragma unroll
      for (int it = 0; it < 4; ++it) {
        const int c = it * 64 + lane;
        if (c < 224) {
          const int e = c * 8;
          const uint4 w = it == 0 ? c_pb0 : (it == 1 ? c_pb1 : (it == 2 ? c_pb2 : c_pb3));
          float pv[8] = {bf2f(w.x & 0xffff), bf2f(w.x >> 16), bf2f(w.y & 0xffff), bf2f(w.y >> 16), bf2f(w.z & 0xffff), bf2f(w.z >> 16), bf2f(w.w & 0xffff), bf2f(w.w >> 16)};
          float pq[8];
          if (t > 0) {
            const uint4 q = it == 0 ? q_pb0 : (it == 1 ? q_pb1 : (it == 2 ? q_pb2 : q_pb3));
            pq[0] = bf2f(q.x & 0xffff); pq[1] = bf2f(q.x >> 16); pq[2] = bf2f(q.y & 0xffff); pq[3] = bf2f(q.y >> 16);
            pq[4] = bf2f(q.z & 0xffff); pq[5] = bf2f(q.z >> 16); pq[6] = bf2f(q.w & 0xffff); pq[7] = bf2f(q.w >> 16);
          } else if (!isP) {
            float4 q0 = *(const float4*)(sh0 + e), q1 = *(const float4*)(sh0 + e + 4);
            pq[0] = q0.x; pq[1] = q0.y; pq[2] = q0.z; pq[3] = q0.w; pq[4] = q1.x; pq[5] = q1.y; pq[6] = q1.z; pq[7] = q1.w;
          } else {
#pragma unroll
            for (int j = 0; j < 8; ++j) pq[j] = 0.f;
          }
          float4 m0 = *(const float4*)(mu + e), m1 = *(const float4*)(mu + e + 4);
          float mm[8] = {m0.x, m0.y, m0.z, m0.w, m1.x, m1.y, m1.z, m1.w};
          float xs[8];
#pragma unroll
          for (int j = 0; j < 8; ++j) xs[j] = pv[j] + mm[j] * (pq[j] - pv[j]);
          if (last) { *(float4*)(osh + e) = make_float4(pv[0], pv[1], pv[2], pv[3]); *(float4*)(osh + e + 4) = make_float4(pv[4], pv[5], pv[6], pv[7]); }
          if (it == 0) {
            float* o = RB + (size_t)g * 512 + e;
            *(float4*)o = make_float4(xs[0], xs[1], xs[2], xs[3]); *(float4*)(o + 4) = make_float4(xs[4], xs[5], xs[6], xs[7]);
          } else if (it == 1) {
            const int cc = e - 512;
            float* o = KB + (size_t)g * 512 + cc;
            *(float4*)o = make_float4(xs[0], xs[1], xs[2], xs[3]); *(float4*)(o + 4) = make_float4(xs[4], xs[5], xs[6], xs[7]);
            float4 k0 = *(const float4*)(kkw + cc), k1 = *(const float4*)(kkw + cc + 4);
            float kk[8] = {xs[0] * k0.x, xs[1] * k0.y, xs[2] * k0.z, xs[3] * k0.w, xs[4] * k1.x, xs[5] * k1.y, xs[6] * k1.z, xs[7] * k1.w};
            float ss = 0.f;
#pragma unroll
            for (int j = 0; j < 8; ++j) ss += kk[j] * kk[j];
            ss = dpp_sum8(ss);
            float rn = rsqrtf(ss + 1e-12f);
            float* o2 = KKB + (size_t)g * 512 + cc;
            *(float4*)o2 = make_float4(kk[0] * rn, kk[1] * rn, kk[2] * rn, kk[3] * rn); *(float4*)(o2 + 4) = make_float4(kk[4] * rn, kk[5] * rn, kk[6] * rn, kk[7] * rn);
          } else if (it == 2) {
            float* o = VB + (size_t)g * 512 + (e - 1024);
            *(float4*)o = make_float4(xs[0], xs[1], xs[2], xs[3]); *(float4*)(o + 4) = make_float4(xs[4], xs[5], xs[6], xs[7]);
          } else {
            const int cc = e - 1536;
            float y[8];
#pragma unroll
            for (int j = 0; j < 8; ++j) y[j] = cc < 64 ? (1.f - 2.f / (1.f + __expf(2.f * xs[j]))) : (cc < 128 ? xs[j] : sigmoidf_(xs[j]));
            uint4 o; o.x = pack2(y[0], y[1]); o.y = pack2(y[2], y[3]); o.z = pack2(y[4], y[5]); o.w = pack2(y[6], y[7]);
            *(uint4*)(A2 + (size_t)g * 256 + cc) = o;
          }
        }
      }
    }
    q_pb0 = c_pb0; q_pb1 = c_pb1; q_pb2 = c_pb2; q_pb3 = c_pb3;
  }
#undef PREP_LOAD
  __syncthreads();
  for (int idx = tid; idx < 128 * 9; idx += NTHR) {
    const int d = idx & 127, rl0 = (idx >> 7) * 8, g = chunk * 72 + rl0;
    unsigned w[4];
#pragma unroll
    for (int j = 0; j < 4; ++j) w[j] = (unsigned)sv[(rl0 + 2 * j) * 128 + d] | ((unsigned)sv[(rl0 + 2 * j + 1) * 128 + d] << 16);
    u16* dst;
    if (g < TP) dst = VTP + ((size_t)(g >> 12) * 128 + d) * 4096 + (g & 4095);
    else { const int gg = g - TP; dst = VTS + ((size_t)(gg >> 6) * 128 + d) * 2112 + 2048 + (gg & 63); }
    *(uint4*)dst = make_uint4(w[0], w[1], w[2], w[3]);
  }
  }
}

__device__ __forceinline__ void conv_caches(KPR p, int l, int vb, int nvb) {
  const int tid = tidx();
  u16* KS = (u16*)(p.ws + W_KS); u16* VTS = (u16*)(p.ws + W_VTS);
  {
    const float* cckv = p.in[I_CCKV] + (size_t)l * 32 * 2048 * 128;
    const float* ckr = p.in[I_CKR] + (size_t)l * 32 * 2048 * 32;
    for (int idx = vb * NTHR + tid; idx < 32 * 2048 * 20; idx += nvb * NTHR) {
      int rowi = idx / 20, ch = idx % 20;
      int b = rowi >> 11, t = rowi & 2047;
      const float* s = ch < 16 ? cckv + (size_t)rowi * 128 + ch * 8 : ckr + (size_t)rowi * 32 + (ch - 16) * 8;
      float4 a = *(const float4*)s, c = *(const float4*)(s + 4);
      uint4 o; o.x = pack2(a.x, a.y); o.y = pack2(a.z, a.w); o.z = pack2(c.x, c.y); o.w = pack2(c.z, c.w);
      *(uint4*)(KS + ((size_t)b * 2112 + t) * 160 + ch * 8) = o;
    }
    tconv_v(VTS, 2112, 4096, 2048, vb, nvb, [=](int k, int n) { return cckv[((size_t)(n >> 7) * 2048 + k) * 128 + (n & 127)]; });
    const float* cmk = p.in[I_CMK] + (size_t)l * 32 * 256 * 1024;
    const float* cmv = p.in[I_CMV] + (size_t)l * 32 * 256 * 1024;
    u16* MKS = (u16*)(p.ws + W_MKS); u16* MVTS = (u16*)(p.ws + W_MVTS);
    for (int idx = vb * NTHR + tid; idx < 32 * 4 * 256 * 32; idx += nvb * NTHR) {
      int d8 = idx & 31, m = (idx >> 5) & 255, h = (idx >> 13) & 3, b = idx >> 15;
      const float* s = cmk + ((size_t)(b * 256 + m) * 4 + h) * 256 + d8 * 8;
      float4 a = *(const float4*)s, c = *(const float4*)(s + 4);
      uint4 o; o.x = pack2(a.x, a.y); o.y = pack2(a.z, a.w); o.z = pack2(c.x, c.y); o.w = pack2(c.z, c.w);
      *(uint4*)(MKS + (size_t)idx * 8) = o;
    }
    tconv_v(MVTS, 256, 32768, 256, vb, nvb, [=](int k, int n) { return cmv[((size_t)((n >> 10) * 256 + k) * 4 + ((n >> 8) & 3)) * 256 + (n & 255)]; });
  }
}

__device__ __forceinline__ void mla_sub(KPR p, int b, int c, int half) {
  const u16* QB = (const u16*)(p.ws + W_QB); u16* AO = (u16*)(p.ws + W_AO);
  size_t tok = (size_t)b * 4096 + c * 64 + half * 32;
  attn_item<160, 128, 8>(QB + tok * 1280, 160, 256, (const u16*)(p.ws + W_KP) + (size_t)b * 4096 * 160, 160,
                         (const u16*)(p.ws + W_VTP) + (size_t)b * 128 * 4096, 4096, (c + 1) * 64, AO + tok * 1536, 1536);
}
__device__ __forceinline__ void phase_mix(KPR p, int l, int mode = 0) {
  extern __shared__ __attribute__((aligned(16))) char smem[];
  int* sItem = (int*)(smem + SMEM_ITEM);
  int* cnt = (int*)(p.ws + W_CNT) + l + mode * 8;
  for (;;) {
    __syncthreads();
    if (threadIdx.x == 0) *sItem = atomicAdd(cnt, 1);
    __syncthreads();
    int it = *sItem;
    if (it >= 864) break;
    if (mode == 2 && (it < 32 || it >= 608)) continue;
    if (it < 32) {
      int b = it >> 3, h = it & 7;
      cseq_item(p, b * 4096, h, 64, (b * 8 + h) * 64, nullptr, p.out + OO_WKVP + ((size_t)(l * 4 + b) * 8 + h) * 4096);
    } else if (it < 608) {
      int k = it - 32;
      if (k >= 248 && k < 312) {
        int j = k - 248; int b = j >> 1, half = j & 1;
        const u16* QB = (const u16*)(p.ws + W_QB); u16* AO = (u16*)(p.ws + W_AO);
        size_t tok = (size_t)TP + b * 64 + half * 32;
        attn_item<160, 128, 8>(QB + tok * 1280, 160, 256, (const u16*)(p.ws + W_KS) + (size_t)b * 2112 * 160, 160,
                               (const u16*)(p.ws + W_VTS) + (size_t)b * 128 * 2112, 2112, 2112, AO + tok * 1536, 1536);
      } else {
        if (k >= 312) k -= 64;
        int c = 63 - (k >> 3), b = (k >> 1) & 3, half = k & 1;
        mla_sub(p, b, c, half);
      }
    } else {
      int k = it - 608; int b = k >> 3, h = k & 7;
      cseq_item(p, TP + b * 64, h, 1, 2048 + k, p.in[I_SWKV] + ((size_t)(l * 32 + b) * 8 + h) * 4096,
                p.out + OO_WKVS + ((size_t)(l * 32 + b) * 8 + h) * 4096);
    }
  }
}

__device__ __forceinline__ void xattn_item(KPR p, int l, int it) {
  const u16* QX = (const u16*)(p.ws + W_QX); u16* XO = (u16*)(p.ws + W_XO);
  if (it < 256) {
    int b = it >> 6, h = (it >> 4) & 3, qt = it & 15;
    size_t tok = (size_t)b * 4096 + qt * 256;
    for (int hv = 0; hv < 2; ++hv)
      attn_item<256, 128, 1>(QX + tok * 1024 + h * 256, 1024, 256, (const u16*)(p.ws + W_MKP) + (size_t)((l * 4 + b) * 4 + h) * 65536, 256,
                             (const u16*)(p.ws + W_MVTP) + (size_t)((l * 4 + b) * 4 + h) * 65536 + hv * 128 * 256, 256, 256, XO + tok * 1024 + h * 256 + hv * 128, 1024);
  } else {
    int k = it - 256; int b = k >> 2, h = k & 3;
    size_t tok = (size_t)TP + b * 64;
    for (int hv = 0; hv < 2; ++hv)
      attn_item<256, 128, 1>(QX + tok * 1024 + h * 256, 1024, 64, (const u16*)(p.ws + W_MKS) + (size_t)(b * 4 + h) * 65536, 256,
                             (const u16*)(p.ws + W_MVTS) + (size_t)(b * 4 + h) * 65536 + hv * 128 * 256, 256, 256, XO + tok * 1024 + h * 256 + hv * 128, 1024);
  }
}

constexpr int CH_NST = 10;
__device__ __forceinline__ void phase_chain(KPR p, int ci, int dup = 0) {
  extern __shared__ __attribute__((aligned(16))) char smem[];
  int* sItem = (int*)(smem + SMEM_ITEM);
  int* CT = (int*)(p.ws + W_CNT) + dup * 8192;
  const float rc = dup ? 0.f : 1.f;
  int* q = CT + 3800 + ci; int* xa = CT + 72 + ci; int* oa = CT + 80 + ci;
  int* cnt = CT + 128 + ci * CH_NST * 72;
  int* stamp = CT + 4096 + ci * CH_NST * 72;
  int* G = CT + 8000 + ci; int* xast = CT + 8010 + ci; int* oast = CT + 8020 + ci;
  int lastG = 0;
  const bool hasTail = ci >= 1, hasHead = ci < NL;
  const int lt = ci - 1, lh = ci;
  const int e0 = hasTail ? 288 : 0, e1 = e0 + (hasTail ? 288 : 0), e2 = e1 + (hasTail ? 384 : 0), e3 = e2 + (hasTail ? 288 : 0),
            e4 = e3 + (hasTail ? 792 : 0), e5 = e4 + (hasTail ? 288 : 0), e6 = e5 + (hasHead ? 792 : 0), e7 = e6 + (hasHead ? 288 : 0),
            e8 = e7 + (hasHead ? 224 : 0), e9 = e8 + (hasHead ? 648 : 0);
  float* X = (float*)(p.ws + W_X); u16* XB = (u16*)(p.ws + W_XB); float* SSQ = (float*)(p.ws + W_SSQ); u16* ACT = (u16*)(p.ws + W_ACT);
  const int grp = blockIdx.x & 7;
  int nxt = 0;
  if (tidx() == 0) nxt = atomicAdd(q + grp * 8, 1) * 8 + grp;
  for (;;) {
    const int tid = tidx();
    if (tid == 0) {
      const int it = nxt;
      if (it < e9) {
        int st, idx;
        if (it < e0) { st = 0; idx = it; } else if (it < e1) { st = 1; idx = it - e0; } else if (it < e2) { st = 2; idx = it - e1; }
        else if (it < e3) { st = 3; idx = it - e2; } else if (it < e4) { st = 4; idx = it - e3; } else if (it < e5) { st = 5; idx = it - e4; }
        else if (it < e6) { st = 6; idx = it - e5; } else if (it < e7) { st = 7; idx = it - e6; } else if (it < e8) { st = 8; idx = it - e7; }
        else { st = 9; idx = it - e8; }
        int pm = 0, pn = 0;
        if (st == 2) pm = idx < 256 ? ((idx >> 6) * 16 + (idx & 15)) : (64 + ((idx - 256) >> 4));
        else if (st != 8) tile_map(idx, 72, (st == 4 || st == 6) ? 11 : (st == 9 ? 9 : 4), pm, pn);
        const int* c1 = nullptr; const int* c2 = nullptr;
        switch (st) {
          case 1: c1 = stamp + 0 * 72 + pm; break;
          case 2: c1 = stamp + 1 * 72 + pm; break;
          case 3: c1 = stamp + 2 * 72 + pm; break;
          case 4: c1 = stamp + 3 * 72 + pm; c2 = xast; break;
          case 5: c1 = stamp + 4 * 72 + pm; break;
          case 6: if (hasTail) c1 = stamp + 5 * 72 + pm; break;
          case 7: c1 = stamp + 6 * 72 + pm; break;
          case 8: if (hasTail) c1 = xast; break;
          case 9: c1 = stamp + 7 * 72 + pm; if (hasTail) c2 = oast; break;
          default: break;
        }
        if (dup) { c1 = nullptr; c2 = nullptr; }
        int s1 = 0, s2 = 0;
        if (c1) while ((s1 = __hip_atomic_load(c1, __ATOMIC_RELAXED, __HIP_MEMORY_SCOPE_AGENT)) == 0) __builtin_amdgcn_s_sleep(4);
        if (c2) while ((s2 = __hip_atomic_load(c2, __ATOMIC_RELAXED, __HIP_MEMORY_SCOPE_AGENT)) == 0) __builtin_amdgcn_s_sleep(4);
        if ((s1 > s2 ? s1 : s2) >= lastG) {
          const int g = __hip_atomic_load(G, __ATOMIC_RELAXED, __HIP_MEMORY_SCOPE_AGENT);
          __builtin_amdgcn_fence(__ATOMIC_ACQUIRE, "agent");
          asm volatile("s_waitcnt vmcnt(0)" ::: "memory");
          lastG = g;
        }
        sItem[1] = st; sItem[2] = idx; sItem[3] = pm; sItem[4] = pn;
      }
      sItem[0] = it;
    }
    __syncthreads();
    if (sItem[0] >= e9) break;
    const int st = sItem[1], idx = sItem[2], pm = sItem[3], pn = sItem[4];
    if (tid == 0) nxt = atomicAdd(q + grp * 8, 1) * 8 + grp;
    if (dup && !((PROBE_MASK >> st) & 1)) { __syncthreads(); continue; }
    const u16* WTt = (const u16*)(p.ws + W_WT) + (size_t)(lt < 0 ? 0 : lt) * WE_LAYER;
    const u16* WTh = (const u16*)(p.ws + W_WT) + (size_t)(lh >= NL ? 0 : lh) * WE_LAYER;
    switch (st) {
      case 0: gemm_tile((const u16*)(p.ws + W_AO), WTt + WE_OUT, 1536, pm, pn, EpiRes{X, XB, SSQ, rc}); break;
      case 1: gemm_tile(XB, WTt + WE_MQ, 1024, pm, pn, EpiScaleBf{SSQ, (u16*)(p.ws + W_QX), 1024}); break;
      case 2: xattn_item(p, lt, idx); break;
      case 3: gemm_tile((const u16*)(p.ws + W_XO), WTt + WE_MO, 1024, pm, pn, EpiRes{X, XB, SSQ, rc}); break;
      case 4: gemm_tile(XB, WTt + WE_GU2, 1024, pm, 2 * pn, EpiGU{SSQ, ACT}); gemm_tile(XB, WTt + WE_GU2, 1024, pm, 2 * pn + 1, EpiGU{SSQ, ACT}); break;
      case 5: gemm_tile(ACT, WTt + WE_D2, DFF, pm, pn, EpiRes{X, XB, SSQ, 0.5f * rc}); break;
      case 6: gemm_tile(XB, WTh + WE_GU1, 1024, pm, 2 * pn, EpiGU{SSQ, ACT}); gemm_tile(XB, WTh + WE_GU1, 1024, pm, 2 * pn + 1, EpiGU{SSQ, ACT}); break;
      case 7: gemm_tile(ACT, WTh + WE_D1, DFF, pm, pn, EpiRes{X, XB, SSQ, 0.5f * rc}); break;
      case 8: conv_caches(p, lh, idx, 224); break;
      default: gemm_tile(XB, WTh + WE_IN, 1024, pm, pn, EpiScaleBf{SSQ, (u16*)(p.ws + W_PROJ), DINP}); break;
    }
    asm volatile("s_waitcnt vmcnt(0)" ::: "memory");
    __syncthreads();
    if (tidx() == 64) {
      __builtin_amdgcn_fence(__ATOMIC_RELEASE, "agent");
      asm volatile("s_waitcnt vmcnt(0)" ::: "memory");
      atomicAdd(G, 1);
      const int full = (st == 4 || st == 6) ? 11 : (st == 9 ? 9 : (st == 2 ? (pm < 64 ? 4 : 16) : 4));
      if (atomicAdd(cnt + st * 72 + pm, 1) + 1 == full)
        __hip_atomic_store(stamp + st * 72 + pm, __hip_atomic_load(G, __ATOMIC_RELAXED, __HIP_MEMORY_SCOPE_AGENT), __ATOMIC_RELAXED, __HIP_MEMORY_SCOPE_AGENT);
      if (st == 2 && atomicAdd(xa, 1) + 1 == 384)
        __hip_atomic_store(xast, __hip_atomic_load(G, __ATOMIC_RELAXED, __HIP_MEMORY_SCOPE_AGENT), __ATOMIC_RELAXED, __HIP_MEMORY_SCOPE_AGENT);
      if (st == 0 && atomicAdd(oa, 1) + 1 == 288)
        __hip_atomic_store(oast, __hip_atomic_load(G, __ATOMIC_RELAXED, __HIP_MEMORY_SCOPE_AGENT), __ATOMIC_RELAXED, __HIP_MEMORY_SCOPE_AGENT);
    }
  }
}

__device__ __forceinline__ void phase_final(KPR p) {
  const int tid = tidx(), wid = tid >> 6, lane = tid & 63;
  const float* X = (const float*)(p.ws + W_X); const float* fn = p.in[I_FN];
  for (int g = blockIdx.x * 8 + wid; g < T; g += gridDim.x * 8) {
    float4 v[4]; float ss = 0.f;
#pragma unroll
    for (int i = 0; i < 4; ++i) { v[i] = *(const float4*)(X + (size_t)g * 1024 + i * 256 + lane * 4); ss += v[i].x * v[i].x + v[i].y * v[i].y + v[i].z * v[i].z + v[i].w * v[i].w; }
    ss = wave_sum(ss);
    float rs = rsqrtf(ss * (1.f / 1024.f) + 1e-6f);
#pragma unroll
    for (int i = 0; i < 4; ++i) {
      float4 gn = *(const float4*)(fn + i * 256 + lane * 4);
      *(float4*)(p.out + OO_Y + (size_t)g * 1024 + i * 256 + lane * 4) = make_float4(v[i].x * rs * gn.x, v[i].y * rs * gn.y, v[i].z * rs * gn.z, v[i].w * rs * gn.w);
    }
  }
}

constexpr int NPL = 6;
constexpr int N_PHASES = 3 + NPL * NL + 1;

__device__ __forceinline__ void run_phase(KPR p, int ph) {
  if (ph == 0) { phase_init(p); return; }
  if (ph == 1) {
    for (int l = 0; l < NL; ++l) {
      const u16* WT = (const u16*)(p.ws + W_WT) + (size_t)l * WE_LAYER;
      gemm_phase((const u16*)(p.ws + W_MB), WT + WE_MK, 1024, 4, 4, (2 * l) * 16,
                 EpiMem<false>{p.out + OO_MKP + (size_t)l * 1048576, (u16*)(p.ws + W_MKP) + (size_t)l * 16 * 65536});
      gemm_phase((const u16*)(p.ws + W_MB), WT + WE_MV, 1024, 4, 4, (2 * l + 1) * 16,
                 EpiMem<true>{p.out + OO_MVP + (size_t)l * 1048576, (u16*)(p.ws + W_MVTP) + (size_t)l * 16 * 65536});
    }
    return;
  }
  if (ph == 2) { phase_chain(p, 0); if (PROBE_REP & 1) { cg::this_grid().sync(); phase_chain(p, 0, 1); } return; }
  if (ph == N_PHASES - 1) { if (PROBE_REP & 64) for (int i = 0; i < 40; ++i) cg::this_grid().sync(); phase_final(p); return; }
  const int l = (ph - 3) / NPL, s = (ph - 3) % NPL;
  const u16* WT = (const u16*)(p.ws + W_WT) + (size_t)l * WE_LAYER;
  switch (s) {
    case 0: phase_prep(p, l); if (PROBE_REP & 2) { cg::this_grid().sync(); phase_prep(p, l); } break;
    case 1:
      gemm_phase((const u16*)(p.ws + W_CQB), WT + WE_Q, 256, 72, 5, 0, EpiQ{(u16*)(p.ws + W_QB), (const float2*)(p.ws + W_ROPE)});
      gemm_phase((const u16*)(p.ws + W_A2), WT + WE_RW, 256, 72, 6, 360,
                 EpiRW{p.in[I_W0] + l * 512, p.in[I_A0] + l * 512, p.in[I_KA] + l * 512, p.ws});
      break;
    case 2: phase_cprep(p); if (PROBE_REP & 8) { cg::this_grid().sync(); phase_cprep(p); } break;
    case 3: phase_mix(p, l, 0); if (PROBE_REP & 16) { cg::this_grid().sync(); phase_mix(p, l, 2); } break;
    case 4: phase_yfin(p, l); if (PROBE_REP & 32) { cg::this_grid().sync(); phase_yfin(p, l); } break;
    default: phase_chain(p, l + 1); if (PROBE_REP & 1) { cg::this_grid().sync(); phase_chain(p, l + 1, 1); } break;
  }
}

__device__ __forceinline__ void grid_barrier(int* CT, int gen) {
  asm volatile("s_waitcnt vmcnt(0)" ::: "memory");
  __syncthreads();
  if (tidx() == 0) {
    __builtin_amdgcn_fence(__ATOMIC_RELEASE, "agent");
    asm volatile("s_waitcnt vmcnt(0)" ::: "memory");
    int* grpc = CT + 15000 + (blockIdx.x & 7) * 32;
    int* glob = CT + 15000 + 8 * 32;
    const int per = gridDim.x >> 3;
    if (atomicAdd(grpc, 1) + 1 == per * (gen + 1)) atomicAdd(glob, 1);
    while (__hip_atomic_load(glob, __ATOMIC_RELAXED, __HIP_MEMORY_SCOPE_AGENT) < 8 * (gen + 1)) __builtin_amdgcn_s_sleep(1);
    __builtin_amdgcn_fence(__ATOMIC_ACQUIRE, "agent");
    asm volatile("s_waitcnt vmcnt(0)" ::: "memory");
  }
  __syncthreads();
}

__global__ void __launch_bounds__(NTHR) mega(Params p) {
  cg::grid_group grid = cg::this_grid();
  for (int ph = p.ph_lo; ph < p.ph_hi; ++ph) {
    const __attribute__((address_space(4))) Params* q = (const __attribute__((address_space(4))) Params*)__builtin_amdgcn_kernarg_segment_ptr();
    asm volatile("" : "+s"(q));
    run_phase(*q, ph);
    if (ph + 1 < p.ph_hi) {
      if (ph == p.ph_lo) grid.sync();
      else grid_barrier((int*)(q->ws + W_CNT), ph - p.ph_lo - 1);
    }
  }
}

extern "C" void kernel_launch(void* const* d_in, const int* in_sizes, int n_in, void* d_out, int out_size, void* d_ws,
                              size_t ws_size, hipStream_t stream) {
  static int grid = 0;
  if (grid == 0) {
    if (n_in != N_IN || (size_t)out_size != OO_END || ws_size < W_END) {
      fprintf(stderr, "kernel_launch: unexpected shapes n_in=%d out=%d ws=%zu (need %zu)\n", n_in, out_size, ws_size, (size_t)W_END);
      grid = -1; return;
    }
    int dev = 0, cus = 0, per_cu = 0;
    hipGetDevice(&dev);
    hipDeviceGetAttribute(&cus, hipDeviceAttributeMultiprocessorCount, dev);
    hipFuncSetAttribute((const void*)mega, hipFuncAttributeMaxDynamicSharedMemorySize, SMEM_BYTES);
    hipOccupancyMaxActiveBlocksPerMultiprocessor(&per_cu, (const void*)mega, NTHR, SMEM_BYTES);
    if (per_cu < 1) { fprintf(stderr, "kernel_launch: occupancy query says %d blocks/CU\n", per_cu); per_cu = 1; }
    (void)hipGetLastError();
    grid = cus;
  }
  if (grid < 0) return;
  if (hipMemsetAsync((char*)d_ws + W_CNT, 0, 65536, stream) != hipSuccess) { fprintf(stderr, "kernel_launch: memset of control words failed\n"); return; }
  Params p{};
  for (int i = 0; i < N_IN; ++i) p.in[i] = (const float*)d_in[i];
  p.out = (float*)d_out; p.ws = (char*)d_ws;
#if N_LAUNCH_PER_PHASE
  for (int ph = 0; ph < N_PHASES; ++ph) {
    p.ph_lo = ph; p.ph_hi = ph + 1;
    void* args[] = {&p};
    hipError_t e = hipLaunchCooperativeKernel((const void*)mega, dim3(grid), dim3(NTHR), args, SMEM_BYTES, stream);
    if (e != hipSuccess) { fprintf(stderr, "launch failed: %s\n", hipGetErrorString(e)); break; }
  }
#else
  p.ph_lo = 0; p.ph_hi = N_PHASES;
  void* args[] = {&p};
  hipError_t e = hipLaunchCooperativeKernel((const void*)mega, dim3(grid), dim3(NTHR), args, SMEM_BYTES, stream);
  if (e != hipSuccess) fprintf(stderr, "cooperative launch failed: %s (grid %d)\n", hipGetErrorString(e), grid);
#endif
}
```

```cpp
#include <hip/hip_runtime.h>
#include <hip/hip_cooperative_groups.h>
#include <stdint.h>
#include <stdio.h>
namespace cg = cooperative_groups;

typedef unsigned short u16;
using bf16x8 = __attribute__((ext_vector_type(8))) short;
using f32x4 = __attribute__((ext_vector_type(4))) float;
using f32x16 = __attribute__((ext_vector_type(16))) float;

#ifndef REP_WHICH
#define REP_WHICH 0
#endif
#ifndef PROBE_REP
#define PROBE_REP 0
#endif
#ifndef PROBE_MASK
#define PROBE_MASK 0x3ff
#endif
#ifndef N_LAUNCH_PER_PHASE
#define N_LAUNCH_PER_PHASE 0
#endif

constexpr int TP = 16384, TS = 2048, T = TP + TS, NL = 4;
constexpr int DFF = 2816, DIN = 2208, DINP = 2304, DSH = 1792;
constexpr int NTHR = 512;
constexpr int SMEM_BYTES = 139264 + 2048;
constexpr int SMEM_ITEM = 139264 + 1024;
constexpr float QSCALE = 0.10206207261596577f * 1.4426950408889634f;
constexpr float XSCALE = 0.0625f * 1.4426950408889634f;

constexpr size_t OO_Y = 0;
constexpr size_t OO_CKVP = OO_Y + (size_t)T * 1024;
constexpr size_t OO_KRP = OO_CKVP + (size_t)NL * 4 * 4096 * 128;
constexpr size_t OO_MKP = OO_KRP + (size_t)NL * 4 * 4096 * 32;
constexpr size_t OO_MVP = OO_MKP + (size_t)NL * 4 * 256 * 1024;
constexpr size_t OO_WKVP = OO_MVP + (size_t)NL * 4 * 256 * 1024;
constexpr size_t OO_SHP = OO_WKVP + (size_t)NL * 4 * 8 * 4096;
constexpr size_t OO_CKVS = OO_SHP + (size_t)NL * 4 * DSH;
constexpr size_t OO_KRS = OO_CKVS + (size_t)NL * 32 * 64 * 128;
constexpr size_t OO_WKVS = OO_KRS + (size_t)NL * 32 * 64 * 32;
constexpr size_t OO_SHS = OO_WKVS + (size_t)NL * 32 * 8 * 4096;
constexpr size_t OO_END = OO_SHS + (size_t)NL * 32 * DSH;

constexpr size_t al256(size_t x) { return (x + 255) & ~(size_t)255; }
constexpr size_t W_X = 0;
constexpr size_t W_XB = W_X + al256((size_t)T * 1024 * 4);
constexpr size_t W_SSQ = W_XB + al256((size_t)T * 1024 * 2);
constexpr size_t W_ACT = W_SSQ + al256((size_t)T * 4 * 4);
constexpr size_t W_WB = W_ACT;
constexpr size_t W_BB = W_WB + al256((size_t)T * 512 * 4);
constexpr size_t W_GB = W_BB + al256((size_t)T * 512 * 4);
constexpr size_t W_QX = W_ACT;
constexpr size_t W_PROJ = W_ACT + al256((size_t)T * DFF * 2);
constexpr size_t W_AO = W_PROJ;
constexpr size_t W_CQB = W_PROJ + al256((size_t)T * DINP * 2);
constexpr size_t W_A2 = W_CQB + al256((size_t)T * 256 * 2);
constexpr size_t W_QB = W_A2 + al256((size_t)T * 256 * 2);
constexpr size_t W_XO = W_QB;
constexpr size_t W_RB = W_QB + al256((size_t)T * 1280 * 2);
constexpr size_t W_KB = W_RB + al256((size_t)T * 512 * 4);
constexpr size_t W_VB = W_KB + al256((size_t)T * 512 * 4);
constexpr size_t W_KKB = W_VB + al256((size_t)T * 512 * 4);
constexpr size_t W_KP = W_KKB + al256((size_t)T * 512 * 4);
constexpr size_t W_KS = W_KP + al256((size_t)4 * 4096 * 160 * 2);
constexpr size_t W_VTP = W_KS + al256((size_t)32 * 2112 * 160 * 2);
constexpr size_t W_VTS = W_VTP + al256((size_t)4 * 128 * 4096 * 2);
constexpr size_t W_MKP = W_VTS + al256((size_t)32 * 128 * 2112 * 2);
constexpr size_t W_MVTP = W_MKP + al256((size_t)NL * 16 * 65536 * 2);
constexpr size_t W_MKS = W_MVTP + al256((size_t)NL * 16 * 65536 * 2);
constexpr size_t W_MVTS = W_MKS + al256((size_t)128 * 65536 * 2);
constexpr size_t W_MB = W_MVTS + al256((size_t)128 * 65536 * 2);
constexpr size_t W_ROPE = W_MB + al256((size_t)1024 * 1024 * 2);
constexpr size_t W_CNT = W_ROPE + al256((size_t)4096 * 16 * 8);
constexpr size_t W_YB = W_CNT + 65536;
constexpr size_t W_CQ = W_YB + al256((size_t)T * 512 * 4);
constexpr size_t W_WT = W_CQ + al256((size_t)2304 * 4096 * 4);
constexpr size_t W_CRR = W_PROJ + al256((size_t)T * 1536 * 2);
constexpr size_t W_CPT = W_CQB;
static_assert(W_CRR + (size_t)2304 * 4096 * 2 <= W_CQB, "RRt must fit behind AO");
static_assert((size_t)2304 * 4096 * 2 <= 2 * al256((size_t)T * 256 * 2), "Pt must fit in CQB+A2");
constexpr size_t WE_GU1 = 0;
constexpr size_t WE_D1 = WE_GU1 + (size_t)5632 * 1024;
constexpr size_t WE_IN = WE_D1 + (size_t)1024 * DFF;
constexpr size_t WE_Q = WE_IN + (size_t)DINP * 1024;
constexpr size_t WE_RW = WE_Q + (size_t)1280 * 256;
constexpr size_t WE_OUT = WE_RW + (size_t)1536 * 256;
constexpr size_t WE_MQ = WE_OUT + (size_t)1024 * 1536;
constexpr size_t WE_MK = WE_MQ + (size_t)1024 * 1024;
constexpr size_t WE_MV = WE_MK + (size_t)1024 * 1024;
constexpr size_t WE_MO = WE_MV + (size_t)1024 * 1024;
constexpr size_t WE_GU2 = WE_MO + (size_t)1024 * 1024;
constexpr size_t WE_D2 = WE_GU2 + (size_t)5632 * 1024;
constexpr size_t WE_LAYER = WE_D2 + (size_t)1024 * DFF;
constexpr size_t W_END = W_WT + al256(WE_LAYER * NL * 2);

enum { I_XP = 0, I_XS, I_MEMP, I_CCKV, I_CKR, I_CMK, I_CMV, I_SWKV, I_SSH, I_F1N, I_F1G, I_F1U, I_F1D, I_MIXN, I_WIN,
       I_QN, I_WUQ, I_KVN, I_WUK, I_WUV, I_MU, I_W0, I_WUP, I_A0, I_AUP, I_GUP, I_KK, I_KA, I_RK, I_GNG, I_GNB, I_WOUT,
       I_XN, I_MKVN, I_WMQ, I_WMK, I_WMV, I_WMO, I_F2N, I_F2G, I_F2U, I_F2D, I_FN, N_IN };

struct Params {
  const float* in[N_IN];
  float* out;
  char* ws;
  int ph_lo, ph_hi;
};

typedef const __attribute__((address_space(4))) Params& KPR;

typedef __bf16 bf2_t __attribute__((ext_vector_type(2)));
typedef float f2_t __attribute__((ext_vector_type(2)));
__device__ __forceinline__ u16 f2bf(float f) { __bf16 b = (__bf16)f; return __builtin_bit_cast(u16, b); }
__device__ __forceinline__ float bf2f(u16 h) { return __uint_as_float(((unsigned)h) << 16); }
__device__ __forceinline__ unsigned pack2(float a, float b) { f2_t v = {a, b}; bf2_t r = __builtin_convertvector(v, bf2_t); return __builtin_bit_cast(unsigned, r); }
__device__ __forceinline__ float4 bf4(uint2 w) {
  return make_float4(__uint_as_float(w.x << 16), __uint_as_float(w.x & 0xffff0000u), __uint_as_float(w.y << 16), __uint_as_float(w.y & 0xffff0000u));
}
__device__ __forceinline__ float wave_sum(float x) {
#pragma unroll
  for (int o = 32; o; o >>= 1) x += __shfl_xor(x, o);
  return x;
}
__device__ __forceinline__ float dpp_sum8(float x) {
  x += __int_as_float(__builtin_amdgcn_update_dpp(0, __float_as_int(x), 0xB1, 0xF, 0xF, false));
  x += __int_as_float(__builtin_amdgcn_update_dpp(0, __float_as_int(x), 0x4E, 0xF, 0xF, false));
  x += __int_as_float(__builtin_amdgcn_update_dpp(0, __float_as_int(x), 0x141, 0xF, 0xF, false));
  return x;
}
__device__ __forceinline__ int tidx() { int t = threadIdx.x; asm volatile("" : "+v"(t)); return t; }
__device__ __forceinline__ float fma_s(float a, float b, float c) { float d; asm("v_fma_f32 %0, %1, %2, %3" : "=v"(d) : "v"(a), "v"(b), "v"(c)); return d; }
__device__ __forceinline__ float sub_s(float a, float b) { float d; asm("v_sub_f32 %0, %1, %2" : "=v"(d) : "v"(a), "v"(b)); return d; }
__device__ __forceinline__ float add_s(float a, float b) { float d; asm("v_add_f32 %0, %1, %2" : "=v"(d) : "v"(a), "v"(b)); return d; }
__device__ __forceinline__ float mul_s(float a, float b) { float d; asm("v_mul_f32 %0, %1, %2" : "=v"(d) : "v"(a), "v"(b)); return d; }
__device__ __forceinline__ float sigmoidf_(float x) { return 1.f / (1.f + __expf(-x)); }

constexpr int BM = 256, BK = 64, HALF = 128, HT = HALF * BK;

__device__ __forceinline__ int lds_byte(int r, int c) {
  int st = (r >> 4) * 2 + (c >> 5), rr = r & 15, cc = c & 31, ob = rr * 64 + cc * 2;
  return st * 1024 + (ob ^ (((ob >> 9) & 1) << 5));
}
__device__ __forceinline__ void stage_rc(int b, int& R, int& C) {
  int st = b / 1024, sb = b % 1024, swz = sb ^ (((sb >> 9) & 1) << 5);
  R = (st >> 1) * 16 + swz / 64; C = (st & 1) * 32 + (swz % 64) / 2;
}

__device__ __forceinline__ void tile_map(int tile, int nM, int nN, int& pm, int& pn) {
  const int ntiles = nM * nN;
  int wgid = tile;
  { int q = ntiles / 8, r = ntiles % 8, xcd = wgid % 8, off = wgid / 8;
    wgid = (xcd < r ? xcd * (q + 1) : r * (q + 1) + (xcd - r) * q) + off; }
  int nig = 8 * nN, gid = wgid / nig, fm = gid * 8, gsz = min(nM - fm, 8);
  pm = fm + ((wgid % nig) % gsz); pn = (wgid % nig) / gsz;
}

template <class Epi>
__device__ __forceinline__ void gemm_tile(const u16* __restrict__ A, const u16* __restrict__ Bt, const int K,
                                          const int pm, const int pn, Epi epi) {
  extern __shared__ __attribute__((aligned(16))) char smem[];
  u16* shm = (u16*)smem;
#define SA(b, h) (shm + ((b) * 2 + (h)) * HT)
#define SB(b, h) (shm + (4 + (b) * 2 + (h)) * HT)
#define STAGE(P, BASE, br, kt) do { const u16* _gb = BASE + ((long)(br) * K + (long)(kt) * BK); \
    __builtin_amdgcn_global_load_lds((const unsigned*)((const char*)_gb + so0), \
        (__attribute__((address_space(3))) unsigned*)((char*)(P) + wu16), 16, 0, 0); \
    __builtin_amdgcn_global_load_lds((const unsigned*)((const char*)_gb + so1), \
        (__attribute__((address_space(3))) unsigned*)((char*)(P) + wu16 + 8192), 16, 0, 0); } while (0)
#define LDA(dst, b, h) for (int m = 0; m < 4; ++m) for (int k = 0; k < 2; ++k) \
    dst[m][k] = *reinterpret_cast<const bf16x8*>((char*)SA(b, h) + lds_byte(wr * 64 + m * 16 + fr, k * 32 + fq * 8))
#define LDB(dst, b, h) for (int n = 0; n < 2; ++n) for (int k = 0; k < 2; ++k) \
    dst[n][k] = *reinterpret_cast<const bf16x8*>((char*)SB(b, h) + lds_byte(wc * 32 + n * 16 + fr, k * 32 + fq * 8))
#define MMA(ai, bj, At_, Bt_) do { __builtin_amdgcn_s_setprio(1); \
    for (int m = 0; m < 4; ++m) for (int n = 0; n < 2; ++n) for (int k = 0; k < 2; ++k) \
      acc[ai][bj][m][n] = __builtin_amdgcn_mfma_f32_16x16x32_bf16(At_[m][k], Bt_[n][k], acc[ai][bj][m][n], 0, 0, 0); \
    __builtin_amdgcn_s_setprio(0); } while (0)
#define WAIT_V(n) asm volatile("s_waitcnt vmcnt(" #n ")" ::: "memory")
#define WAIT_L(n) asm volatile("s_waitcnt lgkmcnt(" #n ")" ::: "memory")
#define BAR __builtin_amdgcn_s_barrier()
#define SCHED __builtin_amdgcn_sched_barrier(0)
  const int tid_ = tidx();
  const int wid = tid_ >> 6, lane = tid_ & 63, wr = wid >> 2, wc = wid & 3, fr = lane & 15, fq = lane >> 4;
  const int nt = K / BK;
  const int wu16 = __builtin_amdgcn_readfirstlane(tid_ >> 6) * 1024;
  {
    unsigned so0, so1;
    { int _r, _c; stage_rc(tid_ * 16, _r, _c); so0 = (unsigned)(_r * K + _c) * 2u;
      stage_rc(tid_ * 16 + 8192, _r, _c); so1 = (unsigned)(_r * K + _c) * 2u; }
    const int brow = pm * BM, bcol = pn * BM;
    f32x4 acc[2][2][4][2] = {};
    bf16x8 At[4][2], B0[2][2], B1[2][2];
    STAGE(SB(0, 0), Bt, bcol, 0); STAGE(SA(0, 0), A, brow, 0);
    STAGE(SB(0, 1), Bt, bcol + HALF, 0); STAGE(SA(0, 1), A, brow + HALF, 0);
    if (wr == 1) BAR;
    WAIT_V(4); BAR;
    STAGE(SB(1, 0), Bt, bcol, 1); STAGE(SA(1, 0), A, brow, 1); STAGE(SB(1, 1), Bt, bcol + HALF, 1);
    WAIT_V(6); BAR;
    for (int t = 0; t < nt - 2; t += 2) {
      LDB(B0, 0, 0); SCHED; LDA(At, 0, 0); STAGE(SA(1, 1), A, brow + HALF, t + 1);
      WAIT_L(8); BAR; WAIT_L(0); MMA(0, 0, At, B0); BAR; SCHED;
      LDB(B1, 0, 1); STAGE(SB(0, 0), Bt, bcol, t + 2);
      BAR; WAIT_L(0); MMA(0, 1, At, B1); BAR;
      LDA(At, 0, 1); STAGE(SA(0, 0), A, brow, t + 2);
      BAR; WAIT_L(0); MMA(1, 0, At, B0); BAR; SCHED;
      STAGE(SB(0, 1), Bt, bcol + HALF, t + 2);
      WAIT_V(6); BAR; MMA(1, 1, At, B1); BAR;
      LDB(B0, 1, 0); SCHED; LDA(At, 1, 0); STAGE(SA(0, 1), A, brow + HALF, t + 2);
      WAIT_L(8); BAR; WAIT_L(0); MMA(0, 0, At, B0); BAR; SCHED;
      LDB(B1, 1, 1); STAGE(SB(1, 0), Bt, bcol, t + 3);
      BAR; WAIT_L(0); MMA(0, 1, At, B1); BAR;
      LDA(At, 1, 1); STAGE(SA(1, 0), A, brow, t + 3);
      BAR; WAIT_L(0); MMA(1, 0, At, B0); BAR; SCHED;
      STAGE(SB(1, 1), Bt, bcol + HALF, t + 3);
      WAIT_V(6); BAR; MMA(1, 1, At, B1); BAR;
    }
    { LDB(B0, 0, 0); LDA(At, 0, 0); STAGE(SA(1, 1), A, brow + HALF, nt - 1);
      BAR; WAIT_L(0); MMA(0, 0, At, B0); BAR;
      LDB(B1, 0, 1); BAR; WAIT_L(0); MMA(0, 1, At, B1); BAR;
      LDA(At, 0, 1); WAIT_V(4); BAR; WAIT_L(0); MMA(1, 0, At, B0); MMA(1, 1, At, B1); BAR; }
    { LDB(B0, 1, 0); LDA(At, 1, 0); WAIT_V(2); BAR; WAIT_L(0); MMA(0, 0, At, B0); BAR;
      LDB(B1, 1, 1); WAIT_V(0); BAR; WAIT_L(0); MMA(0, 1, At, B1); BAR;
      LDA(At, 1, 1); BAR; WAIT_L(0); MMA(1, 0, At, B0); MMA(1, 1, At, B1); BAR; }
    if (wr == 0) BAR;
    float* stg = (float*)smem;
    int tx = tid_;
    asm volatile("" : "+v"(tx));
    const int ewr = tx >> 8, ewc = (tx >> 6) & 3, efr = tx & 15, efq = (tx >> 4) & 3;
#define EPI_HALF(ai) do { \
    __syncthreads(); \
    _Pragma("unroll") for (int bj = 0; bj < 2; ++bj) _Pragma("unroll") for (int m = 0; m < 4; ++m) \
    _Pragma("unroll") for (int n = 0; n < 2; ++n) _Pragma("unroll") for (int j = 0; j < 4; ++j) \
      stg[(ewr * 64 + m * 16 + efq * 4 + j) * 260 + bj * HALF + ewc * 32 + n * 16 + efr] = acc[ai][bj][m][n][j]; \
    __syncthreads(); \
    for (int i = 0; i < 8; ++i) { \
      int item = i * NTHR + tx; int rl = item >> 5, qp = item & 31; \
      int cl = (qp >> 2) * 32 + (qp & 3) * 4; \
      float4 v0 = *(const float4*)(stg + rl * 260 + cl), v1 = *(const float4*)(stg + rl * 260 + cl + 16); \
      int row = brow + ai * HALF + rl; \
      float ss = epi.apply4(row, bcol + cl, v0, v1); \
      if (Epi::kSsq) { \
        ss += __shfl_xor(ss, 1); ss += __shfl_xor(ss, 2); ss += __shfl_xor(ss, 4); ss += __shfl_xor(ss, 8); ss += __shfl_xor(ss, 16); \
        if (qp == 0) epi.ssq_out(row, pn, ss); \
      } \
    } } while (0)
    EPI_HALF(0);
    EPI_HALF(1);
#undef EPI_HALF
    __syncthreads();
  }
#undef SA
#undef SB
#undef STAGE
#undef LDA
#undef LDB
#undef MMA
}

template <class Epi>
__device__ __forceinline__ void gemm_phase(const u16* __restrict__ A, const u16* __restrict__ Bt, const int K,
                                           const int nM, const int nN, const int rot, Epi epi) {
  const int G = gridDim.x;
  for (int tile = (int)((blockIdx.x + G - (rot % G)) % G); tile < nM * nN; tile += G) {
    int pm, pn; tile_map(tile, nM, nN, pm, pn);
    gemm_tile(A, Bt, K, pm, pn, epi);
  }
}

__device__ __forceinline__ float rstd_from_ssq(const float* ssq, int row) {
  float4 s = *(const float4*)(ssq + (size_t)row * 4);
  return rsqrtf((s.x + s.y + s.z + s.w) * (1.f / 1024.f) + 1e-6f);
}
__device__ __forceinline__ uint2 pack4(float4 v) { uint2 w; w.x = pack2(v.x, v.y); w.y = pack2(v.z, v.w); return w; }
__device__ __forceinline__ float silu_mul(float g, float u) { return g / (1.f + __expf(-g)) * u; }
struct EpiGU {
  static constexpr bool kSsq = false;
  const float* ssq; u16* act;
  __device__ __forceinline__ float apply4(int row, int c0, float4 g, float4 u) const {
    float rs = rstd_from_ssq(ssq, row);
    float4 o = make_float4(silu_mul(g.x * rs, u.x * rs), silu_mul(g.y * rs, u.y * rs), silu_mul(g.z * rs, u.z * rs), silu_mul(g.w * rs, u.w * rs));
    *(uint2*)(act + (size_t)row * DFF + ((c0 & ~31) >> 1) + (c0 & 15)) = pack4(o);
    return 0.f;
  }
  __device__ __forceinline__ void ssq_out(int, int, float) const {}
};
struct EpiRes {
  static constexpr bool kSsq = true;
  float* x; u16* xb; float* ssq; float coef;
  __device__ __forceinline__ float apply4(int row, int c0, float4 v0, float4 v1) const {
    size_t i = (size_t)row * 1024 + c0;
    float4 a = *(const float4*)(x + i), b = *(const float4*)(x + i + 16);
    a.x += coef * v0.x; a.y += coef * v0.y; a.z += coef * v0.z; a.w += coef * v0.w;
    b.x += coef * v1.x; b.y += coef * v1.y; b.z += coef * v1.z; b.w += coef * v1.w;
    *(float4*)(x + i) = a; *(float4*)(x + i + 16) = b;
    *(uint2*)(xb + i) = pack4(a); *(uint2*)(xb + i + 16) = pack4(b);
    return a.x * a.x + a.y * a.y + a.z * a.z + a.w * a.w + b.x * b.x + b.y * b.y + b.z * b.z + b.w * b.w;
  }
  __device__ __forceinline__ void ssq_out(int row, int pn, float v) const { ssq[(size_t)row * 4 + pn] = v; }
};
struct EpiScaleBf {
  static constexpr bool kSsq = false;
  const float* ssq; u16* o; int ld;
  __device__ __forceinline__ float apply4(int row, int c0, float4 v0, float4 v1) const {
    float rs = rstd_from_ssq(ssq, row);
    size_t i = (size_t)row * ld + c0;
    *(uint2*)(o + i) = pack4(make_float4(v0.x * rs, v0.y * rs, v0.z * rs, v0.w * rs));
    *(uint2*)(o + i + 16) = pack4(make_float4(v1.x * rs, v1.y * rs, v1.z * rs, v1.w * rs));
    return 0.f;
  }
  __device__ __forceinline__ void ssq_out(int, int, float) const {}
};
struct EpiQ {
  static constexpr bool kSsq = false;
  u16* qb; const float2* rope;
  __device__ __forceinline__ float apply4(int row, int c0, float4 v0, float4 v1) const {
    if (c0 < 1024) {
      size_t i = (size_t)row * 1280 + (c0 >> 7) * 160 + (c0 & 127);
      *(uint2*)(qb + i) = pack4(v0); *(uint2*)(qb + i + 16) = pack4(v1);
    } else {
      int h = (c0 - 1024) >> 5, f0 = c0 & 15;
      int pos = row < TP ? (row & 4095) : (2048 + ((row - TP) & 63));
      const float2* cs = rope + pos * 16 + f0;
      float2 c_0 = cs[0], c_1 = cs[1], c_2 = cs[2], c_3 = cs[3];
      size_t i = (size_t)row * 1280 + h * 160 + 128 + f0;
      *(uint2*)(qb + i) = pack4(make_float4(v0.x * c_0.x - v1.x * c_0.y, v0.y * c_1.x - v1.y * c_1.y, v0.z * c_2.x - v1.z * c_2.y, v0.w * c_3.x - v1.w * c_3.y));
      *(uint2*)(qb + i + 16) = pack4(make_float4(v0.x * c_0.y + v1.x * c_0.x, v0.y * c_1.y + v1.y * c_1.x, v0.z * c_2.y + v1.z * c_2.x, v0.w * c_3.y + v1.w * c_3.x));
    }
    return 0.f;
  }
  __device__ __forceinline__ void ssq_out(int, int, float) const {}
};
__device__ __forceinline__ float decay_f(float z) {
  float nz = -z;
  float sp = fmaxf(nz, 0.f) + __logf(1.f + __expf(-fabsf(nz)));
  return __expf(-__expf(-sp - 0.5f));
}
struct EpiRW {
  static constexpr bool kSsq = false;
  const float* w0; const float* a0; const float* ka; char* ws;
  __device__ __forceinline__ void acol(size_t i, int c, float4 v) const {
    u16* bb = (u16*)(ws + W_BB); float* kb = (float*)(ws + W_KB); const u16* kkb = (const u16*)(ws + W_KKB);
    float4 a_0 = *(const float4*)(a0 + c), k_a = *(const float4*)(ka + c), kk = bf4(*(const uint2*)(kkb + i)), k = *(const float4*)(kb + i);
    float4 a = make_float4(sigmoidf_(a_0.x + v.x), sigmoidf_(a_0.y + v.y), sigmoidf_(a_0.z + v.z), sigmoidf_(a_0.w + v.w));
    *(uint2*)(bb + i) = pack4(make_float4(kk.x * a.x, kk.y * a.y, kk.z * a.z, kk.w * a.w));
    *(float4*)(kb + i) = make_float4(k.x * (1.f + (a.x - 1.f) * k_a.x), k.y * (1.f + (a.y - 1.f) * k_a.y), k.z * (1.f + (a.z - 1.f) * k_a.z), k.w * (1.f + (a.w - 1.f) * k_a.w));
  }
  __device__ __forceinline__ float apply4(int row, int c0, float4 v0, float4 v1) const {
    if (c0 < 512) {
      float* wb = (float*)(ws + W_WB);
      float4 z0 = *(const float4*)(w0 + c0), z1 = *(const float4*)(w0 + c0 + 16);
      size_t i = (size_t)row * 512 + c0;
      *(float4*)(wb + i) = make_float4(decay_f(z0.x + v0.x), decay_f(z0.y + v0.y), decay_f(z0.z + v0.z), decay_f(z0.w + v0.w));
      *(float4*)(wb + i + 16) = make_float4(decay_f(z1.x + v1.x), decay_f(z1.y + v1.y), decay_f(z1.z + v1.z), decay_f(z1.w + v1.w));
    } else if (c0 < 1024) {
      int c = c0 - 512; size_t i = (size_t)row * 512 + c;
      acol(i, c, v0); acol(i + 16, c + 16, v1);
    } else {
      u16* gb = (u16*)(ws + W_GB);
      size_t i = (size_t)row * 512 + (c0 - 1024);
      *(uint2*)(gb + i) = pack4(v0); *(uint2*)(gb + i + 16) = pack4(v1);
    }
    return 0.f;
  }
  __device__ __forceinline__ void ssq_out(int, int, float) const {}
};
template <bool ISV>
struct EpiMem {
  static constexpr bool kSsq = false;
  float* of; u16* ob;
  __device__ __forceinline__ void quad(int row, int col, float4 v) const {
    *(float4*)(of + (size_t)row * 1024 + col) = v;
    int b = row >> 8, m = row & 255, h = col >> 8, d = col & 255;
    if (ISV) {
      u16* o = ob + (size_t)((b * 4 + h) * 256 + d) * 256 + m;
      o[0] = f2bf(v.x); o[256] = f2bf(v.y); o[512] = f2bf(v.z); o[768] = f2bf(v.w);
    } else {
      *(uint2*)(ob + (size_t)((b * 4 + h) * 256 + m) * 256 + d) = pack4(v);
    }
  }
  __device__ __forceinline__ float apply4(int row, int c0, float4 v0, float4 v1) const {
    quad(row, c0, v0); quad(row, c0 + 16, v1);
    return 0.f;
  }
  __device__ __forceinline__ void ssq_out(int, int, float) const {}
};

template <class F>
__device__ __forceinline__ void tconv(u16* dst, int ldd, int N, int K, int rot, F f) {
  extern __shared__ __attribute__((aligned(16))) char smem[];
  float* t = (float*)smem;
  const int nk = K / 64, nt = (N / 64) * nk, G = gridDim.x;
  const int tid = tidx(), a = tid >> 6, c = tid & 63;
  for (int tile = (int)((blockIdx.x + G - (rot % G)) % G); tile < nt; tile += G) {
    int n0 = (tile / nk) * 64, k0 = (tile % nk) * 64;
    __syncthreads();
#pragma unroll
    for (int i = 0; i < 8; ++i) { int kk = a + 8 * i; t[kk * 65 + c] = f(k0 + kk, n0 + c); }
    __syncthreads();
#pragma unroll
    for (int i = 0; i < 2; ++i) {
      const int nn = (tid >> 4) + 32 * i, kq = (tid & 15) * 4;
      uint2 w; w.x = pack2(t[kq * 65 + nn], t[(kq + 1) * 65 + nn]); w.y = pack2(t[(kq + 2) * 65 + nn], t[(kq + 3) * 65 + nn]);
      *(uint2*)(dst + (size_t)(n0 + nn) * ldd + k0 + kq) = w;
    }
  }
}

template <class F>
__device__ __forceinline__ void tconv_v(u16* dst, int ldd, int N, int K, int vb, int nvb, F f) {
  extern __shared__ __attribute__((aligned(16))) char smem[];
  float* t = (float*)smem;
  const int nk = K / 64, nt = (N / 64) * nk;
  const int tid = tidx(), a = tid >> 6, c = tid & 63;
  for (int tile = vb; tile < nt; tile += nvb) {
    int n0 = (tile / nk) * 64, k0 = (tile % nk) * 64;
    __syncthreads();
#pragma unroll
    for (int i = 0; i < 8; ++i) { int kk = a + 8 * i; t[kk * 65 + c] = f(k0 + kk, n0 + c); }
    __syncthreads();
#pragma unroll
    for (int i = 0; i < 2; ++i) {
      const int nn = (tid >> 4) + 32 * i, kq = (tid & 15) * 4;
      uint2 w; w.x = pack2(t[kq * 65 + nn], t[(kq + 1) * 65 + nn]); w.y = pack2(t[(kq + 2) * 65 + nn], t[(kq + 3) * 65 + nn]);
      *(uint2*)(dst + (size_t)(n0 + nn) * ldd + k0 + kq) = w;
    }
  }
  __syncthreads();
}

template <int DK, int DV, int RPG>
__device__ __forceinline__ void attn_item(const u16* __restrict__ Qb, int ldq, int nrows, const u16* __restrict__ Kb, int ldk,
                                          const u16* __restrict__ Vtb, int ldvt, int nkeys, u16* __restrict__ Ob, int ldo) {
  extern __shared__ __attribute__((aligned(16))) char smem[];
  constexpr int KS = DK + 8, VS = 68;
  u16* sK = (u16*)smem;
  u16* sV = sK + 64 * KS;
  const int tid = tidx(), wid = tid >> 6, lane = tid & 63, q = lane & 31, hh = lane >> 5;
  const int row = wid * 32 + q;
  const bool active = (wid * 32) < nrows;
  bf16x8 qf[DK / 16];
  if (active) {
#pragma unroll
    for (int ks = 0; ks < DK / 16; ++ks) qf[ks] = *(const bf16x8*)(Qb + (size_t)row * ldq + ks * 16 + hh * 8);
  }
  f32x16 o[DV / 32];
#pragma unroll
  for (int dt = 0; dt < DV / 32; ++dt)
#pragma unroll
    for (int i = 0; i < 16; ++i) o[dt][i] = 0.f;
  float mrun = -1e30f, lrun = 0.f;
  const int nkt = nkeys >> 6;
  constexpr int KCH = (64 * (DK / 8) + NTHR - 1) / NTHR;
  static_assert(DV == 128 && KCH <= 4, "staging registers are written out by hand");
  uint4 kr0, kr1, kr2, kr3, vr0, vr1;
#define AT_KL(N_, kt_) { const int c = tid + N_ * NTHR; if (N_ < KCH && c < 64 * (DK / 8)) { const int r = c / (DK / 8), cc = c % (DK / 8); \
      kr##N_ = *(const uint4*)(Kb + (size_t)((kt_) * 64 + r) * ldk + cc * 8); } }
#define AT_VL(N_, kt_) { const int c = tid + N_ * NTHR; const int r = c >> 3, cc = c & 7; vr##N_ = *(const uint4*)(Vtb + (size_t)r * ldvt + (kt_) * 64 + cc * 8); }
#define AT_GLOAD(kt_) do { AT_KL(0, kt_) AT_KL(1, kt_) AT_KL(2, kt_) AT_KL(3, kt_) AT_VL(0, kt_) AT_VL(1, kt_) } while (0)
#define AT_KS(N_) { const int c = tid + N_ * NTHR; if (N_ < KCH && c < 64 * (DK / 8)) { const int r = c / (DK / 8), cc = c % (DK / 8); *(uint4*)(sK + r * KS + cc * 8) = kr##N_; } }
#define AT_VS(N_) { const int c = tid + N_ * NTHR; const int r = c >> 3, cc = c & 7; uint2* d = (uint2*)(sV + r * VS + cc * 8); \
      const uint4 t_ = vr##N_; d[0] = make_uint2(t_.x, t_.y); d[1] = make_uint2(t_.z, t_.w); }
  AT_GLOAD(0);
  for (int kt = 0; kt < nkt; ++kt) {
    __syncthreads();
    AT_KS(0) AT_KS(1) AT_KS(2) AT_KS(3) AT_VS(0) AT_VS(1)
    __syncthreads();
    if (kt + 1 < nkt) AT_GLOAD(kt + 1);
    if (active) {
      f32x16 s0, s1;
#pragma unroll
      for (int i = 0; i < 16; ++i) { s0[i] = 0.f; s1[i] = 0.f; }
#pragma unroll
      for (int ks = 0; ks < DK / 16; ++ks) {
        bf16x8 a0 = *(const bf16x8*)(sK + q * KS + ks * 16 + hh * 8);
        bf16x8 a1 = *(const bf16x8*)(sK + (32 + q) * KS + ks * 16 + hh * 8);
        s0 = __builtin_amdgcn_mfma_f32_32x32x16_bf16(a0, qf[ks], s0, 0, 0, 0);
        s1 = __builtin_amdgcn_mfma_f32_32x32x16_bf16(a1, qf[ks], s1, 0, 0, 0);
      }
      float mx = s0[0];
#pragma unroll
      for (int i = 1; i < 16; ++i) mx = fmaxf(mx, s0[i]);
#pragma unroll
      for (int i = 0; i < 16; ++i) mx = fmaxf(mx, s1[i]);
      mx = fmaxf(mx, __shfl_xor(mx, 32));
      float mn = fmaxf(mrun, mx);
      float alpha = __builtin_amdgcn_exp2f(mrun - mn);
      mrun = mn;
      float ps = 0.f;
#pragma unroll
      for (int i = 0; i < 16; ++i) { s0[i] = __builtin_amdgcn_exp2f(sub_s(s0[i], mn)); ps = add_s(ps, s0[i]); }
#pragma unroll
      for (int i = 0; i < 16; ++i) { s1[i] = __builtin_amdgcn_exp2f(sub_s(s1[i], mn)); ps = add_s(ps, s1[i]); }
      lrun = lrun * alpha + ps;
#pragma unroll
      for (int dt = 0; dt < DV / 32; ++dt)
#pragma unroll
        for (int i = 0; i < 16; ++i) o[dt][i] = mul_s(o[dt][i], alpha);
#pragma unroll
      for (int kb = 0; kb < 2; ++kb)
#pragma unroll
        for (int s = 0; s < 2; ++s) {
          union { bf16x8 v; unsigned u[4]; } pf;
#pragma unroll
          for (int jj = 0; jj < 4; ++jj) {
            float e0 = kb ? s1[8 * s + 2 * jj] : s0[8 * s + 2 * jj];
            float e1 = kb ? s1[8 * s + 2 * jj + 1] : s0[8 * s + 2 * jj + 1];
            pf.u[jj] = pack2(e0, e1);
          }
          const int kbase = kb * 32 + s * 16 + 4 * hh;
#pragma unroll
          for (int dt = 0; dt < DV / 32; ++dt) {
            const u16* vp = sV + (dt * 32 + q) * VS + kbase;
            union { bf16x8 v; uint2 u[2]; } vf;
            vf.u[0] = *(const uint2*)vp; vf.u[1] = *(const uint2*)(vp + 8);
            o[dt] = __builtin_amdgcn_mfma_f32_32x32x16_bf16(vf.v, pf.v, o[dt], 0, 0, 0);
          }
        }
    }
  }
  if (active) {
    lrun += __shfl_xor(lrun, 32);
    float inv = 1.f / lrun;
    u16* op = Ob + (size_t)(row / RPG) * ldo + (size_t)(row % RPG) * DV;
#pragma unroll
    for (int dt = 0; dt < DV / 32; ++dt)
#pragma unroll
      for (int g = 0; g < 4; ++g) {
        uint2 w;
        w.x = pack2(o[dt][4 * g] * inv, o[dt][4 * g + 1] * inv);
        w.y = pack2(o[dt][4 * g + 2] * inv, o[dt][4 * g + 3] * inv);
        *(uint2*)(op + dt * 32 + 8 * g + 4 * hh) = w;
      }
  }
}

#undef AT_GLOAD
#undef AT_KL
#undef AT_VL
#undef AT_KS
#undef AT_VS
__device__ __forceinline__ float dpp_sum16(float x) {
  x += __int_as_float(__builtin_amdgcn_update_dpp(0, __float_as_int(x), 0xB1, 0xF, 0xF, false));
  x += __int_as_float(__builtin_amdgcn_update_dpp(0, __float_as_int(x), 0x4E, 0xF, 0xF, false));
  x += __int_as_float(__builtin_amdgcn_update_dpp(0, __float_as_int(x), 0x141, 0xF, 0xF, false));
  x += __int_as_float(__builtin_amdgcn_update_dpp(0, __float_as_int(x), 0x140, 0xF, 0xF, false));
  return x;
}
__device__ __forceinline__ void scan_item(KPR p, int l, int g0, int h, int half, int nsteps, const float* S0, float* Sout) {
  extern __shared__ __attribute__((aligned(16))) char smem[];
  float* sT = (float*)smem;
  float* sV = sT + 5 * 4096;
  const float* src0 = (const float*)(p.ws + W_RB) + h * 64; const float* src1 = (const float*)(p.ws + W_WB) + h * 64;
  const float* src2 = (const float*)(p.ws + W_KB) + h * 64; const float* src3 = (const float*)(p.ws + W_KKB) + h * 64;
  const float* src4 = (const float*)(p.ws + W_BB) + h * 64;
  const float* VB = (const float*)(p.ws + W_VB) + h * 64 + half * 32;
  float* YB = (float*)(p.ws + W_YB) + h * 64 + half * 32;
  const int tid = tidx();
  const int il = tid >> 4, sub = tid & 15, j0 = sub * 4, i = half * 32 + il;
  float s[4];
#pragma unroll
  for (int j = 0; j < 4; ++j) s[j] = S0 ? S0[i * 64 + j0 + j] : 0.f;
  float4 pa0, pa1, pa2, pa3, pa4, pb0, pb1, pb2, pb3, pb4, pfv;
  const int e0 = tid, e1 = tid + NTHR;
  const int st0 = e0 >> 4, c40 = (e0 & 15) * 4, st1 = e1 >> 4, c41 = (e1 & 15) * 4;
  const int stv = tid >> 3, c4v = (tid & 7) * 4;
#define SC_GL1(x, c0_) pa##x = *(const float4*)(src##x + (size_t)(g0 + (c0_) + st0) * 512 + c40); \
                       pb##x = *(const float4*)(src##x + (size_t)(g0 + (c0_) + st1) * 512 + c41);
#define SC_GLOAD(c0_) do { SC_GL1(0, c0_) SC_GL1(1, c0_) SC_GL1(2, c0_) SC_GL1(3, c0_) SC_GL1(4, c0_) \
    pfv = *(const float4*)(VB + (size_t)(g0 + (c0_) + stv) * 512 + c4v); } while (0)
#define SC_ST1(x) *(float4*)(sT + x * 4096 + st0 * 64 + c40) = pa##x; *(float4*)(sT + x * 4096 + st1 * 64 + c41) = pb##x;
  SC_GLOAD(0);
  for (int c0 = 0; c0 < nsteps; c0 += 64) {
    __syncthreads();
    SC_ST1(0) SC_ST1(1) SC_ST1(2) SC_ST1(3) SC_ST1(4)
    *(float4*)(sV + stv * 32 + c4v) = pfv;
    __syncthreads();
    if (c0 + 64 < nsteps) SC_GLOAD(c0 + 64);
#define SC_LD(S, st_) do { const int _s = (st_) < 64 ? (st_) : 63; \
      S##r = *(const float4*)(sT + _s * 64 + j0); S##w = *(const float4*)(sT + 4096 + _s * 64 + j0); \
      S##k = *(const float4*)(sT + 8192 + _s * 64 + j0); S##q = *(const float4*)(sT + 12288 + _s * 64 + j0); \
      S##b = *(const float4*)(sT + 16384 + _s * 64 + j0); S##v = sV[_s * 32 + il]; } while (0)
#define SC_STEP(S, st_) do { \
      float sa = -dpp_sum16(fma_s(s[1], S##q.y, mul_s(s[0], S##q.x)) + fma_s(s[3], S##q.w, mul_s(s[2], S##q.z))); \
      s[0] = fma_s(sa, S##b.x, fma_s(s[0], S##w.x, mul_s(S##v, S##k.x))); \
      s[1] = fma_s(sa, S##b.y, fma_s(s[1], S##w.y, mul_s(S##v, S##k.y))); \
      s[2] = fma_s(sa, S##b.z, fma_s(s[2], S##w.z, mul_s(S##v, S##k.z))); \
      s[3] = fma_s(sa, S##b.w, fma_s(s[3], S##w.w, mul_s(S##v, S##k.w))); \
      float y = dpp_sum16(fma_s(s[1], S##r.y, mul_s(s[0], S##r.x)) + fma_s(s[3], S##r.w, mul_s(s[2], S##r.z))); \
      ykeep = (sub == ((st_) & 15)) ? y : ykeep; } while (0)
    float4 Ar, Aw, Ak, Aq, Ab, Br, Bw, Bk, Bq, Bb, Cr, Cw, Ck, Cq, Cb, Dr, Dw, Dk, Dq, Db;
    float Av, Bv, Cv, Dv, ykeep = 0.f;
    SC_LD(A, 0); SC_LD(B, 1); SC_LD(C, 2);
    for (int st = 0; st < 64; st += 4) {
      SC_LD(D, st + 3); SC_STEP(A, st);
      SC_LD(A, st + 4); SC_STEP(B, st + 1);
      SC_LD(B, st + 5); SC_STEP(C, st + 2);
      SC_LD(C, st + 6); SC_STEP(D, st + 3);
      if ((st & 15) == 12) YB[(size_t)(g0 + c0 + (st - 12) + sub) * 512 + il] = ykeep;
    }
  }
#undef SC_LD
#undef SC_STEP
#undef SC_GLOAD
#undef SC_GL1
#undef SC_ST1
  *(float4*)(Sout + i * 64 + j0) = make_float4(s[0], s[1], s[2], s[3]);
}

constexpr int LS = 68;
constexpr int LBUF = 64 * LS;
constexpr int LH = 72;

__device__ __forceinline__ void split8(const float* x, bf16x8& hi, bf16x8& lo) {
  union { bf16x8 v; unsigned u[4]; } H, Lo;
#pragma unroll
  for (int j = 0; j < 4; ++j) {
    const unsigned h = pack2(x[2 * j], x[2 * j + 1]);
    H.u[j] = h;
    Lo.u[j] = pack2(x[2 * j] - __uint_as_float(h << 16), x[2 * j + 1] - __uint_as_float(h & 0xffff0000u));
  }
  hi = H.v; lo = Lo.v;
}
template <int AM, int AK, int BKS, int BN, bool SPLIT = true>
__device__ __forceinline__ void mm64(const float* A, const float* B, f32x4 (&acc)[2], int m0, int n0, int lane) {
  const int lr = lane & 15, lq = lane >> 4;
#pragma unroll
  for (int ks = 0; ks < 2; ++ks) {
    const int k0 = ks * 32 + lq * 8;
    float a[8];
    if (AK == 1) {
      float4 x0 = *(const float4*)(A + (m0 + lr) * AM + k0), x1 = *(const float4*)(A + (m0 + lr) * AM + k0 + 4);
      a[0] = x0.x; a[1] = x0.y; a[2] = x0.z; a[3] = x0.w; a[4] = x1.x; a[5] = x1.y; a[6] = x1.z; a[7] = x1.w;
    } else {
#pragma unroll
      for (int j = 0; j < 8; ++j) a[j] = A[(m0 + lr) * AM + (k0 + j) * AK];
    }
    bf16x8 ah, al;
    if (SPLIT) split8(a, ah, al);
    else { union { bf16x8 v; unsigned u[4]; } H; for (int j = 0; j < 4; ++j) H.u[j] = pack2(a[2 * j], a[2 * j + 1]); ah = H.v; al = H.v; }
#pragma unroll
    for (int nt = 0; nt < 2; ++nt) {
      const int n = n0 + nt * 16 + lr;
      float b[8];
      if (BKS == 1) {
        float4 x0 = *(const float4*)(B + n * BN + k0), x1 = *(const float4*)(B + n * BN + k0 + 4);
        b[0] = x0.x; b[1] = x0.y; b[2] = x0.z; b[3] = x0.w; b[4] = x1.x; b[5] = x1.y; b[6] = x1.z; b[7] = x1.w;
      } else {
#pragma unroll
        for (int j = 0; j < 8; ++j) b[j] = B[(k0 + j) * BKS + n * BN];
      }
      if (SPLIT) {
        bf16x8 bh, bl; split8(b, bh, bl);
        acc[nt] = __builtin_amdgcn_mfma_f32_16x16x32_bf16(ah, bh, acc[nt], 0, 0, 0);
        acc[nt] = __builtin_amdgcn_mfma_f32_16x16x32_bf16(ah, bl, acc[nt], 0, 0, 0);
        acc[nt] = __builtin_amdgcn_mfma_f32_16x16x32_bf16(al, bh, acc[nt], 0, 0, 0);
      } else {
        union { bf16x8 v; unsigned u[4]; } Bh;
#pragma unroll
        for (int j = 0; j < 4; ++j) Bh.u[j] = pack2(b[2 * j], b[2 * j + 1]);
        acc[nt] = __builtin_amdgcn_mfma_f32_16x16x32_bf16(ah, Bh.v, acc[nt], 0, 0, 0);
      }
    }
  }
}
#define MM_ZERO(acc) do { acc[0] = f32x4{0.f, 0.f, 0.f, 0.f}; acc[1] = f32x4{0.f, 0.f, 0.f, 0.f}; } while (0)
#define MM_FOREACH(acc, BODY) do { _Pragma("unroll") for (int nt_ = 0; nt_ < 2; ++nt_) _Pragma("unroll") for (int rg_ = 0; rg_ < 4; ++rg_) { \
    const int m = m0 + lq * 4 + rg_, n = n0 + nt_ * 16 + lr; const float val = acc[nt_][rg_]; BODY } } while (0)

#define CPRE_PARAMS float4& c_w0, float4& c_w1, uint2& c_q0, uint2& c_q1, uint2& c_b0, uint2& c_b1, float4& c_k0, float4& c_k1, uint2& c_r0, uint2& c_r1, uint2& c_v0, uint2& c_v1
#define CPRE_ARGS(P) P##w0, P##w1, P##q0, P##q1, P##b0, P##b1, P##k0, P##k1, P##r0, P##r1, P##v0, P##v1
__device__ __forceinline__ void cprep_load(KPR p, int grow0, int h, int tid, CPRE_PARAMS) {
  const int t0 = tid >> 4, c4 = (tid & 15) * 4;
  const size_t g0 = (size_t)(grow0 + t0) * 512 + h * 64 + c4, g1 = g0 + (size_t)32 * 512;
  const float* WB = (const float*)(p.ws + W_WB); const u16* KKB = (const u16*)(p.ws + W_KKB); const u16* BB = (const u16*)(p.ws + W_BB);
  const float* KB = (const float*)(p.ws + W_KB); const u16* RB = (const u16*)(p.ws + W_RB); const u16* VB = (const u16*)(p.ws + W_VB);
  c_w0 = *(const float4*)(WB + g0); c_w1 = *(const float4*)(WB + g1); c_q0 = *(const uint2*)(KKB + g0); c_q1 = *(const uint2*)(KKB + g1);
  c_b0 = *(const uint2*)(BB + g0); c_b1 = *(const uint2*)(BB + g1); c_k0 = *(const float4*)(KB + g0); c_k1 = *(const float4*)(KB + g1);
  c_r0 = *(const uint2*)(RB + g0); c_r1 = *(const uint2*)(RB + g1); c_v0 = *(const uint2*)(VB + g0); c_v1 = *(const uint2*)(VB + g1);
}
__device__ __forceinline__ void cprep_item(KPR p, int grow0, int h, int cid, int ngrow0, int nh, CPRE_PARAMS) {
  extern __shared__ __attribute__((aligned(16))) char smem[];
  float* B0 = (float*)smem; float* B1 = B0 + LBUF; float* B2 = B1 + LBUF; float* B3 = B2 + LBUF;
  float* B4 = B3 + LBUF; float* B5 = B4 + LBUF; float* B6 = B5 + LBUF; float* B7 = B6 + LBUF;
  float* wC = (float*)(smem + 139264);
  const int tid = tidx(), wid = tid >> 6, lane = tid & 63, lr = lane & 15, lq = lane >> 4;
  const int m0 = (wid >> 1) * 16, n0 = (wid & 1) * 32;
  const float* WB = (const float*)(p.ws + W_WB) + h * 64; const float* KKB = (const float*)(p.ws + W_KKB) + h * 64;
  const float* BB = (const float*)(p.ws + W_BB) + h * 64; const float* KB = (const float*)(p.ws + W_KB) + h * 64;
  const float* RB = (const float*)(p.ws + W_RB) + h * 64; const float* VB = (const float*)(p.ws + W_VB) + h * 64;
  f32x4 acc[2];
  __syncthreads();
  {
    const int t0 = tid >> 4, c4 = (tid & 15) * 4, o0 = t0 * LS + c4, o1 = (t0 + 32) * LS + c4;
    *(float4*)(B0 + o0) = c_w0; *(float4*)(B0 + o1) = c_w1;
    { const float4 a0_ = bf4(c_q0), a1_ = bf4(c_q1);
      *(float4*)(B1 + o0) = make_float4(-a0_.x, -a0_.y, -a0_.z, -a0_.w); *(float4*)(B1 + o1) = make_float4(-a1_.x, -a1_.y, -a1_.z, -a1_.w); }
    *(float4*)(B2 + o0) = bf4(c_b0); *(float4*)(B2 + o1) = bf4(c_b1);
    *(float4*)(B3 + o0) = c_k0; *(float4*)(B3 + o1) = c_k1;
    *(float4*)(B4 + o0) = bf4(c_r0); *(float4*)(B4 + o1) = bf4(c_r1);
  }
  const uint2 vk0 = c_v0, vk1 = c_v1;
  __syncthreads();
  cprep_load(p, ngrow0, nh, tid, CPRE_ARGS(c_));
  {
    const int j = tid & 63, sg = tid >> 6;
    float wv[8];
#pragma unroll
    for (int u = 0; u < 8; ++u) wv[u] = B0[(sg * 8 + u) * LS + j];
#pragma unroll
    for (int u = 1; u < 8; ++u) wv[u] *= wv[u - 1];
    float* segp = B5;
    segp[sg * 64 + j] = wv[7];
    __syncthreads();
    float pre = 1.f;
    for (int u = 0; u < sg; ++u) pre *= segp[u * 64 + j];
#pragma unroll
    for (int u = 0; u < 8; ++u) B0[(sg * 8 + u) * LS + j] = wv[u] * pre;
    if (sg == 7) wC[j] = wv[7] * pre;
  }
  __syncthreads();
  for (int e = tid; e < 4096; e += NTHR) {
    const int t = e >> 6, j = e & 63, o = t * LS + j;
    const float wt = B0[o], wp = t ? B0[o - LS] : 1.f, iw = 1.f / wt;
    B1[o] *= wp; B2[o] *= iw; B3[o] *= iw; B4[o] *= wt;
  }
  __syncthreads();
  MM_ZERO(acc); mm64<LS, 1, 1, LS>(B2, B1, acc, m0, n0, lane);
  MM_FOREACH(acc, { const float v = m < n ? val : 0.f; B5[m * LS + n] = v; B6[m * LS + n] = v + (m == n ? 1.f : 0.f); });
  __syncthreads();
  MM_ZERO(acc); mm64<LS, 1, LS, 1>(B5, B5, acc, m0, n0, lane);
  MM_FOREACH(acc, { B7[m * LS + n] = val; });
  __syncthreads();
  for (int it = 0; it < 5; ++it) {
    MM_ZERO(acc); mm64<LS, 1, LS, 1>(B6, B7, acc, m0, n0, lane);
    f32x4 acc2[2]; MM_ZERO(acc2);
    if (it < 4) mm64<LS, 1, LS, 1>(B7, B7, acc2, m0, n0, lane);
    __syncthreads();
    MM_FOREACH(acc, { B6[m * LS + n] += val; });
    if (it < 4) MM_FOREACH(acc2, { B7[m * LS + n] = val; });
    __syncthreads();
  }
  MM_ZERO(acc); mm64<1, LS, LS, 1>(B1, B6, acc, m0, n0, lane);
  MM_FOREACH(acc, { B5[m * LS + n] = val; });
  MM_ZERO(acc); mm64<LS, 1, 1, LS>(B3, B1, acc, m0, n0, lane);
  MM_FOREACH(acc, { B0[m * LS + n] = m < n ? val : 0.f; });
  __syncthreads();
  MM_ZERO(acc); mm64<LS, 1, LS, 1>(B0, B6, acc, m0, n0, lane);
  MM_FOREACH(acc, { B7[m * LS + n] = val; });
  __syncthreads();
  MM_ZERO(acc); mm64<LS, 1, 1, LS, false>(B2, B4, acc, m0, n0, lane);
  {
    f32x4 acc2[2]; MM_ZERO(acc2); mm64<LS, 1, 1, LS, false>(B3, B4, acc2, m0, n0, lane);
    __syncthreads();
    MM_FOREACH(acc, { B0[m * LS + n] = m <= n ? val : 0.f; });
    MM_FOREACH(acc2, { B1[m * LS + n] = m <= n ? val : 0.f; });
  }
  __syncthreads();
  {
    u16* RRT = (u16*)(p.ws + W_CRR) + (size_t)cid * 4096;
    MM_ZERO(acc); mm64<1, LS, 1, LS, false>(B0, B5, acc, m0, n0, lane);
    MM_FOREACH(acc, { RRT[m * 64 + n] = f2bf(val + B4[m * LS + n]); });
    MM_ZERO(acc); mm64<LS, 1, LS, 1, false>(B7, B0, acc, m0, n0, lane);
    MM_FOREACH(acc, { B6[m * LS + n] = val + B1[m * LS + n]; });
  }
  __syncthreads();
  for (int e = tid; e < 4096; e += NTHR) {
    const int t = e >> 6, j = e & 63, o = t * LS + j;
    const float wc = wC[j];
    B2[o] *= wc; B3[o] *= wc;
  }
  { const int t0 = tid >> 4, c4 = (tid & 15) * 4; *(float4*)(B4 + t0 * LS + c4) = bf4(vk0); *(float4*)(B4 + (t0 + 32) * LS + c4) = bf4(vk1); }
  __syncthreads();
  {
    float* YB = (float*)(p.ws + W_YB) + h * 64;
    MM_ZERO(acc); mm64<1, LS, LS, 1, false>(B6, B4, acc, m0, n0, lane);
    MM_FOREACH(acc, { YB[(size_t)(grow0 + m) * 512 + n] = val; });
    u16* PT = (u16*)(p.ws + W_CPT) + (size_t)cid * 4096;
    MM_ZERO(acc); mm64<1, LS, 1, LS, false>(B2, B5, acc, m0, n0, lane);
    MM_FOREACH(acc, { PT[m * 64 + n] = f2bf(val + (m == n ? wC[m] : 0.f)); });
    MM_ZERO(acc); mm64<LS, 1, LS, 1, false>(B7, B2, acc, m0, n0, lane);
    MM_FOREACH(acc, { B0[m * LS + n] = val + B3[m * LS + n]; });
  }
  __syncthreads();
  {
    float* CQ = (float*)(p.ws + W_CQ) + (size_t)cid * 4096;
    MM_ZERO(acc); mm64<1, LS, LS, 1, false>(B4, B0, acc, m0, n0, lane);
    MM_FOREACH(acc, { CQ[m * 64 + n] = val; });
  }
}

__device__ __forceinline__ void cprep_decode(int id, int& grow0, int& h) {
  if (id < 2048) { grow0 = (id >> 9) * 4096 + (id & 63) * 64; h = (id >> 6) & 7; }
  else { const int k = id - 2048; grow0 = TP + (k >> 3) * 64; h = k & 7; }
}
__device__ __forceinline__ void phase_cprep(KPR p) {
  float4 u_w0, u_w1, u_k0, u_k1; uint2 u_q0, u_q1, u_b0, u_b1, u_r0, u_r1, u_v0, u_v1;
  int id = blockIdx.x, grow0 = 0, h = 0;
  cprep_decode(id < 2304 ? id : 0, grow0, h); cprep_load(p, grow0, h, tidx(), CPRE_ARGS(u_));
  for (; id < 2304; id += gridDim.x) {
    const int nid = id + gridDim.x;
    int ng = 0, nh = 0;
    cprep_decode(nid < 2304 ? nid : id, ng, nh);
    cprep_item(p, grow0, h, id, ng, nh, CPRE_ARGS(u_));
    grow0 = ng; h = nh;
  }
}

__device__ __forceinline__ void cseq_item(KPR p, int g0, int h, int nch, int cid0, const float* S0, float* Sout) {
  extern __shared__ __attribute__((aligned(16))) char smem[];
  float* Sf = (float*)smem;
  float* Qf = Sf + LBUF;
  float* Yf = Qf + LBUF;
  u16* Rb = (u16*)(Yf + LBUF);
  u16* Pb = Rb + 64 * LH;
  const int tid = tidx(), wid = tid >> 6, lane = tid & 63, lr = lane & 15, lq = lane >> 4;
  const int m0 = (wid >> 1) * 16, n0 = (wid & 1) * 32;
  float* YB = (float*)(p.ws + W_YB) + h * 64;
  const u16* RRT = (const u16*)(p.ws + W_CRR) + (size_t)cid0 * 4096;
  const u16* PT = (const u16*)(p.ws + W_CPT) + (size_t)cid0 * 4096;
  const float* CQ = (const float*)(p.ws + W_CQ) + (size_t)cid0 * 4096;
  __syncthreads();
  for (int e = tid; e < 4096; e += NTHR) { const int i = e >> 6, j = e & 63; Sf[i * LS + j] = S0 ? S0[e] : 0.f; }
  const int hr = tid >> 3, hc = (tid & 7) * 8;
  const int f0t = tid >> 4, f0c = (tid & 15) * 4;
  uint4 pr, pp; float4 q0, q1, y0, y1;
#define CS_LOAD(c_) do { \
    pr = *(const uint4*)(RRT + (size_t)(c_) * 4096 + hr * 64 + hc); pp = *(const uint4*)(PT + (size_t)(c_) * 4096 + hr * 64 + hc); \
    q0 = *(const float4*)(CQ + (size_t)(c_) * 4096 + f0t * 64 + f0c); q1 = *(const float4*)(CQ + (size_t)(c_) * 4096 + (f0t + 32) * 64 + f0c); \
    y0 = *(const float4*)(YB + (size_t)(g0 + (c_) * 64 + f0t) * 512 + f0c); y1 = *(const float4*)(YB + (size_t)(g0 + (c_) * 64 + f0t + 32) * 512 + f0c); } while (0)
  CS_LOAD(0);
  for (int c = 0; c < nch; ++c) {
    __syncthreads();
    *(uint4*)(Rb + hr * LH + hc) = pr; *(uint4*)(Pb + hr * LH + hc) = pp;
    *(float4*)(Qf + f0t * LS + f0c) = q0; *(float4*)(Qf + (f0t + 32) * LS + f0c) = q1;
    *(float4*)(Yf + f0t * LS + f0c) = y0; *(float4*)(Yf + (f0t + 32) * LS + f0c) = y1;
    __syncthreads();
    if (c + 1 < nch) CS_LOAD(c + 1);
    f32x4 ay[2], as[2]; MM_ZERO(ay); MM_ZERO(as);
#pragma unroll
    for (int ks = 0; ks < 2; ++ks) {
      const int k0 = ks * 32 + lq * 8;
      const bf16x8 ra = *(const bf16x8*)(Rb + (m0 + lr) * LH + k0);
      float sa[8];
      { float4 x0 = *(const float4*)(Sf + (m0 + lr) * LS + k0), x1 = *(const float4*)(Sf + (m0 + lr) * LS + k0 + 4);
        sa[0] = x0.x; sa[1] = x0.y; sa[2] = x0.z; sa[3] = x0.w; sa[4] = x1.x; sa[5] = x1.y; sa[6] = x1.z; sa[7] = x1.w; }
      bf16x8 sah, sal; split8(sa, sah, sal);
#pragma unroll
      for (int nt = 0; nt < 2; ++nt) {
        const int n = n0 + nt * 16 + lr;
        float sb[8];
        { float4 x0 = *(const float4*)(Sf + n * LS + k0), x1 = *(const float4*)(Sf + n * LS + k0 + 4);
          sb[0] = x0.x; sb[1] = x0.y; sb[2] = x0.z; sb[3] = x0.w; sb[4] = x1.x; sb[5] = x1.y; sb[6] = x1.z; sb[7] = x1.w; }
        bf16x8 sbh, sbl; split8(sb, sbh, sbl);
        ay[nt] = __builtin_amdgcn_mfma_f32_16x16x32_bf16(ra, sbh, ay[nt], 0, 0, 0);
        ay[nt] = __builtin_amdgcn_mfma_f32_16x16x32_bf16(ra, sbl, ay[nt], 0, 0, 0);
        const bf16x8 pb = *(const bf16x8*)(Pb + n * LH + k0);
        as[nt] = __builtin_amdgcn_mfma_f32_16x16x32_bf16(sah, pb, as[nt], 0, 0, 0);
        as[nt] = __builtin_amdgcn_mfma_f32_16x16x32_bf16(sal, pb, as[nt], 0, 0, 0);
      }
    }
    MM_FOREACH(ay, { YB[(size_t)(g0 + c * 64 + m) * 512 + n] = val + Yf[m * LS + n]; });
    __syncthreads();
    MM_FOREACH(as, { Sf[m * LS + n] = val + Qf[m * LS + n]; });
  }
#undef CS_LOAD
  __syncthreads();
  for (int e = tid; e < 4096; e += NTHR) { const int i = e >> 6, j = e & 63; Sout[e] = Sf[i * LS + j]; }
}

__device__ __forceinline__ void phase_yfin(KPR p, int l) {
  const int tid = tidx(), wid = tid >> 6, lane = tid & 63;
  const float* YB = (const float*)(p.ws + W_YB); const float* RB = (const float*)(p.ws + W_RB); const float* KB = (const float*)(p.ws + W_KB);
  const float* VB = (const float*)(p.ws + W_VB); const u16* GB = (const u16*)(p.ws + W_GB); u16* AO = (u16*)(p.ws + W_AO);
  const float* rk = p.in[I_RK] + l * 512; const float* gng = p.in[I_GNG] + l * 512; const float* gnb = p.in[I_GNB] + l * 512;
  for (int g = blockIdx.x * 8 + wid; g < T; g += gridDim.x * 8) {
#pragma unroll 2
    for (int h = 0; h < 8; ++h) {
      size_t i = (size_t)g * 512 + h * 64 + lane;
      float y = YB[i];
      float mu = wave_sum(y) * (1.f / 64.f);
      float dlt = y - mu;
      float var = wave_sum(dlt * dlt) * (1.f / 64.f);
      float bon = wave_sum(bf2f(((const u16*)RB)[i]) * KB[i] * rk[h * 64 + lane]);
      float v = dlt * rsqrtf(var + 64e-5f) * gng[h * 64 + lane] + gnb[h * 64 + lane] + bon * bf2f(((const u16*)VB)[i]);
      AO[(size_t)g * 1536 + 1024 + h * 64 + lane] = f2bf(v * bf2f(GB[i]));
    }
  }
}

__device__ __forceinline__ void phase_init(KPR p) {
  const int G = gridDim.x, tid = tidx(), wid = tid >> 6, lane = tid & 63;
  const int gw = blockIdx.x * 8 + wid, nw = G * 8;
  {
    float* X = (float*)(p.ws + W_X); u16* XB = (u16*)(p.ws + W_XB); float* SSQ = (float*)(p.ws + W_SSQ);
    for (int g = gw; g < T; g += nw) {
      const float* src = g < TP ? p.in[I_XP] + (size_t)g * 1024 : p.in[I_XS] + (size_t)(g - TP) * 1024;
      float ss = 0.f;
#pragma unroll
      for (int i = 0; i < 4; ++i) {
        float4 v = *(const float4*)(src + i * 256 + lane * 4);
        *(float4*)(X + (size_t)g * 1024 + i * 256 + lane * 4) = v;
        uint2 w; w.x = pack2(v.x, v.y); w.y = pack2(v.z, v.w);
        *(uint2*)(XB + (size_t)g * 1024 + i * 256 + lane * 4) = w;
        ss += v.x * v.x + v.y * v.y + v.z * v.z + v.w * v.w;
      }
      ss = wave_sum(ss);
      if (lane == 0) *(float4*)(SSQ + (size_t)g * 4) = make_float4(ss, 0.f, 0.f, 0.f);
    }
  }
  {
    u16* MB = (u16*)(p.ws + W_MB);
    for (int g = gw; g < 1024; g += nw) {
      const float* src = p.in[I_MEMP] + (size_t)g * 1024;
      float4 v[4]; float ss = 0.f;
#pragma unroll
      for (int i = 0; i < 4; ++i) { v[i] = *(const float4*)(src + i * 256 + lane * 4); ss += v[i].x * v[i].x + v[i].y * v[i].y + v[i].z * v[i].z + v[i].w * v[i].w; }
      ss = wave_sum(ss);
      float rs = rsqrtf(ss * (1.f / 1024.f) + 1e-6f);
#pragma unroll
      for (int i = 0; i < 4; ++i) {
        uint2 w; w.x = pack2(v[i].x * rs, v[i].y * rs); w.y = pack2(v[i].z * rs, v[i].w * rs);
        *(uint2*)(MB + (size_t)g * 1024 + i * 256 + lane * 4) = w;
      }
    }
  }
  {
    float2* RT = (float2*)(p.ws + W_ROPE);
    for (int e = blockIdx.x * NTHR + tid; e < 4096 * 16; e += G * NTHR) {
      int pos = e >> 4, i = e & 15;
      float inv = powf(10000.f, -(float)i / 16.f);
      float ang = (float)pos * inv;
      float sn, cs; sincosf(ang, &sn, &cs);
      RT[e] = make_float2(cs, sn);
    }
  }
  int rot = 0;
  for (int l = 0; l < NL; ++l) {
    u16* WT = (u16*)(p.ws + W_WT) + (size_t)l * WE_LAYER;
    for (int f = 0; f < 2; ++f) {
      const float* nrm = p.in[f ? I_F2N : I_F1N] + l * 1024;
      const float* wg = p.in[f ? I_F2G : I_F1G] + (size_t)l * 1024 * DFF;
      const float* wu = p.in[f ? I_F2U : I_F1U] + (size_t)l * 1024 * DFF;
      const float* wd = p.in[f ? I_F2D : I_F1D] + (size_t)l * 1024 * DFF;
      tconv(WT + (f ? WE_GU2 : WE_GU1), 1024, 5632, 1024, rot, [=](int k, int n) {
        int j = (n >> 5) * 16 + (n & 15);
        const float* s = ((n >> 4) & 1) ? wu : wg;
        return nrm[k] * s[(size_t)k * DFF + j];
      });
      rot += 88 * 16;
      tconv(WT + (f ? WE_D2 : WE_D1), DFF, 1024, DFF, rot, [=](int k, int n) { return wd[(size_t)k * 1024 + n]; });
      rot += 16 * 44;
    }
    {
      const float* nrm = p.in[I_MIXN] + l * 1024; const float* w = p.in[I_WIN] + (size_t)l * 1024 * DIN;
      tconv(WT + WE_IN, 1024, DINP, 1024, rot, [=](int k, int n) { return n < DIN ? nrm[k] * w[(size_t)k * DIN + n] : 0.f; });
      rot += 36 * 16;
    }
    {
      const float* nrm = p.in[I_QN] + l * 256; const float* wuq = p.in[I_WUQ] + (size_t)l * 256 * 768;
      const float* wuk = p.in[I_WUK] + (size_t)l * 8 * 128 * 64;
      tconv(WT + WE_Q, 256, 1280, 256, rot, [=](int k, int n) {
        float r;
        if (n < 1024) {
          int h = n >> 7, c = n & 127;
          const float* a = wuq + (size_t)k * 768 + h * 96; const float* b = wuk + (size_t)(h * 128 + c) * 64;
          r = 0.f;
          for (int d = 0; d < 64; ++d) r += a[d] * b[d];
        } else {
          int hr = n - 1024;
          r = wuq[(size_t)k * 768 + (hr >> 5) * 96 + 64 + (hr & 31)];
        }
        return r * nrm[k] * QSCALE;
      });
      rot += 20 * 4;
    }
    {
      const float* wup = p.in[I_WUP] + (size_t)l * 64 * 512; const float* aup = p.in[I_AUP] + (size_t)l * 64 * 512;
      const float* gup = p.in[I_GUP] + (size_t)l * 128 * 512;
      tconv(WT + WE_RW, 256, 1536, 256, rot, [=](int k, int n) {
        if (n < 512) return k < 64 ? wup[k * 512 + n] : 0.f;
        if (n < 1024) return (k >= 64 && k < 128) ? aup[(k - 64) * 512 + n - 512] : 0.f;
        return k >= 128 ? gup[(k - 128) * 512 + n - 1024] : 0.f;
      });
      rot += 24 * 4;
    }
    {
      const float* wuv = p.in[I_WUV] + (size_t)l * 8 * 128 * 64; const float* wo = p.in[I_WOUT] + (size_t)l * 1024 * 1024;
      tconv(WT + WE_OUT, 1536, 1024, 1536, rot, [=](int k, int n) {
        if (k < 1024) {
          int h = k >> 7, c = k & 127;
          const float* a = wuv + (size_t)(h * 128 + c) * 64; const float* b = wo + (size_t)(h * 64) * 1024 + n;
          float r = 0.f;
          for (int v = 0; v < 64; ++v) r += a[v] * b[(size_t)v * 1024];
          return r;
        }
        return wo[(size_t)(512 + k - 1024) * 1024 + n];
      });
      rot += 16 * 24;
    }
    {
      const float* nx = p.in[I_XN] + l * 1024; const float* nm = p.in[I_MKVN] + l * 1024;
      const float* wq = p.in[I_WMQ] + (size_t)l * 1048576; const float* wk = p.in[I_WMK] + (size_t)l * 1048576;
      const float* wv = p.in[I_WMV] + (size_t)l * 1048576; const float* wo = p.in[I_WMO] + (size_t)l * 1048576;
      tconv(WT + WE_MQ, 1024, 1024, 1024, rot, [=](int k, int n) { return nx[k] * wq[(size_t)k * 1024 + n] * XSCALE; });
      tconv(WT + WE_MK, 1024, 1024, 1024, rot, [=](int k, int n) { return nm[k] * wk[(size_t)k * 1024 + n]; });
      tconv(WT + WE_MV, 1024, 1024, 1024, rot, [=](int k, int n) { return nm[k] * wv[(size_t)k * 1024 + n]; });
      tconv(WT + WE_MO, 1024, 1024, 1024, rot, [=](int k, int n) { return wo[(size_t)k * 1024 + n]; });
    }
  }
}

__device__ __forceinline__ void phase_prep(KPR p, int l) {
  extern __shared__ __attribute__((aligned(16))) char smem[];
  u16* sv = (u16*)smem;
  const int tid = tidx(), wid = tid >> 6, lane = tid & 63;
  const u16* PROJ = (const u16*)(p.ws + W_PROJ);
  u16* CQB = (u16*)(p.ws + W_CQB); u16* A2 = (u16*)(p.ws + W_A2);
  float* RB = (float*)(p.ws + W_RB); float* KB = (float*)(p.ws + W_KB); float* VB = (float*)(p.ws + W_VB); float* KKB = (float*)(p.ws + W_KKB);
  u16* KP = (u16*)(p.ws + W_KP); u16* KS = (u16*)(p.ws + W_KS); u16* VTP = (u16*)(p.ws + W_VTP); u16* VTS = (u16*)(p.ws + W_VTS);
  const float2* RT = (const float2*)(p.ws + W_ROPE);
  const float* kvn = p.in[I_KVN] + l * 128; const float* mu = p.in[I_MU] + l * DSH; const float* kkw = p.in[I_KK] + l * 512;
  for (int chunk = blockIdx.x; chunk < T / 72; chunk += gridDim.x) {
  __syncthreads();
  uint2 n_cq; unsigned n_ckv; u16 n_k1 = 0, n_k2 = 0; uint4 n_pb0, n_pb1, n_pb2, n_pb3 = make_uint4(0, 0, 0, 0);
  uint4 q_pb0, q_pb1, q_pb2, q_pb3 = make_uint4(0, 0, 0, 0);
#define PREP_LOAD(ROW) do { const u16* pr_ = PROJ + (size_t)(ROW) * DINP; \
    n_cq = *(const uint2*)(pr_ + lane * 4); n_ckv = *(const unsigned*)(pr_ + 256 + lane * 2); \
    if (lane < 16) { n_k1 = pr_[384 + lane]; n_k2 = pr_[400 + lane]; } \
    n_pb0 = *(const uint4*)(pr_ + 416 + lane * 8); n_pb1 = *(const uint4*)(pr_ + 416 + 512 + lane * 8); \
    n_pb2 = *(const uint4*)(pr_ + 416 + 1024 + lane * 8); if (lane < 32) n_pb3 = *(const uint4*)(pr_ + 416 + 1536 + lane * 8); } while (0)
  {
    const int gfirst = chunk * 72 + wid * 9;
    if (gfirst > 0) { PREP_LOAD(gfirst - 1); q_pb0 = n_pb0; q_pb1 = n_pb1; q_pb2 = n_pb2; q_pb3 = n_pb3; }
    else { q_pb0 = q_pb1 = q_pb2 = make_uint4(0, 0, 0, 0); }
    PREP_LOAD(gfirst);
  }
  for (int ri = 0; ri < 9; ++ri) {
    const int rl = wid * 9 + ri, g = chunk * 72 + rl;
    const u16* pr = PROJ + (size_t)g * DINP;
    const uint2 c_cq = n_cq; const unsigned c_ckv = n_ckv; const u16 c_k1 = n_k1, c_k2 = n_k2;
    const uint4 c_pb0 = n_pb0, c_pb1 = n_pb1, c_pb2 = n_pb2, c_pb3 = n_pb3;
    { const int gn = g + 1 < T ? g + 1 : g; PREP_LOAD(gn); }
    const bool isP = g < TP;
    int b, t, pos, tlen;
    if (isP) { b = g >> 12; t = g & 4095; pos = t; tlen = 4096; } else { int gg = g - TP; b = gg >> 6; t = gg & 63; pos = 2048 + t; tlen = 64; }
    {
      uint2 w = c_cq;
      float v0 = bf2f(w.x & 0xffff), v1 = bf2f(w.x >> 16), v2 = bf2f(w.y & 0xffff), v3 = bf2f(w.y >> 16);
      float ss = wave_sum(v0 * v0 + v1 * v1 + v2 * v2 + v3 * v3);
      float rs = rsqrtf(ss * (1.f / 256.f) + 1e-6f);
      uint2 o; o.x = pack2(v0 * rs, v1 * rs); o.y = pack2(v2 * rs, v3 * rs);
      *(uint2*)(CQB + (size_t)g * 256 + lane * 4) = o;
    }
    {
      unsigned w = c_ckv;
      float v0 = bf2f(w & 0xffff), v1 = bf2f(w >> 16);
      float ss = wave_sum(v0 * v0 + v1 * v1);
      float rs = rsqrtf(ss * (1.f / 128.f) + 1e-6f);
      int c = lane * 2;
      v0 = v0 * rs * kvn[c]; v1 = v1 * rs * kvn[c + 1];
      float* of = isP ? p.out + OO_CKVP + ((size_t)(l * 4 + b) * 4096 + t) * 128 : p.out + OO_CKVS + ((size_t)(l * 32 + b) * 64 + t) * 128;
      *(float2*)(of + c) = make_float2(v0, v1);
      u16* kr = isP ? KP + ((size_t)b * 4096 + t) * 160 : KS + ((size_t)b * 2112 + 2048 + t) * 160;
      *(unsigned*)(kr + c) = pack2(v0, v1);
      *(unsigned*)(sv + rl * 128 + c) = pack2(v0, v1);
      if (lane < 16) {
        float x1 = bf2f(c_k1), x2 = bf2f(c_k2);
        float2 cs = RT[pos * 16 + lane];
        float o1 = x1 * cs.x - x2 * cs.y, o2 = x1 * cs.y + x2 * cs.x;
        float* okr = isP ? p.out + OO_KRP + ((size_t)(l * 4 + b) * 4096 + t) * 32 : p.out + OO_KRS + ((size_t)(l * 32 + b) * 64 + t) * 32;
        okr[lane] = o1; okr[lane + 16] = o2;
        kr[128 + lane] = f2bf(o1); kr[144 + lane] = f2bf(o2);
      }
    }
    {
      const u16* pb = pr + 416;
      const u16* pp = pr - DINP + 416;
      const float* sh0 = p.in[I_SSH] + (size_t)(l * 32 + b) * DSH;
      const bool last = (t == tlen - 1);
      float* osh = isP ? p.out + OO_SHP + (size_t)(l * 4 + b) * DSH : p.out + OO_SHS + (size_t)(l * 32 + b) * DSH;
#pragma unroll
      for (int it = 0; it < 4; ++it) {
        const int c = it * 64 + lane;
        if (c < 224) {
          const int e = c * 8;
          const uint4 w = it == 0 ? c_pb0 : (it == 1 ? c_pb1 : (it == 2 ? c_pb2 : c_pb3));
          float pv[8] = {bf2f(w.x & 0xffff), bf2f(w.x >> 16), bf2f(w.y & 0xffff), bf2f(w.y >> 16), bf2f(w.z & 0xffff), bf2f(w.z >> 16), bf2f(w.w & 0xffff), bf2f(w.w >> 16)};
          float pq[8];
          if (t > 0) {
            const uint4 q = it == 0 ? q_pb0 : (it == 1 ? q_pb1 : (it == 2 ? q_pb2 : q_pb3));
            pq[0] = bf2f(q.x & 0xffff); pq[1] = bf2f(q.x >> 16); pq[2] = bf2f(q.y & 0xffff); pq[3] = bf2f(q.y >> 16);
            pq[4] = bf2f(q.z & 0xffff); pq[5] = bf2f(q.z >> 16); pq[6] = bf2f(q.w & 0xffff); pq[7] = bf2f(q.w >> 16);
          } else if (!isP) {
            float4 q0 = *(const float4*)(sh0 + e), q1 = *(const float4*)(sh0 + e + 4);
            pq[0] = q0.x; pq[1] = q0.y; pq[2] = q0.z; pq[3] = q0.w; pq[4] = q1.x; pq[5] = q1.y; pq[6] = q1.z; pq[7] = q1.w;
          } else {
#pragma unroll
            for (int j = 0; j < 8; ++j) pq[j] = 0.f;
          }
          float4 m0 = *(const float4*)(mu + e), m1 = *(const float4*)(mu + e + 4);
          float mm[8] = {m0.x, m0.y, m0.z, m0.w, m1.x, m1.y, m1.z, m1.w};
          float xs[8];
#pragma unroll
          for (int j = 0; j < 8; ++j) xs[j] = pv[j] + mm[j] * (pq[j] - pv[j]);
          if (last) { *(float4*)(osh + e) = make_float4(pv[0], pv[1], pv[2], pv[3]); *(float4*)(osh + e + 4) = make_float4(pv[4], pv[5], pv[6], pv[7]); }
          if (it == 0) {
            *(uint4*)((u16*)RB + (size_t)g * 512 + e) = make_uint4(pack2(xs[0], xs[1]), pack2(xs[2], xs[3]), pack2(xs[4], xs[5]), pack2(xs[6], xs[7]));
          } else if (it == 1) {
            const int cc = e - 512;
            float* o = KB + (size_t)g * 512 + cc;
            *(float4*)o = make_float4(xs[0], xs[1], xs[2], xs[3]); *(float4*)(o + 4) = make_float4(xs[4], xs[5], xs[6], xs[7]);
            float4 k0 = *(const float4*)(kkw + cc), k1 = *(const float4*)(kkw + cc + 4);
            float kk[8] = {xs[0] * k0.x, xs[1] * k0.y, xs[2] * k0.z, xs[3] * k0.w, xs[4] * k1.x, xs[5] * k1.y, xs[6] * k1.z, xs[7] * k1.w};
            float ss = 0.f;
#pragma unroll
            for (int j = 0; j < 8; ++j) ss += kk[j] * kk[j];
            ss = dpp_sum8(ss);
            float rn = rsqrtf(ss + 1e-12f);
            *(uint4*)((u16*)KKB + (size_t)g * 512 + cc) = make_uint4(pack2(kk[0] * rn, kk[1] * rn), pack2(kk[2] * rn, kk[3] * rn), pack2(kk[4] * rn, kk[5] * rn), pack2(kk[6] * rn, kk[7] * rn));
          } else if (it == 2) {
            *(uint4*)((u16*)VB + (size_t)g * 512 + (e - 1024)) = make_uint4(pack2(xs[0], xs[1]), pack2(xs[2], xs[3]), pack2(xs[4], xs[5]), pack2(xs[6], xs[7]));
          } else {
            const int cc = e - 1536;
            float y[8];
#pragma unroll
            for (int j = 0; j < 8; ++j) y[j] = cc < 64 ? (1.f - 2.f / (1.f + __expf(2.f * xs[j]))) : (cc < 128 ? xs[j] : sigmoidf_(xs[j]));
            uint4 o; o.x = pack2(y[0], y[1]); o.y = pack2(y[2], y[3]); o.z = pack2(y[4], y[5]); o.w = pack2(y[6], y[7]);
            *(uint4*)(A2 + (size_t)g * 256 + cc) = o;
          }
        }
      }
    }
    q_pb0 = c_pb0; q_pb1 = c_pb1; q_pb2 = c_pb2; q_pb3 = c_pb3;
  }
#undef PREP_LOAD
  __syncthreads();
  for (int idx = tid; idx < 128 * 9; idx += NTHR) {
    const int d = idx & 127, rl0 = (idx >> 7) * 8, g = chunk * 72 + rl0;
    unsigned w[4];
#pragma unroll
    for (int j = 0; j < 4; ++j) w[j] = (unsigned)sv[(rl0 + 2 * j) * 128 + d] | ((unsigned)sv[(rl0 + 2 * j + 1) * 128 + d] << 16);
    u16* dst;
    if (g < TP) dst = VTP + ((size_t)(g >> 12) * 128 + d) * 4096 + (g & 4095);
    else { const int gg = g - TP; dst = VTS + ((size_t)(gg >> 6) * 128 + d) * 2112 + 2048 + (gg & 63); }
    *(uint4*)dst = make_uint4(w[0], w[1], w[2], w[3]);
  }
  }
}

__device__ __forceinline__ void conv_caches(KPR p, int l, int vb, int nvb) {
  const int tid = tidx();
  u16* KS = (u16*)(p.ws + W_KS); u16* VTS = (u16*)(p.ws + W_VTS);
  {
    const float* cckv = p.in[I_CCKV] + (size_t)l * 32 * 2048 * 128;
    const float* ckr = p.in[I_CKR] + (size_t)l * 32 * 2048 * 32;
    for (int idx = vb * NTHR + tid; idx < 32 * 2048 * 20; idx += nvb * NTHR) {
      int rowi = idx / 20, ch = idx % 20;
      int b = rowi >> 11, t = rowi & 2047;
      const float* s = ch < 16 ? cckv + (size_t)rowi * 128 + ch * 8 : ckr + (size_t)rowi * 32 + (ch - 16) * 8;
      float4 a = *(const float4*)s, c = *(const float4*)(s + 4);
      uint4 o; o.x = pack2(a.x, a.y); o.y = pack2(a.z, a.w); o.z = pack2(c.x, c.y); o.w = pack2(c.z, c.w);
      *(uint4*)(KS + ((size_t)b * 2112 + t) * 160 + ch * 8) = o;
    }
    tconv_v(VTS, 2112, 4096, 2048, vb, nvb, [=](int k, int n) { return cckv[((size_t)(n >> 7) * 2048 + k) * 128 + (n & 127)]; });
    const float* cmk = p.in[I_CMK] + (size_t)l * 32 * 256 * 1024;
    const float* cmv = p.in[I_CMV] + (size_t)l * 32 * 256 * 1024;
    u16* MKS = (u16*)(p.ws + W_MKS); u16* MVTS = (u16*)(p.ws + W_MVTS);
    for (int idx = vb * NTHR + tid; idx < 32 * 4 * 256 * 32; idx += nvb * NTHR) {
      int d8 = idx & 31, m = (idx >> 5) & 255, h = (idx >> 13) & 3, b = idx >> 15;
      const float* s = cmk + ((size_t)(b * 256 + m) * 4 + h) * 256 + d8 * 8;
      float4 a = *(const float4*)s, c = *(const float4*)(s + 4);
      uint4 o; o.x = pack2(a.x, a.y); o.y = pack2(a.z, a.w); o.z = pack2(c.x, c.y); o.w = pack2(c.z, c.w);
      *(uint4*)(MKS + (size_t)idx * 8) = o;
    }
    tconv_v(MVTS, 256, 32768, 256, vb, nvb, [=](int k, int n) { return cmv[((size_t)((n >> 10) * 256 + k) * 4 + ((n >> 8) & 3)) * 256 + (n & 255)]; });
  }
}

__device__ __forceinline__ void mla_sub(KPR p, int b, int c, int half) {
  const u16* QB = (const u16*)(p.ws + W_QB); u16* AO = (u16*)(p.ws + W_AO);
  size_t tok = (size_t)b * 4096 + c * 64 + half * 32;
  attn_item<160, 128, 8>(QB + tok * 1280, 160, 256, (const u16*)(p.ws + W_KP) + (size_t)b * 4096 * 160, 160,
                         (const u16*)(p.ws + W_VTP) + (size_t)b * 128 * 4096, 4096, (c + 1) * 64, AO + tok * 1536, 1536);
}
__device__ __forceinline__ void phase_mix(KPR p, int l, int mode = 0) {
  extern __shared__ __attribute__((aligned(16))) char smem[];
  int* sItem = (int*)(smem + SMEM_ITEM);
  int* cnt = (int*)(p.ws + W_CNT) + l + mode * 8;
  for (;;) {
    __syncthreads();
    if (threadIdx.x == 0) *sItem = atomicAdd(cnt, 1);
    __syncthreads();
    int it = *sItem;
    if (it >= 864) break;
    if (mode == 2 && (it < 32 || it >= 608)) continue;
    if (it < 32) {
      int b = it >> 3, h = it & 7;
      cseq_item(p, b * 4096, h, 64, (b * 8 + h) * 64, nullptr, p.out + OO_WKVP + ((size_t)(l * 4 + b) * 8 + h) * 4096);
    } else if (it < 608) {
      int k = it - 32;
      if (k >= 248 && k < 312) {
        int j = k - 248; int b = j >> 1, half = j & 1;
        const u16* QB = (const u16*)(p.ws + W_QB); u16* AO = (u16*)(p.ws + W_AO);
        size_t tok = (size_t)TP + b * 64 + half * 32;
        attn_item<160, 128, 8>(QB + tok * 1280, 160, 256, (const u16*)(p.ws + W_KS) + (size_t)b * 2112 * 160, 160,
                               (const u16*)(p.ws + W_VTS) + (size_t)b * 128 * 2112, 2112, 2112, AO + tok * 1536, 1536);
      } else {
        if (k >= 312) k -= 64;
        int c = 63 - (k >> 3), b = (k >> 1) & 3, half = k & 1;
        mla_sub(p, b, c, half);
      }
    } else {
      int k = it - 608; int b = k >> 3, h = k & 7;
      cseq_item(p, TP + b * 64, h, 1, 2048 + k, p.in[I_SWKV] + ((size_t)(l * 32 + b) * 8 + h) * 4096,
                p.out + OO_WKVS + ((size_t)(l * 32 + b) * 8 + h) * 4096);
    }
  }
}

__device__ __forceinline__ void xattn_item(KPR p, int l, int it) {
  const u16* QX = (const u16*)(p.ws + W_QX); u16* XO = (u16*)(p.ws + W_XO);
  if (it < 256) {
    int b = it >> 6, h = (it >> 4) & 3, qt = it & 15;
    size_t tok = (size_t)b * 4096 + qt * 256;
    for (int hv = 0; hv < 2; ++hv)
      attn_item<256, 128, 1>(QX + tok * 1024 + h * 256, 1024, 256, (const u16*)(p.ws + W_MKP) + (size_t)((l * 4 + b) * 4 + h) * 65536, 256,
                             (const u16*)(p.ws + W_MVTP) + (size_t)((l * 4 + b) * 4 + h) * 65536 + hv * 128 * 256, 256, 256, XO + tok * 1024 + h * 256 + hv * 128, 1024);
  } else {
    int k = it - 256; int b = k >> 2, h = k & 3;
    size_t tok = (size_t)TP + b * 64;
    for (int hv = 0; hv < 2; ++hv)
      attn_item<256, 128, 1>(QX + tok * 1024 + h * 256, 1024, 64, (const u16*)(p.ws + W_MKS) + (size_t)(b * 4 + h) * 65536, 256,
                             (const u16*)(p.ws + W_MVTS) + (size_t)(b * 4 + h) * 65536 + hv * 128 * 256, 256, 256, XO + tok * 1024 + h * 256 + hv * 128, 1024);
  }
}

constexpr int CH_NST = 10;
__device__ __forceinline__ void phase_chain(KPR p, int ci, int dup = 0) {
  extern __shared__ __attribute__((aligned(16))) char smem[];
  int* sItem = (int*)(smem + SMEM_ITEM);
  int* CT = (int*)(p.ws + W_CNT) + dup * 8192;
  const float rc = dup ? 0.f : 1.f;
  int* q = CT + 3800 + ci; int* xa = CT + 72 + ci; int* oa = CT + 80 + ci;
  int* cnt = CT + 128 + ci * CH_NST * 72;
  int* stamp = CT + 4096 + ci * CH_NST * 72;
  int* G = CT + 8000 + ci; int* xast = CT + 8010 + ci; int* oast = CT + 8020 + ci;
  int lastG = 0;
  const bool hasTail = ci >= 1, hasHead = ci < NL;
  const int lt = ci - 1, lh = ci;
  const int e0 = hasTail ? 288 : 0, e1 = e0 + (hasTail ? 288 : 0), e2 = e1 + (hasTail ? 384 : 0), e3 = e2 + (hasTail ? 288 : 0),
            e4 = e3 + (hasTail ? 792 : 0), e5 = e4 + (hasTail ? 288 : 0), e6 = e5 + (hasHead ? 792 : 0), e7 = e6 + (hasHead ? 288 : 0),
            e8 = e7 + (hasHead ? 224 : 0), e9 = e8 + (hasHead ? 648 : 0);
  float* X = (float*)(p.ws + W_X); u16* XB = (u16*)(p.ws + W_XB); float* SSQ = (float*)(p.ws + W_SSQ); u16* ACT = (u16*)(p.ws + W_ACT);
  const int grp = blockIdx.x & 7;
  int nxt = 0;
  if (tidx() == 0) nxt = atomicAdd(q + grp * 8, 1) * 8 + grp;
  for (;;) {
    const int tid = tidx();
    if (tid == 0) {
      const int it = nxt;
      if (it < e9) {
        int st, idx;
        if (it < e0) { st = 0; idx = it; } else if (it < e1) { st = 1; idx = it - e0; } else if (it < e2) { st = 2; idx = it - e1; }
        else if (it < e3) { st = 3; idx = it - e2; } else if (it < e4) { st = 4; idx = it - e3; } else if (it < e5) { st = 5; idx = it - e4; }
        else if (it < e6) { st = 6; idx = it - e5; } else if (it < e7) { st = 7; idx = it - e6; } else if (it < e8) { st = 8; idx = it - e7; }
        else { st = 9; idx = it - e8; }
        int pm = 0, pn = 0;
        if (st == 2) pm = idx < 256 ? ((idx >> 6) * 16 + (idx & 15)) : (64 + ((idx - 256) >> 4));
        else if (st != 8) tile_map(idx, 72, (st == 4 || st == 6) ? 11 : (st == 9 ? 9 : 4), pm, pn);
        const int* c1 = nullptr; const int* c2 = nullptr;
        switch (st) {
          case 1: c1 = stamp + 0 * 72 + pm; break;
          case 2: c1 = stamp + 1 * 72 + pm; break;
          case 3: c1 = stamp + 2 * 72 + pm; break;
          case 4: c1 = stamp + 3 * 72 + pm; c2 = xast; break;
          case 5: c1 = stamp + 4 * 72 + pm; break;
          case 6: if (hasTail) c1 = stamp + 5 * 72 + pm; break;
          case 7: c1 = stamp + 6 * 72 + pm; break;
          case 8: if (hasTail) c1 = xast; break;
          case 9: c1 = stamp + 7 * 72 + pm; if (hasTail) c2 = oast; break;
          default: break;
        }
        if (dup) { c1 = nullptr; c2 = nullptr; }
        int s1 = 0, s2 = 0;
        if (c1) while ((s1 = __hip_atomic_load(c1, __ATOMIC_RELAXED, __HIP_MEMORY_SCOPE_AGENT)) == 0) __builtin_amdgcn_s_sleep(4);
        if (c2) while ((s2 = __hip_atomic_load(c2, __ATOMIC_RELAXED, __HIP_MEMORY_SCOPE_AGENT)) == 0) __builtin_amdgcn_s_sleep(4);
        if ((s1 > s2 ? s1 : s2) >= lastG) {
          const int g = __hip_atomic_load(G, __ATOMIC_RELAXED, __HIP_MEMORY_SCOPE_AGENT);
          __builtin_amdgcn_fence(__ATOMIC_ACQUIRE, "agent");
          asm volatile("s_waitcnt vmcnt(0)" ::: "memory");
          lastG = g;
        }
        sItem[1] = st; sItem[2] = idx; sItem[3] = pm; sItem[4] = pn;
      }
      sItem[0] = it;
    }
    __syncthreads();
    if (sItem[0] >= e9) break;
    const int st = sItem[1], idx = sItem[2], pm = sItem[3], pn = sItem[4];
    if (tid == 0) nxt = atomicAdd(q + grp * 8, 1) * 8 + grp;
    if (dup && !((PROBE_MASK >> st) & 1)) { __syncthreads(); continue; }
    const u16* WTt = (const u16*)(p.ws + W_WT) + (size_t)(lt < 0 ? 0 : lt) * WE_LAYER;
    const u16* WTh = (const u16*)(p.ws + W_WT) + (size_t)(lh >= NL ? 0 : lh) * WE_LAYER;
    switch (st) {
      case 0: gemm_tile((const u16*)(p.ws + W_AO), WTt + WE_OUT, 1536, pm, pn, EpiRes{X, XB, SSQ, rc}); break;
      case 1: gemm_tile(XB, WTt + WE_MQ, 1024, pm, pn, EpiScaleBf{SSQ, (u16*)(p.ws + W_QX), 1024}); break;
      case 2: xattn_item(p, lt, idx); break;
      case 3: gemm_tile((const u16*)(p.ws + W_XO), WTt + WE_MO, 1024, pm, pn, EpiRes{X, XB, SSQ, rc}); break;
      case 4: gemm_tile(XB, WTt + WE_GU2, 1024, pm, 2 * pn, EpiGU{SSQ, ACT}); gemm_tile(XB, WTt + WE_GU2, 1024, pm, 2 * pn + 1, EpiGU{SSQ, ACT}); break;
      case 5: gemm_tile(ACT, WTt + WE_D2, DFF, pm, pn, EpiRes{X, XB, SSQ, 0.5f * rc}); break;
      case 6: gemm_tile(XB, WTh + WE_GU1, 1024, pm, 2 * pn, EpiGU{SSQ, ACT}); gemm_tile(XB, WTh + WE_GU1, 1024, pm, 2 * pn + 1, EpiGU{SSQ, ACT}); break;
      case 7: gemm_tile(ACT, WTh + WE_D1, DFF, pm, pn, EpiRes{X, XB, SSQ, 0.5f * rc}); break;
      case 8: conv_caches(p, lh, idx, 224); break;
      default: gemm_tile(XB, WTh + WE_IN, 1024, pm, pn, EpiScaleBf{SSQ, (u16*)(p.ws + W_PROJ), DINP}); break;
    }
    asm volatile("s_waitcnt vmcnt(0)" ::: "memory");
    __syncthreads();
    if (tidx() == 64) {
      __builtin_amdgcn_fence(__ATOMIC_RELEASE, "agent");
      asm volatile("s_waitcnt vmcnt(0)" ::: "memory");
      atomicAdd(G, 1);
      const int full = (st == 4 || st == 6) ? 11 : (st == 9 ? 9 : (st == 2 ? (pm < 64 ? 4 : 16) : 4));
      if (atomicAdd(cnt + st * 72 + pm, 1) + 1 == full)
        __hip_atomic_store(stamp + st * 72 + pm, __hip_atomic_load(G, __ATOMIC_RELAXED, __HIP_MEMORY_SCOPE_AGENT), __ATOMIC_RELAXED, __HIP_MEMORY_SCOPE_AGENT);
      if (st == 2 && atomicAdd(xa, 1) + 1 == 384)
        __hip_atomic_store(xast, __hip_atomic_load(G, __ATOMIC_RELAXED, __HIP_MEMORY_SCOPE_AGENT), __ATOMIC_RELAXED, __HIP_MEMORY_SCOPE_AGENT);
      if (st == 0 && atomicAdd(oa, 1) + 1 == 288)
        __hip_atomic_store(oast, __hip_atomic_load(G, __ATOMIC_RELAXED, __HIP_MEMORY_SCOPE_AGENT), __ATOMIC_RELAXED, __HIP_MEMORY_SCOPE_AGENT);
    }
  }
}

__device__ __forceinline__ void phase_final(KPR p) {
  const int tid = tidx(), wid = tid >> 6, lane = tid & 63;
  const float* X = (const float*)(p.ws + W_X); const float* fn = p.in[I_FN];
  for (int g = blockIdx.x * 8 + wid; g < T; g += gridDim.x * 8) {
    float4 v[4]; float ss = 0.f;
#pragma unroll
    for (int i = 0; i < 4; ++i) { v[i] = *(const float4*)(X + (size_t)g * 1024 + i * 256 + lane * 4); ss += v[i].x * v[i].x + v[i].y * v[i].y + v[i].z * v[i].z + v[i].w * v[i].w; }
    ss = wave_sum(ss);
    float rs = rsqrtf(ss * (1.f / 1024.f) + 1e-6f);
#pragma unroll
    for (int i = 0; i < 4; ++i) {
      float4 gn = *(const float4*)(fn + i * 256 + lane * 4);
      *(float4*)(p.out + OO_Y + (size_t)g * 1024 + i * 256 + lane * 4) = make_float4(v[i].x * rs * gn.x, v[i].y * rs * gn.y, v[i].z * rs * gn.z, v[i].w * rs * gn.w);
    }
  }
}

constexpr int NPL = 6;
constexpr int N_PHASES = 3 + NPL * NL + 1;

__device__ __forceinline__ void run_phase(KPR p, int ph) {
  if (ph == 0) { phase_init(p); return; }
  if (ph == 1) {
    for (int l = 0; l < NL; ++l) {
      const u16* WT = (const u16*)(p.ws + W_WT) + (size_t)l * WE_LAYER;
      gemm_phase((const u16*)(p.ws + W_MB), WT + WE_MK, 1024, 4, 4, (2 * l) * 16,
                 EpiMem<false>{p.out + OO_MKP + (size_t)l * 1048576, (u16*)(p.ws + W_MKP) + (size_t)l * 16 * 65536});
      gemm_phase((const u16*)(p.ws + W_MB), WT + WE_MV, 1024, 4, 4, (2 * l + 1) * 16,
                 EpiMem<true>{p.out + OO_MVP + (size_t)l * 1048576, (u16*)(p.ws + W_MVTP) + (size_t)l * 16 * 65536});
    }
    return;
  }
  if (ph == 2) { phase_chain(p, 0); if (PROBE_REP & 1) { cg::this_grid().sync(); phase_chain(p, 0, 1); } return; }
  if (ph == N_PHASES - 1) { if (PROBE_REP & 64) for (int i = 0; i < 40; ++i) cg::this_grid().sync(); phase_final(p); return; }
  const int l = (ph - 3) / NPL, s = (ph - 3) % NPL;
  const u16* WT = (const u16*)(p.ws + W_WT) + (size_t)l * WE_LAYER;
  switch (s) {
    case 0: phase_prep(p, l); if (PROBE_REP & 2) { cg::this_grid().sync(); phase_prep(p, l); } break;
    case 1:
      gemm_phase((const u16*)(p.ws + W_CQB), WT + WE_Q, 256, 72, 5, 0, EpiQ{(u16*)(p.ws + W_QB), (const float2*)(p.ws + W_ROPE)});
      gemm_phase((const u16*)(p.ws + W_A2), WT + WE_RW, 256, 72, 6, 360,
                 EpiRW{p.in[I_W0] + l * 512, p.in[I_A0] + l * 512, p.in[I_KA] + l * 512, p.ws});
      break;
    case 2: phase_cprep(p); if (PROBE_REP & 8) { cg::this_grid().sync(); phase_cprep(p); } break;
    case 3: phase_mix(p, l, 0); if (PROBE_REP & 16) { cg::this_grid().sync(); phase_mix(p, l, 2); } break;
    case 4: phase_yfin(p, l); if (PROBE_REP & 32) { cg::this_grid().sync(); phase_yfin(p, l); } break;
    default: phase_chain(p, l + 1); if (PROBE_REP & 1) { cg::this_grid().sync(); phase_chain(p, l + 1, 1); } break;
  }
}

__device__ __forceinline__ void grid_barrier(int* CT, int gen) {
  asm volatile("s_waitcnt vmcnt(0)" ::: "memory");
  __syncthreads();
  if (tidx() == 0) {
    __builtin_amdgcn_fence(__ATOMIC_RELEASE, "agent");
    asm volatile("s_waitcnt vmcnt(0)" ::: "memory");
    int* grpc = CT + 15000 + (blockIdx.x & 7) * 32;
    int* glob = CT + 15000 + 8 * 32;
    const int per = gridDim.x >> 3;
    if (atomicAdd(grpc, 1) + 1 == per * (gen + 1)) atomicAdd(glob, 1);
    while (__hip_atomic_load(glob, __ATOMIC_RELAXED, __HIP_MEMORY_SCOPE_AGENT) < 8 * (gen + 1)) __builtin_amdgcn_s_sleep(1);
    __builtin_amdgcn_fence(__ATOMIC_ACQUIRE, "agent");
    asm volatile("s_waitcnt vmcnt(0)" ::: "memory");
  }
  __syncthreads();
}

__global__ void __launch_bounds__(NTHR) mega(Params p) {
  cg::grid_group grid = cg::this_grid();
  for (int ph = p.ph_lo; ph < p.ph_hi; ++ph) {
    const __attribute__((address_space(4))) Params* q = (const __attribute__((address_space(4))) Params*)__builtin_amdgcn_kernarg_segment_ptr();
    asm volatile("" : "+s"(q));
    run_phase(*q, ph);
    if (ph + 1 < p.ph_hi) {
      if (ph == p.ph_lo) grid.sync();
      else grid_barrier((int*)(q->ws + W_CNT), ph - p.ph_lo - 1);
    }
  }
}

extern "C" void kernel_launch(void* const* d_in, const int* in_sizes, int n_in, void* d_out, int out_size, void* d_ws,
                              size_t ws_size, hipStream_t stream) {
  static int grid = 0;
  if (grid == 0) {
    if (n_in != N_IN || (size_t)out_size != OO_END || ws_size < W_END) {
      fprintf(stderr, "kernel_launch: unexpected shapes n_in=%d out=%d ws=%zu (need %zu)\n", n_in, out_size, ws_size, (size_t)W_END);
      grid = -1; return;
    }
    int dev = 0, cus = 0, per_cu = 0;
    hipGetDevice(&dev);
    hipDeviceGetAttribute(&cus, hipDeviceAttributeMultiprocessorCount, dev);
    hipFuncSetAttribute((const void*)mega, hipFuncAttributeMaxDynamicSharedMemorySize, SMEM_BYTES);
    hipOccupancyMaxActiveBlocksPerMultiprocessor(&per_cu, (const void*)mega, NTHR, SMEM_BYTES);
    if (per_cu < 1) { fprintf(stderr, "kernel_launch: occupancy query says %d blocks/CU\n", per_cu); per_cu = 1; }
    (void)hipGetLastError();
    grid = cus;
  }
  if (grid < 0) return;
  if (hipMemsetAsync((char*)d_ws + W_CNT, 0, 65536, stream) != hipSuccess) { fprintf(stderr, "kernel_launch: memset of control words failed\n"); return; }
  Params p{};
  for (int i = 0; i < N_IN; ++i) p.in[i] = (const float*)d_in[i];
  p.out = (float*)d_out; p.ws = (char*)d_ws;
#if N_LAUNCH_PER_PHASE
  for (int ph = 0; ph < N_PHASES; ++ph) {
    p.ph_lo = ph; p.ph_hi = ph + 1;
    void* args[] = {&p};
    hipError_t e = hipLaunchCooperativeKernel((const void*)mega, dim3(grid), dim3(NTHR), args, SMEM_BYTES, stream);
    if (e != hipSuccess) { fprintf(stderr, "launch failed: %s\n", hipGetErrorString(e)); break; }
  }
#else
  p.ph_lo = 0; p.ph_hi = N_PHASES;
  void* args[] = {&p};
  hipError_t e = hipLaunchCooperativeKernel((const void*)mega, dim3(grid), dim3(NTHR), args, SMEM_BYTES, stream);
  if (e != hipSuccess) fprintf(stderr, "cooperative launch failed: %s (grid %d)\n", hipGetErrorString(e), grid);
#endif
}
```

```cpp
#include <hip/hip_runtime.h>
#include <hip/hip_cooperative_groups.h>
#include <stdint.h>
#include <stdio.h>
namespace cg = cooperative_groups;

typedef unsigned short u16;
using bf16x8 = __attribute__((ext_vector_type(8))) short;
using f32x4 = __attribute__((ext_vector_type(4))) float;
using f32x16 = __attribute__((ext_vector_type(16))) float;

#ifndef REP_WHICH
#define REP_WHICH 0
#endif
#ifndef PROBE_REP
#define PROBE_REP 0
#endif
#ifndef PROBE_MASK
#define PROBE_MASK 0x3ff
#endif
#ifndef N_LAUNCH_PER_PHASE
#define N_LAUNCH_PER_PHASE 0
#endif

constexpr int TP = 16384, TS = 2048, T = TP + TS, NL = 4;
constexpr int DFF = 2816, DIN = 2208, DINP = 2304, DSH = 1792;
constexpr int NTHR = 512;
constexpr int SMEM_BYTES = 139264 + 2048;
constexpr int SMEM_ITEM = 139264 + 1024;
constexpr float QSCALE = 0.10206207261596577f * 1.4426950408889634f;
constexpr float XSCALE = 0.0625f * 1.4426950408889634f;

constexpr size_t OO_Y = 0;
constexpr size_t OO_CKVP = OO_Y + (size_t)T * 1024;
constexpr size_t OO_KRP = OO_CKVP + (size_t)NL * 4 * 4096 * 128;
constexpr size_t OO_MKP = OO_KRP + (size_t)NL * 4 * 4096 * 32;
constexpr size_t OO_MVP = OO_MKP + (size_t)NL * 4 * 256 * 1024;
constexpr size_t OO_WKVP = OO_MVP + (size_t)NL * 4 * 256 * 1024;
constexpr size_t OO_SHP = OO_WKVP + (size_t)NL * 4 * 8 * 4096;
constexpr size_t OO_CKVS = OO_SHP + (size_t)NL * 4 * DSH;
constexpr size_t OO_KRS = OO_CKVS + (size_t)NL * 32 * 64 * 128;
constexpr size_t OO_WKVS = OO_KRS + (size_t)NL * 32 * 64 * 32;
constexpr size_t OO_SHS = OO_WKVS + (size_t)NL * 32 * 8 * 4096;
constexpr size_t OO_END = OO_SHS + (size_t)NL * 32 * DSH;

constexpr size_t al256(size_t x) { return (x + 255) & ~(size_t)255; }
constexpr size_t W_X = 0;
constexpr size_t W_XB = W_X + al256((size_t)T * 1024 * 4);
constexpr size_t W_SSQ = W_XB + al256((size_t)T * 1024 * 2);
constexpr size_t W_ACT = W_SSQ + al256((size_t)T * 4 * 4);
constexpr size_t W_WB = W_ACT;
constexpr size_t W_BB = W_WB + al256((size_t)T * 512 * 4);
constexpr size_t W_GB = W_BB + al256((size_t)T * 512 * 4);
constexpr size_t W_QX = W_ACT;
constexpr size_t W_PROJ = W_ACT + al256((size_t)T * DFF * 2);
constexpr size_t W_AO = W_PROJ;
constexpr size_t W_CQB = W_PROJ + al256((size_t)T * DINP * 2);
constexpr size_t W_A2 = W_CQB + al256((size_t)T * 256 * 2);
constexpr size_t W_QB = W_A2 + al256((size_t)T * 256 * 2);
constexpr size_t W_XO = W_QB;
constexpr size_t W_RB = W_QB + al256((size_t)T * 1280 * 2);
constexpr size_t W_KB = W_RB + al256((size_t)T * 512 * 4);
constexpr size_t W_VB = W_KB + al256((size_t)T * 512 * 4);
constexpr size_t W_KKB = W_VB + al256((size_t)T * 512 * 4);
constexpr size_t W_KP = W_KKB + al256((size_t)T * 512 * 4);
constexpr size_t W_KS = W_KP + al256((size_t)4 * 4096 * 160 * 2);
constexpr size_t W_VTP = W_KS + al256((size_t)32 * 2112 * 160 * 2);
constexpr size_t W_VTS = W_VTP + al256((size_t)4 * 128 * 4096 * 2);
constexpr size_t W_MKP = W_VTS + al256((size_t)32 * 128 * 2112 * 2);
constexpr size_t W_MVTP = W_MKP + al256((size_t)NL * 16 * 65536 * 2);
constexpr size_t W_MKS = W_MVTP + al256((size_t)NL * 16 * 65536 * 2);
constexpr size_t W_MVTS = W_MKS + al256((size_t)128 * 65536 * 2);
constexpr size_t W_MB = W_MVTS + al256((size_t)128 * 65536 * 2);
constexpr size_t W_ROPE = W_MB + al256((size_t)1024 * 1024 * 2);
constexpr size_t W_CNT = W_ROPE + al256((size_t)4096 * 16 * 8);
constexpr size_t W_YB = W_CNT + 65536;
constexpr size_t W_CQ = W_YB + al256((size_t)T * 512 * 4);
constexpr size_t W_WT = W_CQ + al256((size_t)2304 * 4096 * 4);
constexpr size_t W_CRR = W_PROJ + al256((size_t)T * 1536 * 2);
constexpr size_t W_CPT = W_CQB;
static_assert(W_CRR + (size_t)2304 * 4096 * 2 <= W_CQB, "RRt must fit behind AO");
static_assert((size_t)2304 * 4096 * 2 <= 2 * al256((size_t)T * 256 * 2), "Pt must fit in CQB+A2");
constexpr size_t WE_GU1 = 0;
constexpr size_t WE_D1 = WE_GU1 + (size_t)5632 * 1024;
constexpr size_t WE_IN = WE_D1 + (size_t)1024 * DFF;
constexpr size_t WE_Q = WE_IN + (size_t)DINP * 1024;
constexpr size_t WE_RW = WE_Q + (size_t)1280 * 256;
constexpr size_t WE_OUT = WE_RW + (size_t)1536 * 256;
constexpr size_t WE_MQ = WE_OUT + (size_t)1024 * 1536;
constexpr size_t WE_MK = WE_MQ + (size_t)1024 * 1024;
constexpr size_t WE_MV = WE_MK + (size_t)1024 * 1024;
constexpr size_t WE_MO = WE_MV + (size_t)1024 * 1024;
constexpr size_t WE_GU2 = WE_MO + (size_t)1024 * 1024;
constexpr size_t WE_D2 = WE_GU2 + (size_t)5632 * 1024;
constexpr size_t WE_LAYER = WE_D2 + (size_t)1024 * DFF;
constexpr size_t W_END = W_WT + al256(WE_LAYER * NL * 2);

enum { I_XP = 0, I_XS, I_MEMP, I_CCKV, I_CKR, I_CMK, I_CMV, I_SWKV, I_SSH, I_F1N, I_F1G, I_F1U, I_F1D, I_MIXN, I_WIN,
       I_QN, I_WUQ, I_KVN, I_WUK, I_WUV, I_MU, I_W0, I_WUP, I_A0, I_AUP, I_GUP, I_KK, I_KA, I_RK, I_GNG, I_GNB, I_WOUT,
       I_XN, I_MKVN, I_WMQ, I_WMK, I_WMV, I_WMO, I_F2N, I_F2G, I_F2U, I_F2D, I_FN, N_IN };

struct Params {
  const float* in[N_IN];
  float* out;
  char* ws;
  int ph_lo, ph_hi;
};

typedef const __attribute__((address_space(4))) Params& KPR;

typedef __bf16 bf2_t __attribute__((ext_vector_type(2)));
typedef float f2_t __attribute__((ext_vector_type(2)));
__device__ __forceinline__ u16 f2bf(float f) { __bf16 b = (__bf16)f; return __builtin_bit_cast(u16, b); }
__device__ __forceinline__ float bf2f(u16 h) { return __uint_as_float(((unsigned)h) << 16); }
__device__ __forceinline__ unsigned pack2(float a, float b) { f2_t v = {a, b}; bf2_t r = __builtin_convertvector(v, bf2_t); return __builtin_bit_cast(unsigned, r); }
__device__ __forceinline__ float4 bf4(uint2 w) {
  return make_float4(__uint_as_float(w.x << 16), __uint_as_float(w.x & 0xffff0000u), __uint_as_float(w.y << 16), __uint_as_float(w.y & 0xffff0000u));
}
__device__ __forceinline__ float wave_sum(float x) {
#pragma unroll
  for (int o = 32; o; o >>= 1) x += __shfl_xor(x, o);
  return x;
}
__device__ __forceinline__ float dpp_sum8(float x) {
  x += __int_as_float(__builtin_amdgcn_update_dpp(0, __float_as_int(x), 0xB1, 0xF, 0xF, false));
  x += __int_as_float(__builtin_amdgcn_update_dpp(0, __float_as_int(x), 0x4E, 0xF, 0xF, false));
  x += __int_as_float(__builtin_amdgcn_update_dpp(0, __float_as_int(x), 0x141, 0xF, 0xF, false));
  return x;
}
__device__ __forceinline__ int tidx() { int t = threadIdx.x; asm volatile("" : "+v"(t)); return t; }
__device__ __forceinline__ float fma_s(float a, float b, float c) { float d; asm("v_fma_f32 %0, %1, %2, %3" : "=v"(d) : "v"(a), "v"(b), "v"(c)); return d; }
__device__ __forceinline__ float sub_s(float a, float b) { float d; asm("v_sub_f32 %0, %1, %2" : "=v"(d) : "v"(a), "v"(b)); return d; }
__device__ __forceinline__ float add_s(float a, float b) { float d; asm("v_add_f32 %0, %1, %2" : "=v"(d) : "v"(a), "v"(b)); return d; }
__device__ __forceinline__ float mul_s(float a, float b) { float d; asm("v_mul_f32 %0, %1, %2" : "=v"(d) : "v"(a), "v"(b)); return d; }
__device__ __forceinline__ float sigmoidf_(float x) { return 1.f / (1.f + __expf(-x)); }

constexpr int BM = 256, BK = 64, HALF = 128, HT = HALF * BK;

__device__ __forceinline__ int lds_byte(int r, int c) {
  int st = (r >> 4) * 2 + (c >> 5), rr = r & 15, cc = c & 31, ob = rr * 64 + cc * 2;
  return st * 1024 + (ob ^ (((ob >> 9) & 1) << 5));
}
__device__ __forceinline__ void stage_rc(int b, int& R, int& C) {
  int st = b / 1024, sb = b % 1024, swz = sb ^ (((sb >> 9) & 1) << 5);
  R = (st >> 1) * 16 + swz / 64; C = (st & 1) * 32 + (swz % 64) / 2;
}

__device__ __forceinline__ void tile_map(int tile, int nM, int nN, int& pm, int& pn) {
  const int ntiles = nM * nN;
  int wgid = tile;
  { int q = ntiles / 8, r = ntiles % 8, xcd = wgid % 8, off = wgid / 8;
    wgid = (xcd < r ? xcd * (q + 1) : r * (q + 1) + (xcd - r) * q) + off; }
  int nig = 8 * nN, gid = wgid / nig, fm = gid * 8, gsz = min(nM - fm, 8);
  pm = fm + ((wgid % nig) % gsz); pn = (wgid % nig) / gsz;
}

template <class Epi>
__device__ __forceinline__ void gemm_tile(const u16* __restrict__ A, const u16* __restrict__ Bt, const int K,
                                          const int pm, const int pn, Epi epi) {
  extern __shared__ __attribute__((aligned(16))) char smem[];
  u16* shm = (u16*)smem;
#define SA(b, h) (shm + ((b) * 2 + (h)) * HT)
#define SB(b, h) (shm + (4 + (b) * 2 + (h)) * HT)
#define STAGE(P, BASE, br, kt) do { const u16* _gb = BASE + ((long)(br) * K + (long)(kt) * BK); \
    __builtin_amdgcn_global_load_lds((const unsigned*)((const char*)_gb + so0), \
        (__attribute__((address_space(3))) unsigned*)((char*)(P) + wu16), 16, 0, 0); \
    __builtin_amdgcn_global_load_lds((const unsigned*)((const char*)_gb + so1), \
        (__attribute__((address_space(3))) unsigned*)((char*)(P) + wu16 + 8192), 16, 0, 0); } while (0)
#define LDA(dst, b, h) for (int m = 0; m < 4; ++m) for (int k = 0; k < 2; ++k) \
    dst[m][k] = *reinterpret_cast<const bf16x8*>((char*)SA(b, h) + lds_byte(wr * 64 + m * 16 + fr, k * 32 + fq * 8))
#define LDB(dst, b, h) for (int n = 0; n < 2; ++n) for (int k = 0; k < 2; ++k) \
    dst[n][k] = *reinterpret_cast<const bf16x8*>((char*)SB(b, h) + lds_byte(wc * 32 + n * 16 + fr, k * 32 + fq * 8))
#define MMA(ai, bj, At_, Bt_) do { __builtin_amdgcn_s_setprio(1); \
    for (int m = 0; m < 4; ++m) for (int n = 0; n < 2; ++n) for (int k = 0; k < 2; ++k) \
      acc[ai][bj][m][n] = __builtin_amdgcn_mfma_f32_16x16x32_bf16(At_[m][k], Bt_[n][k], acc[ai][bj][m][n], 0, 0, 0); \
    __builtin_amdgcn_s_setprio(0); } while (0)
#define WAIT_V(n) asm volatile("s_waitcnt vmcnt(" #n ")" ::: "memory")
#define WAIT_L(n) asm volatile("s_waitcnt lgkmcnt(" #n ")" ::: "memory")
#define BAR __builtin_amdgcn_s_barrier()
#define SCHED __builtin_amdgcn_sched_barrier(0)
  const int tid_ = tidx();
  const int wid = tid_ >> 6, lane = tid_ & 63, wr = wid >> 2, wc = wid & 3, fr = lane & 15, fq = lane >> 4;
  const int nt = K / BK;
  const int wu16 = __builtin_amdgcn_readfirstlane(tid_ >> 6) * 1024;
  {
    unsigned so0, so1;
    { int _r, _c; stage_rc(tid_ * 16, _r, _c); so0 = (unsigned)(_r * K + _c) * 2u;
      stage_rc(tid_ * 16 + 8192, _r, _c); so1 = (unsigned)(_r * K + _c) * 2u; }
    const int brow = pm * BM, bcol = pn * BM;
    f32x4 acc[2][2][4][2] = {};
    bf16x8 At[4][2], B0[2][2], B1[2][2];
    STAGE(SB(0, 0), Bt, bcol, 0); STAGE(SA(0, 0), A, brow, 0);
    STAGE(SB(0, 1), Bt, bcol + HALF, 0); STAGE(SA(0, 1), A, brow + HALF, 0);
    if (wr == 1) BAR;
    WAIT_V(4); BAR;
    STAGE(SB(1, 0), Bt, bcol, 1); STAGE(SA(1, 0), A, brow, 1); STAGE(SB(1, 1), Bt, bcol + HALF, 1);
    WAIT_V(6); BAR;
    for (int t = 0; t < nt - 2; t += 2) {
      LDB(B0, 0, 0); SCHED; LDA(At, 0, 0); STAGE(SA(1, 1), A, brow + HALF, t + 1);
      WAIT_L(8); BAR; WAIT_L(0); MMA(0, 0, At, B0); BAR; SCHED;
      LDB(B1, 0, 1); STAGE(SB(0, 0), Bt, bcol, t + 2);
      BAR; WAIT_L(0); MMA(0, 1, At, B1); BAR;
      LDA(At, 0, 1); STAGE(SA(0, 0), A, brow, t + 2);
      BAR; WAIT_L(0); MMA(1, 0, At, B0); BAR; SCHED;
      STAGE(SB(0, 1), Bt, bcol + HALF, t + 2);
      WAIT_V(6); BAR; MMA(1, 1, At, B1); BAR;
      LDB(B0, 1, 0); SCHED; LDA(At, 1, 0); STAGE(SA(0, 1), A, brow + HALF, t + 2);
      WAIT_L(8); BAR; WAIT_L(0); MMA(0, 0, At, B0); BAR; SCHED;
      LDB(B1, 1, 1); STAGE(SB(1, 0), Bt, bcol, t + 3);
      BAR; WAIT_L(0); MMA(0, 1, At, B1); BAR;
      LDA(At, 1, 1); STAGE(SA(1, 0), A, brow, t + 3);
      BAR; WAIT_L(0); MMA(1, 0, At, B0); BAR; SCHED;
      STAGE(SB(1, 1), Bt, bcol + HALF, t + 3);
      WAIT_V(6); BAR; MMA(1, 1, At, B1); BAR;
    }
    { LDB(B0, 0, 0); LDA(At, 0, 0); STAGE(SA(1, 1), A, brow + HALF, nt - 1);
      BAR; WAIT_L(0); MMA(0, 0, At, B0); BAR;
      LDB(B1, 0, 1); BAR; WAIT_L(0); MMA(0, 1, At, B1); BAR;
      LDA(At, 0, 1); WAIT_V(4); BAR; WAIT_L(0); MMA(1, 0, At, B0); MMA(1, 1, At, B1); BAR; }
    { LDB(B0, 1, 0); LDA(At, 1, 0); WAIT_V(2); BAR; WAIT_L(0); MMA(0, 0, At, B0); BAR;
      LDB(B1, 1, 1); WAIT_V(0); BAR; WAIT_L(0); MMA(0, 1, At, B1); BAR;
      LDA(At, 1, 1); BAR; WAIT_L(0); MMA(1, 0, At, B0); MMA(1, 1, At, B1); BAR; }
    if (wr == 0) BAR;
    float* stg = (float*)smem;
    int tx = tid_;
    asm volatile("" : "+v"(tx));
    const int ewr = tx >> 8, ewc = (tx >> 6) & 3, efr = tx & 15, efq = (tx >> 4) & 3;
#define EPI_HALF(ai) do { \
    __syncthreads(); \
    _Pragma("unroll") for (int bj = 0; bj < 2; ++bj) _Pragma("unroll") for (int m = 0; m < 4; ++m) \
    _Pragma("unroll") for (int n = 0; n < 2; ++n) _Pragma("unroll") for (int j = 0; j < 4; ++j) \
      stg[(ewr * 64 + m * 16 + efq * 4 + j) * 260 + bj * HALF + ewc * 32 + n * 16 + efr] = acc[ai][bj][m][n][j]; \
    __syncthreads(); \
    for (int i = 0; i < 8; ++i) { \
      int item = i * NTHR + tx; int rl = item >> 5, qp = item & 31; \
      int cl = (qp >> 2) * 32 + (qp & 3) * 4; \
      float4 v0 = *(const float4*)(stg + rl * 260 + cl), v1 = *(const float4*)(stg + rl * 260 + cl + 16); \
      int row = brow + ai * HALF + rl; \
      float ss = epi.apply4(row, bcol + cl, v0, v1); \
      if (Epi::kSsq) { \
        ss += __shfl_xor(ss, 1); ss += __shfl_xor(ss, 2); ss += __shfl_xor(ss, 4); ss += __shfl_xor(ss, 8); ss += __shfl_xor(ss, 16); \
        if (qp == 0) epi.ssq_out(row, pn, ss); \
      } \
    } } while (0)
    EPI_HALF(0);
    EPI_HALF(1);
#undef EPI_HALF
    __syncthreads();
  }
#undef SA
#undef SB
#undef STAGE
#undef LDA
#undef LDB
#undef MMA
}

template <class Epi>
__device__ __forceinline__ void gemm_phase(const u16* __restrict__ A, const u16* __restrict__ Bt, const int K,
                                           const int nM, const int nN, const int rot, Epi epi) {
  const int G = gridDim.x;
  for (int tile = (int)((blockIdx.x + G - (rot % G)) % G); tile < nM * nN; tile += G) {
    int pm, pn; tile_map(tile, nM, nN, pm, pn);
    gemm_tile(A, Bt, K, pm, pn, epi);
  }
}

__device__ __forceinline__ float rstd_from_ssq(const float* ssq, int row) {
  float4 s = *(const float4*)(ssq + (size_t)row * 4);
  return rsqrtf((s.x + s.y + s.z + s.w) * (1.f / 1024.f) + 1e-6f);
}
__device__ __forceinline__ uint2 pack4(float4 v) { uint2 w; w.x = pack2(v.x, v.y); w.y = pack2(v.z, v.w); return w; }
__device__ __forceinline__ float silu_mul(float g, float u) { return g / (1.f + __expf(-g)) * u; }
struct EpiGU {
  static constexpr bool kSsq = false;
  const float* ssq; u16* act;
  __device__ __forceinline__ float apply4(int row, int c0, float4 g, float4 u) const {
    float rs = rstd_from_ssq(ssq, row);
    float4 o = make_float4(silu_mul(g.x * rs, u.x * rs), silu_mul(g.y * rs, u.y * rs), silu_mul(g.z * rs, u.z * rs), silu_mul(g.w * rs, u.w * rs));
    *(uint2*)(act + (size_t)row * DFF + ((c0 & ~31) >> 1) + (c0 & 15)) = pack4(o);
    return 0.f;
  }
  __device__ __forceinline__ void ssq_out(int, int, float) const {}
};
struct EpiRes {
  static constexpr bool kSsq = true;
  float* x; u16* xb; float* ssq; float coef;
  __device__ __forceinline__ float apply4(int row, int c0, float4 v0, float4 v1) const {
    size_t i = (size_t)row * 1024 + c0;
    float4 a = *(const float4*)(x + i), b = *(const float4*)(x + i + 16);
    a.x += coef * v0.x; a.y += coef * v0.y; a.z += coef * v0.z; a.w += coef * v0.w;
    b.x += coef * v1.x; b.y += coef * v1.y; b.z += coef * v1.z; b.w += coef * v1.w;
    *(float4*)(x + i) = a; *(float4*)(x + i + 16) = b;
    *(uint2*)(xb + i) = pack4(a); *(uint2*)(xb + i + 16) = pack4(b);
    return a.x * a.x + a.y * a.y + a.z * a.z + a.w * a.w + b.x * b.x + b.y * b.y + b.z * b.z + b.w * b.w;
  }
  __device__ __forceinline__ void ssq_out(int row, int pn, float v) const { ssq[(size_t)row * 4 + pn] = v; }
};
struct EpiScaleBf {
  static constexpr bool kSsq = false;
  const float* ssq; u16* o; int ld;
  __device__ __forceinline__ float apply4(int row, int c0, float4 v0, float4 v1) const {
    float rs = rstd_from_ssq(ssq, row);
    size_t i = (size_t)row * ld + c0;
    *(uint2*)(o + i) = pack4(make_float4(v0.x * rs, v0.y * rs, v0.z * rs, v0.w * rs));
    *(uint2*)(o + i + 16) = pack4(make_float4(v1.x * rs, v1.y * rs, v1.z * rs, v1.w * rs));
    return 0.f;
  }
  __device__ __forceinline__ void ssq_out(int, int, float) const {}
};
struct EpiQ {
  static constexpr bool kSsq = false;
  u16* qb; const float2* rope;
  __device__ __forceinline__ float apply4(int row, int c0, float4 v0, float4 v1) const {
    if (c0 < 1024) {
      size_t i = (size_t)row * 1280 + (c0 >> 7) * 160 + (c0 & 127);
      *(uint2*)(qb + i) = pack4(v0); *(uint2*)(qb + i + 16) = pack4(v1);
    } else {
      int h = (c0 - 1024) >> 5, f0 = c0 & 15;
      int pos = row < TP ? (row & 4095) : (2048 + ((row - TP) & 63));
      const float2* cs = rope + pos * 16 + f0;
      float2 c_0 = cs[0], c_1 = cs[1], c_2 = cs[2], c_3 = cs[3];
      size_t i = (size_t)row * 1280 + h * 160 + 128 + f0;
      *(uint2*)(qb + i) = pack4(make_float4(v0.x * c_0.x - v1.x * c_0.y, v0.y * c_1.x - v1.y * c_1.y, v0.z * c_2.x - v1.z * c_2.y, v0.w * c_3.x - v1.w * c_3.y));
      *(uint2*)(qb + i + 16) = pack4(make_float4(v0.x * c_0.y + v1.x * c_0.x, v0.y * c_1.y + v1.y * c_1.x, v0.z * c_2.y + v1.z * c_2.x, v0.w * c_3.y + v1.w * c_3.x));
    }
    return 0.f;
  }
  __device__ __forceinline__ void ssq_out(int, int, float) const {}
};
__device__ __forceinline__ float decay_f(float z) {
  float nz = -z;
  float sp = fmaxf(nz, 0.f) + __logf(1.f + __expf(-fabsf(nz)));
  return __expf(-__expf(-sp - 0.5f));
}
struct EpiRW {
  static constexpr bool kSsq = false;
  const float* w0; const float* a0; const float* ka; char* ws;
  __device__ __forceinline__ void acol(size_t i, int c, float4 v) const {
    u16* bb = (u16*)(ws + W_BB); u16* kb = (u16*)(ws + W_KB); const u16* kkb = (const u16*)(ws + W_KKB);
    float4 a_0 = *(const float4*)(a0 + c), k_a = *(const float4*)(ka + c), kk = bf4(*(const uint2*)(kkb + i)), k = bf4(*(const uint2*)(kb + i));
    float4 a = make_float4(sigmoidf_(a_0.x + v.x), sigmoidf_(a_0.y + v.y), sigmoidf_(a_0.z + v.z), sigmoidf_(a_0.w + v.w));
    *(uint2*)(bb + i) = pack4(make_float4(kk.x * a.x, kk.y * a.y, kk.z * a.z, kk.w * a.w));
    *(uint2*)(kb + i) = pack4(make_float4(k.x * (1.f + (a.x - 1.f) * k_a.x), k.y * (1.f + (a.y - 1.f) * k_a.y), k.z * (1.f + (a.z - 1.f) * k_a.z), k.w * (1.f + (a.w - 1.f) * k_a.w)));
  }
  __device__ __forceinline__ float apply4(int row, int c0, float4 v0, float4 v1) const {
    if (c0 < 512) {
      float* wb = (float*)(ws + W_WB);
      float4 z0 = *(const float4*)(w0 + c0), z1 = *(const float4*)(w0 + c0 + 16);
      size_t i = (size_t)row * 512 + c0;
      *(float4*)(wb + i) = make_float4(decay_f(z0.x + v0.x), decay_f(z0.y + v0.y), decay_f(z0.z + v0.z), decay_f(z0.w + v0.w));
      *(float4*)(wb + i + 16) = make_float4(decay_f(z1.x + v1.x), decay_f(z1.y + v1.y), decay_f(z1.z + v1.z), decay_f(z1.w + v1.w));
    } else if (c0 < 1024) {
      int c = c0 - 512; size_t i = (size_t)row * 512 + c;
      acol(i, c, v0); acol(i + 16, c + 16, v1);
    } else {
      u16* gb = (u16*)(ws + W_GB);
      size_t i = (size_t)row * 512 + (c0 - 1024);
      *(uint2*)(gb + i) = pack4(v0); *(uint2*)(gb + i + 16) = pack4(v1);
    }
    return 0.f;
  }
  __device__ __forceinline__ void ssq_out(int, int, float) const {}
};
template <bool ISV>
struct EpiMem {
  static constexpr bool kSsq = false;
  float* of; u16* ob;
  __device__ __forceinline__ void quad(int row, int col, float4 v) const {
    *(float4*)(of + (size_t)row * 1024 + col) = v;
    int b = row >> 8, m = row & 255, h = col >> 8, d = col & 255;
    if (ISV) {
      u16* o = ob + (size_t)((b * 4 + h) * 256 + d) * 256 + m;
      o[0] = f2bf(v.x); o[256] = f2bf(v.y); o[512] = f2bf(v.z); o[768] = f2bf(v.w);
    } else {
      *(uint2*)(ob + (size_t)((b * 4 + h) * 256 + m) * 256 + d) = pack4(v);
    }
  }
  __device__ __forceinline__ float apply4(int row, int c0, float4 v0, float4 v1) const {
    quad(row, c0, v0); quad(row, c0 + 16, v1);
    return 0.f;
  }
  __device__ __forceinline__ void ssq_out(int, int, float) const {}
};

template <class F>
__device__ __forceinline__ void tconv(u16* dst, int ldd, int N, int K, int rot, F f) {
  extern __shared__ __attribute__((aligned(16))) char smem[];
  float* t = (float*)smem;
  const int nk = K / 64, nt = (N / 64) * nk, G = gridDim.x;
  const int tid = tidx(), a = tid >> 6, c = tid & 63;
  for (int tile = (int)((blockIdx.x + G - (rot % G)) % G); tile < nt; tile += G) {
    int n0 = (tile / nk) * 64, k0 = (tile % nk) * 64;
    __syncthreads();
#pragma unroll
    for (int i = 0; i < 8; ++i) { int kk = a + 8 * i; t[kk * 65 + c] = f(k0 + kk, n0 + c); }
    __syncthreads();
#pragma unroll
    for (int i = 0; i < 2; ++i) {
      const int nn = (tid >> 4) + 32 * i, kq = (tid & 15) * 4;
      uint2 w; w.x = pack2(t[kq * 65 + nn], t[(kq + 1) * 65 + nn]); w.y = pack2(t[(kq + 2) * 65 + nn], t[(kq + 3) * 65 + nn]);
      *(uint2*)(dst + (size_t)(n0 + nn) * ldd + k0 + kq) = w;
    }
  }
}

template <class F>
__device__ __forceinline__ void tconv_v(u16* dst, int ldd, int N, int K, int vb, int nvb, F f) {
  extern __shared__ __attribute__((aligned(16))) char smem[];
  float* t = (float*)smem;
  const int nk = K / 64, nt = (N / 64) * nk;
  const int tid = tidx(), a = tid >> 6, c = tid & 63;
  for (int tile = vb; tile < nt; tile += nvb) {
    int n0 = (tile / nk) * 64, k0 = (tile % nk) * 64;
    __syncthreads();
#pragma unroll
    for (int i = 0; i < 8; ++i) { int kk = a + 8 * i; t[kk * 65 + c] = f(k0 + kk, n0 + c); }
    __syncthreads();
#pragma unroll
    for (int i = 0; i < 2; ++i) {
      const int nn = (tid >> 4) + 32 * i, kq = (tid & 15) * 4;
      uint2 w; w.x = pack2(t[kq * 65 + nn], t[(kq + 1) * 65 + nn]); w.y = pack2(t[(kq + 2) * 65 + nn], t[(kq + 3) * 65 + nn]);
      *(uint2*)(dst + (size_t)(n0 + nn) * ldd + k0 + kq) = w;
    }
  }
  __syncthreads();
}

template <int DK, int DV, int RPG>
__device__ __forceinline__ void attn_item(const u16* __restrict__ Qb, int ldq, int nrows, const u16* __restrict__ Kb, int ldk,
                                          const u16* __restrict__ Vtb, int ldvt, int nkeys, u16* __restrict__ Ob, int ldo) {
  extern __shared__ __attribute__((aligned(16))) char smem[];
  constexpr int KS = DK + 8, VS = 68;
  u16* sK = (u16*)smem;
  u16* sV = sK + 64 * KS;
  const int tid = tidx(), wid = tid >> 6, lane = tid & 63, q = lane & 31, hh = lane >> 5;
  const int row = wid * 32 + q;
  const bool active = (wid * 32) < nrows;
  bf16x8 qf[DK / 16];
  if (active) {
#pragma unroll
    for (int ks = 0; ks < DK / 16; ++ks) qf[ks] = *(const bf16x8*)(Qb + (size_t)row * ldq + ks * 16 + hh * 8);
  }
  f32x16 o[DV / 32];
#pragma unroll
  for (int dt = 0; dt < DV / 32; ++dt)
#pragma unroll
    for (int i = 0; i < 16; ++i) o[dt][i] = 0.f;
  float mrun = -1e30f, lrun = 0.f;
  const int nkt = nkeys >> 6;
  constexpr int KCH = (64 * (DK / 8) + NTHR - 1) / NTHR;
  static_assert(DV == 128 && KCH <= 4, "staging registers are written out by hand");
  uint4 kr0, kr1, kr2, kr3, vr0, vr1;
#define AT_KL(N_, kt_) { const int c = tid + N_ * NTHR; if (N_ < KCH && c < 64 * (DK / 8)) { const int r = c / (DK / 8), cc = c % (DK / 8); \
      kr##N_ = *(const uint4*)(Kb + (size_t)((kt_) * 64 + r) * ldk + cc * 8); } }
#define AT_VL(N_, kt_) { const int c = tid + N_ * NTHR; const int r = c >> 3, cc = c & 7; vr##N_ = *(const uint4*)(Vtb + (size_t)r * ldvt + (kt_) * 64 + cc * 8); }
#define AT_GLOAD(kt_) do { AT_KL(0, kt_) AT_KL(1, kt_) AT_KL(2, kt_) AT_KL(3, kt_) AT_VL(0, kt_) AT_VL(1, kt_) } while (0)
#define AT_KS(N_) { const int c = tid + N_ * NTHR; if (N_ < KCH && c < 64 * (DK / 8)) { const int r = c / (DK / 8), cc = c % (DK / 8); *(uint4*)(sK + r * KS + cc * 8) = kr##N_; } }
#define AT_VS(N_) { const int c = tid + N_ * NTHR; const int r = c >> 3, cc = c & 7; uint2* d = (uint2*)(sV + r * VS + cc * 8); \
      const uint4 t_ = vr##N_; d[0] = make_uint2(t_.x, t_.y); d[1] = make_uint2(t_.z, t_.w); }
  AT_GLOAD(0);
  for (int kt = 0; kt < nkt; ++kt) {
    __syncthreads();
    AT_KS(0) AT_KS(1) AT_KS(2) AT_KS(3) AT_VS(0) AT_VS(1)
    __syncthreads();
    if (kt + 1 < nkt) AT_GLOAD(kt + 1);
    if (active) {
      f32x16 s0, s1;
#pragma unroll
      for (int i = 0; i < 16; ++i) { s0[i] = 0.f; s1[i] = 0.f; }
#pragma unroll
      for (int ks = 0; ks < DK / 16; ++ks) {
        bf16x8 a0 = *(const bf16x8*)(sK + q * KS + ks * 16 + hh * 8);
        bf16x8 a1 = *(const bf16x8*)(sK + (32 + q) * KS + ks * 16 + hh * 8);
        s0 = __builtin_amdgcn_mfma_f32_32x32x16_bf16(a0, qf[ks], s0, 0, 0, 0);
        s1 = __builtin_amdgcn_mfma_f32_32x32x16_bf16(a1, qf[ks], s1, 0, 0, 0);
      }
      float mx = s0[0];
#pragma unroll
      for (int i = 1; i < 16; ++i) mx = fmaxf(mx, s0[i]);
#pragma unroll
      for (int i = 0; i < 16; ++i) mx = fmaxf(mx, s1[i]);
      mx = fmaxf(mx, __shfl_xor(mx, 32));
      float mn = fmaxf(mrun, mx);
      float alpha = __builtin_amdgcn_exp2f(mrun - mn);
      mrun = mn;
      float ps = 0.f;
#pragma unroll
      for (int i = 0; i < 16; ++i) { s0[i] = __builtin_amdgcn_exp2f(sub_s(s0[i], mn)); ps = add_s(ps, s0[i]); }
#pragma unroll
      for (int i = 0; i < 16; ++i) { s1[i] = __builtin_amdgcn_exp2f(sub_s(s1[i], mn)); ps = add_s(ps, s1[i]); }
      lrun = lrun * alpha + ps;
#pragma unroll
      for (int dt = 0; dt < DV / 32; ++dt)
#pragma unroll
        for (int i = 0; i < 16; ++i) o[dt][i] = mul_s(o[dt][i], alpha);
#pragma unroll
      for (int kb = 0; kb < 2; ++kb)
#pragma unroll
        for (int s = 0; s < 2; ++s) {
          union { bf16x8 v; unsigned u[4]; } pf;
#pragma unroll
          for (int jj = 0; jj < 4; ++jj) {
            float e0 = kb ? s1[8 * s + 2 * jj] : s0[8 * s + 2 * jj];
            float e1 = kb ? s1[8 * s + 2 * jj + 1] : s0[8 * s + 2 * jj + 1];
            pf.u[jj] = pack2(e0, e1);
          }
          const int kbase = kb * 32 + s * 16 + 4 * hh;
#pragma unroll
          for (int dt = 0; dt < DV / 32; ++dt) {
            const u16* vp = sV + (dt * 32 + q) * VS + kbase;
            union { bf16x8 v; uint2 u[2]; } vf;
            vf.u[0] = *(const uint2*)vp; vf.u[1] = *(const uint2*)(vp + 8);
            o[dt] = __builtin_amdgcn_mfma_f32_32x32x16_bf16(vf.v, pf.v, o[dt], 0, 0, 0);
          }
        }
    }
  }
  if (active) {
    lrun += __shfl_xor(lrun, 32);
    float inv = 1.f / lrun;
    u16* op = Ob + (size_t)(row / RPG) * ldo + (size_t)(row % RPG) * DV;
#pragma unroll
    for (int dt = 0; dt < DV / 32; ++dt)
#pragma unroll
      for (int g = 0; g < 4; ++g) {
        uint2 w;
        w.x = pack2(o[dt][4 * g] * inv, o[dt][4 * g + 1] * inv);
        w.y = pack2(o[dt][4 * g + 2] * inv, o[dt][4 * g + 3] * inv);
        *(uint2*)(op + dt * 32 + 8 * g + 4 * hh) = w;
      }
  }
}

#undef AT_GLOAD
#undef AT_KL
#undef AT_VL
#undef AT_KS
#undef AT_VS
__device__ __forceinline__ float dpp_sum16(float x) {
  x += __int_as_float(__builtin_amdgcn_update_dpp(0, __float_as_int(x), 0xB1, 0xF, 0xF, false));
  x += __int_as_float(__builtin_amdgcn_update_dpp(0, __float_as_int(x), 0x4E, 0xF, 0xF, false));
  x += __int_as_float(__builtin_amdgcn_update_dpp(0, __float_as_int(x), 0x141, 0xF, 0xF, false));
  x += __int_as_float(__builtin_amdgcn_update_dpp(0, __float_as_int(x), 0x140, 0xF, 0xF, false));
  return x;
}
__device__ __forceinline__ void scan_item(KPR p, int l, int g0, int h, int half, int nsteps, const float* S0, float* Sout) {
  extern __shared__ __attribute__((aligned(16))) char smem[];
  float* sT = (float*)smem;
  float* sV = sT + 5 * 4096;
  const float* src0 = (const float*)(p.ws + W_RB) + h * 64; const float* src1 = (const float*)(p.ws + W_WB) + h * 64;
  const float* src2 = (const float*)(p.ws + W_KB) + h * 64; const float* src3 = (const float*)(p.ws + W_KKB) + h * 64;
  const float* src4 = (const float*)(p.ws + W_BB) + h * 64;
  const float* VB = (const float*)(p.ws + W_VB) + h * 64 + half * 32;
  float* YB = (float*)(p.ws + W_YB) + h * 64 + half * 32;
  const int tid = tidx();
  const int il = tid >> 4, sub = tid & 15, j0 = sub * 4, i = half * 32 + il;
  float s[4];
#pragma unroll
  for (int j = 0; j < 4; ++j) s[j] = S0 ? S0[i * 64 + j0 + j] : 0.f;
  float4 pa0, pa1, pa2, pa3, pa4, pb0, pb1, pb2, pb3, pb4, pfv;
  const int e0 = tid, e1 = tid + NTHR;
  const int st0 = e0 >> 4, c40 = (e0 & 15) * 4, st1 = e1 >> 4, c41 = (e1 & 15) * 4;
  const int stv = tid >> 3, c4v = (tid & 7) * 4;
#define SC_GL1(x, c0_) pa##x = *(const float4*)(src##x + (size_t)(g0 + (c0_) + st0) * 512 + c40); \
                       pb##x = *(const float4*)(src##x + (size_t)(g0 + (c0_) + st1) * 512 + c41);
#define SC_GLOAD(c0_) do { SC_GL1(0, c0_) SC_GL1(1, c0_) SC_GL1(2, c0_) SC_GL1(3, c0_) SC_GL1(4, c0_) \
    pfv = *(const float4*)(VB + (size_t)(g0 + (c0_) + stv) * 512 + c4v); } while (0)
#define SC_ST1(x) *(float4*)(sT + x * 4096 + st0 * 64 + c40) = pa##x; *(float4*)(sT + x * 4096 + st1 * 64 + c41) = pb##x;
  SC_GLOAD(0);
  for (int c0 = 0; c0 < nsteps; c0 += 64) {
    __syncthreads();
    SC_ST1(0) SC_ST1(1) SC_ST1(2) SC_ST1(3) SC_ST1(4)
    *(float4*)(sV + stv * 32 + c4v) = pfv;
    __syncthreads();
    if (c0 + 64 < nsteps) SC_GLOAD(c0 + 64);
#define SC_LD(S, st_) do { const int _s = (st_) < 64 ? (st_) : 63; \
      S##r = *(const float4*)(sT + _s * 64 + j0); S##w = *(const float4*)(sT + 4096 + _s * 64 + j0); \
      S##k = *(const float4*)(sT + 8192 + _s * 64 + j0); S##q = *(const float4*)(sT + 12288 + _s * 64 + j0); \
      S##b = *(const float4*)(sT + 16384 + _s * 64 + j0); S##v = sV[_s * 32 + il]; } while (0)
#define SC_STEP(S, st_) do { \
      float sa = -dpp_sum16(fma_s(s[1], S##q.y, mul_s(s[0], S##q.x)) + fma_s(s[3], S##q.w, mul_s(s[2], S##q.z))); \
      s[0] = fma_s(sa, S##b.x, fma_s(s[0], S##w.x, mul_s(S##v, S##k.x))); \
      s[1] = fma_s(sa, S##b.y, fma_s(s[1], S##w.y, mul_s(S##v, S##k.y))); \
      s[2] = fma_s(sa, S##b.z, fma_s(s[2], S##w.z, mul_s(S##v, S##k.z))); \
      s[3] = fma_s(sa, S##b.w, fma_s(s[3], S##w.w, mul_s(S##v, S##k.w))); \
      float y = dpp_sum16(fma_s(s[1], S##r.y, mul_s(s[0], S##r.x)) + fma_s(s[3], S##r.w, mul_s(s[2], S##r.z))); \
      ykeep = (sub == ((st_) & 15)) ? y : ykeep; } while (0)
    float4 Ar, Aw, Ak, Aq, Ab, Br, Bw, Bk, Bq, Bb, Cr, Cw, Ck, Cq, Cb, Dr, Dw, Dk, Dq, Db;
    float Av, Bv, Cv, Dv, ykeep = 0.f;
    SC_LD(A, 0); SC_LD(B, 1); SC_LD(C, 2);
    for (int st = 0; st < 64; st += 4) {
      SC_LD(D, st + 3); SC_STEP(A, st);
      SC_LD(A, st + 4); SC_STEP(B, st + 1);
      SC_LD(B, st + 5); SC_STEP(C, st + 2);
      SC_LD(C, st + 6); SC_STEP(D, st + 3);
      if ((st & 15) == 12) YB[(size_t)(g0 + c0 + (st - 12) + sub) * 512 + il] = ykeep;
    }
  }
#undef SC_LD
#undef SC_STEP
#undef SC_GLOAD
#undef SC_GL1
#undef SC_ST1
  *(float4*)(Sout + i * 64 + j0) = make_float4(s[0], s[1], s[2], s[3]);
}

constexpr int LS = 68;
constexpr int LBUF = 64 * LS;
constexpr int LH = 72;

__device__ __forceinline__ void split8(const float* x, bf16x8& hi, bf16x8& lo) {
  union { bf16x8 v; unsigned u[4]; } H, Lo;
#pragma unroll
  for (int j = 0; j < 4; ++j) {
    const unsigned h = pack2(x[2 * j], x[2 * j + 1]);
    H.u[j] = h;
    Lo.u[j] = pack2(x[2 * j] - __uint_as_float(h << 16), x[2 * j + 1] - __uint_as_float(h & 0xffff0000u));
  }
  hi = H.v; lo = Lo.v;
}
template <int AM, int AK, int BKS, int BN, bool SPLIT = true>
__device__ __forceinline__ void mm64(const float* A, const float* B, f32x4 (&acc)[2], int m0, int n0, int lane) {
  const int lr = lane & 15, lq = lane >> 4;
#pragma unroll
  for (int ks = 0; ks < 2; ++ks) {
    const int k0 = ks * 32 + lq * 8;
    float a[8];
    if (AK == 1) {
      float4 x0 = *(const float4*)(A + (m0 + lr) * AM + k0), x1 = *(const float4*)(A + (m0 + lr) * AM + k0 + 4);
      a[0] = x0.x; a[1] = x0.y; a[2] = x0.z; a[3] = x0.w; a[4] = x1.x; a[5] = x1.y; a[6] = x1.z; a[7] = x1.w;
    } else {
#pragma unroll
      for (int j = 0; j < 8; ++j) a[j] = A[(m0 + lr) * AM + (k0 + j) * AK];
    }
    bf16x8 ah, al;
    if (SPLIT) split8(a, ah, al);
    else { union { bf16x8 v; unsigned u[4]; } H; for (int j = 0; j < 4; ++j) H.u[j] = pack2(a[2 * j], a[2 * j + 1]); ah = H.v; al = H.v; }
#pragma unroll
    for (int nt = 0; nt < 2; ++nt) {
      const int n = n0 + nt * 16 + lr;
      float b[8];
      if (BKS == 1) {
        float4 x0 = *(const float4*)(B + n * BN + k0), x1 = *(const float4*)(B + n * BN + k0 + 4);
        b[0] = x0.x; b[1] = x0.y; b[2] = x0.z; b[3] = x0.w; b[4] = x1.x; b[5] = x1.y; b[6] = x1.z; b[7] = x1.w;
      } else {
#pragma unroll
        for (int j = 0; j < 8; ++j) b[j] = B[(k0 + j) * BKS + n * BN];
      }
      if (SPLIT) {
        bf16x8 bh, bl; split8(b, bh, bl);
        acc[nt] = __builtin_amdgcn_mfma_f32_16x16x32_bf16(ah, bh, acc[nt], 0, 0, 0);
        acc[nt] = __builtin_amdgcn_mfma_f32_16x16x32_bf16(ah, bl, acc[nt], 0, 0, 0);
        acc[nt] = __builtin_amdgcn_mfma_f32_16x16x32_bf16(al, bh, acc[nt], 0, 0, 0);
      } else {
        union { bf16x8 v; unsigned u[4]; } Bh;
#pragma unroll
        for (int j = 0; j < 4; ++j) Bh.u[j] = pack2(b[2 * j], b[2 * j + 1]);
        acc[nt] = __builtin_amdgcn_mfma_f32_16x16x32_bf16(ah, Bh.v, acc[nt], 0, 0, 0);
      }
    }
  }
}
#define MM_ZERO(acc) do { acc[0] = f32x4{0.f, 0.f, 0.f, 0.f}; acc[1] = f32x4{0.f, 0.f, 0.f, 0.f}; } while (0)
#define MM_FOREACH(acc, BODY) do { _Pragma("unroll") for (int nt_ = 0; nt_ < 2; ++nt_) _Pragma("unroll") for (int rg_ = 0; rg_ < 4; ++rg_) { \
    const int m = m0 + lq * 4 + rg_, n = n0 + nt_ * 16 + lr; const float val = acc[nt_][rg_]; BODY } } while (0)

#define CPRE_PARAMS float4& c_w0, float4& c_w1, uint2& c_q0, uint2& c_q1, uint2& c_b0, uint2& c_b1, uint2& c_k0, uint2& c_k1, uint2& c_r0, uint2& c_r1, uint2& c_v0, uint2& c_v1
#define CPRE_ARGS(P) P##w0, P##w1, P##q0, P##q1, P##b0, P##b1, P##k0, P##k1, P##r0, P##r1, P##v0, P##v1
__device__ __forceinline__ void cprep_load(KPR p, int grow0, int h, int tid, CPRE_PARAMS) {
  const int t0 = tid >> 4, c4 = (tid & 15) * 4;
  const size_t g0 = (size_t)(grow0 + t0) * 512 + h * 64 + c4, g1 = g0 + (size_t)32 * 512;
  const float* WB = (const float*)(p.ws + W_WB); const u16* KKB = (const u16*)(p.ws + W_KKB); const u16* BB = (const u16*)(p.ws + W_BB);
  const u16* KB = (const u16*)(p.ws + W_KB); const u16* RB = (const u16*)(p.ws + W_RB); const u16* VB = (const u16*)(p.ws + W_VB);
  c_w0 = *(const float4*)(WB + g0); c_w1 = *(const float4*)(WB + g1); c_q0 = *(const uint2*)(KKB + g0); c_q1 = *(const uint2*)(KKB + g1);
  c_b0 = *(const uint2*)(BB + g0); c_b1 = *(const uint2*)(BB + g1); c_k0 = *(const uint2*)(KB + g0); c_k1 = *(const uint2*)(KB + g1);
  c_r0 = *(const uint2*)(RB + g0); c_r1 = *(const uint2*)(RB + g1); c_v0 = *(const uint2*)(VB + g0); c_v1 = *(const uint2*)(VB + g1);
}
__device__ __forceinline__ void cprep_item(KPR p, int grow0, int h, int cid, int ngrow0, int nh, CPRE_PARAMS) {
  extern __shared__ __attribute__((aligned(16))) char smem[];
  float* B0 = (float*)smem; float* B1 = B0 + LBUF; float* B2 = B1 + LBUF; float* B3 = B2 + LBUF;
  float* B4 = B3 + LBUF; float* B5 = B4 + LBUF; float* B6 = B5 + LBUF; float* B7 = B6 + LBUF;
  float* wC = (float*)(smem + 139264);
  const int tid = tidx(), wid = tid >> 6, lane = tid & 63, lr = lane & 15, lq = lane >> 4;
  const int m0 = (wid >> 1) * 16, n0 = (wid & 1) * 32;
  const float* WB = (const float*)(p.ws + W_WB) + h * 64; const float* KKB = (const float*)(p.ws + W_KKB) + h * 64;
  const float* BB = (const float*)(p.ws + W_BB) + h * 64; const float* KB = (const float*)(p.ws + W_KB) + h * 64;
  const float* RB = (const float*)(p.ws + W_RB) + h * 64; const float* VB = (const float*)(p.ws + W_VB) + h * 64;
  f32x4 acc[2];
  __syncthreads();
  {
    const int t0 = tid >> 4, c4 = (tid & 15) * 4, o0 = t0 * LS + c4, o1 = (t0 + 32) * LS + c4;
    *(float4*)(B0 + o0) = c_w0; *(float4*)(B0 + o1) = c_w1;
    { const float4 a0_ = bf4(c_q0), a1_ = bf4(c_q1);
      *(float4*)(B1 + o0) = make_float4(-a0_.x, -a0_.y, -a0_.z, -a0_.w); *(float4*)(B1 + o1) = make_float4(-a1_.x, -a1_.y, -a1_.z, -a1_.w); }
    *(float4*)(B2 + o0) = bf4(c_b0); *(float4*)(B2 + o1) = bf4(c_b1);
    *(float4*)(B3 + o0) = bf4(c_k0); *(float4*)(B3 + o1) = bf4(c_k1);
    *(float4*)(B4 + o0) = bf4(c_r0); *(float4*)(B4 + o1) = bf4(c_r1);
  }
  const uint2 vk0 = c_v0, vk1 = c_v1;
  __syncthreads();
  cprep_load(p, ngrow0, nh, tid, CPRE_ARGS(c_));
  {
    const int j = tid & 63, sg = tid >> 6;
    float wv[8];
#pragma unroll
    for (int u = 0; u < 8; ++u) wv[u] = B0[(sg * 8 + u) * LS + j];
#pragma unroll
    for (int u = 1; u < 8; ++u) wv[u] *= wv[u - 1];
    float* segp = B5;
    segp[sg * 64 + j] = wv[7];
    __syncthreads();
    float pre = 1.f;
    for (int u = 0; u < sg; ++u) pre *= segp[u * 64 + j];
#pragma unroll
    for (int u = 0; u < 8; ++u) B0[(sg * 8 + u) * LS + j] = wv[u] * pre;
    if (sg == 7) wC[j] = wv[7] * pre;
  }
  __syncthreads();
  for (int e = tid; e < 4096; e += NTHR) {
    const int t = e >> 6, j = e & 63, o = t * LS + j;
    const float wt = B0[o], wp = t ? B0[o - LS] : 1.f, iw = 1.f / wt;
    B1[o] *= wp; B2[o] *= iw; B3[o] *= iw; B4[o] *= wt;
  }
  __syncthreads();
  MM_ZERO(acc); mm64<LS, 1, 1, LS>(B2, B1, acc, m0, n0, lane);
  MM_FOREACH(acc, { const float v = m < n ? val : 0.f; B5[m * LS + n] = v; B6[m * LS + n] = v + (m == n ? 1.f : 0.f); });
  __syncthreads();
  MM_ZERO(acc); mm64<LS, 1, LS, 1>(B5, B5, acc, m0, n0, lane);
  MM_FOREACH(acc, { B7[m * LS + n] = val; });
  __syncthreads();
  for (int it = 0; it < 5; ++it) {
    MM_ZERO(acc); mm64<LS, 1, LS, 1>(B6, B7, acc, m0, n0, lane);
    f32x4 acc2[2]; MM_ZERO(acc2);
    if (it < 4) mm64<LS, 1, LS, 1>(B7, B7, acc2, m0, n0, lane);
    __syncthreads();
    MM_FOREACH(acc, { B6[m * LS + n] += val; });
    if (it < 4) MM_FOREACH(acc2, { B7[m * LS + n] = val; });
    __syncthreads();
  }
  MM_ZERO(acc); mm64<1, LS, LS, 1>(B1, B6, acc, m0, n0, lane);
  MM_FOREACH(acc, { B5[m * LS + n] = val; });
  MM_ZERO(acc); mm64<LS, 1, 1, LS>(B3, B1, acc, m0, n0, lane);
  MM_FOREACH(acc, { B0[m * LS + n] = m < n ? val : 0.f; });
  __syncthreads();
  MM_ZERO(acc); mm64<LS, 1, LS, 1>(B0, B6, acc, m0, n0, lane);
  MM_FOREACH(acc, { B7[m * LS + n] = val; });
  __syncthreads();
  MM_ZERO(acc); mm64<LS, 1, 1, LS, false>(B2, B4, acc, m0, n0, lane);
  {
    f32x4 acc2[2]; MM_ZERO(acc2); mm64<LS, 1, 1, LS, false>(B3, B4, acc2, m0, n0, lane);
    __syncthreads();
    MM_FOREACH(acc, { B0[m * LS + n] = m <= n ? val : 0.f; });
    MM_FOREACH(acc2, { B1[m * LS + n] = m <= n ? val : 0.f; });
  }
  __syncthreads();
  {
    u16* RRT = (u16*)(p.ws + W_CRR) + (size_t)cid * 4096;
    MM_ZERO(acc); mm64<1, LS, 1, LS, false>(B0, B5, acc, m0, n0, lane);
    MM_FOREACH(acc, { RRT[m * 64 + n] = f2bf(val + B4[m * LS + n]); });
    MM_ZERO(acc); mm64<LS, 1, LS, 1, false>(B7, B0, acc, m0, n0, lane);
    MM_FOREACH(acc, { B6[m * LS + n] = val + B1[m * LS + n]; });
  }
  __syncthreads();
  for (int e = tid; e < 4096; e += NTHR) {
    const int t = e >> 6, j = e & 63, o = t * LS + j;
    const float wc = wC[j];
    B2[o] *= wc; B3[o] *= wc;
  }
  { const int t0 = tid >> 4, c4 = (tid & 15) * 4; *(float4*)(B4 + t0 * LS + c4) = bf4(vk0); *(float4*)(B4 + (t0 + 32) * LS + c4) = bf4(vk1); }
  __syncthreads();
  {
    u16* YB = (u16*)(p.ws + W_YB) + h * 64;
    MM_ZERO(acc); mm64<1, LS, LS, 1, false>(B6, B4, acc, m0, n0, lane);
    MM_FOREACH(acc, { YB[(size_t)(grow0 + m) * 512 + n] = f2bf(val); });
    u16* PT = (u16*)(p.ws + W_CPT) + (size_t)cid * 4096;
    MM_ZERO(acc); mm64<1, LS, 1, LS, false>(B2, B5, acc, m0, n0, lane);
    MM_FOREACH(acc, { PT[m * 64 + n] = f2bf(val + (m == n ? wC[m] : 0.f)); });
    MM_ZERO(acc); mm64<LS, 1, LS, 1, false>(B7, B2, acc, m0, n0, lane);
    MM_FOREACH(acc, { B0[m * LS + n] = val + B3[m * LS + n]; });
  }
  __syncthreads();
  {
    float* CQ = (float*)(p.ws + W_CQ) + (size_t)cid * 4096;
    MM_ZERO(acc); mm64<1, LS, LS, 1, false>(B4, B0, acc, m0, n0, lane);
    MM_FOREACH(acc, { CQ[m * 64 + n] = val; });
  }
}

__device__ __forceinline__ void cprep_decode(int id, int& grow0, int& h) {
  if (id < 2048) { grow0 = (id >> 9) * 4096 + (id & 63) * 64; h = (id >> 6) & 7; }
  else { const int k = id - 2048; grow0 = TP + (k >> 3) * 64; h = k & 7; }
}
__device__ __forceinline__ void phase_cprep(KPR p) {
  float4 u_w0, u_w1; uint2 u_k0, u_k1, u_q0, u_q1, u_b0, u_b1, u_r0, u_r1, u_v0, u_v1;
  int id = blockIdx.x, grow0 = 0, h = 0;
  cprep_decode(id < 2304 ? id : 0, grow0, h); cprep_load(p, grow0, h, tidx(), CPRE_ARGS(u_));
  for (; id < 2304; id += gridDim.x) {
    const int nid = id + gridDim.x;
    int ng = 0, nh = 0;
    cprep_decode(nid < 2304 ? nid : id, ng, nh);
    cprep_item(p, grow0, h, id, ng, nh, CPRE_ARGS(u_));
    grow0 = ng; h = nh;
  }
}

__device__ __forceinline__ void cseq_item(KPR p, int g0, int h, int nch, int cid0, const float* S0, float* Sout) {
  extern __shared__ __attribute__((aligned(16))) char smem[];
  float* Sf = (float*)smem;
  float* Qf = Sf + LBUF;
  float* Yf = Qf + LBUF;
  u16* Rb = (u16*)(Yf + LBUF);
  u16* Pb = Rb + 64 * LH;
  const int tid = tidx(), wid = tid >> 6, lane = tid & 63, lr = lane & 15, lq = lane >> 4;
  const int m0 = (wid >> 1) * 16, n0 = (wid & 1) * 32;
  u16* YB = (u16*)(p.ws + W_YB) + h * 64;
  const u16* RRT = (const u16*)(p.ws + W_CRR) + (size_t)cid0 * 4096;
  const u16* PT = (const u16*)(p.ws + W_CPT) + (size_t)cid0 * 4096;
  const float* CQ = (const float*)(p.ws + W_CQ) + (size_t)cid0 * 4096;
  __syncthreads();
  for (int e = tid; e < 4096; e += NTHR) { const int i = e >> 6, j = e & 63; Sf[i * LS + j] = S0 ? S0[e] : 0.f; }
  const int hr = tid >> 3, hc = (tid & 7) * 8;
  const int f0t = tid >> 4, f0c = (tid & 15) * 4;
  uint4 pr, pp; float4 q0, q1; uint2 y0, y1;
#define CS_LOAD(c_) do { \
    pr = *(const uint4*)(RRT + (size_t)(c_) * 4096 + hr * 64 + hc); pp = *(const uint4*)(PT + (size_t)(c_) * 4096 + hr * 64 + hc); \
    q0 = *(const float4*)(CQ + (size_t)(c_) * 4096 + f0t * 64 + f0c); q1 = *(const float4*)(CQ + (size_t)(c_) * 4096 + (f0t + 32) * 64 + f0c); \
    y0 = *(const uint2*)(YB + (size_t)(g0 + (c_) * 64 + f0t) * 512 + f0c); y1 = *(const uint2*)(YB + (size_t)(g0 + (c_) * 64 + f0t + 32) * 512 + f0c); } while (0)
  CS_LOAD(0);
  for (int c = 0; c < nch; ++c) {
    __syncthreads();
    *(uint4*)(Rb + hr * LH + hc) = pr; *(uint4*)(Pb + hr * LH + hc) = pp;
    *(float4*)(Qf + f0t * LS + f0c) = q0; *(float4*)(Qf + (f0t + 32) * LS + f0c) = q1;
    *(float4*)(Yf + f0t * LS + f0c) = bf4(y0); *(float4*)(Yf + (f0t + 32) * LS + f0c) = bf4(y1);
    __syncthreads();
    if (c + 1 < nch) CS_LOAD(c + 1);
    f32x4 ay[2], as[2]; MM_ZERO(ay); MM_ZERO(as);
#pragma unroll
    for (int ks = 0; ks < 2; ++ks) {
      const int k0 = ks * 32 + lq * 8;
      const bf16x8 ra = *(const bf16x8*)(Rb + (m0 + lr) * LH + k0);
      float sa[8];
      { float4 x0 = *(const float4*)(Sf + (m0 + lr) * LS + k0), x1 = *(const float4*)(Sf + (m0 + lr) * LS + k0 + 4);
        sa[0] = x0.x; sa[1] = x0.y; sa[2] = x0.z; sa[3] = x0.w; sa[4] = x1.x; sa[5] = x1.y; sa[6] = x1.z; sa[7] = x1.w; }
      bf16x8 sah, sal; split8(sa, sah, sal);
#pragma unroll
      for (int nt = 0; nt < 2; ++nt) {
        const int n = n0 + nt * 16 + lr;
        float sb[8];
        { float4 x0 = *(const float4*)(Sf + n * LS + k0), x1 = *(const float4*)(Sf + n * LS + k0 + 4);
          sb[0] = x0.x; sb[1] = x0.y; sb[2] = x0.z; sb[3] = x0.w; sb[4] = x1.x; sb[5] = x1.y; sb[6] = x1.z; sb[7] = x1.w; }
        bf16x8 sbh, sbl; split8(sb, sbh, sbl);
        ay[nt] = __builtin_amdgcn_mfma_f32_16x16x32_bf16(ra, sbh, ay[nt], 0, 0, 0);
        ay[nt] = __builtin_amdgcn_mfma_f32_16x16x32_bf16(ra, sbl, ay[nt], 0, 0, 0);
        const bf16x8 pb = *(const bf16x8*)(Pb + n * LH + k0);
        as[nt] = __builtin_amdgcn_mfma_f32_16x16x32_bf16(sah, pb, as[nt], 0, 0, 0);
        as[nt] = __builtin_amdgcn_mfma_f32_16x16x32_bf16(sal, pb, as[nt], 0, 0, 0);
      }
    }
    MM_FOREACH(ay, { YB[(size_t)(g0 + c * 64 + m) * 512 + n] = f2bf(val + Yf[m * LS + n]); });
    __syncthreads();
    MM_FOREACH(as, { Sf[m * LS + n] = val + Qf[m * LS + n]; });
  }
#undef CS_LOAD
  __syncthreads();
  for (int e = tid; e < 4096; e += NTHR) { const int i = e >> 6, j = e & 63; Sout[e] = Sf[i * LS + j]; }
}

__device__ __forceinline__ void phase_yfin(KPR p, int l) {
  const int tid = tidx(), wid = tid >> 6, lane = tid & 63;
  const float* YB = (const float*)(p.ws + W_YB); const float* RB = (const float*)(p.ws + W_RB); const float* KB = (const float*)(p.ws + W_KB);
  const float* VB = (const float*)(p.ws + W_VB); const u16* GB = (const u16*)(p.ws + W_GB); u16* AO = (u16*)(p.ws + W_AO);
  const float* rk = p.in[I_RK] + l * 512; const float* gng = p.in[I_GNG] + l * 512; const float* gnb = p.in[I_GNB] + l * 512;
  for (int g = blockIdx.x * 8 + wid; g < T; g += gridDim.x * 8) {
#pragma unroll 2
    for (int h = 0; h < 8; ++h) {
      size_t i = (size_t)g * 512 + h * 64 + lane;
      float y = bf2f(((const u16*)YB)[i]);
      float mu = wave_sum(y) * (1.f / 64.f);
      float dlt = y - mu;
      float var = wave_sum(dlt * dlt) * (1.f / 64.f);
      float bon = wave_sum(bf2f(((const u16*)RB)[i]) * bf2f(((const u16*)KB)[i]) * rk[h * 64 + lane]);
      float v = dlt * rsqrtf(var + 64e-5f) * gng[h * 64 + lane] + gnb[h * 64 + lane] + bon * bf2f(((const u16*)VB)[i]);
      AO[(size_t)g * 1536 + 1024 + h * 64 + lane] = f2bf(v * bf2f(GB[i]));
    }
  }
}

__device__ __forceinline__ void phase_init(KPR p) {
  const int G = gridDim.x, tid = tidx(), wid = tid >> 6, lane = tid & 63;
  const int gw = blockIdx.x * 8 + wid, nw = G * 8;
  {
    float* X = (float*)(p.ws + W_X); u16* XB = (u16*)(p.ws + W_XB); float* SSQ = (float*)(p.ws + W_SSQ);
    for (int g = gw; g < T; g += nw) {
      const float* src = g < TP ? p.in[I_XP] + (size_t)g * 1024 : p.in[I_XS] + (size_t)(g - TP) * 1024;
      float ss = 0.f;
#pragma unroll
      for (int i = 0; i < 4; ++i) {
        float4 v = *(const float4*)(src + i * 256 + lane * 4);
        *(float4*)(X + (size_t)g * 1024 + i * 256 + lane * 4) = v;
        uint2 w; w.x = pack2(v.x, v.y); w.y = pack2(v.z, v.w);
        *(uint2*)(XB + (size_t)g * 1024 + i * 256 + lane * 4) = w;
        ss += v.x * v.x + v.y * v.y + v.z * v.z + v.w * v.w;
      }
      ss = wave_sum(ss);
      if (lane == 0) *(float4*)(SSQ + (size_t)g * 4) = make_float4(ss, 0.f, 0.f, 0.f);
    }
  }
  {
    u16* MB = (u16*)(p.ws + W_MB);
    for (int g = gw; g < 1024; g += nw) {
      const float* src = p.in[I_MEMP] + (size_t)g * 1024;
      float4 v[4]; float ss = 0.f;
#pragma unroll
      for (int i = 0; i < 4; ++i) { v[i] = *(const float4*)(src + i * 256 + lane * 4); ss += v[i].x * v[i].x + v[i].y * v[i].y + v[i].z * v[i].z + v[i].w * v[i].w; }
      ss = wave_sum(ss);
      float rs = rsqrtf(ss * (1.f / 1024.f) + 1e-6f);
#pragma unroll
      for (int i = 0; i < 4; ++i) {
        uint2 w; w.x = pack2(v[i].x * rs, v[i].y * rs); w.y = pack2(v[i].z * rs, v[i].w * rs);
        *(uint2*)(MB + (size_t)g * 1024 + i * 256 + lane * 4) = w;
      }
    }
  }
  {
    float2* RT = (float2*)(p.ws + W_ROPE);
    for (int e = blockIdx.x * NTHR + tid; e < 4096 * 16; e += G * NTHR) {
      int pos = e >> 4, i = e & 15;
      float inv = powf(10000.f, -(float)i / 16.f);
      float ang = (float)pos * inv;
      float sn, cs; sincosf(ang, &sn, &cs);
      RT[e] = make_float2(cs, sn);
    }
  }
  int rot = 0;
  for (int l = 0; l < NL; ++l) {
    u16* WT = (u16*)(p.ws + W_WT) + (size_t)l * WE_LAYER;
    for (int f = 0; f < 2; ++f) {
      const float* nrm = p.in[f ? I_F2N : I_F1N] + l * 1024;
      const float* wg = p.in[f ? I_F2G : I_F1G] + (size_t)l * 1024 * DFF;
      const float* wu = p.in[f ? I_F2U : I_F1U] + (size_t)l * 1024 * DFF;
      const float* wd = p.in[f ? I_F2D : I_F1D] + (size_t)l * 1024 * DFF;
      tconv(WT + (f ? WE_GU2 : WE_GU1), 1024, 5632, 1024, rot, [=](int k, int n) {
        int j = (n >> 5) * 16 + (n & 15);
        const float* s = ((n >> 4) & 1) ? wu : wg;
        return nrm[k] * s[(size_t)k * DFF + j];
      });
      rot += 88 * 16;
      tconv(WT + (f ? WE_D2 : WE_D1), DFF, 1024, DFF, rot, [=](int k, int n) { return wd[(size_t)k * 1024 + n]; });
      rot += 16 * 44;
    }
    {
      const float* nrm = p.in[I_MIXN] + l * 1024; const float* w = p.in[I_WIN] + (size_t)l * 1024 * DIN;
      tconv(WT + WE_IN, 1024, DINP, 1024, rot, [=](int k, int n) { return n < DIN ? nrm[k] * w[(size_t)k * DIN + n] : 0.f; });
      rot += 36 * 16;
    }
    {
      const float* nrm = p.in[I_QN] + l * 256; const float* wuq = p.in[I_WUQ] + (size_t)l * 256 * 768;
      const float* wuk = p.in[I_WUK] + (size_t)l * 8 * 128 * 64;
      tconv(WT + WE_Q, 256, 1280, 256, rot, [=](int k, int n) {
        float r;
        if (n < 1024) {
          int h = n >> 7, c = n & 127;
          const float* a = wuq + (size_t)k * 768 + h * 96; const float* b = wuk + (size_t)(h * 128 + c) * 64;
          r = 0.f;
          for (int d = 0; d < 64; ++d) r += a[d] * b[d];
        } else {
          int hr = n - 1024;
          r = wuq[(size_t)k * 768 + (hr >> 5) * 96 + 64 + (hr & 31)];
        }
        return r * nrm[k] * QSCALE;
      });
      rot += 20 * 4;
    }
    {
      const float* wup = p.in[I_WUP] + (size_t)l * 64 * 512; const float* aup = p.in[I_AUP] + (size_t)l * 64 * 512;
      const float* gup = p.in[I_GUP] + (size_t)l * 128 * 512;
      tconv(WT + WE_RW, 256, 1536, 256, rot, [=](int k, int n) {
        if (n < 512) return k < 64 ? wup[k * 512 + n] : 0.f;
        if (n < 1024) return (k >= 64 && k < 128) ? aup[(k - 64) * 512 + n - 512] : 0.f;
        return k >= 128 ? gup[(k - 128) * 512 + n - 1024] : 0.f;
      });
      rot += 24 * 4;
    }
    {
      const float* wuv = p.in[I_WUV] + (size_t)l * 8 * 128 * 64; const float* wo = p.in[I_WOUT] + (size_t)l * 1024 * 1024;
      tconv(WT + WE_OUT, 1536, 1024, 1536, rot, [=](int k, int n) {
        if (k < 1024) {
          int h = k >> 7, c = k & 127;
          const float* a = wuv + (size_t)(h * 128 + c) * 64; const float* b = wo + (size_t)(h * 64) * 1024 + n;
          float r = 0.f;
          for (int v = 0; v < 64; ++v) r += a[v] * b[(size_t)v * 1024];
          return r;
        }
        return wo[(size_t)(512 + k - 1024) * 1024 + n];
      });
      rot += 16 * 24;
    }
    {
      const float* nx = p.in[I_XN] + l * 1024; const float* nm = p.in[I_MKVN] + l * 1024;
      const float* wq = p.in[I_WMQ] + (size_t)l * 1048576; const float* wk = p.in[I_WMK] + (size_t)l * 1048576;
      const float* wv = p.in[I_WMV] + (size_t)l * 1048576; const float* wo = p.in[I_WMO] + (size_t)l * 1048576;
      tconv(WT + WE_MQ, 1024, 1024, 1024, rot, [=](int k, int n) { return nx[k] * wq[(size_t)k * 1024 + n] * XSCALE; });
      tconv(WT + WE_MK, 1024, 1024, 1024, rot, [=](int k, int n) { return nm[k] * wk[(size_t)k * 1024 + n]; });
      tconv(WT + WE_MV, 1024, 1024, 1024, rot, [=](int k, int n) { return nm[k] * wv[(size_t)k * 1024 + n]; });
      tconv(WT + WE_MO, 1024, 1024, 1024, rot, [=](int k, int n) { return wo[(size_t)k * 1024 + n]; });
    }
  }
}

__device__ __forceinline__ void phase_prep(KPR p, int l) {
  extern __shared__ __attribute__((aligned(16))) char smem[];
  u16* sv = (u16*)smem;
  const int tid = tidx(), wid = tid >> 6, lane = tid & 63;
  const u16* PROJ = (const u16*)(p.ws + W_PROJ);
  u16* CQB = (u16*)(p.ws + W_CQB); u16* A2 = (u16*)(p.ws + W_A2);
  float* RB = (float*)(p.ws + W_RB); float* KB = (float*)(p.ws + W_KB); float* VB = (float*)(p.ws + W_VB); float* KKB = (float*)(p.ws + W_KKB);
  u16* KP = (u16*)(p.ws + W_KP); u16* KS = (u16*)(p.ws + W_KS); u16* VTP = (u16*)(p.ws + W_VTP); u16* VTS = (u16*)(p.ws + W_VTS);
  const float2* RT = (const float2*)(p.ws + W_ROPE);
  const float* kvn = p.in[I_KVN] + l * 128; const float* mu = p.in[I_MU] + l * DSH; const float* kkw = p.in[I_KK] + l * 512;
  for (int chunk = blockIdx.x; chunk < T / 72; chunk += gridDim.x) {
  __syncthreads();
  uint2 n_cq; unsigned n_ckv; u16 n_k1 = 0, n_k2 = 0; uint4 n_pb0, n_pb1, n_pb2, n_pb3 = make_uint4(0, 0, 0, 0);
  uint4 q_pb0, q_pb1, q_pb2, q_pb3 = make_uint4(0, 0, 0, 0);
#define PREP_LOAD(ROW) do { const u16* pr_ = PROJ + (size_t)(ROW) * DINP; \
    n_cq = *(const uint2*)(pr_ + lane * 4); n_ckv = *(const unsigned*)(pr_ + 256 + lane * 2); \
    if (lane < 16) { n_k1 = pr_[384 + lane]; n_k2 = pr_[400 + lane]; } \
    n_pb0 = *(const uint4*)(pr_ + 416 + lane * 8); n_pb1 = *(const uint4*)(pr_ + 416 + 512 + lane * 8); \
    n_pb2 = *(const uint4*)(pr_ + 416 + 1024 + lane * 8); if (lane < 32) n_pb3 = *(const uint4*)(pr_ + 416 + 1536 + lane * 8); } while (0)
  {
    const int gfirst = chunk * 72 + wid * 9;
    if (gfirst > 0) { PREP_LOAD(gfirst - 1); q_pb0 = n_pb0; q_pb1 = n_pb1; q_pb2 = n_pb2; q_pb3 = n_pb3; }
    else { q_pb0 = q_pb1 = q_pb2 = make_uint4(0, 0, 0, 0); }
    PREP_LOAD(gfirst);
  }
  for (int ri = 0; ri < 9; ++ri) {
    const int rl = wid * 9 + ri, g = chunk * 72 + rl;
    const u16* pr = PROJ + (size_t)g * DINP;
    const uint2 c_cq = n_cq; const unsigned c_ckv = n_ckv; const u16 c_k1 = n_k1, c_k2 = n_k2;
    const uint4 c_pb0 = n_pb0, c_pb1 = n_pb1, c_pb2 = n_pb2, c_pb3 = n_pb3;
    { const int gn = g + 1 < T ? g + 1 : g; PREP_LOAD(gn); }
    const bool isP = g < TP;
    int b, t, pos, tlen;
    if (isP) { b = g >> 12; t = g & 4095; pos = t; tlen = 4096; } else { int gg = g - TP; b = gg >> 6; t = gg & 63; pos = 2048 + t; tlen = 64; }
    {
      uint2 w = c_cq;
      float v0 = bf2f(w.x & 0xffff), v1 = bf2f(w.x >> 16), v2 = bf2f(w.y & 0xffff), v3 = bf2f(w.y >> 16);
      float ss = wave_sum(v0 * v0 + v1 * v1 + v2 * v2 + v3 * v3);
      float rs = rsqrtf(ss * (1.f / 256.f) + 1e-6f);
      uint2 o; o.x = pack2(v0 * rs, v1 * rs); o.y = pack2(v2 * rs, v3 * rs);
      *(uint2*)(CQB + (size_t)g * 256 + lane * 4) = o;
    }
    {
      unsigned w = c_ckv;
      float v0 = bf2f(w & 0xffff), v1 = bf2f(w >> 16);
      float ss = wave_sum(v0 * v0 + v1 * v1);
      float rs = rsqrtf(ss * (1.f / 128.f) + 1e-6f);
      int c = lane * 2;
      v0 = v0 * rs * kvn[c]; v1 = v1 * rs * kvn[c + 1];
      float* of = isP ? p.out + OO_CKVP + ((size_t)(l * 4 + b) * 4096 + t) * 128 : p.out + OO_CKVS + ((size_t)(l * 32 + b) * 64 + t) * 128;
      *(float2*)(of + c) = make_float2(v0, v1);
      u16* kr = isP ? KP + ((size_t)b * 4096 + t) * 160 : KS + ((size_t)b * 2112 + 2048 + t) * 160;
      *(unsigned*)(kr + c) = pack2(v0, v1);
      *(unsigned*)(sv + rl * 128 + c) = pack2(v0, v1);
      if (lane < 16) {
        float x1 = bf2f(c_k1), x2 = bf2f(c_k2);
        float2 cs = RT[pos * 16 + lane];
        float o1 = x1 * cs.x - x2 * cs.y, o2 = x1 * cs.y + x2 * cs.x;
        float* okr = isP ? p.out + OO_KRP + ((size_t)(l * 4 + b) * 4096 + t) * 32 : p.out + OO_KRS + ((size_t)(l * 32 + b) * 64 + t) * 32;
        okr[lane] = o1; okr[lane + 16] = o2;
        kr[128 + lane] = f2bf(o1); kr[144 + lane] = f2bf(o2);
      }
    }
    {
      const u16* pb = pr + 416;
      const u16* pp = pr - DINP + 416;
      const float* sh0 = p.in[I_SSH] + (size_t)(l * 32 + b) * DSH;
      const bool last = (t == tlen - 1);
      float* osh = isP ? p.out + OO_SHP + (size_t)(l * 4 + b) * DSH : p.out + OO_SHS + (size_t)(l * 32 + b) * DSH;
#pragma unroll
      for (int it = 0; it < 4; ++it) {
        const int c = it * 64 + lane;
        if (c < 224) {
          const int e = c * 8;
          const uint4 w = it == 0 ? c_pb0 : (it == 1 ? c_pb1 : (it == 2 ? c_pb2 : c_pb3));
          float pv[8] = {bf2f(w.x & 0xffff), bf2f(w.x >> 16), bf2f(w.y & 0xffff), bf2f(w.y >> 16), bf2f(w.z & 0xffff), bf2f(w.z >> 16), bf2f(w.w & 0xffff), bf2f(w.w >> 16)};
          float pq[8];
          if (t > 0) {
            const uint4 q = it == 0 ? q_pb0 : (it == 1 ? q_pb1 : (it == 2 ? q_pb2 : q_pb3));
            pq[0] = bf2f(q.x & 0xffff); pq[1] = bf2f(q.x >> 16); pq[2] = bf2f(q.y & 0xffff); pq[3] = bf2f(q.y >> 16);
            pq[4] = bf2f(q.z & 0xffff); pq[5] = bf2f(q.z >> 16); pq[6] = bf2f(q.w & 0xffff); pq[7] = bf2f(q.w >> 16);
          } else if (!isP) {
            float4 q0 = *(const float4*)(sh0 + e), q1 = *(const float4*)(sh0 + e + 4);
            pq[0] = q0.x; pq[1] = q0.y; pq[2] = q0.z; pq[3] = q0.w; pq[4] = q1.x; pq[5] = q1.y; pq[6] = q1.z; pq[7] = q1.w;
          } else {
#pragma unroll
            for (int j = 0; j < 8; ++j) pq[j] = 0.f;
          }
          float4 m0 = *(const float4*)(mu + e), m1 = *(const float4*)(mu + e + 4);
          float mm[8] = {m0.x, m0.y, m0.z, m0.w, m1.x, m1.y, m1.z, m1.w};
          float xs[8];
#pragma unroll
          for (int j = 0; j < 8; ++j) xs[j] = pv[j] + mm[j] * (pq[j] - pv[j]);
          if (last) { *(float4*)(osh + e) = make_float4(pv[0], pv[1], pv[2], pv[3]); *(float4*)(osh + e + 4) = make_float4(pv[4], pv[5], pv[6], pv[7]); }
          if (it == 0) {
            *(uint4*)((u16*)RB + (size_t)g * 512 + e) = make_uint4(pack2(xs[0], xs[1]), pack2(xs[2], xs[3]), pack2(xs[4], xs[5]), pack2(xs[6], xs[7]));
          } else if (it == 1) {
            const int cc = e - 512;
            *(uint4*)((u16*)KB + (size_t)g * 512 + cc) = make_uint4(pack2(xs[0], xs[1]), pack2(xs[2], xs[3]), pack2(xs[4], xs[5]), pack2(xs[6], xs[7]));
            float4 k0 = *(const float4*)(kkw + cc), k1 = *(const float4*)(kkw + cc + 4);
            float kk[8] = {xs[0] * k0.x, xs[1] * k0.y, xs[2] * k0.z, xs[3] * k0.w, xs[4] * k1.x, xs[5] * k1.y, xs[6] * k1.z, xs[7] * k1.w};
            float ss = 0.f;
#pragma unroll
            for (int j = 0; j < 8; ++j) ss += kk[j] * kk[j];
            ss = dpp_sum8(ss);
            float rn = rsqrtf(ss + 1e-12f);
            *(uint4*)((u16*)KKB + (size_t)g * 512 + cc) = make_uint4(pack2(kk[0] * rn, kk[1] * rn), pack2(kk[2] * rn, kk[3] * rn), pack2(kk[4] * rn, kk[5] * rn), pack2(kk[6] * rn, kk[7] * rn));
          } else if (it == 2) {
            *(uint4*)((u16*)VB + (size_t)g * 512 + (e - 1024)) = make_uint4(pack2(xs[0], xs[1]), pack2(xs[2], xs[3]), pack2(xs[4], xs[5]), pack2(xs[6], xs[7]));
          } else {
            const int cc = e - 1536;
            float y[8];
#pragma unroll
            for (int j = 0; j < 8; ++j) y[j] = cc < 64 ? (1.f - 2.f / (1.f + __expf(2.f * xs[j]))) : (cc < 128 ? xs[j] : sigmoidf_(xs[j]));
            uint4 o; o.x = pack2(y[0], y[1]); o.y = pack2(y[2], y[3]); o.z = pack2(y[4], y[5]); o.w = pack2(y[6], y[7]);
            *(uint4*)(A2 + (size_t)g * 256 + cc) = o;
          }
        }
      }
    }
    q_pb0 = c_pb0; q_pb1 = c_pb1; q_pb2 = c_pb2; q_pb3 = c_pb3;
  }
#undef PREP_LOAD
  __syncthreads();
  for (int idx = tid; idx < 128 * 9; idx += NTHR) {
    const int d = idx & 127, rl0 = (idx >> 7) * 8, g = chunk * 72 + rl0;
    unsigned w[4];
#pragma unroll
    for (int j = 0; j < 4; ++j) w[j] = (unsigned)sv[(rl0 + 2 * j) * 128 + d] | ((unsigned)sv[(rl0 + 2 * j + 1) * 128 + d] << 16);
    u16* dst;
    if (g < TP) dst = VTP + ((size_t)(g >> 12) * 128 + d) * 4096 + (g & 4095);
    else { const int gg = g - TP; dst = VTS + ((size_t)(gg >> 6) * 128 + d) * 2112 + 2048 + (gg & 63); }
    *(uint4*)dst = make_uint4(w[0], w[1], w[2], w[3]);
  }
  }
}

__device__ __forceinline__ void conv_caches(KPR p, int l, int vb, int nvb) {
  const int tid = tidx();
  u16* KS = (u16*)(p.ws + W_KS); u16* VTS = (u16*)(p.ws + W_VTS);
  {
    const float* cckv = p.in[I_CCKV] + (size_t)l * 32 * 2048 * 128;
    const float* ckr = p.in[I_CKR] + (size_t)l * 32 * 2048 * 32;
    for (int idx = vb * NTHR + tid; idx < 32 * 2048 * 20; idx += nvb * NTHR) {
      int rowi = idx / 20, ch = idx % 20;
      int b = rowi >> 11, t = rowi & 2047;
      const float* s = ch < 16 ? cckv + (size_t)rowi * 128 + ch * 8 : ckr + (size_t)rowi * 32 + (ch - 16) * 8;
      float4 a = *(const float4*)s, c = *(const float4*)(s + 4);
      uint4 o; o.x = pack2(a.x, a.y); o.y = pack2(a.z, a.w); o.z = pack2(c.x, c.y); o.w = pack2(c.z, c.w);
      *(uint4*)(KS + ((size_t)b * 2112 + t) * 160 + ch * 8) = o;
    }
    tconv_v(VTS, 2112, 4096, 2048, vb, nvb, [=](int k, int n) { return cckv[((size_t)(n >> 7) * 2048 + k) * 128 + (n & 127)]; });
    const float* cmk = p.in[I_CMK] + (size_t)l * 32 * 256 * 1024;
    const float* cmv = p.in[I_CMV] + (size_t)l * 32 * 256 * 1024;
    u16* MKS = (u16*)(p.ws + W_MKS); u16* MVTS = (u16*)(p.ws + W_MVTS);
    for (int idx = vb * NTHR + tid; idx < 32 * 4 * 256 * 32; idx += nvb * NTHR) {
      int d8 = idx & 31, m = (idx >> 5) & 255, h = (idx >> 13) & 3, b = idx >> 15;
      const float* s = cmk + ((size_t)(b * 256 + m) * 4 + h) * 256 + d8 * 8;
      float4 a = *(const float4*)s, c = *(const float4*)(s + 4);
      uint4 o; o.x = pack2(a.x, a.y); o.y = pack2(a.z, a.w); o.z = pack2(c.x, c.y); o.w = pack2(c.z, c.w);
      *(uint4*)(MKS + (size_t)idx * 8) = o;
    }
    tconv_v(MVTS, 256, 32768, 256, vb, nvb, [=](int k, int n) { return cmv[((size_t)((n >> 10) * 256 + k) * 4 + ((n >> 8) & 3)) * 256 + (n & 255)]; });
  }
}

__device__ __forceinline__ void mla_sub(KPR p, int b, int c, int half) {
  const u16* QB = (const u16*)(p.ws + W_QB); u16* AO = (u16*)(p.ws + W_AO);
  size_t tok = (size_t)b * 4096 + c * 64 + half * 32;
  attn_item<160, 128, 8>(QB + tok * 1280, 160, 256, (const u16*)(p.ws + W_KP) + (size_t)b * 4096 * 160, 160,
                         (const u16*)(p.ws + W_VTP) + (size_t)b * 128 * 4096, 4096, (c + 1) * 64, AO + tok * 1536, 1536);
}
__device__ __forceinline__ void phase_mix(KPR p, int l, int mode = 0) {
  extern __shared__ __attribute__((aligned(16))) char smem[];
  int* sItem = (int*)(smem + SMEM_ITEM);
  int* cnt = (int*)(p.ws + W_CNT) + l + mode * 8;
  for (;;) {
    __syncthreads();
    if (threadIdx.x == 0) *sItem = atomicAdd(cnt, 1);
    __syncthreads();
    int it = *sItem;
    if (it >= 864) break;
    if (mode == 2 && (it < 32 || it >= 608)) continue;
    if (it < 32) {
      int b = it >> 3, h = it & 7;
      cseq_item(p, b * 4096, h, 64, (b * 8 + h) * 64, nullptr, p.out + OO_WKVP + ((size_t)(l * 4 + b) * 8 + h) * 4096);
    } else if (it < 608) {
      int k = it - 32;
      if (k >= 248 && k < 312) {
        int j = k - 248; int b = j >> 1, half = j & 1;
        const u16* QB = (const u16*)(p.ws + W_QB); u16* AO = (u16*)(p.ws + W_AO);
        size_t tok = (size_t)TP + b * 64 + half * 32;
        attn_item<160, 128, 8>(QB + tok * 1280, 160, 256, (const u16*)(p.ws + W_KS) + (size_t)b * 2112 * 160, 160,
                               (const u16*)(p.ws + W_VTS) + (size_t)b * 128 * 2112, 2112, 2112, AO + tok * 1536, 1536);
      } else {
        if (k >= 312) k -= 64;
        int c = 63 - (k >> 3), b = (k >> 1) & 3, half = k & 1;
        mla_sub(p, b, c, half);
      }
    } else {
      int k = it - 608; int b = k >> 3, h = k & 7;
      cseq_item(p, TP + b * 64, h, 1, 2048 + k, p.in[I_SWKV] + ((size_t)(l * 32 + b) * 8 + h) * 4096,
                p.out + OO_WKVS + ((size_t)(l * 32 + b) * 8 + h) * 4096);
    }
  }
}

__device__ __forceinline__ void xattn_item(KPR p, int l, int it) {
  const u16* QX = (const u16*)(p.ws + W_QX); u16* XO = (u16*)(p.ws + W_XO);
  if (it < 256) {
    int b = it >> 6, h = (it >> 4) & 3, qt = it & 15;
    size_t tok = (size_t)b * 4096 + qt * 256;
    for (int hv = 0; hv < 2; ++hv)
      attn_item<256, 128, 1>(QX + tok * 1024 + h * 256, 1024, 256, (const u16*)(p.ws + W_MKP) + (size_t)((l * 4 + b) * 4 + h) * 65536, 256,
                             (const u16*)(p.ws + W_MVTP) + (size_t)((l * 4 + b) * 4 + h) * 65536 + hv * 128 * 256, 256, 256, XO + tok * 1024 + h * 256 + hv * 128, 1024);
  } else {
    int k = it - 256; int b = k >> 2, h = k & 3;
    size_t tok = (size_t)TP + b * 64;
    for (int hv = 0; hv < 2; ++hv)
      attn_item<256, 128, 1>(QX + tok * 1024 + h * 256, 1024, 64, (const u16*)(p.ws + W_MKS) + (size_t)(b * 4 + h) * 65536, 256,
                             (const u16*)(p.ws + W_MVTS) + (size_t)(b * 4 + h) * 65536 + hv * 128 * 256, 256, 256, XO + tok * 1024 + h * 256 + hv * 128, 1024);
  }
}

constexpr int CH_NST = 10;
__device__ __forceinline__ void phase_chain(KPR p, int ci, int dup = 0) {
  extern __shared__ __attribute__((aligned(16))) char smem[];
  int* sItem = (int*)(smem + SMEM_ITEM);
  int* CT = (int*)(p.ws + W_CNT) + dup * 8192;
  const float rc = dup ? 0.f : 1.f;
  int* q = CT + 3800 + ci; int* xa = CT + 72 + ci; int* oa = CT + 80 + ci;
  int* cnt = CT + 128 + ci * CH_NST * 72;
  int* stamp = CT + 4096 + ci * CH_NST * 72;
  int* G = CT + 8000 + ci; int* xast = CT + 8010 + ci; int* oast = CT + 8020 + ci;
  int lastG = 0;
  const bool hasTail = ci >= 1, hasHead = ci < NL;
  const int lt = ci - 1, lh = ci;
  const int e0 = hasTail ? 288 : 0, e1 = e0 + (hasTail ? 288 : 0), e2 = e1 + (hasTail ? 384 : 0), e3 = e2 + (hasTail ? 288 : 0),
            e4 = e3 + (hasTail ? 792 : 0), e5 = e4 + (hasTail ? 288 : 0), e6 = e5 + (hasHead ? 792 : 0), e7 = e6 + (hasHead ? 288 : 0),
            e8 = e7 + (hasHead ? 224 : 0), e9 = e8 + (hasHead ? 648 : 0);
  float* X = (float*)(p.ws + W_X); u16* XB = (u16*)(p.ws + W_XB); float* SSQ = (float*)(p.ws + W_SSQ); u16* ACT = (u16*)(p.ws + W_ACT);
  const int grp = blockIdx.x & 7;
  int nxt = 0;
  if (tidx() == 0) nxt = atomicAdd(q + grp * 8, 1) * 8 + grp;
  for (;;) {
    const int tid = tidx();
    if (tid == 0) {
      const int it = nxt;
      if (it < e9) {
        int st, idx;
        if (it < e0) { st = 0; idx = it; } else if (it < e1) { st = 1; idx = it - e0; } else if (it < e2) { st = 2; idx = it - e1; }
        else if (it < e3) { st = 3; idx = it - e2; } else if (it < e4) { st = 4; idx = it - e3; } else if (it < e5) { st = 5; idx = it - e4; }
        else if (it < e6) { st = 6; idx = it - e5; } else if (it < e7) { st = 7; idx = it - e6; } else if (it < e8) { st = 8; idx = it - e7; }
        else { st = 9; idx = it - e8; }
        int pm = 0, pn = 0;
        if (st == 2) pm = idx < 256 ? ((idx >> 6) * 16 + (idx & 15)) : (64 + ((idx - 256) >> 4));
        else if (st != 8) tile_map(idx, 72, (st == 4 || st == 6) ? 11 : (st == 9 ? 9 : 4), pm, pn);
        const int* c1 = nullptr; const int* c2 = nullptr;
        switch (st) {
          case 1: c1 = stamp + 0 * 72 + pm; break;
          case 2: c1 = stamp + 1 * 72 + pm; break;
          case 3: c1 = stamp + 2 * 72 + pm; break;
          case 4: c1 = stamp + 3 * 72 + pm; c2 = xast; break;
          case 5: c1 = stamp + 4 * 72 + pm; break;
          case 6: if (hasTail) c1 = stamp + 5 * 72 + pm; break;
          case 7: c1 = stamp + 6 * 72 + pm; break;
          case 8: if (hasTail) c1 = xast; break;
          case 9: c1 = stamp + 7 * 72 + pm; if (hasTail) c2 = oast; break;
          default: break;
        }
        if (dup) { c1 = nullptr; c2 = nullptr; }
        int s1 = 0, s2 = 0;
        if (c1) while ((s1 = __hip_atomic_load(c1, __ATOMIC_RELAXED, __HIP_MEMORY_SCOPE_AGENT)) == 0) __builtin_amdgcn_s_sleep(4);
        if (c2) while ((s2 = __hip_atomic_load(c2, __ATOMIC_RELAXED, __HIP_MEMORY_SCOPE_AGENT)) == 0) __builtin_amdgcn_s_sleep(4);
        if ((s1 > s2 ? s1 : s2) >= lastG) {
          const int g = __hip_atomic_load(G, __ATOMIC_RELAXED, __HIP_MEMORY_SCOPE_AGENT);
          __builtin_amdgcn_fence(__ATOMIC_ACQUIRE, "agent");
          asm volatile("s_waitcnt vmcnt(0)" ::: "memory");
          lastG = g;
        }
        sItem[1] = st; sItem[2] = idx; sItem[3] = pm; sItem[4] = pn;
      }
      sItem[0] = it;
    }
    __syncthreads();
    if (sItem[0] >= e9) break;
    const int st = sItem[1], idx = sItem[2], pm = sItem[3], pn = sItem[4];
    if (tid == 0) nxt = atomicAdd(q + grp * 8, 1) * 8 + grp;
    if (dup && !((PROBE_MASK >> st) & 1)) { __syncthreads(); continue; }
    const u16* WTt = (const u16*)(p.ws + W_WT) + (size_t)(lt < 0 ? 0 : lt) * WE_LAYER;
    const u16* WTh = (const u16*)(p.ws + W_WT) + (size_t)(lh >= NL ? 0 : lh) * WE_LAYER;
    switch (st) {
      case 0: gemm_tile((const u16*)(p.ws + W_AO), WTt + WE_OUT, 1536, pm, pn, EpiRes{X, XB, SSQ, rc}); break;
      case 1: gemm_tile(XB, WTt + WE_MQ, 1024, pm, pn, EpiScaleBf{SSQ, (u16*)(p.ws + W_QX), 1024}); break;
      case 2: xattn_item(p, lt, idx); break;
      case 3: gemm_tile((const u16*)(p.ws + W_XO), WTt + WE_MO, 1024, pm, pn, EpiRes{X, XB, SSQ, rc}); break;
      case 4: gemm_tile(XB, WTt + WE_GU2, 1024, pm, 2 * pn, EpiGU{SSQ, ACT}); gemm_tile(XB, WTt + WE_GU2, 1024, pm, 2 * pn + 1, EpiGU{SSQ, ACT}); break;
      case 5: gemm_tile(ACT, WTt + WE_D2, DFF, pm, pn, EpiRes{X, XB, SSQ, 0.5f * rc}); break;
      case 6: gemm_tile(XB, WTh + WE_GU1, 1024, pm, 2 * pn, EpiGU{SSQ, ACT}); gemm_tile(XB, WTh + WE_GU1, 1024, pm, 2 * pn + 1, EpiGU{SSQ, ACT}); break;
      case 7: gemm_tile(ACT, WTh + WE_D1, DFF, pm, pn, EpiRes{X, XB, SSQ, 0.5f * rc}); break;
      case 8: conv_caches(p, lh, idx, 224); break;
      default: gemm_tile(XB, WTh + WE_IN, 1024, pm, pn, EpiScaleBf{SSQ, (u16*)(p.ws + W_PROJ), DINP}); break;
    }
    asm volatile("s_waitcnt vmcnt(0)" ::: "memory");
    __syncthreads();
    if (tidx() == 64) {
      __builtin_amdgcn_fence(__ATOMIC_RELEASE, "agent");
      asm volatile("s_waitcnt vmcnt(0)" ::: "memory");
      atomicAdd(G, 1);
      const int full = (st == 4 || st == 6) ? 11 : (st == 9 ? 9 : (st == 2 ? (pm < 64 ? 4 : 16) : 4));
      if (atomicAdd(cnt + st * 72 + pm, 1) + 1 == full)
        __hip_atomic_store(stamp + st * 72 + pm, __hip_atomic_load(G, __ATOMIC_RELAXED, __HIP_MEMORY_SCOPE_AGENT), __ATOMIC_RELAXED, __HIP_MEMORY_SCOPE_AGENT);
      if (st == 2 && atomicAdd(xa, 1) + 1 == 384)
        __hip_atomic_store(xast, __hip_atomic_load(G, __ATOMIC_RELAXED, __HIP_MEMORY_SCOPE_AGENT), __ATOMIC_RELAXED, __HIP_MEMORY_SCOPE_AGENT);
      if (st == 0 && atomicAdd(oa, 1) + 1 == 288)
        __hip_atomic_store(oast, __hip_atomic_load(G, __ATOMIC_RELAXED, __HIP_MEMORY_SCOPE_AGENT), __ATOMIC_RELAXED, __HIP_MEMORY_SCOPE_AGENT);
    }
  }
}

__device__ __forceinline__ void phase_final(KPR p) {
  const int tid = tidx(), wid = tid >> 6, lane = tid & 63;
  const float* X = (const float*)(p.ws + W_X); const float* fn = p.in[I_FN];
  for (int g = blockIdx.x * 8 + wid; g < T; g += gridDim.x * 8) {
    float4 v[4]; float ss = 0.f;
#pragma unroll
    for (int i = 0; i < 4; ++i) { v[i] = *(const float4*)(X + (size_t)g * 1024 + i * 256 + lane * 4); ss += v[i].x * v[i].x + v[i].y * v[i].y + v[i].z * v[i].z + v[i].w * v[i].w; }
    ss = wave_sum(ss);
    float rs = rsqrtf(ss * (1.f / 1024.f) + 1e-6f);
#pragma unroll
    for (int i = 0; i < 4; ++i) {
      float4 gn = *(const float4*)(fn + i * 256 + lane * 4);
      *(float4*)(p.out + OO_Y + (size_t)g * 1024 + i * 256 + lane * 4) = make_float4(v[i].x * rs * gn.x, v[i].y * rs * gn.y, v[i].z * rs * gn.z, v[i].w * rs * gn.w);
    }
  }
}

constexpr int NPL = 6;
constexpr int N_PHASES = 3 + NPL * NL + 1;

__device__ __forceinline__ void run_phase(KPR p, int ph) {
  if (ph == 0) { phase_init(p); return; }
  if (ph == 1) {
    for (int l = 0; l < NL; ++l) {
      const u16* WT = (const u16*)(p.ws + W_WT) + (size_t)l * WE_LAYER;
      gemm_phase((const u16*)(p.ws + W_MB), WT + WE_MK, 1024, 4, 4, (2 * l) * 16,
                 EpiMem<false>{p.out + OO_MKP + (size_t)l * 1048576, (u16*)(p.ws + W_MKP) + (size_t)l * 16 * 65536});
      gemm_phase((const u16*)(p.ws + W_MB), WT + WE_MV, 1024, 4, 4, (2 * l + 1) * 16,
                 EpiMem<true>{p.out + OO_MVP + (size_t)l * 1048576, (u16*)(p.ws + W_MVTP) + (size_t)l * 16 * 65536});
    }
    return;
  }
  if (ph == 2) { phase_chain(p, 0); if (PROBE_REP & 1) { cg::this_grid().sync(); phase_chain(p, 0, 1); } return; }
  if (ph == N_PHASES - 1) { if (PROBE_REP & 64) for (int i = 0; i < 40; ++i) cg::this_grid().sync(); phase_final(p); return; }
  const int l = (ph - 3) / NPL, s = (ph - 3) % NPL;
  const u16* WT = (const u16*)(p.ws + W_WT) + (size_t)l * WE_LAYER;
  switch (s) {
    case 0: phase_prep(p, l); if (PROBE_REP & 2) { cg::this_grid().sync(); phase_prep(p, l); } break;
    case 1:
      gemm_phase((const u16*)(p.ws + W_CQB), WT + WE_Q, 256, 72, 5, 0, EpiQ{(u16*)(p.ws + W_QB), (const float2*)(p.ws + W_ROPE)});
      gemm_phase((const u16*)(p.ws + W_A2), WT + WE_RW, 256, 72, 6, 360,
                 EpiRW{p.in[I_W0] + l * 512, p.in[I_A0] + l * 512, p.in[I_KA] + l * 512, p.ws});
      break;
    case 2: phase_cprep(p); if (PROBE_REP & 8) { cg::this_grid().sync(); phase_cprep(p); } break;
    case 3: phase_mix(p, l, 0); if (PROBE_REP & 16) { cg::this_grid().sync(); phase_mix(p, l, 2); } break;
    case 4: phase_yfin(p, l); if (PROBE_REP & 32) { cg::this_grid().sync(); phase_yfin(p, l); } break;
    default: phase_chain(p, l + 1); if (PROBE_REP & 1) { cg::this_grid().sync(); phase_chain(p, l + 1, 1); } break;
  }
}

__device__ __forceinline__ void grid_barrier(int* CT, int gen) {
  asm volatile("s_waitcnt vmcnt(0)" ::: "memory");
  __syncthreads();
  if (tidx() == 0) {
    __builtin_amdgcn_fence(__ATOMIC_RELEASE, "agent");
    asm volatile("s_waitcnt vmcnt(0)" ::: "memory");
    int* grpc = CT + 15000 + (blockIdx.x & 7) * 32;
    int* glob = CT + 15000 + 8 * 32;
    const int per = gridDim.x >> 3;
    if (atomicAdd(grpc, 1) + 1 == per * (gen + 1)) atomicAdd(glob, 1);
    while (__hip_atomic_load(glob, __ATOMIC_RELAXED, __HIP_MEMORY_SCOPE_AGENT) < 8 * (gen + 1)) __builtin_amdgcn_s_sleep(1);
    __builtin_amdgcn_fence(__ATOMIC_ACQUIRE, "agent");
    asm volatile("s_waitcnt vmcnt(0)" ::: "memory");
  }
  __syncthreads();
}

__global__ void __launch_bounds__(NTHR) mega(Params p) {
  cg::grid_group grid = cg::this_grid();
  for (int ph = p.ph_lo; ph < p.ph_hi; ++ph) {
    const __attribute__((address_space(4))) Params* q = (const __attribute__((address_space(4))) Params*)__builtin_amdgcn_kernarg_segment_ptr();
    asm volatile("" : "+s"(q));
    run_phase(*q, ph);
    if (ph + 1 < p.ph_hi) {
      if (ph == p.ph_lo) grid.sync();
      else grid_barrier((int*)(q->ws + W_CNT), ph - p.ph_lo - 1);
    }
  }
}

extern "C" void kernel_launch(void* const* d_in, const int* in_sizes, int n_in, void* d_out, int out_size, void* d_ws,
                              size_t ws_size, hipStream_t stream) {
  static int grid = 0;
  if (grid == 0) {
    if (n_in != N_IN || (size_t)out_size != OO_END || ws_size < W_END) {
      fprintf(stderr, "kernel_launch: unexpected shapes n_in=%d out=%d ws=%zu (need %zu)\n", n_in, out_size, ws_size, (size_t)W_END);
      grid = -1; return;
    }
    int dev = 0, cus = 0, per_cu = 0;
    hipGetDevice(&dev);
    hipDeviceGetAttribute(&cus, hipDeviceAttributeMultiprocessorCount, dev);
    hipFuncSetAttribute((const void*)mega, hipFuncAttributeMaxDynamicSharedMemorySize, SMEM_BYTES);
    hipOccupancyMaxActiveBlocksPerMultiprocessor(&per_cu, (const void*)mega, NTHR, SMEM_BYTES);
    if (per_cu < 1) { fprintf(stderr, "kernel_launch: occupancy query says %d blocks/CU\n", per_cu); per_cu = 1; }
    (void)hipGetLastError();
    grid = cus;
  }
  if (grid < 0) return;
  if (hipMemsetAsync((char*)d_ws + W_CNT, 0, 65536, stream) != hipSuccess) { fprintf(stderr, "kernel_launch: memset of control words failed\n"); return; }
  Params p{};
  for (int i = 0; i < N_IN; ++i) p.in[i] = (const float*)d_in[i];
  p.out = (float*)d_out; p.ws = (char*)d_ws;
#if N_LAUNCH_PER_PHASE
  for (int ph = 0; ph < N_PHASES; ++ph) {
    p.ph_lo = ph; p.ph_hi = ph + 1;
    void* args[] = {&p};
    hipError_t e = hipLaunchCooperativeKernel((const void*)mega, dim3(grid), dim3(NTHR), args, SMEM_BYTES, stream);
    if (e != hipSuccess) { fprintf(stderr, "launch failed: %s\n", hipGetErrorString(e)); break; }
  }
#else
  p.ph_lo = 0; p.ph_hi = N_PHASES;
  void* args[] = {&p};
  hipError_t e = hipLaunchCooperativeKernel((const void*)mega, dim3(grid), dim3(NTHR), args, SMEM_BYTES, stream);
  if (e != hipSuccess) fprintf(stderr, "cooperative launch failed: %s (grid %d)\n", hipGetErrorString(e), grid);
#endif
}
```

```cpp
#include <hip/hip_runtime.h>
#include <hip/hip_cooperative_groups.h>
#include <stdint.h>
#include <stdio.h>
namespace cg = cooperative_groups;

typedef unsigned short u16;
using bf16x8 = __attribute__((ext_vector_type(8))) short;
using f32x4 = __attribute__((ext_vector_type(4))) float;
using f32x16 = __attribute__((ext_vector_type(16))) float;

#ifndef REP_WHICH
#define REP_WHICH 0
#endif
#ifndef PROBE_REP
#define PROBE_REP 0
#endif
#ifndef PROBE_MASK
#define PROBE_MASK 0x3ff
#endif
#ifndef N_LAUNCH_PER_PHASE
#define N_LAUNCH_PER_PHASE 0
#endif

constexpr int TP = 16384, TS = 2048, T = TP + TS, NL = 4;
constexpr int DFF = 2816, DIN = 2208, DINP = 2304, DSH = 1792;
constexpr int NTHR = 512;
constexpr int SMEM_BYTES = 139264 + 2048;
constexpr int SMEM_ITEM = 139264 + 1024;
constexpr float QSCALE = 0.10206207261596577f * 1.4426950408889634f;
constexpr float XSCALE = 0.0625f * 1.4426950408889634f;

constexpr size_t OO_Y = 0;
constexpr size_t OO_CKVP = OO_Y + (size_t)T * 1024;
constexpr size_t OO_KRP = OO_CKVP + (size_t)NL * 4 * 4096 * 128;
constexpr size_t OO_MKP = OO_KRP + (size_t)NL * 4 * 4096 * 32;
constexpr size_t OO_MVP = OO_MKP + (size_t)NL * 4 * 256 * 1024;
constexpr size_t OO_WKVP = OO_MVP + (size_t)NL * 4 * 256 * 1024;
constexpr size_t OO_SHP = OO_WKVP + (size_t)NL * 4 * 8 * 4096;
constexpr size_t OO_CKVS = OO_SHP + (size_t)NL * 4 * DSH;
constexpr size_t OO_KRS = OO_CKVS + (size_t)NL * 32 * 64 * 128;
constexpr size_t OO_WKVS = OO_KRS + (size_t)NL * 32 * 64 * 32;
constexpr size_t OO_SHS = OO_WKVS + (size_t)NL * 32 * 8 * 4096;
constexpr size_t OO_END = OO_SHS + (size_t)NL * 32 * DSH;

constexpr size_t al256(size_t x) { return (x + 255) & ~(size_t)255; }
constexpr size_t W_X = 0;
constexpr size_t W_XB = W_X + al256((size_t)T * 1024 * 4);
constexpr size_t W_SSQ = W_XB + al256((size_t)T * 1024 * 2);
constexpr size_t W_ACT = W_SSQ + al256((size_t)T * 4 * 4);
constexpr size_t W_WB = W_ACT;
constexpr size_t W_BB = W_WB + al256((size_t)T * 512 * 4);
constexpr size_t W_GB = W_BB + al256((size_t)T * 512 * 4);
constexpr size_t W_QX = W_ACT;
constexpr size_t W_PROJ = W_ACT + al256((size_t)T * DFF * 2);
constexpr size_t W_AO = W_PROJ;
constexpr size_t W_CQB = W_PROJ + al256((size_t)T * DINP * 2);
constexpr size_t W_A2 = W_CQB + al256((size_t)T * 256 * 2);
constexpr size_t W_QB = W_A2 + al256((size_t)T * 256 * 2);
constexpr size_t W_XO = W_QB;
constexpr size_t W_RB = W_QB + al256((size_t)T * 1280 * 2);
constexpr size_t W_KB = W_RB + al256((size_t)T * 512 * 4);
constexpr size_t W_VB = W_KB + al256((size_t)T * 512 * 4);
constexpr size_t W_KKB = W_VB + al256((size_t)T * 512 * 4);
constexpr size_t W_KP = W_KKB + al256((size_t)T * 512 * 4);
constexpr size_t W_KS = W_KP + al256((size_t)4 * 4096 * 160 * 2);
constexpr size_t W_VTP = W_KS + al256((size_t)32 * 2112 * 160 * 2);
constexpr size_t W_VTS = W_VTP + al256((size_t)4 * 128 * 4096 * 2);
constexpr size_t W_MKP = W_VTS + al256((size_t)32 * 128 * 2112 * 2);
constexpr size_t W_MVTP = W_MKP + al256((size_t)NL * 16 * 65536 * 2);
constexpr size_t W_MKS = W_MVTP + al256((size_t)NL * 16 * 65536 * 2);
constexpr size_t W_MVTS = W_MKS + al256((size_t)128 * 65536 * 2);
constexpr size_t W_MB = W_MVTS + al256((size_t)128 * 65536 * 2);
constexpr size_t W_ROPE = W_MB + al256((size_t)1024 * 1024 * 2);
constexpr size_t W_CNT = W_ROPE + al256((size_t)4096 * 16 * 8);
constexpr size_t W_YB = W_CNT + 65536;
constexpr size_t W_CQ = W_YB + al256((size_t)T * 512 * 4);
constexpr size_t W_WT = W_CQ + al256((size_t)2304 * 4096 * 4);
constexpr size_t W_CRR = W_PROJ + al256((size_t)T * 1536 * 2);
constexpr size_t W_CPT = W_CQB;
static_assert(W_CRR + (size_t)2304 * 4096 * 2 <= W_CQB, "RRt must fit behind AO");
static_assert((size_t)2304 * 4096 * 2 <= 2 * al256((size_t)T * 256 * 2), "Pt must fit in CQB+A2");
constexpr size_t WE_GU1 = 0;
constexpr size_t WE_D1 = WE_GU1 + (size_t)5632 * 1024;
constexpr size_t WE_IN = WE_D1 + (size_t)1024 * DFF;
constexpr size_t WE_Q = WE_IN + (size_t)DINP * 1024;
constexpr size_t WE_RW = WE_Q + (size_t)1280 * 256;
constexpr size_t WE_OUT = WE_RW + (size_t)1536 * 256;
constexpr size_t WE_MQ = WE_OUT + (size_t)1024 * 1536;
constexpr size_t WE_MK = WE_MQ + (size_t)1024 * 1024;
constexpr size_t WE_MV = WE_MK + (size_t)1024 * 1024;
constexpr size_t WE_MO = WE_MV + (size_t)1024 * 1024;
constexpr size_t WE_GU2 = WE_MO + (size_t)1024 * 1024;
constexpr size_t WE_D2 = WE_GU2 + (size_t)5632 * 1024;
constexpr size_t WE_LAYER = WE_D2 + (size_t)1024 * DFF;
constexpr size_t W_END = W_WT + al256(WE_LAYER * NL * 2);

enum { I_XP = 0, I_XS, I_MEMP, I_CCKV, I_CKR, I_CMK, I_CMV, I_SWKV, I_SSH, I_F1N, I_F1G, I_F1U, I_F1D, I_MIXN, I_WIN,
       I_QN, I_WUQ, I_KVN, I_WUK, I_WUV, I_MU, I_W0, I_WUP, I_A0, I_AUP, I_GUP, I_KK, I_KA, I_RK, I_GNG, I_GNB, I_WOUT,
       I_XN, I_MKVN, I_WMQ, I_WMK, I_WMV, I_WMO, I_F2N, I_F2G, I_F2U, I_F2D, I_FN, N_IN };

struct Params {
  const float* in[N_IN];
  float* out;
  char* ws;
  int ph_lo, ph_hi;
};

typedef const __attribute__((address_space(4))) Params& KPR;

typedef __bf16 bf2_t __attribute__((ext_vector_type(2)));
typedef float f2_t __attribute__((ext_vector_type(2)));
__device__ __forceinline__ u16 f2bf(float f) { __bf16 b = (__bf16)f; return __builtin_bit_cast(u16, b); }
__device__ __forceinline__ float bf2f(u16 h) { return __uint_as_float(((unsigned)h) << 16); }
__device__ __forceinline__ unsigned pack2(float a, float b) { f2_t v = {a, b}; bf2_t r = __builtin_convertvector(v, bf2_t); return __builtin_bit_cast(unsigned, r); }
__device__ __forceinline__ float4 bf4(uint2 w) {
  return make_float4(__uint_as_float(w.x << 16), __uint_as_float(w.x & 0xffff0000u), __uint_as_float(w.y << 16), __uint_as_float(w.y & 0xffff0000u));
}
__device__ __forceinline__ float wave_sum(float x) {
  x += __int_as_float(__builtin_amdgcn_update_dpp(0, __float_as_int(x), 0xB1, 0xF, 0xF, false));
  x += __int_as_float(__builtin_amdgcn_update_dpp(0, __float_as_int(x), 0x4E, 0xF, 0xF, false));
  x += __int_as_float(__builtin_amdgcn_update_dpp(0, __float_as_int(x), 0x141, 0xF, 0xF, false));
  x += __int_as_float(__builtin_amdgcn_update_dpp(0, __float_as_int(x), 0x140, 0xF, 0xF, false));
  const float s0 = __int_as_float(__builtin_amdgcn_readlane(__float_as_int(x), 0)), s1 = __int_as_float(__builtin_amdgcn_readlane(__float_as_int(x), 16));
  const float s2 = __int_as_float(__builtin_amdgcn_readlane(__float_as_int(x), 32)), s3 = __int_as_float(__builtin_amdgcn_readlane(__float_as_int(x), 48));
  return (s0 + s1) + (s2 + s3);
}
__device__ __forceinline__ float dpp_sum8(float x) {
  x += __int_as_float(__builtin_amdgcn_update_dpp(0, __float_as_int(x), 0xB1, 0xF, 0xF, false));
  x += __int_as_float(__builtin_amdgcn_update_dpp(0, __float_as_int(x), 0x4E, 0xF, 0xF, false));
  x += __int_as_float(__builtin_amdgcn_update_dpp(0, __float_as_int(x), 0x141, 0xF, 0xF, false));
  return x;
}
__device__ __forceinline__ int tidx() { int t = threadIdx.x; asm volatile("" : "+v"(t)); return t; }
__device__ __forceinline__ float fma_s(float a, float b, float c) { float d; asm("v_fma_f32 %0, %1, %2, %3" : "=v"(d) : "v"(a), "v"(b), "v"(c)); return d; }
__device__ __forceinline__ float sub_s(float a, float b) { float d; asm("v_sub_f32 %0, %1, %2" : "=v"(d) : "v"(a), "v"(b)); return d; }
__device__ __forceinline__ float add_s(float a, float b) { float d; asm("v_add_f32 %0, %1, %2" : "=v"(d) : "v"(a), "v"(b)); return d; }
__device__ __forceinline__ float mul_s(float a, float b) { float d; asm("v_mul_f32 %0, %1, %2" : "=v"(d) : "v"(a), "v"(b)); return d; }
__device__ __forceinline__ float sigmoidf_(float x) { return 1.f / (1.f + __expf(-x)); }

constexpr int BM = 256, BK = 64, HALF = 128, HT = HALF * BK;

__device__ __forceinline__ int lds_byte(int r, int c) {
  int st = (r >> 4) * 2 + (c >> 5), rr = r & 15, cc = c & 31, ob = rr * 64 + cc * 2;
  return st * 1024 + (ob ^ (((ob >> 9) & 1) << 5));
}
__device__ __forceinline__ void stage_rc(int b, int& R, int& C) {
  int st = b / 1024, sb = b % 1024, swz = sb ^ (((sb >> 9) & 1) << 5);
  R = (st >> 1) * 16 + swz / 64; C = (st & 1) * 32 + (swz % 64) / 2;
}

__device__ __forceinline__ void tile_map(int tile, int nM, int nN, int& pm, int& pn) {
  const int ntiles = nM * nN;
  int wgid = tile;
  { int q = ntiles / 8, r = ntiles % 8, xcd = wgid % 8, off = wgid / 8;
    wgid = (xcd < r ? xcd * (q + 1) : r * (q + 1) + (xcd - r) * q) + off; }
  int nig = 8 * nN, gid = wgid / nig, fm = gid * 8, gsz = min(nM - fm, 8);
  pm = fm + ((wgid % nig) % gsz); pn = (wgid % nig) / gsz;
}

template <class Epi>
__device__ __forceinline__ void gemm_tile(const u16* __restrict__ A, const u16* __restrict__ Bt, const int K,
                                          const int pm, const int pn, Epi epi) {
  extern __shared__ __attribute__((aligned(16))) char smem[];
  u16* shm = (u16*)smem;
#define SA(b, h) (shm + ((b) * 2 + (h)) * HT)
#define SB(b, h) (shm + (4 + (b) * 2 + (h)) * HT)
#define STAGE(P, BASE, br, kt) do { const u16* _gb = BASE + ((long)(br) * K + (long)(kt) * BK); \
    __builtin_amdgcn_global_load_lds((const unsigned*)((const char*)_gb + so0), \
        (__attribute__((address_space(3))) unsigned*)((char*)(P) + wu16), 16, 0, 0); \
    __builtin_amdgcn_global_load_lds((const unsigned*)((const char*)_gb + so1), \
        (__attribute__((address_space(3))) unsigned*)((char*)(P) + wu16 + 8192), 16, 0, 0); } while (0)
#define LDA(dst, b, h) for (int m = 0; m < 4; ++m) for (int k = 0; k < 2; ++k) \
    dst[m][k] = *reinterpret_cast<const bf16x8*>((char*)SA(b, h) + lds_byte(wr * 64 + m * 16 + fr, k * 32 + fq * 8))
#define LDB(dst, b, h) for (int n = 0; n < 2; ++n) for (int k = 0; k < 2; ++k) \
    dst[n][k] = *reinterpret_cast<const bf16x8*>((char*)SB(b, h) + lds_byte(wc * 32 + n * 16 + fr, k * 32 + fq * 8))
#define MMA(ai, bj, At_, Bt_) do { __builtin_amdgcn_s_setprio(1); \
    for (int m = 0; m < 4; ++m) for (int n = 0; n < 2; ++n) for (int k = 0; k < 2; ++k) \
      acc[ai][bj][m][n] = __builtin_amdgcn_mfma_f32_16x16x32_bf16(At_[m][k], Bt_[n][k], acc[ai][bj][m][n], 0, 0, 0); \
    __builtin_amdgcn_s_setprio(0); } while (0)
#define WAIT_V(n) asm volatile("s_waitcnt vmcnt(" #n ")" ::: "memory")
#define WAIT_L(n) asm volatile("s_waitcnt lgkmcnt(" #n ")" ::: "memory")
#define BAR __builtin_amdgcn_s_barrier()
#define SCHED __builtin_amdgcn_sched_barrier(0)
  const int tid_ = tidx();
  const int wid = tid_ >> 6, lane = tid_ & 63, wr = wid >> 2, wc = wid & 3, fr = lane & 15, fq = lane >> 4;
  const int nt = K / BK;
  const int wu16 = __builtin_amdgcn_readfirstlane(tid_ >> 6) * 1024;
  {
    unsigned so0, so1;
    { int _r, _c; stage_rc(tid_ * 16, _r, _c); so0 = (unsigned)(_r * K + _c) * 2u;
      stage_rc(tid_ * 16 + 8192, _r, _c); so1 = (unsigned)(_r * K + _c) * 2u; }
    const int brow = pm * BM, bcol = pn * BM;
    f32x4 acc[2][2][4][2] = {};
    bf16x8 At[4][2], B0[2][2], B1[2][2];
    STAGE(SB(0, 0), Bt, bcol, 0); STAGE(SA(0, 0), A, brow, 0);
    STAGE(SB(0, 1), Bt, bcol + HALF, 0); STAGE(SA(0, 1), A, brow + HALF, 0);
    if (wr == 1) BAR;
    WAIT_V(4); BAR;
    STAGE(SB(1, 0), Bt, bcol, 1); STAGE(SA(1, 0), A, brow, 1); STAGE(SB(1, 1), Bt, bcol + HALF, 1);
    WAIT_V(6); BAR;
    for (int t = 0; t < nt - 2; t += 2) {
      LDB(B0, 0, 0); SCHED; LDA(At, 0, 0); STAGE(SA(1, 1), A, brow + HALF, t + 1);
      WAIT_L(8); BAR; WAIT_L(0); MMA(0, 0, At, B0); BAR; SCHED;
      LDB(B1, 0, 1); STAGE(SB(0, 0), Bt, bcol, t + 2);
      BAR; WAIT_L(0); MMA(0, 1, At, B1); BAR;
      LDA(At, 0, 1); STAGE(SA(0, 0), A, brow, t + 2);
      BAR; WAIT_L(0); MMA(1, 0, At, B0); BAR; SCHED;
      STAGE(SB(0, 1), Bt, bcol + HALF, t + 2);
      WAIT_V(6); BAR; MMA(1, 1, At, B1); BAR;
      LDB(B0, 1, 0); SCHED; LDA(At, 1, 0); STAGE(SA(0, 1), A, brow + HALF, t + 2);
      WAIT_L(8); BAR; WAIT_L(0); MMA(0, 0, At, B0); BAR; SCHED;
      LDB(B1, 1, 1); STAGE(SB(1, 0), Bt, bcol, t + 3);
      BAR; WAIT_L(0); MMA(0, 1, At, B1); BAR;
      LDA(At, 1, 1); STAGE(SA(1, 0), A, brow, t + 3);
      BAR; WAIT_L(0); MMA(1, 0, At, B0); BAR; SCHED;
      STAGE(SB(1, 1), Bt, bcol + HALF, t + 3);
      WAIT_V(6); BAR; MMA(1, 1, At, B1); BAR;
    }
    { LDB(B0, 0, 0); LDA(At, 0, 0); STAGE(SA(1, 1), A, brow + HALF, nt - 1);
      BAR; WAIT_L(0); MMA(0, 0, At, B0); BAR;
      LDB(B1, 0, 1); BAR; WAIT_L(0); MMA(0, 1, At, B1); BAR;
      LDA(At, 0, 1); WAIT_V(4); BAR; WAIT_L(0); MMA(1, 0, At, B0); MMA(1, 1, At, B1); BAR; }
    { LDB(B0, 1, 0); LDA(At, 1, 0); WAIT_V(2); BAR; WAIT_L(0); MMA(0, 0, At, B0); BAR;
      LDB(B1, 1, 1); WAIT_V(0); BAR; WAIT_L(0); MMA(0, 1, At, B1); BAR;
      LDA(At, 1, 1); BAR; WAIT_L(0); MMA(1, 0, At, B0); MMA(1, 1, At, B1); BAR; }
    if (wr == 0) BAR;
    float* stg = (float*)smem;
    int tx = tid_;
    asm volatile("" : "+v"(tx));
    const int ewr = tx >> 8, ewc = (tx >> 6) & 3, efr = tx & 15, efq = (tx >> 4) & 3;
#define EPI_HALF(ai) do { \
    __syncthreads(); \
    _Pragma("unroll") for (int bj = 0; bj < 2; ++bj) _Pragma("unroll") for (int m = 0; m < 4; ++m) \
    _Pragma("unroll") for (int n = 0; n < 2; ++n) _Pragma("unroll") for (int j = 0; j < 4; ++j) \
      stg[(ewr * 64 + m * 16 + efq * 4 + j) * 260 + bj * HALF + ewc * 32 + n * 16 + efr] = acc[ai][bj][m][n][j]; \
    __syncthreads(); \
    for (int i = 0; i < 8; ++i) { \
      int item = i * NTHR + tx; int rl = item >> 5, qp = item & 31; \
      int cl = (qp >> 2) * 32 + (qp & 3) * 4; \
      float4 v0 = *(const float4*)(stg + rl * 260 + cl), v1 = *(const float4*)(stg + rl * 260 + cl + 16); \
      int row = brow + ai * HALF + rl; \
      float ss = epi.apply4(row, bcol + cl, v0, v1); \
      if (Epi::kSsq) { \
        ss += __shfl_xor(ss, 1); ss += __shfl_xor(ss, 2); ss += __shfl_xor(ss, 4); ss += __shfl_xor(ss, 8); ss += __shfl_xor(ss, 16); \
        if (qp == 0) epi.ssq_out(row, pn, ss); \
      } \
    } } while (0)
    EPI_HALF(0);
    EPI_HALF(1);
#undef EPI_HALF
    __syncthreads();
  }
#undef SA
#undef SB
#undef STAGE
#undef LDA
#undef LDB
#undef MMA
}

template <class Epi>
__device__ __forceinline__ void gemm_phase(const u16* __restrict__ A, const u16* __restrict__ Bt, const int K,
                                           const int nM, const int nN, const int rot, Epi epi) {
  const int G = gridDim.x;
  for (int tile = (int)((blockIdx.x + G - (rot % G)) % G); tile < nM * nN; tile += G) {
    int pm, pn; tile_map(tile, nM, nN, pm, pn);
    gemm_tile(A, Bt, K, pm, pn, epi);
  }
}

__device__ __forceinline__ float rstd_from_ssq(const float* ssq, int row) {
  float4 s = *(const float4*)(ssq + (size_t)row * 4);
  return rsqrtf((s.x + s.y + s.z + s.w) * (1.f / 1024.f) + 1e-6f);
}
__device__ __forceinline__ uint2 pack4(float4 v) { uint2 w; w.x = pack2(v.x, v.y); w.y = pack2(v.z, v.w); return w; }
__device__ __forceinline__ float silu_mul(float g, float u) { return g / (1.f + __expf(-g)) * u; }
struct EpiGU {
  static constexpr bool kSsq = false;
  const float* ssq; u16* act;
  __device__ __forceinline__ float apply4(int row, int c0, float4 g, float4 u) const {
    float rs = rstd_from_ssq(ssq, row);
    float4 o = make_float4(silu_mul(g.x * rs, u.x * rs), silu_mul(g.y * rs, u.y * rs), silu_mul(g.z * rs, u.z * rs), silu_mul(g.w * rs, u.w * rs));
    *(uint2*)(act + (size_t)row * DFF + ((c0 & ~31) >> 1) + (c0 & 15)) = pack4(o);
    return 0.f;
  }
  __device__ __forceinline__ void ssq_out(int, int, float) const {}
};
struct EpiRes {
  static constexpr bool kSsq = true;
  float* x; u16* xb; float* ssq; float coef;
  __device__ __forceinline__ float apply4(int row, int c0, float4 v0, float4 v1) const {
    size_t i = (size_t)row * 1024 + c0;
    float4 a = *(const float4*)(x + i), b = *(const float4*)(x + i + 16);
    a.x += coef * v0.x; a.y += coef * v0.y; a.z += coef * v0.z; a.w += coef * v0.w;
    b.x += coef * v1.x; b.y += coef * v1.y; b.z += coef * v1.z; b.w += coef * v1.w;
    *(float4*)(x + i) = a; *(float4*)(x + i + 16) = b;
    *(uint2*)(xb + i) = pack4(a); *(uint2*)(xb + i + 16) = pack4(b);
    return a.x * a.x + a.y * a.y + a.z * a.z + a.w * a.w + b.x * b.x + b.y * b.y + b.z * b.z + b.w * b.w;
  }
  __device__ __forceinline__ void ssq_out(int row, int pn, float v) const { ssq[(size_t)row * 4 + pn] = v; }
};
struct EpiScaleBf {
  static constexpr bool kSsq = false;
  const float* ssq; u16* o; int ld;
  __device__ __forceinline__ float apply4(int row, int c0, float4 v0, float4 v1) const {
    float rs = rstd_from_ssq(ssq, row);
    size_t i = (size_t)row * ld + c0;
    *(uint2*)(o + i) = pack4(make_float4(v0.x * rs, v0.y * rs, v0.z * rs, v0.w * rs));
    *(uint2*)(o + i + 16) = pack4(make_float4(v1.x * rs, v1.y * rs, v1.z * rs, v1.w * rs));
    return 0.f;
  }
  __device__ __forceinline__ void ssq_out(int, int, float) const {}
};
struct EpiQ {
  static constexpr bool kSsq = false;
  u16* qb; const float2* rope;
  __device__ __forceinline__ float apply4(int row, int c0, float4 v0, float4 v1) const {
    if (c0 < 1024) {
      size_t i = (size_t)row * 1280 + (c0 >> 7) * 160 + (c0 & 127);
      *(uint2*)(qb + i) = pack4(v0); *(uint2*)(qb + i + 16) = pack4(v1);
    } else {
      int h = (c0 - 1024) >> 5, f0 = c0 & 15;
      int pos = row < TP ? (row & 4095) : (2048 + ((row - TP) & 63));
      const float2* cs = rope + pos * 16 + f0;
      float2 c_0 = cs[0], c_1 = cs[1], c_2 = cs[2], c_3 = cs[3];
      size_t i = (size_t)row * 1280 + h * 160 + 128 + f0;
      *(uint2*)(qb + i) = pack4(make_float4(v0.x * c_0.x - v1.x * c_0.y, v0.y * c_1.x - v1.y * c_1.y, v0.z * c_2.x - v1.z * c_2.y, v0.w * c_3.x - v1.w * c_3.y));
      *(uint2*)(qb + i + 16) = pack4(make_float4(v0.x * c_0.y + v1.x * c_0.x, v0.y * c_1.y + v1.y * c_1.x, v0.z * c_2.y + v1.z * c_2.x, v0.w * c_3.y + v1.w * c_3.x));
    }
    return 0.f;
  }
  __device__ __forceinline__ void ssq_out(int, int, float) const {}
};
__device__ __forceinline__ float decay_f(float z) {
  float nz = -z;
  float sp = fmaxf(nz, 0.f) + __logf(1.f + __expf(-fabsf(nz)));
  return __expf(-__expf(-sp - 0.5f));
}
struct EpiRW {
  static constexpr bool kSsq = false;
  const float* w0; const float* a0; const float* ka; char* ws;
  __device__ __forceinline__ void acol(size_t i, int c, float4 v) const {
    u16* bb = (u16*)(ws + W_BB); u16* kb = (u16*)(ws + W_KB); const u16* kkb = (const u16*)(ws + W_KKB);
    float4 a_0 = *(const float4*)(a0 + c), k_a = *(const float4*)(ka + c), kk = bf4(*(const uint2*)(kkb + i)), k = bf4(*(const uint2*)(kb + i));
    float4 a = make_float4(sigmoidf_(a_0.x + v.x), sigmoidf_(a_0.y + v.y), sigmoidf_(a_0.z + v.z), sigmoidf_(a_0.w + v.w));
    *(uint2*)(bb + i) = pack4(make_float4(kk.x * a.x, kk.y * a.y, kk.z * a.z, kk.w * a.w));
    *(uint2*)(kb + i) = pack4(make_float4(k.x * (1.f + (a.x - 1.f) * k_a.x), k.y * (1.f + (a.y - 1.f) * k_a.y), k.z * (1.f + (a.z - 1.f) * k_a.z), k.w * (1.f + (a.w - 1.f) * k_a.w)));
  }
  __device__ __forceinline__ float apply4(int row, int c0, float4 v0, float4 v1) const {
    if (c0 < 512) {
      float* wb = (float*)(ws + W_WB);
      float4 z0 = *(const float4*)(w0 + c0), z1 = *(const float4*)(w0 + c0 + 16);
      size_t i = (size_t)row * 512 + c0;
      *(float4*)(wb + i) = make_float4(decay_f(z0.x + v0.x), decay_f(z0.y + v0.y), decay_f(z0.z + v0.z), decay_f(z0.w + v0.w));
      *(float4*)(wb + i + 16) = make_float4(decay_f(z1.x + v1.x), decay_f(z1.y + v1.y), decay_f(z1.z + v1.z), decay_f(z1.w + v1.w));
    } else if (c0 < 1024) {
      int c = c0 - 512; size_t i = (size_t)row * 512 + c;
      acol(i, c, v0); acol(i + 16, c + 16, v1);
    } else {
      u16* gb = (u16*)(ws + W_GB);
      size_t i = (size_t)row * 512 + (c0 - 1024);
      *(uint2*)(gb + i) = pack4(v0); *(uint2*)(gb + i + 16) = pack4(v1);
    }
    return 0.f;
  }
  __device__ __forceinline__ void ssq_out(int, int, float) const {}
};
template <bool ISV>
struct EpiMem {
  static constexpr bool kSsq = false;
  float* of; u16* ob;
  __device__ __forceinline__ void quad(int row, int col, float4 v) const {
    *(float4*)(of + (size_t)row * 1024 + col) = v;
    int b = row >> 8, m = row & 255, h = col >> 8, d = col & 255;
    if (ISV) {
      u16* o = ob + (size_t)((b * 4 + h) * 256 + d) * 256 + m;
      o[0] = f2bf(v.x); o[256] = f2bf(v.y); o[512] = f2bf(v.z); o[768] = f2bf(v.w);
    } else {
      *(uint2*)(ob + (size_t)((b * 4 + h) * 256 + m) * 256 + d) = pack4(v);
    }
  }
  __device__ __forceinline__ float apply4(int row, int c0, float4 v0, float4 v1) const {
    quad(row, c0, v0); quad(row, c0 + 16, v1);
    return 0.f;
  }
  __device__ __forceinline__ void ssq_out(int, int, float) const {}
};

template <class F>
__device__ __forceinline__ void tconv(u16* dst, int ldd, int N, int K, int rot, F f) {
  extern __shared__ __attribute__((aligned(16))) char smem[];
  float* t = (float*)smem;
  const int nk = K / 64, nt = (N / 64) * nk, G = gridDim.x;
  const int tid = tidx(), a = tid >> 6, c = tid & 63;
  for (int tile = (int)((blockIdx.x + G - (rot % G)) % G); tile < nt; tile += G) {
    int n0 = (tile / nk) * 64, k0 = (tile % nk) * 64;
    __syncthreads();
#pragma unroll
    for (int i = 0; i < 8; ++i) { int kk = a + 8 * i; t[kk * 65 + c] = f(k0 + kk, n0 + c); }
    __syncthreads();
#pragma unroll
    for (int i = 0; i < 2; ++i) {
      const int nn = (tid >> 4) + 32 * i, kq = (tid & 15) * 4;
      uint2 w; w.x = pack2(t[kq * 65 + nn], t[(kq + 1) * 65 + nn]); w.y = pack2(t[(kq + 2) * 65 + nn], t[(kq + 3) * 65 + nn]);
      *(uint2*)(dst + (size_t)(n0 + nn) * ldd + k0 + kq) = w;
    }
  }
}

template <class F>
__device__ __forceinline__ void tconv_v(u16* dst, int ldd, int N, int K, int vb, int nvb, F f) {
  extern __shared__ __attribute__((aligned(16))) char smem[];
  float* t = (float*)smem;
  const int nk = K / 64, nt = (N / 64) * nk;
  const int tid = tidx(), a = tid >> 6, c = tid & 63;
  for (int tile = vb; tile < nt; tile += nvb) {
    int n0 = (tile / nk) * 64, k0 = (tile % nk) * 64;
    __syncthreads();
#pragma unroll
    for (int i = 0; i < 8; ++i) { int kk = a + 8 * i; t[kk * 65 + c] = f(k0 + kk, n0 + c); }
    __syncthreads();
#pragma unroll
    for (int i = 0; i < 2; ++i) {
      const int nn = (tid >> 4) + 32 * i, kq = (tid & 15) * 4;
      uint2 w; w.x = pack2(t[kq * 65 + nn], t[(kq + 1) * 65 + nn]); w.y = pack2(t[(kq + 2) * 65 + nn], t[(kq + 3) * 65 + nn]);
      *(uint2*)(dst + (size_t)(n0 + nn) * ldd + k0 + kq) = w;
    }
  }
  __syncthreads();
}

template <int DK, int DV, int RPG>
__device__ __forceinline__ void attn_item(const u16* __restrict__ Qb, int ldq, int nrows, const u16* __restrict__ Kb, int ldk,
                                          const u16* __restrict__ Vtb, int ldvt, int nkeys, u16* __restrict__ Ob, int ldo) {
  extern __shared__ __attribute__((aligned(16))) char smem[];
  constexpr int KS = DK + 8, VS = 68;
  u16* sK = (u16*)smem;
  u16* sV = sK + 64 * KS;
  const int tid = tidx(), wid = tid >> 6, lane = tid & 63, q = lane & 31, hh = lane >> 5;
  const int row = wid * 32 + q;
  const bool active = (wid * 32) < nrows;
  bf16x8 qf[DK / 16];
  if (active) {
#pragma unroll
    for (int ks = 0; ks < DK / 16; ++ks) qf[ks] = *(const bf16x8*)(Qb + (size_t)row * ldq + ks * 16 + hh * 8);
  }
  f32x16 o[DV / 32];
#pragma unroll
  for (int dt = 0; dt < DV / 32; ++dt)
#pragma unroll
    for (int i = 0; i < 16; ++i) o[dt][i] = 0.f;
  float mrun = -1e30f, lrun = 0.f;
  const int nkt = nkeys >> 6;
  constexpr int KCH = (64 * (DK / 8) + NTHR - 1) / NTHR;
  static_assert(DV == 128 && KCH <= 4, "staging registers are written out by hand");
  uint4 kr0, kr1, kr2, kr3, vr0, vr1;
#define AT_KL(N_, kt_) { const int c = tid + N_ * NTHR; if (N_ < KCH && c < 64 * (DK / 8)) { const int r = c / (DK / 8), cc = c % (DK / 8); \
      kr##N_ = *(const uint4*)(Kb + (size_t)((kt_) * 64 + r) * ldk + cc * 8); } }
#define AT_VL(N_, kt_) { const int c = tid + N_ * NTHR; const int r = c >> 3, cc = c & 7; vr##N_ = *(const uint4*)(Vtb + (size_t)r * ldvt + (kt_) * 64 + cc * 8); }
#define AT_GLOAD(kt_) do { AT_KL(0, kt_) AT_KL(1, kt_) AT_KL(2, kt_) AT_KL(3, kt_) AT_VL(0, kt_) AT_VL(1, kt_) } while (0)
#define AT_KS(N_) { const int c = tid + N_ * NTHR; if (N_ < KCH && c < 64 * (DK / 8)) { const int r = c / (DK / 8), cc = c % (DK / 8); *(uint4*)(sK + r * KS + cc * 8) = kr##N_; } }
#define AT_VS(N_) { const int c = tid + N_ * NTHR; const int r = c >> 3, cc = c & 7; uint2* d = (uint2*)(sV + r * VS + cc * 8); \
      const uint4 t_ = vr##N_; d[0] = make_uint2(t_.x, t_.y); d[1] = make_uint2(t_.z, t_.w); }
  AT_GLOAD(0);
  for (int kt = 0; kt < nkt; ++kt) {
    __syncthreads();
    AT_KS(0) AT_KS(1) AT_KS(2) AT_KS(3) AT_VS(0) AT_VS(1)
    __syncthreads();
    if (kt + 1 < nkt) AT_GLOAD(kt + 1);
    if (active) {
      f32x16 s0, s1;
#pragma unroll
      for (int i = 0; i < 16; ++i) { s0[i] = 0.f; s1[i] = 0.f; }
#pragma unroll
      for (int ks = 0; ks < DK / 16; ++ks) {
        bf16x8 a0 = *(const bf16x8*)(sK + q * KS + ks * 16 + hh * 8);
        bf16x8 a1 = *(const bf16x8*)(sK + (32 + q) * KS + ks * 16 + hh * 8);
        s0 = __builtin_amdgcn_mfma_f32_32x32x16_bf16(a0, qf[ks], s0, 0, 0, 0);
        s1 = __builtin_amdgcn_mfma_f32_32x32x16_bf16(a1, qf[ks], s1, 0, 0, 0);
      }
      float mx = s0[0];
#pragma unroll
      for (int i = 1; i < 16; ++i) mx = fmaxf(mx, s0[i]);
#pragma unroll
      for (int i = 0; i < 16; ++i) mx = fmaxf(mx, s1[i]);
      mx = fmaxf(mx, __shfl_xor(mx, 32));
      float mn = fmaxf(mrun, mx);
      float alpha = __builtin_amdgcn_exp2f(mrun - mn);
      mrun = mn;
      float ps = 0.f;
#pragma unroll
      for (int i = 0; i < 16; ++i) { s0[i] = __builtin_amdgcn_exp2f(sub_s(s0[i], mn)); ps = add_s(ps, s0[i]); }
#pragma unroll
      for (int i = 0; i < 16; ++i) { s1[i] = __builtin_amdgcn_exp2f(sub_s(s1[i], mn)); ps = add_s(ps, s1[i]); }
      lrun = lrun * alpha + ps;
#pragma unroll
      for (int dt = 0; dt < DV / 32; ++dt)
#pragma unroll
        for (int i = 0; i < 16; ++i) o[dt][i] = mul_s(o[dt][i], alpha);
#pragma unroll
      for (int kb = 0; kb < 2; ++kb)
#pragma unroll
        for (int s = 0; s < 2; ++s) {
          union { bf16x8 v; unsigned u[4]; } pf;
#pragma unroll
          for (int jj = 0; jj < 4; ++jj) {
            float e0 = kb ? s1[8 * s + 2 * jj] : s0[8 * s + 2 * jj];
            float e1 = kb ? s1[8 * s + 2 * jj + 1] : s0[8 * s + 2 * jj + 1];
            pf.u[jj] = pack2(e0, e1);
          }
          const int kbase = kb * 32 + s * 16 + 4 * hh;
#pragma unroll
          for (int dt = 0; dt < DV / 32; ++dt) {
            const u16* vp = sV + (dt * 32 + q) * VS + kbase;
            union { bf16x8 v; uint2 u[2]; } vf;
            vf.u[0] = *(const uint2*)vp; vf.u[1] = *(const uint2*)(vp + 8);
            o[dt] = __builtin_amdgcn_mfma_f32_32x32x16_bf16(vf.v, pf.v, o[dt], 0, 0, 0);
          }
        }
    }
  }
  if (active) {
    lrun += __shfl_xor(lrun, 32);
    float inv = 1.f / lrun;
    u16* op = Ob + (size_t)(row / RPG) * ldo + (size_t)(row % RPG) * DV;
#pragma unroll
    for (int dt = 0; dt < DV / 32; ++dt)
#pragma unroll
      for (int g = 0; g < 4; ++g) {
        uint2 w;
        w.x = pack2(o[dt][4 * g] * inv, o[dt][4 * g + 1] * inv);
        w.y = pack2(o[dt][4 * g + 2] * inv, o[dt][4 * g + 3] * inv);
        *(uint2*)(op + dt * 32 + 8 * g + 4 * hh) = w;
      }
  }
}

#undef AT_GLOAD
#undef AT_KL
#undef AT_VL
#undef AT_KS
#undef AT_VS
__device__ __forceinline__ float dpp_sum16(float x) {
  x += __int_as_float(__builtin_amdgcn_update_dpp(0, __float_as_int(x), 0xB1, 0xF, 0xF, false));
  x += __int_as_float(__builtin_amdgcn_update_dpp(0, __float_as_int(x), 0x4E, 0xF, 0xF, false));
  x += __int_as_float(__builtin_amdgcn_update_dpp(0, __float_as_int(x), 0x141, 0xF, 0xF, false));
  x += __int_as_float(__builtin_amdgcn_update_dpp(0, __float_as_int(x), 0x140, 0xF, 0xF, false));
  return x;
}
__device__ __forceinline__ void scan_item(KPR p, int l, int g0, int h, int half, int nsteps, const float* S0, float* Sout) {
  extern __shared__ __attribute__((aligned(16))) char smem[];
  float* sT = (float*)smem;
  float* sV = sT + 5 * 4096;
  const float* src0 = (const float*)(p.ws + W_RB) + h * 64; const float* src1 = (const float*)(p.ws + W_WB) + h * 64;
  const float* src2 = (const float*)(p.ws + W_KB) + h * 64; const float* src3 = (const float*)(p.ws + W_KKB) + h * 64;
  const float* src4 = (const float*)(p.ws + W_BB) + h * 64;
  const float* VB = (const float*)(p.ws + W_VB) + h * 64 + half * 32;
  float* YB = (float*)(p.ws + W_YB) + h * 64 + half * 32;
  const int tid = tidx();
  const int il = tid >> 4, sub = tid & 15, j0 = sub * 4, i = half * 32 + il;
  float s[4];
#pragma unroll
  for (int j = 0; j < 4; ++j) s[j] = S0 ? S0[i * 64 + j0 + j] : 0.f;
  float4 pa0, pa1, pa2, pa3, pa4, pb0, pb1, pb2, pb3, pb4, pfv;
  const int e0 = tid, e1 = tid + NTHR;
  const int st0 = e0 >> 4, c40 = (e0 & 15) * 4, st1 = e1 >> 4, c41 = (e1 & 15) * 4;
  const int stv = tid >> 3, c4v = (tid & 7) * 4;
#define SC_GL1(x, c0_) pa##x = *(const float4*)(src##x + (size_t)(g0 + (c0_) + st0) * 512 + c40); \
                       pb##x = *(const float4*)(src##x + (size_t)(g0 + (c0_) + st1) * 512 + c41);
#define SC_GLOAD(c0_) do { SC_GL1(0, c0_) SC_GL1(1, c0_) SC_GL1(2, c0_) SC_GL1(3, c0_) SC_GL1(4, c0_) \
    pfv = *(const float4*)(VB + (size_t)(g0 + (c0_) + stv) * 512 + c4v); } while (0)
#define SC_ST1(x) *(float4*)(sT + x * 4096 + st0 * 64 + c40) = pa##x; *(float4*)(sT + x * 4096 + st1 * 64 + c41) = pb##x;
  SC_GLOAD(0);
  for (int c0 = 0; c0 < nsteps; c0 += 64) {
    __syncthreads();
    SC_ST1(0) SC_ST1(1) SC_ST1(2) SC_ST1(3) SC_ST1(4)
    *(float4*)(sV + stv * 32 + c4v) = pfv;
    __syncthreads();
    if (c0 + 64 < nsteps) SC_GLOAD(c0 + 64);
#define SC_LD(S, st_) do { const int _s = (st_) < 64 ? (st_) : 63; \
      S##r = *(const float4*)(sT + _s * 64 + j0); S##w = *(const float4*)(sT + 4096 + _s * 64 + j0); \
      S##k = *(const float4*)(sT + 8192 + _s * 64 + j0); S##q = *(const float4*)(sT + 12288 + _s * 64 + j0); \
      S##b = *(const float4*)(sT + 16384 + _s * 64 + j0); S##v = sV[_s * 32 + il]; } while (0)
#define SC_STEP(S, st_) do { \
      float sa = -dpp_sum16(fma_s(s[1], S##q.y, mul_s(s[0], S##q.x)) + fma_s(s[3], S##q.w, mul_s(s[2], S##q.z))); \
      s[0] = fma_s(sa, S##b.x, fma_s(s[0], S##w.x, mul_s(S##v, S##k.x))); \
      s[1] = fma_s(sa, S##b.y, fma_s(s[1], S##w.y, mul_s(S##v, S##k.y))); \
      s[2] = fma_s(sa, S##b.z, fma_s(s[2], S##w.z, mul_s(S##v, S##k.z))); \
      s[3] = fma_s(sa, S##b.w, fma_s(s[3], S##w.w, mul_s(S##v, S##k.w))); \
      float y = dpp_sum16(fma_s(s[1], S##r.y, mul_s(s[0], S##r.x)) + fma_s(s[3], S##r.w, mul_s(s[2], S##r.z))); \
      ykeep = (sub == ((st_) & 15)) ? y : ykeep; } while (0)
    float4 Ar, Aw, Ak, Aq, Ab, Br, Bw, Bk, Bq, Bb, Cr, Cw, Ck, Cq, Cb, Dr, Dw, Dk, Dq, Db;
    float Av, Bv, Cv, Dv, ykeep = 0.f;
    SC_LD(A, 0); SC_LD(B, 1); SC_LD(C, 2);
    for (int st = 0; st < 64; st += 4) {
      SC_LD(D, st + 3); SC_STEP(A, st);
      SC_LD(A, st + 4); SC_STEP(B, st + 1);
      SC_LD(B, st + 5); SC_STEP(C, st + 2);
      SC_LD(C, st + 6); SC_STEP(D, st + 3);
      if ((st & 15) == 12) YB[(size_t)(g0 + c0 + (st - 12) + sub) * 512 + il] = ykeep;
    }
  }
#undef SC_LD
#undef SC_STEP
#undef SC_GLOAD
#undef SC_GL1
#undef SC_ST1
  *(float4*)(Sout + i * 64 + j0) = make_float4(s[0], s[1], s[2], s[3]);
}

constexpr int LS = 68;
constexpr int LBUF = 64 * LS;
constexpr int LH = 72;

__device__ __forceinline__ void split8(const float* x, bf16x8& hi, bf16x8& lo) {
  union { bf16x8 v; unsigned u[4]; } H, Lo;
#pragma unroll
  for (int j = 0; j < 4; ++j) {
    const unsigned h = pack2(x[2 * j], x[2 * j + 1]);
    H.u[j] = h;
    Lo.u[j] = pack2(x[2 * j] - __uint_as_float(h << 16), x[2 * j + 1] - __uint_as_float(h & 0xffff0000u));
  }
  hi = H.v; lo = Lo.v;
}
template <int AM, int AK, int BKS, int BN, bool SPLIT = true>
__device__ __forceinline__ void mm64(const float* A, const float* B, f32x4 (&acc)[2], int m0, int n0, int lane) {
  const int lr = lane & 15, lq = lane >> 4;
#pragma unroll
  for (int ks = 0; ks < 2; ++ks) {
    const int k0 = ks * 32 + lq * 8;
    float a[8];
    if (AK == 1) {
      float4 x0 = *(const float4*)(A + (m0 + lr) * AM + k0), x1 = *(const float4*)(A + (m0 + lr) * AM + k0 + 4);
      a[0] = x0.x; a[1] = x0.y; a[2] = x0.z; a[3] = x0.w; a[4] = x1.x; a[5] = x1.y; a[6] = x1.z; a[7] = x1.w;
    } else {
#pragma unroll
      for (int j = 0; j < 8; ++j) a[j] = A[(m0 + lr) * AM + (k0 + j) * AK];
    }
    bf16x8 ah, al;
    if (SPLIT) split8(a, ah, al);
    else { union { bf16x8 v; unsigned u[4]; } H; for (int j = 0; j < 4; ++j) H.u[j] = pack2(a[2 * j], a[2 * j + 1]); ah = H.v; al = H.v; }
#pragma unroll
    for (int nt = 0; nt < 2; ++nt) {
      const int n = n0 + nt * 16 + lr;
      float b[8];
      if (BKS == 1) {
        float4 x0 = *(const float4*)(B + n * BN + k0), x1 = *(const float4*)(B + n * BN + k0 + 4);
        b[0] = x0.x; b[1] = x0.y; b[2] = x0.z; b[3] = x0.w; b[4] = x1.x; b[5] = x1.y; b[6] = x1.z; b[7] = x1.w;
      } else {
#pragma unroll
        for (int j = 0; j < 8; ++j) b[j] = B[(k0 + j) * BKS + n * BN];
      }
      if (SPLIT) {
        bf16x8 bh, bl; split8(b, bh, bl);
        acc[nt] = __builtin_amdgcn_mfma_f32_16x16x32_bf16(ah, bh, acc[nt], 0, 0, 0);
        acc[nt] = __builtin_amdgcn_mfma_f32_16x16x32_bf16(ah, bl, acc[nt], 0, 0, 0);
        acc[nt] = __builtin_amdgcn_mfma_f32_16x16x32_bf16(al, bh, acc[nt], 0, 0, 0);
      } else {
        union { bf16x8 v; unsigned u[4]; } Bh;
#pragma unroll
        for (int j = 0; j < 4; ++j) Bh.u[j] = pack2(b[2 * j], b[2 * j + 1]);
        acc[nt] = __builtin_amdgcn_mfma_f32_16x16x32_bf16(ah, Bh.v, acc[nt], 0, 0, 0);
      }
    }
  }
}
#define MM_ZERO(acc) do { acc[0] = f32x4{0.f, 0.f, 0.f, 0.f}; acc[1] = f32x4{0.f, 0.f, 0.f, 0.f}; } while (0)
#define MM_FOREACH(acc, BODY) do { _Pragma("unroll") for (int nt_ = 0; nt_ < 2; ++nt_) _Pragma("unroll") for (int rg_ = 0; rg_ < 4; ++rg_) { \
    const int m = m0 + lq * 4 + rg_, n = n0 + nt_ * 16 + lr; const float val = acc[nt_][rg_]; BODY } } while (0)

#define CPRE_PARAMS float4& c_w0, float4& c_w1, uint2& c_q0, uint2& c_q1, uint2& c_b0, uint2& c_b1, uint2& c_k0, uint2& c_k1, uint2& c_r0, uint2& c_r1, uint2& c_v0, uint2& c_v1
#define CPRE_ARGS(P) P##w0, P##w1, P##q0, P##q1, P##b0, P##b1, P##k0, P##k1, P##r0, P##r1, P##v0, P##v1
__device__ __forceinline__ void cprep_load(KPR p, int grow0, int h, int tid, CPRE_PARAMS) {
  const int t0 = tid >> 4, c4 = (tid & 15) * 4;
  const size_t g0 = (size_t)(grow0 + t0) * 512 + h * 64 + c4, g1 = g0 + (size_t)32 * 512;
  const float* WB = (const float*)(p.ws + W_WB); const u16* KKB = (const u16*)(p.ws + W_KKB); const u16* BB = (const u16*)(p.ws + W_BB);
  const u16* KB = (const u16*)(p.ws + W_KB); const u16* RB = (const u16*)(p.ws + W_RB); const u16* VB = (const u16*)(p.ws + W_VB);
  c_w0 = *(const float4*)(WB + g0); c_w1 = *(const float4*)(WB + g1); c_q0 = *(const uint2*)(KKB + g0); c_q1 = *(const uint2*)(KKB + g1);
  c_b0 = *(const uint2*)(BB + g0); c_b1 = *(const uint2*)(BB + g1); c_k0 = *(const uint2*)(KB + g0); c_k1 = *(const uint2*)(KB + g1);
  c_r0 = *(const uint2*)(RB + g0); c_r1 = *(const uint2*)(RB + g1); c_v0 = *(const uint2*)(VB + g0); c_v1 = *(const uint2*)(VB + g1);
}
__device__ __forceinline__ void cprep_item(KPR p, int grow0, int h, int cid, int ngrow0, int nh, CPRE_PARAMS) {
  extern __shared__ __attribute__((aligned(16))) char smem[];
  float* B0 = (float*)smem; float* B1 = B0 + LBUF; float* B2 = B1 + LBUF; float* B3 = B2 + LBUF;
  float* B4 = B3 + LBUF; float* B5 = B4 + LBUF; float* B6 = B5 + LBUF; float* B7 = B6 + LBUF;
  float* wC = (float*)(smem + 139264);
  const int tid = tidx(), wid = tid >> 6, lane = tid & 63, lr = lane & 15, lq = lane >> 4;
  const int m0 = (wid >> 1) * 16, n0 = (wid & 1) * 32;
  const float* WB = (const float*)(p.ws + W_WB) + h * 64; const float* KKB = (const float*)(p.ws + W_KKB) + h * 64;
  const float* BB = (const float*)(p.ws + W_BB) + h * 64; const float* KB = (const float*)(p.ws + W_KB) + h * 64;
  const float* RB = (const float*)(p.ws + W_RB) + h * 64; const float* VB = (const float*)(p.ws + W_VB) + h * 64;
  f32x4 acc[2];
  __syncthreads();
  {
    const int t0 = tid >> 4, c4 = (tid & 15) * 4, o0 = t0 * LS + c4, o1 = (t0 + 32) * LS + c4;
    *(float4*)(B0 + o0) = c_w0; *(float4*)(B0 + o1) = c_w1;
    { const float4 a0_ = bf4(c_q0), a1_ = bf4(c_q1);
      *(float4*)(B1 + o0) = make_float4(-a0_.x, -a0_.y, -a0_.z, -a0_.w); *(float4*)(B1 + o1) = make_float4(-a1_.x, -a1_.y, -a1_.z, -a1_.w); }
    *(float4*)(B2 + o0) = bf4(c_b0); *(float4*)(B2 + o1) = bf4(c_b1);
    *(float4*)(B3 + o0) = bf4(c_k0); *(float4*)(B3 + o1) = bf4(c_k1);
    *(float4*)(B4 + o0) = bf4(c_r0); *(float4*)(B4 + o1) = bf4(c_r1);
  }
  const uint2 vk0 = c_v0, vk1 = c_v1;
  __syncthreads();
  cprep_load(p, ngrow0, nh, tid, CPRE_ARGS(c_));
  {
    const int j = tid & 63, sg = tid >> 6;
    float wv[8];
#pragma unroll
    for (int u = 0; u < 8; ++u) wv[u] = B0[(sg * 8 + u) * LS + j];
#pragma unroll
    for (int u = 1; u < 8; ++u) wv[u] *= wv[u - 1];
    float* segp = B5;
    segp[sg * 64 + j] = wv[7];
    __syncthreads();
    float pre = 1.f;
    for (int u = 0; u < sg; ++u) pre *= segp[u * 64 + j];
#pragma unroll
    for (int u = 0; u < 8; ++u) B0[(sg * 8 + u) * LS + j] = wv[u] * pre;
    if (sg == 7) wC[j] = wv[7] * pre;
  }
  __syncthreads();
  for (int e = tid; e < 4096; e += NTHR) {
    const int t = e >> 6, j = e & 63, o = t * LS + j;
    const float wt = B0[o], wp = t ? B0[o - LS] : 1.f, iw = 1.f / wt;
    B1[o] *= wp; B2[o] *= iw; B3[o] *= iw; B4[o] *= wt;
  }
  __syncthreads();
  MM_ZERO(acc); mm64<LS, 1, 1, LS>(B2, B1, acc, m0, n0, lane);
  MM_FOREACH(acc, { const float v = m < n ? val : 0.f; B5[m * LS + n] = v; B6[m * LS + n] = v + (m == n ? 1.f : 0.f); });
  __syncthreads();
  MM_ZERO(acc); mm64<LS, 1, LS, 1>(B5, B5, acc, m0, n0, lane);
  MM_FOREACH(acc, { B7[m * LS + n] = val; });
  __syncthreads();
  for (int it = 0; it < 5; ++it) {
    MM_ZERO(acc); mm64<LS, 1, LS, 1>(B6, B7, acc, m0, n0, lane);
    f32x4 acc2[2]; MM_ZERO(acc2);
    if (it < 4) mm64<LS, 1, LS, 1>(B7, B7, acc2, m0, n0, lane);
    __syncthreads();
    MM_FOREACH(acc, { B6[m * LS + n] += val; });
    if (it < 4) MM_FOREACH(acc2, { B7[m * LS + n] = val; });
    __syncthreads();
  }
  MM_ZERO(acc); mm64<1, LS, LS, 1>(B1, B6, acc, m0, n0, lane);
  MM_FOREACH(acc, { B5[m * LS + n] = val; });
  MM_ZERO(acc); mm64<LS, 1, 1, LS>(B3, B1, acc, m0, n0, lane);
  MM_FOREACH(acc, { B0[m * LS + n] = m < n ? val : 0.f; });
  __syncthreads();
  MM_ZERO(acc); mm64<LS, 1, LS, 1>(B0, B6, acc, m0, n0, lane);
  MM_FOREACH(acc, { B7[m * LS + n] = val; });
  __syncthreads();
  MM_ZERO(acc); mm64<LS, 1, 1, LS, false>(B2, B4, acc, m0, n0, lane);
  {
    f32x4 acc2[2]; MM_ZERO(acc2); mm64<LS, 1, 1, LS, false>(B3, B4, acc2, m0, n0, lane);
    __syncthreads();
    MM_FOREACH(acc, { B0[m * LS + n] = m <= n ? val : 0.f; });
    MM_FOREACH(acc2, { B1[m * LS + n] = m <= n ? val : 0.f; });
  }
  __syncthreads();
  {
    u16* RRT = (u16*)(p.ws + W_CRR) + (size_t)cid * 4096;
    MM_ZERO(acc); mm64<1, LS, 1, LS, false>(B0, B5, acc, m0, n0, lane);
    MM_FOREACH(acc, { RRT[m * 64 + n] = f2bf(val + B4[m * LS + n]); });
    MM_ZERO(acc); mm64<LS, 1, LS, 1, false>(B7, B0, acc, m0, n0, lane);
    MM_FOREACH(acc, { B6[m * LS + n] = val + B1[m * LS + n]; });
  }
  __syncthreads();
  for (int e = tid; e < 4096; e += NTHR) {
    const int t = e >> 6, j = e & 63, o = t * LS + j;
    const float wc = wC[j];
    B2[o] *= wc; B3[o] *= wc;
  }
  { const int t0 = tid >> 4, c4 = (tid & 15) * 4; *(float4*)(B4 + t0 * LS + c4) = bf4(vk0); *(float4*)(B4 + (t0 + 32) * LS + c4) = bf4(vk1); }
  __syncthreads();
  {
    u16* YB = (u16*)(p.ws + W_YB) + h * 64;
    MM_ZERO(acc); mm64<1, LS, LS, 1, false>(B6, B4, acc, m0, n0, lane);
    MM_FOREACH(acc, { YB[(size_t)(grow0 + m) * 512 + n] = f2bf(val); });
    u16* PT = (u16*)(p.ws + W_CPT) + (size_t)cid * 4096;
    MM_ZERO(acc); mm64<1, LS, 1, LS, false>(B2, B5, acc, m0, n0, lane);
    MM_FOREACH(acc, { PT[m * 64 + n] = f2bf(val + (m == n ? wC[m] : 0.f)); });
    MM_ZERO(acc); mm64<LS, 1, LS, 1, false>(B7, B2, acc, m0, n0, lane);
    MM_FOREACH(acc, { B0[m * LS + n] = val + B3[m * LS + n]; });
  }
  __syncthreads();
  {
    float* CQ = (float*)(p.ws + W_CQ) + (size_t)cid * 4096;
    MM_ZERO(acc); mm64<1, LS, LS, 1, false>(B4, B0, acc, m0, n0, lane);
    MM_FOREACH(acc, { CQ[m * 64 + n] = val; });
  }
}

__device__ __forceinline__ void cprep_decode(int id, int& grow0, int& h) {
  if (id < 2048) { grow0 = (id >> 9) * 4096 + (id & 63) * 64; h = (id >> 6) & 7; }
  else { const int k = id - 2048; grow0 = TP + (k >> 3) * 64; h = k & 7; }
}
__device__ __forceinline__ void phase_cprep(KPR p) {
  float4 u_w0, u_w1; uint2 u_k0, u_k1, u_q0, u_q1, u_b0, u_b1, u_r0, u_r1, u_v0, u_v1;
  int id = blockIdx.x, grow0 = 0, h = 0;
  cprep_decode(id < 2304 ? id : 0, grow0, h); cprep_load(p, grow0, h, tidx(), CPRE_ARGS(u_));
  for (; id < 2304; id += gridDim.x) {
    const int nid = id + gridDim.x;
    int ng = 0, nh = 0;
    cprep_decode(nid < 2304 ? nid : id, ng, nh);
    cprep_item(p, grow0, h, id, ng, nh, CPRE_ARGS(u_));
    grow0 = ng; h = nh;
  }
}

__device__ __forceinline__ void cseq_item(KPR p, int g0, int h, int nch, int cid0, const float* S0, float* Sout) {
  extern __shared__ __attribute__((aligned(16))) char smem[];
  float* Sf = (float*)smem;
  float* Qf = Sf + LBUF;
  float* Yf = Qf + LBUF;
  u16* Rb = (u16*)(Yf + LBUF);
  u16* Pb = Rb + 64 * LH;
  const int tid = tidx(), wid = tid >> 6, lane = tid & 63, lr = lane & 15, lq = lane >> 4;
  const int m0 = (wid >> 1) * 16, n0 = (wid & 1) * 32;
  u16* YB = (u16*)(p.ws + W_YB) + h * 64;
  const u16* RRT = (const u16*)(p.ws + W_CRR) + (size_t)cid0 * 4096;
  const u16* PT = (const u16*)(p.ws + W_CPT) + (size_t)cid0 * 4096;
  const float* CQ = (const float*)(p.ws + W_CQ) + (size_t)cid0 * 4096;
  __syncthreads();
  for (int e = tid; e < 4096; e += NTHR) { const int i = e >> 6, j = e & 63; Sf[i * LS + j] = S0 ? S0[e] : 0.f; }
  const int hr = tid >> 3, hc = (tid & 7) * 8;
  const int f0t = tid >> 4, f0c = (tid & 15) * 4;
  uint4 pr, pp; float4 q0, q1; uint2 y0, y1;
#define CS_LOAD(c_) do { \
    pr = *(const uint4*)(RRT + (size_t)(c_) * 4096 + hr * 64 + hc); pp = *(const uint4*)(PT + (size_t)(c_) * 4096 + hr * 64 + hc); \
    q0 = *(const float4*)(CQ + (size_t)(c_) * 4096 + f0t * 64 + f0c); q1 = *(const float4*)(CQ + (size_t)(c_) * 4096 + (f0t + 32) * 64 + f0c); \
    y0 = *(const uint2*)(YB + (size_t)(g0 + (c_) * 64 + f0t) * 512 + f0c); y1 = *(const uint2*)(YB + (size_t)(g0 + (c_) * 64 + f0t + 32) * 512 + f0c); } while (0)
  CS_LOAD(0);
  for (int c = 0; c < nch; ++c) {
    __syncthreads();
    *(uint4*)(Rb + hr * LH + hc) = pr; *(uint4*)(Pb + hr * LH + hc) = pp;
    *(float4*)(Qf + f0t * LS + f0c) = q0; *(float4*)(Qf + (f0t + 32) * LS + f0c) = q1;
    *(float4*)(Yf + f0t * LS + f0c) = bf4(y0); *(float4*)(Yf + (f0t + 32) * LS + f0c) = bf4(y1);
    __syncthreads();
    if (c + 1 < nch) CS_LOAD(c + 1);
    f32x4 ay[2], as[2]; MM_ZERO(ay); MM_ZERO(as);
#pragma unroll
    for (int ks = 0; ks < 2; ++ks) {
      const int k0 = ks * 32 + lq * 8;
      const bf16x8 ra = *(const bf16x8*)(Rb + (m0 + lr) * LH + k0);
      float sa[8];
      { float4 x0 = *(const float4*)(Sf + (m0 + lr) * LS + k0), x1 = *(const float4*)(Sf + (m0 + lr) * LS + k0 + 4);
        sa[0] = x0.x; sa[1] = x0.y; sa[2] = x0.z; sa[3] = x0.w; sa[4] = x1.x; sa[5] = x1.y; sa[6] = x1.z; sa[7] = x1.w; }
      bf16x8 sah, sal; split8(sa, sah, sal);
#pragma unroll
      for (int nt = 0; nt < 2; ++nt) {
        const int n = n0 + nt * 16 + lr;
        float sb[8];
        { float4 x0 = *(const float4*)(Sf + n * LS + k0), x1 = *(const float4*)(Sf + n * LS + k0 + 4);
          sb[0] = x0.x; sb[1] = x0.y; sb[2] = x0.z; sb[3] = x0.w; sb[4] = x1.x; sb[5] = x1.y; sb[6] = x1.z; sb[7] = x1.w; }
        bf16x8 sbh, sbl; split8(sb, sbh, sbl);
        ay[nt] = __builtin_amdgcn_mfma_f32_16x16x32_bf16(ra, sbh, ay[nt], 0, 0, 0);
        ay[nt] = __builtin_amdgcn_mfma_f32_16x16x32_bf16(ra, sbl, ay[nt], 0, 0, 0);
        const bf16x8 pb = *(const bf16x8*)(Pb + n * LH + k0);
        as[nt] = __builtin_amdgcn_mfma_f32_16x16x32_bf16(sah, pb, as[nt], 0, 0, 0);
        as[nt] = __builtin_amdgcn_mfma_f32_16x16x32_bf16(sal, pb, as[nt], 0, 0, 0);
      }
    }
    MM_FOREACH(ay, { YB[(size_t)(g0 + c * 64 + m) * 512 + n] = f2bf(val + Yf[m * LS + n]); });
    __syncthreads();
    MM_FOREACH(as, { Sf[m * LS + n] = val + Qf[m * LS + n]; });
  }
#undef CS_LOAD
  __syncthreads();
  for (int e = tid; e < 4096; e += NTHR) { const int i = e >> 6, j = e & 63; Sout[e] = Sf[i * LS + j]; }
}

__device__ __forceinline__ void phase_yfin(KPR p, int l) {
  const int tid = tidx(), wid = tid >> 6, lane = tid & 63;
  const float* YB = (const float*)(p.ws + W_YB); const float* RB = (const float*)(p.ws + W_RB); const float* KB = (const float*)(p.ws + W_KB);
  const float* VB = (const float*)(p.ws + W_VB); const u16* GB = (const u16*)(p.ws + W_GB); u16* AO = (u16*)(p.ws + W_AO);
  const float* rk = p.in[I_RK] + l * 512; const float* gng = p.in[I_GNG] + l * 512; const float* gnb = p.in[I_GNB] + l * 512;
  for (int g = blockIdx.x * 8 + wid; g < T; g += gridDim.x * 8) {
#pragma unroll 2
    for (int h = 0; h < 8; ++h) {
      size_t i = (size_t)g * 512 + h * 64 + lane;
      float y = bf2f(((const u16*)YB)[i]);
      float mu = wave_sum(y) * (1.f / 64.f);
      float dlt = y - mu;
      float var = wave_sum(dlt * dlt) * (1.f / 64.f);
      float bon = wave_sum(bf2f(((const u16*)RB)[i]) * bf2f(((const u16*)KB)[i]) * rk[h * 64 + lane]);
      float v = dlt * rsqrtf(var + 64e-5f) * gng[h * 64 + lane] + gnb[h * 64 + lane] + bon * bf2f(((const u16*)VB)[i]);
      AO[(size_t)g * 1536 + 1024 + h * 64 + lane] = f2bf(v * bf2f(GB[i]));
    }
  }
}

__device__ __forceinline__ void phase_init(KPR p) {
  const int G = gridDim.x, tid = tidx(), wid = tid >> 6, lane = tid & 63;
  const int gw = blockIdx.x * 8 + wid, nw = G * 8;
  {
    float* X = (float*)(p.ws + W_X); u16* XB = (u16*)(p.ws + W_XB); float* SSQ = (float*)(p.ws + W_SSQ);
    for (int g = gw; g < T; g += nw) {
      const float* src = g < TP ? p.in[I_XP] + (size_t)g * 1024 : p.in[I_XS] + (size_t)(g - TP) * 1024;
      float ss = 0.f;
#pragma unroll
      for (int i = 0; i < 4; ++i) {
        float4 v = *(const float4*)(src + i * 256 + lane * 4);
        *(float4*)(X + (size_t)g * 1024 + i * 256 + lane * 4) = v;
        uint2 w; w.x = pack2(v.x, v.y); w.y = pack2(v.z, v.w);
        *(uint2*)(XB + (size_t)g * 1024 + i * 256 + lane * 4) = w;
        ss += v.x * v.x + v.y * v.y + v.z * v.z + v.w * v.w;
      }
      ss = wave_sum(ss);
      if (lane == 0) *(float4*)(SSQ + (size_t)g * 4) = make_float4(ss, 0.f, 0.f, 0.f);
    }
  }
  {
    u16* MB = (u16*)(p.ws + W_MB);
    for (int g = gw; g < 1024; g += nw) {
      const float* src = p.in[I_MEMP] + (size_t)g * 1024;
      float4 v[4]; float ss = 0.f;
#pragma unroll
      for (int i = 0; i < 4; ++i) { v[i] = *(const float4*)(src + i * 256 + lane * 4); ss += v[i].x * v[i].x + v[i].y * v[i].y + v[i].z * v[i].z + v[i].w * v[i].w; }
      ss = wave_sum(ss);
      float rs = rsqrtf(ss * (1.f / 1024.f) + 1e-6f);
#pragma unroll
      for (int i = 0; i < 4; ++i) {
        uint2 w; w.x = pack2(v[i].x * rs, v[i].y * rs); w.y = pack2(v[i].z * rs, v[i].w * rs);
        *(uint2*)(MB + (size_t)g * 1024 + i * 256 + lane * 4) = w;
      }
    }
  }
  {
    float2* RT = (float2*)(p.ws + W_ROPE);
    for (int e = blockIdx.x * NTHR + tid; e < 4096 * 16; e += G * NTHR) {
      int pos = e >> 4, i = e & 15;
      float inv = powf(10000.f, -(float)i / 16.f);
      float ang = (float)pos * inv;
      float sn, cs; sincosf(ang, &sn, &cs);
      RT[e] = make_float2(cs, sn);
    }
  }
  int rot = 0;
  for (int l = 0; l < NL; ++l) {
    u16* WT = (u16*)(p.ws + W_WT) + (size_t)l * WE_LAYER;
    for (int f = 0; f < 2; ++f) {
      const float* nrm = p.in[f ? I_F2N : I_F1N] + l * 1024;
      const float* wg = p.in[f ? I_F2G : I_F1G] + (size_t)l * 1024 * DFF;
      const float* wu = p.in[f ? I_F2U : I_F1U] + (size_t)l * 1024 * DFF;
      const float* wd = p.in[f ? I_F2D : I_F1D] + (size_t)l * 1024 * DFF;
      tconv(WT + (f ? WE_GU2 : WE_GU1), 1024, 5632, 1024, rot, [=](int k, int n) {
        int j = (n >> 5) * 16 + (n & 15);
        const float* s = ((n >> 4) & 1) ? wu : wg;
        return nrm[k] * s[(size_t)k * DFF + j];
      });
      rot += 88 * 16;
      tconv(WT + (f ? WE_D2 : WE_D1), DFF, 1024, DFF, rot, [=](int k, int n) { return wd[(size_t)k * 1024 + n]; });
      rot += 16 * 44;
    }
    {
      const float* nrm = p.in[I_MIXN] + l * 1024; const float* w = p.in[I_WIN] + (size_t)l * 1024 * DIN;
      tconv(WT + WE_IN, 1024, DINP, 1024, rot, [=](int k, int n) { return n < DIN ? nrm[k] * w[(size_t)k * DIN + n] : 0.f; });
      rot += 36 * 16;
    }
    {
      const float* nrm = p.in[I_QN] + l * 256; const float* wuq = p.in[I_WUQ] + (size_t)l * 256 * 768;
      const float* wuk = p.in[I_WUK] + (size_t)l * 8 * 128 * 64;
      tconv(WT + WE_Q, 256, 1280, 256, rot, [=](int k, int n) {
        float r;
        if (n < 1024) {
          int h = n >> 7, c = n & 127;
          const float* a = wuq + (size_t)k * 768 + h * 96; const float* b = wuk + (size_t)(h * 128 + c) * 64;
          r = 0.f;
          for (int d = 0; d < 64; ++d) r += a[d] * b[d];
        } else {
          int hr = n - 1024;
          r = wuq[(size_t)k * 768 + (hr >> 5) * 96 + 64 + (hr & 31)];
        }
        return r * nrm[k] * QSCALE;
      });
      rot += 20 * 4;
    }
    {
      const float* wup = p.in[I_WUP] + (size_t)l * 64 * 512; const float* aup = p.in[I_AUP] + (size_t)l * 64 * 512;
      const float* gup = p.in[I_GUP] + (size_t)l * 128 * 512;
      tconv(WT + WE_RW, 256, 1536, 256, rot, [=](int k, int n) {
        if (n < 512) return k < 64 ? wup[k * 512 + n] : 0.f;
        if (n < 1024) return (k >= 64 && k < 128) ? aup[(k - 64) * 512 + n - 512] : 0.f;
        return k >= 128 ? gup[(k - 128) * 512 + n - 1024] : 0.f;
      });
      rot += 24 * 4;
    }
    {
      const float* wuv = p.in[I_WUV] + (size_t)l * 8 * 128 * 64; const float* wo = p.in[I_WOUT] + (size_t)l * 1024 * 1024;
      tconv(WT + WE_OUT, 1536, 1024, 1536, rot, [=](int k, int n) {
        if (k < 1024) {
          int h = k >> 7, c = k & 127;
          const float* a = wuv + (size_t)(h * 128 + c) * 64; const float* b = wo + (size_t)(h * 64) * 1024 + n;
          float r = 0.f;
          for (int v = 0; v < 64; ++v) r += a[v] * b[(size_t)v * 1024];
          return r;
        }
        return wo[(size_t)(512 + k - 1024) * 1024 + n];
      });
      rot += 16 * 24;
    }
    {
      const float* nx = p.in[I_XN] + l * 1024; const float* nm = p.in[I_MKVN] + l * 1024;
      const float* wq = p.in[I_WMQ] + (size_t)l * 1048576; const float* wk = p.in[I_WMK] + (size_t)l * 1048576;
      const float* wv = p.in[I_WMV] + (size_t)l * 1048576; const float* wo = p.in[I_WMO] + (size_t)l * 1048576;
      tconv(WT + WE_MQ, 1024, 1024, 1024, rot, [=](int k, int n) { return nx[k] * wq[(size_t)k * 1024 + n] * XSCALE; });
      tconv(WT + WE_MK, 1024, 1024, 1024, rot, [=](int k, int n) { return nm[k] * wk[(size_t)k * 1024 + n]; });
      tconv(WT + WE_MV, 1024, 1024, 1024, rot, [=](int k, int n) { return nm[k] * wv[(size_t)k * 1024 + n]; });
      tconv(WT + WE_MO, 1024, 1024, 1024, rot, [=](int k, int n) { return wo[(size_t)k * 1024 + n]; });
    }
  }
}

__device__ __forceinline__ void phase_prep(KPR p, int l) {
  extern __shared__ __attribute__((aligned(16))) char smem[];
  u16* sv = (u16*)smem;
  const int tid = tidx(), wid = tid >> 6, lane = tid & 63;
  const u16* PROJ = (const u16*)(p.ws + W_PROJ);
  u16* CQB = (u16*)(p.ws + W_CQB); u16* A2 = (u16*)(p.ws + W_A2);
  float* RB = (float*)(p.ws + W_RB); float* KB = (float*)(p.ws + W_KB); float* VB = (float*)(p.ws + W_VB); float* KKB = (float*)(p.ws + W_KKB);
  u16* KP = (u16*)(p.ws + W_KP); u16* KS = (u16*)(p.ws + W_KS); u16* VTP = (u16*)(p.ws + W_VTP); u16* VTS = (u16*)(p.ws + W_VTS);
  const float2* RT = (const float2*)(p.ws + W_ROPE);
  const float* kvn = p.in[I_KVN] + l * 128; const float* mu = p.in[I_MU] + l * DSH; const float* kkw = p.in[I_KK] + l * 512;
  for (int chunk = blockIdx.x; chunk < T / 72; chunk += gridDim.x) {
  __syncthreads();
  uint2 n_cq; unsigned n_ckv; u16 n_k1 = 0, n_k2 = 0; uint4 n_pb0, n_pb1, n_pb2, n_pb3 = make_uint4(0, 0, 0, 0);
  uint4 q_pb0, q_pb1, q_pb2, q_pb3 = make_uint4(0, 0, 0, 0);
#define PREP_LOAD(ROW) do { const u16* pr_ = PROJ + (size_t)(ROW) * DINP; \
    n_cq = *(const uint2*)(pr_ + lane * 4); n_ckv = *(const unsigned*)(pr_ + 256 + lane * 2); \
    if (lane < 16) { n_k1 = pr_[384 + lane]; n_k2 = pr_[400 + lane]; } \
    n_pb0 = *(const uint4*)(pr_ + 416 + lane * 8); n_pb1 = *(const uint4*)(pr_ + 416 + 512 + lane * 8); \
    n_pb2 = *(const uint4*)(pr_ + 416 + 1024 + lane * 8); if (lane < 32) n_pb3 = *(const uint4*)(pr_ + 416 + 1536 + lane * 8); } while (0)
  {
    const int gfirst = chunk * 72 + wid * 9;
    if (gfirst > 0) { PREP_LOAD(gfirst - 1); q_pb0 = n_pb0; q_pb1 = n_pb1; q_pb2 = n_pb2; q_pb3 = n_pb3; }
    else { q_pb0 = q_pb1 = q_pb2 = make_uint4(0, 0, 0, 0); }
    PREP_LOAD(gfirst);
  }
  for (int ri = 0; ri < 9; ++ri) {
    const int rl = wid * 9 + ri, g = chunk * 72 + rl;
    const u16* pr = PROJ + (size_t)g * DINP;
    const uint2 c_cq = n_cq; const unsigned c_ckv = n_ckv; const u16 c_k1 = n_k1, c_k2 = n_k2;
    const uint4 c_pb0 = n_pb0, c_pb1 = n_pb1, c_pb2 = n_pb2, c_pb3 = n_pb3;
    { const int gn = g + 1 < T ? g + 1 : g; PREP_LOAD(gn); }
    const bool isP = g < TP;
    int b, t, pos, tlen;
    if (isP) { b = g >> 12; t = g & 4095; pos = t; tlen = 4096; } else { int gg = g - TP; b = gg >> 6; t = gg & 63; pos = 2048 + t; tlen = 64; }
    {
      uint2 w = c_cq;
      float v0 = bf2f(w.x & 0xffff), v1 = bf2f(w.x >> 16), v2 = bf2f(w.y & 0xffff), v3 = bf2f(w.y >> 16);
      float ss = wave_sum(v0 * v0 + v1 * v1 + v2 * v2 + v3 * v3);
      float rs = rsqrtf(ss * (1.f / 256.f) + 1e-6f);
      uint2 o; o.x = pack2(v0 * rs, v1 * rs); o.y = pack2(v2 * rs, v3 * rs);
      *(uint2*)(CQB + (size_t)g * 256 + lane * 4) = o;
    }
    {
      unsigned w = c_ckv;
      float v0 = bf2f(w & 0xffff), v1 = bf2f(w >> 16);
      float ss = wave_sum(v0 * v0 + v1 * v1);
      float rs = rsqrtf(ss * (1.f / 128.f) + 1e-6f);
      int c = lane * 2;
      v0 = v0 * rs * kvn[c]; v1 = v1 * rs * kvn[c + 1];
      float* of = isP ? p.out + OO_CKVP + ((size_t)(l * 4 + b) * 4096 + t) * 128 : p.out + OO_CKVS + ((size_t)(l * 32 + b) * 64 + t) * 128;
      *(float2*)(of + c) = make_float2(v0, v1);
      u16* kr = isP ? KP + ((size_t)b * 4096 + t) * 160 : KS + ((size_t)b * 2112 + 2048 + t) * 160;
      *(unsigned*)(kr + c) = pack2(v0, v1);
      *(unsigned*)(sv + rl * 128 + c) = pack2(v0, v1);
      if (lane < 16) {
        float x1 = bf2f(c_k1), x2 = bf2f(c_k2);
        float2 cs = RT[pos * 16 + lane];
        float o1 = x1 * cs.x - x2 * cs.y, o2 = x1 * cs.y + x2 * cs.x;
        float* okr = isP ? p.out + OO_KRP + ((size_t)(l * 4 + b) * 4096 + t) * 32 : p.out + OO_KRS + ((size_t)(l * 32 + b) * 64 + t) * 32;
        okr[lane] = o1; okr[lane + 16] = o2;
        kr[128 + lane] = f2bf(o1); kr[144 + lane] = f2bf(o2);
      }
    }
    {
      const u16* pb = pr + 416;
      const u16* pp = pr - DINP + 416;
      const float* sh0 = p.in[I_SSH] + (size_t)(l * 32 + b) * DSH;
      const bool last = (t == tlen - 1);
      float* osh = isP ? p.out + OO_SHP + (size_t)(l * 4 + b) * DSH : p.out + OO_SHS + (size_t)(l * 32 + b) * DSH;
#pragma unroll
      for (int it = 0; it < 4; ++it) {
        const int c = it * 64 + lane;
        if (c < 224) {
          const int e = c * 8;
          const uint4 w = it == 0 ? c_pb0 : (it == 1 ? c_pb1 : (it == 2 ? c_pb2 : c_pb3));
          float pv[8] = {bf2f(w.x & 0xffff), bf2f(w.x >> 16), bf2f(w.y & 0xffff), bf2f(w.y >> 16), bf2f(w.z & 0xffff), bf2f(w.z >> 16), bf2f(w.w & 0xffff), bf2f(w.w >> 16)};
          float pq[8];
          if (t > 0) {
            const uint4 q = it == 0 ? q_pb0 : (it == 1 ? q_pb1 : (it == 2 ? q_pb2 : q_pb3));
            pq[0] = bf2f(q.x & 0xffff); pq[1] = bf2f(q.x >> 16); pq[2] = bf2f(q.y & 0xffff); pq[3] = bf2f(q.y >> 16);
            pq[4] = bf2f(q.z & 0xffff); pq[5] = bf2f(q.z >> 16); pq[6] = bf2f(q.w & 0xffff); pq[7] = bf2f(q.w >> 16);
          } else if (!isP) {
            float4 q0 = *(const float4*)(sh0 + e), q1 = *(const float4*)(sh0 + e + 4);
            pq[0] = q0.x; pq[1] = q0.y; pq[2] = q0.z; pq[3] = q0.w; pq[4] = q1.x; pq[5] = q1.y; pq[6] = q1.z; pq[7] = q1.w;
          } else {
#pragma unroll
            for (int j = 0; j < 8; ++j) pq[j] = 0.f;
          }
          float4 m0 = *(const float4*)(mu + e), m1 = *(const float4*)(mu + e + 4);
          float mm[8] = {m0.x, m0.y, m0.z, m0.w, m1.x, m1.y, m1.z, m1.w};
          float xs[8];
#pragma unroll
          for (int j = 0; j < 8; ++j) xs[j] = pv[j] + mm[j] * (pq[j] - pv[j]);
          if (last) { *(float4*)(osh + e) = make_float4(pv[0], pv[1], pv[2], pv[3]); *(float4*)(osh + e + 4) = make_float4(pv[4], pv[5], pv[6], pv[7]); }
          if (it == 0) {
            *(uint4*)((u16*)RB + (size_t)g * 512 + e) = make_uint4(pack2(xs[0], xs[1]), pack2(xs[2], xs[3]), pack2(xs[4], xs[5]), pack2(xs[6], xs[7]));
          } else if (it == 1) {
            const int cc = e - 512;
            *(uint4*)((u16*)KB + (size_t)g * 512 + cc) = make_uint4(pack2(xs[0], xs[1]), pack2(xs[2], xs[3]), pack2(xs[4], xs[5]), pack2(xs[6], xs[7]));
            float4 k0 = *(const float4*)(kkw + cc), k1 = *(const float4*)(kkw + cc + 4);
            float kk[8] = {xs[0] * k0.x, xs[1] * k0.y, xs[2] * k0.z, xs[3] * k0.w, xs[4] * k1.x, xs[5] * k1.y, xs[6] * k1.z, xs[7] * k1.w};
            float ss = 0.f;
#pragma unroll
            for (int j = 0; j < 8; ++j) ss += kk[j] * kk[j];
            ss = dpp_sum8(ss);
            float rn = rsqrtf(ss + 1e-12f);
            *(uint4*)((u16*)KKB + (size_t)g * 512 + cc) = make_uint4(pack2(kk[0] * rn, kk[1] * rn), pack2(kk[2] * rn, kk[3] * rn), pack2(kk[4] * rn, kk[5] * rn), pack2(kk[6] * rn, kk[7] * rn));
          } else if (it == 2) {
            *(uint4*)((u16*)VB + (size_t)g * 512 + (e - 1024)) = make_uint4(pack2(xs[0], xs[1]), pack2(xs[2], xs[3]), pack2(xs[4], xs[5]), pack2(xs[6], xs[7]));
          } else {
            const int cc = e - 1536;
            float y[8];
#pragma unroll
            for (int j = 0; j < 8; ++j) y[j] = cc < 64 ? (1.f - 2.f / (1.f + __expf(2.f * xs[j]))) : (cc < 128 ? xs[j] : sigmoidf_(xs[j]));
            uint4 o; o.x = pack2(y[0], y[1]); o.y = pack2(y[2], y[3]); o.z = pack2(y[4], y[5]); o.w = pack2(y[6], y[7]);
            *(uint4*)(A2 + (size_t)g * 256 + cc) = o;
          }
        }
      }
    }
    q_pb0 = c_pb0; q_pb1 = c_pb1; q_pb2 = c_pb2; q_pb3 = c_pb3;
  }
#undef PREP_LOAD
  __syncthreads();
  for (int idx = tid; idx < 128 * 9; idx += NTHR) {
    const int d = idx & 127, rl0 = (idx >> 7) * 8, g = chunk * 72 + rl0;
    unsigned w[4];
#pragma unroll
    for (int j = 0; j < 4; ++j) w[j] = (unsigned)sv[(rl0 + 2 * j) * 128 + d] | ((unsigned)sv[(rl0 + 2 * j + 1) * 128 + d] << 16);
    u16* dst;
    if (g < TP) dst = VTP + ((size_t)(g >> 12) * 128 + d) * 4096 + (g & 4095);
    else { const int gg = g - TP; dst = VTS + ((size_t)(gg >> 6) * 128 + d) * 2112 + 2048 + (gg & 63); }
    *(uint4*)dst = make_uint4(w[0], w[1], w[2], w[3]);
  }
  }
}

__device__ __forceinline__ void conv_caches(KPR p, int l, int vb, int nvb) {
  const int tid = tidx();
  u16* KS = (u16*)(p.ws + W_KS); u16* VTS = (u16*)(p.ws + W_VTS);
  {
    const float* cckv = p.in[I_CCKV] + (size_t)l * 32 * 2048 * 128;
    const float* ckr = p.in[I_CKR] + (size_t)l * 32 * 2048 * 32;
    for (int idx = vb * NTHR + tid; idx < 32 * 2048 * 20; idx += nvb * NTHR) {
      int rowi = idx / 20, ch = idx % 20;
      int b = rowi >> 11, t = rowi & 2047;
      const float* s = ch < 16 ? cckv + (size_t)rowi * 128 + ch * 8 : ckr + (size_t)rowi * 32 + (ch - 16) * 8;
      float4 a = *(const float4*)s, c = *(const float4*)(s + 4);
      uint4 o; o.x = pack2(a.x, a.y); o.y = pack2(a.z, a.w); o.z = pack2(c.x, c.y); o.w = pack2(c.z, c.w);
      *(uint4*)(KS + ((size_t)b * 2112 + t) * 160 + ch * 8) = o;
    }
    tconv_v(VTS, 2112, 4096, 2048, vb, nvb, [=](int k, int n) { return cckv[((size_t)(n >> 7) * 2048 + k) * 128 + (n & 127)]; });
    const float* cmk = p.in[I_CMK] + (size_t)l * 32 * 256 * 1024;
    const float* cmv = p.in[I_CMV] + (size_t)l * 32 * 256 * 1024;
    u16* MKS = (u16*)(p.ws + W_MKS); u16* MVTS = (u16*)(p.ws + W_MVTS);
    for (int idx = vb * NTHR + tid; idx < 32 * 4 * 256 * 32; idx += nvb * NTHR) {
      int d8 = idx & 31, m = (idx >> 5) & 255, h = (idx >> 13) & 3, b = idx >> 15;
      const float* s = cmk + ((size_t)(b * 256 + m) * 4 + h) * 256 + d8 * 8;
      float4 a = *(const float4*)s, c = *(const float4*)(s + 4);
      uint4 o; o.x = pack2(a.x, a.y); o.y = pack2(a.z, a.w); o.z = pack2(c.x, c.y); o.w = pack2(c.z, c.w);
      *(uint4*)(MKS + (size_t)idx * 8) = o;
    }
    tconv_v(MVTS, 256, 32768, 256, vb, nvb, [=](int k, int n) { return cmv[((size_t)((n >> 10) * 256 + k) * 4 + ((n >> 8) & 3)) * 256 + (n & 255)]; });
  }
}

__device__ __forceinline__ void mla_sub(KPR p, int b, int c, int half) {
  const u16* QB = (const u16*)(p.ws + W_QB); u16* AO = (u16*)(p.ws + W_AO);
  size_t tok = (size_t)b * 4096 + c * 64 + half * 32;
  attn_item<160, 128, 8>(QB + tok * 1280, 160, 256, (const u16*)(p.ws + W_KP) + (size_t)b * 4096 * 160, 160,
                         (const u16*)(p.ws + W_VTP) + (size_t)b * 128 * 4096, 4096, (c + 1) * 64, AO + tok * 1536, 1536);
}
__device__ __forceinline__ void phase_mix(KPR p, int l, int mode = 0) {
  extern __shared__ __attribute__((aligned(16))) char smem[];
  int* sItem = (int*)(smem + SMEM_ITEM);
  int* cnt = (int*)(p.ws + W_CNT) + l + mode * 8;
  for (;;) {
    __syncthreads();
    if (threadIdx.x == 0) *sItem = atomicAdd(cnt, 1);
    __syncthreads();
    int it = *sItem;
    if (it >= 864) break;
    if (mode == 2 && (it < 32 || it >= 608)) continue;
    if (it < 32) {
      int b = it >> 3, h = it & 7;
      cseq_item(p, b * 4096, h, 64, (b * 8 + h) * 64, nullptr, p.out + OO_WKVP + ((size_t)(l * 4 + b) * 8 + h) * 4096);
    } else if (it < 608) {
      int k = it - 32;
      if (k >= 248 && k < 312) {
        int j = k - 248; int b = j >> 1, half = j & 1;
        const u16* QB = (const u16*)(p.ws + W_QB); u16* AO = (u16*)(p.ws + W_AO);
        size_t tok = (size_t)TP + b * 64 + half * 32;
        attn_item<160, 128, 8>(QB + tok * 1280, 160, 256, (const u16*)(p.ws + W_KS) + (size_t)b * 2112 * 160, 160,
                               (const u16*)(p.ws + W_VTS) + (size_t)b * 128 * 2112, 2112, 2112, AO + tok * 1536, 1536);
      } else {
        if (k >= 312) k -= 64;
        int c = 63 - (k >> 3), b = (k >> 1) & 3, half = k & 1;
        mla_sub(p, b, c, half);
      }
    } else {
      int k = it - 608; int b = k >> 3, h = k & 7;
      cseq_item(p, TP + b * 64, h, 1, 2048 + k, p.in[I_SWKV] + ((size_t)(l * 32 + b) * 8 + h) * 4096,
                p.out + OO_WKVS + ((size_t)(l * 32 + b) * 8 + h) * 4096);
    }
  }
}

__device__ __forceinline__ void xattn_item(KPR p, int l, int it) {
  const u16* QX = (const u16*)(p.ws + W_QX); u16* XO = (u16*)(p.ws + W_XO);
  if (it < 256) {
    int b = it >> 6, h = (it >> 4) & 3, qt = it & 15;
    size_t tok = (size_t)b * 4096 + qt * 256;
    for (int hv = 0; hv < 2; ++hv)
      attn_item<256, 128, 1>(QX + tok * 1024 + h * 256, 1024, 256, (const u16*)(p.ws + W_MKP) + (size_t)((l * 4 + b) * 4 + h) * 65536, 256,
                             (const u16*)(p.ws + W_MVTP) + (size_t)((l * 4 + b) * 4 + h) * 65536 + hv * 128 * 256, 256, 256, XO + tok * 1024 + h * 256 + hv * 128, 1024);
  } else {
    int k = it - 256; int b = k >> 2, h = k & 3;
    size_t tok = (size_t)TP + b * 64;
    for (int hv = 0; hv < 2; ++hv)
      attn_item<256, 128, 1>(QX + tok * 1024 + h * 256, 1024, 64, (const u16*)(p.ws + W_MKS) + (size_t)(b * 4 + h) * 65536, 256,
                             (const u16*)(p.ws + W_MVTS) + (size_t)(b * 4 + h) * 65536 + hv * 128 * 256, 256, 256, XO + tok * 1024 + h * 256 + hv * 128, 1024);
  }
}

constexpr int CH_NST = 10;
__device__ __forceinline__ void phase_chain(KPR p, int ci, int dup = 0) {
  extern __shared__ __attribute__((aligned(16))) char smem[];
  int* sItem = (int*)(smem + SMEM_ITEM);
  int* CT = (int*)(p.ws + W_CNT) + dup * 8192;
  const float rc = dup ? 0.f : 1.f;
  int* q = CT + 3800 + ci; int* xa = CT + 72 + ci; int* oa = CT + 80 + ci;
  int* cnt = CT + 128 + ci * CH_NST * 72;
  int* stamp = CT + 4096 + ci * CH_NST * 72;
  int* G = CT + 8000 + ci; int* xast = CT + 8010 + ci; int* oast = CT + 8020 + ci;
  int lastG = 0;
  const bool hasTail = ci >= 1, hasHead = ci < NL;
  const int lt = ci - 1, lh = ci;
  const int e0 = hasTail ? 288 : 0, e1 = e0 + (hasTail ? 288 : 0), e2 = e1 + (hasTail ? 384 : 0), e3 = e2 + (hasTail ? 288 : 0),
            e4 = e3 + (hasTail ? 792 : 0), e5 = e4 + (hasTail ? 288 : 0), e6 = e5 + (hasHead ? 792 : 0), e7 = e6 + (hasHead ? 288 : 0),
            e8 = e7 + (hasHead ? 224 : 0), e9 = e8 + (hasHead ? 648 : 0);
  float* X = (float*)(p.ws + W_X); u16* XB = (u16*)(p.ws + W_XB); float* SSQ = (float*)(p.ws + W_SSQ); u16* ACT = (u16*)(p.ws + W_ACT);
  const int grp = blockIdx.x & 7;
  int nxt = 0;
  if (tidx() == 0) nxt = atomicAdd(q + grp * 8, 1) * 8 + grp;
  for (;;) {
    const int tid = tidx();
    if (tid == 0) {
      const int it = nxt;
      if (it < e9) {
        int st, idx;
        if (it < e0) { st = 0; idx = it; } else if (it < e1) { st = 1; idx = it - e0; } else if (it < e2) { st = 2; idx = it - e1; }
        else if (it < e3) { st = 3; idx = it - e2; } else if (it < e4) { st = 4; idx = it - e3; } else if (it < e5) { st = 5; idx = it - e4; }
        else if (it < e6) { st = 6; idx = it - e5; } else if (it < e7) { st = 7; idx = it - e6; } else if (it < e8) { st = 8; idx = it - e7; }
        else { st = 9; idx = it - e8; }
        int pm = 0, pn = 0;
        if (st == 2) pm = idx < 256 ? ((idx >> 6) * 16 + (idx & 15)) : (64 + ((idx - 256) >> 4));
        else if (st != 8) tile_map(idx, 72, (st == 4 || st == 6) ? 11 : (st == 9 ? 9 : 4), pm, pn);
        const int* c1 = nullptr; const int* c2 = nullptr;
        switch (st) {
          case 1: c1 = stamp + 0 * 72 + pm; break;
          case 2: c1 = stamp + 1 * 72 + pm; break;
          case 3: c1 = stamp + 2 * 72 + pm; break;
          case 4: c1 = stamp + 3 * 72 + pm; c2 = xast; break;
          case 5: c1 = stamp + 4 * 72 + pm; break;
          case 6: if (hasTail) c1 = stamp + 5 * 72 + pm; break;
          case 7: c1 = stamp + 6 * 72 + pm; break;
          case 8: if (hasTail) c1 = xast; break;
          case 9: c1 = stamp + 7 * 72 + pm; if (hasTail) c2 = oast; break;
          default: break;
        }
        if (dup) { c1 = nullptr; c2 = nullptr; }
        int s1 = 0, s2 = 0;
        if (c1) while ((s1 = __hip_atomic_load(c1, __ATOMIC_RELAXED, __HIP_MEMORY_SCOPE_AGENT)) == 0) __builtin_amdgcn_s_sleep(4);
        if (c2) while ((s2 = __hip_atomic_load(c2, __ATOMIC_RELAXED, __HIP_MEMORY_SCOPE_AGENT)) == 0) __builtin_amdgcn_s_sleep(4);
        if ((s1 > s2 ? s1 : s2) >= lastG) {
          const int g = __hip_atomic_load(G, __ATOMIC_RELAXED, __HIP_MEMORY_SCOPE_AGENT);
          __builtin_amdgcn_fence(__ATOMIC_ACQUIRE, "agent");
          asm volatile("s_waitcnt vmcnt(0)" ::: "memory");
          lastG = g;
        }
        sItem[1] = st; sItem[2] = idx; sItem[3] = pm; sItem[4] = pn;
      }
      sItem[0] = it;
    }
    __syncthreads();
    if (sItem[0] >= e9) break;
    const int st = sItem[1], idx = sItem[2], pm = sItem[3], pn = sItem[4];
    if (tid == 0) nxt = atomicAdd(q + grp * 8, 1) * 8 + grp;
    if (dup && !((PROBE_MASK >> st) & 1)) { __syncthreads(); continue; }
    const u16* WTt = (const u16*)(p.ws + W_WT) + (size_t)(lt < 0 ? 0 : lt) * WE_LAYER;
    const u16* WTh = (const u16*)(p.ws + W_WT) + (size_t)(lh >= NL ? 0 : lh) * WE_LAYER;
    switch (st) {
      case 0: gemm_tile((const u16*)(p.ws + W_AO), WTt + WE_OUT, 1536, pm, pn, EpiRes{X, XB, SSQ, rc}); break;
      case 1: gemm_tile(XB, WTt + WE_MQ, 1024, pm, pn, EpiScaleBf{SSQ, (u16*)(p.ws + W_QX), 1024}); break;
      case 2: xattn_item(p, lt, idx); break;
      case 3: gemm_tile((const u16*)(p.ws + W_XO), WTt + WE_MO, 1024, pm, pn, EpiRes{X, XB, SSQ, rc}); break;
      case 4: gemm_tile(XB, WTt + WE_GU2, 1024, pm, 2 * pn, EpiGU{SSQ, ACT}); gemm_tile(XB, WTt + WE_GU2, 1024, pm, 2 * pn + 1, EpiGU{SSQ, ACT}); break;
      case 5: gemm_tile(ACT, WTt + WE_D2, DFF, pm, pn, EpiRes{X, XB, SSQ, 0.5f * rc}); break;
      case 6: gemm_tile(XB, WTh + WE_GU1, 1024, pm, 2 * pn, EpiGU{SSQ, ACT}); gemm_tile(XB, WTh + WE_GU1, 1024, pm, 2 * pn + 1, EpiGU{SSQ, ACT}); break;
      case 7: gemm_tile(ACT, WTh + WE_D1, DFF, pm, pn, EpiRes{X, XB, SSQ, 0.5f * rc}); break;
      case 8: conv_caches(p, lh, idx, 224); break;
      default: gemm_tile(XB, WTh + WE_IN, 1024, pm, pn, EpiScaleBf{SSQ, (u16*)(p.ws + W_PROJ), DINP}); break;
    }
    asm volatile("s_waitcnt vmcnt(0)" ::: "memory");
    __syncthreads();
    if (tidx() == 64) {
      __builtin_amdgcn_fence(__ATOMIC_RELEASE, "agent");
      asm volatile("s_waitcnt vmcnt(0)" ::: "memory");
      atomicAdd(G, 1);
      const int full = (st == 4 || st == 6) ? 11 : (st == 9 ? 9 : (st == 2 ? (pm < 64 ? 4 : 16) : 4));
      if (atomicAdd(cnt + st * 72 + pm, 1) + 1 == full)
        __hip_atomic_store(stamp + st * 72 + pm, __hip_atomic_load(G, __ATOMIC_RELAXED, __HIP_MEMORY_SCOPE_AGENT), __ATOMIC_RELAXED, __HIP_MEMORY_SCOPE_AGENT);
      if (st == 2 && atomicAdd(xa, 1) + 1 == 384)
        __hip_atomic_store(xast, __hip_atomic_load(G, __ATOMIC_RELAXED, __HIP_MEMORY_SCOPE_AGENT), __ATOMIC_RELAXED, __HIP_MEMORY_SCOPE_AGENT);
      if (st == 0 && atomicAdd(oa, 1) + 1 == 288)
        __hip_atomic_store(oast, __hip_atomic_load(G, __ATOMIC_RELAXED, __HIP_MEMORY_SCOPE_AGENT), __ATOMIC_RELAXED, __HIP_MEMORY_SCOPE_AGENT);
    }
  }
}

__device__ __forceinline__ void phase_final(KPR p) {
  const int tid = tidx(), wid = tid >> 6, lane = tid & 63;
  const float* X = (const float*)(p.ws + W_X); const float* fn = p.in[I_FN];
  for (int g = blockIdx.x * 8 + wid; g < T; g += gridDim.x * 8) {
    float4 v[4]; float ss = 0.f;
#pragma unroll
    for (int i = 0; i < 4; ++i) { v[i] = *(const float4*)(X + (size_t)g * 1024 + i * 256 + lane * 4); ss += v[i].x * v[i].x + v[i].y * v[i].y + v[i].z * v[i].z + v[i].w * v[i].w; }
    ss = wave_sum(ss);
    float rs = rsqrtf(ss * (1.f / 1024.f) + 1e-6f);
#pragma unroll
    for (int i = 0; i < 4; ++i) {
      float4 gn = *(const float4*)(fn + i * 256 + lane * 4);
      *(float4*)(p.out + OO_Y + (size_t)g * 1024 + i * 256 + lane * 4) = make_float4(v[i].x * rs * gn.x, v[i].y * rs * gn.y, v[i].z * rs * gn.z, v[i].w * rs * gn.w);
    }
  }
}

constexpr int NPL = 6;
constexpr int N_PHASES = 3 + NPL * NL + 1;

__device__ __forceinline__ void run_phase(KPR p, int ph) {
  if (ph == 0) { phase_init(p); return; }
  if (ph == 1) {
    for (int l = 0; l < NL; ++l) {
      const u16* WT = (const u16*)(p.ws + W_WT) + (size_t)l * WE_LAYER;
      gemm_phase((const u16*)(p.ws + W_MB), WT + WE_MK, 1024, 4, 4, (2 * l) * 16,
                 EpiMem<false>{p.out + OO_MKP + (size_t)l * 1048576, (u16*)(p.ws + W_MKP) + (size_t)l * 16 * 65536});
      gemm_phase((const u16*)(p.ws + W_MB), WT + WE_MV, 1024, 4, 4, (2 * l + 1) * 16,
                 EpiMem<true>{p.out + OO_MVP + (size_t)l * 1048576, (u16*)(p.ws + W_MVTP) + (size_t)l * 16 * 65536});
    }
    return;
  }
  if (ph == 2) { phase_chain(p, 0); if (PROBE_REP & 1) { cg::this_grid().sync(); phase_chain(p, 0, 1); } return; }
  if (ph == N_PHASES - 1) { if (PROBE_REP & 64) for (int i = 0; i < 40; ++i) cg::this_grid().sync(); phase_final(p); return; }
  const int l = (ph - 3) / NPL, s = (ph - 3) % NPL;
  const u16* WT = (const u16*)(p.ws + W_WT) + (size_t)l * WE_LAYER;
  switch (s) {
    case 0: phase_prep(p, l); if (PROBE_REP & 2) { cg::this_grid().sync(); phase_prep(p, l); } break;
    case 1:
      gemm_phase((const u16*)(p.ws + W_CQB), WT + WE_Q, 256, 72, 5, 0, EpiQ{(u16*)(p.ws + W_QB), (const float2*)(p.ws + W_ROPE)});
      gemm_phase((const u16*)(p.ws + W_A2), WT + WE_RW, 256, 72, 6, 360,
                 EpiRW{p.in[I_W0] + l * 512, p.in[I_A0] + l * 512, p.in[I_KA] + l * 512, p.ws});
      break;
    case 2: phase_cprep(p); if (PROBE_REP & 8) { cg::this_grid().sync(); phase_cprep(p); } break;
    case 3: phase_mix(p, l, 0); if (PROBE_REP & 16) { cg::this_grid().sync(); phase_mix(p, l, 2); } break;
    case 4: phase_yfin(p, l); if (PROBE_REP & 32) { cg::this_grid().sync(); phase_yfin(p, l); } break;
    default: phase_chain(p, l + 1); if (PROBE_REP & 1) { cg::this_grid().sync(); phase_chain(p, l + 1, 1); } break;
  }
}

__device__ __forceinline__ void grid_barrier(int* CT, int gen) {
  asm volatile("s_waitcnt vmcnt(0)" ::: "memory");
  __syncthreads();
  if (tidx() == 0) {
    __builtin_amdgcn_fence(__ATOMIC_RELEASE, "agent");
    asm volatile("s_waitcnt vmcnt(0)" ::: "memory");
    int* grpc = CT + 15000 + (blockIdx.x & 7) * 32;
    int* glob = CT + 15000 + 8 * 32;
    const int per = gridDim.x >> 3;
    if (atomicAdd(grpc, 1) + 1 == per * (gen + 1)) atomicAdd(glob, 1);
    while (__hip_atomic_load(glob, __ATOMIC_RELAXED, __HIP_MEMORY_SCOPE_AGENT) < 8 * (gen + 1)) __builtin_amdgcn_s_sleep(1);
    __builtin_amdgcn_fence(__ATOMIC_ACQUIRE, "agent");
    asm volatile("s_waitcnt vmcnt(0)" ::: "memory");
  }
  __syncthreads();
}

__global__ void __launch_bounds__(NTHR) mega(Params p) {
  cg::grid_group grid = cg::this_grid();
  for (int ph = p.ph_lo; ph < p.ph_hi; ++ph) {
    const __attribute__((address_space(4))) Params* q = (const __attribute__((address_space(4))) Params*)__builtin_amdgcn_kernarg_segment_ptr();
    asm volatile("" : "+s"(q));
    run_phase(*q, ph);
    if (ph + 1 < p.ph_hi) {
      if (ph == p.ph_lo) grid.sync();
      else grid_barrier((int*)(q->ws + W_CNT), ph - p.ph_lo - 1);
    }
  }
}

extern "C" void kernel_launch(void* const* d_in, const int* in_sizes, int n_in, void* d_out, int out_size, void* d_ws,
                              size_t ws_size, hipStream_t stream) {
  static int grid = 0;
  if (grid == 0) {
    if (n_in != N_IN || (size_t)out_size != OO_END || ws_size < W_END) {
      fprintf(stderr, "kernel_launch: unexpected shapes n_in=%d out=%d ws=%zu (need %zu)\n", n_in, out_size, ws_size, (size_t)W_END);
      grid = -1; return;
    }
    int dev = 0, cus = 0, per_cu = 0;
    hipGetDevice(&dev);
    hipDeviceGetAttribute(&cus, hipDeviceAttributeMultiprocessorCount, dev);
    hipFuncSetAttribute((const void*)mega, hipFuncAttributeMaxDynamicSharedMemorySize, SMEM_BYTES);
    hipOccupancyMaxActiveBlocksPerMultiprocessor(&per_cu, (const void*)mega, NTHR, SMEM_BYTES);
    if (per_cu < 1) { fprintf(stderr, "kernel_launch: occupancy query says %d blocks/CU\n", per_cu); per_cu = 1; }
    (void)hipGetLastError();
    grid = cus;
  }
  if (grid < 0) return;
  if (hipMemsetAsync((char*)d_ws + W_CNT, 0, 65536, stream) != hipSuccess) { fprintf(stderr, "kernel_launch: memset of control words failed\n"); return; }
  Params p{};
  for (int i = 0; i < N_IN; ++i) p.in[i] = (const float*)d_in[i];
  p.out = (float*)d_out; p.ws = (char*)d_ws;
#if N_LAUNCH_PER_PHASE
  for (int ph = 0; ph < N_PHASES; ++ph) {
    p.ph_lo = ph; p.ph_hi = ph + 1;
    void* args[] = {&p};
    hipError_t e = hipLaunchCooperativeKernel((const void*)mega, dim3(grid), dim3(NTHR), args, SMEM_BYTES, stream);
    if (e != hipSuccess) { fprintf(stderr, "launch failed: %s\n", hipGetErrorString(e)); break; }
  }
#else
  p.ph_lo = 0; p.ph_hi = N_PHASES;
  void* args[] = {&p};
  hipError_t e = hipLaunchCooperativeKernel((const void*)mega, dim3(grid), dim3(NTHR), args, SMEM_BYTES, stream);
  if (e != hipSuccess) fprintf(stderr, "cooperative launch failed: %s (grid %d)\n", hipGetErrorString(e), grid);
#endif
}
```

```cpp
#include <hip/hip_runtime.h>
#include <hip/hip_cooperative_groups.h>
#include <stdint.h>
#include <stdio.h>
namespace cg = cooperative_groups;

typedef unsigned short u16;
using bf16x8 = __attribute__((ext_vector_type(8))) short;
using f32x4 = __attribute__((ext_vector_type(4))) float;
using f32x16 = __attribute__((ext_vector_type(16))) float;

#ifndef REP_WHICH
#define REP_WHICH 0
#endif
#ifndef PROBE_REP
#define PROBE_REP 0
#endif
#ifndef PROBE_MASK
#define PROBE_MASK 0x3ff
#endif
#ifndef N_LAUNCH_PER_PHASE
#define N_LAUNCH_PER_PHASE 0
#endif

constexpr int TP = 16384, TS = 2048, T = TP + TS, NL = 4;
constexpr int DFF = 2816, DIN = 2208, DINP = 2304, DSH = 1792;
constexpr int NTHR = 512;
constexpr int SMEM_BYTES = 139264 + 2048;
constexpr int SMEM_ITEM = 139264 + 1024;
constexpr float QSCALE = 0.10206207261596577f * 1.4426950408889634f;
constexpr float XSCALE = 0.0625f * 1.4426950408889634f;

constexpr size_t OO_Y = 0;
constexpr size_t OO_CKVP = OO_Y + (size_t)T * 1024;
constexpr size_t OO_KRP = OO_CKVP + (size_t)NL * 4 * 4096 * 128;
constexpr size_t OO_MKP = OO_KRP + (size_t)NL * 4 * 4096 * 32;
constexpr size_t OO_MVP = OO_MKP + (size_t)NL * 4 * 256 * 1024;
constexpr size_t OO_WKVP = OO_MVP + (size_t)NL * 4 * 256 * 1024;
constexpr size_t OO_SHP = OO_WKVP + (size_t)NL * 4 * 8 * 4096;
constexpr size_t OO_CKVS = OO_SHP + (size_t)NL * 4 * DSH;
constexpr size_t OO_KRS = OO_CKVS + (size_t)NL * 32 * 64 * 128;
constexpr size_t OO_WKVS = OO_KRS + (size_t)NL * 32 * 64 * 32;
constexpr size_t OO_SHS = OO_WKVS + (size_t)NL * 32 * 8 * 4096;
constexpr size_t OO_END = OO_SHS + (size_t)NL * 32 * DSH;

constexpr size_t al256(size_t x) { return (x + 255) & ~(size_t)255; }
constexpr size_t W_X = 0;
constexpr size_t W_XB = W_X + al256((size_t)T * 1024 * 4);
constexpr size_t W_SSQ = W_XB + al256((size_t)T * 1024 * 2);
constexpr size_t W_ACT = W_SSQ + al256((size_t)T * 4 * 4);
constexpr size_t W_WB = W_ACT;
constexpr size_t W_BB = W_WB + al256((size_t)T * 512 * 4);
constexpr size_t W_GB = W_BB + al256((size_t)T * 512 * 4);
constexpr size_t W_QX = W_ACT;
constexpr size_t W_PROJ = W_ACT + al256((size_t)T * DFF * 2);
constexpr size_t W_AO = W_PROJ;
constexpr size_t W_CQB = W_PROJ + al256((size_t)T * DINP * 2);
constexpr size_t W_A2 = W_CQB + al256((size_t)T * 256 * 2);
constexpr size_t W_QB = W_A2 + al256((size_t)T * 256 * 2);
constexpr size_t W_XO = W_QB;
constexpr size_t W_RB = W_QB + al256((size_t)T * 1280 * 2);
constexpr size_t W_KB = W_RB + al256((size_t)T * 512 * 4);
constexpr size_t W_VB = W_KB + al256((size_t)T * 512 * 4);
constexpr size_t W_KKB = W_VB + al256((size_t)T * 512 * 4);
constexpr size_t W_KP = W_KKB + al256((size_t)T * 512 * 4);
constexpr size_t W_KS = W_KP + al256((size_t)4 * 4096 * 160 * 2);
constexpr size_t W_VTP = W_KS + al256((size_t)32 * 2112 * 160 * 2);
constexpr size_t W_VTS = W_VTP + al256((size_t)4 * 128 * 4096 * 2);
constexpr size_t W_MKP = W_VTS + al256((size_t)32 * 128 * 2112 * 2);
constexpr size_t W_MVTP = W_MKP + al256((size_t)NL * 16 * 65536 * 2);
constexpr size_t W_MKS = W_MVTP + al256((size_t)NL * 16 * 65536 * 2);
constexpr size_t W_MVTS = W_MKS + al256((size_t)128 * 65536 * 2);
constexpr size_t W_MB = W_MVTS + al256((size_t)128 * 65536 * 2);
constexpr size_t W_ROPE = W_MB + al256((size_t)1024 * 1024 * 2);
constexpr size_t W_CNT = W_ROPE + al256((size_t)4096 * 16 * 8);
constexpr size_t W_YB = W_CNT + 65536;
constexpr size_t W_CQ = W_YB + al256((size_t)T * 512 * 4);
constexpr size_t W_WT = W_CQ + al256((size_t)2304 * 4096 * 4);
constexpr size_t W_CRR = W_PROJ + al256((size_t)T * 1536 * 2);
constexpr size_t W_CPT = W_CQB;
static_assert(W_CRR + (size_t)2304 * 4096 * 2 <= W_CQB, "RRt must fit behind AO");
static_assert((size_t)2304 * 4096 * 2 <= 2 * al256((size_t)T * 256 * 2), "Pt must fit in CQB+A2");
constexpr size_t WE_GU1 = 0;
constexpr size_t WE_D1 = WE_GU1 + (size_t)5632 * 1024;
constexpr size_t WE_IN = WE_D1 + (size_t)1024 * DFF;
constexpr size_t WE_Q = WE_IN + (size_t)DINP * 1024;
constexpr size_t WE_RW = WE_Q + (size_t)1280 * 256;
constexpr size_t WE_OUT = WE_RW + (size_t)1536 * 256;
constexpr size_t WE_MQ = WE_OUT + (size_t)1024 * 1536;
constexpr size_t WE_MK = WE_MQ + (size_t)1024 * 1024;
constexpr size_t WE_MV = WE_MK + (size_t)1024 * 1024;
constexpr size_t WE_MO = WE_MV + (size_t)1024 * 1024;
constexpr size_t WE_GU2 = WE_MO + (size_t)1024 * 1024;
constexpr size_t WE_D2 = WE_GU2 + (size_t)5632 * 1024;
constexpr size_t WE_LAYER = WE_D2 + (size_t)1024 * DFF;
constexpr size_t W_END = W_WT + al256(WE_LAYER * NL * 2);

enum { I_XP = 0, I_XS, I_MEMP, I_CCKV, I_CKR, I_CMK, I_CMV, I_SWKV, I_SSH, I_F1N, I_F1G, I_F1U, I_F1D, I_MIXN, I_WIN,
       I_QN, I_WUQ, I_KVN, I_WUK, I_WUV, I_MU, I_W0, I_WUP, I_A0, I_AUP, I_GUP, I_KK, I_KA, I_RK, I_GNG, I_GNB, I_WOUT,
       I_XN, I_MKVN, I_WMQ, I_WMK, I_WMV, I_WMO, I_F2N, I_F2G, I_F2U, I_F2D, I_FN, N_IN };

struct Params {
  const float* in[N_IN];
  float* out;
  char* ws;
  int ph_lo, ph_hi;
};

typedef const __attribute__((address_space(4))) Params& KPR;

typedef __bf16 bf2_t __attribute__((ext_vector_type(2)));
typedef float f2_t __attribute__((ext_vector_type(2)));
__device__ __forceinline__ u16 f2bf(float f) { __bf16 b = (__bf16)f; return __builtin_bit_cast(u16, b); }
__device__ __forceinline__ float bf2f(u16 h) { return __uint_as_float(((unsigned)h) << 16); }
__device__ __forceinline__ unsigned pack2(float a, float b) { f2_t v = {a, b}; bf2_t r = __builtin_convertvector(v, bf2_t); return __builtin_bit_cast(unsigned, r); }
__device__ __forceinline__ float4 bf4(uint2 w) {
  return make_float4(__uint_as_float(w.x << 16), __uint_as_float(w.x & 0xffff0000u), __uint_as_float(w.y << 16), __uint_as_float(w.y & 0xffff0000u));
}
__device__ __forceinline__ float wave_sum(float x) {
  x += __int_as_float(__builtin_amdgcn_update_dpp(0, __float_as_int(x), 0xB1, 0xF, 0xF, false));
  x += __int_as_float(__builtin_amdgcn_update_dpp(0, __float_as_int(x), 0x4E, 0xF, 0xF, false));
  x += __int_as_float(__builtin_amdgcn_update_dpp(0, __float_as_int(x), 0x141, 0xF, 0xF, false));
  x += __int_as_float(__builtin_amdgcn_update_dpp(0, __float_as_int(x), 0x140, 0xF, 0xF, false));
  const float s0 = __int_as_float(__builtin_amdgcn_readlane(__float_as_int(x), 0)), s1 = __int_as_float(__builtin_amdgcn_readlane(__float_as_int(x), 16));
  const float s2 = __int_as_float(__builtin_amdgcn_readlane(__float_as_int(x), 32)), s3 = __int_as_float(__builtin_amdgcn_readlane(__float_as_int(x), 48));
  return (s0 + s1) + (s2 + s3);
}
__device__ __forceinline__ float dpp_sum8(float x) {
  x += __int_as_float(__builtin_amdgcn_update_dpp(0, __float_as_int(x), 0xB1, 0xF, 0xF, false));
  x += __int_as_float(__builtin_amdgcn_update_dpp(0, __float_as_int(x), 0x4E, 0xF, 0xF, false));
  x += __int_as_float(__builtin_amdgcn_update_dpp(0, __float_as_int(x), 0x141, 0xF, 0xF, false));
  return x;
}
__device__ __forceinline__ int tidx() { int t = threadIdx.x; asm volatile("" : "+v"(t)); return t; }
__device__ __forceinline__ float fma_s(float a, float b, float c) { float d; asm("v_fma_f32 %0, %1, %2, %3" : "=v"(d) : "v"(a), "v"(b), "v"(c)); return d; }
__device__ __forceinline__ float sub_s(float a, float b) { float d; asm("v_sub_f32 %0, %1, %2" : "=v"(d) : "v"(a), "v"(b)); return d; }
__device__ __forceinline__ float add_s(float a, float b) { float d; asm("v_add_f32 %0, %1, %2" : "=v"(d) : "v"(a), "v"(b)); return d; }
__device__ __forceinline__ float mul_s(float a, float b) { float d; asm("v_mul_f32 %0, %1, %2" : "=v"(d) : "v"(a), "v"(b)); return d; }
__device__ __forceinline__ float sigmoidf_(float x) { return 1.f / (1.f + __expf(-x)); }

constexpr int BM = 256, BK = 64, HALF = 128, HT = HALF * BK;

__device__ __forceinline__ int lds_byte(int r, int c) {
  int st = (r >> 4) * 2 + (c >> 5), rr = r & 15, cc = c & 31, ob = rr * 64 + cc * 2;
  return st * 1024 + (ob ^ (((ob >> 9) & 1) << 5));
}
__device__ __forceinline__ void stage_rc(int b, int& R, int& C) {
  int st = b / 1024, sb = b % 1024, swz = sb ^ (((sb >> 9) & 1) << 5);
  R = (st >> 1) * 16 + swz / 64; C = (st & 1) * 32 + (swz % 64) / 2;
}

__device__ __forceinline__ void tile_map(int tile, int nM, int nN, int& pm, int& pn) {
  const int ntiles = nM * nN;
  int wgid = tile;
  { int q = ntiles / 8, r = ntiles % 8, xcd = wgid % 8, off = wgid / 8;
    wgid = (xcd < r ? xcd * (q + 1) : r * (q + 1) + (xcd - r) * q) + off; }
  int nig = 8 * nN, gid = wgid / nig, fm = gid * 8, gsz = min(nM - fm, 8);
  pm = fm + ((wgid % nig) % gsz); pn = (wgid % nig) / gsz;
}

template <class Epi>
__device__ __forceinline__ void gemm_tile(const u16* __restrict__ A, const u16* __restrict__ Bt, const int K,
                                          const int pm, const int pn, Epi epi) {
  extern __shared__ __attribute__((aligned(16))) char smem[];
  u16* shm = (u16*)smem;
#define SA(b, h) (shm + ((b) * 2 + (h)) * HT)
#define SB(b, h) (shm + (4 + (b) * 2 + (h)) * HT)
#define STAGE(P, BASE, br, kt) do { const u16* _gb = BASE + ((long)(br) * K + (long)(kt) * BK); \
    __builtin_amdgcn_global_load_lds((const unsigned*)((const char*)_gb + so0), \
        (__attribute__((address_space(3))) unsigned*)((char*)(P) + wu16), 16, 0, 0); \
    __builtin_amdgcn_global_load_lds((const unsigned*)((const char*)_gb + so1), \
        (__attribute__((address_space(3))) unsigned*)((char*)(P) + wu16 + 8192), 16, 0, 0); } while (0)
#define LDA(dst, b, h) for (int m = 0; m < 4; ++m) for (int k = 0; k < 2; ++k) \
    dst[m][k] = *reinterpret_cast<const bf16x8*>((char*)SA(b, h) + lds_byte(wr * 64 + m * 16 + fr, k * 32 + fq * 8))
#define LDB(dst, b, h) for (int n = 0; n < 2; ++n) for (int k = 0; k < 2; ++k) \
    dst[n][k] = *reinterpret_cast<const bf16x8*>((char*)SB(b, h) + lds_byte(wc * 32 + n * 16 + fr, k * 32 + fq * 8))
#define MMA(ai, bj, At_, Bt_) do { __builtin_amdgcn_s_setprio(1); \
    for (int m = 0; m < 4; ++m) for (int n = 0; n < 2; ++n) for (int k = 0; k < 2; ++k) \
      acc[ai][bj][m][n] = __builtin_amdgcn_mfma_f32_16x16x32_bf16(At_[m][k], Bt_[n][k], acc[ai][bj][m][n], 0, 0, 0); \
    __builtin_amdgcn_s_setprio(0); } while (0)
#define WAIT_V(n) asm volatile("s_waitcnt vmcnt(" #n ")" ::: "memory")
#define WAIT_L(n) asm volatile("s_waitcnt lgkmcnt(" #n ")" ::: "memory")
#define BAR __builtin_amdgcn_s_barrier()
#define SCHED __builtin_amdgcn_sched_barrier(0)
  const int tid_ = tidx();
  const int wid = tid_ >> 6, lane = tid_ & 63, wr = wid >> 2, wc = wid & 3, fr = lane & 15, fq = lane >> 4;
  const int nt = K / BK;
  const int wu16 = __builtin_amdgcn_readfirstlane(tid_ >> 6) * 1024;
  {
    unsigned so0, so1;
    { int _r, _c; stage_rc(tid_ * 16, _r, _c); so0 = (unsigned)(_r * K + _c) * 2u;
      stage_rc(tid_ * 16 + 8192, _r, _c); so1 = (unsigned)(_r * K + _c) * 2u; }
    const int brow = pm * BM, bcol = pn * BM;
    f32x4 acc[2][2][4][2] = {};
    bf16x8 At[4][2], B0[2][2], B1[2][2];
    STAGE(SB(0, 0), Bt, bcol, 0); STAGE(SA(0, 0), A, brow, 0);
    STAGE(SB(0, 1), Bt, bcol + HALF, 0); STAGE(SA(0, 1), A, brow + HALF, 0);
    if (wr == 1) BAR;
    WAIT_V(4); BAR;
    STAGE(SB(1, 0), Bt, bcol, 1); STAGE(SA(1, 0), A, brow, 1); STAGE(SB(1, 1), Bt, bcol + HALF, 1);
    WAIT_V(6); BAR;
    for (int t = 0; t < nt - 2; t += 2) {
      LDB(B0, 0, 0); SCHED; LDA(At, 0, 0); STAGE(SA(1, 1), A, brow + HALF, t + 1);
      WAIT_L(8); BAR; WAIT_L(0); MMA(0, 0, At, B0); BAR; SCHED;
      LDB(B1, 0, 1); STAGE(SB(0, 0), Bt, bcol, t + 2);
      BAR; WAIT_L(0); MMA(0, 1, At, B1); BAR;
      LDA(At, 0, 1); STAGE(SA(0, 0), A, brow, t + 2);
      BAR; WAIT_L(0); MMA(1, 0, At, B0); BAR; SCHED;
      STAGE(SB(0, 1), Bt, bcol + HALF, t + 2);
      WAIT_V(6); BAR; MMA(1, 1, At, B1); BAR;
      LDB(B0, 1, 0); SCHED; LDA(At, 1, 0); STAGE(SA(0, 1), A, brow + HALF, t + 2);
      WAIT_L(8); BAR; WAIT_L(0); MMA(0, 0, At, B0); BAR; SCHED;
      LDB(B1, 1, 1); STAGE(SB(1, 0), Bt, bcol, t + 3);
      BAR; WAIT_L(0); MMA(0, 1, At, B1); BAR;
      LDA(At, 1, 1); STAGE(SA(1, 0), A, brow, t + 3);
      BAR; WAIT_L(0); MMA(1, 0, At, B0); BAR; SCHED;
      STAGE(SB(1, 1), Bt, bcol + HALF, t + 3);
      WAIT_V(6); BAR; MMA(1, 1, At, B1); BAR;
    }
    { LDB(B0, 0, 0); LDA(At, 0, 0); STAGE(SA(1, 1), A, brow + HALF, nt - 1);
      BAR; WAIT_L(0); MMA(0, 0, At, B0); BAR;
      LDB(B1, 0, 1); BAR; WAIT_L(0); MMA(0, 1, At, B1); BAR;
      LDA(At, 0, 1); WAIT_V(4); BAR; WAIT_L(0); MMA(1, 0, At, B0); MMA(1, 1, At, B1); BAR; }
    { LDB(B0, 1, 0); LDA(At, 1, 0); WAIT_V(2); BAR; WAIT_L(0); MMA(0, 0, At, B0); BAR;
      LDB(B1, 1, 1); WAIT_V(0); BAR; WAIT_L(0); MMA(0, 1, At, B1); BAR;
      LDA(At, 1, 1); BAR; WAIT_L(0); MMA(1, 0, At, B0); MMA(1, 1, At, B1); BAR; }
    if (wr == 0) BAR;
    float* stg = (float*)smem;
    int tx = tid_;
    asm volatile("" : "+v"(tx));
    const int ewr = tx >> 8, ewc = (tx >> 6) & 3, efr = tx & 15, efq = (tx >> 4) & 3;
#define EPI_HALF(ai) do { \
    __syncthreads(); \
    _Pragma("unroll") for (int bj = 0; bj < 2; ++bj) _Pragma("unroll") for (int m = 0; m < 4; ++m) \
    _Pragma("unroll") for (int n = 0; n < 2; ++n) _Pragma("unroll") for (int j = 0; j < 4; ++j) \
      stg[(ewr * 64 + m * 16 + efq * 4 + j) * 260 + bj * HALF + ewc * 32 + n * 16 + efr] = acc[ai][bj][m][n][j]; \
    __syncthreads(); \
    for (int i = 0; i < 8; ++i) { \
      int item = i * NTHR + tx; int rl = item >> 5, qp = item & 31; \
      int cl = (qp >> 2) * 32 + (qp & 3) * 4; \
      float4 v0 = *(const float4*)(stg + rl * 260 + cl), v1 = *(const float4*)(stg + rl * 260 + cl + 16); \
      int row = brow + ai * HALF + rl; \
      float ss = epi.apply4(row, bcol + cl, v0, v1); \
      if (Epi::kSsq) { \
        ss += __shfl_xor(ss, 1); ss += __shfl_xor(ss, 2); ss += __shfl_xor(ss, 4); ss += __shfl_xor(ss, 8); ss += __shfl_xor(ss, 16); \
        if (qp == 0) epi.ssq_out(row, pn, ss); \
      } \
    } } while (0)
    EPI_HALF(0);
    EPI_HALF(1);
#undef EPI_HALF
    __syncthreads();
  }
#undef SA
#undef SB
#undef STAGE
#undef LDA
#undef LDB
#undef MMA
}

template <class Epi>
__device__ __forceinline__ void gemm_phase(const u16* __restrict__ A, const u16* __restrict__ Bt, const int K,
                                           const int nM, const int nN, const int rot, Epi epi) {
  const int G = gridDim.x;
  for (int tile = (int)((blockIdx.x + G - (rot % G)) % G); tile < nM * nN; tile += G) {
    int pm, pn; tile_map(tile, nM, nN, pm, pn);
    gemm_tile(A, Bt, K, pm, pn, epi);
  }
}

__device__ __forceinline__ float rstd_from_ssq(const float* ssq, int row) {
  float4 s = *(const float4*)(ssq + (size_t)row * 4);
  return rsqrtf((s.x + s.y + s.z + s.w) * (1.f / 1024.f) + 1e-6f);
}
__device__ __forceinline__ uint2 pack4(float4 v) { uint2 w; w.x = pack2(v.x, v.y); w.y = pack2(v.z, v.w); return w; }
__device__ __forceinline__ float silu_mul(float g, float u) { return g / (1.f + __expf(-g)) * u; }
struct EpiGU {
  static constexpr bool kSsq = false;
  const float* ssq; u16* act;
  __device__ __forceinline__ float apply4(int row, int c0, float4 g, float4 u) const {
    float rs = rstd_from_ssq(ssq, row);
    float4 o = make_float4(silu_mul(g.x * rs, u.x * rs), silu_mul(g.y * rs, u.y * rs), silu_mul(g.z * rs, u.z * rs), silu_mul(g.w * rs, u.w * rs));
    *(uint2*)(act + (size_t)row * DFF + ((c0 & ~31) >> 1) + (c0 & 15)) = pack4(o);
    return 0.f;
  }
  __device__ __forceinline__ void ssq_out(int, int, float) const {}
};
struct EpiRes {
  static constexpr bool kSsq = true;
  float* x; u16* xb; float* ssq; float coef;
  __device__ __forceinline__ float apply4(int row, int c0, float4 v0, float4 v1) const {
    size_t i = (size_t)row * 1024 + c0;
    float4 a = *(const float4*)(x + i), b = *(const float4*)(x + i + 16);
    a.x += coef * v0.x; a.y += coef * v0.y; a.z += coef * v0.z; a.w += coef * v0.w;
    b.x += coef * v1.x; b.y += coef * v1.y; b.z += coef * v1.z; b.w += coef * v1.w;
    *(float4*)(x + i) = a; *(float4*)(x + i + 16) = b;
    *(uint2*)(xb + i) = pack4(a); *(uint2*)(xb + i + 16) = pack4(b);
    return a.x * a.x + a.y * a.y + a.z * a.z + a.w * a.w + b.x * b.x + b.y * b.y + b.z * b.z + b.w * b.w;
  }
  __device__ __forceinline__ void ssq_out(int row, int pn, float v) const { ssq[(size_t)row * 4 + pn] = v; }
};
struct EpiScaleBf {
  static constexpr bool kSsq = false;
  const float* ssq; u16* o; int ld;
  __device__ __forceinline__ float apply4(int row, int c0, float4 v0, float4 v1) const {
    float rs = rstd_from_ssq(ssq, row);
    size_t i = (size_t)row * ld + c0;
    *(uint2*)(o + i) = pack4(make_float4(v0.x * rs, v0.y * rs, v0.z * rs, v0.w * rs));
    *(uint2*)(o + i + 16) = pack4(make_float4(v1.x * rs, v1.y * rs, v1.z * rs, v1.w * rs));
    return 0.f;
  }
  __device__ __forceinline__ void ssq_out(int, int, float) const {}
};
struct EpiQ {
  static constexpr bool kSsq = false;
  u16* qb; const float2* rope;
  __device__ __forceinline__ float apply4(int row, int c0, float4 v0, float4 v1) const {
    if (c0 < 1024) {
      size_t i = (size_t)row * 1280 + (c0 >> 7) * 160 + (c0 & 127);
      *(uint2*)(qb + i) = pack4(v0); *(uint2*)(qb + i + 16) = pack4(v1);
    } else {
      int h = (c0 - 1024) >> 5, f0 = c0 & 15;
      int pos = row < TP ? (row & 4095) : (2048 + ((row - TP) & 63));
      const float2* cs = rope + pos * 16 + f0;
      float2 c_0 = cs[0], c_1 = cs[1], c_2 = cs[2], c_3 = cs[3];
      size_t i = (size_t)row * 1280 + h * 160 + 128 + f0;
      *(uint2*)(qb + i) = pack4(make_float4(v0.x * c_0.x - v1.x * c_0.y, v0.y * c_1.x - v1.y * c_1.y, v0.z * c_2.x - v1.z * c_2.y, v0.w * c_3.x - v1.w * c_3.y));
      *(uint2*)(qb + i + 16) = pack4(make_float4(v0.x * c_0.y + v1.x * c_0.x, v0.y * c_1.y + v1.y * c_1.x, v0.z * c_2.y + v1.z * c_2.x, v0.w * c_3.y + v1.w * c_3.x));
    }
    return 0.f;
  }
  __device__ __forceinline__ void ssq_out(int, int, float) const {}
};
__device__ __forceinline__ float decay_f(float z) {
  float nz = -z;
  float sp = fmaxf(nz, 0.f) + __logf(1.f + __expf(-fabsf(nz)));
  return __expf(-__expf(-sp - 0.5f));
}
struct EpiRW {
  static constexpr bool kSsq = false;
  const float* w0; const float* a0; const float* ka; char* ws;
  __device__ __forceinline__ void acol(size_t i, int c, float4 v) const {
    u16* bb = (u16*)(ws + W_BB); u16* kb = (u16*)(ws + W_KB); const u16* kkb = (const u16*)(ws + W_KKB);
    float4 a_0 = *(const float4*)(a0 + c), k_a = *(const float4*)(ka + c), kk = bf4(*(const uint2*)(kkb + i)), k = bf4(*(const uint2*)(kb + i));
    float4 a = make_float4(sigmoidf_(a_0.x + v.x), sigmoidf_(a_0.y + v.y), sigmoidf_(a_0.z + v.z), sigmoidf_(a_0.w + v.w));
    *(uint2*)(bb + i) = pack4(make_float4(kk.x * a.x, kk.y * a.y, kk.z * a.z, kk.w * a.w));
    *(uint2*)(kb + i) = pack4(make_float4(k.x * (1.f + (a.x - 1.f) * k_a.x), k.y * (1.f + (a.y - 1.f) * k_a.y), k.z * (1.f + (a.z - 1.f) * k_a.z), k.w * (1.f + (a.w - 1.f) * k_a.w)));
  }
  __device__ __forceinline__ float apply4(int row, int c0, float4 v0, float4 v1) const {
    if (c0 < 512) {
      float* wb = (float*)(ws + W_WB);
      float4 z0 = *(const float4*)(w0 + c0), z1 = *(const float4*)(w0 + c0 + 16);
      size_t i = (size_t)row * 512 + c0;
      *(float4*)(wb + i) = make_float4(decay_f(z0.x + v0.x), decay_f(z0.y + v0.y), decay_f(z0.z + v0.z), decay_f(z0.w + v0.w));
      *(float4*)(wb + i + 16) = make_float4(decay_f(z1.x + v1.x), decay_f(z1.y + v1.y), decay_f(z1.z + v1.z), decay_f(z1.w + v1.w));
    } else if (c0 < 1024) {
      int c = c0 - 512; size_t i = (size_t)row * 512 + c;
      acol(i, c, v0); acol(i + 16, c + 16, v1);
    } else {
      u16* gb = (u16*)(ws + W_GB);
      size_t i = (size_t)row * 512 + (c0 - 1024);
      *(uint2*)(gb + i) = pack4(v0); *(uint2*)(gb + i + 16) = pack4(v1);
    }
    return 0.f;
  }
  __device__ __forceinline__ void ssq_out(int, int, float) const {}
};
template <bool ISV>
struct EpiMem {
  static constexpr bool kSsq = false;
  float* of; u16* ob;
  __device__ __forceinline__ void quad(int row, int col, float4 v) const {
    *(float4*)(of + (size_t)row * 1024 + col) = v;
    int b = row >> 8, m = row & 255, h = col >> 8, d = col & 255;
    if (ISV) {
      u16* o = ob + (size_t)((b * 4 + h) * 256 + d) * 256 + m;
      o[0] = f2bf(v.x); o[256] = f2bf(v.y); o[512] = f2bf(v.z); o[768] = f2bf(v.w);
    } else {
      *(uint2*)(ob + (size_t)((b * 4 + h) * 256 + m) * 256 + d) = pack4(v);
    }
  }
  __device__ __forceinline__ float apply4(int row, int c0, float4 v0, float4 v1) const {
    quad(row, c0, v0); quad(row, c0 + 16, v1);
    return 0.f;
  }
  __device__ __forceinline__ void ssq_out(int, int, float) const {}
};

template <class F>
__device__ __forceinline__ void tconv(u16* dst, int ldd, int N, int K, int rot, F f) {
  extern __shared__ __attribute__((aligned(16))) char smem[];
  float* t = (float*)smem;
  const int nk = K / 64, nt = (N / 64) * nk, G = gridDim.x;
  const int tid = tidx(), a = tid >> 6, c = tid & 63;
  for (int tile = (int)((blockIdx.x + G - (rot % G)) % G); tile < nt; tile += G) {
    int n0 = (tile / nk) * 64, k0 = (tile % nk) * 64;
    __syncthreads();
#pragma unroll
    for (int i = 0; i < 8; ++i) { int kk = a + 8 * i; t[kk * 65 + c] = f(k0 + kk, n0 + c); }
    __syncthreads();
#pragma unroll
    for (int i = 0; i < 2; ++i) {
      const int nn = (tid >> 4) + 32 * i, kq = (tid & 15) * 4;
      uint2 w; w.x = pack2(t[kq * 65 + nn], t[(kq + 1) * 65 + nn]); w.y = pack2(t[(kq + 2) * 65 + nn], t[(kq + 3) * 65 + nn]);
      *(uint2*)(dst + (size_t)(n0 + nn) * ldd + k0 + kq) = w;
    }
  }
}

template <class F>
__device__ __forceinline__ void tconv_v(u16* dst, int ldd, int N, int K, int vb, int nvb, F f) {
  extern __shared__ __attribute__((aligned(16))) char smem[];
  float* t = (float*)smem;
  const int nk = K / 64, nt = (N / 64) * nk;
  const int tid = tidx(), a = tid >> 6, c = tid & 63;
  for (int tile = vb; tile < nt; tile += nvb) {
    int n0 = (tile / nk) * 64, k0 = (tile % nk) * 64;
    __syncthreads();
#pragma unroll
    for (int i = 0; i < 8; ++i) { int kk = a + 8 * i; t[kk * 65 + c] = f(k0 + kk, n0 + c); }
    __syncthreads();
#pragma unroll
    for (int i = 0; i < 2; ++i) {
      const int nn = (tid >> 4) + 32 * i, kq = (tid & 15) * 4;
      uint2 w; w.x = pack2(t[kq * 65 + nn], t[(kq + 1) * 65 + nn]); w.y = pack2(t[(kq + 2) * 65 + nn], t[(kq + 3) * 65 + nn]);
      *(uint2*)(dst + (size_t)(n0 + nn) * ldd + k0 + kq) = w;
    }
  }
  __syncthreads();
}

template <int DK, int DV, int RPG>
__device__ __forceinline__ void attn_item(const u16* __restrict__ Qb, int ldq, int nrows, const u16* __restrict__ Kb, int ldk,
                                          const u16* __restrict__ Vtb, int ldvt, int nkeys, u16* __restrict__ Ob, int ldo) {
  extern __shared__ __attribute__((aligned(16))) char smem[];
  constexpr int KS = DK + 8, VS = 68;
  u16* sK = (u16*)smem;
  u16* sV = sK + 64 * KS;
  const int tid = tidx(), wid = tid >> 6, lane = tid & 63, q = lane & 31, hh = lane >> 5;
  const int row = wid * 32 + q;
  const bool active = (wid * 32) < nrows;
  bf16x8 qf[DK / 16];
  if (active) {
#pragma unroll
    for (int ks = 0; ks < DK / 16; ++ks) qf[ks] = *(const bf16x8*)(Qb + (size_t)row * ldq + ks * 16 + hh * 8);
  }
  f32x16 o[DV / 32];
#pragma unroll
  for (int dt = 0; dt < DV / 32; ++dt)
#pragma unroll
    for (int i = 0; i < 16; ++i) o[dt][i] = 0.f;
  float mrun = -1e30f, lrun = 0.f;
  const int nkt = nkeys >> 6;
  constexpr int KCH = (64 * (DK / 8) + NTHR - 1) / NTHR;
  static_assert(DV == 128 && KCH <= 4, "staging registers are written out by hand");
  uint4 kr0, kr1, kr2, kr3, vr0, vr1;
#define AT_KL(N_, kt_) { const int c = tid + N_ * NTHR; if (N_ < KCH && c < 64 * (DK / 8)) { const int r = c / (DK / 8), cc = c % (DK / 8); \
      kr##N_ = *(const uint4*)(Kb + (size_t)((kt_) * 64 + r) * ldk + cc * 8); } }
#define AT_VL(N_, kt_) { const int c = tid + N_ * NTHR; const int r = c >> 3, cc = c & 7; vr##N_ = *(const uint4*)(Vtb + (size_t)r * ldvt + (kt_) * 64 + cc * 8); }
#define AT_GLOAD(kt_) do { AT_KL(0, kt_) AT_KL(1, kt_) AT_KL(2, kt_) AT_KL(3, kt_) AT_VL(0, kt_) AT_VL(1, kt_) } while (0)
#define AT_KS(N_) { const int c = tid + N_ * NTHR; if (N_ < KCH && c < 64 * (DK / 8)) { const int r = c / (DK / 8), cc = c % (DK / 8); *(uint4*)(sK + r * KS + cc * 8) = kr##N_; } }
#define AT_VS(N_) { const int c = tid + N_ * NTHR; const int r = c >> 3, cc = c & 7; uint2* d = (uint2*)(sV + r * VS + cc * 8); \
      const uint4 t_ = vr##N_; d[0] = make_uint2(t_.x, t_.y); d[1] = make_uint2(t_.z, t_.w); }
  AT_GLOAD(0);
  for (int kt = 0; kt < nkt; ++kt) {
    __syncthreads();
    AT_KS(0) AT_KS(1) AT_KS(2) AT_KS(3) AT_VS(0) AT_VS(1)
    __syncthreads();
    if (kt + 1 < nkt) AT_GLOAD(kt + 1);
    if (active) {
      f32x16 s0, s1;
#pragma unroll
      for (int i = 0; i < 16; ++i) { s0[i] = 0.f; s1[i] = 0.f; }
#pragma unroll
      for (int ks = 0; ks < DK / 16; ++ks) {
        bf16x8 a0 = *(const bf16x8*)(sK + q * KS + ks * 16 + hh * 8);
        bf16x8 a1 = *(const bf16x8*)(sK + (32 + q) * KS + ks * 16 + hh * 8);
        s0 = __builtin_amdgcn_mfma_f32_32x32x16_bf16(a0, qf[ks], s0, 0, 0, 0);
        s1 = __builtin_amdgcn_mfma_f32_32x32x16_bf16(a1, qf[ks], s1, 0, 0, 0);
      }
      float mx = s0[0];
#pragma unroll
      for (int i = 1; i < 16; ++i) mx = fmaxf(mx, s0[i]);
#pragma unroll
      for (int i = 0; i < 16; ++i) mx = fmaxf(mx, s1[i]);
      mx = fmaxf(mx, __shfl_xor(mx, 32));
      float mn = fmaxf(mrun, mx);
      float alpha = __builtin_amdgcn_exp2f(mrun - mn);
      mrun = mn;
      float ps = 0.f;
#pragma unroll
      for (int i = 0; i < 16; ++i) { s0[i] = __builtin_amdgcn_exp2f(sub_s(s0[i], mn)); ps = add_s(ps, s0[i]); }
#pragma unroll
      for (int i = 0; i < 16; ++i) { s1[i] = __builtin_amdgcn_exp2f(sub_s(s1[i], mn)); ps = add_s(ps, s1[i]); }
      lrun = lrun * alpha + ps;
#pragma unroll
      for (int dt = 0; dt < DV / 32; ++dt)
#pragma unroll
        for (int i = 0; i < 16; ++i) o[dt][i] = mul_s(o[dt][i], alpha);
#pragma unroll
      for (int kb = 0; kb < 2; ++kb)
#pragma unroll
        for (int s = 0; s < 2; ++s) {
          union { bf16x8 v; unsigned u[4]; } pf;
#pragma unroll
          for (int jj = 0; jj < 4; ++jj) {
            float e0 = kb ? s1[8 * s + 2 * jj] : s0[8 * s + 2 * jj];
            float e1 = kb ? s1[8 * s + 2 * jj + 1] : s0[8 * s + 2 * jj + 1];
            pf.u[jj] = pack2(e0, e1);
          }
          const int kbase = kb * 32 + s * 16 + 4 * hh;
#pragma unroll
          for (int dt = 0; dt < DV / 32; ++dt) {
            const u16* vp = sV + (dt * 32 + q) * VS + kbase;
            union { bf16x8 v; uint2 u[2]; } vf;
            vf.u[0] = *(const uint2*)vp; vf.u[1] = *(const uint2*)(vp + 8);
            o[dt] = __builtin_amdgcn_mfma_f32_32x32x16_bf16(vf.v, pf.v, o[dt], 0, 0, 0);
          }
        }
    }
  }
  if (active) {
    lrun += __shfl_xor(lrun, 32);
    float inv = 1.f / lrun;
    u16* op = Ob + (size_t)(row / RPG) * ldo + (size_t)(row % RPG) * DV;
#pragma unroll
    for (int dt = 0; dt < DV / 32; ++dt)
#pragma unroll
      for (int g = 0; g < 4; ++g) {
        uint2 w;
        w.x = pack2(o[dt][4 * g] * inv, o[dt][4 * g + 1] * inv);
        w.y = pack2(o[dt][4 * g + 2] * inv, o[dt][4 * g + 3] * inv);
        *(uint2*)(op + dt * 32 + 8 * g + 4 * hh) = w;
      }
  }
}

#undef AT_GLOAD
#undef AT_KL
#undef AT_VL
#undef AT_KS
#undef AT_VS
__device__ __forceinline__ float dpp_sum16(float x) {
  x += __int_as_float(__builtin_amdgcn_update_dpp(0, __float_as_int(x), 0xB1, 0xF, 0xF, false));
  x += __int_as_float(__builtin_amdgcn_update_dpp(0, __float_as_int(x), 0x4E, 0xF, 0xF, false));
  x += __int_as_float(__builtin_amdgcn_update_dpp(0, __float_as_int(x), 0x141, 0xF, 0xF, false));
  x += __int_as_float(__builtin_amdgcn_update_dpp(0, __float_as_int(x), 0x140, 0xF, 0xF, false));
  return x;
}
__device__ __forceinline__ void scan_item(KPR p, int l, int g0, int h, int half, int nsteps, const float* S0, float* Sout) {
  extern __shared__ __attribute__((aligned(16))) char smem[];
  float* sT = (float*)smem;
  float* sV = sT + 5 * 4096;
  const float* src0 = (const float*)(p.ws + W_RB) + h * 64; const float* src1 = (const float*)(p.ws + W_WB) + h * 64;
  const float* src2 = (const float*)(p.ws + W_KB) + h * 64; const float* src3 = (const float*)(p.ws + W_KKB) + h * 64;
  const float* src4 = (const float*)(p.ws + W_BB) + h * 64;
  const float* VB = (const float*)(p.ws + W_VB) + h * 64 + half * 32;
  float* YB = (float*)(p.ws + W_YB) + h * 64 + half * 32;
  const int tid = tidx();
  const int il = tid >> 4, sub = tid & 15, j0 = sub * 4, i = half * 32 + il;
  float s[4];
#pragma unroll
  for (int j = 0; j < 4; ++j) s[j] = S0 ? S0[i * 64 + j0 + j] : 0.f;
  float4 pa0, pa1, pa2, pa3, pa4, pb0, pb1, pb2, pb3, pb4, pfv;
  const int e0 = tid, e1 = tid + NTHR;
  const int st0 = e0 >> 4, c40 = (e0 & 15) * 4, st1 = e1 >> 4, c41 = (e1 & 15) * 4;
  const int stv = tid >> 3, c4v = (tid & 7) * 4;
#define SC_GL1(x, c0_) pa##x = *(const float4*)(src##x + (size_t)(g0 + (c0_) + st0) * 512 + c40); \
                       pb##x = *(const float4*)(src##x + (size_t)(g0 + (c0_) + st1) * 512 + c41);
#define SC_GLOAD(c0_) do { SC_GL1(0, c0_) SC_GL1(1, c0_) SC_GL1(2, c0_) SC_GL1(3, c0_) SC_GL1(4, c0_) \
    pfv = *(const float4*)(VB + (size_t)(g0 + (c0_) + stv) * 512 + c4v); } while (0)
#define SC_ST1(x) *(float4*)(sT + x * 4096 + st0 * 64 + c40) = pa##x; *(float4*)(sT + x * 4096 + st1 * 64 + c41) = pb##x;
  SC_GLOAD(0);
  for (int c0 = 0; c0 < nsteps; c0 += 64) {
    __syncthreads();
    SC_ST1(0) SC_ST1(1) SC_ST1(2) SC_ST1(3) SC_ST1(4)
    *(float4*)(sV + stv * 32 + c4v) = pfv;
    __syncthreads();
    if (c0 + 64 < nsteps) SC_GLOAD(c0 + 64);
#define SC_LD(S, st_) do { const int _s = (st_) < 64 ? (st_) : 63; \
      S##r = *(const float4*)(sT + _s * 64 + j0); S##w = *(const float4*)(sT + 4096 + _s * 64 + j0); \
      S##k = *(const float4*)(sT + 8192 + _s * 64 + j0); S##q = *(const float4*)(sT + 12288 + _s * 64 + j0); \
      S##b = *(const float4*)(sT + 16384 + _s * 64 + j0); S##v = sV[_s * 32 + il]; } while (0)
#define SC_STEP(S, st_) do { \
      float sa = -dpp_sum16(fma_s(s[1], S##q.y, mul_s(s[0], S##q.x)) + fma_s(s[3], S##q.w, mul_s(s[2], S##q.z))); \
      s[0] = fma_s(sa, S##b.x, fma_s(s[0], S##w.x, mul_s(S##v, S##k.x))); \
      s[1] = fma_s(sa, S##b.y, fma_s(s[1], S##w.y, mul_s(S##v, S##k.y))); \
      s[2] = fma_s(sa, S##b.z, fma_s(s[2], S##w.z, mul_s(S##v, S##k.z))); \
      s[3] = fma_s(sa, S##b.w, fma_s(s[3], S##w.w, mul_s(S##v, S##k.w))); \
      float y = dpp_sum16(fma_s(s[1], S##r.y, mul_s(s[0], S##r.x)) + fma_s(s[3], S##r.w, mul_s(s[2], S##r.z))); \
      ykeep = (sub == ((st_) & 15)) ? y : ykeep; } while (0)
    float4 Ar, Aw, Ak, Aq, Ab, Br, Bw, Bk, Bq, Bb, Cr, Cw, Ck, Cq, Cb, Dr, Dw, Dk, Dq, Db;
    float Av, Bv, Cv, Dv, ykeep = 0.f;
    SC_LD(A, 0); SC_LD(B, 1); SC_LD(C, 2);
    for (int st = 0; st < 64; st += 4) {
      SC_LD(D, st + 3); SC_STEP(A, st);
      SC_LD(A, st + 4); SC_STEP(B, st + 1);
      SC_LD(B, st + 5); SC_STEP(C, st + 2);
      SC_LD(C, st + 6); SC_STEP(D, st + 3);
      if ((st & 15) == 12) YB[(size_t)(g0 + c0 + (st - 12) + sub) * 512 + il] = ykeep;
    }
  }
#undef SC_LD
#undef SC_STEP
#undef SC_GLOAD
#undef SC_GL1
#undef SC_ST1
  *(float4*)(Sout + i * 64 + j0) = make_float4(s[0], s[1], s[2], s[3]);
}

constexpr int LS = 68;
constexpr int LBUF = 64 * LS;
constexpr int LH = 72;

__device__ __forceinline__ void split8(const float* x, bf16x8& hi, bf16x8& lo) {
  union { bf16x8 v; unsigned u[4]; } H, Lo;
#pragma unroll
  for (int j = 0; j < 4; ++j) {
    const unsigned h = pack2(x[2 * j], x[2 * j + 1]);
    H.u[j] = h;
    Lo.u[j] = pack2(x[2 * j] - __uint_as_float(h << 16), x[2 * j + 1] - __uint_as_float(h & 0xffff0000u));
  }
  hi = H.v; lo = Lo.v;
}
template <int AM, int AK, int BKS, int BN, bool SPLIT = true>
__device__ __forceinline__ void mm64(const float* A, const float* B, f32x4 (&acc)[2], int m0, int n0, int lane) {
  const int lr = lane & 15, lq = lane >> 4;
#pragma unroll
  for (int ks = 0; ks < 2; ++ks) {
    const int k0 = ks * 32 + lq * 8;
    float a[8];
    if (AK == 1) {
      float4 x0 = *(const float4*)(A + (m0 + lr) * AM + k0), x1 = *(const float4*)(A + (m0 + lr) * AM + k0 + 4);
      a[0] = x0.x; a[1] = x0.y; a[2] = x0.z; a[3] = x0.w; a[4] = x1.x; a[5] = x1.y; a[6] = x1.z; a[7] = x1.w;
    } else {
#pragma unroll
      for (int j = 0; j < 8; ++j) a[j] = A[(m0 + lr) * AM + (k0 + j) * AK];
    }
    bf16x8 ah, al;
    if (SPLIT) split8(a, ah, al);
    else { union { bf16x8 v; unsigned u[4]; } H; for (int j = 0; j < 4; ++j) H.u[j] = pack2(a[2 * j], a[2 * j + 1]); ah = H.v; al = H.v; }
#pragma unroll
    for (int nt = 0; nt < 2; ++nt) {
      const int n = n0 + nt * 16 + lr;
      float b[8];
      if (BKS == 1) {
        float4 x0 = *(const float4*)(B + n * BN + k0), x1 = *(const float4*)(B + n * BN + k0 + 4);
        b[0] = x0.x; b[1] = x0.y; b[2] = x0.z; b[3] = x0.w; b[4] = x1.x; b[5] = x1.y; b[6] = x1.z; b[7] = x1.w;
      } else {
#pragma unroll
        for (int j = 0; j < 8; ++j) b[j] = B[(k0 + j) * BKS + n * BN];
      }
      if (SPLIT) {
        bf16x8 bh, bl; split8(b, bh, bl);
        acc[nt] = __builtin_amdgcn_mfma_f32_16x16x32_bf16(ah, bh, acc[nt], 0, 0, 0);
        acc[nt] = __builtin_amdgcn_mfma_f32_16x16x32_bf16(ah, bl, acc[nt], 0, 0, 0);
        acc[nt] = __builtin_amdgcn_mfma_f32_16x16x32_bf16(al, bh, acc[nt], 0, 0, 0);
      } else {
        union { bf16x8 v; unsigned u[4]; } Bh;
#pragma unroll
        for (int j = 0; j < 4; ++j) Bh.u[j] = pack2(b[2 * j], b[2 * j + 1]);
        acc[nt] = __builtin_amdgcn_mfma_f32_16x16x32_bf16(ah, Bh.v, acc[nt], 0, 0, 0);
      }
    }
  }
}
#define MM_ZERO(acc) do { acc[0] = f32x4{0.f, 0.f, 0.f, 0.f}; acc[1] = f32x4{0.f, 0.f, 0.f, 0.f}; } while (0)
#define MM_FOREACH(acc, BODY) do { _Pragma("unroll") for (int nt_ = 0; nt_ < 2; ++nt_) _Pragma("unroll") for (int rg_ = 0; rg_ < 4; ++rg_) { \
    const int m = m0 + lq * 4 + rg_, n = n0 + nt_ * 16 + lr; const float val = acc[nt_][rg_]; BODY } } while (0)

#define CPRE_PARAMS float4& c_w0, float4& c_w1, uint2& c_q0, uint2& c_q1, uint2& c_b0, uint2& c_b1, uint2& c_k0, uint2& c_k1, uint2& c_r0, uint2& c_r1, uint2& c_v0, uint2& c_v1
#define CPRE_ARGS(P) P##w0, P##w1, P##q0, P##q1, P##b0, P##b1, P##k0, P##k1, P##r0, P##r1, P##v0, P##v1
__device__ __forceinline__ void cprep_load(KPR p, int grow0, int h, int tid, CPRE_PARAMS) {
  const int t0 = tid >> 4, c4 = (tid & 15) * 4;
  const size_t g0 = (size_t)(grow0 + t0) * 512 + h * 64 + c4, g1 = g0 + (size_t)32 * 512;
  const float* WB = (const float*)(p.ws + W_WB); const u16* KKB = (const u16*)(p.ws + W_KKB); const u16* BB = (const u16*)(p.ws + W_BB);
  const u16* KB = (const u16*)(p.ws + W_KB); const u16* RB = (const u16*)(p.ws + W_RB); const u16* VB = (const u16*)(p.ws + W_VB);
  c_w0 = *(const float4*)(WB + g0); c_w1 = *(const float4*)(WB + g1); c_q0 = *(const uint2*)(KKB + g0); c_q1 = *(const uint2*)(KKB + g1);
  c_b0 = *(const uint2*)(BB + g0); c_b1 = *(const uint2*)(BB + g1); c_k0 = *(const uint2*)(KB + g0); c_k1 = *(const uint2*)(KB + g1);
  c_r0 = *(const uint2*)(RB + g0); c_r1 = *(const uint2*)(RB + g1); c_v0 = *(const uint2*)(VB + g0); c_v1 = *(const uint2*)(VB + g1);
}
__device__ __forceinline__ void cprep_item(KPR p, int grow0, int h, int cid, int ngrow0, int nh, CPRE_PARAMS) {
  extern __shared__ __attribute__((aligned(16))) char smem[];
  float* B0 = (float*)smem; float* B1 = B0 + LBUF; float* B2 = B1 + LBUF; float* B3 = B2 + LBUF;
  float* B4 = B3 + LBUF; float* B5 = B4 + LBUF; float* B6 = B5 + LBUF; float* B7 = B6 + LBUF;
  float* wC = (float*)(smem + 139264);
  const int tid = tidx(), wid = tid >> 6, lane = tid & 63, lr = lane & 15, lq = lane >> 4;
  const int m0 = (wid >> 1) * 16, n0 = (wid & 1) * 32;
  const float* WB = (const float*)(p.ws + W_WB) + h * 64; const float* KKB = (const float*)(p.ws + W_KKB) + h * 64;
  const float* BB = (const float*)(p.ws + W_BB) + h * 64; const float* KB = (const float*)(p.ws + W_KB) + h * 64;
  const float* RB = (const float*)(p.ws + W_RB) + h * 64; const float* VB = (const float*)(p.ws + W_VB) + h * 64;
  f32x4 acc[2];
  __syncthreads();
  {
    const int t0 = tid >> 4, c4 = (tid & 15) * 4, o0 = t0 * LS + c4, o1 = (t0 + 32) * LS + c4;
    *(float4*)(B0 + o0) = c_w0; *(float4*)(B0 + o1) = c_w1;
    { const float4 a0_ = bf4(c_q0), a1_ = bf4(c_q1);
      *(float4*)(B1 + o0) = make_float4(-a0_.x, -a0_.y, -a0_.z, -a0_.w); *(float4*)(B1 + o1) = make_float4(-a1_.x, -a1_.y, -a1_.z, -a1_.w); }
    *(float4*)(B2 + o0) = bf4(c_b0); *(float4*)(B2 + o1) = bf4(c_b1);
    *(float4*)(B3 + o0) = bf4(c_k0); *(float4*)(B3 + o1) = bf4(c_k1);
    *(float4*)(B4 + o0) = bf4(c_r0); *(float4*)(B4 + o1) = bf4(c_r1);
  }
  const uint2 vk0 = c_v0, vk1 = c_v1;
  __syncthreads();
  cprep_load(p, ngrow0, nh, tid, CPRE_ARGS(c_));
  {
    const int j = tid & 63, sg = tid >> 6;
    float wv[8];
#pragma unroll
    for (int u = 0; u < 8; ++u) wv[u] = B0[(sg * 8 + u) * LS + j];
#pragma unroll
    for (int u = 1; u < 8; ++u) wv[u] *= wv[u - 1];
    float* segp = B5;
    segp[sg * 64 + j] = wv[7];
    __syncthreads();
    float pre = 1.f;
    for (int u = 0; u < sg; ++u) pre *= segp[u * 64 + j];
#pragma unroll
    for (int u = 0; u < 8; ++u) B0[(sg * 8 + u) * LS + j] = wv[u] * pre;
    if (sg == 7) wC[j] = wv[7] * pre;
  }
  __syncthreads();
  for (int e = tid; e < 4096; e += NTHR) {
    const int t = e >> 6, j = e & 63, o = t * LS + j;
    const float wt = B0[o], wp = t ? B0[o - LS] : 1.f, iw = 1.f / wt;
    B1[o] *= wp; B2[o] *= iw; B3[o] *= iw; B4[o] *= wt;
  }
  __syncthreads();
  MM_ZERO(acc); mm64<LS, 1, 1, LS>(B2, B1, acc, m0, n0, lane);
  MM_FOREACH(acc, { const float v = m < n ? val : 0.f; B5[m * LS + n] = v; B6[m * LS + n] = v + (m == n ? 1.f : 0.f); });
  __syncthreads();
  MM_ZERO(acc); mm64<LS, 1, LS, 1>(B5, B5, acc, m0, n0, lane);
  MM_FOREACH(acc, { B7[m * LS + n] = val; });
  __syncthreads();
  for (int it = 0; it < 5; ++it) {
    MM_ZERO(acc); mm64<LS, 1, LS, 1>(B6, B7, acc, m0, n0, lane);
    f32x4 acc2[2]; MM_ZERO(acc2);
    if (it < 4) mm64<LS, 1, LS, 1>(B7, B7, acc2, m0, n0, lane);
    __syncthreads();
    MM_FOREACH(acc, { B6[m * LS + n] += val; });
    if (it < 4) MM_FOREACH(acc2, { B7[m * LS + n] = val; });
    __syncthreads();
  }
  MM_ZERO(acc); mm64<1, LS, LS, 1>(B1, B6, acc, m0, n0, lane);
  MM_FOREACH(acc, { B5[m * LS + n] = val; });
  MM_ZERO(acc); mm64<LS, 1, 1, LS>(B3, B1, acc, m0, n0, lane);
  MM_FOREACH(acc, { B0[m * LS + n] = m < n ? val : 0.f; });
  __syncthreads();
  MM_ZERO(acc); mm64<LS, 1, LS, 1>(B0, B6, acc, m0, n0, lane);
  MM_FOREACH(acc, { B7[m * LS + n] = val; });
  __syncthreads();
  MM_ZERO(acc); mm64<LS, 1, 1, LS, false>(B2, B4, acc, m0, n0, lane);
  {
    f32x4 acc2[2]; MM_ZERO(acc2); mm64<LS, 1, 1, LS, false>(B3, B4, acc2, m0, n0, lane);
    __syncthreads();
    MM_FOREACH(acc, { B0[m * LS + n] = m <= n ? val : 0.f; });
    MM_FOREACH(acc2, { B1[m * LS + n] = m <= n ? val : 0.f; });
  }
  __syncthreads();
  {
    u16* RRT = (u16*)(p.ws + W_CRR) + (size_t)cid * 4096;
    MM_ZERO(acc); mm64<1, LS, 1, LS, false>(B0, B5, acc, m0, n0, lane);
    MM_FOREACH(acc, { RRT[m * 64 + n] = f2bf(val + B4[m * LS + n]); });
    MM_ZERO(acc); mm64<LS, 1, LS, 1, false>(B7, B0, acc, m0, n0, lane);
    MM_FOREACH(acc, { B6[m * LS + n] = val + B1[m * LS + n]; });
  }
  __syncthreads();
  for (int e = tid; e < 4096; e += NTHR) {
    const int t = e >> 6, j = e & 63, o = t * LS + j;
    const float wc = wC[j];
    B2[o] *= wc; B3[o] *= wc;
  }
  { const int t0 = tid >> 4, c4 = (tid & 15) * 4; *(float4*)(B4 + t0 * LS + c4) = bf4(vk0); *(float4*)(B4 + (t0 + 32) * LS + c4) = bf4(vk1); }
  __syncthreads();
  {
    u16* YB = (u16*)(p.ws + W_YB) + h * 64;
    MM_ZERO(acc); mm64<1, LS, LS, 1, false>(B6, B4, acc, m0, n0, lane);
    MM_FOREACH(acc, { YB[(size_t)(grow0 + m) * 512 + n] = f2bf(val); });
    u16* PT = (u16*)(p.ws + W_CPT) + (size_t)cid * 4096;
    MM_ZERO(acc); mm64<1, LS, 1, LS, false>(B2, B5, acc, m0, n0, lane);
    MM_FOREACH(acc, { PT[m * 64 + n] = f2bf(val + (m == n ? wC[m] : 0.f)); });
    MM_ZERO(acc); mm64<LS, 1, LS, 1, false>(B7, B2, acc, m0, n0, lane);
    MM_FOREACH(acc, { B0[m * LS + n] = val + B3[m * LS + n]; });
  }
  __syncthreads();
  {
    u16* CQ = (u16*)(p.ws + W_CQ) + (size_t)cid * 4096;
    MM_ZERO(acc); mm64<1, LS, LS, 1, false>(B4, B0, acc, m0, n0, lane);
    MM_FOREACH(acc, { CQ[m * 64 + n] = f2bf(val); });
  }
}

__device__ __forceinline__ void cprep_decode(int id, int& grow0, int& h) {
  if (id < 2048) { grow0 = (id >> 9) * 4096 + (id & 63) * 64; h = (id >> 6) & 7; }
  else { const int k = id - 2048; grow0 = TP + (k >> 3) * 64; h = k & 7; }
}
__device__ __forceinline__ void phase_cprep(KPR p) {
  float4 u_w0, u_w1; uint2 u_k0, u_k1, u_q0, u_q1, u_b0, u_b1, u_r0, u_r1, u_v0, u_v1;
  int id = blockIdx.x, grow0 = 0, h = 0;
  cprep_decode(id < 2304 ? id : 0, grow0, h); cprep_load(p, grow0, h, tidx(), CPRE_ARGS(u_));
  for (; id < 2304; id += gridDim.x) {
    const int nid = id + gridDim.x;
    int ng = 0, nh = 0;
    cprep_decode(nid < 2304 ? nid : id, ng, nh);
    cprep_item(p, grow0, h, id, ng, nh, CPRE_ARGS(u_));
    grow0 = ng; h = nh;
  }
}

__device__ __forceinline__ void cseq_item(KPR p, int g0, int h, int nch, int cid0, const float* S0, float* Sout) {
  extern __shared__ __attribute__((aligned(16))) char smem[];
  float* Sf = (float*)smem;
  float* Qf = Sf + LBUF;
  float* Yf = Qf + LBUF;
  u16* Rb = (u16*)(Yf + LBUF);
  u16* Pb = Rb + 64 * LH;
  const int tid = tidx(), wid = tid >> 6, lane = tid & 63, lr = lane & 15, lq = lane >> 4;
  const int m0 = (wid >> 1) * 16, n0 = (wid & 1) * 32;
  u16* YB = (u16*)(p.ws + W_YB) + h * 64;
  const u16* RRT = (const u16*)(p.ws + W_CRR) + (size_t)cid0 * 4096;
  const u16* PT = (const u16*)(p.ws + W_CPT) + (size_t)cid0 * 4096;
  const u16* CQ = (const u16*)(p.ws + W_CQ) + (size_t)cid0 * 4096;
  __syncthreads();
  for (int e = tid; e < 4096; e += NTHR) { const int i = e >> 6, j = e & 63; Sf[i * LS + j] = S0 ? S0[e] : 0.f; }
  const int hr = tid >> 3, hc = (tid & 7) * 8;
  const int f0t = tid >> 4, f0c = (tid & 15) * 4;
  uint4 pr, pp; uint2 q0, q1, y0, y1;
#define CS_LOAD(c_) do { \
    pr = *(const uint4*)(RRT + (size_t)(c_) * 4096 + hr * 64 + hc); pp = *(const uint4*)(PT + (size_t)(c_) * 4096 + hr * 64 + hc); \
    q0 = *(const uint2*)(CQ + (size_t)(c_) * 4096 + f0t * 64 + f0c); q1 = *(const uint2*)(CQ + (size_t)(c_) * 4096 + (f0t + 32) * 64 + f0c); \
    y0 = *(const uint2*)(YB + (size_t)(g0 + (c_) * 64 + f0t) * 512 + f0c); y1 = *(const uint2*)(YB + (size_t)(g0 + (c_) * 64 + f0t + 32) * 512 + f0c); } while (0)
  CS_LOAD(0);
  for (int c = 0; c < nch; ++c) {
    __syncthreads();
    *(uint4*)(Rb + hr * LH + hc) = pr; *(uint4*)(Pb + hr * LH + hc) = pp;
    *(float4*)(Qf + f0t * LS + f0c) = bf4(q0); *(float4*)(Qf + (f0t + 32) * LS + f0c) = bf4(q1);
    *(float4*)(Yf + f0t * LS + f0c) = bf4(y0); *(float4*)(Yf + (f0t + 32) * LS + f0c) = bf4(y1);
    __syncthreads();
    if (c + 1 < nch) CS_LOAD(c + 1);
    f32x4 ay[2], as[2]; MM_ZERO(ay); MM_ZERO(as);
#pragma unroll
    for (int ks = 0; ks < 2; ++ks) {
      const int k0 = ks * 32 + lq * 8;
      const bf16x8 ra = *(const bf16x8*)(Rb + (m0 + lr) * LH + k0);
      float sa[8];
      { float4 x0 = *(const float4*)(Sf + (m0 + lr) * LS + k0), x1 = *(const float4*)(Sf + (m0 + lr) * LS + k0 + 4);
        sa[0] = x0.x; sa[1] = x0.y; sa[2] = x0.z; sa[3] = x0.w; sa[4] = x1.x; sa[5] = x1.y; sa[6] = x1.z; sa[7] = x1.w; }
      bf16x8 sah, sal; split8(sa, sah, sal);
#pragma unroll
      for (int nt = 0; nt < 2; ++nt) {
        const int n = n0 + nt * 16 + lr;
        float sb[8];
        { float4 x0 = *(const float4*)(Sf + n * LS + k0), x1 = *(const float4*)(Sf + n * LS + k0 + 4);
          sb[0] = x0.x; sb[1] = x0.y; sb[2] = x0.z; sb[3] = x0.w; sb[4] = x1.x; sb[5] = x1.y; sb[6] = x1.z; sb[7] = x1.w; }
        bf16x8 sbh, sbl; split8(sb, sbh, sbl);
        ay[nt] = __builtin_amdgcn_mfma_f32_16x16x32_bf16(ra, sbh, ay[nt], 0, 0, 0);
        ay[nt] = __builtin_amdgcn_mfma_f32_16x16x32_bf16(ra, sbl, ay[nt], 0, 0, 0);
        const bf16x8 pb = *(const bf16x8*)(Pb + n * LH + k0);
        as[nt] = __builtin_amdgcn_mfma_f32_16x16x32_bf16(sah, pb, as[nt], 0, 0, 0);
        as[nt] = __builtin_amdgcn_mfma_f32_16x16x32_bf16(sal, pb, as[nt], 0, 0, 0);
      }
    }
    MM_FOREACH(ay, { YB[(size_t)(g0 + c * 64 + m) * 512 + n] = f2bf(val + Yf[m * LS + n]); });
    __syncthreads();
    MM_FOREACH(as, { Sf[m * LS + n] = val + Qf[m * LS + n]; });
  }
#undef CS_LOAD
  __syncthreads();
  for (int e = tid; e < 4096; e += NTHR) { const int i = e >> 6, j = e & 63; Sout[e] = Sf[i * LS + j]; }
}

__device__ __forceinline__ void phase_yfin(KPR p, int l) {
  const int tid = tidx(), wid = tid >> 6, lane = tid & 63;
  const float* YB = (const float*)(p.ws + W_YB); const float* RB = (const float*)(p.ws + W_RB); const float* KB = (const float*)(p.ws + W_KB);
  const float* VB = (const float*)(p.ws + W_VB); const u16* GB = (const u16*)(p.ws + W_GB); u16* AO = (u16*)(p.ws + W_AO);
  const float* rk = p.in[I_RK] + l * 512; const float* gng = p.in[I_GNG] + l * 512; const float* gnb = p.in[I_GNB] + l * 512;
  for (int g = blockIdx.x * 8 + wid; g < T; g += gridDim.x * 8) {
#pragma unroll 4
    for (int h = 0; h < 8; ++h) {
      size_t i = (size_t)g * 512 + h * 64 + lane;
      float y = bf2f(((const u16*)YB)[i]);
      float mu = wave_sum(y) * (1.f / 64.f);
      float dlt = y - mu;
      float var = wave_sum(dlt * dlt) * (1.f / 64.f);
      float bon = wave_sum(bf2f(((const u16*)RB)[i]) * bf2f(((const u16*)KB)[i]) * rk[h * 64 + lane]);
      float v = dlt * rsqrtf(var + 64e-5f) * gng[h * 64 + lane] + gnb[h * 64 + lane] + bon * bf2f(((const u16*)VB)[i]);
      AO[(size_t)g * 1536 + 1024 + h * 64 + lane] = f2bf(v * bf2f(GB[i]));
    }
  }
}

__device__ __forceinline__ void phase_init(KPR p) {
  const int G = gridDim.x, tid = tidx(), wid = tid >> 6, lane = tid & 63;
  const int gw = blockIdx.x * 8 + wid, nw = G * 8;
  {
    float* X = (float*)(p.ws + W_X); u16* XB = (u16*)(p.ws + W_XB); float* SSQ = (float*)(p.ws + W_SSQ);
    for (int g = gw; g < T; g += nw) {
      const float* src = g < TP ? p.in[I_XP] + (size_t)g * 1024 : p.in[I_XS] + (size_t)(g - TP) * 1024;
      float ss = 0.f;
#pragma unroll
      for (int i = 0; i < 4; ++i) {
        float4 v = *(const float4*)(src + i * 256 + lane * 4);
        *(float4*)(X + (size_t)g * 1024 + i * 256 + lane * 4) = v;
        uint2 w; w.x = pack2(v.x, v.y); w.y = pack2(v.z, v.w);
        *(uint2*)(XB + (size_t)g * 1024 + i * 256 + lane * 4) = w;
        ss += v.x * v.x + v.y * v.y + v.z * v.z + v.w * v.w;
      }
      ss = wave_sum(ss);
      if (lane == 0) *(float4*)(SSQ + (size_t)g * 4) = make_float4(ss, 0.f, 0.f, 0.f);
    }
  }
  {
    u16* MB = (u16*)(p.ws + W_MB);
    for (int g = gw; g < 1024; g += nw) {
      const float* src = p.in[I_MEMP] + (size_t)g * 1024;
      float4 v[4]; float ss = 0.f;
#pragma unroll
      for (int i = 0; i < 4; ++i) { v[i] = *(const float4*)(src + i * 256 + lane * 4); ss += v[i].x * v[i].x + v[i].y * v[i].y + v[i].z * v[i].z + v[i].w * v[i].w; }
      ss = wave_sum(ss);
      float rs = rsqrtf(ss * (1.f / 1024.f) + 1e-6f);
#pragma unroll
      for (int i = 0; i < 4; ++i) {
        uint2 w; w.x = pack2(v[i].x * rs, v[i].y * rs); w.y = pack2(v[i].z * rs, v[i].w * rs);
        *(uint2*)(MB + (size_t)g * 1024 + i * 256 + lane * 4) = w;
      }
    }
  }
  {
    float2* RT = (float2*)(p.ws + W_ROPE);
    for (int e = blockIdx.x * NTHR + tid; e < 4096 * 16; e += G * NTHR) {
      int pos = e >> 4, i = e & 15;
      float inv = powf(10000.f, -(float)i / 16.f);
      float ang = (float)pos * inv;
      float sn, cs; sincosf(ang, &sn, &cs);
      RT[e] = make_float2(cs, sn);
    }
  }
  int rot = 0;
  for (int l = 0; l < NL; ++l) {
    u16* WT = (u16*)(p.ws + W_WT) + (size_t)l * WE_LAYER;
    for (int f = 0; f < 2; ++f) {
      const float* nrm = p.in[f ? I_F2N : I_F1N] + l * 1024;
      const float* wg = p.in[f ? I_F2G : I_F1G] + (size_t)l * 1024 * DFF;
      const float* wu = p.in[f ? I_F2U : I_F1U] + (size_t)l * 1024 * DFF;
      const float* wd = p.in[f ? I_F2D : I_F1D] + (size_t)l * 1024 * DFF;
      tconv(WT + (f ? WE_GU2 : WE_GU1), 1024, 5632, 1024, rot, [=](int k, int n) {
        int j = (n >> 5) * 16 + (n & 15);
        const float* s = ((n >> 4) & 1) ? wu : wg;
        return nrm[k] * s[(size_t)k * DFF + j];
      });
      rot += 88 * 16;
      tconv(WT + (f ? WE_D2 : WE_D1), DFF, 1024, DFF, rot, [=](int k, int n) { return wd[(size_t)k * 1024 + n]; });
      rot += 16 * 44;
    }
    {
      const float* nrm = p.in[I_MIXN] + l * 1024; const float* w = p.in[I_WIN] + (size_t)l * 1024 * DIN;
      tconv(WT + WE_IN, 1024, DINP, 1024, rot, [=](int k, int n) { return n < DIN ? nrm[k] * w[(size_t)k * DIN + n] : 0.f; });
      rot += 36 * 16;
    }
    {
      const float* nrm = p.in[I_QN] + l * 256; const float* wuq = p.in[I_WUQ] + (size_t)l * 256 * 768;
      const float* wuk = p.in[I_WUK] + (size_t)l * 8 * 128 * 64;
      tconv(WT + WE_Q, 256, 1280, 256, rot, [=](int k, int n) {
        float r;
        if (n < 1024) {
          int h = n >> 7, c = n & 127;
          const float* a = wuq + (size_t)k * 768 + h * 96; const float* b = wuk + (size_t)(h * 128 + c) * 64;
          r = 0.f;
          for (int d = 0; d < 64; ++d) r += a[d] * b[d];
        } else {
          int hr = n - 1024;
          r = wuq[(size_t)k * 768 + (hr >> 5) * 96 + 64 + (hr & 31)];
        }
        return r * nrm[k] * QSCALE;
      });
      rot += 20 * 4;
    }
    {
      const float* wup = p.in[I_WUP] + (size_t)l * 64 * 512; const float* aup = p.in[I_AUP] + (size_t)l * 64 * 512;
      const float* gup = p.in[I_GUP] + (size_t)l * 128 * 512;
      tconv(WT + WE_RW, 256, 1536, 256, rot, [=](int k, int n) {
        if (n < 512) return k < 64 ? wup[k * 512 + n] : 0.f;
        if (n < 1024) return (k >= 64 && k < 128) ? aup[(k - 64) * 512 + n - 512] : 0.f;
        return k >= 128 ? gup[(k - 128) * 512 + n - 1024] : 0.f;
      });
      rot += 24 * 4;
    }
    {
      const float* wuv = p.in[I_WUV] + (size_t)l * 8 * 128 * 64; const float* wo = p.in[I_WOUT] + (size_t)l * 1024 * 1024;
      tconv(WT + WE_OUT, 1536, 1024, 1536, rot, [=](int k, int n) {
        if (k < 1024) {
          int h = k >> 7, c = k & 127;
          const float* a = wuv + (size_t)(h * 128 + c) * 64; const float* b = wo + (size_t)(h * 64) * 1024 + n;
          float r = 0.f;
          for (int v = 0; v < 64; ++v) r += a[v] * b[(size_t)v * 1024];
          return r;
        }
        return wo[(size_t)(512 + k - 1024) * 1024 + n];
      });
      rot += 16 * 24;
    }
    {
      const float* nx = p.in[I_XN] + l * 1024; const float* nm = p.in[I_MKVN] + l * 1024;
      const float* wq = p.in[I_WMQ] + (size_t)l * 1048576; const float* wk = p.in[I_WMK] + (size_t)l * 1048576;
      const float* wv = p.in[I_WMV] + (size_t)l * 1048576; const float* wo = p.in[I_WMO] + (size_t)l * 1048576;
      tconv(WT + WE_MQ, 1024, 1024, 1024, rot, [=](int k, int n) { return nx[k] * wq[(size_t)k * 1024 + n] * XSCALE; });
      tconv(WT + WE_MK, 1024, 1024, 1024, rot, [=](int k, int n) { return nm[k] * wk[(size_t)k * 1024 + n]; });
      tconv(WT + WE_MV, 1024, 1024, 1024, rot, [=](int k, int n) { return nm[k] * wv[(size_t)k * 1024 + n]; });
      tconv(WT + WE_MO, 1024, 1024, 1024, rot, [=](int k, int n) { return wo[(size_t)k * 1024 + n]; });
    }
  }
}

__device__ __forceinline__ void phase_prep(KPR p, int l) {
  extern __shared__ __attribute__((aligned(16))) char smem[];
  u16* sv = (u16*)smem;
  const int tid = tidx(), wid = tid >> 6, lane = tid & 63;
  const u16* PROJ = (const u16*)(p.ws + W_PROJ);
  u16* CQB = (u16*)(p.ws + W_CQB); u16* A2 = (u16*)(p.ws + W_A2);
  float* RB = (float*)(p.ws + W_RB); float* KB = (float*)(p.ws + W_KB); float* VB = (float*)(p.ws + W_VB); float* KKB = (float*)(p.ws + W_KKB);
  u16* KP = (u16*)(p.ws + W_KP); u16* KS = (u16*)(p.ws + W_KS); u16* VTP = (u16*)(p.ws + W_VTP); u16* VTS = (u16*)(p.ws + W_VTS);
  const float2* RT = (const float2*)(p.ws + W_ROPE);
  const float* kvn = p.in[I_KVN] + l * 128; const float* mu = p.in[I_MU] + l * DSH; const float* kkw = p.in[I_KK] + l * 512;
  for (int chunk = blockIdx.x; chunk < T / 72; chunk += gridDim.x) {
  __syncthreads();
  uint2 n_cq; unsigned n_ckv; u16 n_k1 = 0, n_k2 = 0; uint4 n_pb0, n_pb1, n_pb2, n_pb3 = make_uint4(0, 0, 0, 0);
  uint4 q_pb0, q_pb1, q_pb2, q_pb3 = make_uint4(0, 0, 0, 0);
#define PREP_LOAD(ROW) do { const u16* pr_ = PROJ + (size_t)(ROW) * DINP; \
    n_cq = *(const uint2*)(pr_ + lane * 4); n_ckv = *(const unsigned*)(pr_ + 256 + lane * 2); \
    if (lane < 16) { n_k1 = pr_[384 + lane]; n_k2 = pr_[400 + lane]; } \
    n_pb0 = *(const uint4*)(pr_ + 416 + lane * 8); n_pb1 = *(const uint4*)(pr_ + 416 + 512 + lane * 8); \
    n_pb2 = *(const uint4*)(pr_ + 416 + 1024 + lane * 8); if (lane < 32) n_pb3 = *(const uint4*)(pr_ + 416 + 1536 + lane * 8); } while (0)
  {
    const int gfirst = chunk * 72 + wid * 9;
    if (gfirst > 0) { PREP_LOAD(gfirst - 1); q_pb0 = n_pb0; q_pb1 = n_pb1; q_pb2 = n_pb2; q_pb3 = n_pb3; }
    else { q_pb0 = q_pb1 = q_pb2 = make_uint4(0, 0, 0, 0); }
    PREP_LOAD(gfirst);
  }
  for (int ri = 0; ri < 9; ++ri) {
    const int rl = wid * 9 + ri, g = chunk * 72 + rl;
    const u16* pr = PROJ + (size_t)g * DINP;
    const uint2 c_cq = n_cq; const unsigned c_ckv = n_ckv; const u16 c_k1 = n_k1, c_k2 = n_k2;
    const uint4 c_pb0 = n_pb0, c_pb1 = n_pb1, c_pb2 = n_pb2, c_pb3 = n_pb3;
    { const int gn = g + 1 < T ? g + 1 : g; PREP_LOAD(gn); }
    const bool isP = g < TP;
    int b, t, pos, tlen;
    if (isP) { b = g >> 12; t = g & 4095; pos = t; tlen = 4096; } else { int gg = g - TP; b = gg >> 6; t = gg & 63; pos = 2048 + t; tlen = 64; }
    {
      uint2 w = c_cq;
      float v0 = bf2f(w.x & 0xffff), v1 = bf2f(w.x >> 16), v2 = bf2f(w.y & 0xffff), v3 = bf2f(w.y >> 16);
      float ss = wave_sum(v0 * v0 + v1 * v1 + v2 * v2 + v3 * v3);
      float rs = rsqrtf(ss * (1.f / 256.f) + 1e-6f);
      uint2 o; o.x = pack2(v0 * rs, v1 * rs); o.y = pack2(v2 * rs, v3 * rs);
      *(uint2*)(CQB + (size_t)g * 256 + lane * 4) = o;
    }
    {
      unsigned w = c_ckv;
      float v0 = bf2f(w & 0xffff), v1 = bf2f(w >> 16);
      float ss = wave_sum(v0 * v0 + v1 * v1);
      float rs = rsqrtf(ss * (1.f / 128.f) + 1e-6f);
      int c = lane * 2;
      v0 = v0 * rs * kvn[c]; v1 = v1 * rs * kvn[c + 1];
      float* of = isP ? p.out + OO_CKVP + ((size_t)(l * 4 + b) * 4096 + t) * 128 : p.out + OO_CKVS + ((size_t)(l * 32 + b) * 64 + t) * 128;
      *(float2*)(of + c) = make_float2(v0, v1);
      u16* kr = isP ? KP + ((size_t)b * 4096 + t) * 160 : KS + ((size_t)b * 2112 + 2048 + t) * 160;
      *(unsigned*)(kr + c) = pack2(v0, v1);
      *(unsigned*)(sv + rl * 128 + c) = pack2(v0, v1);
      if (lane < 16) {
        float x1 = bf2f(c_k1), x2 = bf2f(c_k2);
        float2 cs = RT[pos * 16 + lane];
        float o1 = x1 * cs.x - x2 * cs.y, o2 = x1 * cs.y + x2 * cs.x;
        float* okr = isP ? p.out + OO_KRP + ((size_t)(l * 4 + b) * 4096 + t) * 32 : p.out + OO_KRS + ((size_t)(l * 32 + b) * 64 + t) * 32;
        okr[lane] = o1; okr[lane + 16] = o2;
        kr[128 + lane] = f2bf(o1); kr[144 + lane] = f2bf(o2);
      }
    }
    {
      const u16* pb = pr + 416;
      const u16* pp = pr - DINP + 416;
      const float* sh0 = p.in[I_SSH] + (size_t)(l * 32 + b) * DSH;
      const bool last = (t == tlen - 1);
      float* osh = isP ? p.out + OO_SHP + (size_t)(l * 4 + b) * DSH : p.out + OO_SHS + (size_t)(l * 32 + b) * DSH;
#pragma unroll
      for (int it = 0; it < 4; ++it) {
        const int c = it * 64 + lane;
        if (c < 224) {
          const int e = c * 8;
          const uint4 w = it == 0 ? c_pb0 : (it == 1 ? c_pb1 : (it == 2 ? c_pb2 : c_pb3));
          float pv[8] = {bf2f(w.x & 0xffff), bf2f(w.x >> 16), bf2f(w.y & 0xffff), bf2f(w.y >> 16), bf2f(w.z & 0xffff), bf2f(w.z >> 16), bf2f(w.w & 0xffff), bf2f(w.w >> 16)};
          float pq[8];
          if (t > 0) {
            const uint4 q = it == 0 ? q_pb0 : (it == 1 ? q_pb1 : (it == 2 ? q_pb2 : q_pb3));
            pq[0] = bf2f(q.x & 0xffff); pq[1] = bf2f(q.x >> 16); pq[2] = bf2f(q.y & 0xffff); pq[3] = bf2f(q.y >> 16);
            pq[4] = bf2f(q.z & 0xffff); pq[5] = bf2f(q.z >> 16); pq[6] = bf2f(q.w & 0xffff); pq[7] = bf2f(q.w >> 16);
          } else if (!isP) {
            float4 q0 = *(const float4*)(sh0 + e), q1 = *(const float4*)(sh0 + e + 4);
            pq[0] = q0.x; pq[1] = q0.y; pq[2] = q0.z; pq[3] = q0.w; pq[4] = q1.x; pq[5] = q1.y; pq[6] = q1.z; pq[7] = q1.w;
          } else {
#pragma unroll
            for (int j = 0; j < 8; ++j) pq[j] = 0.f;
          }
          float4 m0 = *(const float4*)(mu + e), m1 = *(const float4*)(mu + e + 4);
          float mm[8] = {m0.x, m0.y, m0.z, m0.w, m1.x, m1.y, m1.z, m1.w};
          float xs[8];
#pragma unroll
          for (int j = 0; j < 8; ++j) xs[j] = pv[j] + mm[j] * (pq[j] - pv[j]);
          if (last) { *(float4*)(osh + e) = make_float4(pv[0], pv[1], pv[2], pv[3]); *(float4*)(osh + e + 4) = make_float4(pv[4], pv[5], pv[6], pv[7]); }
          if (it == 0) {
            *(uint4*)((u16*)RB + (size_t)g * 512 + e) = make_uint4(pack2(xs[0], xs[1]), pack2(xs[2], xs[3]), pack2(xs[4], xs[5]), pack2(xs[6], xs[7]));
          } else if (it == 1) {
            const int cc = e - 512;
            *(uint4*)((u16*)KB + (size_t)g * 512 + cc) = make_uint4(pack2(xs[0], xs[1]), pack2(xs[2], xs[3]), pack2(xs[4], xs[5]), pack2(xs[6], xs[7]));
            float4 k0 = *(const float4*)(kkw + cc), k1 = *(const float4*)(kkw + cc + 4);
            float kk[8] = {xs[0] * k0.x, xs[1] * k0.y, xs[2] * k0.z, xs[3] * k0.w, xs[4] * k1.x, xs[5] * k1.y, xs[6] * k1.z, xs[7] * k1.w};
            float ss = 0.f;
#pragma unroll
            for (int j = 0; j < 8; ++j) ss += kk[j] * kk[j];
            ss = dpp_sum8(ss);
            float rn = rsqrtf(ss + 1e-12f);
            *(uint4*)((u16*)KKB + (size_t)g * 512 + cc) = make_uint4(pack2(kk[0] * rn, kk[1] * rn), pack2(kk[2] * rn, kk[3] * rn), pack2(kk[4] * rn, kk[5] * rn), pack2(kk[6] * rn, kk[7] * rn));
          } else if (it == 2) {
            *(uint4*)((u16*)VB + (size_t)g * 512 + (e - 1024)) = make_uint4(pack2(xs[0], xs[1]), pack2(xs[2], xs[3]), pack2(xs[4], xs[5]), pack2(xs[6], xs[7]));
          } else {
            const int cc = e - 1536;
            float y[8];
#pragma unroll
            for (int j = 0; j < 8; ++j) y[j] = cc < 64 ? (1.f - 2.f / (1.f + __expf(2.f * xs[j]))) : (cc < 128 ? xs[j] : sigmoidf_(xs[j]));
            uint4 o; o.x = pack2(y[0], y[1]); o.y = pack2(y[2], y[3]); o.z = pack2(y[4], y[5]); o.w = pack2(y[6], y[7]);
            *(uint4*)(A2 + (size_t)g * 256 + cc) = o;
          }
        }
      }
    }
    q_pb0 = c_pb0; q_pb1 = c_pb1; q_pb2 = c_pb2; q_pb3 = c_pb3;
  }
#undef PREP_LOAD
  __syncthreads();
  for (int idx = tid; idx < 128 * 9; idx += NTHR) {
    const int d = idx & 127, rl0 = (idx >> 7) * 8, g = chunk * 72 + rl0;
    unsigned w[4];
#pragma unroll
    for (int j = 0; j < 4; ++j) w[j] = (unsigned)sv[(rl0 + 2 * j) * 128 + d] | ((unsigned)sv[(rl0 + 2 * j + 1) * 128 + d] << 16);
    u16* dst;
    if (g < TP) dst = VTP + ((size_t)(g >> 12) * 128 + d) * 4096 + (g & 4095);
    else { const int gg = g - TP; dst = VTS + ((size_t)(gg >> 6) * 128 + d) * 2112 + 2048 + (gg & 63); }
    *(uint4*)dst = make_uint4(w[0], w[1], w[2], w[3]);
  }
  }
}

__device__ __forceinline__ void conv_caches(KPR p, int l, int vb, int nvb) {
  const int tid = tidx();
  u16* KS = (u16*)(p.ws + W_KS); u16* VTS = (u16*)(p.ws + W_VTS);
  {
    const float* cckv = p.in[I_CCKV] + (size_t)l * 32 * 2048 * 128;
    const float* ckr = p.in[I_CKR] + (size_t)l * 32 * 2048 * 32;
    for (int idx = vb * NTHR + tid; idx < 32 * 2048 * 20; idx += nvb * NTHR) {
      int rowi = idx / 20, ch = idx % 20;
      int b = rowi >> 11, t = rowi & 2047;
      const float* s = ch < 16 ? cckv + (size_t)rowi * 128 + ch * 8 : ckr + (size_t)rowi * 32 + (ch - 16) * 8;
      float4 a = *(const float4*)s, c = *(const float4*)(s + 4);
      uint4 o; o.x = pack2(a.x, a.y); o.y = pack2(a.z, a.w); o.z = pack2(c.x, c.y); o.w = pack2(c.z, c.w);
      *(uint4*)(KS + ((size_t)b * 2112 + t) * 160 + ch * 8) = o;
    }
    tconv_v(VTS, 2112, 4096, 2048, vb, nvb, [=](int k, int n) { return cckv[((size_t)(n >> 7) * 2048 + k) * 128 + (n & 127)]; });
    const float* cmk = p.in[I_CMK] + (size_t)l * 32 * 256 * 1024;
    const float* cmv = p.in[I_CMV] + (size_t)l * 32 * 256 * 1024;
    u16* MKS = (u16*)(p.ws + W_MKS); u16* MVTS = (u16*)(p.ws + W_MVTS);
    for (int idx = vb * NTHR + tid; idx < 32 * 4 * 256 * 32; idx += nvb * NTHR) {
      int d8 = idx & 31, m = (idx >> 5) & 255, h = (idx >> 13) & 3, b = idx >> 15;
      const float* s = cmk + ((size_t)(b * 256 + m) * 4 + h) * 256 + d8 * 8;
      float4 a = *(const float4*)s, c = *(const float4*)(s + 4);
      uint4 o; o.x = pack2(a.x, a.y); o.y = pack2(a.z, a.w); o.z = pack2(c.x, c.y); o.w = pack2(c.z, c.w);
      *(uint4*)(MKS + (size_t)idx * 8) = o;
    }
    tconv_v(MVTS, 256, 32768, 256, vb, nvb, [=](int k, int n) { return cmv[((size_t)((n >> 10) * 256 + k) * 4 + ((n >> 8) & 3)) * 256 + (n & 255)]; });
  }
}

__device__ __forceinline__ void mla_sub(KPR p, int b, int c, int half) {
  const u16* QB = (const u16*)(p.ws + W_QB); u16* AO = (u16*)(p.ws + W_AO);
  size_t tok = (size_t)b * 4096 + c * 64 + half * 32;
  attn_item<160, 128, 8>(QB + tok * 1280, 160, 256, (const u16*)(p.ws + W_KP) + (size_t)b * 4096 * 160, 160,
                         (const u16*)(p.ws + W_VTP) + (size_t)b * 128 * 4096, 4096, (c + 1) * 64, AO + tok * 1536, 1536);
}
__device__ __forceinline__ void phase_mix(KPR p, int l, int mode = 0) {
  extern __shared__ __attribute__((aligned(16))) char smem[];
  int* sItem = (int*)(smem + SMEM_ITEM);
  int* cnt = (int*)(p.ws + W_CNT) + l + mode * 8;
  for (;;) {
    __syncthreads();
    if (threadIdx.x == 0) *sItem = atomicAdd(cnt, 1);
    __syncthreads();
    int it = *sItem;
    if (it >= 864) break;
    if (mode == 2 && (it < 32 || it >= 608)) continue;
    if (it < 32) {
      int b = it >> 3, h = it & 7;
      cseq_item(p, b * 4096, h, 64, (b * 8 + h) * 64, nullptr, p.out + OO_WKVP + ((size_t)(l * 4 + b) * 8 + h) * 4096);
    } else if (it < 608) {
      int k = it - 32;
      if (k >= 248 && k < 312) {
        int j = k - 248; int b = j >> 1, half = j & 1;
        const u16* QB = (const u16*)(p.ws + W_QB); u16* AO = (u16*)(p.ws + W_AO);
        size_t tok = (size_t)TP + b * 64 + half * 32;
        attn_item<160, 128, 8>(QB + tok * 1280, 160, 256, (const u16*)(p.ws + W_KS) + (size_t)b * 2112 * 160, 160,
                               (const u16*)(p.ws + W_VTS) + (size_t)b * 128 * 2112, 2112, 2112, AO + tok * 1536, 1536);
      } else {
        if (k >= 312) k -= 64;
        int c = 63 - (k >> 3), b = (k >> 1) & 3, half = k & 1;
        mla_sub(p, b, c, half);
      }
    } else {
      int k = it - 608; int b = k >> 3, h = k & 7;
      cseq_item(p, TP + b * 64, h, 1, 2048 + k, p.in[I_SWKV] + ((size_t)(l * 32 + b) * 8 + h) * 4096,
                p.out + OO_WKVS + ((size_t)(l * 32 + b) * 8 + h) * 4096);
    }
  }
}

__device__ __forceinline__ void xattn_item(KPR p, int l, int it) {
  const u16* QX = (const u16*)(p.ws + W_QX); u16* XO = (u16*)(p.ws + W_XO);
  if (it < 256) {
    int b = it >> 6, h = (it >> 4) & 3, qt = it & 15;
    size_t tok = (size_t)b * 4096 + qt * 256;
    for (int hv = 0; hv < 2; ++hv)
      attn_item<256, 128, 1>(QX + tok * 1024 + h * 256, 1024, 256, (const u16*)(p.ws + W_MKP) + (size_t)((l * 4 + b) * 4 + h) * 65536, 256,
                             (const u16*)(p.ws + W_MVTP) + (size_t)((l * 4 + b) * 4 + h) * 65536 + hv * 128 * 256, 256, 256, XO + tok * 1024 + h * 256 + hv * 128, 1024);
  } else {
    int k = it - 256; int b = k >> 2, h = k & 3;
    size_t tok = (size_t)TP + b * 64;
    for (int hv = 0; hv < 2; ++hv)
      attn_item<256, 128, 1>(QX + tok * 1024 + h * 256, 1024, 64, (const u16*)(p.ws + W_MKS) + (size_t)(b * 4 + h) * 65536, 256,
                             (const u16*)(p.ws + W_MVTS) + (size_t)(b * 4 + h) * 65536 + hv * 128 * 256, 256, 256, XO + tok * 1024 + h * 256 + hv * 128, 1024);
  }
}

constexpr int CH_NST = 10;
__device__ __forceinline__ void phase_chain(KPR p, int ci, int dup = 0) {
  extern __shared__ __attribute__((aligned(16))) char smem[];
  int* sItem = (int*)(smem + SMEM_ITEM);
  int* CT = (int*)(p.ws + W_CNT) + dup * 8192;
  const float rc = dup ? 0.f : 1.f;
  int* q = CT + 3800 + ci; int* xa = CT + 72 + ci; int* oa = CT + 80 + ci;
  int* cnt = CT + 128 + ci * CH_NST * 72;
  int* stamp = CT + 4096 + ci * CH_NST * 72;
  int* G = CT + 8000 + ci; int* xast = CT + 8010 + ci; int* oast = CT + 8020 + ci;
  int lastG = 0;
  const bool hasTail = ci >= 1, hasHead = ci < NL;
  const int lt = ci - 1, lh = ci;
  const int e0 = hasTail ? 288 : 0, e1 = e0 + (hasTail ? 288 : 0), e2 = e1 + (hasTail ? 384 : 0), e3 = e2 + (hasTail ? 288 : 0),
            e4 = e3 + (hasTail ? 792 : 0), e5 = e4 + (hasTail ? 288 : 0), e6 = e5 + (hasHead ? 792 : 0), e7 = e6 + (hasHead ? 288 : 0),
            e8 = e7 + (hasHead ? 224 : 0), e9 = e8 + (hasHead ? 648 : 0);
  float* X = (float*)(p.ws + W_X); u16* XB = (u16*)(p.ws + W_XB); float* SSQ = (float*)(p.ws + W_SSQ); u16* ACT = (u16*)(p.ws + W_ACT);
  const int grp = blockIdx.x & 7;
  int nxt = 0;
  if (tidx() == 0) nxt = atomicAdd(q + grp * 8, 1) * 8 + grp;
  for (;;) {
    const int tid = tidx();
    if (tid == 0) {
      const int it = nxt;
      if (it < e9) {
        int st, idx;
        if (it < e0) { st = 0; idx = it; } else if (it < e1) { st = 1; idx = it - e0; } else if (it < e2) { st = 2; idx = it - e1; }
        else if (it < e3) { st = 3; idx = it - e2; } else if (it < e4) { st = 4; idx = it - e3; } else if (it < e5) { st = 5; idx = it - e4; }
        else if (it < e6) { st = 6; idx = it - e5; } else if (it < e7) { st = 7; idx = it - e6; } else if (it < e8) { st = 8; idx = it - e7; }
        else { st = 9; idx = it - e8; }
        int pm = 0, pn = 0;
        if (st == 2) pm = idx < 256 ? ((idx >> 6) * 16 + (idx & 15)) : (64 + ((idx - 256) >> 4));
        else if (st != 8) tile_map(idx, 72, (st == 4 || st == 6) ? 11 : (st == 9 ? 9 : 4), pm, pn);
        const int* c1 = nullptr; const int* c2 = nullptr;
        switch (st) {
          case 1: c1 = stamp + 0 * 72 + pm; break;
          case 2: c1 = stamp + 1 * 72 + pm; break;
          case 3: c1 = stamp + 2 * 72 + pm; break;
          case 4: c1 = stamp + 3 * 72 + pm; c2 = xast; break;
          case 5: c1 = stamp + 4 * 72 + pm; break;
          case 6: if (hasTail) c1 = stamp + 5 * 72 + pm; break;
          case 7: c1 = stamp + 6 * 72 + pm; break;
          case 8: if (hasTail) c1 = xast; break;
          case 9: c1 = stamp + 7 * 72 + pm; if (hasTail) c2 = oast; break;
          default: break;
        }
        if (dup) { c1 = nullptr; c2 = nullptr; }
        int s1 = 0, s2 = 0;
        if (c1) while ((s1 = __hip_atomic_load(c1, __ATOMIC_RELAXED, __HIP_MEMORY_SCOPE_AGENT)) == 0) __builtin_amdgcn_s_sleep(4);
        if (c2) while ((s2 = __hip_atomic_load(c2, __ATOMIC_RELAXED, __HIP_MEMORY_SCOPE_AGENT)) == 0) __builtin_amdgcn_s_sleep(4);
        if ((s1 > s2 ? s1 : s2) >= lastG) {
          const int g = __hip_atomic_load(G, __ATOMIC_RELAXED, __HIP_MEMORY_SCOPE_AGENT);
          __builtin_amdgcn_fence(__ATOMIC_ACQUIRE, "agent");
          asm volatile("s_waitcnt vmcnt(0)" ::: "memory");
          lastG = g;
        }
        sItem[1] = st; sItem[2] = idx; sItem[3] = pm; sItem[4] = pn;
      }
      sItem[0] = it;
    }
    __syncthreads();
    if (sItem[0] >= e9) break;
    const int st = sItem[1], idx = sItem[2], pm = sItem[3], pn = sItem[4];
    if (tid == 0) nxt = atomicAdd(q + grp * 8, 1) * 8 + grp;
    if (dup && !((PROBE_MASK >> st) & 1)) { __syncthreads(); continue; }
    const u16* WTt = (const u16*)(p.ws + W_WT) + (size_t)(lt < 0 ? 0 : lt) * WE_LAYER;
    const u16* WTh = (const u16*)(p.ws + W_WT) + (size_t)(lh >= NL ? 0 : lh) * WE_LAYER;
    switch (st) {
      case 0: gemm_tile((const u16*)(p.ws + W_AO), WTt + WE_OUT, 1536, pm, pn, EpiRes{X, XB, SSQ, rc}); break;
      case 1: gemm_tile(XB, WTt + WE_MQ, 1024, pm, pn, EpiScaleBf{SSQ, (u16*)(p.ws + W_QX), 1024}); break;
      case 2: xattn_item(p, lt, idx); break;
      case 3: gemm_tile((const u16*)(p.ws + W_XO), WTt + WE_MO, 1024, pm, pn, EpiRes{X, XB, SSQ, rc}); break;
      case 4: gemm_tile(XB, WTt + WE_GU2, 1024, pm, 2 * pn, EpiGU{SSQ, ACT}); gemm_tile(XB, WTt + WE_GU2, 1024, pm, 2 * pn + 1, EpiGU{SSQ, ACT}); break;
      case 5: gemm_tile(ACT, WTt + WE_D2, DFF, pm, pn, EpiRes{X, XB, SSQ, 0.5f * rc}); break;
      case 6: gemm_tile(XB, WTh + WE_GU1, 1024, pm, 2 * pn, EpiGU{SSQ, ACT}); gemm_tile(XB, WTh + WE_GU1, 1024, pm, 2 * pn + 1, EpiGU{SSQ, ACT}); break;
      case 7: gemm_tile(ACT, WTh + WE_D1, DFF, pm, pn, EpiRes{X, XB, SSQ, 0.5f * rc}); break;
      case 8: conv_caches(p, lh, idx, 224); break;
      default: gemm_tile(XB, WTh + WE_IN, 1024, pm, pn, EpiScaleBf{SSQ, (u16*)(p.ws + W_PROJ), DINP}); break;
    }
    asm volatile("s_waitcnt vmcnt(0)" ::: "memory");
    __syncthreads();
    if (tidx() == 64) {
      __builtin_amdgcn_fence(__ATOMIC_RELEASE, "agent");
      asm volatile("s_waitcnt vmcnt(0)" ::: "memory");
      atomicAdd(G, 1);
      const int full = (st == 4 || st == 6) ? 11 : (st == 9 ? 9 : (st == 2 ? (pm < 64 ? 4 : 16) : 4));
      if (atomicAdd(cnt + st * 72 + pm, 1) + 1 == full)
        __hip_atomic_store(stamp + st * 72 + pm, __hip_atomic_load(G, __ATOMIC_RELAXED, __HIP_MEMORY_SCOPE_AGENT), __ATOMIC_RELAXED, __HIP_MEMORY_SCOPE_AGENT);
      if (st == 2 && atomicAdd(xa, 1) + 1 == 384)
        __hip_atomic_store(xast, __hip_atomic_load(G, __ATOMIC_RELAXED, __HIP_MEMORY_SCOPE_AGENT), __ATOMIC_RELAXED, __HIP_MEMORY_SCOPE_AGENT);
      if (st == 0 && atomicAdd(oa, 1) + 1 == 288)
        __hip_atomic_store(oast, __hip_atomic_load(G, __ATOMIC_RELAXED, __HIP_MEMORY_SCOPE_AGENT), __ATOMIC_RELAXED, __HIP_MEMORY_SCOPE_AGENT);
    }
  }
}

__device__ __forceinline__ void phase_final(KPR p) {
  const int tid = tidx(), wid = tid >> 6, lane = tid & 63;
  const float* X = (const float*)(p.ws + W_X); const float* fn = p.in[I_FN];
  for (int g = blockIdx.x * 8 + wid; g < T; g += gridDim.x * 8) {
    float4 v[4]; float ss = 0.f;
#pragma unroll
    for (int i = 0; i < 4; ++i) { v[i] = *(const float4*)(X + (size_t)g * 1024 + i * 256 + lane * 4); ss += v[i].x * v[i].x + v[i].y * v[i].y + v[i].z * v[i].z + v[i].w * v[i].w; }
    ss = wave_sum(ss);
    float rs = rsqrtf(ss * (1.f / 1024.f) + 1e-6f);
#pragma unroll
    for (int i = 0; i < 4; ++i) {
      float4 gn = *(const float4*)(fn + i * 256 + lane * 4);
      *(float4*)(p.out + OO_Y + (size_t)g * 1024 + i * 256 + lane * 4) = make_float4(v[i].x * rs * gn.x, v[i].y * rs * gn.y, v[i].z * rs * gn.z, v[i].w * rs * gn.w);
    }
  }
}

constexpr int NPL = 6;
constexpr int N_PHASES = 3 + NPL * NL + 1;

__device__ __forceinline__ void run_phase(KPR p, int ph) {
  if (ph == 0) { phase_init(p); return; }
  if (ph == 1) {
    for (int l = 0; l < NL; ++l) {
      const u16* WT = (const u16*)(p.ws + W_WT) + (size_t)l * WE_LAYER;
      gemm_phase((const u16*)(p.ws + W_MB), WT + WE_MK, 1024, 4, 4, (2 * l) * 16,
                 EpiMem<false>{p.out + OO_MKP + (size_t)l * 1048576, (u16*)(p.ws + W_MKP) + (size_t)l * 16 * 65536});
      gemm_phase((const u16*)(p.ws + W_MB), WT + WE_MV, 1024, 4, 4, (2 * l + 1) * 16,
                 EpiMem<true>{p.out + OO_MVP + (size_t)l * 1048576, (u16*)(p.ws + W_MVTP) + (size_t)l * 16 * 65536});
    }
    return;
  }
  if (ph == 2) { phase_chain(p, 0); if (PROBE_REP & 1) { cg::this_grid().sync(); phase_chain(p, 0, 1); } return; }
  if (ph == N_PHASES - 1) { if (PROBE_REP & 64) for (int i = 0; i < 40; ++i) cg::this_grid().sync(); phase_final(p); return; }
  const int l = (ph - 3) / NPL, s = (ph - 3) % NPL;
  const u16* WT = (const u16*)(p.ws + W_WT) + (size_t)l * WE_LAYER;
  switch (s) {
    case 0: phase_prep(p, l); if (PROBE_REP & 2) { cg::this_grid().sync(); phase_prep(p, l); } break;
    case 1:
      gemm_phase((const u16*)(p.ws + W_CQB), WT + WE_Q, 256, 72, 5, 0, EpiQ{(u16*)(p.ws + W_QB), (const float2*)(p.ws + W_ROPE)});
      gemm_phase((const u16*)(p.ws + W_A2), WT + WE_RW, 256, 72, 6, 360,
                 EpiRW{p.in[I_W0] + l * 512, p.in[I_A0] + l * 512, p.in[I_KA] + l * 512, p.ws});
      break;
    case 2: phase_cprep(p); if (PROBE_REP & 8) { cg::this_grid().sync(); phase_cprep(p); } break;
    case 3: phase_mix(p, l, 0); if (PROBE_REP & 16) { cg::this_grid().sync(); phase_mix(p, l, 2); } break;
    case 4: phase_yfin(p, l); if (PROBE_REP & 32) { cg::this_grid().sync(); phase_yfin(p, l); } break;
    default: phase_chain(p, l + 1); if (PROBE_REP & 1) { cg::this_grid().sync(); phase_chain(p, l + 1, 1); } break;
  }
}

__device__ __forceinline__ void grid_barrier(int* CT, int gen) {
  asm volatile("s_waitcnt vmcnt(0)" ::: "memory");
  __syncthreads();
  if (tidx() == 0) {
    __builtin_amdgcn_fence(__ATOMIC_RELEASE, "agent");
    asm volatile("s_waitcnt vmcnt(0)" ::: "memory");
    int* grpc = CT + 15000 + (blockIdx.x & 7) * 32;
    int* glob = CT + 15000 + 8 * 32;
    const int per = gridDim.x >> 3;
    if (atomicAdd(grpc, 1) + 1 == per * (gen + 1)) atomicAdd(glob, 1);
    while (__hip_atomic_load(glob, __ATOMIC_RELAXED, __HIP_MEMORY_SCOPE_AGENT) < 8 * (gen + 1)) __builtin_amdgcn_s_sleep(1);
    __builtin_amdgcn_fence(__ATOMIC_ACQUIRE, "agent");
    asm volatile("s_waitcnt vmcnt(0)" ::: "memory");
  }
  __syncthreads();
}

__global__ void __launch_bounds__(NTHR) mega(Params p) {
  cg::grid_group grid = cg::this_grid();
  for (int ph = p.ph_lo; ph < p.ph_hi; ++ph) {
    const __attribute__((address_space(4))) Params* q = (const __attribute__((address_space(4))) Params*)__builtin_amdgcn_kernarg_segment_ptr();
    asm volatile("" : "+s"(q));
    run_phase(*q, ph);
    if (ph + 1 < p.ph_hi) {
      if (ph == p.ph_lo) grid.sync();
      else grid_barrier((int*)(q->ws + W_CNT), ph - p.ph_lo - 1);
    }
  }
}

extern "C" void kernel_launch(void* const* d_in, const int* in_sizes, int n_in, void* d_out, int out_size, void* d_ws,
                              size_t ws_size, hipStream_t stream) {
  static int grid = 0;
  if (grid == 0) {
    if (n_in != N_IN || (size_t)out_size != OO_END || ws_size < W_END) {
      fprintf(stderr, "kernel_launch: unexpected shapes n_in=%d out=%d ws=%zu (need %zu)\n", n_in, out_size, ws_size, (size_t)W_END);
      grid = -1; return;
    }
    int dev = 0, cus = 0, per_cu = 0;
    hipGetDevice(&dev);
    hipDeviceGetAttribute(&cus, hipDeviceAttributeMultiprocessorCount, dev);
    hipFuncSetAttribute((const void*)mega, hipFuncAttributeMaxDynamicSharedMemorySize, SMEM_BYTES);
    hipOccupancyMaxActiveBlocksPerMultiprocessor(&per_cu, (const void*)mega, NTHR, SMEM_BYTES);
    if (per_cu < 1) { fprintf(stderr, "kernel_launch: occupancy query says %d blocks/CU\n", per_cu); per_cu = 1; }
    (void)hipGetLastError();
    grid = cus;
  }
  if (grid < 0) return;
  if (hipMemsetAsync((char*)d_ws + W_CNT, 0, 65536, stream) != hipSuccess) { fprintf(stderr, "kernel_launch: memset of control words failed\n"); return; }
  Params p{};
  for (int i = 0; i < N_IN; ++i) p.in[i] = (const float*)d_in[i];
  p.out = (float*)d_out; p.ws = (char*)d_ws;
#if N_LAUNCH_PER_PHASE
  for (int ph = 0; ph < N_PHASES; ++ph) {
    p.ph_lo = ph; p.ph_hi = ph + 1;
    void* args[] = {&p};
    hipError_t e = hipLaunchCooperativeKernel((const void*)mega, dim3(grid), dim3(NTHR), args, SMEM_BYTES, stream);
    if (e != hipSuccess) { fprintf(stderr, "launch failed: %s\n", hipGetErrorString(e)); break; }
  }
#else
  p.ph_lo = 0; p.ph_hi = N_PHASES;
  void* args[] = {&p};
  hipError_t e = hipLaunchCooperativeKernel((const void*)mega, dim3(grid), dim3(NTHR), args, SMEM_BYTES, stream);
  if (e != hipSuccess) fprintf(stderr, "cooperative launch failed: %s (grid %d)\n", hipGetErrorString(e), grid);
#endif
}
```

```cpp
#include <hip/hip_runtime.h>
#include <hip/hip_cooperative_groups.h>
#include <stdint.h>
#include <stdio.h>
namespace cg = cooperative_groups;

typedef unsigned short u16;
using bf16x8 = __attribute__((ext_vector_type(8))) short;
using f32x4 = __attribute__((ext_vector_type(4))) float;
using f32x16 = __attribute__((ext_vector_type(16))) float;

#ifndef REP_WHICH
#define REP_WHICH 0
#endif
#ifndef PROBE_REP
#define PROBE_REP 0
#endif
#ifndef PROBE_MASK
#define PROBE_MASK 0x3ff
#endif
#ifndef N_LAUNCH_PER_PHASE
#define N_LAUNCH_PER_PHASE 0
#endif

constexpr int TP = 16384, TS = 2048, T = TP + TS, NL = 4;
constexpr int DFF = 2816, DIN = 2208, DINP = 2304, DSH = 1792;
constexpr int NTHR = 512;
constexpr int SMEM_BYTES = 139264 + 2048;
constexpr int SMEM_ITEM = 139264 + 1024;
constexpr float QSCALE = 0.10206207261596577f * 1.4426950408889634f;
constexpr float XSCALE = 0.0625f * 1.4426950408889634f;

constexpr size_t OO_Y = 0;
constexpr size_t OO_CKVP = OO_Y + (size_t)T * 1024;
constexpr size_t OO_KRP = OO_CKVP + (size_t)NL * 4 * 4096 * 128;
constexpr size_t OO_MKP = OO_KRP + (size_t)NL * 4 * 4096 * 32;
constexpr size_t OO_MVP = OO_MKP + (size_t)NL * 4 * 256 * 1024;
constexpr size_t OO_WKVP = OO_MVP + (size_t)NL * 4 * 256 * 1024;
constexpr size_t OO_SHP = OO_WKVP + (size_t)NL * 4 * 8 * 4096;
constexpr size_t OO_CKVS = OO_SHP + (size_t)NL * 4 * DSH;
constexpr size_t OO_KRS = OO_CKVS + (size_t)NL * 32 * 64 * 128;
constexpr size_t OO_WKVS = OO_KRS + (size_t)NL * 32 * 64 * 32;
constexpr size_t OO_SHS = OO_WKVS + (size_t)NL * 32 * 8 * 4096;
constexpr size_t OO_END = OO_SHS + (size_t)NL * 32 * DSH;

constexpr size_t al256(size_t x) { return (x + 255) & ~(size_t)255; }
constexpr size_t W_X = 0;
constexpr size_t W_XB = W_X + al256((size_t)T * 1024 * 4);
constexpr size_t W_SSQ = W_XB + al256((size_t)T * 1024 * 2);
constexpr size_t W_ACT = W_SSQ + al256((size_t)T * 4 * 4);
constexpr size_t W_WB = W_ACT;
constexpr size_t W_BB = W_WB + al256((size_t)T * 512 * 4);
constexpr size_t W_GB = W_BB + al256((size_t)T * 512 * 4);
constexpr size_t W_QX = W_ACT;
constexpr size_t W_PROJ = W_ACT + al256((size_t)T * DFF * 2);
constexpr size_t W_AO = W_PROJ;
constexpr size_t W_CQB = W_PROJ + al256((size_t)T * DINP * 2);
constexpr size_t W_A2 = W_CQB + al256((size_t)T * 256 * 2);
constexpr size_t W_QB = W_A2 + al256((size_t)T * 256 * 2);
constexpr size_t W_XO = W_QB;
constexpr size_t W_RB = W_QB + al256((size_t)T * 1280 * 2);
constexpr size_t W_KB = W_RB + al256((size_t)T * 512 * 4);
constexpr size_t W_VB = W_KB + al256((size_t)T * 512 * 4);
constexpr size_t W_KKB = W_VB + al256((size_t)T * 512 * 4);
constexpr size_t W_KP = W_KKB + al256((size_t)T * 512 * 4);
constexpr size_t W_KS = W_KP + al256((size_t)4 * 4096 * 160 * 2);
constexpr size_t W_VTP = W_KS + al256((size_t)32 * 2112 * 160 * 2);
constexpr size_t W_VTS = W_VTP + al256((size_t)4 * 128 * 4096 * 2);
constexpr size_t W_MKP = W_VTS + al256((size_t)32 * 128 * 2112 * 2);
constexpr size_t W_MVTP = W_MKP + al256((size_t)NL * 16 * 65536 * 2);
constexpr size_t W_MKS = W_MVTP + al256((size_t)NL * 16 * 65536 * 2);
constexpr size_t W_MVTS = W_MKS + al256((size_t)128 * 65536 * 2);
constexpr size_t W_MB = W_MVTS + al256((size_t)128 * 65536 * 2);
constexpr size_t W_ROPE = W_MB + al256((size_t)1024 * 1024 * 2);
constexpr size_t W_CNT = W_ROPE + al256((size_t)4096 * 16 * 8);
constexpr size_t W_YB = W_CNT + 65536;
constexpr size_t W_CQ = W_YB + al256((size_t)T * 512 * 4);
constexpr size_t W_WT = W_CQ + al256((size_t)2304 * 4096 * 4);
constexpr size_t W_CRR = W_PROJ + al256((size_t)T * 1536 * 2);
constexpr size_t W_CPT = W_CQB;
static_assert(W_CRR + (size_t)2304 * 4096 * 2 <= W_CQB, "RRt must fit behind AO");
static_assert((size_t)2304 * 4096 * 2 <= 2 * al256((size_t)T * 256 * 2), "Pt must fit in CQB+A2");
constexpr size_t WE_GU1 = 0;
constexpr size_t WE_D1 = WE_GU1 + (size_t)5632 * 1024;
constexpr size_t WE_IN = WE_D1 + (size_t)1024 * DFF;
constexpr size_t WE_Q = WE_IN + (size_t)DINP * 1024;
constexpr size_t WE_RW = WE_Q + (size_t)1280 * 256;
constexpr size_t WE_OUT = WE_RW + (size_t)1536 * 256;
constexpr size_t WE_MQ = WE_OUT + (size_t)1024 * 1536;
constexpr size_t WE_MK = WE_MQ + (size_t)1024 * 1024;
constexpr size_t WE_MV = WE_MK + (size_t)1024 * 1024;
constexpr size_t WE_MO = WE_MV + (size_t)1024 * 1024;
constexpr size_t WE_GU2 = WE_MO + (size_t)1024 * 1024;
constexpr size_t WE_D2 = WE_GU2 + (size_t)5632 * 1024;
constexpr size_t WE_LAYER = WE_D2 + (size_t)1024 * DFF;
constexpr size_t W_END = W_WT + al256(WE_LAYER * NL * 2);

enum { I_XP = 0, I_XS, I_MEMP, I_CCKV, I_CKR, I_CMK, I_CMV, I_SWKV, I_SSH, I_F1N, I_F1G, I_F1U, I_F1D, I_MIXN, I_WIN,
       I_QN, I_WUQ, I_KVN, I_WUK, I_WUV, I_MU, I_W0, I_WUP, I_A0, I_AUP, I_GUP, I_KK, I_KA, I_RK, I_GNG, I_GNB, I_WOUT,
       I_XN, I_MKVN, I_WMQ, I_WMK, I_WMV, I_WMO, I_F2N, I_F2G, I_F2U, I_F2D, I_FN, N_IN };

struct Params {
  const float* in[N_IN];
  float* out;
  char* ws;
  int ph_lo, ph_hi;
};

typedef const __attribute__((address_space(4))) Params& KPR;

typedef __bf16 bf2_t __attribute__((ext_vector_type(2)));
typedef float f2_t __attribute__((ext_vector_type(2)));
__device__ __forceinline__ u16 f2bf(float f) { __bf16 b = (__bf16)f; return __builtin_bit_cast(u16, b); }
__device__ __forceinline__ float bf2f(u16 h) { return __uint_as_float(((unsigned)h) << 16); }
__device__ __forceinline__ unsigned pack2(float a, float b) { f2_t v = {a, b}; bf2_t r = __builtin_convertvector(v, bf2_t); return __builtin_bit_cast(unsigned, r); }
__device__ __forceinline__ float4 bf4(uint2 w) {
  return make_float4(__uint_as_float(w.x << 16), __uint_as_float(w.x & 0xffff0000u), __uint_as_float(w.y << 16), __uint_as_float(w.y & 0xffff0000u));
}
__device__ __forceinline__ float wave_sum(float x) {
  x += __int_as_float(__builtin_amdgcn_update_dpp(0, __float_as_int(x), 0xB1, 0xF, 0xF, false));
  x += __int_as_float(__builtin_amdgcn_update_dpp(0, __float_as_int(x), 0x4E, 0xF, 0xF, false));
  x += __int_as_float(__builtin_amdgcn_update_dpp(0, __float_as_int(x), 0x141, 0xF, 0xF, false));
  x += __int_as_float(__builtin_amdgcn_update_dpp(0, __float_as_int(x), 0x140, 0xF, 0xF, false));
  const float s0 = __int_as_float(__builtin_amdgcn_readlane(__float_as_int(x), 0)), s1 = __int_as_float(__builtin_amdgcn_readlane(__float_as_int(x), 16));
  const float s2 = __int_as_float(__builtin_amdgcn_readlane(__float_as_int(x), 32)), s3 = __int_as_float(__builtin_amdgcn_readlane(__float_as_int(x), 48));
  return (s0 + s1) + (s2 + s3);
}
__device__ __forceinline__ float dpp_sum8(float x) {
  x += __int_as_float(__builtin_amdgcn_update_dpp(0, __float_as_int(x), 0xB1, 0xF, 0xF, false));
  x += __int_as_float(__builtin_amdgcn_update_dpp(0, __float_as_int(x), 0x4E, 0xF, 0xF, false));
  x += __int_as_float(__builtin_amdgcn_update_dpp(0, __float_as_int(x), 0x141, 0xF, 0xF, false));
  return x;
}
__device__ __forceinline__ int tidx() { int t = threadIdx.x; asm volatile("" : "+v"(t)); return t; }
__device__ __forceinline__ float fma_s(float a, float b, float c) { float d; asm("v_fma_f32 %0, %1, %2, %3" : "=v"(d) : "v"(a), "v"(b), "v"(c)); return d; }
__device__ __forceinline__ float sub_s(float a, float b) { float d; asm("v_sub_f32 %0, %1, %2" : "=v"(d) : "v"(a), "v"(b)); return d; }
__device__ __forceinline__ float add_s(float a, float b) { float d; asm("v_add_f32 %0, %1, %2" : "=v"(d) : "v"(a), "v"(b)); return d; }
__device__ __forceinline__ float mul_s(float a, float b) { float d; asm("v_mul_f32 %0, %1, %2" : "=v"(d) : "v"(a), "v"(b)); return d; }
__device__ __forceinline__ float sigmoidf_(float x) { return 1.f / (1.f + __expf(-x)); }

constexpr int BM = 256, BK = 64, HALF = 128, HT = HALF * BK;

__device__ __forceinline__ int lds_byte(int r, int c) {
  int st = (r >> 4) * 2 + (c >> 5), rr = r & 15, cc = c & 31, ob = rr * 64 + cc * 2;
  return st * 1024 + (ob ^ (((ob >> 9) & 1) << 5));
}
__device__ __forceinline__ void stage_rc(int b, int& R, int& C) {
  int st = b / 1024, sb = b % 1024, swz = sb ^ (((sb >> 9) & 1) << 5);
  R = (st >> 1) * 16 + swz / 64; C = (st & 1) * 32 + (swz % 64) / 2;
}

__device__ __forceinline__ void tile_map(int tile, int nM, int nN, int& pm, int& pn) {
  const int ntiles = nM * nN;
  int wgid = tile;
  { int q = ntiles / 8, r = ntiles % 8, xcd = wgid % 8, off = wgid / 8;
    wgid = (xcd < r ? xcd * (q + 1) : r * (q + 1) + (xcd - r) * q) + off; }
  int nig = 8 * nN, gid = wgid / nig, fm = gid * 8, gsz = min(nM - fm, 8);
  pm = fm + ((wgid % nig) % gsz); pn = (wgid % nig) / gsz;
}

template <class Epi>
__device__ __forceinline__ void gemm_tile(const u16* __restrict__ A, const u16* __restrict__ Bt, const int K,
                                          const int pm, const int pn, Epi epi) {
  extern __shared__ __attribute__((aligned(16))) char smem[];
  u16* shm = (u16*)smem;
#define SA(b, h) (shm + ((b) * 2 + (h)) * HT)
#define SB(b, h) (shm + (4 + (b) * 2 + (h)) * HT)
#define STAGE(P, BASE, br, kt) do { const u16* _gb = BASE + ((long)(br) * K + (long)(kt) * BK); \
    __builtin_amdgcn_global_load_lds((const unsigned*)((const char*)_gb + so0), \
        (__attribute__((address_space(3))) unsigned*)((char*)(P) + wu16), 16, 0, 0); \
    __builtin_amdgcn_global_load_lds((const unsigned*)((const char*)_gb + so1), \
        (__attribute__((address_space(3))) unsigned*)((char*)(P) + wu16 + 8192), 16, 0, 0); } while (0)
#define LDA(dst, b, h) for (int m = 0; m < 4; ++m) for (int k = 0; k < 2; ++k) \
    dst[m][k] = *reinterpret_cast<const bf16x8*>((char*)SA(b, h) + lds_byte(wr * 64 + m * 16 + fr, k * 32 + fq * 8))
#define LDB(dst, b, h) for (int n = 0; n < 2; ++n) for (int k = 0; k < 2; ++k) \
    dst[n][k] = *reinterpret_cast<const bf16x8*>((char*)SB(b, h) + lds_byte(wc * 32 + n * 16 + fr, k * 32 + fq * 8))
#define MMA(ai, bj, At_, Bt_) do { __builtin_amdgcn_s_setprio(1); \
    for (int m = 0; m < 4; ++m) for (int n = 0; n < 2; ++n) for (int k = 0; k < 2; ++k) \
      acc[ai][bj][m][n] = __builtin_amdgcn_mfma_f32_16x16x32_bf16(At_[m][k], Bt_[n][k], acc[ai][bj][m][n], 0, 0, 0); \
    __builtin_amdgcn_s_setprio(0); } while (0)
#define WAIT_V(n) asm volatile("s_waitcnt vmcnt(" #n ")" ::: "memory")
#define WAIT_L(n) asm volatile("s_waitcnt lgkmcnt(" #n ")" ::: "memory")
#define BAR __builtin_amdgcn_s_barrier()
#define SCHED __builtin_amdgcn_sched_barrier(0)
  const int tid_ = tidx();
  const int wid = tid_ >> 6, lane = tid_ & 63, wr = wid >> 2, wc = wid & 3, fr = lane & 15, fq = lane >> 4;
  const int nt = K / BK;
  const int wu16 = __builtin_amdgcn_readfirstlane(tid_ >> 6) * 1024;
  {
    unsigned so0, so1;
    { int _r, _c; stage_rc(tid_ * 16, _r, _c); so0 = (unsigned)(_r * K + _c) * 2u;
      stage_rc(tid_ * 16 + 8192, _r, _c); so1 = (unsigned)(_r * K + _c) * 2u; }
    const int brow = pm * BM, bcol = pn * BM;
    f32x4 acc[2][2][4][2] = {};
    bf16x8 At[4][2], B0[2][2], B1[2][2];
    STAGE(SB(0, 0), Bt, bcol, 0); STAGE(SA(0, 0), A, brow, 0);
    STAGE(SB(0, 1), Bt, bcol + HALF, 0); STAGE(SA(0, 1), A, brow + HALF, 0);
    if (wr == 1) BAR;
    WAIT_V(4); BAR;
    STAGE(SB(1, 0), Bt, bcol, 1); STAGE(SA(1, 0), A, brow, 1); STAGE(SB(1, 1), Bt, bcol + HALF, 1);
    WAIT_V(6); BAR;
    for (int t = 0; t < nt - 2; t += 2) {
      LDB(B0, 0, 0); SCHED; LDA(At, 0, 0); STAGE(SA(1, 1), A, brow + HALF, t + 1);
      WAIT_L(8); BAR; WAIT_L(0); MMA(0, 0, At, B0); BAR; SCHED;
      LDB(B1, 0, 1); STAGE(SB(0, 0), Bt, bcol, t + 2);
      BAR; WAIT_L(0); MMA(0, 1, At, B1); BAR;
      LDA(At, 0, 1); STAGE(SA(0, 0), A, brow, t + 2);
      BAR; WAIT_L(0); MMA(1, 0, At, B0); BAR; SCHED;
      STAGE(SB(0, 1), Bt, bcol + HALF, t + 2);
      WAIT_V(6); BAR; MMA(1, 1, At, B1); BAR;
      LDB(B0, 1, 0); SCHED; LDA(At, 1, 0); STAGE(SA(0, 1), A, brow + HALF, t + 2);
      WAIT_L(8); BAR; WAIT_L(0); MMA(0, 0, At, B0); BAR; SCHED;
      LDB(B1, 1, 1); STAGE(SB(1, 0), Bt, bcol, t + 3);
      BAR; WAIT_L(0); MMA(0, 1, At, B1); BAR;
      LDA(At, 1, 1); STAGE(SA(1, 0), A, brow, t + 3);
      BAR; WAIT_L(0); MMA(1, 0, At, B0); BAR; SCHED;
      STAGE(SB(1, 1), Bt, bcol + HALF, t + 3);
      WAIT_V(6); BAR; MMA(1, 1, At, B1); BAR;
    }
    { LDB(B0, 0, 0); LDA(At, 0, 0); STAGE(SA(1, 1), A, brow + HALF, nt - 1);
      BAR; WAIT_L(0); MMA(0, 0, At, B0); BAR;
      LDB(B1, 0, 1); BAR; WAIT_L(0); MMA(0, 1, At, B1); BAR;
      LDA(At, 0, 1); WAIT_V(4); BAR; WAIT_L(0); MMA(1, 0, At, B0); MMA(1, 1, At, B1); BAR; }
    { LDB(B0, 1, 0); LDA(At, 1, 0); WAIT_V(2); BAR; WAIT_L(0); MMA(0, 0, At, B0); BAR;
      LDB(B1, 1, 1); WAIT_V(0); BAR; WAIT_L(0); MMA(0, 1, At, B1); BAR;
      LDA(At, 1, 1); BAR; WAIT_L(0); MMA(1, 0, At, B0); MMA(1, 1, At, B1); BAR; }
    if (wr == 0) BAR;
    float* stg = (float*)smem;
    int tx = tid_;
    asm volatile("" : "+v"(tx));
    const int ewr = tx >> 8, ewc = (tx >> 6) & 3, efr = tx & 15, efq = (tx >> 4) & 3;
#define EPI_HALF(ai) do { \
    __syncthreads(); \
    _Pragma("unroll") for (int bj = 0; bj < 2; ++bj) _Pragma("unroll") for (int m = 0; m < 4; ++m) \
    _Pragma("unroll") for (int n = 0; n < 2; ++n) _Pragma("unroll") for (int j = 0; j < 4; ++j) \
      stg[(ewr * 64 + m * 16 + efq * 4 + j) * 260 + bj * HALF + ewc * 32 + n * 16 + efr] = acc[ai][bj][m][n][j]; \
    __syncthreads(); \
    for (int i = 0; i < 8; ++i) { \
      int item = i * NTHR + tx; int rl = item >> 5, qp = item & 31; \
      int cl = (qp >> 2) * 32 + (qp & 3) * 4; \
      float4 v0 = *(const float4*)(stg + rl * 260 + cl), v1 = *(const float4*)(stg + rl * 260 + cl + 16); \
      int row = brow + ai * HALF + rl; \
      float ss = epi.apply4(row, bcol + cl, v0, v1); \
      if (Epi::kSsq) { \
        ss += __shfl_xor(ss, 1); ss += __shfl_xor(ss, 2); ss += __shfl_xor(ss, 4); ss += __shfl_xor(ss, 8); ss += __shfl_xor(ss, 16); \
        if (qp == 0) epi.ssq_out(row, pn, ss); \
      } \
    } } while (0)
    EPI_HALF(0);
    EPI_HALF(1);
#undef EPI_HALF
    __syncthreads();
  }
#undef SA
#undef SB
#undef STAGE
#undef LDA
#undef LDB
#undef MMA
}

template <class Epi>
__device__ __forceinline__ void gemm_phase(const u16* __restrict__ A, const u16* __restrict__ Bt, const int K,
                                           const int nM, const int nN, const int rot, Epi epi) {
  const int G = gridDim.x;
  for (int tile = (int)((blockIdx.x + G - (rot % G)) % G); tile < nM * nN; tile += G) {
    int pm, pn; tile_map(tile, nM, nN, pm, pn);
    gemm_tile(A, Bt, K, pm, pn, epi);
  }
}

__device__ __forceinline__ float rstd_from_ssq(const float* ssq, int row) {
  float4 s = *(const float4*)(ssq + (size_t)row * 4);
  return rsqrtf((s.x + s.y + s.z + s.w) * (1.f / 1024.f) + 1e-6f);
}
__device__ __forceinline__ uint2 pack4(float4 v) { uint2 w; w.x = pack2(v.x, v.y); w.y = pack2(v.z, v.w); return w; }
__device__ __forceinline__ float silu_mul(float g, float u) { return g / (1.f + __expf(-g)) * u; }
struct EpiGU {
  static constexpr bool kSsq = false;
  const float* ssq; u16* act;
  __device__ __forceinline__ float apply4(int row, int c0, float4 g, float4 u) const {
    float rs = rstd_from_ssq(ssq, row);
    float4 o = make_float4(silu_mul(g.x * rs, u.x * rs), silu_mul(g.y * rs, u.y * rs), silu_mul(g.z * rs, u.z * rs), silu_mul(g.w * rs, u.w * rs));
    *(uint2*)(act + (size_t)row * DFF + ((c0 & ~31) >> 1) + (c0 & 15)) = pack4(o);
    return 0.f;
  }
  __device__ __forceinline__ void ssq_out(int, int, float) const {}
};
struct EpiRes {
  static constexpr bool kSsq = true;
  float* x; u16* xb; float* ssq; float coef;
  __device__ __forceinline__ float apply4(int row, int c0, float4 v0, float4 v1) const {
    size_t i = (size_t)row * 1024 + c0;
    float4 a = *(const float4*)(x + i), b = *(const float4*)(x + i + 16);
    a.x += coef * v0.x; a.y += coef * v0.y; a.z += coef * v0.z; a.w += coef * v0.w;
    b.x += coef * v1.x; b.y += coef * v1.y; b.z += coef * v1.z; b.w += coef * v1.w;
    *(float4*)(x + i) = a; *(float4*)(x + i + 16) = b;
    *(uint2*)(xb + i) = pack4(a); *(uint2*)(xb + i + 16) = pack4(b);
    return a.x * a.x + a.y * a.y + a.z * a.z + a.w * a.w + b.x * b.x + b.y * b.y + b.z * b.z + b.w * b.w;
  }
  __device__ __forceinline__ void ssq_out(int row, int pn, float v) const { ssq[(size_t)row * 4 + pn] = v; }
};
struct EpiScaleBf {
  static constexpr bool kSsq = false;
  const float* ssq; u16* o; int ld;
  __device__ __forceinline__ float apply4(int row, int c0, float4 v0, float4 v1) const {
    float rs = rstd_from_ssq(ssq, row);
    size_t i = (size_t)row * ld + c0;
    *(uint2*)(o + i) = pack4(make_float4(v0.x * rs, v0.y * rs, v0.z * rs, v0.w * rs));
    *(uint2*)(o + i + 16) = pack4(make_float4(v1.x * rs, v1.y * rs, v1.z * rs, v1.w * rs));
    return 0.f;
  }
  __device__ __forceinline__ void ssq_out(int, int, float) const {}
};
struct EpiQ {
  static constexpr bool kSsq = false;
  u16* qb; const float2* rope;
  __device__ __forceinline__ float apply4(int row, int c0, float4 v0, float4 v1) const {
    if (c0 < 1024) {
      size_t i = (size_t)row * 1280 + (c0 >> 7) * 160 + (c0 & 127);
      *(uint2*)(qb + i) = pack4(v0); *(uint2*)(qb + i + 16) = pack4(v1);
    } else {
      int h = (c0 - 1024) >> 5, f0 = c0 & 15;
      int pos = row < TP ? (row & 4095) : (2048 + ((row - TP) & 63));
      const float2* cs = rope + pos * 16 + f0;
      float2 c_0 = cs[0], c_1 = cs[1], c_2 = cs[2], c_3 = cs[3];
      size_t i = (size_t)row * 1280 + h * 160 + 128 + f0;
      *(uint2*)(qb + i) = pack4(make_float4(v0.x * c_0.x - v1.x * c_0.y, v0.y * c_1.x - v1.y * c_1.y, v0.z * c_2.x - v1.z * c_2.y, v0.w * c_3.x - v1.w * c_3.y));
      *(uint2*)(qb + i + 16) = pack4(make_float4(v0.x * c_0.y + v1.x * c_0.x, v0.y * c_1.y + v1.y * c_1.x, v0.z * c_2.y + v1.z * c_2.x, v0.w * c_3.y + v1.w * c_3.x));
    }
    return 0.f;
  }
  __device__ __forceinline__ void ssq_out(int, int, float) const {}
};
__device__ __forceinline__ float decay_f(float z) {
  float nz = -z;
  float sp = fmaxf(nz, 0.f) + __logf(1.f + __expf(-fabsf(nz)));
  return __expf(-__expf(-sp - 0.5f));
}
struct EpiRW {
  static constexpr bool kSsq = false;
  const float* w0; const float* a0; const float* ka; char* ws;
  __device__ __forceinline__ void acol(size_t i, int c, float4 v) const {
    u16* bb = (u16*)(ws + W_BB); u16* kb = (u16*)(ws + W_KB); const u16* kkb = (const u16*)(ws + W_KKB);
    float4 a_0 = *(const float4*)(a0 + c), k_a = *(const float4*)(ka + c), kk = bf4(*(const uint2*)(kkb + i)), k = bf4(*(const uint2*)(kb + i));
    float4 a = make_float4(sigmoidf_(a_0.x + v.x), sigmoidf_(a_0.y + v.y), sigmoidf_(a_0.z + v.z), sigmoidf_(a_0.w + v.w));
    *(uint2*)(bb + i) = pack4(make_float4(kk.x * a.x, kk.y * a.y, kk.z * a.z, kk.w * a.w));
    *(uint2*)(kb + i) = pack4(make_float4(k.x * (1.f + (a.x - 1.f) * k_a.x), k.y * (1.f + (a.y - 1.f) * k_a.y), k.z * (1.f + (a.z - 1.f) * k_a.z), k.w * (1.f + (a.w - 1.f) * k_a.w)));
  }
  __device__ __forceinline__ float apply4(int row, int c0, float4 v0, float4 v1) const {
    if (c0 < 512) {
      float* wb = (float*)(ws + W_WB);
      float4 z0 = *(const float4*)(w0 + c0), z1 = *(const float4*)(w0 + c0 + 16);
      size_t i = (size_t)row * 512 + c0;
      *(float4*)(wb + i) = make_float4(decay_f(z0.x + v0.x), decay_f(z0.y + v0.y), decay_f(z0.z + v0.z), decay_f(z0.w + v0.w));
      *(float4*)(wb + i + 16) = make_float4(decay_f(z1.x + v1.x), decay_f(z1.y + v1.y), decay_f(z1.z + v1.z), decay_f(z1.w + v1.w));
    } else if (c0 < 1024) {
      int c = c0 - 512; size_t i = (size_t)row * 512 + c;
      acol(i, c, v0); acol(i + 16, c + 16, v1);
    } else {
      u16* gb = (u16*)(ws + W_GB);
      size_t i = (size_t)row * 512 + (c0 - 1024);
      *(uint2*)(gb + i) = pack4(v0); *(uint2*)(gb + i + 16) = pack4(v1);
    }
    return 0.f;
  }
  __device__ __forceinline__ void ssq_out(int, int, float) const {}
};
template <bool ISV>
struct EpiMem {
  static constexpr bool kSsq = false;
  float* of; u16* ob;
  __device__ __forceinline__ void quad(int row, int col, float4 v) const {
    *(float4*)(of + (size_t)row * 1024 + col) = v;
    int b = row >> 8, m = row & 255, h = col >> 8, d = col & 255;
    if (ISV) {
      u16* o = ob + (size_t)((b * 4 + h) * 256 + d) * 256 + m;
      o[0] = f2bf(v.x); o[256] = f2bf(v.y); o[512] = f2bf(v.z); o[768] = f2bf(v.w);
    } else {
      *(uint2*)(ob + (size_t)((b * 4 + h) * 256 + m) * 256 + d) = pack4(v);
    }
  }
  __device__ __forceinline__ float apply4(int row, int c0, float4 v0, float4 v1) const {
    quad(row, c0, v0); quad(row, c0 + 16, v1);
    return 0.f;
  }
  __device__ __forceinline__ void ssq_out(int, int, float) const {}
};

template <class F>
__device__ __forceinline__ void tconv(u16* dst, int ldd, int N, int K, int rot, F f) {
  extern __shared__ __attribute__((aligned(16))) char smem[];
  float* t = (float*)smem;
  const int nk = K / 64, nt = (N / 64) * nk, G = gridDim.x;
  const int tid = tidx(), a = tid >> 6, c = tid & 63;
  for (int tile = (int)((blockIdx.x + G - (rot % G)) % G); tile < nt; tile += G) {
    int n0 = (tile / nk) * 64, k0 = (tile % nk) * 64;
    __syncthreads();
#pragma unroll
    for (int i = 0; i < 8; ++i) { int kk = a + 8 * i; t[kk * 65 + c] = f(k0 + kk, n0 + c); }
    __syncthreads();
#pragma unroll
    for (int i = 0; i < 2; ++i) {
      const int nn = (tid >> 4) + 32 * i, kq = (tid & 15) * 4;
      uint2 w; w.x = pack2(t[kq * 65 + nn], t[(kq + 1) * 65 + nn]); w.y = pack2(t[(kq + 2) * 65 + nn], t[(kq + 3) * 65 + nn]);
      *(uint2*)(dst + (size_t)(n0 + nn) * ldd + k0 + kq) = w;
    }
  }
}

template <class F>
__device__ __forceinline__ void tconv_v(u16* dst, int ldd, int N, int K, int vb, int nvb, F f) {
  extern __shared__ __attribute__((aligned(16))) char smem[];
  float* t = (float*)smem;
  const int nk = K / 64, nt = (N / 64) * nk;
  const int tid = tidx(), a = tid >> 6, c = tid & 63;
  for (int tile = vb; tile < nt; tile += nvb) {
    int n0 = (tile / nk) * 64, k0 = (tile % nk) * 64;
    __syncthreads();
#pragma unroll
    for (int i = 0; i < 8; ++i) { int kk = a + 8 * i; t[kk * 65 + c] = f(k0 + kk, n0 + c); }
    __syncthreads();
#pragma unroll
    for (int i = 0; i < 2; ++i) {
      const int nn = (tid >> 4) + 32 * i, kq = (tid & 15) * 4;
      uint2 w; w.x = pack2(t[kq * 65 + nn], t[(kq + 1) * 65 + nn]); w.y = pack2(t[(kq + 2) * 65 + nn], t[(kq + 3) * 65 + nn]);
      *(uint2*)(dst + (size_t)(n0 + nn) * ldd + k0 + kq) = w;
    }
  }
  __syncthreads();
}

template <int DK, int DV, int RPG>
__device__ __forceinline__ void attn_item(const u16* __restrict__ Qb, int ldq, int nrows, const u16* __restrict__ Kb, int ldk,
                                          const u16* __restrict__ Vtb, int ldvt, int nkeys, u16* __restrict__ Ob, int ldo) {
  extern __shared__ __attribute__((aligned(16))) char smem[];
  constexpr int KS = DK + 8, VS = 68;
  u16* sK = (u16*)smem;
  u16* sV = sK + 64 * KS;
  const int tid = tidx(), wid = tid >> 6, lane = tid & 63, q = lane & 31, hh = lane >> 5;
  const int row = wid * 32 + q;
  const bool active = (wid * 32) < nrows;
  bf16x8 qf[DK / 16];
  if (active) {
#pragma unroll
    for (int ks = 0; ks < DK / 16; ++ks) qf[ks] = *(const bf16x8*)(Qb + (size_t)row * ldq + ks * 16 + hh * 8);
  }
  f32x16 o[DV / 32];
#pragma unroll
  for (int dt = 0; dt < DV / 32; ++dt)
#pragma unroll
    for (int i = 0; i < 16; ++i) o[dt][i] = 0.f;
  float mrun = -1e30f, lrun = 0.f;
  const int nkt = nkeys >> 6;
  constexpr int KCH = (64 * (DK / 8) + NTHR - 1) / NTHR;
  static_assert(DV == 128 && KCH <= 4, "staging registers are written out by hand");
  uint4 kr0, kr1, kr2, kr3, vr0, vr1;
#define AT_KL(N_, kt_) { const int c = tid + N_ * NTHR; if (N_ < KCH && c < 64 * (DK / 8)) { const int r = c / (DK / 8), cc = c % (DK / 8); \
      kr##N_ = *(const uint4*)(Kb + (size_t)((kt_) * 64 + r) * ldk + cc * 8); } }
#define AT_VL(N_, kt_) { const int c = tid + N_ * NTHR; const int r = c >> 3, cc = c & 7; vr##N_ = *(const uint4*)(Vtb + (size_t)r * ldvt + (kt_) * 64 + cc * 8); }
#define AT_GLOAD(kt_) do { AT_KL(0, kt_) AT_KL(1, kt_) AT_KL(2, kt_) AT_KL(3, kt_) AT_VL(0, kt_) AT_VL(1, kt_) } while (0)
#define AT_KS(N_) { const int c = tid + N_ * NTHR; if (N_ < KCH && c < 64 * (DK / 8)) { const int r = c / (DK / 8), cc = c % (DK / 8); *(uint4*)(sK + r * KS + cc * 8) = kr##N_; } }
#define AT_VS(N_) { const int c = tid + N_ * NTHR; const int r = c >> 3, cc = c & 7; uint2* d = (uint2*)(sV + r * VS + cc * 8); \
      const uint4 t_ = vr##N_; d[0] = make_uint2(t_.x, t_.y); d[1] = make_uint2(t_.z, t_.w); }
  AT_GLOAD(0);
  for (int kt = 0; kt < nkt; ++kt) {
    __syncthreads();
    AT_KS(0) AT_KS(1) AT_KS(2) AT_KS(3) AT_VS(0) AT_VS(1)
    __syncthreads();
    if (kt + 1 < nkt) AT_GLOAD(kt + 1);
    if (active) {
      f32x16 s0, s1;
#pragma unroll
      for (int i = 0; i < 16; ++i) { s0[i] = 0.f; s1[i] = 0.f; }
#pragma unroll
      for (int ks = 0; ks < DK / 16; ++ks) {
        bf16x8 a0 = *(const bf16x8*)(sK + q * KS + ks * 16 + hh * 8);
        bf16x8 a1 = *(const bf16x8*)(sK + (32 + q) * KS + ks * 16 + hh * 8);
        s0 = __builtin_amdgcn_mfma_f32_32x32x16_bf16(a0, qf[ks], s0, 0, 0, 0);
        s1 = __builtin_amdgcn_mfma_f32_32x32x16_bf16(a1, qf[ks], s1, 0, 0, 0);
      }
      float mx = s0[0];
#pragma unroll
      for (int i = 1; i < 16; ++i) mx = fmaxf(mx, s0[i]);
#pragma unroll
      for (int i = 0; i < 16; ++i) mx = fmaxf(mx, s1[i]);
      mx = fmaxf(mx, __shfl_xor(mx, 32));
      float mn = fmaxf(mrun, mx);
      float alpha = __builtin_amdgcn_exp2f(mrun - mn);
      mrun = mn;
      float ps = 0.f;
#pragma unroll
      for (int i = 0; i < 16; ++i) { s0[i] = __builtin_amdgcn_exp2f(sub_s(s0[i], mn)); ps = add_s(ps, s0[i]); }
#pragma unroll
      for (int i = 0; i < 16; ++i) { s1[i] = __builtin_amdgcn_exp2f(sub_s(s1[i], mn)); ps = add_s(ps, s1[i]); }
      lrun = lrun * alpha + ps;
#pragma unroll
      for (int dt = 0; dt < DV / 32; ++dt)
#pragma unroll
        for (int i = 0; i < 16; ++i) o[dt][i] = mul_s(o[dt][i], alpha);
#pragma unroll
      for (int kb = 0; kb < 2; ++kb)
#pragma unroll
        for (int s = 0; s < 2; ++s) {
          union { bf16x8 v; unsigned u[4]; } pf;
#pragma unroll
          for (int jj = 0; jj < 4; ++jj) {
            float e0 = kb ? s1[8 * s + 2 * jj] : s0[8 * s + 2 * jj];
            float e1 = kb ? s1[8 * s + 2 * jj + 1] : s0[8 * s + 2 * jj + 1];
            pf.u[jj] = pack2(e0, e1);
          }
          const int kbase = kb * 32 + s * 16 + 4 * hh;
#pragma unroll
          for (int dt = 0; dt < DV / 32; ++dt) {
            const u16* vp = sV + (dt * 32 + q) * VS + kbase;
            union { bf16x8 v; uint2 u[2]; } vf;
            vf.u[0] = *(const uint2*)vp; vf.u[1] = *(const uint2*)(vp + 8);
            o[dt] = __builtin_amdgcn_mfma_f32_32x32x16_bf16(vf.v, pf.v, o[dt], 0, 0, 0);
          }
        }
    }
  }
  if (active) {
    lrun += __shfl_xor(lrun, 32);
    float inv = 1.f / lrun;
    u16* op = Ob + (size_t)(row / RPG) * ldo + (size_t)(row % RPG) * DV;
#pragma unroll
    for (int dt = 0; dt < DV / 32; ++dt)
#pragma unroll
      for (int g = 0; g < 4; ++g) {
        uint2 w;
        w.x = pack2(o[dt][4 * g] * inv, o[dt][4 * g + 1] * inv);
        w.y = pack2(o[dt][4 * g + 2] * inv, o[dt][4 * g + 3] * inv);
        *(uint2*)(op + dt * 32 + 8 * g + 4 * hh) = w;
      }
  }
}

#undef AT_GLOAD
#undef AT_KL
#undef AT_VL
#undef AT_KS
#undef AT_VS
__device__ __forceinline__ float dpp_sum16(float x) {
  x += __int_as_float(__builtin_amdgcn_update_dpp(0, __float_as_int(x), 0xB1, 0xF, 0xF, false));
  x += __int_as_float(__builtin_amdgcn_update_dpp(0, __float_as_int(x), 0x4E, 0xF, 0xF, false));
  x += __int_as_float(__builtin_amdgcn_update_dpp(0, __float_as_int(x), 0x141, 0xF, 0xF, false));
  x += __int_as_float(__builtin_amdgcn_update_dpp(0, __float_as_int(x), 0x140, 0xF, 0xF, false));
  return x;
}
__device__ __forceinline__ void scan_item(KPR p, int l, int g0, int h, int half, int nsteps, const float* S0, float* Sout) {
  extern __shared__ __attribute__((aligned(16))) char smem[];
  float* sT = (float*)smem;
  float* sV = sT + 5 * 4096;
  const float* src0 = (const float*)(p.ws + W_RB) + h * 64; const float* src1 = (const float*)(p.ws + W_WB) + h * 64;
  const float* src2 = (const float*)(p.ws + W_KB) + h * 64; const float* src3 = (const float*)(p.ws + W_KKB) + h * 64;
  const float* src4 = (const float*)(p.ws + W_BB) + h * 64;
  const float* VB = (const float*)(p.ws + W_VB) + h * 64 + half * 32;
  float* YB = (float*)(p.ws + W_YB) + h * 64 + half * 32;
  const int tid = tidx();
  const int il = tid >> 4, sub = tid & 15, j0 = sub * 4, i = half * 32 + il;
  float s[4];
#pragma unroll
  for (int j = 0; j < 4; ++j) s[j] = S0 ? S0[i * 64 + j0 + j] : 0.f;
  float4 pa0, pa1, pa2, pa3, pa4, pb0, pb1, pb2, pb3, pb4, pfv;
  const int e0 = tid, e1 = tid + NTHR;
  const int st0 = e0 >> 4, c40 = (e0 & 15) * 4, st1 = e1 >> 4, c41 = (e1 & 15) * 4;
  const int stv = tid >> 3, c4v = (tid & 7) * 4;
#define SC_GL1(x, c0_) pa##x = *(const float4*)(src##x + (size_t)(g0 + (c0_) + st0) * 512 + c40); \
                       pb##x = *(const float4*)(src##x + (size_t)(g0 + (c0_) + st1) * 512 + c41);
#define SC_GLOAD(c0_) do { SC_GL1(0, c0_) SC_GL1(1, c0_) SC_GL1(2, c0_) SC_GL1(3, c0_) SC_GL1(4, c0_) \
    pfv = *(const float4*)(VB + (size_t)(g0 + (c0_) + stv) * 512 + c4v); } while (0)
#define SC_ST1(x) *(float4*)(sT + x * 4096 + st0 * 64 + c40) = pa##x; *(float4*)(sT + x * 4096 + st1 * 64 + c41) = pb##x;
  SC_GLOAD(0);
  for (int c0 = 0; c0 < nsteps; c0 += 64) {
    __syncthreads();
    SC_ST1(0) SC_ST1(1) SC_ST1(2) SC_ST1(3) SC_ST1(4)
    *(float4*)(sV + stv * 32 + c4v) = pfv;
    __syncthreads();
    if (c0 + 64 < nsteps) SC_GLOAD(c0 + 64);
#define SC_LD(S, st_) do { const int _s = (st_) < 64 ? (st_) : 63; \
      S##r = *(const float4*)(sT + _s * 64 + j0); S##w = *(const float4*)(sT + 4096 + _s * 64 + j0); \
      S##k = *(const float4*)(sT + 8192 + _s * 64 + j0); S##q = *(const float4*)(sT + 12288 + _s * 64 + j0); \
      S##b = *(const float4*)(sT + 16384 + _s * 64 + j0); S##v = sV[_s * 32 + il]; } while (0)
#define SC_STEP(S, st_) do { \
      float sa = -dpp_sum16(fma_s(s[1], S##q.y, mul_s(s[0], S##q.x)) + fma_s(s[3], S##q.w, mul_s(s[2], S##q.z))); \
      s[0] = fma_s(sa, S##b.x, fma_s(s[0], S##w.x, mul_s(S##v, S##k.x))); \
      s[1] = fma_s(sa, S##b.y, fma_s(s[1], S##w.y, mul_s(S##v, S##k.y))); \
      s[2] = fma_s(sa, S##b.z, fma_s(s[2], S##w.z, mul_s(S##v, S##k.z))); \
      s[3] = fma_s(sa, S##b.w, fma_s(s[3], S##w.w, mul_s(S##v, S##k.w))); \
      float y = dpp_sum16(fma_s(s[1], S##r.y, mul_s(s[0], S##r.x)) + fma_s(s[3], S##r.w, mul_s(s[2], S##r.z))); \
      ykeep = (sub == ((st_) & 15)) ? y : ykeep; } while (0)
    float4 Ar, Aw, Ak, Aq, Ab, Br, Bw, Bk, Bq, Bb, Cr, Cw, Ck, Cq, Cb, Dr, Dw, Dk, Dq, Db;
    float Av, Bv, Cv, Dv, ykeep = 0.f;
    SC_LD(A, 0); SC_LD(B, 1); SC_LD(C, 2);
    for (int st = 0; st < 64; st += 4) {
      SC_LD(D, st + 3); SC_STEP(A, st);
      SC_LD(A, st + 4); SC_STEP(B, st + 1);
      SC_LD(B, st + 5); SC_STEP(C, st + 2);
      SC_LD(C, st + 6); SC_STEP(D, st + 3);
      if ((st & 15) == 12) YB[(size_t)(g0 + c0 + (st - 12) + sub) * 512 + il] = ykeep;
    }
  }
#undef SC_LD
#undef SC_STEP
#undef SC_GLOAD
#undef SC_GL1
#undef SC_ST1
  *(float4*)(Sout + i * 64 + j0) = make_float4(s[0], s[1], s[2], s[3]);
}

constexpr int LS = 68;
constexpr int LBUF = 64 * LS;
constexpr int LH = 72;

__device__ __forceinline__ void split8(const float* x, bf16x8& hi, bf16x8& lo) {
  union { bf16x8 v; unsigned u[4]; } H, Lo;
#pragma unroll
  for (int j = 0; j < 4; ++j) {
    const unsigned h = pack2(x[2 * j], x[2 * j + 1]);
    H.u[j] = h;
    Lo.u[j] = pack2(x[2 * j] - __uint_as_float(h << 16), x[2 * j + 1] - __uint_as_float(h & 0xffff0000u));
  }
  hi = H.v; lo = Lo.v;
}
template <int AM, int AK, int BKS, int BN, bool SPLIT = true>
__device__ __forceinline__ void mm64(const float* A, const float* B, f32x4 (&acc)[2], int m0, int n0, int lane) {
  const int lr = lane & 15, lq = lane >> 4;
#pragma unroll
  for (int ks = 0; ks < 2; ++ks) {
    const int k0 = ks * 32 + lq * 8;
    float a[8];
    if (AK == 1) {
      float4 x0 = *(const float4*)(A + (m0 + lr) * AM + k0), x1 = *(const float4*)(A + (m0 + lr) * AM + k0 + 4);
      a[0] = x0.x; a[1] = x0.y; a[2] = x0.z; a[3] = x0.w; a[4] = x1.x; a[5] = x1.y; a[6] = x1.z; a[7] = x1.w;
    } else {
#pragma unroll
      for (int j = 0; j < 8; ++j) a[j] = A[(m0 + lr) * AM + (k0 + j) * AK];
    }
    bf16x8 ah, al;
    if (SPLIT) split8(a, ah, al);
    else { union { bf16x8 v; unsigned u[4]; } H; for (int j = 0; j < 4; ++j) H.u[j] = pack2(a[2 * j], a[2 * j + 1]); ah = H.v; al = H.v; }
#pragma unroll
    for (int nt = 0; nt < 2; ++nt) {
      const int n = n0 + nt * 16 + lr;
      float b[8];
      if (BKS == 1) {
        float4 x0 = *(const float4*)(B + n * BN + k0), x1 = *(const float4*)(B + n * BN + k0 + 4);
        b[0] = x0.x; b[1] = x0.y; b[2] = x0.z; b[3] = x0.w; b[4] = x1.x; b[5] = x1.y; b[6] = x1.z; b[7] = x1.w;
      } else {
#pragma unroll
        for (int j = 0; j < 8; ++j) b[j] = B[(k0 + j) * BKS + n * BN];
      }
      if (SPLIT) {
        bf16x8 bh, bl; split8(b, bh, bl);
        acc[nt] = __builtin_amdgcn_mfma_f32_16x16x32_bf16(ah, bh, acc[nt], 0, 0, 0);
        acc[nt] = __builtin_amdgcn_mfma_f32_16x16x32_bf16(ah, bl, acc[nt], 0, 0, 0);
        acc[nt] = __builtin_amdgcn_mfma_f32_16x16x32_bf16(al, bh, acc[nt], 0, 0, 0);
      } else {
        union { bf16x8 v; unsigned u[4]; } Bh;
#pragma unroll
        for (int j = 0; j < 4; ++j) Bh.u[j] = pack2(b[2 * j], b[2 * j + 1]);
        acc[nt] = __builtin_amdgcn_mfma_f32_16x16x32_bf16(ah, Bh.v, acc[nt], 0, 0, 0);
      }
    }
  }
}
#define MM_ZERO(acc) do { acc[0] = f32x4{0.f, 0.f, 0.f, 0.f}; acc[1] = f32x4{0.f, 0.f, 0.f, 0.f}; } while (0)
#define MM_FOREACH(acc, BODY) do { _Pragma("unroll") for (int nt_ = 0; nt_ < 2; ++nt_) _Pragma("unroll") for (int rg_ = 0; rg_ < 4; ++rg_) { \
    const int m = m0 + lq * 4 + rg_, n = n0 + nt_ * 16 + lr; const float val = acc[nt_][rg_]; BODY } } while (0)

#define CPRE_PARAMS float4& c_w0, float4& c_w1, uint2& c_q0, uint2& c_q1, uint2& c_b0, uint2& c_b1, uint2& c_k0, uint2& c_k1, uint2& c_r0, uint2& c_r1, uint2& c_v0, uint2& c_v1
#define CPRE_ARGS(P) P##w0, P##w1, P##q0, P##q1, P##b0, P##b1, P##k0, P##k1, P##r0, P##r1, P##v0, P##v1
__device__ __forceinline__ void cprep_load(KPR p, int grow0, int h, int tid, CPRE_PARAMS) {
  const int t0 = tid >> 4, c4 = (tid & 15) * 4;
  const size_t g0 = (size_t)(grow0 + t0) * 512 + h * 64 + c4, g1 = g0 + (size_t)32 * 512;
  const float* WB = (const float*)(p.ws + W_WB); const u16* KKB = (const u16*)(p.ws + W_KKB); const u16* BB = (const u16*)(p.ws + W_BB);
  const u16* KB = (const u16*)(p.ws + W_KB); const u16* RB = (const u16*)(p.ws + W_RB); const u16* VB = (const u16*)(p.ws + W_VB);
  c_w0 = *(const float4*)(WB + g0); c_w1 = *(const float4*)(WB + g1); c_q0 = *(const uint2*)(KKB + g0); c_q1 = *(const uint2*)(KKB + g1);
  c_b0 = *(const uint2*)(BB + g0); c_b1 = *(const uint2*)(BB + g1); c_k0 = *(const uint2*)(KB + g0); c_k1 = *(const uint2*)(KB + g1);
  c_r0 = *(const uint2*)(RB + g0); c_r1 = *(const uint2*)(RB + g1); c_v0 = *(const uint2*)(VB + g0); c_v1 = *(const uint2*)(VB + g1);
}
__device__ __forceinline__ void cprep_item(KPR p, int grow0, int h, int cid, int ngrow0, int nh, CPRE_PARAMS) {
  extern __shared__ __attribute__((aligned(16))) char smem[];
  float* B0 = (float*)smem; float* B1 = B0 + LBUF; float* B2 = B1 + LBUF; float* B3 = B2 + LBUF;
  float* B4 = B3 + LBUF; float* B5 = B4 + LBUF; float* B6 = B5 + LBUF; float* B7 = B6 + LBUF;
  float* wC = (float*)(smem + 139264);
  const int tid = tidx(), wid = tid >> 6, lane = tid & 63, lr = lane & 15, lq = lane >> 4;
  const int m0 = (wid >> 1) * 16, n0 = (wid & 1) * 32;
  const float* WB = (const float*)(p.ws + W_WB) + h * 64; const float* KKB = (const float*)(p.ws + W_KKB) + h * 64;
  const float* BB = (const float*)(p.ws + W_BB) + h * 64; const float* KB = (const float*)(p.ws + W_KB) + h * 64;
  const float* RB = (const float*)(p.ws + W_RB) + h * 64; const float* VB = (const float*)(p.ws + W_VB) + h * 64;
  f32x4 acc[2];
  __syncthreads();
  {
    const int t0 = tid >> 4, c4 = (tid & 15) * 4, o0 = t0 * LS + c4, o1 = (t0 + 32) * LS + c4;
    *(float4*)(B0 + o0) = c_w0; *(float4*)(B0 + o1) = c_w1;
    { const float4 a0_ = bf4(c_q0), a1_ = bf4(c_q1);
      *(float4*)(B1 + o0) = make_float4(-a0_.x, -a0_.y, -a0_.z, -a0_.w); *(float4*)(B1 + o1) = make_float4(-a1_.x, -a1_.y, -a1_.z, -a1_.w); }
    *(float4*)(B2 + o0) = bf4(c_b0); *(float4*)(B2 + o1) = bf4(c_b1);
    *(float4*)(B3 + o0) = bf4(c_k0); *(float4*)(B3 + o1) = bf4(c_k1);
    *(float4*)(B4 + o0) = bf4(c_r0); *(float4*)(B4 + o1) = bf4(c_r1);
  }
  const uint2 vk0 = c_v0, vk1 = c_v1;
  __syncthreads();
  cprep_load(p, ngrow0, nh, tid, CPRE_ARGS(c_));
  {
    const int j = tid & 63, sg = tid >> 6;
    float wv[8];
#pragma unroll
    for (int u = 0; u < 8; ++u) wv[u] = B0[(sg * 8 + u) * LS + j];
#pragma unroll
    for (int u = 1; u < 8; ++u) wv[u] *= wv[u - 1];
    float* segp = B5;
    segp[sg * 64 + j] = wv[7];
    __syncthreads();
    float pre = 1.f;
    for (int u = 0; u < sg; ++u) pre *= segp[u * 64 + j];
#pragma unroll
    for (int u = 0; u < 8; ++u) B0[(sg * 8 + u) * LS + j] = wv[u] * pre;
    if (sg == 7) wC[j] = wv[7] * pre;
  }
  __syncthreads();
  for (int e = tid; e < 4096; e += NTHR) {
    const int t = e >> 6, j = e & 63, o = t * LS + j;
    const float wt = B0[o], wp = t ? B0[o - LS] : 1.f, iw = 1.f / wt;
    B1[o] *= wp; B2[o] *= iw; B3[o] *= iw; B4[o] *= wt;
  }
  __syncthreads();
  MM_ZERO(acc); mm64<LS, 1, 1, LS>(B2, B1, acc, m0, n0, lane);
  MM_FOREACH(acc, { const float v = m < n ? val : 0.f; B5[m * LS + n] = v; B6[m * LS + n] = v + (m == n ? 1.f : 0.f); });
  __syncthreads();
  MM_ZERO(acc); mm64<LS, 1, LS, 1>(B5, B5, acc, m0, n0, lane);
  MM_FOREACH(acc, { B7[m * LS + n] = val; });
  __syncthreads();
  for (int it = 0; it < 5; ++it) {
    MM_ZERO(acc); mm64<LS, 1, LS, 1>(B6, B7, acc, m0, n0, lane);
    f32x4 acc2[2]; MM_ZERO(acc2);
    if (it < 4) mm64<LS, 1, LS, 1>(B7, B7, acc2, m0, n0, lane);
    __syncthreads();
    MM_FOREACH(acc, { B6[m * LS + n] += val; });
    if (it < 4) MM_FOREACH(acc2, { B7[m * LS + n] = val; });
    __syncthreads();
  }
  MM_ZERO(acc); mm64<1, LS, LS, 1>(B1, B6, acc, m0, n0, lane);
  MM_FOREACH(acc, { B5[m * LS + n] = val; });
  MM_ZERO(acc); mm64<LS, 1, 1, LS>(B3, B1, acc, m0, n0, lane);
  MM_FOREACH(acc, { B0[m * LS + n] = m < n ? val : 0.f; });
  __syncthreads();
  MM_ZERO(acc); mm64<LS, 1, LS, 1>(B0, B6, acc, m0, n0, lane);
  MM_FOREACH(acc, { B7[m * LS + n] = val; });
  __syncthreads();
  MM_ZERO(acc); mm64<LS, 1, 1, LS, false>(B2, B4, acc, m0, n0, lane);
  {
    f32x4 acc2[2]; MM_ZERO(acc2); mm64<LS, 1, 1, LS, false>(B3, B4, acc2, m0, n0, lane);
    __syncthreads();
    MM_FOREACH(acc, { B0[m * LS + n] = m <= n ? val : 0.f; });
    MM_FOREACH(acc2, { B1[m * LS + n] = m <= n ? val : 0.f; });
  }
  __syncthreads();
  {
    u16* RRT = (u16*)(p.ws + W_CRR) + (size_t)cid * 4096;
    MM_ZERO(acc); mm64<1, LS, 1, LS, false>(B0, B5, acc, m0, n0, lane);
    MM_FOREACH(acc, { RRT[m * 64 + n] = f2bf(val + B4[m * LS + n]); });
    MM_ZERO(acc); mm64<LS, 1, LS, 1, false>(B7, B0, acc, m0, n0, lane);
    MM_FOREACH(acc, { B6[m * LS + n] = val + B1[m * LS + n]; });
  }
  __syncthreads();
  for (int e = tid; e < 4096; e += NTHR) {
    const int t = e >> 6, j = e & 63, o = t * LS + j;
    const float wc = wC[j];
    B2[o] *= wc; B3[o] *= wc;
  }
  { const int t0 = tid >> 4, c4 = (tid & 15) * 4; *(float4*)(B4 + t0 * LS + c4) = bf4(vk0); *(float4*)(B4 + (t0 + 32) * LS + c4) = bf4(vk1); }
  __syncthreads();
  {
    u16* YB = (u16*)(p.ws + W_YB) + h * 64;
    MM_ZERO(acc); mm64<1, LS, LS, 1, false>(B6, B4, acc, m0, n0, lane);
    MM_FOREACH(acc, { YB[(size_t)(grow0 + m) * 512 + n] = f2bf(val); });
    u16* PT = (u16*)(p.ws + W_CPT) + (size_t)cid * 4096;
    MM_ZERO(acc); mm64<1, LS, 1, LS, false>(B2, B5, acc, m0, n0, lane);
    MM_FOREACH(acc, { PT[m * 64 + n] = f2bf(val + (m == n ? wC[m] : 0.f)); });
    MM_ZERO(acc); mm64<LS, 1, LS, 1, false>(B7, B2, acc, m0, n0, lane);
    MM_FOREACH(acc, { B0[m * LS + n] = val + B3[m * LS + n]; });
  }
  __syncthreads();
  {
    u16* CQ = (u16*)(p.ws + W_CQ) + (size_t)cid * 4096;
    MM_ZERO(acc); mm64<1, LS, LS, 1, false>(B4, B0, acc, m0, n0, lane);
    MM_FOREACH(acc, { CQ[m * 64 + n] = f2bf(val); });
  }
}

__device__ __forceinline__ void cprep_decode(int id, int& grow0, int& h) {
  if (id < 2048) { grow0 = (id >> 9) * 4096 + (id & 63) * 64; h = (id >> 6) & 7; }
  else { const int k = id - 2048; grow0 = TP + (k >> 3) * 64; h = k & 7; }
}
__device__ __forceinline__ void phase_cprep(KPR p) {
  float4 u_w0, u_w1; uint2 u_k0, u_k1, u_q0, u_q1, u_b0, u_b1, u_r0, u_r1, u_v0, u_v1;
  int id = blockIdx.x, grow0 = 0, h = 0;
  cprep_decode(id < 2304 ? id : 0, grow0, h); cprep_load(p, grow0, h, tidx(), CPRE_ARGS(u_));
  for (; id < 2304; id += gridDim.x) {
    const int nid = id + gridDim.x;
    int ng = 0, nh = 0;
    cprep_decode(nid < 2304 ? nid : id, ng, nh);
    cprep_item(p, grow0, h, id, ng, nh, CPRE_ARGS(u_));
    grow0 = ng; h = nh;
  }
}

__device__ __forceinline__ void cseq_item(KPR p, int g0, int h, int nch, int cid0, const float* S0, float* Sout) {
  extern __shared__ __attribute__((aligned(16))) char smem[];
  float* Sf = (float*)smem;
  float* Qf = Sf + LBUF;
  float* Yf = Qf + LBUF;
  u16* Rb = (u16*)(Yf + LBUF);
  u16* Pb = Rb + 64 * LH;
  const int tid = tidx(), wid = tid >> 6, lane = tid & 63, lr = lane & 15, lq = lane >> 4;
  const int m0 = (wid >> 1) * 16, n0 = (wid & 1) * 32;
  u16* YB = (u16*)(p.ws + W_YB) + h * 64;
  const u16* RRT = (const u16*)(p.ws + W_CRR) + (size_t)cid0 * 4096;
  const u16* PT = (const u16*)(p.ws + W_CPT) + (size_t)cid0 * 4096;
  const u16* CQ = (const u16*)(p.ws + W_CQ) + (size_t)cid0 * 4096;
  __syncthreads();
  for (int e = tid; e < 4096; e += NTHR) { const int i = e >> 6, j = e & 63; Sf[i * LS + j] = S0 ? S0[e] : 0.f; }
  const int hr = tid >> 3, hc = (tid & 7) * 8;
  const int f0t = tid >> 4, f0c = (tid & 15) * 4;
  uint4 pr, pp; uint2 q0, q1, y0, y1;
#define CS_LOAD(c_) do { \
    pr = *(const uint4*)(RRT + (size_t)(c_) * 4096 + hr * 64 + hc); pp = *(const uint4*)(PT + (size_t)(c_) * 4096 + hr * 64 + hc); \
    q0 = *(const uint2*)(CQ + (size_t)(c_) * 4096 + f0t * 64 + f0c); q1 = *(const uint2*)(CQ + (size_t)(c_) * 4096 + (f0t + 32) * 64 + f0c); \
    y0 = *(const uint2*)(YB + (size_t)(g0 + (c_) * 64 + f0t) * 512 + f0c); y1 = *(const uint2*)(YB + (size_t)(g0 + (c_) * 64 + f0t + 32) * 512 + f0c); } while (0)
  CS_LOAD(0);
  for (int c = 0; c < nch; ++c) {
    __syncthreads();
    *(uint4*)(Rb + hr * LH + hc) = pr; *(uint4*)(Pb + hr * LH + hc) = pp;
    *(float4*)(Qf + f0t * LS + f0c) = bf4(q0); *(float4*)(Qf + (f0t + 32) * LS + f0c) = bf4(q1);
    *(float4*)(Yf + f0t * LS + f0c) = bf4(y0); *(float4*)(Yf + (f0t + 32) * LS + f0c) = bf4(y1);
    __syncthreads();
    if (c + 1 < nch) CS_LOAD(c + 1);
    f32x4 ay[2], as[2]; MM_ZERO(ay); MM_ZERO(as);
#pragma unroll
    for (int ks = 0; ks < 2; ++ks) {
      const int k0 = ks * 32 + lq * 8;
      const bf16x8 ra = *(const bf16x8*)(Rb + (m0 + lr) * LH + k0);
      float sa[8];
      { float4 x0 = *(const float4*)(Sf + (m0 + lr) * LS + k0), x1 = *(const float4*)(Sf + (m0 + lr) * LS + k0 + 4);
        sa[0] = x0.x; sa[1] = x0.y; sa[2] = x0.z; sa[3] = x0.w; sa[4] = x1.x; sa[5] = x1.y; sa[6] = x1.z; sa[7] = x1.w; }
      bf16x8 sah, sal; split8(sa, sah, sal);
#pragma unroll
      for (int nt = 0; nt < 2; ++nt) {
        const int n = n0 + nt * 16 + lr;
        float sb[8];
        { float4 x0 = *(const float4*)(Sf + n * LS + k0), x1 = *(const float4*)(Sf + n * LS + k0 + 4);
          sb[0] = x0.x; sb[1] = x0.y; sb[2] = x0.z; sb[3] = x0.w; sb[4] = x1.x; sb[5] = x1.y; sb[6] = x1.z; sb[7] = x1.w; }
        bf16x8 sbh, sbl; split8(sb, sbh, sbl);
        ay[nt] = __builtin_amdgcn_mfma_f32_16x16x32_bf16(ra, sbh, ay[nt], 0, 0, 0);
        ay[nt] = __builtin_amdgcn_mfma_f32_16x16x32_bf16(ra, sbl, ay[nt], 0, 0, 0);
        const bf16x8 pb = *(const bf16x8*)(Pb + n * LH + k0);
        as[nt] = __builtin_amdgcn_mfma_f32_16x16x32_bf16(sah, pb, as[nt], 0, 0, 0);
        as[nt] = __builtin_amdgcn_mfma_f32_16x16x32_bf16(sal, pb, as[nt], 0, 0, 0);
      }
    }
    MM_FOREACH(ay, { YB[(size_t)(g0 + c * 64 + m) * 512 + n] = f2bf(val + Yf[m * LS + n]); });
    __syncthreads();
    MM_FOREACH(as, { Sf[m * LS + n] = val + Qf[m * LS + n]; });
  }
#undef CS_LOAD
  __syncthreads();
  for (int e = tid; e < 4096; e += NTHR) { const int i = e >> 6, j = e & 63; Sout[e] = Sf[i * LS + j]; }
}

__device__ __forceinline__ void phase_yfin(KPR p, int l) {
  const int tid = tidx(), wid = tid >> 6, lane = tid & 63;
  const float* YB = (const float*)(p.ws + W_YB); const float* RB = (const float*)(p.ws + W_RB); const float* KB = (const float*)(p.ws + W_KB);
  const float* VB = (const float*)(p.ws + W_VB); const u16* GB = (const u16*)(p.ws + W_GB); u16* AO = (u16*)(p.ws + W_AO);
  const float* rk = p.in[I_RK] + l * 512; const float* gng = p.in[I_GNG] + l * 512; const float* gnb = p.in[I_GNB] + l * 512;
  for (int g = blockIdx.x * 8 + wid; g < T; g += gridDim.x * 8) {
#pragma unroll 8
    for (int h = 0; h < 8; ++h) {
      size_t i = (size_t)g * 512 + h * 64 + lane;
      float y = bf2f(((const u16*)YB)[i]);
      float mu = wave_sum(y) * (1.f / 64.f);
      float dlt = y - mu;
      float var = wave_sum(dlt * dlt) * (1.f / 64.f);
      float bon = wave_sum(bf2f(((const u16*)RB)[i]) * bf2f(((const u16*)KB)[i]) * rk[h * 64 + lane]);
      float v = dlt * rsqrtf(var + 64e-5f) * gng[h * 64 + lane] + gnb[h * 64 + lane] + bon * bf2f(((const u16*)VB)[i]);
      AO[(size_t)g * 1536 + 1024 + h * 64 + lane] = f2bf(v * bf2f(GB[i]));
    }
  }
}

__device__ __forceinline__ void phase_init(KPR p) {
  const int G = gridDim.x, tid = tidx(), wid = tid >> 6, lane = tid & 63;
  const int gw = blockIdx.x * 8 + wid, nw = G * 8;
  {
    float* X = (float*)(p.ws + W_X); u16* XB = (u16*)(p.ws + W_XB); float* SSQ = (float*)(p.ws + W_SSQ);
    for (int g = gw; g < T; g += nw) {
      const float* src = g < TP ? p.in[I_XP] + (size_t)g * 1024 : p.in[I_XS] + (size_t)(g - TP) * 1024;
      float ss = 0.f;
#pragma unroll
      for (int i = 0; i < 4; ++i) {
        float4 v = *(const float4*)(src + i * 256 + lane * 4);
        *(float4*)(X + (size_t)g * 1024 + i * 256 + lane * 4) = v;
        uint2 w; w.x = pack2(v.x, v.y); w.y = pack2(v.z, v.w);
        *(uint2*)(XB + (size_t)g * 1024 + i * 256 + lane * 4) = w;
        ss += v.x * v.x + v.y * v.y + v.z * v.z + v.w * v.w;
      }
      ss = wave_sum(ss);
      if (lane == 0) *(float4*)(SSQ + (size_t)g * 4) = make_float4(ss, 0.f, 0.f, 0.f);
    }
  }
  {
    u16* MB = (u16*)(p.ws + W_MB);
    for (int g = gw; g < 1024; g += nw) {
      const float* src = p.in[I_MEMP] + (size_t)g * 1024;
      float4 v[4]; float ss = 0.f;
#pragma unroll
      for (int i = 0; i < 4; ++i) { v[i] = *(const float4*)(src + i * 256 + lane * 4); ss += v[i].x * v[i].x + v[i].y * v[i].y + v[i].z * v[i].z + v[i].w * v[i].w; }
      ss = wave_sum(ss);
      float rs = rsqrtf(ss * (1.f / 1024.f) + 1e-6f);
#pragma unroll
      for (int i = 0; i < 4; ++i) {
        uint2 w; w.x = pack2(v[i].x * rs, v[i].y * rs); w.y = pack2(v[i].z * rs, v[i].w * rs);
        *(uint2*)(MB + (size_t)g * 1024 + i * 256 + lane * 4) = w;
      }
    }
  }
  {
    float2* RT = (float2*)(p.ws + W_ROPE);
    for (int e = blockIdx.x * NTHR + tid; e < 4096 * 16; e += G * NTHR) {
      int pos = e >> 4, i = e & 15;
      float inv = powf(10000.f, -(float)i / 16.f);
      float ang = (float)pos * inv;
      float sn, cs; sincosf(ang, &sn, &cs);
      RT[e] = make_float2(cs, sn);
    }
  }
  int rot = 0;
  for (int l = 0; l < NL; ++l) {
    u16* WT = (u16*)(p.ws + W_WT) + (size_t)l * WE_LAYER;
    for (int f = 0; f < 2; ++f) {
      const float* nrm = p.in[f ? I_F2N : I_F1N] + l * 1024;
      const float* wg = p.in[f ? I_F2G : I_F1G] + (size_t)l * 1024 * DFF;
      const float* wu = p.in[f ? I_F2U : I_F1U] + (size_t)l * 1024 * DFF;
      const float* wd = p.in[f ? I_F2D : I_F1D] + (size_t)l * 1024 * DFF;
      tconv(WT + (f ? WE_GU2 : WE_GU1), 1024, 5632, 1024, rot, [=](int k, int n) {
        int j = (n >> 5) * 16 + (n & 15);
        const float* s = ((n >> 4) & 1) ? wu : wg;
        return nrm[k] * s[(size_t)k * DFF + j];
      });
      rot += 88 * 16;
      tconv(WT + (f ? WE_D2 : WE_D1), DFF, 1024, DFF, rot, [=](int k, int n) { return wd[(size_t)k * 1024 + n]; });
      rot += 16 * 44;
    }
    {
      const float* nrm = p.in[I_MIXN] + l * 1024; const float* w = p.in[I_WIN] + (size_t)l * 1024 * DIN;
      tconv(WT + WE_IN, 1024, DINP, 1024, rot, [=](int k, int n) { return n < DIN ? nrm[k] * w[(size_t)k * DIN + n] : 0.f; });
      rot += 36 * 16;
    }
    {
      const float* nrm = p.in[I_QN] + l * 256; const float* wuq = p.in[I_WUQ] + (size_t)l * 256 * 768;
      const float* wuk = p.in[I_WUK] + (size_t)l * 8 * 128 * 64;
      tconv(WT + WE_Q, 256, 1280, 256, rot, [=](int k, int n) {
        float r;
        if (n < 1024) {
          int h = n >> 7, c = n & 127;
          const float* a = wuq + (size_t)k * 768 + h * 96; const float* b = wuk + (size_t)(h * 128 + c) * 64;
          r = 0.f;
          for (int d = 0; d < 64; ++d) r += a[d] * b[d];
        } else {
          int hr = n - 1024;
          r = wuq[(size_t)k * 768 + (hr >> 5) * 96 + 64 + (hr & 31)];
        }
        return r * nrm[k] * QSCALE;
      });
      rot += 20 * 4;
    }
    {
      const float* wup = p.in[I_WUP] + (size_t)l * 64 * 512; const float* aup = p.in[I_AUP] + (size_t)l * 64 * 512;
      const float* gup = p.in[I_GUP] + (size_t)l * 128 * 512;
      tconv(WT + WE_RW, 256, 1536, 256, rot, [=](int k, int n) {
        if (n < 512) return k < 64 ? wup[k * 512 + n] : 0.f;
        if (n < 1024) return (k >= 64 && k < 128) ? aup[(k - 64) * 512 + n - 512] : 0.f;
        return k >= 128 ? gup[(k - 128) * 512 + n - 1024] : 0.f;
      });
      rot += 24 * 4;
    }
    {
      const float* wuv = p.in[I_WUV] + (size_t)l * 8 * 128 * 64; const float* wo = p.in[I_WOUT] + (size_t)l * 1024 * 1024;
      tconv(WT + WE_OUT, 1536, 1024, 1536, rot, [=](int k, int n) {
        if (k < 1024) {
          int h = k >> 7, c = k & 127;
          const float* a = wuv + (size_t)(h * 128 + c) * 64; const float* b = wo + (size_t)(h * 64) * 1024 + n;
          float r = 0.f;
          for (int v = 0; v < 64; ++v) r += a[v] * b[(size_t)v * 1024];
          return r;
        }
        return wo[(size_t)(512 + k - 1024) * 1024 + n];
      });
      rot += 16 * 24;
    }
    {
      const float* nx = p.in[I_XN] + l * 1024; const float* nm = p.in[I_MKVN] + l * 1024;
      const float* wq = p.in[I_WMQ] + (size_t)l * 1048576; const float* wk = p.in[I_WMK] + (size_t)l * 1048576;
      const float* wv = p.in[I_WMV] + (size_t)l * 1048576; const float* wo = p.in[I_WMO] + (size_t)l * 1048576;
      tconv(WT + WE_MQ, 1024, 1024, 1024, rot, [=](int k, int n) { return nx[k] * wq[(size_t)k * 1024 + n] * XSCALE; });
      tconv(WT + WE_MK, 1024, 1024, 1024, rot, [=](int k, int n) { return nm[k] * wk[(size_t)k * 1024 + n]; });
      tconv(WT + WE_MV, 1024, 1024, 1024, rot, [=](int k, int n) { return nm[k] * wv[(size_t)k * 1024 + n]; });
      tconv(WT + WE_MO, 1024, 1024, 1024, rot, [=](int k, int n) { return wo[(size_t)k * 1024 + n]; });
    }
  }
}

__device__ __forceinline__ void phase_prep(KPR p, int l) {
  extern __shared__ __attribute__((aligned(16))) char smem[];
  u16* sv = (u16*)smem;
  const int tid = tidx(), wid = tid >> 6, lane = tid & 63;
  const u16* PROJ = (const u16*)(p.ws + W_PROJ);
  u16* CQB = (u16*)(p.ws + W_CQB); u16* A2 = (u16*)(p.ws + W_A2);
  float* RB = (float*)(p.ws + W_RB); float* KB = (float*)(p.ws + W_KB); float* VB = (float*)(p.ws + W_VB); float* KKB = (float*)(p.ws + W_KKB);
  u16* KP = (u16*)(p.ws + W_KP); u16* KS = (u16*)(p.ws + W_KS); u16* VTP = (u16*)(p.ws + W_VTP); u16* VTS = (u16*)(p.ws + W_VTS);
  const float2* RT = (const float2*)(p.ws + W_ROPE);
  const float* kvn = p.in[I_KVN] + l * 128; const float* mu = p.in[I_MU] + l * DSH; const float* kkw = p.in[I_KK] + l * 512;
  for (int chunk = blockIdx.x; chunk < T / 72; chunk += gridDim.x) {
  __syncthreads();
  uint2 n_cq; unsigned n_ckv; u16 n_k1 = 0, n_k2 = 0; uint4 n_pb0, n_pb1, n_pb2, n_pb3 = make_uint4(0, 0, 0, 0);
  uint4 q_pb0, q_pb1, q_pb2, q_pb3 = make_uint4(0, 0, 0, 0);
#define PREP_LOAD(ROW) do { const u16* pr_ = PROJ + (size_t)(ROW) * DINP; \
    n_cq = *(const uint2*)(pr_ + lane * 4); n_ckv = *(const unsigned*)(pr_ + 256 + lane * 2); \
    if (lane < 16) { n_k1 = pr_[384 + lane]; n_k2 = pr_[400 + lane]; } \
    n_pb0 = *(const uint4*)(pr_ + 416 + lane * 8); n_pb1 = *(const uint4*)(pr_ + 416 + 512 + lane * 8); \
    n_pb2 = *(const uint4*)(pr_ + 416 + 1024 + lane * 8); if (lane < 32) n_pb3 = *(const uint4*)(pr_ + 416 + 1536 + lane * 8); } while (0)
  {
    const int gfirst = chunk * 72 + wid * 9;
    if (gfirst > 0) { PREP_LOAD(gfirst - 1); q_pb0 = n_pb0; q_pb1 = n_pb1; q_pb2 = n_pb2; q_pb3 = n_pb3; }
    else { q_pb0 = q_pb1 = q_pb2 = make_uint4(0, 0, 0, 0); }
    PREP_LOAD(gfirst);
  }
  for (int ri = 0; ri < 9; ++ri) {
    const int rl = wid * 9 + ri, g = chunk * 72 + rl;
    const u16* pr = PROJ + (size_t)g * DINP;
    const uint2 c_cq = n_cq; const unsigned c_ckv = n_ckv; const u16 c_k1 = n_k1, c_k2 = n_k2;
    const uint4 c_pb0 = n_pb0, c_pb1 = n_pb1, c_pb2 = n_pb2, c_pb3 = n_pb3;
    { const int gn = g + 1 < T ? g + 1 : g; PREP_LOAD(gn); }
    const bool isP = g < TP;
    int b, t, pos, tlen;
    if (isP) { b = g >> 12; t = g & 4095; pos = t; tlen = 4096; } else { int gg = g - TP; b = gg >> 6; t = gg & 63; pos = 2048 + t; tlen = 64; }
    {
      uint2 w = c_cq;
      float v0 = bf2f(w.x & 0xffff), v1 = bf2f(w.x >> 16), v2 = bf2f(w.y & 0xffff), v3 = bf2f(w.y >> 16);
      float ss = wave_sum(v0 * v0 + v1 * v1 + v2 * v2 + v3 * v3);
      float rs = rsqrtf(ss * (1.f / 256.f) + 1e-6f);
      uint2 o; o.x = pack2(v0 * rs, v1 * rs); o.y = pack2(v2 * rs, v3 * rs);
      *(uint2*)(CQB + (size_t)g * 256 + lane * 4) = o;
    }
    {
      unsigned w = c_ckv;
      float v0 = bf2f(w & 0xffff), v1 = bf2f(w >> 16);
      float ss = wave_sum(v0 * v0 + v1 * v1);
      float rs = rsqrtf(ss * (1.f / 128.f) + 1e-6f);
      int c = lane * 2;
      v0 = v0 * rs * kvn[c]; v1 = v1 * rs * kvn[c + 1];
      float* of = isP ? p.out + OO_CKVP + ((size_t)(l * 4 + b) * 4096 + t) * 128 : p.out + OO_CKVS + ((size_t)(l * 32 + b) * 64 + t) * 128;
      *(float2*)(of + c) = make_float2(v0, v1);
      u16* kr = isP ? KP + ((size_t)b * 4096 + t) * 160 : KS + ((size_t)b * 2112 + 2048 + t) * 160;
      *(unsigned*)(kr + c) = pack2(v0, v1);
      *(unsigned*)(sv + rl * 128 + c) = pack2(v0, v1);
      if (lane < 16) {
        float x1 = bf2f(c_k1), x2 = bf2f(c_k2);
        float2 cs = RT[pos * 16 + lane];
        float o1 = x1 * cs.x - x2 * cs.y, o2 = x1 * cs.y + x2 * cs.x;
        float* okr = isP ? p.out + OO_KRP + ((size_t)(l * 4 + b) * 4096 + t) * 32 : p.out + OO_KRS + ((size_t)(l * 32 + b) * 64 + t) * 32;
        okr[lane] = o1; okr[lane + 16] = o2;
        kr[128 + lane] = f2bf(o1); kr[144 + lane] = f2bf(o2);
      }
    }
    {
      const u16* pb = pr + 416;
      const u16* pp = pr - DINP + 416;
      const float* sh0 = p.in[I_SSH] + (size_t)(l * 32 + b) * DSH;
      const bool last = (t == tlen - 1);
      float* osh = isP ? p.out + OO_SHP + (size_t)(l * 4 + b) * DSH : p.out + OO_SHS + (size_t)(l * 32 + b) * DSH;
#pragma unroll
      for (int it = 0; it < 4; ++it) {
        const int c = it * 64 + lane;
        if (c < 224) {
          const int e = c * 8;
          const uint4 w = it == 0 ? c_pb0 : (it == 1 ? c_pb1 : (it == 2 ? c_pb2 : c_pb3));
          float pv[8] = {bf2f(w.x & 0xffff), bf2f(w.x >> 16), bf2f(w.y & 0xffff), bf2f(w.y >> 16), bf2f(w.z & 0xffff), bf2f(w.z >> 16), bf2f(w.w & 0xffff), bf2f(w.w >> 16)};
          float pq[8];
          if (t > 0) {
            const uint4 q = it == 0 ? q_pb0 : (it == 1 ? q_pb1 : (it == 2 ? q_pb2 : q_pb3));
            pq[0] = bf2f(q.x & 0xffff); pq[1] = bf2f(q.x >> 16); pq[2] = bf2f(q.y & 0xffff); pq[3] = bf2f(q.y >> 16);
            pq[4] = bf2f(q.z & 0xffff); pq[5] = bf2f(q.z >> 16); pq[6] = bf2f(q.w & 0xffff); pq[7] = bf2f(q.w >> 16);
          } else if (!isP) {
            float4 q0 = *(const float4*)(sh0 + e), q1 = *(const float4*)(sh0 + e + 4);
            pq[0] = q0.x; pq[1] = q0.y; pq[2] = q0.z; pq[3] = q0.w; pq[4] = q1.x; pq[5] = q1.y; pq[6] = q1.z; pq[7] = q1.w;
          } else {
#pragma unroll
            for (int j = 0; j < 8; ++j) pq[j] = 0.f;
          }
          float4 m0 = *(const float4*)(mu + e), m1 = *(const float4*)(mu + e + 4);
          float mm[8] = {m0.x, m0.y, m0.z, m0.w, m1.x, m1.y, m1.z, m1.w};
          float xs[8];
#pragma unroll
          for (int j = 0; j < 8; ++j) xs[j] = pv[j] + mm[j] * (pq[j] - pv[j]);
          if (last) { *(float4*)(osh + e) = make_float4(pv[0], pv[1], pv[2], pv[3]); *(float4*)(osh + e + 4) = make_float4(pv[4], pv[5], pv[6], pv[7]); }
          if (it == 0) {
            *(uint4*)((u16*)RB + (size_t)g * 512 + e) = make_uint4(pack2(xs[0], xs[1]), pack2(xs[2], xs[3]), pack2(xs[4], xs[5]), pack2(xs[6], xs[7]));
          } else if (it == 1) {
            const int cc = e - 512;
            *(uint4*)((u16*)KB + (size_t)g * 512 + cc) = make_uint4(pack2(xs[0], xs[1]), pack2(xs[2], xs[3]), pack2(xs[4], xs[5]), pack2(xs[6], xs[7]));
            float4 k0 = *(const float4*)(kkw + cc), k1 = *(const float4*)(kkw + cc + 4);
            float kk[8] = {xs[0] * k0.x, xs[1] * k0.y, xs[2] * k0.z, xs[3] * k0.w, xs[4] * k1.x, xs[5] * k1.y, xs[6] * k1.z, xs[7] * k1.w};
            float ss = 0.f;
#pragma unroll
            for (int j = 0; j < 8; ++j) ss += kk[j] * kk[j];
            ss = dpp_sum8(ss);
            float rn = rsqrtf(ss + 1e-12f);
            *(uint4*)((u16*)KKB + (size_t)g * 512 + cc) = make_uint4(pack2(kk[0] * rn, kk[1] * rn), pack2(kk[2] * rn, kk[3] * rn), pack2(kk[4] * rn, kk[5] * rn), pack2(kk[6] * rn, kk[7] * rn));
          } else if (it == 2) {
            *(uint4*)((u16*)VB + (size_t)g * 512 + (e - 1024)) = make_uint4(pack2(xs[0], xs[1]), pack2(xs[2], xs[3]), pack2(xs[4], xs[5]), pack2(xs[6], xs[7]));
          } else {
            const int cc = e - 1536;
            float y[8];
#pragma unroll
            for (int j = 0; j < 8; ++j) y[j] = cc < 64 ? (1.f - 2.f / (1.f + __expf(2.f * xs[j]))) : (cc < 128 ? xs[j] : sigmoidf_(xs[j]));
            uint4 o; o.x = pack2(y[0], y[1]); o.y = pack2(y[2], y[3]); o.z = pack2(y[4], y[5]); o.w = pack2(y[6], y[7]);
            *(uint4*)(A2 + (size_t)g * 256 + cc) = o;
          }
        }
      }
    }
    q_pb0 = c_pb0; q_pb1 = c_pb1; q_pb2 = c_pb2; q_pb3 = c_pb3;
  }
#undef PREP_LOAD
  __syncthreads();
  for (int idx = tid; idx < 128 * 9; idx += NTHR) {
    const int d = idx & 127, rl0 = (idx >> 7) * 8, g = chunk * 72 + rl0;
    unsigned w[4];
#pragma unroll
    for (int j = 0; j < 4; ++j) w[j] = (unsigned)sv[(rl0 + 2 * j) * 128 + d] | ((unsigned)sv[(rl0 + 2 * j + 1) * 128 + d] << 16);
    u16* dst;
    if (g < TP) dst = VTP + ((size_t)(g >> 12) * 128 + d) * 4096 + (g & 4095);
    else { const int gg = g - TP; dst = VTS + ((size_t)(gg >> 6) * 128 + d) * 2112 + 2048 + (gg & 63); }
    *(uint4*)dst = make_uint4(w[0], w[1], w[2], w[3]);
  }
  }
}

__device__ __forceinline__ void conv_caches(KPR p, int l, int vb, int nvb) {
  const int tid = tidx();
  u16* KS = (u16*)(p.ws + W_KS); u16* VTS = (u16*)(p.ws + W_VTS);
  {
    const float* cckv = p.in[I_CCKV] + (size_t)l * 32 * 2048 * 128;
    const float* ckr = p.in[I_CKR] + (size_t)l * 32 * 2048 * 32;
    for (int idx = vb * NTHR + tid; idx < 32 * 2048 * 20; idx += nvb * NTHR) {
      int rowi = idx / 20, ch = idx % 20;
      int b = rowi >> 11, t = rowi & 2047;
      const float* s = ch < 16 ? cckv + (size_t)rowi * 128 + ch * 8 : ckr + (size_t)rowi * 32 + (ch - 16) * 8;
      float4 a = *(const float4*)s, c = *(const float4*)(s + 4);
      uint4 o; o.x = pack2(a.x, a.y); o.y = pack2(a.z, a.w); o.z = pack2(c.x, c.y); o.w = pack2(c.z, c.w);
      *(uint4*)(KS + ((size_t)b * 2112 + t) * 160 + ch * 8) = o;
    }
    tconv_v(VTS, 2112, 4096, 2048, vb, nvb, [=](int k, int n) { return cckv[((size_t)(n >> 7) * 2048 + k) * 128 + (n & 127)]; });
    const float* cmk = p.in[I_CMK] + (size_t)l * 32 * 256 * 1024;
    const float* cmv = p.in[I_CMV] + (size_t)l * 32 * 256 * 1024;
    u16* MKS = (u16*)(p.ws + W_MKS); u16* MVTS = (u16*)(p.ws + W_MVTS);
    for (int idx = vb * NTHR + tid; idx < 32 * 4 * 256 * 32; idx += nvb * NTHR) {
      int d8 = idx & 31, m = (idx >> 5) & 255, h = (idx >> 13) & 3, b = idx >> 15;
      const float* s = cmk + ((size_t)(b * 256 + m) * 4 + h) * 256 + d8 * 8;
      float4 a = *(const float4*)s, c = *(const float4*)(s + 4);
      uint4 o; o.x = pack2(a.x, a.y); o.y = pack2(a.z, a.w); o.z = pack2(c.x, c.y); o.w = pack2(c.z, c.w);
      *(uint4*)(MKS + (size_t)idx * 8) = o;
    }
    tconv_v(MVTS, 256, 32768, 256, vb, nvb, [=](int k, int n) { return cmv[((size_t)((n >> 10) * 256 + k) * 4 + ((n >> 8) & 3)) * 256 + (n & 255)]; });
  }
}

__device__ __forceinline__ void mla_sub(KPR p, int b, int c, int half) {
  const u16* QB = (const u16*)(p.ws + W_QB); u16* AO = (u16*)(p.ws + W_AO);
  size_t tok = (size_t)b * 4096 + c * 64 + half * 32;
  attn_item<160, 128, 8>(QB + tok * 1280, 160, 256, (const u16*)(p.ws + W_KP) + (size_t)b * 4096 * 160, 160,
                         (const u16*)(p.ws + W_VTP) + (size_t)b * 128 * 4096, 4096, (c + 1) * 64, AO + tok * 1536, 1536);
}
__device__ __forceinline__ void phase_mix(KPR p, int l, int mode = 0) {
  extern __shared__ __attribute__((aligned(16))) char smem[];
  int* sItem = (int*)(smem + SMEM_ITEM);
  int* cnt = (int*)(p.ws + W_CNT) + l + mode * 8;
  for (;;) {
    __syncthreads();
    if (threadIdx.x == 0) *sItem = atomicAdd(cnt, 1);
    __syncthreads();
    int it = *sItem;
    if (it >= 864) break;
    if (mode == 2 && (it < 32 || it >= 608)) continue;
    if (it < 32) {
      int b = it >> 3, h = it & 7;
      cseq_item(p, b * 4096, h, 64, (b * 8 + h) * 64, nullptr, p.out + OO_WKVP + ((size_t)(l * 4 + b) * 8 + h) * 4096);
    } else if (it < 608) {
      int k = it - 32;
      if (k >= 248 && k < 312) {
        int j = k - 248; int b = j >> 1, half = j & 1;
        const u16* QB = (const u16*)(p.ws + W_QB); u16* AO = (u16*)(p.ws + W_AO);
        size_t tok = (size_t)TP + b * 64 + half * 32;
        attn_item<160, 128, 8>(QB + tok * 1280, 160, 256, (const u16*)(p.ws + W_KS) + (size_t)b * 2112 * 160, 160,
                               (const u16*)(p.ws + W_VTS) + (size_t)b * 128 * 2112, 2112, 2112, AO + tok * 1536, 1536);
      } else {
        if (k >= 312) k -= 64;
        int c = 63 - (k >> 3), b = (k >> 1) & 3, half = k & 1;
        mla_sub(p, b, c, half);
      }
    } else {
      int k = it - 608; int b = k >> 3, h = k & 7;
      cseq_item(p, TP + b * 64, h, 1, 2048 + k, p.in[I_SWKV] + ((size_t)(l * 32 + b) * 8 + h) * 4096,
                p.out + OO_WKVS + ((size_t)(l * 32 + b) * 8 + h) * 4096);
    }
  }
}

__device__ __forceinline__ void xattn_item(KPR p, int l, int it) {
  const u16* QX = (const u16*)(p.ws + W_QX); u16* XO = (u16*)(p.ws + W_XO);
  if (it < 256) {
    int b = it >> 6, h = (it >> 4) & 3, qt = it & 15;
    size_t tok = (size_t)b * 4096 + qt * 256;
    for (int hv = 0; hv < 2; ++hv)
      attn_item<256, 128, 1>(QX + tok * 1024 + h * 256, 1024, 256, (const u16*)(p.ws + W_MKP) + (size_t)((l * 4 + b) * 4 + h) * 65536, 256,
                             (const u16*)(p.ws + W_MVTP) + (size_t)((l * 4 + b) * 4 + h) * 65536 + hv * 128 * 256, 256, 256, XO + tok * 1024 + h * 256 + hv * 128, 1024);
  } else {
    int k = it - 256; int b = k >> 2, h = k & 3;
    size_t tok = (size_t)TP + b * 64;
    for (int hv = 0; hv < 2; ++hv)
      attn_item<256, 128, 1>(QX + tok * 1024 + h * 256, 1024, 64, (const u16*)(p.ws + W_MKS) + (size_t)(b * 4 + h) * 65536, 256,
                             (const u16*)(p.ws + W_MVTS) + (size_t)(b * 4 + h) * 65536 + hv * 128 * 256, 256, 256, XO + tok * 1024 + h * 256 + hv * 128, 1024);
  }
}

constexpr int CH_NST = 10;
__device__ __forceinline__ void phase_chain(KPR p, int ci, int dup = 0) {
  extern __shared__ __attribute__((aligned(16))) char smem[];
  int* sItem = (int*)(smem + SMEM_ITEM);
  int* CT = (int*)(p.ws + W_CNT) + dup * 8192;
  const float rc = dup ? 0.f : 1.f;
  int* q = CT + 3800 + ci; int* xa = CT + 72 + ci; int* oa = CT + 80 + ci;
  int* cnt = CT + 128 + ci * CH_NST * 72;
  int* stamp = CT + 4096 + ci * CH_NST * 72;
  int* G = CT + 8000 + ci; int* xast = CT + 8010 + ci; int* oast = CT + 8020 + ci;
  int lastG = 0;
  const bool hasTail = ci >= 1, hasHead = ci < NL;
  const int lt = ci - 1, lh = ci;
  const int e0 = hasTail ? 288 : 0, e1 = e0 + (hasTail ? 288 : 0), e2 = e1 + (hasTail ? 384 : 0), e3 = e2 + (hasTail ? 288 : 0),
            e4 = e3 + (hasTail ? 792 : 0), e5 = e4 + (hasTail ? 288 : 0), e6 = e5 + (hasHead ? 792 : 0), e7 = e6 + (hasHead ? 288 : 0),
            e8 = e7 + (hasHead ? 224 : 0), e9 = e8 + (hasHead ? 648 : 0);
  float* X = (float*)(p.ws + W_X); u16* XB = (u16*)(p.ws + W_XB); float* SSQ = (float*)(p.ws + W_SSQ); u16* ACT = (u16*)(p.ws + W_ACT);
  const int grp = blockIdx.x & 7;
  int nxt = 0;
  if (tidx() == 0) nxt = atomicAdd(q + grp * 8, 1) * 8 + grp;
  for (;;) {
    const int tid = tidx();
    if (tid == 0) {
      const int it = nxt;
      if (it < e9) {
        int st, idx;
        if (it < e0) { st = 0; idx = it; } else if (it < e1) { st = 1; idx = it - e0; } else if (it < e2) { st = 2; idx = it - e1; }
        else if (it < e3) { st = 3; idx = it - e2; } else if (it < e4) { st = 4; idx = it - e3; } else if (it < e5) { st = 5; idx = it - e4; }
        else if (it < e6) { st = 6; idx = it - e5; } else if (it < e7) { st = 7; idx = it - e6; } else if (it < e8) { st = 8; idx = it - e7; }
        else { st = 9; idx = it - e8; }
        int pm = 0, pn = 0;
        if (st == 2) pm = idx < 256 ? ((idx >> 6) * 16 + (idx & 15)) : (64 + ((idx - 256) >> 4));
        else if (st != 8) tile_map(idx, 72, (st == 4 || st == 6) ? 11 : (st == 9 ? 9 : 4), pm, pn);
        const int* c1 = nullptr; const int* c2 = nullptr;
        switch (st) {
          case 1: c1 = stamp + 0 * 72 + pm; break;
          case 2: c1 = stamp + 1 * 72 + pm; break;
          case 3: c1 = stamp + 2 * 72 + pm; break;
          case 4: c1 = stamp + 3 * 72 + pm; c2 = xast; break;
          case 5: c1 = stamp + 4 * 72 + pm; break;
          case 6: if (hasTail) c1 = stamp + 5 * 72 + pm; break;
          case 7: c1 = stamp + 6 * 72 + pm; break;
          case 8: if (hasTail) c1 = xast; break;
          case 9: c1 = stamp + 7 * 72 + pm; if (hasTail) c2 = oast; break;
          default: break;
        }
        if (dup) { c1 = nullptr; c2 = nullptr; }
        int s1 = 0, s2 = 0;
        if (c1) while ((s1 = __hip_atomic_load(c1, __ATOMIC_RELAXED, __HIP_MEMORY_SCOPE_AGENT)) == 0) __builtin_amdgcn_s_sleep(4);
        if (c2) while ((s2 = __hip_atomic_load(c2, __ATOMIC_RELAXED, __HIP_MEMORY_SCOPE_AGENT)) == 0) __builtin_amdgcn_s_sleep(4);
        if ((s1 > s2 ? s1 : s2) >= lastG) {
          const int g = __hip_atomic_load(G, __ATOMIC_RELAXED, __HIP_MEMORY_SCOPE_AGENT);
          __builtin_amdgcn_fence(__ATOMIC_ACQUIRE, "agent");
          asm volatile("s_waitcnt vmcnt(0)" ::: "memory");
          lastG = g;
        }
        sItem[1] = st; sItem[2] = idx; sItem[3] = pm; sItem[4] = pn;
      }
      sItem[0] = it;
    }
    __syncthreads();
    if (sItem[0] >= e9) break;
    const int st = sItem[1], idx = sItem[2], pm = sItem[3], pn = sItem[4];
    if (tid == 0) nxt = atomicAdd(q + grp * 8, 1) * 8 + grp;
    if (dup && !((PROBE_MASK >> st) & 1)) { __syncthreads(); continue; }
    const u16* WTt = (const u16*)(p.ws + W_WT) + (size_t)(lt < 0 ? 0 : lt) * WE_LAYER;
    const u16* WTh = (const u16*)(p.ws + W_WT) + (size_t)(lh >= NL ? 0 : lh) * WE_LAYER;
    switch (st) {
      case 0: gemm_tile((const u16*)(p.ws + W_AO), WTt + WE_OUT, 1536, pm, pn, EpiRes{X, XB, SSQ, rc}); break;
      case 1: gemm_tile(XB, WTt + WE_MQ, 1024, pm, pn, EpiScaleBf{SSQ, (u16*)(p.ws + W_QX), 1024}); break;
      case 2: xattn_item(p, lt, idx); break;
      case 3: gemm_tile((const u16*)(p.ws + W_XO), WTt + WE_MO, 1024, pm, pn, EpiRes{X, XB, SSQ, rc}); break;
      case 4: gemm_tile(XB, WTt + WE_GU2, 1024, pm, 2 * pn, EpiGU{SSQ, ACT}); gemm_tile(XB, WTt + WE_GU2, 1024, pm, 2 * pn + 1, EpiGU{SSQ, ACT}); break;
      case 5: gemm_tile(ACT, WTt + WE_D2, DFF, pm, pn, EpiRes{X, XB, SSQ, 0.5f * rc}); break;
      case 6: gemm_tile(XB, WTh + WE_GU1, 1024, pm, 2 * pn, EpiGU{SSQ, ACT}); gemm_tile(XB, WTh + WE_GU1, 1024, pm, 2 * pn + 1, EpiGU{SSQ, ACT}); break;
      case 7: gemm_tile(ACT, WTh + WE_D1, DFF, pm, pn, EpiRes{X, XB, SSQ, 0.5f * rc}); break;
      case 8: conv_caches(p, lh, idx, 224); break;
      default: gemm_tile(XB, WTh + WE_IN, 1024, pm, pn, EpiScaleBf{SSQ, (u16*)(p.ws + W_PROJ), DINP}); break;
    }
    asm volatile("s_waitcnt vmcnt(0)" ::: "memory");
    __syncthreads();
    if (tidx() == 64) {
      __builtin_amdgcn_fence(__ATOMIC_RELEASE, "agent");
      asm volatile("s_waitcnt vmcnt(0)" ::: "memory");
      atomicAdd(G, 1);
      const int full = (st == 4 || st == 6) ? 11 : (st == 9 ? 9 : (st == 2 ? (pm < 64 ? 4 : 16) : 4));
      if (atomicAdd(cnt + st * 72 + pm, 1) + 1 == full)
        __hip_atomic_store(stamp + st * 72 + pm, __hip_atomic_load(G, __ATOMIC_RELAXED, __HIP_MEMORY_SCOPE_AGENT), __ATOMIC_RELAXED, __HIP_MEMORY_SCOPE_AGENT);
      if (st == 2 && atomicAdd(xa, 1) + 1 == 384)
        __hip_atomic_store(xast, __hip_atomic_load(G, __ATOMIC_RELAXED, __HIP_MEMORY_SCOPE_AGENT), __ATOMIC_RELAXED, __HIP_MEMORY_SCOPE_AGENT);
      if (st == 0 && atomicAdd(oa, 1) + 1 == 288)
        __hip_atomic_store(oast, __hip_atomic_load(G, __ATOMIC_RELAXED, __HIP_MEMORY_SCOPE_AGENT), __ATOMIC_RELAXED, __HIP_MEMORY_SCOPE_AGENT);
    }
  }
}

__device__ __forceinline__ void phase_final(KPR p) {
  const int tid = tidx(), wid = tid >> 6, lane = tid & 63;
  const float* X = (const float*)(p.ws + W_X); const float* fn = p.in[I_FN];
  for (int g = blockIdx.x * 8 + wid; g < T; g += gridDim.x * 8) {
    float4 v[4]; float ss = 0.f;
#pragma unroll
    for (int i = 0; i < 4; ++i) { v[i] = *(const float4*)(X + (size_t)g * 1024 + i * 256 + lane * 4); ss += v[i].x * v[i].x + v[i].y * v[i].y + v[i].z * v[i].z + v[i].w * v[i].w; }
    ss = wave_sum(ss);
    float rs = rsqrtf(ss * (1.f / 1024.f) + 1e-6f);
#pragma unroll
    for (int i = 0; i < 4; ++i) {
      float4 gn = *(const float4*)(fn + i * 256 + lane * 4);
      *(float4*)(p.out + OO_Y + (size_t)g * 1024 + i * 256 + lane * 4) = make_float4(v[i].x * rs * gn.x, v[i].y * rs * gn.y, v[i].z * rs * gn.z, v[i].w * rs * gn.w);
    }
  }
}

constexpr int NPL = 6;
constexpr int N_PHASES = 3 + NPL * NL + 1;

__device__ __forceinline__ void run_phase(KPR p, int ph) {
  if (ph == 0) { phase_init(p); return; }
  if (ph == 1) {
    for (int l = 0; l < NL; ++l) {
      const u16* WT = (const u16*)(p.ws + W_WT) + (size_t)l * WE_LAYER;
      gemm_phase((const u16*)(p.ws + W_MB), WT + WE_MK, 1024, 4, 4, (2 * l) * 16,
                 EpiMem<false>{p.out + OO_MKP + (size_t)l * 1048576, (u16*)(p.ws + W_MKP) + (size_t)l * 16 * 65536});
      gemm_phase((const u16*)(p.ws + W_MB), WT + WE_MV, 1024, 4, 4, (2 * l + 1) * 16,
                 EpiMem<true>{p.out + OO_MVP + (size_t)l * 1048576, (u16*)(p.ws + W_MVTP) + (size_t)l * 16 * 65536});
    }
    return;
  }
  if (ph == 2) { phase_chain(p, 0); if (PROBE_REP & 1) { cg::this_grid().sync(); phase_chain(p, 0, 1); } return; }
  if (ph == N_PHASES - 1) { if (PROBE_REP & 64) for (int i = 0; i < 40; ++i) cg::this_grid().sync(); phase_final(p); return; }
  const int l = (ph - 3) / NPL, s = (ph - 3) % NPL;
  const u16* WT = (const u16*)(p.ws + W_WT) + (size_t)l * WE_LAYER;
  switch (s) {
    case 0: phase_prep(p, l); if (PROBE_REP & 2) { cg::this_grid().sync(); phase_prep(p, l); } break;
    case 1:
      gemm_phase((const u16*)(p.ws + W_CQB), WT + WE_Q, 256, 72, 5, 0, EpiQ{(u16*)(p.ws + W_QB), (const float2*)(p.ws + W_ROPE)});
      gemm_phase((const u16*)(p.ws + W_A2), WT + WE_RW, 256, 72, 6, 360,
                 EpiRW{p.in[I_W0] + l * 512, p.in[I_A0] + l * 512, p.in[I_KA] + l * 512, p.ws});
      break;
    case 2: phase_cprep(p); if (PROBE_REP & 8) { cg::this_grid().sync(); phase_cprep(p); } break;
    case 3: phase_mix(p, l, 0); if (PROBE_REP & 16) { cg::this_grid().sync(); phase_mix(p, l, 2); } break;
    case 4: phase_yfin(p, l); if (PROBE_REP & 32) { cg::this_grid().sync(); phase_yfin(p, l); } break;
    default: phase_chain(p, l + 1); if (PROBE_REP & 1) { cg::this_grid().sync(); phase_chain(p, l + 1, 1); } break;
  }
}

__device__ __forceinline__ void grid_barrier(int* CT, int gen) {
  asm volatile("s_waitcnt vmcnt(0)" ::: "memory");
  __syncthreads();
  if (tidx() == 0) {
    __builtin_amdgcn_fence(__ATOMIC_RELEASE, "agent");
    asm volatile("s_waitcnt vmcnt(0)" ::: "memory");
    int* grpc = CT + 15000 + (blockIdx.x & 7) * 32;
    int* glob = CT + 15000 + 8 * 32;
    const int per = gridDim.x >> 3;
    if (atomicAdd(grpc, 1) + 1 == per * (gen + 1)) atomicAdd(glob, 1);
    while (__hip_atomic_load(glob, __ATOMIC_RELAXED, __HIP_MEMORY_SCOPE_AGENT) < 8 * (gen + 1)) __builtin_amdgcn_s_sleep(1);
    __builtin_amdgcn_fence(__ATOMIC_ACQUIRE, "agent");
    asm volatile("s_waitcnt vmcnt(0)" ::: "memory");
  }
  __syncthreads();
}

__global__ void __launch_bounds__(NTHR) mega(Params p) {
  cg::grid_group grid = cg::this_grid();
  for (int ph = p.ph_lo; ph < p.ph_hi; ++ph) {
    const __attribute__((address_space(4))) Params* q = (const __attribute__((address_space(4))) Params*)__builtin_amdgcn_kernarg_segment_ptr();
    asm volatile("" : "+s"(q));
    run_phase(*q, ph);
    if (ph + 1 < p.ph_hi) {
      if (ph == p.ph_lo) grid.sync();
      else grid_barrier((int*)(q->ws + W_CNT), ph - p.ph_lo - 1);
    }
  }
}

extern "C" void kernel_launch(void* const* d_in, const int* in_sizes, int n_in, void* d_out, int out_size, void* d_ws,
                              size_t ws_size, hipStream_t stream) {
  static int grid = 0;
  if (grid == 0) {
    if (n_in != N_IN || (size_t)out_size != OO_END || ws_size < W_END) {
      fprintf(stderr, "kernel_launch: unexpected shapes n_in=%d out=%d ws=%zu (need %zu)\n", n_in, out_size, ws_size, (size_t)W_END);
      grid = -1; return;
    }
    int dev = 0, cus = 0, per_cu = 0;
    hipGetDevice(&dev);
    hipDeviceGetAttribute(&cus, hipDeviceAttributeMultiprocessorCount, dev);
    hipFuncSetAttribute((const void*)mega, hipFuncAttributeMaxDynamicSharedMemorySize, SMEM_BYTES);
    hipOccupancyMaxActiveBlocksPerMultiprocessor(&per_cu, (const void*)mega, NTHR, SMEM_BYTES);
    if (per_cu < 1) { fprintf(stderr, "kernel_launch: occupancy query says %d blocks/CU\n", per_cu); per_cu = 1; }
    (void)hipGetLastError();
    grid = cus;
  }
  if (grid < 0) return;
  if (hipMemsetAsync((char*)d_ws + W_CNT, 0, 65536, stream) != hipSuccess) { fprintf(stderr, "kernel_launch: memset of control words failed\n"); return; }
  Params p{};
  for (int i = 0; i < N_IN; ++i) p.in[i] = (const float*)d_in[i];
  p.out = (float*)d_out; p.ws = (char*)d_ws;
#if N_LAUNCH_PER_PHASE
  for (int ph = 0; ph < N_PHASES; ++ph) {
    p.ph_lo = ph; p.ph_hi = ph + 1;
    void* args[] = {&p};
    hipError_t e = hipLaunchCooperativeKernel((const void*)mega, dim3(grid), dim3(NTHR), args, SMEM_BYTES, stream);
    if (e != hipSuccess) { fprintf(stderr, "launch failed: %s\n", hipGetErrorString(e)); break; }
  }
#else
  p.ph_lo = 0; p.ph_hi = N_PHASES;
  void* args[] = {&p};
  hipError_t e = hipLaunchCooperativeKernel((const void*)mega, dim3(grid), dim3(NTHR), args, SMEM_BYTES, stream);
  if (e != hipSuccess) fprintf(stderr, "cooperative launch failed: %s (grid %d)\n", hipGetErrorString(e), grid);
#endif
}
```

```cpp
#include <hip/hip_runtime.h>
#include <hip/hip_cooperative_groups.h>
#include <stdint.h>
#include <stdio.h>
namespace cg = cooperative_groups;

typedef unsigned short u16;
using bf16x8 = __attribute__((ext_vector_type(8))) short;
using f32x4 = __attribute__((ext_vector_type(4))) float;
using f32x16 = __attribute__((ext_vector_type(16))) float;

#ifndef REP_WHICH
#define REP_WHICH 0
#endif
#ifndef PROBE_REP
#define PROBE_REP 0
#endif
#ifndef PROBE_MASK
#define PROBE_MASK 0x3ff
#endif
#ifndef N_LAUNCH_PER_PHASE
#define N_LAUNCH_PER_PHASE 0
#endif

constexpr int TP = 16384, TS = 2048, T = TP + TS, NL = 4;
constexpr int DFF = 2816, DIN = 2208, DINP = 2304, DSH = 1792;
constexpr int NTHR = 512;
constexpr int SMEM_BYTES = 139264 + 2048;
constexpr int SMEM_ITEM = 139264 + 1024;
constexpr float QSCALE = 0.10206207261596577f * 1.4426950408889634f;
constexpr float XSCALE = 0.0625f * 1.4426950408889634f;

constexpr size_t OO_Y = 0;
constexpr size_t OO_CKVP = OO_Y + (size_t)T * 1024;
constexpr size_t OO_KRP = OO_CKVP + (size_t)NL * 4 * 4096 * 128;
constexpr size_t OO_MKP = OO_KRP + (size_t)NL * 4 * 4096 * 32;
constexpr size_t OO_MVP = OO_MKP + (size_t)NL * 4 * 256 * 1024;
constexpr size_t OO_WKVP = OO_MVP + (size_t)NL * 4 * 256 * 1024;
constexpr size_t OO_SHP = OO_WKVP + (size_t)NL * 4 * 8 * 4096;
constexpr size_t OO_CKVS = OO_SHP + (size_t)NL * 4 * DSH;
constexpr size_t OO_KRS = OO_CKVS + (size_t)NL * 32 * 64 * 128;
constexpr size_t OO_WKVS = OO_KRS + (size_t)NL * 32 * 64 * 32;
constexpr size_t OO_SHS = OO_WKVS + (size_t)NL * 32 * 8 * 4096;
constexpr size_t OO_END = OO_SHS + (size_t)NL * 32 * DSH;

constexpr size_t al256(size_t x) { return (x + 255) & ~(size_t)255; }
constexpr size_t W_X = 0;
constexpr size_t W_XB = W_X + al256((size_t)T * 1024 * 4);
constexpr size_t W_SSQ = W_XB + al256((size_t)T * 1024 * 2);
constexpr size_t W_ACT = W_SSQ + al256((size_t)T * 4 * 4);
constexpr size_t W_WB = W_ACT;
constexpr size_t W_BB = W_WB + al256((size_t)T * 512 * 4);
constexpr size_t W_GB = W_BB + al256((size_t)T * 512 * 4);
constexpr size_t W_QX = W_ACT;
constexpr size_t W_PROJ = W_ACT + al256((size_t)T * DFF * 2);
constexpr size_t W_AO = W_PROJ;
constexpr size_t W_CQB = W_PROJ + al256((size_t)T * DINP * 2);
constexpr size_t W_A2 = W_CQB + al256((size_t)T * 256 * 2);
constexpr size_t W_QB = W_A2 + al256((size_t)T * 256 * 2);
constexpr size_t W_XO = W_QB;
constexpr size_t W_RB = W_QB + al256((size_t)T * 1280 * 2);
constexpr size_t W_KB = W_RB + al256((size_t)T * 512 * 4);
constexpr size_t W_VB = W_KB + al256((size_t)T * 512 * 4);
constexpr size_t W_KKB = W_VB + al256((size_t)T * 512 * 4);
constexpr size_t W_KP = W_KKB + al256((size_t)T * 512 * 4);
constexpr size_t W_KS = W_KP + al256((size_t)4 * 4096 * 160 * 2);
constexpr size_t W_VTP = W_KS + al256((size_t)32 * 2112 * 160 * 2);
constexpr size_t W_VTS = W_VTP + al256((size_t)4 * 128 * 4096 * 2);
constexpr size_t W_MKP = W_VTS + al256((size_t)32 * 128 * 2112 * 2);
constexpr size_t W_MVTP = W_MKP + al256((size_t)NL * 16 * 65536 * 2);
constexpr size_t W_MKS = W_MVTP + al256((size_t)NL * 16 * 65536 * 2);
constexpr size_t W_MVTS = W_MKS + al256((size_t)128 * 65536 * 2);
constexpr size_t W_MB = W_MVTS + al256((size_t)128 * 65536 * 2);
constexpr size_t W_ROPE = W_MB + al256((size_t)1024 * 1024 * 2);
constexpr size_t W_CNT = W_ROPE + al256((size_t)4096 * 16 * 8);
constexpr size_t W_YB = W_CNT + 65536;
constexpr size_t W_CQ = W_YB + al256((size_t)T * 512 * 4);
constexpr size_t W_WT = W_CQ + al256((size_t)2304 * 4096 * 4);
constexpr size_t W_CRR = W_PROJ + al256((size_t)T * 1536 * 2);
constexpr size_t W_CPT = W_CQB;
static_assert(W_CRR + (size_t)2304 * 4096 * 2 <= W_CQB, "RRt must fit behind AO");
static_assert((size_t)2304 * 4096 * 2 <= 2 * al256((size_t)T * 256 * 2), "Pt must fit in CQB+A2");
constexpr size_t WE_GU1 = 0;
constexpr size_t WE_D1 = WE_GU1 + (size_t)5632 * 1024;
constexpr size_t WE_IN = WE_D1 + (size_t)1024 * DFF;
constexpr size_t WE_Q = WE_IN + (size_t)DINP * 1024;
constexpr size_t WE_RW = WE_Q + (size_t)1280 * 256;
constexpr size_t WE_OUT = WE_RW + (size_t)1536 * 256;
constexpr size_t WE_MQ = WE_OUT + (size_t)1024 * 1536;
constexpr size_t WE_MK = WE_MQ + (size_t)1024 * 1024;
constexpr size_t WE_MV = WE_MK + (size_t)1024 * 1024;
constexpr size_t WE_MO = WE_MV + (size_t)1024 * 1024;
constexpr size_t WE_GU2 = WE_MO + (size_t)1024 * 1024;
constexpr size_t WE_D2 = WE_GU2 + (size_t)5632 * 1024;
constexpr size_t WE_LAYER = WE_D2 + (size_t)1024 * DFF;
constexpr size_t W_END = W_WT + al256(WE_LAYER * NL * 2);

enum { I_XP = 0, I_XS, I_MEMP, I_CCKV, I_CKR, I_CMK, I_CMV, I_SWKV, I_SSH, I_F1N, I_F1G, I_F1U, I_F1D, I_MIXN, I_WIN,
       I_QN, I_WUQ, I_KVN, I_WUK, I_WUV, I_MU, I_W0, I_WUP, I_A0, I_AUP, I_GUP, I_KK, I_KA, I_RK, I_GNG, I_GNB, I_WOUT,
       I_XN, I_MKVN, I_WMQ, I_WMK, I_WMV, I_WMO, I_F2N, I_F2G, I_F2U, I_F2D, I_FN, N_IN };

struct Params {
  const float* in[N_IN];
  float* out;
  char* ws;
  int ph_lo, ph_hi;
};

typedef const __attribute__((address_space(4))) Params& KPR;

typedef __bf16 bf2_t __attribute__((ext_vector_type(2)));
typedef float f2_t __attribute__((ext_vector_type(2)));
__device__ __forceinline__ u16 f2bf(float f) { __bf16 b = (__bf16)f; return __builtin_bit_cast(u16, b); }
__device__ __forceinline__ float bf2f(u16 h) { return __uint_as_float(((unsigned)h) << 16); }
__device__ __forceinline__ unsigned pack2(float a, float b) { f2_t v = {a, b}; bf2_t r = __builtin_convertvector(v, bf2_t); return __builtin_bit_cast(unsigned, r); }
__device__ __forceinline__ float4 bf4(uint2 w) {
  return make_float4(__uint_as_float(w.x << 16), __uint_as_float(w.x & 0xffff0000u), __uint_as_float(w.y << 16), __uint_as_float(w.y & 0xffff0000u));
}
__device__ __forceinline__ float wave_sum(float x) {
  x += __int_as_float(__builtin_amdgcn_update_dpp(0, __float_as_int(x), 0xB1, 0xF, 0xF, false));
  x += __int_as_float(__builtin_amdgcn_update_dpp(0, __float_as_int(x), 0x4E, 0xF, 0xF, false));
  x += __int_as_float(__builtin_amdgcn_update_dpp(0, __float_as_int(x), 0x141, 0xF, 0xF, false));
  x += __int_as_float(__builtin_amdgcn_update_dpp(0, __float_as_int(x), 0x140, 0xF, 0xF, false));
  const float s0 = __int_as_float(__builtin_amdgcn_readlane(__float_as_int(x), 0)), s1 = __int_as_float(__builtin_amdgcn_readlane(__float_as_int(x), 16));
  const float s2 = __int_as_float(__builtin_amdgcn_readlane(__float_as_int(x), 32)), s3 = __int_as_float(__builtin_amdgcn_readlane(__float_as_int(x), 48));
  return (s0 + s1) + (s2 + s3);
}
__device__ __forceinline__ float dpp_sum8(float x) {
  x += __int_as_float(__builtin_amdgcn_update_dpp(0, __float_as_int(x), 0xB1, 0xF, 0xF, false));
  x += __int_as_float(__builtin_amdgcn_update_dpp(0, __float_as_int(x), 0x4E, 0xF, 0xF, false));
  x += __int_as_float(__builtin_amdgcn_update_dpp(0, __float_as_int(x), 0x141, 0xF, 0xF, false));
  return x;
}
__device__ __forceinline__ int tidx() { int t = threadIdx.x; asm volatile("" : "+v"(t)); return t; }
__device__ __forceinline__ float fma_s(float a, float b, float c) { float d; asm("v_fma_f32 %0, %1, %2, %3" : "=v"(d) : "v"(a), "v"(b), "v"(c)); return d; }
__device__ __forceinline__ float sub_s(float a, float b) { float d; asm("v_sub_f32 %0, %1, %2" : "=v"(d) : "v"(a), "v"(b)); return d; }
__device__ __forceinline__ float add_s(float a, float b) { float d; asm("v_add_f32 %0, %1, %2" : "=v"(d) : "v"(a), "v"(b)); return d; }
__device__ __forceinline__ float mul_s(float a, float b) { float d; asm("v_mul_f32 %0, %1, %2" : "=v"(d) : "v"(a), "v"(b)); return d; }
__device__ __forceinline__ float sigmoidf_(float x) { return 1.f / (1.f + __expf(-x)); }

constexpr int BM = 256, BK = 64, HALF = 128, HT = HALF * BK;

__device__ __forceinline__ int lds_byte(int r, int c) {
  int st = (r >> 4) * 2 + (c >> 5), rr = r & 15, cc = c & 31, ob = rr * 64 + cc * 2;
  return st * 1024 + (ob ^ (((ob >> 9) & 1) << 5));
}
__device__ __forceinline__ void stage_rc(int b, int& R, int& C) {
  int st = b / 1024, sb = b % 1024, swz = sb ^ (((sb >> 9) & 1) << 5);
  R = (st >> 1) * 16 + swz / 64; C = (st & 1) * 32 + (swz % 64) / 2;
}

__device__ __forceinline__ void tile_map(int tile, int nM, int nN, int& pm, int& pn) {
  const int ntiles = nM * nN;
  int wgid = tile;
  { int q = ntiles / 8, r = ntiles % 8, xcd = wgid % 8, off = wgid / 8;
    wgid = (xcd < r ? xcd * (q + 1) : r * (q + 1) + (xcd - r) * q) + off; }
  int nig = 8 * nN, gid = wgid / nig, fm = gid * 8, gsz = min(nM - fm, 8);
  pm = fm + ((wgid % nig) % gsz); pn = (wgid % nig) / gsz;
}

template <class Epi>
__device__ __forceinline__ void gemm_tile(const u16* __restrict__ A, const u16* __restrict__ Bt, const int K,
                                          const int pm, const int pn, Epi epi) {
  extern __shared__ __attribute__((aligned(16))) char smem[];
  u16* shm = (u16*)smem;
#define SA(b, h) (shm + ((b) * 2 + (h)) * HT)
#define SB(b, h) (shm + (4 + (b) * 2 + (h)) * HT)
#define STAGE(P, BASE, br, kt) do { const u16* _gb = BASE + ((long)(br) * K + (long)(kt) * BK); \
    __builtin_amdgcn_global_load_lds((const unsigned*)((const char*)_gb + so0), \
        (__attribute__((address_space(3))) unsigned*)((char*)(P) + wu16), 16, 0, 0); \
    __builtin_amdgcn_global_load_lds((const unsigned*)((const char*)_gb + so1), \
        (__attribute__((address_space(3))) unsigned*)((char*)(P) + wu16 + 8192), 16, 0, 0); } while (0)
#define LDA(dst, b, h) for (int m = 0; m < 4; ++m) for (int k = 0; k < 2; ++k) \
    dst[m][k] = *reinterpret_cast<const bf16x8*>((char*)SA(b, h) + lds_byte(wr * 64 + m * 16 + fr, k * 32 + fq * 8))
#define LDB(dst, b, h) for (int n = 0; n < 2; ++n) for (int k = 0; k < 2; ++k) \
    dst[n][k] = *reinterpret_cast<const bf16x8*>((char*)SB(b, h) + lds_byte(wc * 32 + n * 16 + fr, k * 32 + fq * 8))
#define MMA(ai, bj, At_, Bt_) do { __builtin_amdgcn_s_setprio(1); \
    for (int m = 0; m < 4; ++m) for (int n = 0; n < 2; ++n) for (int k = 0; k < 2; ++k) \
      acc[ai][bj][m][n] = __builtin_amdgcn_mfma_f32_16x16x32_bf16(At_[m][k], Bt_[n][k], acc[ai][bj][m][n], 0, 0, 0); \
    __builtin_amdgcn_s_setprio(0); } while (0)
#define WAIT_V(n) asm volatile("s_waitcnt vmcnt(" #n ")" ::: "memory")
#define WAIT_L(n) asm volatile("s_waitcnt lgkmcnt(" #n ")" ::: "memory")
#define BAR __builtin_amdgcn_s_barrier()
#define SCHED __builtin_amdgcn_sched_barrier(0)
  const int tid_ = tidx();
  const int wid = tid_ >> 6, lane = tid_ & 63, wr = wid >> 2, wc = wid & 3, fr = lane & 15, fq = lane >> 4;
  const int nt = K / BK;
  const int wu16 = __builtin_amdgcn_readfirstlane(tid_ >> 6) * 1024;
  {
    unsigned so0, so1;
    { int _r, _c; stage_rc(tid_ * 16, _r, _c); so0 = (unsigned)(_r * K + _c) * 2u;
      stage_rc(tid_ * 16 + 8192, _r, _c); so1 = (unsigned)(_r * K + _c) * 2u; }
    const int brow = pm * BM, bcol = pn * BM;
    f32x4 acc[2][2][4][2] = {};
    bf16x8 At[4][2], B0[2][2], B1[2][2];
    STAGE(SB(0, 0), Bt, bcol, 0); STAGE(SA(0, 0), A, brow, 0);
    STAGE(SB(0, 1), Bt, bcol + HALF, 0); STAGE(SA(0, 1), A, brow + HALF, 0);
    if (wr == 1) BAR;
    WAIT_V(4); BAR;
    STAGE(SB(1, 0), Bt, bcol, 1); STAGE(SA(1, 0), A, brow, 1); STAGE(SB(1, 1), Bt, bcol + HALF, 1);
    WAIT_V(6); BAR;
    for (int t = 0; t < nt - 2; t += 2) {
      LDB(B0, 0, 0); SCHED; LDA(At, 0, 0); STAGE(SA(1, 1), A, brow + HALF, t + 1);
      WAIT_L(8); BAR; WAIT_L(0); MMA(0, 0, At, B0); BAR; SCHED;
      LDB(B1, 0, 1); STAGE(SB(0, 0), Bt, bcol, t + 2);
      BAR; WAIT_L(0); MMA(0, 1, At, B1); BAR;
      LDA(At, 0, 1); STAGE(SA(0, 0), A, brow, t + 2);
      BAR; WAIT_L(0); MMA(1, 0, At, B0); BAR; SCHED;
      STAGE(SB(0, 1), Bt, bcol + HALF, t + 2);
      WAIT_V(6); BAR; MMA(1, 1, At, B1); BAR;
      LDB(B0, 1, 0); SCHED; LDA(At, 1, 0); STAGE(SA(0, 1), A, brow + HALF, t + 2);
      WAIT_L(8); BAR; WAIT_L(0); MMA(0, 0, At, B0); BAR; SCHED;
      LDB(B1, 1, 1); STAGE(SB(1, 0), Bt, bcol, t + 3);
      BAR; WAIT_L(0); MMA(0, 1, At, B1); BAR;
      LDA(At, 1, 1); STAGE(SA(1, 0), A, brow, t + 3);
      BAR; WAIT_L(0); MMA(1, 0, At, B0); BAR; SCHED;
      STAGE(SB(1, 1), Bt, bcol + HALF, t + 3);
      WAIT_V(6); BAR; MMA(1, 1, At, B1); BAR;
    }
    { LDB(B0, 0, 0); LDA(At, 0, 0); STAGE(SA(1, 1), A, brow + HALF, nt - 1);
      BAR; WAIT_L(0); MMA(0, 0, At, B0); BAR;
      LDB(B1, 0, 1); BAR; WAIT_L(0); MMA(0, 1, At, B1); BAR;
      LDA(At, 0, 1); WAIT_V(4); BAR; WAIT_L(0); MMA(1, 0, At, B0); MMA(1, 1, At, B1); BAR; }
    { LDB(B0, 1, 0); LDA(At, 1, 0); WAIT_V(2); BAR; WAIT_L(0); MMA(0, 0, At, B0); BAR;
      LDB(B1, 1, 1); WAIT_V(0); BAR; WAIT_L(0); MMA(0, 1, At, B1); BAR;
      LDA(At, 1, 1); BAR; WAIT_L(0); MMA(1, 0, At, B0); MMA(1, 1, At, B1); BAR; }
    if (wr == 0) BAR;
    float* stg = (float*)smem;
    int tx = tid_;
    asm volatile("" : "+v"(tx));
    const int ewr = tx >> 8, ewc = (tx >> 6) & 3, efr = tx & 15, efq = (tx >> 4) & 3;
#define EPI_HALF(ai) do { \
    __syncthreads(); \
    _Pragma("unroll") for (int bj = 0; bj < 2; ++bj) _Pragma("unroll") for (int m = 0; m < 4; ++m) \
    _Pragma("unroll") for (int n = 0; n < 2; ++n) _Pragma("unroll") for (int j = 0; j < 4; ++j) \
      stg[(ewr * 64 + m * 16 + efq * 4 + j) * 260 + bj * HALF + ewc * 32 + n * 16 + efr] = acc[ai][bj][m][n][j]; \
    __syncthreads(); \
    _Pragma("unroll") for (int i = 0; i < 8; ++i) { \
      int item = i * NTHR + tx; int rl = item >> 5, qp = item & 31; \
      int cl = (qp >> 2) * 32 + (qp & 3) * 4; \
      float4 v0 = *(const float4*)(stg + rl * 260 + cl), v1 = *(const float4*)(stg + rl * 260 + cl + 16); \
      int row = brow + ai * HALF + rl; \
      float ss = epi.apply4(row, bcol + cl, v0, v1); \
      if (Epi::kSsq) { \
        ss += __shfl_xor(ss, 1); ss += __shfl_xor(ss, 2); ss += __shfl_xor(ss, 4); ss += __shfl_xor(ss, 8); ss += __shfl_xor(ss, 16); \
        if (qp == 0) epi.ssq_out(row, pn, ss); \
      } \
    } } while (0)
    EPI_HALF(0);
    EPI_HALF(1);
#undef EPI_HALF
    __syncthreads();
  }
#undef SA
#undef SB
#undef STAGE
#undef LDA
#undef LDB
#undef MMA
}

template <class Epi>
__device__ __forceinline__ void gemm_phase(const u16* __restrict__ A, const u16* __restrict__ Bt, const int K,
                                           const int nM, const int nN, const int rot, Epi epi) {
  const int G = gridDim.x;
  for (int tile = (int)((blockIdx.x + G - (rot % G)) % G); tile < nM * nN; tile += G) {
    int pm, pn; tile_map(tile, nM, nN, pm, pn);
    gemm_tile(A, Bt, K, pm, pn, epi);
  }
}

__device__ __forceinline__ float rstd_from_ssq(const float* ssq, int row) {
  float4 s = *(const float4*)(ssq + (size_t)row * 4);
  return rsqrtf((s.x + s.y + s.z + s.w) * (1.f / 1024.f) + 1e-6f);
}
__device__ __forceinline__ uint2 pack4(float4 v) { uint2 w; w.x = pack2(v.x, v.y); w.y = pack2(v.z, v.w); return w; }
__device__ __forceinline__ float silu_mul(float g, float u) { return g / (1.f + __expf(-g)) * u; }
struct EpiGU {
  static constexpr bool kSsq = false;
  const float* ssq; u16* act;
  __device__ __forceinline__ float apply4(int row, int c0, float4 g, float4 u) const {
    float rs = rstd_from_ssq(ssq, row);
    float4 o = make_float4(silu_mul(g.x * rs, u.x * rs), silu_mul(g.y * rs, u.y * rs), silu_mul(g.z * rs, u.z * rs), silu_mul(g.w * rs, u.w * rs));
    *(uint2*)(act + (size_t)row * DFF + ((c0 & ~31) >> 1) + (c0 & 15)) = pack4(o);
    return 0.f;
  }
  __device__ __forceinline__ void ssq_out(int, int, float) const {}
};
struct EpiRes {
  static constexpr bool kSsq = true;
  float* x; u16* xb; float* ssq; float coef;
  __device__ __forceinline__ float apply4(int row, int c0, float4 v0, float4 v1) const {
    size_t i = (size_t)row * 1024 + c0;
    float4 a = *(const float4*)(x + i), b = *(const float4*)(x + i + 16);
    a.x += coef * v0.x; a.y += coef * v0.y; a.z += coef * v0.z; a.w += coef * v0.w;
    b.x += coef * v1.x; b.y += coef * v1.y; b.z += coef * v1.z; b.w += coef * v1.w;
    *(float4*)(x + i) = a; *(float4*)(x + i + 16) = b;
    *(uint2*)(xb + i) = pack4(a); *(uint2*)(xb + i + 16) = pack4(b);
    return a.x * a.x + a.y * a.y + a.z * a.z + a.w * a.w + b.x * b.x + b.y * b.y + b.z * b.z + b.w * b.w;
  }
  __device__ __forceinline__ void ssq_out(int row, int pn, float v) const { ssq[(size_t)row * 4 + pn] = v; }
};
struct EpiScaleBf {
  static constexpr bool kSsq = false;
  const float* ssq; u16* o; int ld;
  __device__ __forceinline__ float apply4(int row, int c0, float4 v0, float4 v1) const {
    float rs = rstd_from_ssq(ssq, row);
    size_t i = (size_t)row * ld + c0;
    *(uint2*)(o + i) = pack4(make_float4(v0.x * rs, v0.y * rs, v0.z * rs, v0.w * rs));
    *(uint2*)(o + i + 16) = pack4(make_float4(v1.x * rs, v1.y * rs, v1.z * rs, v1.w * rs));
    return 0.f;
  }
  __device__ __forceinline__ void ssq_out(int, int, float) const {}
};
struct EpiQ {
  static constexpr bool kSsq = false;
  u16* qb; const float2* rope;
  __device__ __forceinline__ float apply4(int row, int c0, float4 v0, float4 v1) const {
    if (c0 < 1024) {
      size_t i = (size_t)row * 1280 + (c0 >> 7) * 160 + (c0 & 127);
      *(uint2*)(qb + i) = pack4(v0); *(uint2*)(qb + i + 16) = pack4(v1);
    } else {
      int h = (c0 - 1024) >> 5, f0 = c0 & 15;
      int pos = row < TP ? (row & 4095) : (2048 + ((row - TP) & 63));
      const float2* cs = rope + pos * 16 + f0;
      float2 c_0 = cs[0], c_1 = cs[1], c_2 = cs[2], c_3 = cs[3];
      size_t i = (size_t)row * 1280 + h * 160 + 128 + f0;
      *(uint2*)(qb + i) = pack4(make_float4(v0.x * c_0.x - v1.x * c_0.y, v0.y * c_1.x - v1.y * c_1.y, v0.z * c_2.x - v1.z * c_2.y, v0.w * c_3.x - v1.w * c_3.y));
      *(uint2*)(qb + i + 16) = pack4(make_float4(v0.x * c_0.y + v1.x * c_0.x, v0.y * c_1.y + v1.y * c_1.x, v0.z * c_2.y + v1.z * c_2.x, v0.w * c_3.y + v1.w * c_3.x));
    }
    return 0.f;
  }
  __device__ __forceinline__ void ssq_out(int, int, float) const {}
};
__device__ __forceinline__ float decay_f(float z) {
  float nz = -z;
  float sp = fmaxf(nz, 0.f) + __logf(1.f + __expf(-fabsf(nz)));
  return __expf(-__expf(-sp - 0.5f));
}
struct EpiRW {
  static constexpr bool kSsq = false;
  const float* w0; const float* a0; const float* ka; char* ws;
  __device__ __forceinline__ void acol(size_t i, int c, float4 v) const {
    u16* bb = (u16*)(ws + W_BB); u16* kb = (u16*)(ws + W_KB); const u16* kkb = (const u16*)(ws + W_KKB);
    float4 a_0 = *(const float4*)(a0 + c), k_a = *(const float4*)(ka + c), kk = bf4(*(const uint2*)(kkb + i)), k = bf4(*(const uint2*)(kb + i));
    float4 a = make_float4(sigmoidf_(a_0.x + v.x), sigmoidf_(a_0.y + v.y), sigmoidf_(a_0.z + v.z), sigmoidf_(a_0.w + v.w));
    *(uint2*)(bb + i) = pack4(make_float4(kk.x * a.x, kk.y * a.y, kk.z * a.z, kk.w * a.w));
    *(uint2*)(kb + i) = pack4(make_float4(k.x * (1.f + (a.x - 1.f) * k_a.x), k.y * (1.f + (a.y - 1.f) * k_a.y), k.z * (1.f + (a.z - 1.f) * k_a.z), k.w * (1.f + (a.w - 1.f) * k_a.w)));
  }
  __device__ __forceinline__ float apply4(int row, int c0, float4 v0, float4 v1) const {
    if (c0 < 512) {
      float* wb = (float*)(ws + W_WB);
      float4 z0 = *(const float4*)(w0 + c0), z1 = *(const float4*)(w0 + c0 + 16);
      size_t i = (size_t)row * 512 + c0;
      *(float4*)(wb + i) = make_float4(decay_f(z0.x + v0.x), decay_f(z0.y + v0.y), decay_f(z0.z + v0.z), decay_f(z0.w + v0.w));
      *(float4*)(wb + i + 16) = make_float4(decay_f(z1.x + v1.x), decay_f(z1.y + v1.y), decay_f(z1.z + v1.z), decay_f(z1.w + v1.w));
    } else if (c0 < 1024) {
      int c = c0 - 512; size_t i = (size_t)row * 512 + c;
      acol(i, c, v0); acol(i + 16, c + 16, v1);
    } else {
      u16* gb = (u16*)(ws + W_GB);
      size_t i = (size_t)row * 512 + (c0 - 1024);
      *(uint2*)(gb + i) = pack4(v0); *(uint2*)(gb + i + 16) = pack4(v1);
    }
    return 0.f;
  }
  __device__ __forceinline__ void ssq_out(int, int, float) const {}
};
template <bool ISV>
struct EpiMem {
  static constexpr bool kSsq = false;
  float* of; u16* ob;
  __device__ __forceinline__ void quad(int row, int col, float4 v) const {
    *(float4*)(of + (size_t)row * 1024 + col) = v;
    int b = row >> 8, m = row & 255, h = col >> 8, d = col & 255;
    if (ISV) {
      u16* o = ob + (size_t)((b * 4 + h) * 256 + d) * 256 + m;
      o[0] = f2bf(v.x); o[256] = f2bf(v.y); o[512] = f2bf(v.z); o[768] = f2bf(v.w);
    } else {
      *(uint2*)(ob + (size_t)((b * 4 + h) * 256 + m) * 256 + d) = pack4(v);
    }
  }
  __device__ __forceinline__ float apply4(int row, int c0, float4 v0, float4 v1) const {
    quad(row, c0, v0); quad(row, c0 + 16, v1);
    return 0.f;
  }
  __device__ __forceinline__ void ssq_out(int, int, float) const {}
};

template <class F>
__device__ __forceinline__ void tconv(u16* dst, int ldd, int N, int K, int rot, F f) {
  extern __shared__ __attribute__((aligned(16))) char smem[];
  float* t = (float*)smem;
  const int nk = K / 64, nt = (N / 64) * nk, G = gridDim.x;
  const int tid = tidx(), a = tid >> 6, c = tid & 63;
  for (int tile = (int)((blockIdx.x + G - (rot % G)) % G); tile < nt; tile += G) {
    int n0 = (tile / nk) * 64, k0 = (tile % nk) * 64;
    __syncthreads();
#pragma unroll
    for (int i = 0; i < 8; ++i) { int kk = a + 8 * i; t[kk * 65 + c] = f(k0 + kk, n0 + c); }
    __syncthreads();
#pragma unroll
    for (int i = 0; i < 2; ++i) {
      const int nn = (tid >> 4) + 32 * i, kq = (tid & 15) * 4;
      uint2 w; w.x = pack2(t[kq * 65 + nn], t[(kq + 1) * 65 + nn]); w.y = pack2(t[(kq + 2) * 65 + nn], t[(kq + 3) * 65 + nn]);
      *(uint2*)(dst + (size_t)(n0 + nn) * ldd + k0 + kq) = w;
    }
  }
}

template <class F>
__device__ __forceinline__ void tconv_v(u16* dst, int ldd, int N, int K, int vb, int nvb, F f) {
  extern __shared__ __attribute__((aligned(16))) char smem[];
  float* t = (float*)smem;
  const int nk = K / 64, nt = (N / 64) * nk;
  const int tid = tidx(), a = tid >> 6, c = tid & 63;
  for (int tile = vb; tile < nt; tile += nvb) {
    int n0 = (tile / nk) * 64, k0 = (tile % nk) * 64;
    __syncthreads();
#pragma unroll
    for (int i = 0; i < 8; ++i) { int kk = a + 8 * i; t[kk * 65 + c] = f(k0 + kk, n0 + c); }
    __syncthreads();
#pragma unroll
    for (int i = 0; i < 2; ++i) {
      const int nn = (tid >> 4) + 32 * i, kq = (tid & 15) * 4;
      uint2 w; w.x = pack2(t[kq * 65 + nn], t[(kq + 1) * 65 + nn]); w.y = pack2(t[(kq + 2) * 65 + nn], t[(kq + 3) * 65 + nn]);
      *(uint2*)(dst + (size_t)(n0 + nn) * ldd + k0 + kq) = w;
    }
  }
  __syncthreads();
}

template <int DK, int DV, int RPG>
__device__ __forceinline__ void attn_item(const u16* __restrict__ Qb, int ldq, int nrows, const u16* __restrict__ Kb, int ldk,
                                          const u16* __restrict__ Vtb, int ldvt, int nkeys, u16* __restrict__ Ob, int ldo) {
  extern __shared__ __attribute__((aligned(16))) char smem[];
  constexpr int KS = DK + 8, VS = 68;
  u16* sK = (u16*)smem;
  u16* sV = sK + 64 * KS;
  const int tid = tidx(), wid = tid >> 6, lane = tid & 63, q = lane & 31, hh = lane >> 5;
  const int row = wid * 32 + q;
  const bool active = (wid * 32) < nrows;
  bf16x8 qf[DK / 16];
  if (active) {
#pragma unroll
    for (int ks = 0; ks < DK / 16; ++ks) qf[ks] = *(const bf16x8*)(Qb + (size_t)row * ldq + ks * 16 + hh * 8);
  }
  f32x16 o[DV / 32];
#pragma unroll
  for (int dt = 0; dt < DV / 32; ++dt)
#pragma unroll
    for (int i = 0; i < 16; ++i) o[dt][i] = 0.f;
  float mrun = -1e30f, lrun = 0.f;
  const int nkt = nkeys >> 6;
  constexpr int KCH = (64 * (DK / 8) + NTHR - 1) / NTHR;
  static_assert(DV == 128 && KCH <= 4, "staging registers are written out by hand");
  uint4 kr0, kr1, kr2, kr3, vr0, vr1;
#define AT_KL(N_, kt_) { const int c = tid + N_ * NTHR; if (N_ < KCH && c < 64 * (DK / 8)) { const int r = c / (DK / 8), cc = c % (DK / 8); \
      kr##N_ = *(const uint4*)(Kb + (size_t)((kt_) * 64 + r) * ldk + cc * 8); } }
#define AT_VL(N_, kt_) { const int c = tid + N_ * NTHR; const int r = c >> 3, cc = c & 7; vr##N_ = *(const uint4*)(Vtb + (size_t)r * ldvt + (kt_) * 64 + cc * 8); }
#define AT_GLOAD(kt_) do { AT_KL(0, kt_) AT_KL(1, kt_) AT_KL(2, kt_) AT_KL(3, kt_) AT_VL(0, kt_) AT_VL(1, kt_) } while (0)
#define AT_KS(N_) { const int c = tid + N_ * NTHR; if (N_ < KCH && c < 64 * (DK / 8)) { const int r = c / (DK / 8), cc = c % (DK / 8); *(uint4*)(sK + r * KS + cc * 8) = kr##N_; } }
#define AT_VS(N_) { const int c = tid + N_ * NTHR; const int r = c >> 3, cc = c & 7; uint2* d = (uint2*)(sV + r * VS + cc * 8); \
      const uint4 t_ = vr##N_; d[0] = make_uint2(t_.x, t_.y); d[1] = make_uint2(t_.z, t_.w); }
  AT_GLOAD(0);
  for (int kt = 0; kt < nkt; ++kt) {
    __syncthreads();
    AT_KS(0) AT_KS(1) AT_KS(2) AT_KS(3) AT_VS(0) AT_VS(1)
    __syncthreads();
    if (kt + 1 < nkt) AT_GLOAD(kt + 1);
    if (active) {
      f32x16 s0, s1;
#pragma unroll
      for (int i = 0; i < 16; ++i) { s0[i] = 0.f; s1[i] = 0.f; }
#pragma unroll
      for (int ks = 0; ks < DK / 16; ++ks) {
        bf16x8 a0 = *(const bf16x8*)(sK + q * KS + ks * 16 + hh * 8);
        bf16x8 a1 = *(const bf16x8*)(sK + (32 + q) * KS + ks * 16 + hh * 8);
        s0 = __builtin_amdgcn_mfma_f32_32x32x16_bf16(a0, qf[ks], s0, 0, 0, 0);
        s1 = __builtin_amdgcn_mfma_f32_32x32x16_bf16(a1, qf[ks], s1, 0, 0, 0);
      }
      float mx = s0[0];
#pragma unroll
      for (int i = 1; i < 16; ++i) mx = fmaxf(mx, s0[i]);
#pragma unroll
      for (int i = 0; i < 16; ++i) mx = fmaxf(mx, s1[i]);
      mx = fmaxf(mx, __shfl_xor(mx, 32));
      float mn = fmaxf(mrun, mx);
      float alpha = __builtin_amdgcn_exp2f(mrun - mn);
      mrun = mn;
      float ps = 0.f;
#pragma unroll
      for (int i = 0; i < 16; ++i) { s0[i] = __builtin_amdgcn_exp2f(sub_s(s0[i], mn)); ps = add_s(ps, s0[i]); }
#pragma unroll
      for (int i = 0; i < 16; ++i) { s1[i] = __builtin_amdgcn_exp2f(sub_s(s1[i], mn)); ps = add_s(ps, s1[i]); }
      lrun = lrun * alpha + ps;
#pragma unroll
      for (int dt = 0; dt < DV / 32; ++dt)
#pragma unroll
        for (int i = 0; i < 16; ++i) o[dt][i] = mul_s(o[dt][i], alpha);
#pragma unroll
      for (int kb = 0; kb < 2; ++kb)
#pragma unroll
        for (int s = 0; s < 2; ++s) {
          union { bf16x8 v; unsigned u[4]; } pf;
#pragma unroll
          for (int jj = 0; jj < 4; ++jj) {
            float e0 = kb ? s1[8 * s + 2 * jj] : s0[8 * s + 2 * jj];
            float e1 = kb ? s1[8 * s + 2 * jj + 1] : s0[8 * s + 2 * jj + 1];
            pf.u[jj] = pack2(e0, e1);
          }
          const int kbase = kb * 32 + s * 16 + 4 * hh;
#pragma unroll
          for (int dt = 0; dt < DV / 32; ++dt) {
            const u16* vp = sV + (dt * 32 + q) * VS + kbase;
            union { bf16x8 v; uint2 u[2]; } vf;
            vf.u[0] = *(const uint2*)vp; vf.u[1] = *(const uint2*)(vp + 8);
            o[dt] = __builtin_amdgcn_mfma_f32_32x32x16_bf16(vf.v, pf.v, o[dt], 0, 0, 0);
          }
        }
    }
  }
  if (active) {
    lrun += __shfl_xor(lrun, 32);
    float inv = 1.f / lrun;
    u16* op = Ob + (size_t)(row / RPG) * ldo + (size_t)(row % RPG) * DV;
#pragma unroll
    for (int dt = 0; dt < DV / 32; ++dt)
#pragma unroll
      for (int g = 0; g < 4; ++g) {
        uint2 w;
        w.x = pack2(o[dt][4 * g] * inv, o[dt][4 * g + 1] * inv);
        w.y = pack2(o[dt][4 * g + 2] * inv, o[dt][4 * g + 3] * inv);
        *(uint2*)(op + dt * 32 + 8 * g + 4 * hh) = w;
      }
  }
}

#undef AT_GLOAD
#undef AT_KL
#undef AT_VL
#undef AT_KS
#undef AT_VS
__device__ __forceinline__ float dpp_sum16(float x) {
  x += __int_as_float(__builtin_amdgcn_update_dpp(0, __float_as_int(x), 0xB1, 0xF, 0xF, false));
  x += __int_as_float(__builtin_amdgcn_update_dpp(0, __float_as_int(x), 0x4E, 0xF, 0xF, false));
  x += __int_as_float(__builtin_amdgcn_update_dpp(0, __float_as_int(x), 0x141, 0xF, 0xF, false));
  x += __int_as_float(__builtin_amdgcn_update_dpp(0, __float_as_int(x), 0x140, 0xF, 0xF, false));
  return x;
}
__device__ __forceinline__ void scan_item(KPR p, int l, int g0, int h, int half, int nsteps, const float* S0, float* Sout) {
  extern __shared__ __attribute__((aligned(16))) char smem[];
  float* sT = (float*)smem;
  float* sV = sT + 5 * 4096;
  const float* src0 = (const float*)(p.ws + W_RB) + h * 64; const float* src1 = (const float*)(p.ws + W_WB) + h * 64;
  const float* src2 = (const float*)(p.ws + W_KB) + h * 64; const float* src3 = (const float*)(p.ws + W_KKB) + h * 64;
  const float* src4 = (const float*)(p.ws + W_BB) + h * 64;
  const float* VB = (const float*)(p.ws + W_VB) + h * 64 + half * 32;
  float* YB = (float*)(p.ws + W_YB) + h * 64 + half * 32;
  const int tid = tidx();
  const int il = tid >> 4, sub = tid & 15, j0 = sub * 4, i = half * 32 + il;
  float s[4];
#pragma unroll
  for (int j = 0; j < 4; ++j) s[j] = S0 ? S0[i * 64 + j0 + j] : 0.f;
  float4 pa0, pa1, pa2, pa3, pa4, pb0, pb1, pb2, pb3, pb4, pfv;
  const int e0 = tid, e1 = tid + NTHR;
  const int st0 = e0 >> 4, c40 = (e0 & 15) * 4, st1 = e1 >> 4, c41 = (e1 & 15) * 4;
  const int stv = tid >> 3, c4v = (tid & 7) * 4;
#define SC_GL1(x, c0_) pa##x = *(const float4*)(src##x + (size_t)(g0 + (c0_) + st0) * 512 + c40); \
                       pb##x = *(const float4*)(src##x + (size_t)(g0 + (c0_) + st1) * 512 + c41);
#define SC_GLOAD(c0_) do { SC_GL1(0, c0_) SC_GL1(1, c0_) SC_GL1(2, c0_) SC_GL1(3, c0_) SC_GL1(4, c0_) \
    pfv = *(const float4*)(VB + (size_t)(g0 + (c0_) + stv) * 512 + c4v); } while (0)
#define SC_ST1(x) *(float4*)(sT + x * 4096 + st0 * 64 + c40) = pa##x; *(float4*)(sT + x * 4096 + st1 * 64 + c41) = pb##x;
  SC_GLOAD(0);
  for (int c0 = 0; c0 < nsteps; c0 += 64) {
    __syncthreads();
    SC_ST1(0) SC_ST1(1) SC_ST1(2) SC_ST1(3) SC_ST1(4)
    *(float4*)(sV + stv * 32 + c4v) = pfv;
    __syncthreads();
    if (c0 + 64 < nsteps) SC_GLOAD(c0 + 64);
#define SC_LD(S, st_) do { const int _s = (st_) < 64 ? (st_) : 63; \
      S##r = *(const float4*)(sT + _s * 64 + j0); S##w = *(const float4*)(sT + 4096 + _s * 64 + j0); \
      S##k = *(const float4*)(sT + 8192 + _s * 64 + j0); S##q = *(const float4*)(sT + 12288 + _s * 64 + j0); \
      S##b = *(const float4*)(sT + 16384 + _s * 64 + j0); S##v = sV[_s * 32 + il]; } while (0)
#define SC_STEP(S, st_) do { \
      float sa = -dpp_sum16(fma_s(s[1], S##q.y, mul_s(s[0], S##q.x)) + fma_s(s[3], S##q.w, mul_s(s[2], S##q.z))); \
      s[0] = fma_s(sa, S##b.x, fma_s(s[0], S##w.x, mul_s(S##v, S##k.x))); \
      s[1] = fma_s(sa, S##b.y, fma_s(s[1], S##w.y, mul_s(S##v, S##k.y))); \
      s[2] = fma_s(sa, S##b.z, fma_s(s[2], S##w.z, mul_s(S##v, S##k.z))); \
      s[3] = fma_s(sa, S##b.w, fma_s(s[3], S##w.w, mul_s(S##v, S##k.w))); \
      float y = dpp_sum16(fma_s(s[1], S##r.y, mul_s(s[0], S##r.x)) + fma_s(s[3], S##r.w, mul_s(s[2], S##r.z))); \
      ykeep = (sub == ((st_) & 15)) ? y : ykeep; } while (0)
    float4 Ar, Aw, Ak, Aq, Ab, Br, Bw, Bk, Bq, Bb, Cr, Cw, Ck, Cq, Cb, Dr, Dw, Dk, Dq, Db;
    float Av, Bv, Cv, Dv, ykeep = 0.f;
    SC_LD(A, 0); SC_LD(B, 1); SC_LD(C, 2);
    for (int st = 0; st < 64; st += 4) {
      SC_LD(D, st + 3); SC_STEP(A, st);
      SC_LD(A, st + 4); SC_STEP(B, st + 1);
      SC_LD(B, st + 5); SC_STEP(C, st + 2);
      SC_LD(C, st + 6); SC_STEP(D, st + 3);
      if ((st & 15) == 12) YB[(size_t)(g0 + c0 + (st - 12) + sub) * 512 + il] = ykeep;
    }
  }
#undef SC_LD
#undef SC_STEP
#undef SC_GLOAD
#undef SC_GL1
#undef SC_ST1
  *(float4*)(Sout + i * 64 + j0) = make_float4(s[0], s[1], s[2], s[3]);
}

constexpr int LS = 68;
constexpr int LBUF = 64 * LS;
constexpr int LH = 72;

__device__ __forceinline__ void split8(const float* x, bf16x8& hi, bf16x8& lo) {
  union { bf16x8 v; unsigned u[4]; } H, Lo;
#pragma unroll
  for (int j = 0; j < 4; ++j) {
    const unsigned h = pack2(x[2 * j], x[2 * j + 1]);
    H.u[j] = h;
    Lo.u[j] = pack2(x[2 * j] - __uint_as_float(h << 16), x[2 * j + 1] - __uint_as_float(h & 0xffff0000u));
  }
  hi = H.v; lo = Lo.v;
}
template <int AM, int AK, int BKS, int BN, bool SPLIT = true>
__device__ __forceinline__ void mm64(const float* A, const float* B, f32x4 (&acc)[2], int m0, int n0, int lane) {
  const int lr = lane & 15, lq = lane >> 4;
#pragma unroll
  for (int ks = 0; ks < 2; ++ks) {
    const int k0 = ks * 32 + lq * 8;
    float a[8];
    if (AK == 1) {
      float4 x0 = *(const float4*)(A + (m0 + lr) * AM + k0), x1 = *(const float4*)(A + (m0 + lr) * AM + k0 + 4);
      a[0] = x0.x; a[1] = x0.y; a[2] = x0.z; a[3] = x0.w; a[4] = x1.x; a[5] = x1.y; a[6] = x1.z; a[7] = x1.w;
    } else {
#pragma unroll
      for (int j = 0; j < 8; ++j) a[j] = A[(m0 + lr) * AM + (k0 + j) * AK];
    }
    bf16x8 ah, al;
    if (SPLIT) split8(a, ah, al);
    else { union { bf16x8 v; unsigned u[4]; } H; for (int j = 0; j < 4; ++j) H.u[j] = pack2(a[2 * j], a[2 * j + 1]); ah = H.v; al = H.v; }
#pragma unroll
    for (int nt = 0; nt < 2; ++nt) {
      const int n = n0 + nt * 16 + lr;
      float b[8];
      if (BKS == 1) {
        float4 x0 = *(const float4*)(B + n * BN + k0), x1 = *(const float4*)(B + n * BN + k0 + 4);
        b[0] = x0.x; b[1] = x0.y; b[2] = x0.z; b[3] = x0.w; b[4] = x1.x; b[5] = x1.y; b[6] = x1.z; b[7] = x1.w;
      } else {
#pragma unroll
        for (int j = 0; j < 8; ++j) b[j] = B[(k0 + j) * BKS + n * BN];
      }
      if (SPLIT) {
        bf16x8 bh, bl; split8(b, bh, bl);
        acc[nt] = __builtin_amdgcn_mfma_f32_16x16x32_bf16(ah, bh, acc[nt], 0, 0, 0);
        acc[nt] = __builtin_amdgcn_mfma_f32_16x16x32_bf16(ah, bl, acc[nt], 0, 0, 0);
        acc[nt] = __builtin_amdgcn_mfma_f32_16x16x32_bf16(al, bh, acc[nt], 0, 0, 0);
      } else {
        union { bf16x8 v; unsigned u[4]; } Bh;
#pragma unroll
        for (int j = 0; j < 4; ++j) Bh.u[j] = pack2(b[2 * j], b[2 * j + 1]);
        acc[nt] = __builtin_amdgcn_mfma_f32_16x16x32_bf16(ah, Bh.v, acc[nt], 0, 0, 0);
      }
    }
  }
}
#define MM_ZERO(acc) do { acc[0] = f32x4{0.f, 0.f, 0.f, 0.f}; acc[1] = f32x4{0.f, 0.f, 0.f, 0.f}; } while (0)
#define MM_FOREACH(acc, BODY) do { _Pragma("unroll") for (int nt_ = 0; nt_ < 2; ++nt_) _Pragma("unroll") for (int rg_ = 0; rg_ < 4; ++rg_) { \
    const int m = m0 + lq * 4 + rg_, n = n0 + nt_ * 16 + lr; const float val = acc[nt_][rg_]; BODY } } while (0)

#define CPRE_PARAMS float4& c_w0, float4& c_w1, uint2& c_q0, uint2& c_q1, uint2& c_b0, uint2& c_b1, uint2& c_k0, uint2& c_k1, uint2& c_r0, uint2& c_r1, uint2& c_v0, uint2& c_v1
#define CPRE_ARGS(P) P##w0, P##w1, P##q0, P##q1, P##b0, P##b1, P##k0, P##k1, P##r0, P##r1, P##v0, P##v1
__device__ __forceinline__ void cprep_load(KPR p, int grow0, int h, int tid, CPRE_PARAMS) {
  const int t0 = tid >> 4, c4 = (tid & 15) * 4;
  const size_t g0 = (size_t)(grow0 + t0) * 512 + h * 64 + c4, g1 = g0 + (size_t)32 * 512;
  const float* WB = (const float*)(p.ws + W_WB); const u16* KKB = (const u16*)(p.ws + W_KKB); const u16* BB = (const u16*)(p.ws + W_BB);
  const u16* KB = (const u16*)(p.ws + W_KB); const u16* RB = (const u16*)(p.ws + W_RB); const u16* VB = (const u16*)(p.ws + W_VB);
  c_w0 = *(const float4*)(WB + g0); c_w1 = *(const float4*)(WB + g1); c_q0 = *(const uint2*)(KKB + g0); c_q1 = *(const uint2*)(KKB + g1);
  c_b0 = *(const uint2*)(BB + g0); c_b1 = *(const uint2*)(BB + g1); c_k0 = *(const uint2*)(KB + g0); c_k1 = *(const uint2*)(KB + g1);
  c_r0 = *(const uint2*)(RB + g0); c_r1 = *(const uint2*)(RB + g1); c_v0 = *(const uint2*)(VB + g0); c_v1 = *(const uint2*)(VB + g1);
}
__device__ __forceinline__ void cprep_item(KPR p, int grow0, int h, int cid, int ngrow0, int nh, CPRE_PARAMS) {
  extern __shared__ __attribute__((aligned(16))) char smem[];
  float* B0 = (float*)smem; float* B1 = B0 + LBUF; float* B2 = B1 + LBUF; float* B3 = B2 + LBUF;
  float* B4 = B3 + LBUF; float* B5 = B4 + LBUF; float* B6 = B5 + LBUF; float* B7 = B6 + LBUF;
  float* wC = (float*)(smem + 139264);
  const int tid = tidx(), wid = tid >> 6, lane = tid & 63, lr = lane & 15, lq = lane >> 4;
  const int m0 = (wid >> 1) * 16, n0 = (wid & 1) * 32;
  const float* WB = (const float*)(p.ws + W_WB) + h * 64; const float* KKB = (const float*)(p.ws + W_KKB) + h * 64;
  const float* BB = (const float*)(p.ws + W_BB) + h * 64; const float* KB = (const float*)(p.ws + W_KB) + h * 64;
  const float* RB = (const float*)(p.ws + W_RB) + h * 64; const float* VB = (const float*)(p.ws + W_VB) + h * 64;
  f32x4 acc[2];
  __syncthreads();
  {
    const int t0 = tid >> 4, c4 = (tid & 15) * 4, o0 = t0 * LS + c4, o1 = (t0 + 32) * LS + c4;
    *(float4*)(B0 + o0) = c_w0; *(float4*)(B0 + o1) = c_w1;
    { const float4 a0_ = bf4(c_q0), a1_ = bf4(c_q1);
      *(float4*)(B1 + o0) = make_float4(-a0_.x, -a0_.y, -a0_.z, -a0_.w); *(float4*)(B1 + o1) = make_float4(-a1_.x, -a1_.y, -a1_.z, -a1_.w); }
    *(float4*)(B2 + o0) = bf4(c_b0); *(float4*)(B2 + o1) = bf4(c_b1);
    *(float4*)(B3 + o0) = bf4(c_k0); *(float4*)(B3 + o1) = bf4(c_k1);
    *(float4*)(B4 + o0) = bf4(c_r0); *(float4*)(B4 + o1) = bf4(c_r1);
  }
  const uint2 vk0 = c_v0, vk1 = c_v1;
  __syncthreads();
  cprep_load(p, ngrow0, nh, tid, CPRE_ARGS(c_));
  {
    const int j = tid & 63, sg = tid >> 6;
    float wv[8];
#pragma unroll
    for (int u = 0; u < 8; ++u) wv[u] = B0[(sg * 8 + u) * LS + j];
#pragma unroll
    for (int u = 1; u < 8; ++u) wv[u] *= wv[u - 1];
    float* segp = B5;
    segp[sg * 64 + j] = wv[7];
    __syncthreads();
    float pre = 1.f;
    for (int u = 0; u < sg; ++u) pre *= segp[u * 64 + j];
#pragma unroll
    for (int u = 0; u < 8; ++u) B0[(sg * 8 + u) * LS + j] = wv[u] * pre;
    if (sg == 7) wC[j] = wv[7] * pre;
  }
  __syncthreads();
  for (int e = tid; e < 4096; e += NTHR) {
    const int t = e >> 6, j = e & 63, o = t * LS + j;
    const float wt = B0[o], wp = t ? B0[o - LS] : 1.f, iw = 1.f / wt;
    B1[o] *= wp; B2[o] *= iw; B3[o] *= iw; B4[o] *= wt;
  }
  __syncthreads();
  MM_ZERO(acc); mm64<LS, 1, 1, LS>(B2, B1, acc, m0, n0, lane);
  MM_FOREACH(acc, { const float v = m < n ? val : 0.f; B5[m * LS + n] = v; B6[m * LS + n] = v + (m == n ? 1.f : 0.f); });
  __syncthreads();
  MM_ZERO(acc); mm64<LS, 1, LS, 1>(B5, B5, acc, m0, n0, lane);
  MM_FOREACH(acc, { B7[m * LS + n] = val; });
  __syncthreads();
  for (int it = 0; it < 5; ++it) {
    MM_ZERO(acc); mm64<LS, 1, LS, 1>(B6, B7, acc, m0, n0, lane);
    f32x4 acc2[2]; MM_ZERO(acc2);
    if (it < 4) mm64<LS, 1, LS, 1>(B7, B7, acc2, m0, n0, lane);
    __syncthreads();
    MM_FOREACH(acc, { B6[m * LS + n] += val; });
    if (it < 4) MM_FOREACH(acc2, { B7[m * LS + n] = val; });
    __syncthreads();
  }
  MM_ZERO(acc); mm64<1, LS, LS, 1>(B1, B6, acc, m0, n0, lane);
  MM_FOREACH(acc, { B5[m * LS + n] = val; });
  MM_ZERO(acc); mm64<LS, 1, 1, LS>(B3, B1, acc, m0, n0, lane);
  MM_FOREACH(acc, { B0[m * LS + n] = m < n ? val : 0.f; });
  __syncthreads();
  MM_ZERO(acc); mm64<LS, 1, LS, 1>(B0, B6, acc, m0, n0, lane);
  MM_FOREACH(acc, { B7[m * LS + n] = val; });
  __syncthreads();
  MM_ZERO(acc); mm64<LS, 1, 1, LS, false>(B2, B4, acc, m0, n0, lane);
  {
    f32x4 acc2[2]; MM_ZERO(acc2); mm64<LS, 1, 1, LS, false>(B3, B4, acc2, m0, n0, lane);
    __syncthreads();
    MM_FOREACH(acc, { B0[m * LS + n] = m <= n ? val : 0.f; });
    MM_FOREACH(acc2, { B1[m * LS + n] = m <= n ? val : 0.f; });
  }
  __syncthreads();
  {
    u16* RRT = (u16*)(p.ws + W_CRR) + (size_t)cid * 4096;
    MM_ZERO(acc); mm64<1, LS, 1, LS, false>(B0, B5, acc, m0, n0, lane);
    MM_FOREACH(acc, { RRT[m * 64 + n] = f2bf(val + B4[m * LS + n]); });
    MM_ZERO(acc); mm64<LS, 1, LS, 1, false>(B7, B0, acc, m0, n0, lane);
    MM_FOREACH(acc, { B6[m * LS + n] = val + B1[m * LS + n]; });
  }
  __syncthreads();
  for (int e = tid; e < 4096; e += NTHR) {
    const int t = e >> 6, j = e & 63, o = t * LS + j;
    const float wc = wC[j];
    B2[o] *= wc; B3[o] *= wc;
  }
  { const int t0 = tid >> 4, c4 = (tid & 15) * 4; *(float4*)(B4 + t0 * LS + c4) = bf4(vk0); *(float4*)(B4 + (t0 + 32) * LS + c4) = bf4(vk1); }
  __syncthreads();
  {
    u16* YB = (u16*)(p.ws + W_YB) + h * 64;
    MM_ZERO(acc); mm64<1, LS, LS, 1, false>(B6, B4, acc, m0, n0, lane);
    MM_FOREACH(acc, { YB[(size_t)(grow0 + m) * 512 + n] = f2bf(val); });
    u16* PT = (u16*)(p.ws + W_CPT) + (size_t)cid * 4096;
    MM_ZERO(acc); mm64<1, LS, 1, LS, false>(B2, B5, acc, m0, n0, lane);
    MM_FOREACH(acc, { PT[m * 64 + n] = f2bf(val + (m == n ? wC[m] : 0.f)); });
    MM_ZERO(acc); mm64<LS, 1, LS, 1, false>(B7, B2, acc, m0, n0, lane);
    MM_FOREACH(acc, { B0[m * LS + n] = val + B3[m * LS + n]; });
  }
  __syncthreads();
  {
    u16* CQ = (u16*)(p.ws + W_CQ) + (size_t)cid * 4096;
    MM_ZERO(acc); mm64<1, LS, LS, 1, false>(B4, B0, acc, m0, n0, lane);
    MM_FOREACH(acc, { CQ[m * 64 + n] = f2bf(val); });
  }
}

__device__ __forceinline__ void cprep_decode(int id, int& grow0, int& h) {
  if (id < 2048) { grow0 = (id >> 9) * 4096 + (id & 63) * 64; h = (id >> 6) & 7; }
  else { const int k = id - 2048; grow0 = TP + (k >> 3) * 64; h = k & 7; }
}
__device__ __forceinline__ void phase_cprep(KPR p) {
  float4 u_w0, u_w1; uint2 u_k0, u_k1, u_q0, u_q1, u_b0, u_b1, u_r0, u_r1, u_v0, u_v1;
  int id = blockIdx.x, grow0 = 0, h = 0;
  cprep_decode(id < 2304 ? id : 0, grow0, h); cprep_load(p, grow0, h, tidx(), CPRE_ARGS(u_));
  for (; id < 2304; id += gridDim.x) {
    const int nid = id + gridDim.x;
    int ng = 0, nh = 0;
    cprep_decode(nid < 2304 ? nid : id, ng, nh);
    cprep_item(p, grow0, h, id, ng, nh, CPRE_ARGS(u_));
    grow0 = ng; h = nh;
  }
}

__device__ __forceinline__ void cseq_item(KPR p, int g0, int h, int nch, int cid0, const float* S0, float* Sout) {
  extern __shared__ __attribute__((aligned(16))) char smem[];
  float* Sf = (float*)smem;
  float* Qf = Sf + LBUF;
  float* Yf = Qf + LBUF;
  u16* Rb = (u16*)(Yf + LBUF);
  u16* Pb = Rb + 64 * LH;
  const int tid = tidx(), wid = tid >> 6, lane = tid & 63, lr = lane & 15, lq = lane >> 4;
  const int m0 = (wid >> 1) * 16, n0 = (wid & 1) * 32;
  u16* YB = (u16*)(p.ws + W_YB) + h * 64;
  const u16* RRT = (const u16*)(p.ws + W_CRR) + (size_t)cid0 * 4096;
  const u16* PT = (const u16*)(p.ws + W_CPT) + (size_t)cid0 * 4096;
  const u16* CQ = (const u16*)(p.ws + W_CQ) + (size_t)cid0 * 4096;
  __syncthreads();
  for (int e = tid; e < 4096; e += NTHR) { const int i = e >> 6, j = e & 63; Sf[i * LS + j] = S0 ? S0[e] : 0.f; }
  const int hr = tid >> 3, hc = (tid & 7) * 8;
  const int f0t = tid >> 4, f0c = (tid & 15) * 4;
  uint4 pr, pp; uint2 q0, q1, y0, y1;
#define CS_LOAD(c_) do { \
    pr = *(const uint4*)(RRT + (size_t)(c_) * 4096 + hr * 64 + hc); pp = *(const uint4*)(PT + (size_t)(c_) * 4096 + hr * 64 + hc); \
    q0 = *(const uint2*)(CQ + (size_t)(c_) * 4096 + f0t * 64 + f0c); q1 = *(const uint2*)(CQ + (size_t)(c_) * 4096 + (f0t + 32) * 64 + f0c); \
    y0 = *(const uint2*)(YB + (size_t)(g0 + (c_) * 64 + f0t) * 512 + f0c); y1 = *(const uint2*)(YB + (size_t)(g0 + (c_) * 64 + f0t + 32) * 512 + f0c); } while (0)
  CS_LOAD(0);
  for (int c = 0; c < nch; ++c) {
    __syncthreads();
    *(uint4*)(Rb + hr * LH + hc) = pr; *(uint4*)(Pb + hr * LH + hc) = pp;
    *(float4*)(Qf + f0t * LS + f0c) = bf4(q0); *(float4*)(Qf + (f0t + 32) * LS + f0c) = bf4(q1);
    *(float4*)(Yf + f0t * LS + f0c) = bf4(y0); *(float4*)(Yf + (f0t + 32) * LS + f0c) = bf4(y1);
    __syncthreads();
    if (c + 1 < nch) CS_LOAD(c + 1);
    f32x4 ay[2], as[2]; MM_ZERO(ay); MM_ZERO(as);
#pragma unroll
    for (int ks = 0; ks < 2; ++ks) {
      const int k0 = ks * 32 + lq * 8;
      const bf16x8 ra = *(const bf16x8*)(Rb + (m0 + lr) * LH + k0);
      float sa[8];
      { float4 x0 = *(const float4*)(Sf + (m0 + lr) * LS + k0), x1 = *(const float4*)(Sf + (m0 + lr) * LS + k0 + 4);
        sa[0] = x0.x; sa[1] = x0.y; sa[2] = x0.z; sa[3] = x0.w; sa[4] = x1.x; sa[5] = x1.y; sa[6] = x1.z; sa[7] = x1.w; }
      bf16x8 sah, sal; split8(sa, sah, sal);
#pragma unroll
      for (int nt = 0; nt < 2; ++nt) {
        const int n = n0 + nt * 16 + lr;
        float sb[8];
        { float4 x0 = *(const float4*)(Sf + n * LS + k0), x1 = *(const float4*)(Sf + n * LS + k0 + 4);
          sb[0] = x0.x; sb[1] = x0.y; sb[2] = x0.z; sb[3] = x0.w; sb[4] = x1.x; sb[5] = x1.y; sb[6] = x1.z; sb[7] = x1.w; }
        bf16x8 sbh, sbl; split8(sb, sbh, sbl);
        ay[nt] = __builtin_amdgcn_mfma_f32_16x16x32_bf16(ra, sbh, ay[nt], 0, 0, 0);
        ay[nt] = __builtin_amdgcn_mfma_f32_16x16x32_bf16(ra, sbl, ay[nt], 0, 0, 0);
        const bf16x8 pb = *(const bf16x8*)(Pb + n * LH + k0);
        as[nt] = __builtin_amdgcn_mfma_f32_16x16x32_bf16(sah, pb, as[nt], 0, 0, 0);
        as[nt] = __builtin_amdgcn_mfma_f32_16x16x32_bf16(sal, pb, as[nt], 0, 0, 0);
      }
    }
    MM_FOREACH(ay, { YB[(size_t)(g0 + c * 64 + m) * 512 + n] = f2bf(val + Yf[m * LS + n]); });
    __syncthreads();
    MM_FOREACH(as, { Sf[m * LS + n] = val + Qf[m * LS + n]; });
  }
#undef CS_LOAD
  __syncthreads();
  for (int e = tid; e < 4096; e += NTHR) { const int i = e >> 6, j = e & 63; Sout[e] = Sf[i * LS + j]; }
}

__device__ __forceinline__ void phase_yfin(KPR p, int l) {
  const int tid = tidx(), wid = tid >> 6, lane = tid & 63;
  const float* YB = (const float*)(p.ws + W_YB); const float* RB = (const float*)(p.ws + W_RB); const float* KB = (const float*)(p.ws + W_KB);
  const float* VB = (const float*)(p.ws + W_VB); const u16* GB = (const u16*)(p.ws + W_GB); u16* AO = (u16*)(p.ws + W_AO);
  const float* rk = p.in[I_RK] + l * 512; const float* gng = p.in[I_GNG] + l * 512; const float* gnb = p.in[I_GNB] + l * 512;
  for (int g = blockIdx.x * 8 + wid; g < T; g += gridDim.x * 8) {
#pragma unroll 8
    for (int h = 0; h < 8; ++h) {
      size_t i = (size_t)g * 512 + h * 64 + lane;
      float y = bf2f(((const u16*)YB)[i]);
      float mu = wave_sum(y) * (1.f / 64.f);
      float dlt = y - mu;
      float var = wave_sum(dlt * dlt) * (1.f / 64.f);
      float bon = wave_sum(bf2f(((const u16*)RB)[i]) * bf2f(((const u16*)KB)[i]) * rk[h * 64 + lane]);
      float v = dlt * rsqrtf(var + 64e-5f) * gng[h * 64 + lane] + gnb[h * 64 + lane] + bon * bf2f(((const u16*)VB)[i]);
      AO[(size_t)g * 1536 + 1024 + h * 64 + lane] = f2bf(v * bf2f(GB[i]));
    }
  }
}

__device__ __forceinline__ void phase_init(KPR p) {
  const int G = gridDim.x, tid = tidx(), wid = tid >> 6, lane = tid & 63;
  const int gw = blockIdx.x * 8 + wid, nw = G * 8;
  {
    float* X = (float*)(p.ws + W_X); u16* XB = (u16*)(p.ws + W_XB); float* SSQ = (float*)(p.ws + W_SSQ);
    for (int g = gw; g < T; g += nw) {
      const float* src = g < TP ? p.in[I_XP] + (size_t)g * 1024 : p.in[I_XS] + (size_t)(g - TP) * 1024;
      float ss = 0.f;
#pragma unroll
      for (int i = 0; i < 4; ++i) {
        float4 v = *(const float4*)(src + i * 256 + lane * 4);
        *(float4*)(X + (size_t)g * 1024 + i * 256 + lane * 4) = v;
        uint2 w; w.x = pack2(v.x, v.y); w.y = pack2(v.z, v.w);
        *(uint2*)(XB + (size_t)g * 1024 + i * 256 + lane * 4) = w;
        ss += v.x * v.x + v.y * v.y + v.z * v.z + v.w * v.w;
      }
      ss = wave_sum(ss);
      if (lane == 0) *(float4*)(SSQ + (size_t)g * 4) = make_float4(ss, 0.f, 0.f, 0.f);
    }
  }
  {
    u16* MB = (u16*)(p.ws + W_MB);
    for (int g = gw; g < 1024; g += nw) {
      const float* src = p.in[I_MEMP] + (size_t)g * 1024;
      float4 v[4]; float ss = 0.f;
#pragma unroll
      for (int i = 0; i < 4; ++i) { v[i] = *(const float4*)(src + i * 256 + lane * 4); ss += v[i].x * v[i].x + v[i].y * v[i].y + v[i].z * v[i].z + v[i].w * v[i].w; }
      ss = wave_sum(ss);
      float rs = rsqrtf(ss * (1.f / 1024.f) + 1e-6f);
#pragma unroll
      for (int i = 0; i < 4; ++i) {
        uint2 w; w.x = pack2(v[i].x * rs, v[i].y * rs); w.y = pack2(v[i].z * rs, v[i].w * rs);
        *(uint2*)(MB + (size_t)g * 1024 + i * 256 + lane * 4) = w;
      }
    }
  }
  {
    float2* RT = (float2*)(p.ws + W_ROPE);
    for (int e = blockIdx.x * NTHR + tid; e < 4096 * 16; e += G * NTHR) {
      int pos = e >> 4, i = e & 15;
      float inv = powf(10000.f, -(float)i / 16.f);
      float ang = (float)pos * inv;
      float sn, cs; sincosf(ang, &sn, &cs);
      RT[e] = make_float2(cs, sn);
    }
  }
  int rot = 0;
  for (int l = 0; l < NL; ++l) {
    u16* WT = (u16*)(p.ws + W_WT) + (size_t)l * WE_LAYER;
    for (int f = 0; f < 2; ++f) {
      const float* nrm = p.in[f ? I_F2N : I_F1N] + l * 1024;
      const float* wg = p.in[f ? I_F2G : I_F1G] + (size_t)l * 1024 * DFF;
      const float* wu = p.in[f ? I_F2U : I_F1U] + (size_t)l * 1024 * DFF;
      const float* wd = p.in[f ? I_F2D : I_F1D] + (size_t)l * 1024 * DFF;
      tconv(WT + (f ? WE_GU2 : WE_GU1), 1024, 5632, 1024, rot, [=](int k, int n) {
        int j = (n >> 5) * 16 + (n & 15);
        const float* s = ((n >> 4) & 1) ? wu : wg;
        return nrm[k] * s[(size_t)k * DFF + j];
      });
      rot += 88 * 16;
      tconv(WT + (f ? WE_D2 : WE_D1), DFF, 1024, DFF, rot, [=](int k, int n) { return wd[(size_t)k * 1024 + n]; });
      rot += 16 * 44;
    }
    {
      const float* nrm = p.in[I_MIXN] + l * 1024; const float* w = p.in[I_WIN] + (size_t)l * 1024 * DIN;
      tconv(WT + WE_IN, 1024, DINP, 1024, rot, [=](int k, int n) { return n < DIN ? nrm[k] * w[(size_t)k * DIN + n] : 0.f; });
      rot += 36 * 16;
    }
    {
      const float* nrm = p.in[I_QN] + l * 256; const float* wuq = p.in[I_WUQ] + (size_t)l * 256 * 768;
      const float* wuk = p.in[I_WUK] + (size_t)l * 8 * 128 * 64;
      tconv(WT + WE_Q, 256, 1280, 256, rot, [=](int k, int n) {
        float r;
        if (n < 1024) {
          int h = n >> 7, c = n & 127;
          const float* a = wuq + (size_t)k * 768 + h * 96; const float* b = wuk + (size_t)(h * 128 + c) * 64;
          r = 0.f;
          for (int d = 0; d < 64; ++d) r += a[d] * b[d];
        } else {
          int hr = n - 1024;
          r = wuq[(size_t)k * 768 + (hr >> 5) * 96 + 64 + (hr & 31)];
        }
        return r * nrm[k] * QSCALE;
      });
      rot += 20 * 4;
    }
    {
      const float* wup = p.in[I_WUP] + (size_t)l * 64 * 512; const float* aup = p.in[I_AUP] + (size_t)l * 64 * 512;
      const float* gup = p.in[I_GUP] + (size_t)l * 128 * 512;
      tconv(WT + WE_RW, 256, 1536, 256, rot, [=](int k, int n) {
        if (n < 512) return k < 64 ? wup[k * 512 + n] : 0.f;
        if (n < 1024) return (k >= 64 && k < 128) ? aup[(k - 64) * 512 + n - 512] : 0.f;
        return k >= 128 ? gup[(k - 128) * 512 + n - 1024] : 0.f;
      });
      rot += 24 * 4;
    }
    {
      const float* wuv = p.in[I_WUV] + (size_t)l * 8 * 128 * 64; const float* wo = p.in[I_WOUT] + (size_t)l * 1024 * 1024;
      tconv(WT + WE_OUT, 1536, 1024, 1536, rot, [=](int k, int n) {
        if (k < 1024) {
          int h = k >> 7, c = k & 127;
          const float* a = wuv + (size_t)(h * 128 + c) * 64; const float* b = wo + (size_t)(h * 64) * 1024 + n;
          float r = 0.f;
          for (int v = 0; v < 64; ++v) r += a[v] * b[(size_t)v * 1024];
          return r;
        }
        return wo[(size_t)(512 + k - 1024) * 1024 + n];
      });
      rot += 16 * 24;
    }
    {
      const float* nx = p.in[I_XN] + l * 1024; const float* nm = p.in[I_MKVN] + l * 1024;
      const float* wq = p.in[I_WMQ] + (size_t)l * 1048576; const float* wk = p.in[I_WMK] + (size_t)l * 1048576;
      const float* wv = p.in[I_WMV] + (size_t)l * 1048576; const float* wo = p.in[I_WMO] + (size_t)l * 1048576;
      tconv(WT + WE_MQ, 1024, 1024, 1024, rot, [=](int k, int n) { return nx[k] * wq[(size_t)k * 1024 + n] * XSCALE; });
      tconv(WT + WE_MK, 1024, 1024, 1024, rot, [=](int k, int n) { return nm[k] * wk[(size_t)k * 1024 + n]; });
      tconv(WT + WE_MV, 1024, 1024, 1024, rot, [=](int k, int n) { return nm[k] * wv[(size_t)k * 1024 + n]; });
      tconv(WT + WE_MO, 1024, 1024, 1024, rot, [=](int k, int n) { return wo[(size_t)k * 1024 + n]; });
    }
  }
}

__device__ __forceinline__ void phase_prep(KPR p, int l) {
  extern __shared__ __attribute__((aligned(16))) char smem[];
  u16* sv = (u16*)smem;
  const int tid = tidx(), wid = tid >> 6, lane = tid & 63;
  const u16* PROJ = (const u16*)(p.ws + W_PROJ);
  u16* CQB = (u16*)(p.ws + W_CQB); u16* A2 = (u16*)(p.ws + W_A2);
  float* RB = (float*)(p.ws + W_RB); float* KB = (float*)(p.ws + W_KB); float* VB = (float*)(p.ws + W_VB); float* KKB = (float*)(p.ws + W_KKB);
  u16* KP = (u16*)(p.ws + W_KP); u16* KS = (u16*)(p.ws + W_KS); u16* VTP = (u16*)(p.ws + W_VTP); u16* VTS = (u16*)(p.ws + W_VTS);
  const float2* RT = (const float2*)(p.ws + W_ROPE);
  const float* kvn = p.in[I_KVN] + l * 128; const float* mu = p.in[I_MU] + l * DSH; const float* kkw = p.in[I_KK] + l * 512;
  for (int chunk = blockIdx.x; chunk < T / 72; chunk += gridDim.x) {
  __syncthreads();
  uint2 n_cq; unsigned n_ckv; u16 n_k1 = 0, n_k2 = 0; uint4 n_pb0, n_pb1, n_pb2, n_pb3 = make_uint4(0, 0, 0, 0);
  uint4 q_pb0, q_pb1, q_pb2, q_pb3 = make_uint4(0, 0, 0, 0);
#define PREP_LOAD(ROW) do { const u16* pr_ = PROJ + (size_t)(ROW) * DINP; \
    n_cq = *(const uint2*)(pr_ + lane * 4); n_ckv = *(const unsigned*)(pr_ + 256 + lane * 2); \
    if (lane < 16) { n_k1 = pr_[384 + lane]; n_k2 = pr_[400 + lane]; } \
    n_pb0 = *(const uint4*)(pr_ + 416 + lane * 8); n_pb1 = *(const uint4*)(pr_ + 416 + 512 + lane * 8); \
    n_pb2 = *(const uint4*)(pr_ + 416 + 1024 + lane * 8); if (lane < 32) n_pb3 = *(const uint4*)(pr_ + 416 + 1536 + lane * 8); } while (0)
  {
    const int gfirst = chunk * 72 + wid * 9;
    if (gfirst > 0) { PREP_LOAD(gfirst - 1); q_pb0 = n_pb0; q_pb1 = n_pb1; q_pb2 = n_pb2; q_pb3 = n_pb3; }
    else { q_pb0 = q_pb1 = q_pb2 = make_uint4(0, 0, 0, 0); }
    PREP_LOAD(gfirst);
  }
  for (int ri = 0; ri < 9; ++ri) {
    const int rl = wid * 9 + ri, g = chunk * 72 + rl;
    const u16* pr = PROJ + (size_t)g * DINP;
    const uint2 c_cq = n_cq; const unsigned c_ckv = n_ckv; const u16 c_k1 = n_k1, c_k2 = n_k2;
    const uint4 c_pb0 = n_pb0, c_pb1 = n_pb1, c_pb2 = n_pb2, c_pb3 = n_pb3;
    { const int gn = g + 1 < T ? g + 1 : g; PREP_LOAD(gn); }
    const bool isP = g < TP;
    int b, t, pos, tlen;
    if (isP) { b = g >> 12; t = g & 4095; pos = t; tlen = 4096; } else { int gg = g - TP; b = gg >> 6; t = gg & 63; pos = 2048 + t; tlen = 64; }
    {
      uint2 w = c_cq;
      float v0 = bf2f(w.x & 0xffff), v1 = bf2f(w.x >> 16), v2 = bf2f(w.y & 0xffff), v3 = bf2f(w.y >> 16);
      float ss = wave_sum(v0 * v0 + v1 * v1 + v2 * v2 + v3 * v3);
      float rs = rsqrtf(ss * (1.f / 256.f) + 1e-6f);
      uint2 o; o.x = pack2(v0 * rs, v1 * rs); o.y = pack2(v2 * rs, v3 * rs);
      *(uint2*)(CQB + (size_t)g * 256 + lane * 4) = o;
    }
    {
      unsigned w = c_ckv;
      float v0 = bf2f(w & 0xffff), v1 = bf2f(w >> 16);
      float ss = wave_sum(v0 * v0 + v1 * v1);
      float rs = rsqrtf(ss * (1.f / 128.f) + 1e-6f);
      int c = lane * 2;
      v0 = v0 * rs * kvn[c]; v1 = v1 * rs * kvn[c + 1];
      float* of = isP ? p.out + OO_CKVP + ((size_t)(l * 4 + b) * 4096 + t) * 128 : p.out + OO_CKVS + ((size_t)(l * 32 + b) * 64 + t) * 128;
      *(float2*)(of + c) = make_float2(v0, v1);
      u16* kr = isP ? KP + ((size_t)b * 4096 + t) * 160 : KS + ((size_t)b * 2112 + 2048 + t) * 160;
      *(unsigned*)(kr + c) = pack2(v0, v1);
      *(unsigned*)(sv + rl * 128 + c) = pack2(v0, v1);
      if (lane < 16) {
        float x1 = bf2f(c_k1), x2 = bf2f(c_k2);
        float2 cs = RT[pos * 16 + lane];
        float o1 = x1 * cs.x - x2 * cs.y, o2 = x1 * cs.y + x2 * cs.x;
        float* okr = isP ? p.out + OO_KRP + ((size_t)(l * 4 + b) * 4096 + t) * 32 : p.out + OO_KRS + ((size_t)(l * 32 + b) * 64 + t) * 32;
        okr[lane] = o1; okr[lane + 16] = o2;
        kr[128 + lane] = f2bf(o1); kr[144 + lane] = f2bf(o2);
      }
    }
    {
      const u16* pb = pr + 416;
      const u16* pp = pr - DINP + 416;
      const float* sh0 = p.in[I_SSH] + (size_t)(l * 32 + b) * DSH;
      const bool last = (t == tlen - 1);
      float* osh = isP ? p.out + OO_SHP + (size_t)(l * 4 + b) * DSH : p.out + OO_SHS + (size_t)(l * 32 + b) * DSH;
#pragma unroll
      for (int it = 0; it < 4; ++it) {
        const int c = it * 64 + lane;
        if (c < 224) {
          const int e = c * 8;
          const uint4 w = it == 0 ? c_pb0 : (it == 1 ? c_pb1 : (it == 2 ? c_pb2 : c_pb3));
          float pv[8] = {bf2f(w.x & 0xffff), bf2f(w.x >> 16), bf2f(w.y & 0xffff), bf2f(w.y >> 16), bf2f(w.z & 0xffff), bf2f(w.z >> 16), bf2f(w.w & 0xffff), bf2f(w.w >> 16)};
          float pq[8];
          if (t > 0) {
            const uint4 q = it == 0 ? q_pb0 : (it == 1 ? q_pb1 : (it == 2 ? q_pb2 : q_pb3));
            pq[0] = bf2f(q.x & 0xffff); pq[1] = bf2f(q.x >> 16); pq[2] = bf2f(q.y & 0xffff); pq[3] = bf2f(q.y >> 16);
            pq[4] = bf2f(q.z & 0xffff); pq[5] = bf2f(q.z >> 16); pq[6] = bf2f(q.w & 0xffff); pq[7] = bf2f(q.w >> 16);
          } else if (!isP) {
            float4 q0 = *(const float4*)(sh0 + e), q1 = *(const float4*)(sh0 + e + 4);
            pq[0] = q0.x; pq[1] = q0.y; pq[2] = q0.z; pq[3] = q0.w; pq[4] = q1.x; pq[5] = q1.y; pq[6] = q1.z; pq[7] = q1.w;
          } else {
#pragma unroll
            for (int j = 0; j < 8; ++j) pq[j] = 0.f;
          }
          float4 m0 = *(const float4*)(mu + e), m1 = *(const float4*)(mu + e + 4);
          float mm[8] = {m0.x, m0.y, m0.z, m0.w, m1.x, m1.y, m1.z, m1.w};
          float xs[8];
#pragma unroll
          for (int j = 0; j < 8; ++j) xs[j] = pv[j] + mm[j] * (pq[j] - pv[j]);
          if (last) { *(float4*)(osh + e) = make_float4(pv[0], pv[1], pv[2], pv[3]); *(float4*)(osh + e + 4) = make_float4(pv[4], pv[5], pv[6], pv[7]); }
          if (it == 0) {
            *(uint4*)((u16*)RB + (size_t)g * 512 + e) = make_uint4(pack2(xs[0], xs[1]), pack2(xs[2], xs[3]), pack2(xs[4], xs[5]), pack2(xs[6], xs[7]));
          } else if (it == 1) {
            const int cc = e - 512;
            *(uint4*)((u16*)KB + (size_t)g * 512 + cc) = make_uint4(pack2(xs[0], xs[1]), pack2(xs[2], xs[3]), pack2(xs[4], xs[5]), pack2(xs[6], xs[7]));
            float4 k0 = *(const float4*)(kkw + cc), k1 = *(const float4*)(kkw + cc + 4);
            float kk[8] = {xs[0] * k0.x, xs[1] * k0.y, xs[2] * k0.z, xs[3] * k0.w, xs[4] * k1.x, xs[5] * k1.y, xs[6] * k1.z, xs[7] * k1.w};
            float ss = 0.f;
#pragma unroll
            for (int j = 0; j < 8; ++j) ss += kk[j] * kk[j];
            ss = dpp_sum8(ss);
            float rn = rsqrtf(ss + 1e-12f);
            *(uint4*)((u16*)KKB + (size_t)g * 512 + cc) = make_uint4(pack2(kk[0] * rn, kk[1] * rn), pack2(kk[2] * rn, kk[3] * rn), pack2(kk[4] * rn, kk[5] * rn), pack2(kk[6] * rn, kk[7] * rn));
          } else if (it == 2) {
            *(uint4*)((u16*)VB + (size_t)g * 512 + (e - 1024)) = make_uint4(pack2(xs[0], xs[1]), pack2(xs[2], xs[3]), pack2(xs[4], xs[5]), pack2(xs[6], xs[7]));
          } else {
            const int cc = e - 1536;
            float y[8];
#pragma unroll
            for (int j = 0; j < 8; ++j) y[j] = cc < 64 ? (1.f - 2.f / (1.f + __expf(2.f * xs[j]))) : (cc < 128 ? xs[j] : sigmoidf_(xs[j]));
            uint4 o; o.x = pack2(y[0], y[1]); o.y = pack2(y[2], y[3]); o.z = pack2(y[4], y[5]); o.w = pack2(y[6], y[7]);
            *(uint4*)(A2 + (size_t)g * 256 + cc) = o;
          }
        }
      }
    }
    q_pb0 = c_pb0; q_pb1 = c_pb1; q_pb2 = c_pb2; q_pb3 = c_pb3;
  }
#undef PREP_LOAD
  __syncthreads();
  for (int idx = tid; idx < 128 * 9; idx += NTHR) {
    const int d = idx & 127, rl0 = (idx >> 7) * 8, g = chunk * 72 + rl0;
    unsigned w[4];
#pragma unroll
    for (int j = 0; j < 4; ++j) w[j] = (unsigned)sv[(rl0 + 2 * j) * 128 + d] | ((unsigned)sv[(rl0 + 2 * j + 1) * 128 + d] << 16);
    u16* dst;
    if (g < TP) dst = VTP + ((size_t)(g >> 12) * 128 + d) * 4096 + (g & 4095);
    else { const int gg = g - TP; dst = VTS + ((size_t)(gg >> 6) * 128 + d) * 2112 + 2048 + (gg & 63); }
    *(uint4*)dst = make_uint4(w[0], w[1], w[2], w[3]);
  }
  }
}

__device__ __forceinline__ void conv_caches(KPR p, int l, int vb, int nvb) {
  const int tid = tidx();
  u16* KS = (u16*)(p.ws + W_KS); u16* VTS = (u16*)(p.ws + W_VTS);
  {
    const float* cckv = p.in[I_CCKV] + (size_t)l * 32 * 2048 * 128;
    const float* ckr = p.in[I_CKR] + (size_t)l * 32 * 2048 * 32;
    for (int idx = vb * NTHR + tid; idx < 32 * 2048 * 20; idx += nvb * NTHR) {
      int rowi = idx / 20, ch = idx % 20;
      int b = rowi >> 11, t = rowi & 2047;
      const float* s = ch < 16 ? cckv + (size_t)rowi * 128 + ch * 8 : ckr + (size_t)rowi * 32 + (ch - 16) * 8;
      float4 a = *(const float4*)s, c = *(const float4*)(s + 4);
      uint4 o; o.x = pack2(a.x, a.y); o.y = pack2(a.z, a.w); o.z = pack2(c.x, c.y); o.w = pack2(c.z, c.w);
      *(uint4*)(KS + ((size_t)b * 2112 + t) * 160 + ch * 8) = o;
    }
    tconv_v(VTS, 2112, 4096, 2048, vb, nvb, [=](int k, int n) { return cckv[((size_t)(n >> 7) * 2048 + k) * 128 + (n & 127)]; });
    const float* cmk = p.in[I_CMK] + (size_t)l * 32 * 256 * 1024;
    const float* cmv = p.in[I_CMV] + (size_t)l * 32 * 256 * 1024;
    u16* MKS = (u16*)(p.ws + W_MKS); u16* MVTS = (u16*)(p.ws + W_MVTS);
    for (int idx = vb * NTHR + tid; idx < 32 * 4 * 256 * 32; idx += nvb * NTHR) {
      int d8 = idx & 31, m = (idx >> 5) & 255, h = (idx >> 13) & 3, b = idx >> 15;
      const float* s = cmk + ((size_t)(b * 256 + m) * 4 + h) * 256 + d8 * 8;
      float4 a = *(const float4*)s, c = *(const float4*)(s + 4);
      uint4 o; o.x = pack2(a.x, a.y); o.y = pack2(a.z, a.w); o.z = pack2(c.x, c.y); o.w = pack2(c.z, c.w);
      *(uint4*)(MKS + (size_t)idx * 8) = o;
    }
    tconv_v(MVTS, 256, 32768, 256, vb, nvb, [=](int k, int n) { return cmv[((size_t)((n >> 10) * 256 + k) * 4 + ((n >> 8) & 3)) * 256 + (n & 255)]; });
  }
}

__device__ __forceinline__ void mla_sub(KPR p, int b, int c, int half) {
  const u16* QB = (const u16*)(p.ws + W_QB); u16* AO = (u16*)(p.ws + W_AO);
  size_t tok = (size_t)b * 4096 + c * 64 + half * 32;
  attn_item<160, 128, 8>(QB + tok * 1280, 160, 256, (const u16*)(p.ws + W_KP) + (size_t)b * 4096 * 160, 160,
                         (const u16*)(p.ws + W_VTP) + (size_t)b * 128 * 4096, 4096, (c + 1) * 64, AO + tok * 1536, 1536);
}
__device__ __forceinline__ void phase_mix(KPR p, int l, int mode = 0) {
  extern __shared__ __attribute__((aligned(16))) char smem[];
  int* sItem = (int*)(smem + SMEM_ITEM);
  int* cnt = (int*)(p.ws + W_CNT) + l + mode * 8;
  for (;;) {
    __syncthreads();
    if (threadIdx.x == 0) *sItem = atomicAdd(cnt, 1);
    __syncthreads();
    int it = *sItem;
    if (it >= 864) break;
    if (mode == 2 && (it < 32 || it >= 608)) continue;
    if (it < 32) {
      int b = it >> 3, h = it & 7;
      cseq_item(p, b * 4096, h, 64, (b * 8 + h) * 64, nullptr, p.out + OO_WKVP + ((size_t)(l * 4 + b) * 8 + h) * 4096);
    } else if (it < 608) {
      int k = it - 32;
      if (k >= 248 && k < 312) {
        int j = k - 248; int b = j >> 1, half = j & 1;
        const u16* QB = (const u16*)(p.ws + W_QB); u16* AO = (u16*)(p.ws + W_AO);
        size_t tok = (size_t)TP + b * 64 + half * 32;
        attn_item<160, 128, 8>(QB + tok * 1280, 160, 256, (const u16*)(p.ws + W_KS) + (size_t)b * 2112 * 160, 160,
                               (const u16*)(p.ws + W_VTS) + (size_t)b * 128 * 2112, 2112, 2112, AO + tok * 1536, 1536);
      } else {
        if (k >= 312) k -= 64;
        int c = 63 - (k >> 3), b = (k >> 1) & 3, half = k & 1;
        mla_sub(p, b, c, half);
      }
    } else {
      int k = it - 608; int b = k >> 3, h = k & 7;
      cseq_item(p, TP + b * 64, h, 1, 2048 + k, p.in[I_SWKV] + ((size_t)(l * 32 + b) * 8 + h) * 4096,
                p.out + OO_WKVS + ((size_t)(l * 32 + b) * 8 + h) * 4096);
    }
  }
}

__device__ __forceinline__ void xattn_item(KPR p, int l, int it) {
  const u16* QX = (const u16*)(p.ws + W_QX); u16* XO = (u16*)(p.ws + W_XO);
  if (it < 256) {
    int b = it >> 6, h = (it >> 4) & 3, qt = it & 15;
    size_t tok = (size_t)b * 4096 + qt * 256;
    for (int hv = 0; hv < 2; ++hv)
      attn_item<256, 128, 1>(QX + tok * 1024 + h * 256, 1024, 256, (const u16*)(p.ws + W_MKP) + (size_t)((l * 4 + b) * 4 + h) * 65536, 256,
                             (const u16*)(p.ws + W_MVTP) + (size_t)((l * 4 + b) * 4 + h) * 65536 + hv * 128 * 256, 256, 256, XO + tok * 1024 + h * 256 + hv * 128, 1024);
  } else {
    int k = it - 256; int b = k >> 2, h = k & 3;
    size_t tok = (size_t)TP + b * 64;
    for (int hv = 0; hv < 2; ++hv)
      attn_item<256, 128, 1>(QX + tok * 1024 + h * 256, 1024, 64, (const u16*)(p.ws + W_MKS) + (size_t)(b * 4 + h) * 65536, 256,
                             (const u16*)(p.ws + W_MVTS) + (size_t)(b * 4 + h) * 65536 + hv * 128 * 256, 256, 256, XO + tok * 1024 + h * 256 + hv * 128, 1024);
  }
}

constexpr int CH_NST = 10;
__device__ __forceinline__ void phase_chain(KPR p, int ci, int dup = 0) {
  extern __shared__ __attribute__((aligned(16))) char smem[];
  int* sItem = (int*)(smem + SMEM_ITEM);
  int* CT = (int*)(p.ws + W_CNT) + dup * 8192;
  const float rc = dup ? 0.f : 1.f;
  int* q = CT + 3800 + ci; int* xa = CT + 72 + ci; int* oa = CT + 80 + ci;
  int* cnt = CT + 128 + ci * CH_NST * 72;
  int* stamp = CT + 4096 + ci * CH_NST * 72;
  int* G = CT + 8000 + ci; int* xast = CT + 8010 + ci; int* oast = CT + 8020 + ci;
  int lastG = 0;
  const bool hasTail = ci >= 1, hasHead = ci < NL;
  const int lt = ci - 1, lh = ci;
  const int e0 = hasTail ? 288 : 0, e1 = e0 + (hasTail ? 288 : 0), e2 = e1 + (hasTail ? 384 : 0), e3 = e2 + (hasTail ? 288 : 0),
            e4 = e3 + (hasTail ? 792 : 0), e5 = e4 + (hasTail ? 288 : 0), e6 = e5 + (hasHead ? 792 : 0), e7 = e6 + (hasHead ? 288 : 0),
            e8 = e7 + (hasHead ? 224 : 0), e9 = e8 + (hasHead ? 648 : 0);
  float* X = (float*)(p.ws + W_X); u16* XB = (u16*)(p.ws + W_XB); float* SSQ = (float*)(p.ws + W_SSQ); u16* ACT = (u16*)(p.ws + W_ACT);
  const int grp = blockIdx.x & 7;
  int nxt = 0;
  if (tidx() == 0) nxt = atomicAdd(q + grp * 8, 1) * 8 + grp;
  for (;;) {
    const int tid = tidx();
    if (tid == 0) {
      const int it = nxt;
      if (it < e9) {
        int st, idx;
        if (it < e0) { st = 0; idx = it; } else if (it < e1) { st = 1; idx = it - e0; } else if (it < e2) { st = 2; idx = it - e1; }
        else if (it < e3) { st = 3; idx = it - e2; } else if (it < e4) { st = 4; idx = it - e3; } else if (it < e5) { st = 5; idx = it - e4; }
        else if (it < e6) { st = 6; idx = it - e5; } else if (it < e7) { st = 7; idx = it - e6; } else if (it < e8) { st = 8; idx = it - e7; }
        else { st = 9; idx = it - e8; }
        int pm = 0, pn = 0;
        if (st == 2) pm = idx < 256 ? ((idx >> 6) * 16 + (idx & 15)) : (64 + ((idx - 256) >> 4));
        else if (st != 8) tile_map(idx, 72, (st == 4 || st == 6) ? 11 : (st == 9 ? 9 : 4), pm, pn);
        const int* c1 = nullptr; const int* c2 = nullptr;
        switch (st) {
          case 1: c1 = stamp + 0 * 72 + pm; break;
          case 2: c1 = stamp + 1 * 72 + pm; break;
          case 3: c1 = stamp + 2 * 72 + pm; break;
          case 4: c1 = stamp + 3 * 72 + pm; c2 = xast; break;
          case 5: c1 = stamp + 4 * 72 + pm; break;
          case 6: if (hasTail) c1 = stamp + 5 * 72 + pm; break;
          case 7: c1 = stamp + 6 * 72 + pm; break;
          case 8: if (hasTail) c1 = xast; break;
          case 9: c1 = stamp + 7 * 72 + pm; if (hasTail) c2 = oast; break;
          default: break;
        }
        if (dup) { c1 = nullptr; c2 = nullptr; }
        int s1 = 0, s2 = 0;
        if (c1) while ((s1 = __hip_atomic_load(c1, __ATOMIC_RELAXED, __HIP_MEMORY_SCOPE_AGENT)) == 0) __builtin_amdgcn_s_sleep(4);
        if (c2) while ((s2 = __hip_atomic_load(c2, __ATOMIC_RELAXED, __HIP_MEMORY_SCOPE_AGENT)) == 0) __builtin_amdgcn_s_sleep(4);
        if ((s1 > s2 ? s1 : s2) >= lastG) {
          const int g = __hip_atomic_load(G, __ATOMIC_RELAXED, __HIP_MEMORY_SCOPE_AGENT);
          __builtin_amdgcn_fence(__ATOMIC_ACQUIRE, "agent");
          asm volatile("s_waitcnt vmcnt(0)" ::: "memory");
          lastG = g;
        }
        sItem[1] = st; sItem[2] = idx; sItem[3] = pm; sItem[4] = pn;
      }
      sItem[0] = it;
    }
    __syncthreads();
    if (sItem[0] >= e9) break;
    const int st = sItem[1], idx = sItem[2], pm = sItem[3], pn = sItem[4];
    if (tid == 0) nxt = atomicAdd(q + grp * 8, 1) * 8 + grp;
    if (dup && !((PROBE_MASK >> st) & 1)) { __syncthreads(); continue; }
    const u16* WTt = (const u16*)(p.ws + W_WT) + (size_t)(lt < 0 ? 0 : lt) * WE_LAYER;
    const u16* WTh = (const u16*)(p.ws + W_WT) + (size_t)(lh >= NL ? 0 : lh) * WE_LAYER;
    switch (st) {
      case 0: gemm_tile((const u16*)(p.ws + W_AO), WTt + WE_OUT, 1536, pm, pn, EpiRes{X, XB, SSQ, rc}); break;
      case 1: gemm_tile(XB, WTt + WE_MQ, 1024, pm, pn, EpiScaleBf{SSQ, (u16*)(p.ws + W_QX), 1024}); break;
      case 2: xattn_item(p, lt, idx); break;
      case 3: gemm_tile((const u16*)(p.ws + W_XO), WTt + WE_MO, 1024, pm, pn, EpiRes{X, XB, SSQ, rc}); break;
      case 4: gemm_tile(XB, WTt + WE_GU2, 1024, pm, 2 * pn, EpiGU{SSQ, ACT}); gemm_tile(XB, WTt + WE_GU2, 1024, pm, 2 * pn + 1, EpiGU{SSQ, ACT}); break;
      case 5: gemm_tile(ACT, WTt + WE_D2, DFF, pm, pn, EpiRes{X, XB, SSQ, 0.5f * rc}); break;
      case 6: gemm_tile(XB, WTh + WE_GU1, 1024, pm, 2 * pn, EpiGU{SSQ, ACT}); gemm_tile(XB, WTh + WE_GU1, 1024, pm, 2 * pn + 1, EpiGU{SSQ, ACT}); break;
      case 7: gemm_tile(ACT, WTh + WE_D1, DFF, pm, pn, EpiRes{X, XB, SSQ, 0.5f * rc}); break;
      case 8: conv_caches(p, lh, idx, 224); break;
      default: gemm_tile(XB, WTh + WE_IN, 1024, pm, pn, EpiScaleBf{SSQ, (u16*)(p.ws + W_PROJ), DINP}); break;
    }
    asm volatile("s_waitcnt vmcnt(0)" ::: "memory");
    __syncthreads();
    if (tidx() == 64) {
      __builtin_amdgcn_fence(__ATOMIC_RELEASE, "agent");
      asm volatile("s_waitcnt vmcnt(0)" ::: "memory");
      atomicAdd(G, 1);
      const int full = (st == 4 || st == 6) ? 11 : (st == 9 ? 9 : (st == 2 ? (pm < 64 ? 4 : 16) : 4));
      if (atomicAdd(cnt + st * 72 + pm, 1) + 1 == full)
        __hip_atomic_store(stamp + st * 72 + pm, __hip_atomic_load(G, __ATOMIC_RELAXED, __HIP_MEMORY_SCOPE_AGENT), __ATOMIC_RELAXED, __HIP_MEMORY_SCOPE_AGENT);
      if (st == 2 && atomicAdd(xa, 1) + 1 == 384)
        __hip_atomic_store(xast, __hip_atomic_load(G, __ATOMIC_RELAXED, __HIP_MEMORY_SCOPE_AGENT), __ATOMIC_RELAXED, __HIP_MEMORY_SCOPE_AGENT);
      if (st == 0 && atomicAdd(oa, 1) + 1 == 288)
        __hip_atomic_store(oast, __hip_atomic_load(G, __ATOMIC_RELAXED, __HIP_MEMORY_SCOPE_AGENT), __ATOMIC_RELAXED, __HIP_MEMORY_SCOPE_AGENT);
    }
  }
}

__device__ __forceinline__ void phase_final(KPR p) {
  const int tid = tidx(), wid = tid >> 6, lane = tid & 63;
  const float* X = (const float*)(p.ws + W_X); const float* fn = p.in[I_FN];
  for (int g = blockIdx.x * 8 + wid; g < T; g += gridDim.x * 8) {
    float4 v[4]; float ss = 0.f;
#pragma unroll
    for (int i = 0; i < 4; ++i) { v[i] = *(const float4*)(X + (size_t)g * 1024 + i * 256 + lane * 4); ss += v[i].x * v[i].x + v[i].y * v[i].y + v[i].z * v[i].z + v[i].w * v[i].w; }
    ss = wave_sum(ss);
    float rs = rsqrtf(ss * (1.f / 1024.f) + 1e-6f);
#pragma unroll
    for (int i = 0; i < 4; ++i) {
      float4 gn = *(const float4*)(fn + i * 256 + lane * 4);
      *(float4*)(p.out + OO_Y + (size_t)g * 1024 + i * 256 + lane * 4) = make_float4(v[i].x * rs * gn.x, v[i].y * rs * gn.y, v[i].z * rs * gn.z, v[i].w * rs * gn.w);
    }
  }
}

constexpr int NPL = 6;
constexpr int N_PHASES = 3 + NPL * NL + 1;

__device__ __forceinline__ void run_phase(KPR p, int ph) {
  if (ph == 0) { phase_init(p); return; }
  if (ph == 1) {
    for (int l = 0; l < NL; ++l) {
      const u16* WT = (const u16*)(p.ws + W_WT) + (size_t)l * WE_LAYER;
      gemm_phase((const u16*)(p.ws + W_MB), WT + WE_MK, 1024, 4, 4, (2 * l) * 16,
                 EpiMem<false>{p.out + OO_MKP + (size_t)l * 1048576, (u16*)(p.ws + W_MKP) + (size_t)l * 16 * 65536});
      gemm_phase((const u16*)(p.ws + W_MB), WT + WE_MV, 1024, 4, 4, (2 * l + 1) * 16,
                 EpiMem<true>{p.out + OO_MVP + (size_t)l * 1048576, (u16*)(p.ws + W_MVTP) + (size_t)l * 16 * 65536});
    }
    return;
  }
  if (ph == 2) { phase_chain(p, 0); if (PROBE_REP & 1) { cg::this_grid().sync(); phase_chain(p, 0, 1); } return; }
  if (ph == N_PHASES - 1) { if (PROBE_REP & 64) for (int i = 0; i < 40; ++i) cg::this_grid().sync(); phase_final(p); return; }
  const int l = (ph - 3) / NPL, s = (ph - 3) % NPL;
  const u16* WT = (const u16*)(p.ws + W_WT) + (size_t)l * WE_LAYER;
  switch (s) {
    case 0: phase_prep(p, l); if (PROBE_REP & 2) { cg::this_grid().sync(); phase_prep(p, l); } break;
    case 1:
      gemm_phase((const u16*)(p.ws + W_CQB), WT + WE_Q, 256, 72, 5, 0, EpiQ{(u16*)(p.ws + W_QB), (const float2*)(p.ws + W_ROPE)});
      gemm_phase((const u16*)(p.ws + W_A2), WT + WE_RW, 256, 72, 6, 360,
                 EpiRW{p.in[I_W0] + l * 512, p.in[I_A0] + l * 512, p.in[I_KA] + l * 512, p.ws});
      break;
    case 2: phase_cprep(p); if (PROBE_REP & 8) { cg::this_grid().sync(); phase_cprep(p); } break;
    case 3: phase_mix(p, l, 0); if (PROBE_REP & 16) { cg::this_grid().sync(); phase_mix(p, l, 2); } break;
    case 4: phase_yfin(p, l); if (PROBE_REP & 32) { cg::this_grid().sync(); phase_yfin(p, l); } break;
    default: phase_chain(p, l + 1); if (PROBE_REP & 1) { cg::this_grid().sync(); phase_chain(p, l + 1, 1); } break;
  }
}

__device__ __forceinline__ void grid_barrier(int* CT, int gen) {
  asm volatile("s_waitcnt vmcnt(0)" ::: "memory");
  __syncthreads();
  if (tidx() == 0) {
    __builtin_amdgcn_fence(__ATOMIC_RELEASE, "agent");
    asm volatile("s_waitcnt vmcnt(0)" ::: "memory");
    int* grpc = CT + 15000 + (blockIdx.x & 7) * 32;
    int* glob = CT + 15000 + 8 * 32;
    const int per = gridDim.x >> 3;
    if (atomicAdd(grpc, 1) + 1 == per * (gen + 1)) atomicAdd(glob, 1);
    while (__hip_atomic_load(glob, __ATOMIC_RELAXED, __HIP_MEMORY_SCOPE_AGENT) < 8 * (gen + 1)) __builtin_amdgcn_s_sleep(1);
    __builtin_amdgcn_fence(__ATOMIC_ACQUIRE, "agent");
    asm volatile("s_waitcnt vmcnt(0)" ::: "memory");
  }
  __syncthreads();
}

__global__ void __launch_bounds__(NTHR) mega(Params p) {
  cg::grid_group grid = cg::this_grid();
  for (int ph = p.ph_lo; ph < p.ph_hi; ++ph) {
    const __attribute__((address_space(4))) Params* q = (const __attribute__((address_space(4))) Params*)__builtin_amdgcn_kernarg_segment_ptr();
    asm volatile("" : "+s"(q));
    run_phase(*q, ph);
    if (ph + 1 < p.ph_hi) {
      if (ph == p.ph_lo) grid.sync();
      else grid_barrier((int*)(q->ws + W_CNT), ph - p.ph_lo - 1);
    }
  }
}

extern "C" void kernel_launch(void* const* d_in, const int* in_sizes, int n_in, void* d_out, int out_size, void* d_ws,
                              size_t ws_size, hipStream_t stream) {
  static int grid = 0;
  if (grid == 0) {
    if (n_in != N_IN || (size_t)out_size != OO_END || ws_size < W_END) {
      fprintf(stderr, "kernel_launch: unexpected shapes n_in=%d out=%d ws=%zu (need %zu)\n", n_in, out_size, ws_size, (size_t)W_END);
      grid = -1; return;
    }
    int dev = 0, cus = 0, per_cu = 0;
    hipGetDevice(&dev);
    hipDeviceGetAttribute(&cus, hipDeviceAttributeMultiprocessorCount, dev);
    hipFuncSetAttribute((const void*)mega, hipFuncAttributeMaxDynamicSharedMemorySize, SMEM_BYTES);
    hipOccupancyMaxActiveBlocksPerMultiprocessor(&per_cu, (const void*)mega, NTHR, SMEM_BYTES);
    if (per_cu < 1) { fprintf(stderr, "kernel_launch: occupancy query says %d blocks/CU\n", per_cu); per_cu = 1; }
    (void)hipGetLastError();
    grid = cus;
  }
  if (grid < 0) return;
  if (hipMemsetAsync((char*)d_ws + W_CNT, 0, 65536, stream) != hipSuccess) { fprintf(stderr, "kernel_launch: memset of control words failed\n"); return; }
  Params p{};
  for (int i = 0; i < N_IN; ++i) p.in[i] = (const float*)d_in[i];
  p.out = (float*)d_out; p.ws = (char*)d_ws;
#if N_LAUNCH_PER_PHASE
  for (int ph = 0; ph < N_PHASES; ++ph) {
    p.ph_lo = ph; p.ph_hi = ph + 1;
    void* args[] = {&p};
    hipError_t e = hipLaunchCooperativeKernel((const void*)mega, dim3(grid), dim3(NTHR), args, SMEM_BYTES, stream);
    if (e != hipSuccess) { fprintf(stderr, "launch failed: %s\n", hipGetErrorString(e)); break; }
  }
#else
  p.ph_lo = 0; p.ph_hi = N_PHASES;
  void* args[] = {&p};
  hipError_t e = hipLaunchCooperativeKernel((const void*)mega, dim3(grid), dim3(NTHR), args, SMEM_BYTES, stream);
  if (e != hipSuccess) fprintf(stderr, "cooperative launch failed: %s (grid %d)\n", hipGetErrorString(e), grid);
#endif
}
```

```cpp
#include <hip/hip_runtime.h>
#include <hip/hip_cooperative_groups.h>
#include <stdint.h>
#include <stdio.h>
namespace cg = cooperative_groups;

typedef unsigned short u16;
using bf16x8 = __attribute__((ext_vector_type(8))) short;
using f32x4 = __attribute__((ext_vector_type(4))) float;
using f32x16 = __attribute__((ext_vector_type(16))) float;

#ifndef REP_WHICH
#define REP_WHICH 0
#endif
#ifndef PROBE_REP
#define PROBE_REP 0
#endif
#ifndef PROBE_MASK
#define PROBE_MASK 0x3ff
#endif
#ifndef N_LAUNCH_PER_PHASE
#define N_LAUNCH_PER_PHASE 0
#endif

constexpr int TP = 16384, TS = 2048, T = TP + TS, NL = 4;
constexpr int DFF = 2816, DIN = 2208, DINP = 2304, DSH = 1792;
constexpr int NTHR = 512;
constexpr int SMEM_BYTES = 139264 + 2048;
constexpr int SMEM_ITEM = 139264 + 1024;
constexpr float QSCALE = 0.10206207261596577f * 1.4426950408889634f;
constexpr float XSCALE = 0.0625f * 1.4426950408889634f;

constexpr size_t OO_Y = 0;
constexpr size_t OO_CKVP = OO_Y + (size_t)T * 1024;
constexpr size_t OO_KRP = OO_CKVP + (size_t)NL * 4 * 4096 * 128;
constexpr size_t OO_MKP = OO_KRP + (size_t)NL * 4 * 4096 * 32;
constexpr size_t OO_MVP = OO_MKP + (size_t)NL * 4 * 256 * 1024;
constexpr size_t OO_WKVP = OO_MVP + (size_t)NL * 4 * 256 * 1024;
constexpr size_t OO_SHP = OO_WKVP + (size_t)NL * 4 * 8 * 4096;
constexpr size_t OO_CKVS = OO_SHP + (size_t)NL * 4 * DSH;
constexpr size_t OO_KRS = OO_CKVS + (size_t)NL * 32 * 64 * 128;
constexpr size_t OO_WKVS = OO_KRS + (size_t)NL * 32 * 64 * 32;
constexpr size_t OO_SHS = OO_WKVS + (size_t)NL * 32 * 8 * 4096;
constexpr size_t OO_END = OO_SHS + (size_t)NL * 32 * DSH;

constexpr size_t al256(size_t x) { return (x + 255) & ~(size_t)255; }
constexpr size_t W_X = 0;
constexpr size_t W_XB = W_X + al256((size_t)T * 1024 * 4);
constexpr size_t W_SSQ = W_XB + al256((size_t)T * 1024 * 2);
constexpr size_t W_ACT = W_SSQ + al256((size_t)T * 4 * 4);
constexpr size_t W_WB = W_ACT;
constexpr size_t W_BB = W_WB + al256((size_t)T * 512 * 4);
constexpr size_t W_GB = W_BB + al256((size_t)T * 512 * 4);
constexpr size_t W_QX = W_ACT;
constexpr size_t W_PROJ = W_ACT + al256((size_t)T * DFF * 2);
constexpr size_t W_AO = W_PROJ;
constexpr size_t W_CQB = W_PROJ + al256((size_t)T * DINP * 2);
constexpr size_t W_A2 = W_CQB + al256((size_t)T * 256 * 2);
constexpr size_t W_QB = W_A2 + al256((size_t)T * 256 * 2);
constexpr size_t W_XO = W_QB;
constexpr size_t W_RB = W_QB + al256((size_t)T * 1280 * 2);
constexpr size_t W_KB = W_RB + al256((size_t)T * 512 * 4);
constexpr size_t W_VB = W_KB + al256((size_t)T * 512 * 4);
constexpr size_t W_KKB = W_VB + al256((size_t)T * 512 * 4);
constexpr size_t W_KP = W_KKB + al256((size_t)T * 512 * 4);
constexpr size_t W_KS = W_KP + al256((size_t)4 * 4096 * 160 * 2);
constexpr size_t W_VTP = W_KS + al256((size_t)32 * 2112 * 160 * 2);
constexpr size_t W_VTS = W_VTP + al256((size_t)4 * 128 * 4096 * 2);
constexpr size_t W_MKP = W_VTS + al256((size_t)32 * 128 * 2112 * 2);
constexpr size_t W_MVTP = W_MKP + al256((size_t)NL * 16 * 65536 * 2);
constexpr size_t W_MKS = W_MVTP + al256((size_t)NL * 16 * 65536 * 2);
constexpr size_t W_MVTS = W_MKS + al256((size_t)128 * 65536 * 2);
constexpr size_t W_MB = W_MVTS + al256((size_t)128 * 65536 * 2);
constexpr size_t W_ROPE = W_MB + al256((size_t)1024 * 1024 * 2);
constexpr size_t W_CNT = W_ROPE + al256((size_t)4096 * 16 * 8);
constexpr size_t W_YB = W_CNT + 65536;
constexpr size_t W_CQ = W_YB + al256((size_t)T * 512 * 4);
constexpr size_t W_WT = W_CQ + al256((size_t)2304 * 4096 * 4);
constexpr size_t W_CRR = W_PROJ + al256((size_t)T * 1536 * 2);
constexpr size_t W_CPT = W_CQB;
static_assert(W_CRR + (size_t)2304 * 4096 * 2 <= W_CQB, "RRt must fit behind AO");
static_assert((size_t)2304 * 4096 * 2 <= 2 * al256((size_t)T * 256 * 2), "Pt must fit in CQB+A2");
constexpr size_t WE_GU1 = 0;
constexpr size_t WE_D1 = WE_GU1 + (size_t)5632 * 1024;
constexpr size_t WE_IN = WE_D1 + (size_t)1024 * DFF;
constexpr size_t WE_Q = WE_IN + (size_t)DINP * 1024;
constexpr size_t WE_RW = WE_Q + (size_t)1280 * 256;
constexpr size_t WE_OUT = WE_RW + (size_t)1536 * 256;
constexpr size_t WE_MQ = WE_OUT + (size_t)1024 * 1536;
constexpr size_t WE_MK = WE_MQ + (size_t)1024 * 1024;
constexpr size_t WE_MV = WE_MK + (size_t)1024 * 1024;
constexpr size_t WE_MO = WE_MV + (size_t)1024 * 1024;
constexpr size_t WE_GU2 = WE_MO + (size_t)1024 * 1024;
constexpr size_t WE_D2 = WE_GU2 + (size_t)5632 * 1024;
constexpr size_t WE_LAYER = WE_D2 + (size_t)1024 * DFF;
constexpr size_t W_END = W_WT + al256(WE_LAYER * NL * 2);

enum { I_XP = 0, I_XS, I_MEMP, I_CCKV, I_CKR, I_CMK, I_CMV, I_SWKV, I_SSH, I_F1N, I_F1G, I_F1U, I_F1D, I_MIXN, I_WIN,
       I_QN, I_WUQ, I_KVN, I_WUK, I_WUV, I_MU, I_W0, I_WUP, I_A0, I_AUP, I_GUP, I_KK, I_KA, I_RK, I_GNG, I_GNB, I_WOUT,
       I_XN, I_MKVN, I_WMQ, I_WMK, I_WMV, I_WMO, I_F2N, I_F2G, I_F2U, I_F2D, I_FN, N_IN };

struct Params {
  const float* in[N_IN];
  float* out;
  char* ws;
  int ph_lo, ph_hi;
};

typedef const __attribute__((address_space(4))) Params& KPR;

typedef __bf16 bf2_t __attribute__((ext_vector_type(2)));
typedef float f2_t __attribute__((ext_vector_type(2)));
__device__ __forceinline__ u16 f2bf(float f) { __bf16 b = (__bf16)f; return __builtin_bit_cast(u16, b); }
__device__ __forceinline__ float bf2f(u16 h) { return __uint_as_float(((unsigned)h) << 16); }
__device__ __forceinline__ unsigned pack2(float a, float b) { f2_t v = {a, b}; bf2_t r = __builtin_convertvector(v, bf2_t); return __builtin_bit_cast(unsigned, r); }
__device__ __forceinline__ float4 bf4(uint2 w) {
  return make_float4(__uint_as_float(w.x << 16), __uint_as_float(w.x & 0xffff0000u), __uint_as_float(w.y << 16), __uint_as_float(w.y & 0xffff0000u));
}
__device__ __forceinline__ float wave_sum(float x) {
  x += __int_as_float(__builtin_amdgcn_update_dpp(0, __float_as_int(x), 0xB1, 0xF, 0xF, false));
  x += __int_as_float(__builtin_amdgcn_update_dpp(0, __float_as_int(x), 0x4E, 0xF, 0xF, false));
  x += __int_as_float(__builtin_amdgcn_update_dpp(0, __float_as_int(x), 0x141, 0xF, 0xF, false));
  x += __int_as_float(__builtin_amdgcn_update_dpp(0, __float_as_int(x), 0x140, 0xF, 0xF, false));
  const float s0 = __int_as_float(__builtin_amdgcn_readlane(__float_as_int(x), 0)), s1 = __int_as_float(__builtin_amdgcn_readlane(__float_as_int(x), 16));
  const float s2 = __int_as_float(__builtin_amdgcn_readlane(__float_as_int(x), 32)), s3 = __int_as_float(__builtin_amdgcn_readlane(__float_as_int(x), 48));
  return (s0 + s1) + (s2 + s3);
}
__device__ __forceinline__ float dpp_sum8(float x) {
  x += __int_as_float(__builtin_amdgcn_update_dpp(0, __float_as_int(x), 0xB1, 0xF, 0xF, false));
  x += __int_as_float(__builtin_amdgcn_update_dpp(0, __float_as_int(x), 0x4E, 0xF, 0xF, false));
  x += __int_as_float(__builtin_amdgcn_update_dpp(0, __float_as_int(x), 0x141, 0xF, 0xF, false));
  return x;
}
__device__ __forceinline__ int tidx() { int t = threadIdx.x; asm volatile("" : "+v"(t)); return t; }
__device__ __forceinline__ float fma_s(float a, float b, float c) { float d; asm("v_fma_f32 %0, %1, %2, %3" : "=v"(d) : "v"(a), "v"(b), "v"(c)); return d; }
__device__ __forceinline__ float sub_s(float a, float b) { float d; asm("v_sub_f32 %0, %1, %2" : "=v"(d) : "v"(a), "v"(b)); return d; }
__device__ __forceinline__ float add_s(float a, float b) { float d; asm("v_add_f32 %0, %1, %2" : "=v"(d) : "v"(a), "v"(b)); return d; }
__device__ __forceinline__ float mul_s(float a, float b) { float d; asm("v_mul_f32 %0, %1, %2" : "=v"(d) : "v"(a), "v"(b)); return d; }
__device__ __forceinline__ float sigmoidf_(float x) { return 1.f / (1.f + __expf(-x)); }

constexpr int BM = 256, BK = 64, HALF = 128, HT = HALF * BK;

__device__ __forceinline__ int lds_byte(int r, int c) {
  int st = (r >> 4) * 2 + (c >> 5), rr = r & 15, cc = c & 31, ob = rr * 64 + cc * 2;
  return st * 1024 + (ob ^ (((ob >> 9) & 1) << 5));
}
__device__ __forceinline__ void stage_rc(int b, int& R, int& C) {
  int st = b / 1024, sb = b % 1024, swz = sb ^ (((sb >> 9) & 1) << 5);
  R = (st >> 1) * 16 + swz / 64; C = (st & 1) * 32 + (swz % 64) / 2;
}

__device__ __forceinline__ void tile_map(int tile, int nM, int nN, int& pm, int& pn) {
  const int ntiles = nM * nN;
  int wgid = tile;
  { int q = ntiles / 8, r = ntiles % 8, xcd = wgid % 8, off = wgid / 8;
    wgid = (xcd < r ? xcd * (q + 1) : r * (q + 1) + (xcd - r) * q) + off; }
  int nig = 8 * nN, gid = wgid / nig, fm = gid * 8, gsz = min(nM - fm, 8);
  pm = fm + ((wgid % nig) % gsz); pn = (wgid % nig) / gsz;
}

template <class Epi>
__device__ __forceinline__ void gemm_tile(const u16* __restrict__ A, const u16* __restrict__ Bt, const int K,
                                          const int pm, const int pn, Epi epi) {
  extern __shared__ __attribute__((aligned(16))) char smem[];
  u16* shm = (u16*)smem;
#define SA(b, h) (shm + ((b) * 2 + (h)) * HT)
#define SB(b, h) (shm + (4 + (b) * 2 + (h)) * HT)
#define STAGE(P, BASE, br, kt) do { const u16* _gb = BASE + ((long)(br) * K + (long)(kt) * BK); \
    __builtin_amdgcn_global_load_lds((const unsigned*)((const char*)_gb + so0), \
        (__attribute__((address_space(3))) unsigned*)((char*)(P) + wu16), 16, 0, 0); \
    __builtin_amdgcn_global_load_lds((const unsigned*)((const char*)_gb + so1), \
        (__attribute__((address_space(3))) unsigned*)((char*)(P) + wu16 + 8192), 16, 0, 0); } while (0)
#define LDA(dst, b, h) for (int m = 0; m < 4; ++m) for (int k = 0; k < 2; ++k) \
    dst[m][k] = *reinterpret_cast<const bf16x8*>((char*)SA(b, h) + lds_byte(wr * 64 + m * 16 + fr, k * 32 + fq * 8))
#define LDB(dst, b, h) for (int n = 0; n < 2; ++n) for (int k = 0; k < 2; ++k) \
    dst[n][k] = *reinterpret_cast<const bf16x8*>((char*)SB(b, h) + lds_byte(wc * 32 + n * 16 + fr, k * 32 + fq * 8))
#define MMA(ai, bj, At_, Bt_) do { __builtin_amdgcn_s_setprio(1); \
    for (int m = 0; m < 4; ++m) for (int n = 0; n < 2; ++n) for (int k = 0; k < 2; ++k) \
      acc[ai][bj][m][n] = __builtin_amdgcn_mfma_f32_16x16x32_bf16(At_[m][k], Bt_[n][k], acc[ai][bj][m][n], 0, 0, 0); \
    __builtin_amdgcn_s_setprio(0); } while (0)
#define WAIT_V(n) asm volatile("s_waitcnt vmcnt(" #n ")" ::: "memory")
#define WAIT_L(n) asm volatile("s_waitcnt lgkmcnt(" #n ")" ::: "memory")
#define BAR __builtin_amdgcn_s_barrier()
#define SCHED __builtin_amdgcn_sched_barrier(0)
  const int tid_ = tidx();
  const int wid = tid_ >> 6, lane = tid_ & 63, wr = wid >> 2, wc = wid & 3, fr = lane & 15, fq = lane >> 4;
  const int nt = K / BK;
  const int wu16 = __builtin_amdgcn_readfirstlane(tid_ >> 6) * 1024;
  {
    unsigned so0, so1;
    { int _r, _c; stage_rc(tid_ * 16, _r, _c); so0 = (unsigned)(_r * K + _c) * 2u;
      stage_rc(tid_ * 16 + 8192, _r, _c); so1 = (unsigned)(_r * K + _c) * 2u; }
    const int brow = pm * BM, bcol = pn * BM;
    f32x4 acc[2][2][4][2] = {};
    bf16x8 At[4][2], B0[2][2], B1[2][2];
    STAGE(SB(0, 0), Bt, bcol, 0); STAGE(SA(0, 0), A, brow, 0);
    STAGE(SB(0, 1), Bt, bcol + HALF, 0); STAGE(SA(0, 1), A, brow + HALF, 0);
    if (wr == 1) BAR;
    WAIT_V(4); BAR;
    STAGE(SB(1, 0), Bt, bcol, 1); STAGE(SA(1, 0), A, brow, 1); STAGE(SB(1, 1), Bt, bcol + HALF, 1);
    WAIT_V(6); BAR;
    for (int t = 0; t < nt - 2; t += 2) {
      LDB(B0, 0, 0); SCHED; LDA(At, 0, 0); STAGE(SA(1, 1), A, brow + HALF, t + 1);
      WAIT_L(8); BAR; WAIT_L(0); MMA(0, 0, At, B0); BAR; SCHED;
      LDB(B1, 0, 1); STAGE(SB(0, 0), Bt, bcol, t + 2);
      BAR; WAIT_L(0); MMA(0, 1, At, B1); BAR;
      LDA(At, 0, 1); STAGE(SA(0, 0), A, brow, t + 2);
      BAR; WAIT_L(0); MMA(1, 0, At, B0); BAR; SCHED;
      STAGE(SB(0, 1), Bt, bcol + HALF, t + 2);
      WAIT_V(6); BAR; MMA(1, 1, At, B1); BAR;
      LDB(B0, 1, 0); SCHED; LDA(At, 1, 0); STAGE(SA(0, 1), A, brow + HALF, t + 2);
      WAIT_L(8); BAR; WAIT_L(0); MMA(0, 0, At, B0); BAR; SCHED;
      LDB(B1, 1, 1); STAGE(SB(1, 0), Bt, bcol, t + 3);
      BAR; WAIT_L(0); MMA(0, 1, At, B1); BAR;
      LDA(At, 1, 1); STAGE(SA(1, 0), A, brow, t + 3);
      BAR; WAIT_L(0); MMA(1, 0, At, B0); BAR; SCHED;
      STAGE(SB(1, 1), Bt, bcol + HALF, t + 3);
      WAIT_V(6); BAR; MMA(1, 1, At, B1); BAR;
    }
    { LDB(B0, 0, 0); LDA(At, 0, 0); STAGE(SA(1, 1), A, brow + HALF, nt - 1);
      BAR; WAIT_L(0); MMA(0, 0, At, B0); BAR;
      LDB(B1, 0, 1); BAR; WAIT_L(0); MMA(0, 1, At, B1); BAR;
      LDA(At, 0, 1); WAIT_V(4); BAR; WAIT_L(0); MMA(1, 0, At, B0); MMA(1, 1, At, B1); BAR; }
    { LDB(B0, 1, 0); LDA(At, 1, 0); WAIT_V(2); BAR; WAIT_L(0); MMA(0, 0, At, B0); BAR;
      LDB(B1, 1, 1); WAIT_V(0); BAR; WAIT_L(0); MMA(0, 1, At, B1); BAR;
      LDA(At, 1, 1); BAR; WAIT_L(0); MMA(1, 0, At, B0); MMA(1, 1, At, B1); BAR; }
    if (wr == 0) BAR;
    float* stg = (float*)smem;
    int tx = tid_;
    asm volatile("" : "+v"(tx));
    const int ewr = tx >> 8, ewc = (tx >> 6) & 3, efr = tx & 15, efq = (tx >> 4) & 3;
#define EPI_HALF(ai) do { \
    __syncthreads(); \
    _Pragma("unroll") for (int bj = 0; bj < 2; ++bj) _Pragma("unroll") for (int m = 0; m < 4; ++m) \
    _Pragma("unroll") for (int n = 0; n < 2; ++n) _Pragma("unroll") for (int j = 0; j < 4; ++j) \
      stg[(ewr * 64 + m * 16 + efq * 4 + j) * 260 + bj * HALF + ewc * 32 + n * 16 + efr] = acc[ai][bj][m][n][j]; \
    __syncthreads(); \
    _Pragma("unroll") for (int i = 0; i < 8; ++i) { \
      int item = i * NTHR + tx; int rl = item >> 5, qp = item & 31; \
      int cl = (qp >> 2) * 32 + (qp & 3) * 4; \
      float4 v0 = *(const float4*)(stg + rl * 260 + cl), v1 = *(const float4*)(stg + rl * 260 + cl + 16); \
      int row = brow + ai * HALF + rl; \
      float ss = epi.apply4(row, bcol + cl, v0, v1); \
      if (Epi::kSsq) { \
        ss += __shfl_xor(ss, 1); ss += __shfl_xor(ss, 2); ss += __shfl_xor(ss, 4); ss += __shfl_xor(ss, 8); ss += __shfl_xor(ss, 16); \
        if (qp == 0) epi.ssq_out(row, pn, ss); \
      } \
    } } while (0)
    EPI_HALF(0);
    EPI_HALF(1);
#undef EPI_HALF
    __syncthreads();
  }
#undef SA
#undef SB
#undef STAGE
#undef LDA
#undef LDB
#undef MMA
}

template <class Epi>
__device__ __forceinline__ void gemm_phase(const u16* __restrict__ A, const u16* __restrict__ Bt, const int K,
                                           const int nM, const int nN, const int rot, Epi epi) {
  const int G = gridDim.x;
  for (int tile = (int)((blockIdx.x + G - (rot % G)) % G); tile < nM * nN; tile += G) {
    int pm, pn; tile_map(tile, nM, nN, pm, pn);
    gemm_tile(A, Bt, K, pm, pn, epi);
  }
}

__device__ __forceinline__ float rstd_from_ssq(const float* ssq, int row) {
  float4 s = *(const float4*)(ssq + (size_t)row * 4);
  return rsqrtf((s.x + s.y + s.z + s.w) * (1.f / 1024.f) + 1e-6f);
}
__device__ __forceinline__ uint2 pack4(float4 v) { uint2 w; w.x = pack2(v.x, v.y); w.y = pack2(v.z, v.w); return w; }
__device__ __forceinline__ float silu_mul(float g, float u) { return g / (1.f + __expf(-g)) * u; }
struct EpiGU {
  static constexpr bool kSsq = false;
  const float* ssq; u16* act;
  __device__ __forceinline__ float apply4(int row, int c0, float4 g, float4 u) const {
    float rs = rstd_from_ssq(ssq, row);
    float4 o = make_float4(silu_mul(g.x * rs, u.x * rs), silu_mul(g.y * rs, u.y * rs), silu_mul(g.z * rs, u.z * rs), silu_mul(g.w * rs, u.w * rs));
    *(uint2*)(act + (size_t)row * DFF + ((c0 & ~31) >> 1) + (c0 & 15)) = pack4(o);
    return 0.f;
  }
  __device__ __forceinline__ void ssq_out(int, int, float) const {}
};
struct EpiRes {
  static constexpr bool kSsq = true;
  float* x; u16* xb; float* ssq; float coef;
  __device__ __forceinline__ float apply4(int row, int c0, float4 v0, float4 v1) const {
    size_t i = (size_t)row * 1024 + c0;
    float4 a = *(const float4*)(x + i), b = *(const float4*)(x + i + 16);
    a.x += coef * v0.x; a.y += coef * v0.y; a.z += coef * v0.z; a.w += coef * v0.w;
    b.x += coef * v1.x; b.y += coef * v1.y; b.z += coef * v1.z; b.w += coef * v1.w;
    *(float4*)(x + i) = a; *(float4*)(x + i + 16) = b;
    *(uint2*)(xb + i) = pack4(a); *(uint2*)(xb + i + 16) = pack4(b);
    return a.x * a.x + a.y * a.y + a.z * a.z + a.w * a.w + b.x * b.x + b.y * b.y + b.z * b.z + b.w * b.w;
  }
  __device__ __forceinline__ void ssq_out(int row, int pn, float v) const { ssq[(size_t)row * 4 + pn] = v; }
};
struct EpiScaleBf {
  static constexpr bool kSsq = false;
  const float* ssq; u16* o; int ld;
  __device__ __forceinline__ float apply4(int row, int c0, float4 v0, float4 v1) const {
    float rs = rstd_from_ssq(ssq, row);
    size_t i = (size_t)row * ld + c0;
    *(uint2*)(o + i) = pack4(make_float4(v0.x * rs, v0.y * rs, v0.z * rs, v0.w * rs));
    *(uint2*)(o + i + 16) = pack4(make_float4(v1.x * rs, v1.y * rs, v1.z * rs, v1.w * rs));
    return 0.f;
  }
  __device__ __forceinline__ void ssq_out(int, int, float) const {}
};
struct EpiQ {
  static constexpr bool kSsq = false;
  u16* qb; const float2* rope;
  __device__ __forceinline__ float apply4(int row, int c0, float4 v0, float4 v1) const {
    if (c0 < 1024) {
      size_t i = (size_t)row * 1280 + (c0 >> 7) * 160 + (c0 & 127);
      *(uint2*)(qb + i) = pack4(v0); *(uint2*)(qb + i + 16) = pack4(v1);
    } else {
      int h = (c0 - 1024) >> 5, f0 = c0 & 15;
      int pos = row < TP ? (row & 4095) : (2048 + ((row - TP) & 63));
      const float2* cs = rope + pos * 16 + f0;
      float2 c_0 = cs[0], c_1 = cs[1], c_2 = cs[2], c_3 = cs[3];
      size_t i = (size_t)row * 1280 + h * 160 + 128 + f0;
      *(uint2*)(qb + i) = pack4(make_float4(v0.x * c_0.x - v1.x * c_0.y, v0.y * c_1.x - v1.y * c_1.y, v0.z * c_2.x - v1.z * c_2.y, v0.w * c_3.x - v1.w * c_3.y));
      *(uint2*)(qb + i + 16) = pack4(make_float4(v0.x * c_0.y + v1.x * c_0.x, v0.y * c_1.y + v1.y * c_1.x, v0.z * c_2.y + v1.z * c_2.x, v0.w * c_3.y + v1.w * c_3.x));
    }
    return 0.f;
  }
  __device__ __forceinline__ void ssq_out(int, int, float) const {}
};
__device__ __forceinline__ float decay_f(float z) {
  float nz = -z;
  float sp = fmaxf(nz, 0.f) + __logf(1.f + __expf(-fabsf(nz)));
  return __expf(-__expf(-sp - 0.5f));
}
struct EpiRW {
  static constexpr bool kSsq = false;
  const float* w0; const float* a0; const float* ka; char* ws;
  __device__ __forceinline__ void acol(size_t i, int c, float4 v) const {
    u16* bb = (u16*)(ws + W_BB); u16* kb = (u16*)(ws + W_KB); const u16* kkb = (const u16*)(ws + W_KKB);
    float4 a_0 = *(const float4*)(a0 + c), k_a = *(const float4*)(ka + c), kk = bf4(*(const uint2*)(kkb + i)), k = bf4(*(const uint2*)(kb + i));
    float4 a = make_float4(sigmoidf_(a_0.x + v.x), sigmoidf_(a_0.y + v.y), sigmoidf_(a_0.z + v.z), sigmoidf_(a_0.w + v.w));
    *(uint2*)(bb + i) = pack4(make_float4(kk.x * a.x, kk.y * a.y, kk.z * a.z, kk.w * a.w));
    *(uint2*)(kb + i) = pack4(make_float4(k.x * (1.f + (a.x - 1.f) * k_a.x), k.y * (1.f + (a.y - 1.f) * k_a.y), k.z * (1.f + (a.z - 1.f) * k_a.z), k.w * (1.f + (a.w - 1.f) * k_a.w)));
  }
  __device__ __forceinline__ float apply4(int row, int c0, float4 v0, float4 v1) const {
    if (c0 < 512) {
      float* wb = (float*)(ws + W_WB);
      float4 z0 = *(const float4*)(w0 + c0), z1 = *(const float4*)(w0 + c0 + 16);
      size_t i = (size_t)row * 512 + c0;
      *(float4*)(wb + i) = make_float4(decay_f(z0.x + v0.x), decay_f(z0.y + v0.y), decay_f(z0.z + v0.z), decay_f(z0.w + v0.w));
      *(float4*)(wb + i + 16) = make_float4(decay_f(z1.x + v1.x), decay_f(z1.y + v1.y), decay_f(z1.z + v1.z), decay_f(z1.w + v1.w));
    } else if (c0 < 1024) {
      int c = c0 - 512; size_t i = (size_t)row * 512 + c;
      acol(i, c, v0); acol(i + 16, c + 16, v1);
    } else {
      u16* gb = (u16*)(ws + W_GB);
      size_t i = (size_t)row * 512 + (c0 - 1024);
      *(uint2*)(gb + i) = pack4(v0); *(uint2*)(gb + i + 16) = pack4(v1);
    }
    return 0.f;
  }
  __device__ __forceinline__ void ssq_out(int, int, float) const {}
};
template <bool ISV>
struct EpiMem {
  static constexpr bool kSsq = false;
  float* of; u16* ob;
  __device__ __forceinline__ void quad(int row, int col, float4 v) const {
    *(float4*)(of + (size_t)row * 1024 + col) = v;
    int b = row >> 8, m = row & 255, h = col >> 8, d = col & 255;
    if (ISV) {
      u16* o = ob + (size_t)((b * 4 + h) * 256 + d) * 256 + m;
      o[0] = f2bf(v.x); o[256] = f2bf(v.y); o[512] = f2bf(v.z); o[768] = f2bf(v.w);
    } else {
      *(uint2*)(ob + (size_t)((b * 4 + h) * 256 + m) * 256 + d) = pack4(v);
    }
  }
  __device__ __forceinline__ float apply4(int row, int c0, float4 v0, float4 v1) const {
    quad(row, c0, v0); quad(row, c0 + 16, v1);
    return 0.f;
  }
  __device__ __forceinline__ void ssq_out(int, int, float) const {}
};

template <class F>
__device__ __forceinline__ void tconv(u16* dst, int ldd, int N, int K, int rot, F f) {
  extern __shared__ __attribute__((aligned(16))) char smem[];
  float* t = (float*)smem;
  const int nk = K / 64, nt = (N / 64) * nk, G = gridDim.x;
  const int tid = tidx(), a = tid >> 6, c = tid & 63;
  for (int tile = (int)((blockIdx.x + G - (rot % G)) % G); tile < nt; tile += G) {
    int n0 = (tile / nk) * 64, k0 = (tile % nk) * 64;
    __syncthreads();
#pragma unroll
    for (int i = 0; i < 8; ++i) { int kk = a + 8 * i; t[kk * 65 + c] = f(k0 + kk, n0 + c); }
    __syncthreads();
#pragma unroll
    for (int i = 0; i < 2; ++i) {
      const int nn = (tid >> 4) + 32 * i, kq = (tid & 15) * 4;
      uint2 w; w.x = pack2(t[kq * 65 + nn], t[(kq + 1) * 65 + nn]); w.y = pack2(t[(kq + 2) * 65 + nn], t[(kq + 3) * 65 + nn]);
      *(uint2*)(dst + (size_t)(n0 + nn) * ldd + k0 + kq) = w;
    }
  }
}

template <class F>
__device__ __forceinline__ void tconv_v(u16* dst, int ldd, int N, int K, int vb, int nvb, F f) {
  extern __shared__ __attribute__((aligned(16))) char smem[];
  float* t = (float*)smem;
  const int nk = K / 64, nt = (N / 64) * nk;
  const int tid = tidx(), a = tid >> 6, c = tid & 63;
  for (int tile = vb; tile < nt; tile += nvb) {
    int n0 = (tile / nk) * 64, k0 = (tile % nk) * 64;
    __syncthreads();
#pragma unroll
    for (int i = 0; i < 8; ++i) { int kk = a + 8 * i; t[kk * 65 + c] = f(k0 + kk, n0 + c); }
    __syncthreads();
#pragma unroll
    for (int i = 0; i < 2; ++i) {
      const int nn = (tid >> 4) + 32 * i, kq = (tid & 15) * 4;
      uint2 w; w.x = pack2(t[kq * 65 + nn], t[(kq + 1) * 65 + nn]); w.y = pack2(t[(kq + 2) * 65 + nn], t[(kq + 3) * 65 + nn]);
      *(uint2*)(dst + (size_t)(n0 + nn) * ldd + k0 + kq) = w;
    }
  }
  __syncthreads();
}

template <int DK, int DV, int RPG>
__device__ __forceinline__ void attn_item(const u16* __restrict__ Qb, int ldq, int nrows, const u16* __restrict__ Kb, int ldk,
                                          const u16* __restrict__ Vtb, int ldvt, int nkeys, u16* __restrict__ Ob, int ldo) {
  extern __shared__ __attribute__((aligned(16))) char smem[];
  constexpr int KS = DK + 8, VS = 68;
  u16* sK = (u16*)smem;
  u16* sV = sK + 64 * KS;
  const int tid = tidx(), wid = tid >> 6, lane = tid & 63, q = lane & 31, hh = lane >> 5;
  const int row = wid * 32 + q;
  const bool active = (wid * 32) < nrows;
  bf16x8 qf[DK / 16];
  if (active) {
#pragma unroll
    for (int ks = 0; ks < DK / 16; ++ks) qf[ks] = *(const bf16x8*)(Qb + (size_t)row * ldq + ks * 16 + hh * 8);
  }
  f32x16 o[DV / 32];
#pragma unroll
  for (int dt = 0; dt < DV / 32; ++dt)
#pragma unroll
    for (int i = 0; i < 16; ++i) o[dt][i] = 0.f;
  float mrun = -1e30f, lrun = 0.f;
  const int nkt = nkeys >> 6;
  constexpr int KCH = (64 * (DK / 8) + NTHR - 1) / NTHR;
  static_assert(DV == 128 && KCH <= 4, "staging registers are written out by hand");
  uint4 kr0, kr1, kr2, kr3, vr0, vr1;
#define AT_KL(N_, kt_) { const int c = tid + N_ * NTHR; if (N_ < KCH && c < 64 * (DK / 8)) { const int r = c / (DK / 8), cc = c % (DK / 8); \
      kr##N_ = *(const uint4*)(Kb + (size_t)((kt_) * 64 + r) * ldk + cc * 8); } }
#define AT_VL(N_, kt_) { const int c = tid + N_ * NTHR; const int r = c >> 3, cc = c & 7; vr##N_ = *(const uint4*)(Vtb + (size_t)r * ldvt + (kt_) * 64 + cc * 8); }
#define AT_GLOAD(kt_) do { AT_KL(0, kt_) AT_KL(1, kt_) AT_KL(2, kt_) AT_KL(3, kt_) AT_VL(0, kt_) AT_VL(1, kt_) } while (0)
#define AT_KS(N_) { const int c = tid + N_ * NTHR; if (N_ < KCH && c < 64 * (DK / 8)) { const int r = c / (DK / 8), cc = c % (DK / 8); *(uint4*)(sK + r * KS + cc * 8) = kr##N_; } }
#define AT_VS(N_) { const int c = tid + N_ * NTHR; const int r = c >> 3, cc = c & 7; uint2* d = (uint2*)(sV + r * VS + cc * 8); \
      const uint4 t_ = vr##N_; d[0] = make_uint2(t_.x, t_.y); d[1] = make_uint2(t_.z, t_.w); }
  AT_GLOAD(0);
  for (int kt = 0; kt < nkt; ++kt) {
    __syncthreads();
    AT_KS(0) AT_KS(1) AT_KS(2) AT_KS(3) AT_VS(0) AT_VS(1)
    __syncthreads();
    if (kt + 1 < nkt) AT_GLOAD(kt + 1);
    if (active) {
      f32x16 s0, s1;
#pragma unroll
      for (int i = 0; i < 16; ++i) { s0[i] = 0.f; s1[i] = 0.f; }
#pragma unroll
      for (int ks = 0; ks < DK / 16; ++ks) {
        bf16x8 a0 = *(const bf16x8*)(sK + q * KS + ks * 16 + hh * 8);
        bf16x8 a1 = *(const bf16x8*)(sK + (32 + q) * KS + ks * 16 + hh * 8);
        s0 = __builtin_amdgcn_mfma_f32_32x32x16_bf16(a0, qf[ks], s0, 0, 0, 0);
        s1 = __builtin_amdgcn_mfma_f32_32x32x16_bf16(a1, qf[ks], s1, 0, 0, 0);
      }
      float mx = s0[0];
#pragma unroll
      for (int i = 1; i < 16; ++i) mx = fmaxf(mx, s0[i]);
#pragma unroll
      for (int i = 0; i < 16; ++i) mx = fmaxf(mx, s1[i]);
      mx = fmaxf(mx, __shfl_xor(mx, 32));
      float mn = fmaxf(mrun, mx);
      float alpha = __builtin_amdgcn_exp2f(mrun - mn);
      mrun = mn;
      float ps = 0.f;
#pragma unroll
      for (int i = 0; i < 16; ++i) { s0[i] = __builtin_amdgcn_exp2f(sub_s(s0[i], mn)); ps = add_s(ps, s0[i]); }
#pragma unroll
      for (int i = 0; i < 16; ++i) { s1[i] = __builtin_amdgcn_exp2f(sub_s(s1[i], mn)); ps = add_s(ps, s1[i]); }
      lrun = lrun * alpha + ps;
#pragma unroll
      for (int dt = 0; dt < DV / 32; ++dt)
#pragma unroll
        for (int i = 0; i < 16; ++i) o[dt][i] = mul_s(o[dt][i], alpha);
#pragma unroll
      for (int kb = 0; kb < 2; ++kb)
#pragma unroll
        for (int s = 0; s < 2; ++s) {
          union { bf16x8 v; unsigned u[4]; } pf;
#pragma unroll
          for (int jj = 0; jj < 4; ++jj) {
            float e0 = kb ? s1[8 * s + 2 * jj] : s0[8 * s + 2 * jj];
            float e1 = kb ? s1[8 * s + 2 * jj + 1] : s0[8 * s + 2 * jj + 1];
            pf.u[jj] = pack2(e0, e1);
          }
          const int kbase = kb * 32 + s * 16 + 4 * hh;
#pragma unroll
          for (int dt = 0; dt < DV / 32; ++dt) {
            const u16* vp = sV + (dt * 32 + q) * VS + kbase;
            union { bf16x8 v; uint2 u[2]; } vf;
            vf.u[0] = *(const uint2*)vp; vf.u[1] = *(const uint2*)(vp + 8);
            o[dt] = __builtin_amdgcn_mfma_f32_32x32x16_bf16(vf.v, pf.v, o[dt], 0, 0, 0);
          }
        }
    }
  }
  if (active) {
    lrun += __shfl_xor(lrun, 32);
    float inv = 1.f / lrun;
    u16* op = Ob + (size_t)(row / RPG) * ldo + (size_t)(row % RPG) * DV;
#pragma unroll
    for (int dt = 0; dt < DV / 32; ++dt)
#pragma unroll
      for (int g = 0; g < 4; ++g) {
        uint2 w;
        w.x = pack2(o[dt][4 * g] * inv, o[dt][4 * g + 1] * inv);
        w.y = pack2(o[dt][4 * g + 2] * inv, o[dt][4 * g + 3] * inv);
        *(uint2*)(op + dt * 32 + 8 * g + 4 * hh) = w;
      }
  }
}

#undef AT_GLOAD
#undef AT_KL
#undef AT_VL
#undef AT_KS
#undef AT_VS
__device__ __forceinline__ float dpp_sum16(float x) {
  x += __int_as_float(__builtin_amdgcn_update_dpp(0, __float_as_int(x), 0xB1, 0xF, 0xF, false));
  x += __int_as_float(__builtin_amdgcn_update_dpp(0, __float_as_int(x), 0x4E, 0xF, 0xF, false));
  x += __int_as_float(__builtin_amdgcn_update_dpp(0, __float_as_int(x), 0x141, 0xF, 0xF, false));
  x += __int_as_float(__builtin_amdgcn_update_dpp(0, __float_as_int(x), 0x140, 0xF, 0xF, false));
  return x;
}
__device__ __forceinline__ void scan_item(KPR p, int l, int g0, int h, int half, int nsteps, const float* S0, float* Sout) {
  extern __shared__ __attribute__((aligned(16))) char smem[];
  float* sT = (float*)smem;
  float* sV = sT + 5 * 4096;
  const float* src0 = (const float*)(p.ws + W_RB) + h * 64; const float* src1 = (const float*)(p.ws + W_WB) + h * 64;
  const float* src2 = (const float*)(p.ws + W_KB) + h * 64; const float* src3 = (const float*)(p.ws + W_KKB) + h * 64;
  const float* src4 = (const float*)(p.ws + W_BB) + h * 64;
  const float* VB = (const float*)(p.ws + W_VB) + h * 64 + half * 32;
  float* YB = (float*)(p.ws + W_YB) + h * 64 + half * 32;
  const int tid = tidx();
  const int il = tid >> 4, sub = tid & 15, j0 = sub * 4, i = half * 32 + il;
  float s[4];
#pragma unroll
  for (int j = 0; j < 4; ++j) s[j] = S0 ? S0[i * 64 + j0 + j] : 0.f;
  float4 pa0, pa1, pa2, pa3, pa4, pb0, pb1, pb2, pb3, pb4, pfv;
  const int e0 = tid, e1 = tid + NTHR;
  const int st0 = e0 >> 4, c40 = (e0 & 15) * 4, st1 = e1 >> 4, c41 = (e1 & 15) * 4;
  const int stv = tid >> 3, c4v = (tid & 7) * 4;
#define SC_GL1(x, c0_) pa##x = *(const float4*)(src##x + (size_t)(g0 + (c0_) + st0) * 512 + c40); \
                       pb##x = *(const float4*)(src##x + (size_t)(g0 + (c0_) + st1) * 512 + c41);
#define SC_GLOAD(c0_) do { SC_GL1(0, c0_) SC_GL1(1, c0_) SC_GL1(2, c0_) SC_GL1(3, c0_) SC_GL1(4, c0_) \
    pfv = *(const float4*)(VB + (size_t)(g0 + (c0_) + stv) * 512 + c4v); } while (0)
#define SC_ST1(x) *(float4*)(sT + x * 4096 + st0 * 64 + c40) = pa##x; *(float4*)(sT + x * 4096 + st1 * 64 + c41) = pb##x;
  SC_GLOAD(0);
  for (int c0 = 0; c0 < nsteps; c0 += 64) {
    __syncthreads();
    SC_ST1(0) SC_ST1(1) SC_ST1(2) SC_ST1(3) SC_ST1(4)
    *(float4*)(sV + stv * 32 + c4v) = pfv;
    __syncthreads();
    if (c0 + 64 < nsteps) SC_GLOAD(c0 + 64);
#define SC_LD(S, st_) do { const int _s = (st_) < 64 ? (st_) : 63; \
      S##r = *(const float4*)(sT + _s * 64 + j0); S##w = *(const float4*)(sT + 4096 + _s * 64 + j0); \
      S##k = *(const float4*)(sT + 8192 + _s * 64 + j0); S##q = *(const float4*)(sT + 12288 + _s * 64 + j0); \
      S##b = *(const float4*)(sT + 16384 + _s * 64 + j0); S##v = sV[_s * 32 + il]; } while (0)
#define SC_STEP(S, st_) do { \
      float sa = -dpp_sum16(fma_s(s[1], S##q.y, mul_s(s[0], S##q.x)) + fma_s(s[3], S##q.w, mul_s(s[2], S##q.z))); \
      s[0] = fma_s(sa, S##b.x, fma_s(s[0], S##w.x, mul_s(S##v, S##k.x))); \
      s[1] = fma_s(sa, S##b.y, fma_s(s[1], S##w.y, mul_s(S##v, S##k.y))); \
      s[2] = fma_s(sa, S##b.z, fma_s(s[2], S##w.z, mul_s(S##v, S##k.z))); \
      s[3] = fma_s(sa, S##b.w, fma_s(s[3], S##w.w, mul_s(S##v, S##k.w))); \
      float y = dpp_sum16(fma_s(s[1], S##r.y, mul_s(s[0], S##r.x)) + fma_s(s[3], S##r.w, mul_s(s[2], S##r.z))); \
      ykeep = (sub == ((st_) & 15)) ? y : ykeep; } while (0)
    float4 Ar, Aw, Ak, Aq, Ab, Br, Bw, Bk, Bq, Bb, Cr, Cw, Ck, Cq, Cb, Dr, Dw, Dk, Dq, Db;
    float Av, Bv, Cv, Dv, ykeep = 0.f;
    SC_LD(A, 0); SC_LD(B, 1); SC_LD(C, 2);
    for (int st = 0; st < 64; st += 4) {
      SC_LD(D, st + 3); SC_STEP(A, st);
      SC_LD(A, st + 4); SC_STEP(B, st + 1);
      SC_LD(B, st + 5); SC_STEP(C, st + 2);
      SC_LD(C, st + 6); SC_STEP(D, st + 3);
      if ((st & 15) == 12) YB[(size_t)(g0 + c0 + (st - 12) + sub) * 512 + il] = ykeep;
    }
  }
#undef SC_LD
#undef SC_STEP
#undef SC_GLOAD
#undef SC_GL1
#undef SC_ST1
  *(float4*)(Sout + i * 64 + j0) = make_float4(s[0], s[1], s[2], s[3]);
}

constexpr int LS = 68;
constexpr int LBUF = 64 * LS;
constexpr int LH = 72;

__device__ __forceinline__ void split8(const float* x, bf16x8& hi, bf16x8& lo) {
  union { bf16x8 v; unsigned u[4]; } H, Lo;
#pragma unroll
  for (int j = 0; j < 4; ++j) {
    const unsigned h = pack2(x[2 * j], x[2 * j + 1]);
    H.u[j] = h;
    Lo.u[j] = pack2(x[2 * j] - __uint_as_float(h << 16), x[2 * j + 1] - __uint_as_float(h & 0xffff0000u));
  }
  hi = H.v; lo = Lo.v;
}
template <int AM, int AK, int BKS, int BN, bool SPLIT = true>
__device__ __forceinline__ void mm64(const float* A, const float* B, f32x4 (&acc)[2], int m0, int n0, int lane) {
  const int lr = lane & 15, lq = lane >> 4;
#pragma unroll
  for (int ks = 0; ks < 2; ++ks) {
    const int k0 = ks * 32 + lq * 8;
    float a[8];
    if (AK == 1) {
      float4 x0 = *(const float4*)(A + (m0 + lr) * AM + k0), x1 = *(const float4*)(A + (m0 + lr) * AM + k0 + 4);
      a[0] = x0.x; a[1] = x0.y; a[2] = x0.z; a[3] = x0.w; a[4] = x1.x; a[5] = x1.y; a[6] = x1.z; a[7] = x1.w;
    } else {
#pragma unroll
      for (int j = 0; j < 8; ++j) a[j] = A[(m0 + lr) * AM + (k0 + j) * AK];
    }
    bf16x8 ah, al;
    if (SPLIT) split8(a, ah, al);
    else { union { bf16x8 v; unsigned u[4]; } H; for (int j = 0; j < 4; ++j) H.u[j] = pack2(a[2 * j], a[2 * j + 1]); ah = H.v; al = H.v; }
#pragma unroll
    for (int nt = 0; nt < 2; ++nt) {
      const int n = n0 + nt * 16 + lr;
      float b[8];
      if (BKS == 1) {
        float4 x0 = *(const float4*)(B + n * BN + k0), x1 = *(const float4*)(B + n * BN + k0 + 4);
        b[0] = x0.x; b[1] = x0.y; b[2] = x0.z; b[3] = x0.w; b[4] = x1.x; b[5] = x1.y; b[6] = x1.z; b[7] = x1.w;
      } else {
#pragma unroll
        for (int j = 0; j < 8; ++j) b[j] = B[(k0 + j) * BKS + n * BN];
      }
      if (SPLIT) {
        bf16x8 bh, bl; split8(b, bh, bl);
        acc[nt] = __builtin_amdgcn_mfma_f32_16x16x32_bf16(ah, bh, acc[nt], 0, 0, 0);
        acc[nt] = __builtin_amdgcn_mfma_f32_16x16x32_bf16(ah, bl, acc[nt], 0, 0, 0);
        acc[nt] = __builtin_amdgcn_mfma_f32_16x16x32_bf16(al, bh, acc[nt], 0, 0, 0);
      } else {
        union { bf16x8 v; unsigned u[4]; } Bh;
#pragma unroll
        for (int j = 0; j < 4; ++j) Bh.u[j] = pack2(b[2 * j], b[2 * j + 1]);
        acc[nt] = __builtin_amdgcn_mfma_f32_16x16x32_bf16(ah, Bh.v, acc[nt], 0, 0, 0);
      }
    }
  }
}
#define MM_ZERO(acc) do { acc[0] = f32x4{0.f, 0.f, 0.f, 0.f}; acc[1] = f32x4{0.f, 0.f, 0.f, 0.f}; } while (0)
#define MM_FOREACH(acc, BODY) do { _Pragma("unroll") for (int nt_ = 0; nt_ < 2; ++nt_) _Pragma("unroll") for (int rg_ = 0; rg_ < 4; ++rg_) { \
    const int m = m0 + lq * 4 + rg_, n = n0 + nt_ * 16 + lr; const float val = acc[nt_][rg_]; BODY } } while (0)

#define CPRE_PARAMS float4& c_w0, float4& c_w1, uint2& c_q0, uint2& c_q1, uint2& c_b0, uint2& c_b1, uint2& c_k0, uint2& c_k1, uint2& c_r0, uint2& c_r1, uint2& c_v0, uint2& c_v1
#define CPRE_ARGS(P) P##w0, P##w1, P##q0, P##q1, P##b0, P##b1, P##k0, P##k1, P##r0, P##r1, P##v0, P##v1
__device__ __forceinline__ void cprep_load(KPR p, int grow0, int h, int tid, CPRE_PARAMS) {
  const int t0 = tid >> 4, c4 = (tid & 15) * 4;
  const size_t g0 = (size_t)(grow0 + t0) * 512 + h * 64 + c4, g1 = g0 + (size_t)32 * 512;
  const float* WB = (const float*)(p.ws + W_WB); const u16* KKB = (const u16*)(p.ws + W_KKB); const u16* BB = (const u16*)(p.ws + W_BB);
  const u16* KB = (const u16*)(p.ws + W_KB); const u16* RB = (const u16*)(p.ws + W_RB); const u16* VB = (const u16*)(p.ws + W_VB);
  c_w0 = *(const float4*)(WB + g0); c_w1 = *(const float4*)(WB + g1); c_q0 = *(const uint2*)(KKB + g0); c_q1 = *(const uint2*)(KKB + g1);
  c_b0 = *(const uint2*)(BB + g0); c_b1 = *(const uint2*)(BB + g1); c_k0 = *(const uint2*)(KB + g0); c_k1 = *(const uint2*)(KB + g1);
  c_r0 = *(const uint2*)(RB + g0); c_r1 = *(const uint2*)(RB + g1); c_v0 = *(const uint2*)(VB + g0); c_v1 = *(const uint2*)(VB + g1);
}
__device__ __forceinline__ void cprep_item(KPR p, int grow0, int h, int cid, int ngrow0, int nh, CPRE_PARAMS) {
  extern __shared__ __attribute__((aligned(16))) char smem[];
  float* B0 = (float*)smem; float* B1 = B0 + LBUF; float* B2 = B1 + LBUF; float* B3 = B2 + LBUF;
  float* B4 = B3 + LBUF; float* B5 = B4 + LBUF; float* B6 = B5 + LBUF; float* B7 = B6 + LBUF;
  float* wC = (float*)(smem + 139264);
  const int tid = tidx(), wid = tid >> 6, lane = tid & 63, lr = lane & 15, lq = lane >> 4;
  const int m0 = (wid >> 1) * 16, n0 = (wid & 1) * 32;
  const float* WB = (const float*)(p.ws + W_WB) + h * 64; const float* KKB = (const float*)(p.ws + W_KKB) + h * 64;
  const float* BB = (const float*)(p.ws + W_BB) + h * 64; const float* KB = (const float*)(p.ws + W_KB) + h * 64;
  const float* RB = (const float*)(p.ws + W_RB) + h * 64; const float* VB = (const float*)(p.ws + W_VB) + h * 64;
  f32x4 acc[2];
  __syncthreads();
  {
    const int t0 = tid >> 4, c4 = (tid & 15) * 4, o0 = t0 * LS + c4, o1 = (t0 + 32) * LS + c4;
    *(float4*)(B0 + o0) = c_w0; *(float4*)(B0 + o1) = c_w1;
    { const float4 a0_ = bf4(c_q0), a1_ = bf4(c_q1);
      *(float4*)(B1 + o0) = make_float4(-a0_.x, -a0_.y, -a0_.z, -a0_.w); *(float4*)(B1 + o1) = make_float4(-a1_.x, -a1_.y, -a1_.z, -a1_.w); }
    *(float4*)(B2 + o0) = bf4(c_b0); *(float4*)(B2 + o1) = bf4(c_b1);
    *(float4*)(B3 + o0) = bf4(c_k0); *(float4*)(B3 + o1) = bf4(c_k1);
    *(float4*)(B4 + o0) = bf4(c_r0); *(float4*)(B4 + o1) = bf4(c_r1);
  }
  const uint2 vk0 = c_v0, vk1 = c_v1;
  __syncthreads();
  cprep_load(p, ngrow0, nh, tid, CPRE_ARGS(c_));
  {
    const int j = tid & 63, sg = tid >> 6;
    float wv[8];
#pragma unroll
    for (int u = 0; u < 8; ++u) wv[u] = B0[(sg * 8 + u) * LS + j];
#pragma unroll
    for (int u = 1; u < 8; ++u) wv[u] *= wv[u - 1];
    float* segp = B5;
    segp[sg * 64 + j] = wv[7];
    __syncthreads();
    float pre = 1.f;
    for (int u = 0; u < sg; ++u) pre *= segp[u * 64 + j];
#pragma unroll
    for (int u = 0; u < 8; ++u) B0[(sg * 8 + u) * LS + j] = wv[u] * pre;
    if (sg == 7) wC[j] = wv[7] * pre;
  }
  __syncthreads();
  for (int e = tid; e < 4096; e += NTHR) {
    const int t = e >> 6, j = e & 63, o = t * LS + j;
    const float wt = B0[o], wp = t ? B0[o - LS] : 1.f, iw = 1.f / wt;
    B1[o] *= wp; B2[o] *= iw; B3[o] *= iw; B4[o] *= wt;
  }
  __syncthreads();
  MM_ZERO(acc); mm64<LS, 1, 1, LS>(B2, B1, acc, m0, n0, lane);
  MM_FOREACH(acc, { const float v = m < n ? val : 0.f; B5[m * LS + n] = v; B6[m * LS + n] = v + (m == n ? 1.f : 0.f); });
  __syncthreads();
  MM_ZERO(acc); mm64<LS, 1, LS, 1>(B5, B5, acc, m0, n0, lane);
  MM_FOREACH(acc, { B7[m * LS + n] = val; });
  __syncthreads();
  for (int it = 0; it < 5; ++it) {
    MM_ZERO(acc); mm64<LS, 1, LS, 1>(B6, B7, acc, m0, n0, lane);
    f32x4 acc2[2]; MM_ZERO(acc2);
    if (it < 4) mm64<LS, 1, LS, 1>(B7, B7, acc2, m0, n0, lane);
    __syncthreads();
    MM_FOREACH(acc, { B6[m * LS + n] += val; });
    if (it < 4) MM_FOREACH(acc2, { B7[m * LS + n] = val; });
    __syncthreads();
  }
  MM_ZERO(acc); mm64<1, LS, LS, 1>(B1, B6, acc, m0, n0, lane);
  MM_FOREACH(acc, { B5[m * LS + n] = val; });
  MM_ZERO(acc); mm64<LS, 1, 1, LS>(B3, B1, acc, m0, n0, lane);
  MM_FOREACH(acc, { B0[m * LS + n] = m < n ? val : 0.f; });
  __syncthreads();
  MM_ZERO(acc); mm64<LS, 1, LS, 1>(B0, B6, acc, m0, n0, lane);
  MM_FOREACH(acc, { B7[m * LS + n] = val; });
  __syncthreads();
  MM_ZERO(acc); mm64<LS, 1, 1, LS, false>(B2, B4, acc, m0, n0, lane);
  {
    f32x4 acc2[2]; MM_ZERO(acc2); mm64<LS, 1, 1, LS, false>(B3, B4, acc2, m0, n0, lane);
    __syncthreads();
    MM_FOREACH(acc, { B0[m * LS + n] = m <= n ? val : 0.f; });
    MM_FOREACH(acc2, { B1[m * LS + n] = m <= n ? val : 0.f; });
  }
  __syncthreads();
  {
    u16* RRT = (u16*)(p.ws + W_CRR) + (size_t)cid * 4096;
    MM_ZERO(acc); mm64<1, LS, 1, LS, false>(B0, B5, acc, m0, n0, lane);
    MM_FOREACH(acc, { RRT[m * 64 + n] = f2bf(val + B4[m * LS + n]); });
    MM_ZERO(acc); mm64<LS, 1, LS, 1, false>(B7, B0, acc, m0, n0, lane);
    MM_FOREACH(acc, { B6[m * LS + n] = val + B1[m * LS + n]; });
  }
  __syncthreads();
  for (int e = tid; e < 4096; e += NTHR) {
    const int t = e >> 6, j = e & 63, o = t * LS + j;
    const float wc = wC[j];
    B2[o] *= wc; B3[o] *= wc;
  }
  { const int t0 = tid >> 4, c4 = (tid & 15) * 4; *(float4*)(B4 + t0 * LS + c4) = bf4(vk0); *(float4*)(B4 + (t0 + 32) * LS + c4) = bf4(vk1); }
  __syncthreads();
  {
    u16* YB = (u16*)(p.ws + W_YB) + h * 64;
    MM_ZERO(acc); mm64<1, LS, LS, 1, false>(B6, B4, acc, m0, n0, lane);
    MM_FOREACH(acc, { YB[(size_t)(grow0 + m) * 512 + n] = f2bf(val); });
    u16* PT = (u16*)(p.ws + W_CPT) + (size_t)cid * 4096;
    MM_ZERO(acc); mm64<1, LS, 1, LS, false>(B2, B5, acc, m0, n0, lane);
    MM_FOREACH(acc, { PT[m * 64 + n] = f2bf(val + (m == n ? wC[m] : 0.f)); });
    MM_ZERO(acc); mm64<LS, 1, LS, 1, false>(B7, B2, acc, m0, n0, lane);
    MM_FOREACH(acc, { B0[m * LS + n] = val + B3[m * LS + n]; });
  }
  __syncthreads();
  {
    u16* CQ = (u16*)(p.ws + W_CQ) + (size_t)cid * 4096;
    MM_ZERO(acc); mm64<1, LS, LS, 1, false>(B4, B0, acc, m0, n0, lane);
    MM_FOREACH(acc, { CQ[m * 64 + n] = f2bf(val); });
  }
}

__device__ __forceinline__ void cprep_decode(int id, int& grow0, int& h) {
  if (id < 2048) { grow0 = (id >> 9) * 4096 + (id & 63) * 64; h = (id >> 6) & 7; }
  else { const int k = id - 2048; grow0 = TP + (k >> 3) * 64; h = k & 7; }
}
__device__ __forceinline__ void phase_cprep(KPR p) {
  float4 u_w0, u_w1; uint2 u_k0, u_k1, u_q0, u_q1, u_b0, u_b1, u_r0, u_r1, u_v0, u_v1;
  int id = blockIdx.x, grow0 = 0, h = 0;
  cprep_decode(id < 2304 ? id : 0, grow0, h); cprep_load(p, grow0, h, tidx(), CPRE_ARGS(u_));
  for (; id < 2304; id += gridDim.x) {
    const int nid = id + gridDim.x;
    int ng = 0, nh = 0;
    cprep_decode(nid < 2304 ? nid : id, ng, nh);
    cprep_item(p, grow0, h, id, ng, nh, CPRE_ARGS(u_));
    grow0 = ng; h = nh;
  }
}

__device__ __forceinline__ void cseq_item(KPR p, int g0, int h, int nch, int cid0, const float* S0, float* Sout) {
  extern __shared__ __attribute__((aligned(16))) char smem[];
  float* Sf = (float*)smem;
  float* Qf = Sf + LBUF;
  float* Yf = Qf + LBUF;
  u16* Rb = (u16*)(Yf + LBUF);
  u16* Pb = Rb + 64 * LH;
  const int tid = tidx(), wid = tid >> 6, lane = tid & 63, lr = lane & 15, lq = lane >> 4;
  const int m0 = (wid >> 1) * 16, n0 = (wid & 1) * 32;
  u16* YB = (u16*)(p.ws + W_YB) + h * 64;
  const u16* RRT = (const u16*)(p.ws + W_CRR) + (size_t)cid0 * 4096;
  const u16* PT = (const u16*)(p.ws + W_CPT) + (size_t)cid0 * 4096;
  const u16* CQ = (const u16*)(p.ws + W_CQ) + (size_t)cid0 * 4096;
  __syncthreads();
  for (int e = tid; e < 4096; e += NTHR) { const int i = e >> 6, j = e & 63; Sf[i * LS + j] = S0 ? S0[e] : 0.f; }
  const int hr = tid >> 3, hc = (tid & 7) * 8;
  const int f0t = tid >> 4, f0c = (tid & 15) * 4;
  uint4 pr, pp; uint2 q0, q1, y0, y1;
#define CS_LOAD(c_) do { \
    pr = *(const uint4*)(RRT + (size_t)(c_) * 4096 + hr * 64 + hc); pp = *(const uint4*)(PT + (size_t)(c_) * 4096 + hr * 64 + hc); \
    q0 = *(const uint2*)(CQ + (size_t)(c_) * 4096 + f0t * 64 + f0c); q1 = *(const uint2*)(CQ + (size_t)(c_) * 4096 + (f0t + 32) * 64 + f0c); \
    y0 = *(const uint2*)(YB + (size_t)(g0 + (c_) * 64 + f0t) * 512 + f0c); y1 = *(const uint2*)(YB + (size_t)(g0 + (c_) * 64 + f0t + 32) * 512 + f0c); } while (0)
  CS_LOAD(0);
  for (int c = 0; c < nch; ++c) {
    __syncthreads();
    *(uint4*)(Rb + hr * LH + hc) = pr; *(uint4*)(Pb + hr * LH + hc) = pp;
    *(float4*)(Qf + f0t * LS + f0c) = bf4(q0); *(float4*)(Qf + (f0t + 32) * LS + f0c) = bf4(q1);
    *(float4*)(Yf + f0t * LS + f0c) = bf4(y0); *(float4*)(Yf + (f0t + 32) * LS + f0c) = bf4(y1);
    __syncthreads();
    if (c + 1 < nch) CS_LOAD(c + 1);
    f32x4 ay[2], as[2]; MM_ZERO(ay); MM_ZERO(as);
#pragma unroll
    for (int ks = 0; ks < 2; ++ks) {
      const int k0 = ks * 32 + lq * 8;
      const bf16x8 ra = *(const bf16x8*)(Rb + (m0 + lr) * LH + k0);
      float sa[8];
      { float4 x0 = *(const float4*)(Sf + (m0 + lr) * LS + k0), x1 = *(const float4*)(Sf + (m0 + lr) * LS + k0 + 4);
        sa[0] = x0.x; sa[1] = x0.y; sa[2] = x0.z; sa[3] = x0.w; sa[4] = x1.x; sa[5] = x1.y; sa[6] = x1.z; sa[7] = x1.w; }
      bf16x8 sah, sal; split8(sa, sah, sal);
#pragma unroll
      for (int nt = 0; nt < 2; ++nt) {
        const int n = n0 + nt * 16 + lr;
        float sb[8];
        { float4 x0 = *(const float4*)(Sf + n * LS + k0), x1 = *(const float4*)(Sf + n * LS + k0 + 4);
          sb[0] = x0.x; sb[1] = x0.y; sb[2] = x0.z; sb[3] = x0.w; sb[4] = x1.x; sb[5] = x1.y; sb[6] = x1.z; sb[7] = x1.w; }
        bf16x8 sbh, sbl; split8(sb, sbh, sbl);
        ay[nt] = __builtin_amdgcn_mfma_f32_16x16x32_bf16(ra, sbh, ay[nt], 0, 0, 0);
        ay[nt] = __builtin_amdgcn_mfma_f32_16x16x32_bf16(ra, sbl, ay[nt], 0, 0, 0);
        const bf16x8 pb = *(const bf16x8*)(Pb + n * LH + k0);
        as[nt] = __builtin_amdgcn_mfma_f32_16x16x32_bf16(sah, pb, as[nt], 0, 0, 0);
        as[nt] = __builtin_amdgcn_mfma_f32_16x16x32_bf16(sal, pb, as[nt], 0, 0, 0);
      }
    }
    MM_FOREACH(ay, { YB[(size_t)(g0 + c * 64 + m) * 512 + n] = f2bf(val + Yf[m * LS + n]); });
    __syncthreads();
    MM_FOREACH(as, { Sf[m * LS + n] = val + Qf[m * LS + n]; });
  }
#undef CS_LOAD
  __syncthreads();
  for (int e = tid; e < 4096; e += NTHR) { const int i = e >> 6, j = e & 63; Sout[e] = Sf[i * LS + j]; }
}

__device__ __forceinline__ void phase_yfin(KPR p, int l) {
  const int tid = tidx(), wid = tid >> 6, lane = tid & 63;
  const float* YB = (const float*)(p.ws + W_YB); const float* RB = (const float*)(p.ws + W_RB); const float* KB = (const float*)(p.ws + W_KB);
  const float* VB = (const float*)(p.ws + W_VB); const u16* GB = (const u16*)(p.ws + W_GB); u16* AO = (u16*)(p.ws + W_AO);
  const float* rk = p.in[I_RK] + l * 512; const float* gng = p.in[I_GNG] + l * 512; const float* gnb = p.in[I_GNB] + l * 512;
  for (int g = blockIdx.x * 8 + wid; g < T; g += gridDim.x * 8) {
#pragma unroll 8
    for (int h = 0; h < 8; ++h) {
      size_t i = (size_t)g * 512 + h * 64 + lane;
      float y = bf2f(((const u16*)YB)[i]);
      float mu = wave_sum(y) * (1.f / 64.f);
      float dlt = y - mu;
      float var = wave_sum(dlt * dlt) * (1.f / 64.f);
      float bon = wave_sum(bf2f(((const u16*)RB)[i]) * bf2f(((const u16*)KB)[i]) * rk[h * 64 + lane]);
      float v = dlt * rsqrtf(var + 64e-5f) * gng[h * 64 + lane] + gnb[h * 64 + lane] + bon * bf2f(((const u16*)VB)[i]);
      AO[(size_t)g * 1536 + 1024 + h * 64 + lane] = f2bf(v * bf2f(GB[i]));
    }
  }
}

__device__ __forceinline__ void phase_init(KPR p) {
  const int G = gridDim.x, tid = tidx(), wid = tid >> 6, lane = tid & 63;
  const int gw = blockIdx.x * 8 + wid, nw = G * 8;
  {
    float* X = (float*)(p.ws + W_X); u16* XB = (u16*)(p.ws + W_XB); float* SSQ = (float*)(p.ws + W_SSQ);
    for (int g = gw; g < T; g += nw) {
      const float* src = g < TP ? p.in[I_XP] + (size_t)g * 1024 : p.in[I_XS] + (size_t)(g - TP) * 1024;
      float ss = 0.f;
#pragma unroll
      for (int i = 0; i < 4; ++i) {
        float4 v = *(const float4*)(src + i * 256 + lane * 4);
        *(float4*)(X + (size_t)g * 1024 + i * 256 + lane * 4) = v;
        uint2 w; w.x = pack2(v.x, v.y); w.y = pack2(v.z, v.w);
        *(uint2*)(XB + (size_t)g * 1024 + i * 256 + lane * 4) = w;
        ss += v.x * v.x + v.y * v.y + v.z * v.z + v.w * v.w;
      }
      ss = wave_sum(ss);
      if (lane == 0) *(float4*)(SSQ + (size_t)g * 4) = make_float4(ss, 0.f, 0.f, 0.f);
    }
  }
  {
    u16* MB = (u16*)(p.ws + W_MB);
    for (int g = gw; g < 1024; g += nw) {
      const float* src = p.in[I_MEMP] + (size_t)g * 1024;
      float4 v[4]; float ss = 0.f;
#pragma unroll
      for (int i = 0; i < 4; ++i) { v[i] = *(const float4*)(src + i * 256 + lane * 4); ss += v[i].x * v[i].x + v[i].y * v[i].y + v[i].z * v[i].z + v[i].w * v[i].w; }
      ss = wave_sum(ss);
      float rs = rsqrtf(ss * (1.f / 1024.f) + 1e-6f);
#pragma unroll
      for (int i = 0; i < 4; ++i) {
        uint2 w; w.x = pack2(v[i].x * rs, v[i].y * rs); w.y = pack2(v[i].z * rs, v[i].w * rs);
        *(uint2*)(MB + (size_t)g * 1024 + i * 256 + lane * 4) = w;
      }
    }
  }
  {
    float2* RT = (float2*)(p.ws + W_ROPE);
    for (int e = blockIdx.x * NTHR + tid; e < 4096 * 16; e += G * NTHR) {
      int pos = e >> 4, i = e & 15;
      float inv = powf(10000.f, -(float)i / 16.f);
      float ang = (float)pos * inv;
      float sn, cs; sincosf(ang, &sn, &cs);
      RT[e] = make_float2(cs, sn);
    }
  }
  int rot = 0;
  for (int l = 0; l < NL; ++l) {
    u16* WT = (u16*)(p.ws + W_WT) + (size_t)l * WE_LAYER;
    for (int f = 0; f < 2; ++f) {
      const float* nrm = p.in[f ? I_F2N : I_F1N] + l * 1024;
      const float* wg = p.in[f ? I_F2G : I_F1G] + (size_t)l * 1024 * DFF;
      const float* wu = p.in[f ? I_F2U : I_F1U] + (size_t)l * 1024 * DFF;
      const float* wd = p.in[f ? I_F2D : I_F1D] + (size_t)l * 1024 * DFF;
      tconv(WT + (f ? WE_GU2 : WE_GU1), 1024, 5632, 1024, rot, [=](int k, int n) {
        int j = (n >> 5) * 16 + (n & 15);
        const float* s = ((n >> 4) & 1) ? wu : wg;
        return nrm[k] * s[(size_t)k * DFF + j];
      });
      rot += 88 * 16;
      tconv(WT + (f ? WE_D2 : WE_D1), DFF, 1024, DFF, rot, [=](int k, int n) { return wd[(size_t)k * 1024 + n]; });
      rot += 16 * 44;
    }
    {
      const float* nrm = p.in[I_MIXN] + l * 1024; const float* w = p.in[I_WIN] + (size_t)l * 1024 * DIN;
      tconv(WT + WE_IN, 1024, DINP, 1024, rot, [=](int k, int n) { return n < DIN ? nrm[k] * w[(size_t)k * DIN + n] : 0.f; });
      rot += 36 * 16;
    }
    {
      const float* nrm = p.in[I_QN] + l * 256; const float* wuq = p.in[I_WUQ] + (size_t)l * 256 * 768;
      const float* wuk = p.in[I_WUK] + (size_t)l * 8 * 128 * 64;
      tconv(WT + WE_Q, 256, 1280, 256, rot, [=](int k, int n) {
        float r;
        if (n < 1024) {
          int h = n >> 7, c = n & 127;
          const float* a = wuq + (size_t)k * 768 + h * 96; const float* b = wuk + (size_t)(h * 128 + c) * 64;
          r = 0.f;
          for (int d = 0; d < 64; ++d) r += a[d] * b[d];
        } else {
          int hr = n - 1024;
          r = wuq[(size_t)k * 768 + (hr >> 5) * 96 + 64 + (hr & 31)];
        }
        return r * nrm[k] * QSCALE;
      });
      rot += 20 * 4;
    }
    {
      const float* wup = p.in[I_WUP] + (size_t)l * 64 * 512; const float* aup = p.in[I_AUP] + (size_t)l * 64 * 512;
      const float* gup = p.in[I_GUP] + (size_t)l * 128 * 512;
      tconv(WT + WE_RW, 256, 1536, 256, rot, [=](int k, int n) {
        if (n < 512) return k < 64 ? wup[k * 512 + n] : 0.f;
        if (n < 1024) return (k >= 64 && k < 128) ? aup[(k - 64) * 512 + n - 512] : 0.f;
        return k >= 128 ? gup[(k - 128) * 512 + n - 1024] : 0.f;
      });
      rot += 24 * 4;
    }
    {
      const float* wuv = p.in[I_WUV] + (size_t)l * 8 * 128 * 64; const float* wo = p.in[I_WOUT] + (size_t)l * 1024 * 1024;
      tconv(WT + WE_OUT, 1536, 1024, 1536, rot, [=](int k, int n) {
        if (k < 1024) {
          int h = k >> 7, c = k & 127;
          const float* a = wuv + (size_t)(h * 128 + c) * 64; const float* b = wo + (size_t)(h * 64) * 1024 + n;
          float r = 0.f;
          for (int v = 0; v < 64; ++v) r += a[v] * b[(size_t)v * 1024];
          return r;
        }
        return wo[(size_t)(512 + k - 1024) * 1024 + n];
      });
      rot += 16 * 24;
    }
    {
      const float* nx = p.in[I_XN] + l * 1024; const float* nm = p.in[I_MKVN] + l * 1024;
      const float* wq = p.in[I_WMQ] + (size_t)l * 1048576; const float* wk = p.in[I_WMK] + (size_t)l * 1048576;
      const float* wv = p.in[I_WMV] + (size_t)l * 1048576; const float* wo = p.in[I_WMO] + (size_t)l * 1048576;
      tconv(WT + WE_MQ, 1024, 1024, 1024, rot, [=](int k, int n) { return nx[k] * wq[(size_t)k * 1024 + n] * XSCALE; });
      tconv(WT + WE_MK, 1024, 1024, 1024, rot, [=](int k, int n) { return nm[k] * wk[(size_t)k * 1024 + n]; });
      tconv(WT + WE_MV, 1024, 1024, 1024, rot, [=](int k, int n) { return nm[k] * wv[(size_t)k * 1024 + n]; });
      tconv(WT + WE_MO, 1024, 1024, 1024, rot, [=](int k, int n) { return wo[(size_t)k * 1024 + n]; });
    }
  }
}

__device__ __forceinline__ void phase_prep(KPR p, int l) {
  extern __shared__ __attribute__((aligned(16))) char smem[];
  u16* sv = (u16*)smem;
  const int tid = tidx(), wid = tid >> 6, lane = tid & 63;
  const u16* PROJ = (const u16*)(p.ws + W_PROJ);
  u16* CQB = (u16*)(p.ws + W_CQB); u16* A2 = (u16*)(p.ws + W_A2);
  float* RB = (float*)(p.ws + W_RB); float* KB = (float*)(p.ws + W_KB); float* VB = (float*)(p.ws + W_VB); float* KKB = (float*)(p.ws + W_KKB);
  u16* KP = (u16*)(p.ws + W_KP); u16* KS = (u16*)(p.ws + W_KS); u16* VTP = (u16*)(p.ws + W_VTP); u16* VTS = (u16*)(p.ws + W_VTS);
  const float2* RT = (const float2*)(p.ws + W_ROPE);
  const float* kvn = p.in[I_KVN] + l * 128; const float* mu = p.in[I_MU] + l * DSH; const float* kkw = p.in[I_KK] + l * 512;
  for (int chunk = blockIdx.x; chunk < T / 72; chunk += gridDim.x) {
  __syncthreads();
  uint2 n_cq; unsigned n_ckv; u16 n_k1 = 0, n_k2 = 0; uint4 n_pb0, n_pb1, n_pb2, n_pb3 = make_uint4(0, 0, 0, 0);
  uint4 q_pb0, q_pb1, q_pb2, q_pb3 = make_uint4(0, 0, 0, 0);
#define PREP_LOAD(ROW) do { const u16* pr_ = PROJ + (size_t)(ROW) * DINP; \
    n_cq = *(const uint2*)(pr_ + lane * 4); n_ckv = *(const unsigned*)(pr_ + 256 + lane * 2); \
    if (lane < 16) { n_k1 = pr_[384 + lane]; n_k2 = pr_[400 + lane]; } \
    n_pb0 = *(const uint4*)(pr_ + 416 + lane * 8); n_pb1 = *(const uint4*)(pr_ + 416 + 512 + lane * 8); \
    n_pb2 = *(const uint4*)(pr_ + 416 + 1024 + lane * 8); if (lane < 32) n_pb3 = *(const uint4*)(pr_ + 416 + 1536 + lane * 8); } while (0)
  {
    const int gfirst = chunk * 72 + wid * 9;
    if (gfirst > 0) { PREP_LOAD(gfirst - 1); q_pb0 = n_pb0; q_pb1 = n_pb1; q_pb2 = n_pb2; q_pb3 = n_pb3; }
    else { q_pb0 = q_pb1 = q_pb2 = make_uint4(0, 0, 0, 0); }
    PREP_LOAD(gfirst);
  }
  for (int ri = 0; ri < 9; ++ri) {
    const int rl = wid * 9 + ri, g = chunk * 72 + rl;
    const u16* pr = PROJ + (size_t)g * DINP;
    const uint2 c_cq = n_cq; const unsigned c_ckv = n_ckv; const u16 c_k1 = n_k1, c_k2 = n_k2;
    const uint4 c_pb0 = n_pb0, c_pb1 = n_pb1, c_pb2 = n_pb2, c_pb3 = n_pb3;
    { const int gn = g + 1 < T ? g + 1 : g; PREP_LOAD(gn); }
    const bool isP = g < TP;
    int b, t, pos, tlen;
    if (isP) { b = g >> 12; t = g & 4095; pos = t; tlen = 4096; } else { int gg = g - TP; b = gg >> 6; t = gg & 63; pos = 2048 + t; tlen = 64; }
    {
      uint2 w = c_cq;
      float v0 = bf2f(w.x & 0xffff), v1 = bf2f(w.x >> 16), v2 = bf2f(w.y & 0xffff), v3 = bf2f(w.y >> 16);
      float ss = wave_sum(v0 * v0 + v1 * v1 + v2 * v2 + v3 * v3);
      float rs = rsqrtf(ss * (1.f / 256.f) + 1e-6f);
      uint2 o; o.x = pack2(v0 * rs, v1 * rs); o.y = pack2(v2 * rs, v3 * rs);
      *(uint2*)(CQB + (size_t)g * 256 + lane * 4) = o;
    }
    {
      unsigned w = c_ckv;
      float v0 = bf2f(w & 0xffff), v1 = bf2f(w >> 16);
      float ss = wave_sum(v0 * v0 + v1 * v1);
      float rs = rsqrtf(ss * (1.f / 128.f) + 1e-6f);
      int c = lane * 2;
      v0 = v0 * rs * kvn[c]; v1 = v1 * rs * kvn[c + 1];
      float* of = isP ? p.out + OO_CKVP + ((size_t)(l * 4 + b) * 4096 + t) * 128 : p.out + OO_CKVS + ((size_t)(l * 32 + b) * 64 + t) * 128;
      *(float2*)(of + c) = make_float2(v0, v1);
      u16* kr = isP ? KP + ((size_t)b * 4096 + t) * 160 : KS + ((size_t)b * 2112 + 2048 + t) * 160;
      *(unsigned*)(kr + c) = pack2(v0, v1);
      *(unsigned*)(sv + rl * 128 + c) = pack2(v0, v1);
      if (lane < 16) {
        float x1 = bf2f(c_k1), x2 = bf2f(c_k2);
        float2 cs = RT[pos * 16 + lane];
        float o1 = x1 * cs.x - x2 * cs.y, o2 = x1 * cs.y + x2 * cs.x;
        float* okr = isP ? p.out + OO_KRP + ((size_t)(l * 4 + b) * 4096 + t) * 32 : p.out + OO_KRS + ((size_t)(l * 32 + b) * 64 + t) * 32;
        okr[lane] = o1; okr[lane + 16] = o2;
        kr[128 + lane] = f2bf(o1); kr[144 + lane] = f2bf(o2);
      }
    }
    {
      const u16* pb = pr + 416;
      const u16* pp = pr - DINP + 416;
      const float* sh0 = p.in[I_SSH] + (size_t)(l * 32 + b) * DSH;
      const bool last = (t == tlen - 1);
      float* osh = isP ? p.out + OO_SHP + (size_t)(l * 4 + b) * DSH : p.out + OO_SHS + (size_t)(l * 32 + b) * DSH;
#pragma unroll
      for (int it = 0; it < 4; ++it) {
        const int c = it * 64 + lane;
        if (c < 224) {
          const int e = c * 8;
          const uint4 w = it == 0 ? c_pb0 : (it == 1 ? c_pb1 : (it == 2 ? c_pb2 : c_pb3));
          float pv[8] = {bf2f(w.x & 0xffff), bf2f(w.x >> 16), bf2f(w.y & 0xffff), bf2f(w.y >> 16), bf2f(w.z & 0xffff), bf2f(w.z >> 16), bf2f(w.w & 0xffff), bf2f(w.w >> 16)};
          float pq[8];
          if (t > 0) {
            const uint4 q = it == 0 ? q_pb0 : (it == 1 ? q_pb1 : (it == 2 ? q_pb2 : q_pb3));
            pq[0] = bf2f(q.x & 0xffff); pq[1] = bf2f(q.x >> 16); pq[2] = bf2f(q.y & 0xffff); pq[3] = bf2f(q.y >> 16);
            pq[4] = bf2f(q.z & 0xffff); pq[5] = bf2f(q.z >> 16); pq[6] = bf2f(q.w & 0xffff); pq[7] = bf2f(q.w >> 16);
          } else if (!isP) {
            float4 q0 = *(const float4*)(sh0 + e), q1 = *(const float4*)(sh0 + e + 4);
            pq[0] = q0.x; pq[1] = q0.y; pq[2] = q0.z; pq[3] = q0.w; pq[4] = q1.x; pq[5] = q1.y; pq[6] = q1.z; pq[7] = q1.w;
          } else {
#pragma unroll
            for (int j = 0; j < 8; ++j) pq[j] = 0.f;
          }
          float4 m0 = *(const float4*)(mu + e), m1 = *(const float4*)(mu + e + 4);
          float mm[8] = {m0.x, m0.y, m0.z, m0.w, m1.x, m1.y, m1.z, m1.w};
          float xs[8];
#pragma unroll
          for (int j = 0; j < 8; ++j) xs[j] = pv[j] + mm[j] * (pq[j] - pv[j]);
          if (last) { *(float4*)(osh + e) = make_float4(pv[0], pv[1], pv[2], pv[3]); *(float4*)(osh + e + 4) = make_float4(pv[4], pv[5], pv[6], pv[7]); }
          if (it == 0) {
            *(uint4*)((u16*)RB + (size_t)g * 512 + e) = make_uint4(pack2(xs[0], xs[1]), pack2(xs[2], xs[3]), pack2(xs[4], xs[5]), pack2(xs[6], xs[7]));
          } else if (it == 1) {
            const int cc = e - 512;
            *(uint4*)((u16*)KB + (size_t)g * 512 + cc) = make_uint4(pack2(xs[0], xs[1]), pack2(xs[2], xs[3]), pack2(xs[4], xs[5]), pack2(xs[6], xs[7]));
            float4 k0 = *(const float4*)(kkw + cc), k1 = *(const float4*)(kkw + cc + 4);
            float kk[8] = {xs[0] * k0.x, xs[1] * k0.y, xs[2] * k0.z, xs[3] * k0.w, xs[4] * k1.x, xs[5] * k1.y, xs[6] * k1.z, xs[7] * k1.w};
            float ss = 0.f;
#pragma unroll
            for (int j = 0; j < 8; ++j) ss += kk[j] * kk[j];
            ss = dpp_sum8(ss);
            float rn = rsqrtf(ss + 1e-12f);
            *(uint4*)((u16*)KKB + (size_t)g * 512 + cc) = make_uint4(pack2(kk[0] * rn, kk[1] * rn), pack2(kk[2] * rn, kk[3] * rn), pack2(kk[4] * rn, kk[5] * rn), pack2(kk[6] * rn, kk[7] * rn));
          } else if (it == 2) {
            *(uint4*)((u16*)VB + (size_t)g * 512 + (e - 1024)) = make_uint4(pack2(xs[0], xs[1]), pack2(xs[2], xs[3]), pack2(xs[4], xs[5]), pack2(xs[6], xs[7]));
          } else {
            const int cc = e - 1536;
            float y[8];
#pragma unroll
            for (int j = 0; j < 8; ++j) y[j] = cc < 64 ? (1.f - 2.f / (1.f + __expf(2.f * xs[j]))) : (cc < 128 ? xs[j] : sigmoidf_(xs[j]));
            uint4 o; o.x = pack2(y[0], y[1]); o.y = pack2(y[2], y[3]); o.z = pack2(y[4], y[5]); o.w = pack2(y[6], y[7]);
            *(uint4*)(A2 + (size_t)g * 256 + cc) = o;
          }
        }
      }
    }
    q_pb0 = c_pb0; q_pb1 = c_pb1; q_pb2 = c_pb2; q_pb3 = c_pb3;
  }
#undef PREP_LOAD
  __syncthreads();
  for (int idx = tid; idx < 128 * 9; idx += NTHR) {
    const int d = idx & 127, rl0 = (idx >> 7) * 8, g = chunk * 72 + rl0;
    unsigned w[4];
#pragma unroll
    for (int j = 0; j < 4; ++j) w[j] = (unsigned)sv[(rl0 + 2 * j) * 128 + d] | ((unsigned)sv[(rl0 + 2 * j + 1) * 128 + d] << 16);
    u16* dst;
    if (g < TP) dst = VTP + ((size_t)(g >> 12) * 128 + d) * 4096 + (g & 4095);
    else { const int gg = g - TP; dst = VTS + ((size_t)(gg >> 6) * 128 + d) * 2112 + 2048 + (gg & 63); }
    *(uint4*)dst = make_uint4(w[0], w[1], w[2], w[3]);
  }
  }
}

__device__ __forceinline__ void conv_caches(KPR p, int l, int vb, int nvb) {
  const int tid = tidx();
  u16* KS = (u16*)(p.ws + W_KS); u16* VTS = (u16*)(p.ws + W_VTS);
  {
    const float* cckv = p.in[I_CCKV] + (size_t)l * 32 * 2048 * 128;
    const float* ckr = p.in[I_CKR] + (size_t)l * 32 * 2048 * 32;
#pragma unroll 4
    for (int idx = vb * NTHR + tid; idx < 32 * 2048 * 20; idx += nvb * NTHR) {
      int rowi = idx / 20, ch = idx % 20;
      int b = rowi >> 11, t = rowi & 2047;
      const float* s = ch < 16 ? cckv + (size_t)rowi * 128 + ch * 8 : ckr + (size_t)rowi * 32 + (ch - 16) * 8;
      float4 a = *(const float4*)s, c = *(const float4*)(s + 4);
      uint4 o; o.x = pack2(a.x, a.y); o.y = pack2(a.z, a.w); o.z = pack2(c.x, c.y); o.w = pack2(c.z, c.w);
      *(uint4*)(KS + ((size_t)b * 2112 + t) * 160 + ch * 8) = o;
    }
    tconv_v(VTS, 2112, 4096, 2048, vb, nvb, [=](int k, int n) { return cckv[((size_t)(n >> 7) * 2048 + k) * 128 + (n & 127)]; });
    const float* cmk = p.in[I_CMK] + (size_t)l * 32 * 256 * 1024;
    const float* cmv = p.in[I_CMV] + (size_t)l * 32 * 256 * 1024;
    u16* MKS = (u16*)(p.ws + W_MKS); u16* MVTS = (u16*)(p.ws + W_MVTS);
#pragma unroll 4
    for (int idx = vb * NTHR + tid; idx < 32 * 4 * 256 * 32; idx += nvb * NTHR) {
      int d8 = idx & 31, m = (idx >> 5) & 255, h = (idx >> 13) & 3, b = idx >> 15;
      const float* s = cmk + ((size_t)(b * 256 + m) * 4 + h) * 256 + d8 * 8;
      float4 a = *(const float4*)s, c = *(const float4*)(s + 4);
      uint4 o; o.x = pack2(a.x, a.y); o.y = pack2(a.z, a.w); o.z = pack2(c.x, c.y); o.w = pack2(c.z, c.w);
      *(uint4*)(MKS + (size_t)idx * 8) = o;
    }
    tconv_v(MVTS, 256, 32768, 256, vb, nvb, [=](int k, int n) { return cmv[((size_t)((n >> 10) * 256 + k) * 4 + ((n >> 8) & 3)) * 256 + (n & 255)]; });
  }
}

__device__ __forceinline__ void mla_sub(KPR p, int b, int c, int half) {
  const u16* QB = (const u16*)(p.ws + W_QB); u16* AO = (u16*)(p.ws + W_AO);
  size_t tok = (size_t)b * 4096 + c * 64 + half * 32;
  attn_item<160, 128, 8>(QB + tok * 1280, 160, 256, (const u16*)(p.ws + W_KP) + (size_t)b * 4096 * 160, 160,
                         (const u16*)(p.ws + W_VTP) + (size_t)b * 128 * 4096, 4096, (c + 1) * 64, AO + tok * 1536, 1536);
}
__device__ __forceinline__ void phase_mix(KPR p, int l, int mode = 0) {
  extern __shared__ __attribute__((aligned(16))) char smem[];
  int* sItem = (int*)(smem + SMEM_ITEM);
  int* cnt = (int*)(p.ws + W_CNT) + l + mode * 8;
  for (;;) {
    __syncthreads();
    if (threadIdx.x == 0) *sItem = atomicAdd(cnt, 1);
    __syncthreads();
    int it = *sItem;
    if (it >= 864) break;
    if (mode == 2 && (it < 32 || it >= 608)) continue;
    if (it < 32) {
      int b = it >> 3, h = it & 7;
      cseq_item(p, b * 4096, h, 64, (b * 8 + h) * 64, nullptr, p.out + OO_WKVP + ((size_t)(l * 4 + b) * 8 + h) * 4096);
    } else if (it < 608) {
      int k = it - 32;
      if (k >= 248 && k < 312) {
        int j = k - 248; int b = j >> 1, half = j & 1;
        const u16* QB = (const u16*)(p.ws + W_QB); u16* AO = (u16*)(p.ws + W_AO);
        size_t tok = (size_t)TP + b * 64 + half * 32;
        attn_item<160, 128, 8>(QB + tok * 1280, 160, 256, (const u16*)(p.ws + W_KS) + (size_t)b * 2112 * 160, 160,
                               (const u16*)(p.ws + W_VTS) + (size_t)b * 128 * 2112, 2112, 2112, AO + tok * 1536, 1536);
      } else {
        if (k >= 312) k -= 64;
        int c = 63 - (k >> 3), b = (k >> 1) & 3, half = k & 1;
        mla_sub(p, b, c, half);
      }
    } else {
      int k = it - 608; int b = k >> 3, h = k & 7;
      cseq_item(p, TP + b * 64, h, 1, 2048 + k, p.in[I_SWKV] + ((size_t)(l * 32 + b) * 8 + h) * 4096,
                p.out + OO_WKVS + ((size_t)(l * 32 + b) * 8 + h) * 4096);
    }
  }
}

__device__ __forceinline__ void xattn_item(KPR p, int l, int it) {
  const u16* QX = (const u16*)(p.ws + W_QX); u16* XO = (u16*)(p.ws + W_XO);
  if (it < 256) {
    int b = it >> 6, h = (it >> 4) & 3, qt = it & 15;
    size_t tok = (size_t)b * 4096 + qt * 256;
    for (int hv = 0; hv < 2; ++hv)
      attn_item<256, 128, 1>(QX + tok * 1024 + h * 256, 1024, 256, (const u16*)(p.ws + W_MKP) + (size_t)((l * 4 + b) * 4 + h) * 65536, 256,
                             (const u16*)(p.ws + W_MVTP) + (size_t)((l * 4 + b) * 4 + h) * 65536 + hv * 128 * 256, 256, 256, XO + tok * 1024 + h * 256 + hv * 128, 1024);
  } else {
    int k = it - 256; int b = k >> 2, h = k & 3;
    size_t tok = (size_t)TP + b * 64;
    for (int hv = 0; hv < 2; ++hv)
      attn_item<256, 128, 1>(QX + tok * 1024 + h * 256, 1024, 64, (const u16*)(p.ws + W_MKS) + (size_t)(b * 4 + h) * 65536, 256,
                             (const u16*)(p.ws + W_MVTS) + (size_t)(b * 4 + h) * 65536 + hv * 128 * 256, 256, 256, XO + tok * 1024 + h * 256 + hv * 128, 1024);
  }
}

constexpr int CH_NST = 10;
__device__ __forceinline__ void phase_chain(KPR p, int ci, int dup = 0) {
  extern __shared__ __attribute__((aligned(16))) char smem[];
  int* sItem = (int*)(smem + SMEM_ITEM);
  int* CT = (int*)(p.ws + W_CNT) + dup * 8192;
  const float rc = dup ? 0.f : 1.f;
  int* q = CT + 3800 + ci; int* xa = CT + 72 + ci; int* oa = CT + 80 + ci;
  int* cnt = CT + 128 + ci * CH_NST * 72;
  int* stamp = CT + 4096 + ci * CH_NST * 72;
  int* G = CT + 8000 + ci; int* xast = CT + 8010 + ci; int* oast = CT + 8020 + ci;
  int lastG = 0;
  const bool hasTail = ci >= 1, hasHead = ci < NL;
  const int lt = ci - 1, lh = ci;
  const int e0 = hasTail ? 288 : 0, e1 = e0 + (hasTail ? 288 : 0), e2 = e1 + (hasTail ? 384 : 0), e3 = e2 + (hasTail ? 288 : 0),
            e4 = e3 + (hasTail ? 792 : 0), e5 = e4 + (hasTail ? 288 : 0), e6 = e5 + (hasHead ? 792 : 0), e7 = e6 + (hasHead ? 288 : 0),
            e8 = e7 + (hasHead ? 224 : 0), e9 = e8 + (hasHead ? 648 : 0);
  float* X = (float*)(p.ws + W_X); u16* XB = (u16*)(p.ws + W_XB); float* SSQ = (float*)(p.ws + W_SSQ); u16* ACT = (u16*)(p.ws + W_ACT);
  const int grp = blockIdx.x & 7;
  int nxt = 0;
  if (tidx() == 0) nxt = atomicAdd(q + grp * 8, 1) * 8 + grp;
  for (;;) {
    const int tid = tidx();
    if (tid == 0) {
      const int it = nxt;
      if (it < e9) {
        int st, idx;
        if (it < e0) { st = 0; idx = it; } else if (it < e1) { st = 1; idx = it - e0; } else if (it < e2) { st = 2; idx = it - e1; }
        else if (it < e3) { st = 3; idx = it - e2; } else if (it < e4) { st = 4; idx = it - e3; } else if (it < e5) { st = 5; idx = it - e4; }
        else if (it < e6) { st = 6; idx = it - e5; } else if (it < e7) { st = 7; idx = it - e6; } else if (it < e8) { st = 8; idx = it - e7; }
        else { st = 9; idx = it - e8; }
        int pm = 0, pn = 0;
        if (st == 2) pm = idx < 256 ? ((idx >> 6) * 16 + (idx & 15)) : (64 + ((idx - 256) >> 4));
        else if (st != 8) tile_map(idx, 72, (st == 4 || st == 6) ? 11 : (st == 9 ? 9 : 4), pm, pn);
        const int* c1 = nullptr; const int* c2 = nullptr;
        switch (st) {
          case 1: c1 = stamp + 0 * 72 + pm; break;
          case 2: c1 = stamp + 1 * 72 + pm; break;
          case 3: c1 = stamp + 2 * 72 + pm; break;
          case 4: c1 = stamp + 3 * 72 + pm; c2 = xast; break;
          case 5: c1 = stamp + 4 * 72 + pm; break;
          case 6: if (hasTail) c1 = stamp + 5 * 72 + pm; break;
          case 7: c1 = stamp + 6 * 72 + pm; break;
          case 8: if (hasTail) c1 = xast; break;
          case 9: c1 = stamp + 7 * 72 + pm; if (hasTail) c2 = oast; break;
          default: break;
        }
        if (dup) { c1 = nullptr; c2 = nullptr; }
        int s1 = 0, s2 = 0;
        if (c1) while ((s1 = __hip_atomic_load(c1, __ATOMIC_RELAXED, __HIP_MEMORY_SCOPE_AGENT)) == 0) __builtin_amdgcn_s_sleep(4);
        if (c2) while ((s2 = __hip_atomic_load(c2, __ATOMIC_RELAXED, __HIP_MEMORY_SCOPE_AGENT)) == 0) __builtin_amdgcn_s_sleep(4);
        if ((s1 > s2 ? s1 : s2) >= lastG) {
          const int g = __hip_atomic_load(G, __ATOMIC_RELAXED, __HIP_MEMORY_SCOPE_AGENT);
          __builtin_amdgcn_fence(__ATOMIC_ACQUIRE, "agent");
          asm volatile("s_waitcnt vmcnt(0)" ::: "memory");
          lastG = g;
        }
        sItem[1] = st; sItem[2] = idx; sItem[3] = pm; sItem[4] = pn;
      }
      sItem[0] = it;
    }
    __syncthreads();
    if (sItem[0] >= e9) break;
    const int st = sItem[1], idx = sItem[2], pm = sItem[3], pn = sItem[4];
    if (tid == 0) nxt = atomicAdd(q + grp * 8, 1) * 8 + grp;
    if (dup && !((PROBE_MASK >> st) & 1)) { __syncthreads(); continue; }
    const u16* WTt = (const u16*)(p.ws + W_WT) + (size_t)(lt < 0 ? 0 : lt) * WE_LAYER;
    const u16* WTh = (const u16*)(p.ws + W_WT) + (size_t)(lh >= NL ? 0 : lh) * WE_LAYER;
    switch (st) {
      case 0: gemm_tile((const u16*)(p.ws + W_AO), WTt + WE_OUT, 1536, pm, pn, EpiRes{X, XB, SSQ, rc}); break;
      case 1: gemm_tile(XB, WTt + WE_MQ, 1024, pm, pn, EpiScaleBf{SSQ, (u16*)(p.ws + W_QX), 1024}); break;
      case 2: xattn_item(p, lt, idx); break;
      case 3: gemm_tile((const u16*)(p.ws + W_XO), WTt + WE_MO, 1024, pm, pn, EpiRes{X, XB, SSQ, rc}); break;
      case 4: gemm_tile(XB, WTt + WE_GU2, 1024, pm, 2 * pn, EpiGU{SSQ, ACT}); gemm_tile(XB, WTt + WE_GU2, 1024, pm, 2 * pn + 1, EpiGU{SSQ, ACT}); break;
      case 5: gemm_tile(ACT, WTt + WE_D2, DFF, pm, pn, EpiRes{X, XB, SSQ, 0.5f * rc}); break;
      case 6: gemm_tile(XB, WTh + WE_GU1, 1024, pm, 2 * pn, EpiGU{SSQ, ACT}); gemm_tile(XB, WTh + WE_GU1, 1024, pm, 2 * pn + 1, EpiGU{SSQ, ACT}); break;
      case 7: gemm_tile(ACT, WTh + WE_D1, DFF, pm, pn, EpiRes{X, XB, SSQ, 0.5f * rc}); break;
      case 8: conv_caches(p, lh, idx, 224); break;
      default: gemm_tile(XB, WTh + WE_IN, 1024, pm, pn, EpiScaleBf{SSQ, (u16*)(p.ws + W_PROJ), DINP}); break;
    }
    asm volatile("s_waitcnt vmcnt(0)" ::: "memory");
    __syncthreads();
    if (tidx() == 64) {
      __builtin_amdgcn_fence(__ATOMIC_RELEASE, "agent");
      asm volatile("s_waitcnt vmcnt(0)" ::: "memory");
      atomicAdd(G, 1);
      const int full = (st == 4 || st == 6) ? 11 : (st == 9 ? 9 : (st == 2 ? (pm < 64 ? 4 : 16) : 4));
      if (atomicAdd(cnt + st * 72 + pm, 1) + 1 == full)
        __hip_atomic_store(stamp + st * 72 + pm, __hip_atomic_load(G, __ATOMIC_RELAXED, __HIP_MEMORY_SCOPE_AGENT), __ATOMIC_RELAXED, __HIP_MEMORY_SCOPE_AGENT);
      if (st == 2 && atomicAdd(xa, 1) + 1 == 384)
        __hip_atomic_store(xast, __hip_atomic_load(G, __ATOMIC_RELAXED, __HIP_MEMORY_SCOPE_AGENT), __ATOMIC_RELAXED, __HIP_MEMORY_SCOPE_AGENT);
      if (st == 0 && atomicAdd(oa, 1) + 1 == 288)
        __hip_atomic_store(oast, __hip_atomic_load(G, __ATOMIC_RELAXED, __HIP_MEMORY_SCOPE_AGENT), __ATOMIC_RELAXED, __HIP_MEMORY_SCOPE_AGENT);
    }
  }
}

__device__ __forceinline__ void phase_final(KPR p) {
  const int tid = tidx(), wid = tid >> 6, lane = tid & 63;
  const float* X = (const float*)(p.ws + W_X); const float* fn = p.in[I_FN];
  for (int g = blockIdx.x * 8 + wid; g < T; g += gridDim.x * 8) {
    float4 v[4]; float ss = 0.f;
#pragma unroll
    for (int i = 0; i < 4; ++i) { v[i] = *(const float4*)(X + (size_t)g * 1024 + i * 256 + lane * 4); ss += v[i].x * v[i].x + v[i].y * v[i].y + v[i].z * v[i].z + v[i].w * v[i].w; }
    ss = wave_sum(ss);
    float rs = rsqrtf(ss * (1.f / 1024.f) + 1e-6f);
#pragma unroll
    for (int i = 0; i < 4; ++i) {
      float4 gn = *(const float4*)(fn + i * 256 + lane * 4);
      *(float4*)(p.out + OO_Y + (size_t)g * 1024 + i * 256 + lane * 4) = make_float4(v[i].x * rs * gn.x, v[i].y * rs * gn.y, v[i].z * rs * gn.z, v[i].w * rs * gn.w);
    }
  }
}

constexpr int NPL = 6;
constexpr int N_PHASES = 3 + NPL * NL + 1;

__device__ __forceinline__ void run_phase(KPR p, int ph) {
  if (ph == 0) { phase_init(p); return; }
  if (ph == 1) {
    for (int l = 0; l < NL; ++l) {
      const u16* WT = (const u16*)(p.ws + W_WT) + (size_t)l * WE_LAYER;
      gemm_phase((const u16*)(p.ws + W_MB), WT + WE_MK, 1024, 4, 4, (2 * l) * 16,
                 EpiMem<false>{p.out + OO_MKP + (size_t)l * 1048576, (u16*)(p.ws + W_MKP) + (size_t)l * 16 * 65536});
      gemm_phase((const u16*)(p.ws + W_MB), WT + WE_MV, 1024, 4, 4, (2 * l + 1) * 16,
                 EpiMem<true>{p.out + OO_MVP + (size_t)l * 1048576, (u16*)(p.ws + W_MVTP) + (size_t)l * 16 * 65536});
    }
    return;
  }
  if (ph == 2) { phase_chain(p, 0); if (PROBE_REP & 1) { cg::this_grid().sync(); phase_chain(p, 0, 1); } return; }
  if (ph == N_PHASES - 1) { if (PROBE_REP & 64) for (int i = 0; i < 40; ++i) cg::this_grid().sync(); phase_final(p); return; }
  const int l = (ph - 3) / NPL, s = (ph - 3) % NPL;
  const u16* WT = (const u16*)(p.ws + W_WT) + (size_t)l * WE_LAYER;
  switch (s) {
    case 0: phase_prep(p, l); if (PROBE_REP & 2) { cg::this_grid().sync(); phase_prep(p, l); } break;
    case 1:
      gemm_phase((const u16*)(p.ws + W_CQB), WT + WE_Q, 256, 72, 5, 0, EpiQ{(u16*)(p.ws + W_QB), (const float2*)(p.ws + W_ROPE)});
      gemm_phase((const u16*)(p.ws + W_A2), WT + WE_RW, 256, 72, 6, 360,
                 EpiRW{p.in[I_W0] + l * 512, p.in[I_A0] + l * 512, p.in[I_KA] + l * 512, p.ws});
      break;
    case 2: phase_cprep(p); if (PROBE_REP & 8) { cg::this_grid().sync(); phase_cprep(p); } break;
    case 3: phase_mix(p, l, 0); if (PROBE_REP & 16) { cg::this_grid().sync(); phase_mix(p, l, 2); } break;
    case 4: phase_yfin(p, l); if (PROBE_REP & 32) { cg::this_grid().sync(); phase_yfin(p, l); } break;
    default: phase_chain(p, l + 1); if (PROBE_REP & 1) { cg::this_grid().sync(); phase_chain(p, l + 1, 1); } break;
  }
}

__device__ __forceinline__ void grid_barrier(int* CT, int gen) {
  asm volatile("s_waitcnt vmcnt(0)" ::: "memory");
  __syncthreads();
  if (tidx() == 0) {
    __builtin_amdgcn_fence(__ATOMIC_RELEASE, "agent");
    asm volatile("s_waitcnt vmcnt(0)" ::: "memory");
    int* grpc = CT + 15000 + (blockIdx.x & 7) * 32;
    int* glob = CT + 15000 + 8 * 32;
    const int per = gridDim.x >> 3;
    if (atomicAdd(grpc, 1) + 1 == per * (gen + 1)) atomicAdd(glob, 1);
    while (__hip_atomic_load(glob, __ATOMIC_RELAXED, __HIP_MEMORY_SCOPE_AGENT) < 8 * (gen + 1)) __builtin_amdgcn_s_sleep(1);
    __builtin_amdgcn_fence(__ATOMIC_ACQUIRE, "agent");
    asm volatile("s_waitcnt vmcnt(0)" ::: "memory");
  }
  __syncthreads();
}

__global__ void __launch_bounds__(NTHR) mega(Params p) {
  cg::grid_group grid = cg::this_grid();
  for (int ph = p.ph_lo; ph < p.ph_hi; ++ph) {
    const __attribute__((address_space(4))) Params* q = (const __attribute__((address_space(4))) Params*)__builtin_amdgcn_kernarg_segment_ptr();
    asm volatile("" : "+s"(q));
    run_phase(*q, ph);
    if (ph + 1 < p.ph_hi) {
      if (ph == p.ph_lo) grid.sync();
      else grid_barrier((int*)(q->ws + W_CNT), ph - p.ph_lo - 1);
    }
  }
}

extern "C" void kernel_launch(void* const* d_in, const int* in_sizes, int n_in, void* d_out, int out_size, void* d_ws,
                              size_t ws_size, hipStream_t stream) {
  static int grid = 0;
  if (grid == 0) {
    if (n_in != N_IN || (size_t)out_size != OO_END || ws_size < W_END) {
      fprintf(stderr, "kernel_launch: unexpected shapes n_in=%d out=%d ws=%zu (need %zu)\n", n_in, out_size, ws_size, (size_t)W_END);
      grid = -1; return;
    }
    int dev = 0, cus = 0, per_cu = 0;
    hipGetDevice(&dev);
    hipDeviceGetAttribute(&cus, hipDeviceAttributeMultiprocessorCount, dev);
    hipFuncSetAttribute((const void*)mega, hipFuncAttributeMaxDynamicSharedMemorySize, SMEM_BYTES);
    hipOccupancyMaxActiveBlocksPerMultiprocessor(&per_cu, (const void*)mega, NTHR, SMEM_BYTES);
    if (per_cu < 1) { fprintf(stderr, "kernel_launch: occupancy query says %d blocks/CU\n", per_cu); per_cu = 1; }
    (void)hipGetLastError();
    grid = cus;
  }
  if (grid < 0) return;
  if (hipMemsetAsync((char*)d_ws + W_CNT, 0, 65536, stream) != hipSuccess) { fprintf(stderr, "kernel_launch: memset of control words failed\n"); return; }
  Params p{};
  for (int i = 0; i < N_IN; ++i) p.in[i] = (const float*)d_in[i];
  p.out = (float*)d_out; p.ws = (char*)d_ws;
#if N_LAUNCH_PER_PHASE
  for (int ph = 0; ph < N_PHASES; ++ph) {
    p.ph_lo = ph; p.ph_hi = ph + 1;
    void* args[] = {&p};
    hipError_t e = hipLaunchCooperativeKernel((const void*)mega, dim3(grid), dim3(NTHR), args, SMEM_BYTES, stream);
    if (e != hipSuccess) { fprintf(stderr, "launch failed: %s\n", hipGetErrorString(e)); break; }
  }
#else
  p.ph_lo = 0; p.ph_hi = N_PHASES;
  void* args[] = {&p};
  hipError_t e = hipLaunchCooperativeKernel((const void*)mega, dim3(grid), dim3(NTHR), args, SMEM_BYTES, stream);
  if (e != hipSuccess) fprintf(stderr, "cooperative launch failed: %s (grid %d)\n", hipGetErrorString(e), grid);
#endif
}
```
